# Optimizing an MI355X kernel written in HIP

```python
import jax
import jax.numpy as jnp
from jax import lax
import numpy as np

D_MODEL = 1024
BATCH = 32
SEQ = 2048
DEPTH = 4

CHUNK = 64
N_MEM = 256
ROPE_THETA = 10000.0
NORM_EPS = 1e-6
NEG_INF = -1e30

RWKV_HEADS = 8
RWKV_HEAD_DIM = 64
RWKV_DIM = RWKV_HEADS * RWKV_HEAD_DIM
RWKV_DECAY_RANK = 64
RWKV_A_RANK = 64
RWKV_V_RANK = 32
RWKV_GATE_RANK = 128
RWKV_LNX_EPS = 1e-5 * RWKV_HEAD_DIM
RWKV_SIZES = (RWKV_DIM, RWKV_DIM, RWKV_DIM, RWKV_DECAY_RANK, RWKV_A_RANK, RWKV_GATE_RANK)
RWKV_COLS = sum(RWKV_SIZES)

DSA_HEADS = 8
DSA_HEAD_DIM = 64
DSA_DIM = DSA_HEADS * DSA_HEAD_DIM
IDX_HEADS = 8
IDX_DIM = 64
DSA_TOPK_MAX = 256
Q_BLOCK = 128
DSA_SIZES = (DSA_DIM, DSA_HEAD_DIM, DSA_HEAD_DIM, IDX_HEADS * IDX_DIM, IDX_DIM, IDX_HEADS)
DSA_COLS = sum(DSA_SIZES)

IN_SIZES = (RWKV_COLS, DSA_COLS, D_MODEL, D_MODEL)
N_IN = sum(IN_SIZES)

MEM_HEADS = 4
MEM_HEAD_DIM = 128
MEM_DIM = MEM_HEADS * MEM_HEAD_DIM

FFN_DIM = 2816
N_EXPERTS = 8
TOP_K = 2
EXPERT_DIM = 1408
N_DENSE = (DEPTH + 1) // 2
N_MOE = DEPTH // 2

kernel_name = 'hybrid_rwkv7_dsa_memxattn_moe_trunk'


def split_cols(t, sizes):
    return jnp.split(t, np.cumsum(sizes)[:-1].tolist(), axis=-1)


def rms_norm(x, g):
    x32 = x.astype(jnp.float32)
    y = x32 * lax.rsqrt(jnp.mean(x32 * x32, axis=-1, keepdims=True) + NORM_EPS)
    return (y * g.astype(jnp.float32)).astype(x.dtype)


def rope_tables(positions, dim):
    inv_freq = 1.0 / (ROPE_THETA ** (jnp.arange(0, dim, 2, dtype=jnp.float32) / dim))
    ang = positions.astype(jnp.float32)[..., None] * inv_freq
    return jnp.cos(ang), jnp.sin(ang)


def apply_rope(x, cos, sin):
    shape = cos.shape[:2] + (1,) * (x.ndim - 3) + cos.shape[2:]
    c, s = cos.reshape(shape), sin.reshape(shape)
    x1, x2 = jnp.split(x.astype(jnp.float32), 2, axis=-1)
    return jnp.concatenate([x1 * c - x2 * s, x2 * c + x1 * s], axis=-1).astype(x.dtype)


def token_shift(t):
    return jnp.pad(t[:, :-1], ((0, 0), (1, 0), (0, 0)))


def rwkv7_scan(r, w, k, v, a, b):
    bsz, _, h, n = r.shape
    xs = tuple(jnp.moveaxis(t, 1, 0) for t in (r, w, k, v, a, b))

    def step(state, inp):
        r_t, w_t, k_t, v_t, a_t, b_t = inp
        sa = jnp.einsum('bhvk,bhk->bhv', state, a_t)
        state = (state * w_t[:, :, None, :] + sa[..., None] * b_t[:, :, None, :]
                 + v_t[..., None] * k_t[:, :, None, :])
        return state, jnp.einsum('bhvk,bhk->bhv', state, r_t)

    _, ys = lax.scan(step, jnp.zeros((bsz, h, n, n), jnp.float32), xs)
    return jnp.moveaxis(ys, 0, 1)


def rwkv7_branch(cols, v_first, mu, w0, w2, a0, a2, g2, v_mix, k_k, k_a, r_k, lnx_g, lnx_b):
    bsz, seqlen, _ = cols.shape
    cols = cols + (token_shift(cols) - cols) * mu
    r, k, v, wd, ad, gd = split_cols(cols, RWKV_SIZES)
    w_log = -jax.nn.softplus(-(w0 + jnp.tanh(wd) @ w2)) - 0.5
    a = jax.nn.sigmoid(a0 + ad @ a2)
    g = jax.nn.sigmoid(gd) @ g2
    if v_mix is None:
        v_first = v
    else:
        v0, v1, v2 = v_mix
        v = v + (v_first - v) * jax.nn.sigmoid(v0 + (v @ v1) @ v2)
    heads = lambda t: t.astype(jnp.float32).reshape(bsz, seqlen, RWKV_HEADS, RWKV_HEAD_DIM)
    kk = heads(k * k_k)
    kk = kk / jnp.maximum(jnp.sqrt(jnp.sum(kk * kk, axis=-1, keepdims=True)), 1e-12)
    k = k * (1.0 + (a - 1.0) * k_a)
    rh, kh, vh, ah = heads(r), heads(k), heads(v), heads(a)
    decay = jnp.exp(-jnp.exp(heads(w_log)))
    y = rwkv7_scan(rh, decay, kh, vh, -kk, kk * ah)
    mean = jnp.mean(y, axis=-1, keepdims=True)
    var = jnp.mean(jnp.square(y - mean), axis=-1, keepdims=True)
    y = (y - mean) * lax.rsqrt(var + RWKV_LNX_EPS)
    y = y.reshape(bsz, seqlen, RWKV_DIM) * lnx_g.astype(jnp.float32) + lnx_b.astype(jnp.float32)
    bonus = jnp.sum(rh * kh * r_k.astype(jnp.float32), axis=-1, keepdims=True) * vh
    y = y + bonus.reshape(bsz, seqlen, RWKV_DIM)
    return (y * g.astype(jnp.float32)).astype(cols.dtype), v_first


def dsa_attention(q, k, v, q_idx, k_idx, w_idx):
    length = q.shape[1]
    top_k = min(DSA_TOPK_MAX, length // 4)
    key_pos = jnp.arange(length)
    gather = jax.vmap(lambda t, i: t[i])
    k_idx32 = k_idx.astype(jnp.float32)

    def query_block(i):
        start = i * Q_BLOCK
        qb = lax.dynamic_slice_in_dim(q, start, Q_BLOCK, axis=1)
        qib = lax.dynamic_slice_in_dim(q_idx, start, Q_BLOCK, axis=1).astype(jnp.float32)
        wb = lax.dynamic_slice_in_dim(w_idx, start, Q_BLOCK, axis=1).astype(jnp.float32)
        limit = ((start + jnp.arange(Q_BLOCK)) // CHUNK + 1) * CHUNK
        admissible = key_pos[None, :] < limit[:, None]
        logits = jnp.einsum('bqhd,bsd->bqhs', qib, k_idx32) * (IDX_DIM ** -0.5)
        score = jnp.einsum('bqhs,bqh->bqs', jax.nn.relu(logits), wb) * (IDX_HEADS ** -0.5)
        score = jnp.where(admissible[None], score, NEG_INF)
        _, sel = lax.top_k(score, top_k)
        valid = sel < limit[None, :, None]
        ks, vs = gather(k, sel), gather(v, sel)
        s = jnp.einsum('bqhd,bqkd->bqhk', qb, ks).astype(jnp.float32) * (DSA_HEAD_DIM ** -0.5)
        p = jax.nn.softmax(jnp.where(valid[:, :, None, :], s, NEG_INF), axis=-1)
        return jnp.einsum('bqhk,bqkd->bqhd', p.astype(vs.dtype), vs)

    out = lax.map(query_block, jnp.arange(length // Q_BLOCK))
    return jnp.moveaxis(out, 0, 1).reshape(q.shape)


def dsa_branch(cols, cos_q, sin_q, cos_i, sin_i, q_norm, k_norm, idx_k_norm):
    bsz, seqlen, _ = cols.shape
    q, k, v, iq, ik, iw = split_cols(cols, DSA_SIZES)
    q = apply_rope(rms_norm(q.reshape(bsz, seqlen, DSA_HEADS, DSA_HEAD_DIM), q_norm), cos_q, sin_q)
    k = apply_rope(rms_norm(k, k_norm), cos_q, sin_q)
    iq = apply_rope(iq.reshape(bsz, seqlen, IDX_HEADS, IDX_DIM), cos_i, sin_i)
    ik = apply_rope(rms_norm(ik, idx_k_norm), cos_i, sin_i)
    return dsa_attention(q, k, v, iq, ik, iw).reshape(bsz, seqlen, DSA_DIM)


def memory_attention(h, mem_n, wq, wkv, q_norm, k_norm, wo):
    bsz, seqlen, _ = h.shape
    n_mem = mem_n.shape[1]
    q = rms_norm((h @ wq).reshape(bsz, seqlen, MEM_HEADS, MEM_HEAD_DIM), q_norm)
    k, v = split_cols(mem_n @ wkv, (MEM_DIM, MEM_DIM))
    k = rms_norm(k.reshape(bsz, n_mem, MEM_HEADS, MEM_HEAD_DIM), k_norm)
    v = v.reshape(bsz, n_mem, MEM_HEADS, MEM_HEAD_DIM)
    s = jnp.einsum('bshd,bmhd->bhsm', q, k).astype(jnp.float32) * (MEM_HEAD_DIM ** -0.5)
    p = jax.nn.softmax(s, axis=-1).astype(v.dtype)
    o = jnp.einsum('bhsm,bmhd->bshd', p, v).reshape(bsz, seqlen, MEM_DIM)
    return o @ wo


def swiglu(h, wg, wu, wd):
    return (jax.nn.silu(h @ wg) * (h @ wu)) @ wd


def moe_swiglu(h, router, bias, wg, wu, wd):
    logits = (h @ router).astype(jnp.float32) + bias.astype(jnp.float32)
    top_logit, top_idx = lax.top_k(logits, TOP_K)
    top_w = jax.nn.softmax(top_logit, axis=-1)
    gates = jnp.sum(jax.nn.one_hot(top_idx, N_EXPERTS, dtype=jnp.float32) * top_w[..., None], axis=-2)
    gates = gates.astype(h.dtype)
    out = jnp.zeros_like(h)
    for e in range(N_EXPERTS):
        out = out + gates[..., e:e + 1] * swiglu(h, wg[e], wu[e], wd[e])
    return out


def setup_inputs(seed: int = 0) -> dict:
    keys = iter(jax.random.split(jax.random.key(seed), 48))
    f32 = jnp.float32

    def normal(shape, scale):
        return jax.random.normal(next(keys), shape, f32) * scale

    def gain(shape):
        return 1.0 + normal(shape, 0.02)

    x = normal((BATCH, SEQ, D_MODEL), 1.0)
    mem = normal((BATCH, N_MEM, D_MODEL), 1.0)
    offsets = jax.random.randint(next(keys), (BATCH, 1), 0, 64) * CHUNK
    positions = (offsets + jnp.arange(SEQ)[None, :]).astype(jnp.int32)
    nv = DEPTH - 1
    return {
        'x': x,
        'mem': mem,
        'positions': positions,
        'norm_mix': gain((DEPTH, D_MODEL)),
        'w_in': normal((DEPTH, D_MODEL, N_IN), D_MODEL ** -0.5),
        'rwkv_mu': jax.random.uniform(next(keys), (DEPTH, RWKV_COLS), f32, 0.0, 1.0),
        'rwkv_w0': jax.random.uniform(next(keys), (DEPTH, RWKV_DIM), f32, -6.0, -1.0),
        'rwkv_w2': normal((DEPTH, RWKV_DECAY_RANK, RWKV_DIM), 0.5 * RWKV_DECAY_RANK ** -0.5),
        'rwkv_a0': normal((DEPTH, RWKV_DIM), 0.1),
        'rwkv_a2': normal((DEPTH, RWKV_A_RANK, RWKV_DIM), RWKV_A_RANK ** -0.5),
        'rwkv_g2': normal((DEPTH, RWKV_GATE_RANK, RWKV_DIM), RWKV_GATE_RANK ** -0.5),
        'rwkv_v0': normal((nv, RWKV_DIM), 0.5),
        'rwkv_v1': normal((nv, RWKV_DIM, RWKV_V_RANK), RWKV_DIM ** -0.5),
        'rwkv_v2': normal((nv, RWKV_V_RANK, RWKV_DIM), RWKV_V_RANK ** -0.5),
        'rwkv_kk': 0.85 + normal((DEPTH, RWKV_DIM), 0.02),
        'rwkv_ka': gain((DEPTH, RWKV_DIM)),
        'rwkv_rk': normal((DEPTH, RWKV_HEADS, RWKV_HEAD_DIM), 0.1),
        'rwkv_lnx_g': gain((DEPTH, RWKV_DIM)),
        'rwkv_lnx_b': normal((DEPTH, RWKV_DIM), 0.02),
        'dsa_q_norm': gain((DEPTH, DSA_HEAD_DIM)),
        'dsa_k_norm': gain((DEPTH, DSA_HEAD_DIM)),
        'idx_k_norm': gain((DEPTH, IDX_DIM)),
        'w_branch_a': normal((DEPTH, RWKV_DIM, D_MODEL), RWKV_DIM ** -0.5),
        'w_branch_b': normal((DEPTH, DSA_DIM, D_MODEL), DSA_DIM ** -0.5),
        'w_out': normal((DEPTH, D_MODEL, D_MODEL), 0.5 * D_MODEL ** -0.5),
        'norm_mem': gain((DEPTH, D_MODEL)),
        'mem_tok_norm': gain((DEPTH, D_MODEL)),
        'mem_wq': normal((DEPTH, D_MODEL, MEM_DIM), D_MODEL ** -0.5),
        'mem_wkv': normal((DEPTH, D_MODEL, 2 * MEM_DIM), D_MODEL ** -0.5),
        'mem_q_norm': gain((DEPTH, MEM_HEAD_DIM)),
        'mem_k_norm': gain((DEPTH, MEM_HEAD_DIM)),
        'mem_wo': normal((DEPTH, MEM_DIM, D_MODEL), 0.5 * MEM_DIM ** -0.5),
        'norm_ffn': gain((DEPTH, D_MODEL)),
        'ffn_wg': normal((N_DENSE, D_MODEL, FFN_DIM), D_MODEL ** -0.5),
        'ffn_wu': normal((N_DENSE, D_MODEL, FFN_DIM), D_MODEL ** -0.5),
        'ffn_wd': normal((N_DENSE, FFN_DIM, D_MODEL), 0.5 * FFN_DIM ** -0.5),
        'moe_router': normal((N_MOE, D_MODEL, N_EXPERTS), D_MODEL ** -0.5),
        'moe_bias': normal((N_MOE, N_EXPERTS), 0.01),
        'moe_wg': normal((N_MOE, N_EXPERTS, D_MODEL, EXPERT_DIM), D_MODEL ** -0.5),
        'moe_wu': normal((N_MOE, N_EXPERTS, D_MODEL, EXPERT_DIM), D_MODEL ** -0.5),
        'moe_wd': normal((N_MOE, N_EXPERTS, EXPERT_DIM, D_MODEL), 0.5 * EXPERT_DIM ** -0.5),
    }


def reference(x, mem, positions, norm_mix, w_in, rwkv_mu, rwkv_w0, rwkv_w2, rwkv_a0, rwkv_a2,
              rwkv_g2, rwkv_v0, rwkv_v1, rwkv_v2, rwkv_kk, rwkv_ka, rwkv_rk, rwkv_lnx_g, rwkv_lnx_b,
              dsa_q_norm, dsa_k_norm, idx_k_norm, w_branch_a, w_branch_b, w_out, norm_mem,
              mem_tok_norm, mem_wq, mem_wkv, mem_q_norm, mem_k_norm, mem_wo, norm_ffn, ffn_wg,
              ffn_wu, ffn_wd, moe_router, moe_bias, moe_wg, moe_wu, moe_wd):
    cos_q, sin_q = rope_tables(positions, DSA_HEAD_DIM)
    cos_i, sin_i = rope_tables(positions, IDX_DIM)
    v_first = None
    for l in range(DEPTH):
        h = rms_norm(x, norm_mix[l])
        cols_a, cols_b, gate_a, gate_b = split_cols(h @ w_in[l], IN_SIZES)
        v_mix = None if l == 0 else (rwkv_v0[l - 1], rwkv_v1[l - 1], rwkv_v2[l - 1])
        y_a, v_first = rwkv7_branch(cols_a, v_first, rwkv_mu[l], rwkv_w0[l], rwkv_w2[l], rwkv_a0[l],
                                    rwkv_a2[l], rwkv_g2[l], v_mix, rwkv_kk[l], rwkv_ka[l], rwkv_rk[l],
                                    rwkv_lnx_g[l], rwkv_lnx_b[l])
        y_b = dsa_branch(cols_b, cos_q, sin_q, cos_i, sin_i, dsa_q_norm[l], dsa_k_norm[l], idx_k_norm[l])
        merged = (jax.nn.sigmoid(gate_a) * (y_a @ w_branch_a[l])
                  + jax.nn.sigmoid(gate_b) * (y_b @ w_branch_b[l]))
        x = x + merged @ w_out[l]
        x = x + memory_attention(rms_norm(x, norm_mem[l]), rms_norm(mem, mem_tok_norm[l]), mem_wq[l],
                                 mem_wkv[l], mem_q_norm[l], mem_k_norm[l], mem_wo[l])
        h = rms_norm(x, norm_ffn[l])
        j = l // 2
        if l % 2 == 0:
            x = x + swiglu(h, ffn_wg[j], ffn_wu[j], ffn_wd[j])
        else:
            x = x + moe_swiglu(h, moe_router[j], moe_bias[j], moe_wg[j], moe_wu[j], moe_wd[j])
    return x
```

```cpp
#include <hip/hip_runtime.h>
#include <cstdio>
#include <cstdint>

#ifndef MK_ONE_LAUNCH
#define MK_ONE_LAUNCH 0
#endif

namespace pg8 {
#define PG8_LAS __attribute__((address_space(3)))
typedef unsigned short bf16_t;
typedef short bf16x8 __attribute__((ext_vector_type(8)));
typedef float f32x4 __attribute__((ext_vector_type(4)));
typedef float f32x2 __attribute__((ext_vector_type(2)));
typedef unsigned u32x4 __attribute__((ext_vector_type(4)));
typedef unsigned u32x2 __attribute__((ext_vector_type(2)));
typedef __bf16 bf16x2_t __attribute__((ext_vector_type(2)));
constexpr int BM = 256, BK = 64, HALF = 128, HTB = HALF * BK * 2, STAGE_BYTES = 8 * HTB, NXCD = 8, WGM = 8;

__host__ __device__ __forceinline__ int lds_byte(int r, int c) { const int st = (r >> 4) * 2 + (c >> 5), rr = r & 15, cc = c & 31, ob = rr * 64 + cc * 2; return st * 1024 + (ob ^ (((ob >> 9) & 1) << 5)); }
__host__ __device__ __forceinline__ void stage_rc(int b, int& R, int& C) { const int st = b / 1024, sb = b % 1024, swz = sb ^ (((sb >> 9) & 1) << 5); R = (st >> 1) * 16 + swz / 64; C = (st & 1) * 32 + (swz % 64) / 2; }
__host__ __device__ __forceinline__ int perm32(int rho) { const int n = rho >> 4, i = rho & 15; return 8 * (i >> 2) + 4 * n + (i & 3); }

struct Unit { int pm, pn, e; };
struct Gemm { const bf16_t* A; const bf16_t* Bt; int K; size_t bstride; const int* rowidx; };

struct StaticOrder {
    int nM, nN, nwg, G, c;
    __device__ void init(int M, int N, int G_, int c_) { nM = M / BM; nN = N / BM; nwg = nM * nN; G = G_; c = c_; }
    __device__ bool next(int i, Unit& u) const {
        const long L = (long)i * G + c; if (L >= nwg) return false;
        int wgid = (int)L; { const int q = nwg / NXCD, r = nwg % NXCD, xcd = wgid % NXCD, off = wgid / NXCD; wgid = (xcd < r ? xcd * (q + 1) : r * (q + 1) + (xcd - r) * q) + off; }
        const int nig = WGM * nN, gid = wgid / nig, fm = gid * WGM, gsz = (nM - fm) < WGM ? (nM - fm) : WGM;
        u.pm = fm + ((wgid % nig) % gsz); u.pn = (wgid % nig) / gsz; u.e = 0; return true;
    }
};
struct MoeOrder {
    int nM, nN, nwg, G, c, pm0; const int* tile_e;
    __device__ void init(int nM_, int nN_, int G_, int c_, int pm0_, const int* te) { nM = nM_; nN = nN_; nwg = nM * nN; G = G_; c = c_; pm0 = pm0_; tile_e = te; }
    __device__ bool next(int i, Unit& u) const {
        const long L = (long)i * G + c; if (L >= nwg) return false;
        int wgid = (int)L; { const int q = nwg / NXCD, r = nwg % NXCD, xcd = wgid % NXCD, off = wgid / NXCD; wgid = (xcd < r ? xcd * (q + 1) : r * (q + 1) + (xcd - r) * q) + off; }
        const int nig = WGM * nN, gid = wgid / nig, fm = gid * WGM, gsz = (nM - fm) < WGM ? (nM - fm) : WGM;
        u.pm = pm0 + fm + ((wgid % nig) % gsz); u.pn = (wgid % nig) / gsz; u.e = __builtin_amdgcn_readfirstlane(tile_e[u.pm]); return true;
    }
};

__device__ __forceinline__ unsigned pk2(float lo, float hi) { const bf16x2_t v = __builtin_convertvector((f32x2){lo, hi}, bf16x2_t); return __builtin_bit_cast(unsigned, v); }
__device__ __forceinline__ float bf_lo(unsigned u) { return __builtin_bit_cast(float, u << 16); }
__device__ __forceinline__ float bf_hi(unsigned u) { return __builtin_bit_cast(float, u & 0xffff0000u); }
__device__ __forceinline__ float bf2f(bf16_t b) { return __builtin_bit_cast(float, (unsigned)b << 16); }
__device__ __forceinline__ bf16_t f2bf(float f) { return (bf16_t)(pk2(f, 0.f) & 0xffffu); }
__device__ __forceinline__ float sigmoidf_(float x) { return __builtin_amdgcn_rcpf(1.0f + __expf(-x)); }

struct EpiPlain {
    static constexpr bool PERM = true;
    bf16_t* O; int ldc;
    __device__ __forceinline__ void operator()(const f32x4 (&acc)[2][2][4][2], const Unit& u, int wr, int wc, int fr, int fq) const {
        const int row0 = u.pm * BM + wr * 64 + fr, col0 = u.pn * BM + wc * 32 + 8 * fq;
#pragma unroll
        for (int ai = 0; ai < 2; ++ai)
#pragma unroll
            for (int m = 0; m < 4; ++m) { bf16_t* rowp = O + (size_t)(row0 + ai * HALF + m * 16) * ldc + col0;
#pragma unroll
                for (int bj = 0; bj < 2; ++bj) { const f32x4 v0 = acc[ai][bj][m][0], v1 = acc[ai][bj][m][1];
                    u32x4 w; w.x = pk2(v0[0], v0[1]); w.y = pk2(v0[2], v0[3]); w.z = pk2(v1[0], v1[1]); w.w = pk2(v1[2], v1[3]);
                    *(u32x4*)(rowp + bj * HALF) = w; } }
    }
};
struct EpiWin {
    static constexpr bool PERM = true;
    bf16_t *CA, *CB, *CG;
    __device__ __forceinline__ void operator()(const f32x4 (&acc)[2][2][4][2], const Unit& u, int wr, int wc, int fr, int fq) const {
        const int row0 = u.pm * BM + wr * 64 + fr; const int pn = u.pn;
        bf16_t* base; int ldc, ct; const bool sg = pn >= 12;
        if (pn < 7) { base = CA; ldc = 1792; ct = pn; } else if (pn < 12) { base = CB; ldc = 1280; ct = pn - 7; } else { base = CG; ldc = 2048; ct = pn - 12; }
        const int col0 = ct * BM + wc * 32 + 8 * fq;
#pragma unroll
        for (int ai = 0; ai < 2; ++ai)
#pragma unroll
            for (int m = 0; m < 4; ++m) { bf16_t* rowp = base + (size_t)(row0 + ai * HALF + m * 16) * ldc + col0;
#pragma unroll
                for (int bj = 0; bj < 2; ++bj) { f32x4 v0 = acc[ai][bj][m][0], v1 = acc[ai][bj][m][1];
                    if (sg) {
#pragma unroll
                        for (int j = 0; j < 4; ++j) { v0[j] = sigmoidf_(v0[j]); v1[j] = sigmoidf_(v1[j]); } }
                    u32x4 w; w.x = pk2(v0[0], v0[1]); w.y = pk2(v0[2], v0[3]); w.z = pk2(v1[0], v1[1]); w.w = pk2(v1[2], v1[3]);
                    *(u32x4*)(rowp + bj * HALF) = w; } }
    }
};
template <bool ADD> struct EpiMerge {
    static constexpr bool PERM = true;
    bf16_t* O; const bf16_t* gate; int gcol;
    __device__ __forceinline__ void operator()(const f32x4 (&acc)[2][2][4][2], const Unit& u, int wr, int wc, int fr, int fq) const {
        const int row0 = u.pm * BM + wr * 64 + fr, col0 = u.pn * BM + wc * 32 + 8 * fq;
#pragma unroll
        for (int ai = 0; ai < 2; ++ai)
#pragma unroll
            for (int m = 0; m < 4; ++m) { const size_t row = (size_t)(row0 + ai * HALF + m * 16);
                bf16_t* rowp = O + row * 1024 + col0; const bf16_t* gp = gate + row * 2048 + gcol + col0;
#pragma unroll
                for (int bj = 0; bj < 2; ++bj) { const f32x4 v0 = acc[ai][bj][m][0], v1 = acc[ai][bj][m][1];
                    const u32x4 g = *(const u32x4*)(gp + bj * HALF);
                    float o[8] = { bf_lo(g.x) * v0[0], bf_hi(g.x) * v0[1], bf_lo(g.y) * v0[2], bf_hi(g.y) * v0[3], bf_lo(g.z) * v1[0], bf_hi(g.z) * v1[1], bf_lo(g.w) * v1[2], bf_hi(g.w) * v1[3] };
                    if (ADD) { const u32x4 p = *(const u32x4*)(rowp + bj * HALF);
                        o[0] += bf_lo(p.x); o[1] += bf_hi(p.x); o[2] += bf_lo(p.y); o[3] += bf_hi(p.y); o[4] += bf_lo(p.z); o[5] += bf_hi(p.z); o[6] += bf_lo(p.w); o[7] += bf_hi(p.w); }
                    u32x4 w; w.x = pk2(o[0], o[1]); w.y = pk2(o[2], o[3]); w.z = pk2(o[4], o[5]); w.w = pk2(o[6], o[7]);
                    *(u32x4*)(rowp + bj * HALF) = w; } }
    }
};
struct EpiResid {
    static constexpr bool PERM = false;
    const float* xi; float* xo;
    __device__ __forceinline__ void operator()(const f32x4 (&acc)[2][2][4][2], const Unit& u, int wr, int wc, int fr, int fq) const {
        const int row0 = u.pm * BM + wr * 64 + fr, col0 = u.pn * BM + wc * 32 + 4 * fq;
#pragma unroll
        for (int ai = 0; ai < 2; ++ai)
#pragma unroll
            for (int m = 0; m < 4; ++m) { const size_t o = (size_t)(row0 + ai * HALF + m * 16) * 1024 + col0;
#pragma unroll
                for (int bj = 0; bj < 2; ++bj)
#pragma unroll
                    for (int n = 0; n < 2; ++n) { const f32x4 x = *(const f32x4*)(xi + o + bj * HALF + n * 16); *(f32x4*)(xo + o + bj * HALF + n * 16) = x + acc[ai][bj][m][n]; } }
    }
};
struct EpiSwiGLU {
    static constexpr bool PERM = true;
    bf16_t* O; int ldc;
    __device__ __forceinline__ void operator()(const f32x4 (&acc)[2][2][4][2], const Unit& u, int wr, int wc, int fr, int fq) const {
        const int row0 = u.pm * BM + wr * 64 + fr, col0 = u.pn * HALF + wc * 32 + 8 * fq;
#pragma unroll
        for (int ai = 0; ai < 2; ++ai)
#pragma unroll
            for (int m = 0; m < 4; ++m) { bf16_t* rowp = O + (size_t)(row0 + ai * HALF + m * 16) * ldc + col0;
                float o[8];
#pragma unroll
                for (int n = 0; n < 2; ++n)
#pragma unroll
                    for (int j = 0; j < 4; ++j) { const float g = acc[ai][0][m][n][j], up = acc[ai][1][m][n][j]; o[4 * n + j] = g * sigmoidf_(g) * up; }
                u32x4 w; w.x = pk2(o[0], o[1]); w.y = pk2(o[2], o[3]); w.z = pk2(o[4], o[5]); w.w = pk2(o[6], o[7]);
                *(u32x4*)rowp = w; }
    }
};
struct EpiMoeDown {
    static constexpr bool PERM = false;
    float* x; const int* tok; const float* wgt;
    __device__ __forceinline__ void operator()(const f32x4 (&acc)[2][2][4][2], const Unit& u, int wr, int wc, int fr, int fq) const {
        const int row0 = u.pm * BM + wr * 64 + fr, col0 = u.pn * BM + wc * 32 + 4 * fq;
#pragma unroll
        for (int ai = 0; ai < 2; ++ai)
#pragma unroll
            for (int m = 0; m < 4; ++m) { const int row = row0 + ai * HALF + m * 16; const int t = tok[row]; const float wv = wgt[row];
                if (t >= 0) { float* xp = x + (size_t)t * 1024 + col0;
#pragma unroll
                    for (int bj = 0; bj < 2; ++bj)
#pragma unroll
                        for (int n = 0; n < 2; ++n) { const f32x4 xv = *(const f32x4*)(xp + bj * HALF + n * 16); *(f32x4*)(xp + bj * HALF + n * 16) = xv + acc[ai][bj][m][n] * wv; } } }
    }
};

template <class Epi, class Sched, bool GATHER = false>
__device__ __forceinline__ void gemm_phase(PG8_LAS unsigned char* lds, const Gemm g, const Sched& S, const Epi& E) {
    int tid_ = threadIdx.x; asm volatile("" : "+v"(tid_));
    const int tid = tid_, wid = __builtin_amdgcn_readfirstlane(tid >> 6), lane = tid & 63, wr = wid >> 2, wc = wid & 3, fr = lane & 15, fq = lane >> 4;
    const int K = g.K, nt = K / BK;
    unsigned voffA[2], voffB[2];
#pragma unroll
    for (int i = 0; i < 2; ++i) { int R, C; stage_rc(tid * 16 + i * 8192, R, C); const int Rb = Epi::PERM ? ((R & ~31) + perm32(R & 31)) : R;
        voffA[i] = (unsigned)(R * K + C) * 2u; voffB[i] = (unsigned)(Rb * K + C) * 2u; }
    const size_t kstep = (size_t)(BK * 2);
    const size_t hstep = (size_t)HALF * K * 2;
    const size_t tstep = 2 * hstep;
    const unsigned ldsw = (unsigned)wid * 1024u;
    const int aoff = lds_byte(wr * 64 + fr, fq * 8), boff = lds_byte(wc * 32 + fr, fq * 8);
    unsigned gvo[2][2];
#define PG8_SA(b, h) (((b) * 2 + (h)) * HTB)
#define PG8_SB(b, h) ((4 + (b) * 2 + (h)) * HTB)
#define PG8_STAGE(bufoff, gbase, voff) do { _Pragma("unroll") for (int _i = 0; _i < 2; ++_i) \
        __builtin_amdgcn_global_load_lds((const unsigned*)((const char*)(gbase) + (voff)[_i]), (PG8_LAS unsigned*)(lds + (bufoff) + ldsw + _i * 8192), 16, 0, 0); } while (0)
#define PG8_STAGE_A(bufoff, h, ubase, kb, nx) do { if constexpr (GATHER) { PG8_STAGE(bufoff, (const char*)g.A + (kb), gvo[h]); } \
        else { PG8_STAGE(bufoff, (ubase) + (kb) + (h) * hstep, voffA); } } while (0)
#define PG8_LOADROWS(dst, unit) do { if constexpr (GATHER) { _Pragma("unroll") for (int _i = 0; _i < 2; ++_i) { int _R, _C; stage_rc(tid * 16 + _i * 8192, _R, _C); \
        _Pragma("unroll") for (int _h = 0; _h < 2; ++_h) { int _t = g.rowidx[(unit).pm * BM + _h * HALF + _R]; _t = _t < 0 ? 0 : _t; dst[_h][_i] = (unsigned)(_t * K + _C) * 2u; } } } } while (0)
#define PG8_LDA(dst, b, h) do { _Pragma("unroll") for (int m = 0; m < 4; ++m) _Pragma("unroll") for (int k = 0; k < 2; ++k) dst[m][k] = *(const PG8_LAS bf16x8*)(lds + PG8_SA(b, h) + aoff + m * 2048 + k * 1024); } while (0)
#define PG8_LDB(dst, b, h) do { _Pragma("unroll") for (int n = 0; n < 2; ++n) _Pragma("unroll") for (int k = 0; k < 2; ++k) dst[n][k] = *(const PG8_LAS bf16x8*)(lds + PG8_SB(b, h) + boff + n * 2048 + k * 1024); } while (0)
#define PG8_MMA(ai, bj, At, Bt) do { __builtin_amdgcn_s_setprio(1); _Pragma("unroll") for (int m = 0; m < 4; ++m) _Pragma("unroll") for (int n = 0; n < 2; ++n) _Pragma("unroll") for (int k = 0; k < 2; ++k) \
        acc[ai][bj][m][n] = __builtin_amdgcn_mfma_f32_16x16x32_bf16(Bt[n][k], At[m][k], acc[ai][bj][m][n], 0, 0, 0); __builtin_amdgcn_s_setprio(0); } while (0)
#define PG8_WAIT_V(n) asm volatile("s_waitcnt vmcnt(" #n ")" ::: "memory")
#define PG8_WAIT_L(n) asm volatile("s_waitcnt lgkmcnt(" #n ")" ::: "memory")
#define PG8_BAR __builtin_amdgcn_s_barrier()
#define PG8_SCHED __builtin_amdgcn_sched_barrier(0)
    Unit cur, nxt; int ui = 0;
    if (!S.next(0, cur)) return;
    f32x4 acc[2][2][4][2];
#pragma unroll
    for (int a = 0; a < 2; ++a)
#pragma unroll
        for (int b = 0; b < 2; ++b)
#pragma unroll
            for (int m = 0; m < 4; ++m)
#pragma unroll
                for (int n = 0; n < 2; ++n) acc[a][b][m][n] = (f32x4){0.f, 0.f, 0.f, 0.f};
    bf16x8 At[4][2], B0[2][2], B1[2][2];
    const char* cA = GATHER ? (const char*)g.A : (const char*)g.A + (size_t)cur.pm * tstep;
    const char* cB = (const char*)g.Bt + ((size_t)cur.e * g.bstride) * 2 + (size_t)cur.pn * tstep;
    PG8_LOADROWS(gvo, cur);
    PG8_STAGE(PG8_SB(0, 0), cB, voffB); PG8_STAGE(PG8_SB(0, 1), cB + hstep, voffB); PG8_STAGE_A(PG8_SA(0, 0), 0, cA, 0, false); PG8_STAGE_A(PG8_SA(0, 1), 1, cA, 0, false);
    if (wr == 1) PG8_BAR;
    PG8_WAIT_V(2); PG8_BAR;
    PG8_STAGE(PG8_SB(1, 0), cB + kstep, voffB); PG8_STAGE_A(PG8_SA(1, 0), 0, cA, kstep, false); PG8_STAGE(PG8_SB(1, 1), cB + hstep + kstep, voffB);
    PG8_WAIT_V(6); PG8_BAR;
    for (;;) {
        const bool has_next = S.next(ui + 1, nxt);
        const char* nA = GATHER ? (const char*)g.A : (has_next ? (const char*)g.A + (size_t)nxt.pm * tstep : cA);
        const char* nB = has_next ? (const char*)g.Bt + ((size_t)nxt.e * g.bstride) * 2 + (size_t)nxt.pn * tstep : cB;
        for (int t = 0; t < nt; t += 2) {
            const bool last = (t == nt - 2);
            const size_t k1 = (size_t)(t + 1) * kstep;
            const size_t k2 = last ? 0 : (size_t)(t + 2) * kstep, k3 = k2 + kstep;
            const char* a2b = last ? nA : cA; const char* b2 = (last ? nB : cB) + k2; const char* b3 = b2 + kstep;
            PG8_LDB(B0, 0, 0); PG8_LDB(B1, 0, 1); PG8_SCHED; PG8_LDA(At, 0, 0); PG8_STAGE_A(PG8_SA(1, 1), 1, cA, k1, false);
            if (last && has_next) PG8_LOADROWS(gvo, nxt);
            PG8_WAIT_V(8); PG8_WAIT_L(0); PG8_BAR; PG8_MMA(0, 0, At, B0); PG8_MMA(0, 1, At, B1); PG8_BAR; PG8_SCHED;
            PG8_LDA(At, 0, 1); PG8_STAGE(PG8_SB(0, 0), b2, voffB); PG8_STAGE(PG8_SB(0, 1), b2 + hstep, voffB); PG8_STAGE_A(PG8_SA(0, 0), 0, a2b, k2, last);
            PG8_WAIT_V(8); PG8_WAIT_L(0); PG8_BAR; PG8_MMA(1, 0, At, B0); PG8_MMA(1, 1, At, B1); PG8_BAR; PG8_SCHED;
            PG8_LDB(B0, 1, 0); PG8_LDB(B1, 1, 1); PG8_SCHED; PG8_LDA(At, 1, 0); PG8_STAGE_A(PG8_SA(0, 1), 1, a2b, k2, last);
            PG8_WAIT_V(8); PG8_WAIT_L(0); PG8_BAR; PG8_MMA(0, 0, At, B0); PG8_MMA(0, 1, At, B1); PG8_BAR; PG8_SCHED;
            PG8_LDA(At, 1, 1); PG8_STAGE(PG8_SB(1, 0), b3, voffB); PG8_STAGE(PG8_SB(1, 1), b3 + hstep, voffB); PG8_STAGE_A(PG8_SA(1, 0), 0, a2b, k3, last);
            PG8_WAIT_V(8); PG8_WAIT_L(0); PG8_BAR; PG8_MMA(1, 0, At, B0); PG8_MMA(1, 1, At, B1); PG8_BAR; PG8_SCHED;
        }
        E(acc, cur, wr, wc, fr, fq);
        if (!has_next) break;
#pragma unroll
        for (int a = 0; a < 2; ++a)
#pragma unroll
            for (int b = 0; b < 2; ++b)
#pragma unroll
                for (int m = 0; m < 4; ++m)
#pragma unroll
                    for (int n = 0; n < 2; ++n) acc[a][b][m][n] = (f32x4){0.f, 0.f, 0.f, 0.f};
        cur = nxt; cA = nA; cB = nB; ++ui;
    }
    PG8_WAIT_V(0);
    if (wr == 0) PG8_BAR;
    PG8_BAR;
#undef PG8_SA
#undef PG8_SB
#undef PG8_STAGE
#undef PG8_STAGE_A
#undef PG8_LOADROWS
#undef PG8_LDA
#undef PG8_LDB
#undef PG8_MMA
#undef PG8_WAIT_V
#undef PG8_WAIT_L
#undef PG8_BAR
#undef PG8_SCHED
}
}
using pg8::bf16_t; using pg8::bf16x8; using pg8::f32x4; using pg8::f32x2; using pg8::u32x4; using pg8::u32x2; using pg8::pk2; using pg8::bf2f; using pg8::f2bf; using pg8::bf_lo; using pg8::bf_hi; using pg8::sigmoidf_;

constexpr int NWAVES = 8, NTHR = 512;
constexpr int D = 1024, NB = 32, SEQ = 2048, T = NB * SEQ, TH = T / 2, DEPTH = 4;
constexpr int RW_COLS = 1792, DS_COLS = 1224, DS_PAD = 1280, N_IN = 5064, N_INP = 5120;
constexpr int NMEM = 256, MEMROWS = NB * NMEM;
constexpr int FFN = 2816, NEXP = 8, EDIM = 1408;
constexpr int MOE_ROWS_MAX = 2 * T + 16 * 256;
constexpr int MOE_TILES_MAX = MOE_ROWS_MAX / 256;

constexpr size_t MiB = 1u << 20;
constexpr size_t WS_CTL = 0, CTL_ZERO_BYTES = 1 * MiB;
constexpr size_t WS_MOE = 1 * MiB;
constexpr size_t MOE_SELE = WS_MOE, MOE_SELW = MOE_SELE + (size_t)T * 2, MOE_ROWTOK = MOE_SELW + (size_t)T * 8, MOE_ROWW = MOE_ROWTOK + (size_t)MOE_ROWS_MAX * 4,
                 MOE_TILEE = MOE_ROWW + (size_t)MOE_ROWS_MAX * 4, MOE_META = MOE_TILEE + (size_t)MOE_TILES_MAX * 4, MOE_END = MOE_META + 256;
static_assert(MOE_END <= 4 * MiB, "moe map");
constexpr size_t WS_W = 4 * MiB;
constexpr size_t W_IN = WS_W, W_BA = W_IN + (size_t)N_INP * D * 2, W_BB = W_BA + (size_t)D * 512 * 2, W_OUT = W_BB + (size_t)D * 512 * 2, W_MQ = W_OUT + (size_t)D * D * 2,
                 W_MO = W_MQ + (size_t)512 * D * 2, W_FF = W_MO + (size_t)D * 512 * 2;
constexpr size_t W_FGU = W_FF, W_FD = W_FGU + (size_t)2 * FFN * D * 2;
constexpr size_t W_EGU = W_FF, W_ED = W_EGU + (size_t)NEXP * 2 * EDIM * D * 2, W_END = W_ED + (size_t)NEXP * D * EDIM * 2;
static_assert(W_FD + (size_t)D * FFN * 2 <= W_END, "w map");
constexpr size_t WS_WKV = (W_END + MiB - 1) / MiB * MiB;
constexpr size_t WS_MEMH = WS_WKV + (size_t)4096 * D * 2;
constexpr size_t WS_MEMK = WS_MEMH + (size_t)MEMROWS * D * 2;
constexpr size_t WS_MEMVT = WS_MEMK + (size_t)DEPTH * MEMROWS * 512 * 2;
constexpr size_t WS_VFIRST = WS_MEMVT + (size_t)DEPTH * MEMROWS * 512 * 2;
constexpr size_t WS_HN = WS_VFIRST + (size_t)T * 512 * 2;
constexpr size_t WS_MIX = WS_HN + (size_t)T * D * 2;
constexpr size_t MX_CA = WS_MIX, MX_CB = MX_CA + (size_t)TH * RW_COLS * 2, MX_CG = MX_CB + (size_t)TH * DS_PAD * 2, MX_RW = MX_CG + (size_t)TH * 2048 * 2;
constexpr size_t RW_ARR = (size_t)TH * 512 * 2;
constexpr size_t MX_VT = MX_RW + 7 * RW_ARR, MX_YB = MX_VT + (size_t)(NB / 2) * 64 * SEQ * 2, MX_END = MX_YB + (size_t)TH * 512 * 2;
constexpr size_t MA_QM = WS_MIX, MA_OM = MA_QM + (size_t)T * 512 * 2;
constexpr size_t FF_GU = WS_MIX;
constexpr size_t PR_KVRAW = WS_MIX;
constexpr size_t WS_END = MX_END;
static_assert(FF_GU + (size_t)T * FFN * 2 <= WS_END && FF_GU + (size_t)MOE_ROWS_MAX * EDIM * 2 <= WS_END && MA_OM + (size_t)T * 512 * 2 <= WS_END, "overlay map");
static_assert(WS_END <= 1000 * MiB, "workspace budget");

constexpr int LDS_BYTES = 160 * 1024;
constexpr int LDS_MISC = LDS_BYTES - 256;

#define XB_TMO      128
#define XB_XCNT(j)  (256  + 64 * (j))
#define XB_XSUB(j)  (1280 + 64 * (j))
#define XB_XGEN(j)  (2304 + 64 * (j))
#define XB_TOP      3328
#define XB_TOPGEN   3392
#define XCD_BAR_WORDS 3456
#define XB_SPIN_CAP (1u << 18)
#define LAS __attribute__((address_space(3)))

__device__ __forceinline__ unsigned xb_ld(unsigned* p)              { return __hip_atomic_load(p, __ATOMIC_RELAXED, __HIP_MEMORY_SCOPE_AGENT); }
__device__ __forceinline__ unsigned xb_add(unsigned* p, unsigned v) { return __hip_atomic_fetch_add(p, v, __ATOMIC_RELAXED, __HIP_MEMORY_SCOPE_AGENT); }
__device__ __forceinline__ unsigned xb_xcc_id() { return (unsigned)__builtin_amdgcn_s_getreg((3 << 11) | 20) & 0xFu; }
#define XB_SPIN(cond, bar) do { unsigned _sp = 0; while (cond) { __builtin_amdgcn_s_sleep(1); \
    if ((++_sp & 255u) == 0u) { if (xb_ld(&(bar)[XB_TMO])) break; if (_sp > XB_SPIN_CAP) { atomicAdd(&(bar)[XB_TMO], 1u); break; } } } } while (0)
struct XcdBarrier { unsigned* bar; unsigned x; volatile LAS unsigned* st; };
__device__ __forceinline__ XcdBarrier xcd_barrier_post(unsigned* bar, volatile LAS unsigned* st) {
    XcdBarrier b; b.bar = bar; b.x = xb_xcc_id(); b.st = st;
    if (threadIdx.x == 0) (void)xb_add(&bar[XB_XCNT(b.x)], 1u);
    return b;
}
__device__ __forceinline__ void xcd_barrier_complete(unsigned* bar, unsigned x, unsigned& nloc, unsigned& nx) {
    const unsigned G = gridDim.x * gridDim.y * gridDim.z;
    unsigned sum, cnt, mine, sp = 0u;
    for (;;) {
        sum = 0u; cnt = 0u; mine = 0u;
#pragma unroll
        for (unsigned j = 0; j < 16; ++j) { const unsigned c = xb_ld(&bar[XB_XCNT(j)]); sum += c; cnt += (c > 0u) ? 1u : 0u; mine = (j == x) ? c : mine; }
        if (sum == G) break;
        __builtin_amdgcn_s_sleep(1);
        if ((++sp & 255u) == 0u) { if (xb_ld(&bar[XB_TMO])) break; if (sp > XB_SPIN_CAP) { atomicAdd(&bar[XB_TMO], 1u); break; } }
    }
    nloc = mine > 0u ? mine : 1u; nx = cnt > 0u ? cnt : 1u;
}
__device__ __forceinline__ void xcd_barrier(const XcdBarrier& b) {
    asm volatile("s_waitcnt vmcnt(0)" ::: "memory");
    __syncthreads();
    if (threadIdx.x == 0) {
        unsigned* bar = b.bar;
        __builtin_amdgcn_s_waitcnt(0);
        unsigned nloc = b.st[0], nx = b.st[1];
        if (nloc == 0u) { xcd_barrier_complete(bar, b.x, nloc, nx); b.st[0] = nloc; b.st[1] = nx; }
        const unsigned old = xb_add(&bar[XB_XSUB(b.x)], 1u);
        const unsigned gen = old / nloc;
        if (old + 1u == (gen + 1u) * nloc) {
            __builtin_amdgcn_fence(__ATOMIC_RELEASE, "agent");
            asm volatile("s_waitcnt vmcnt(0)" ::: "memory");
            const unsigned og = xb_add(&bar[XB_TOP], 1u);
            const unsigned tg = og / nx;
            if (og + 1u == (tg + 1u) * nx) xb_add(&bar[XB_TOPGEN], 1u);
            else XB_SPIN(xb_ld(&bar[XB_TOPGEN]) == tg, bar);
            __builtin_amdgcn_fence(__ATOMIC_ACQUIRE, "agent");
            xb_add(&bar[XB_XGEN(b.x)], 1u);
            asm volatile("s_waitcnt vmcnt(0)" ::: "memory");
        } else {
            XB_SPIN(xb_ld(&bar[XB_XGEN(b.x)]) == gen, bar);
            __builtin_amdgcn_fence(__ATOMIC_ACQUIRE, "agent");
            asm volatile("s_waitcnt vmcnt(0)" ::: "memory");
        }
    }
    __syncthreads();
}

struct Args { const void* in[41]; float* out; unsigned char* ws; int ph_lo, ph_hi; };
static_assert(sizeof(Args) == 41 * 8 + 8 + 8 + 8, "Args has no padding");

enum InIdx { I_X = 0, I_MEM, I_POS, I_NORM_MIX, I_W_IN, I_MU, I_W0, I_W2, I_A0, I_A2, I_G2, I_V0, I_V1, I_V2, I_KK, I_KA, I_RK, I_LNG, I_LNB, I_QN, I_KN, I_IKN,
             I_WBA, I_WBB, I_WOUT, I_NORM_MEM, I_MEM_TOKN, I_MWQ, I_MWKV, I_MQN, I_MKN, I_MWO, I_NORM_FFN, I_FWG, I_FWU, I_FWD, I_ROUTER, I_RBIAS, I_EWG, I_EWU, I_EWD };

typedef decltype(__builtin_amdgcn_kernarg_segment_ptr()) kptr_t;
struct Frame {
    LAS unsigned char* lds; unsigned char* ws; kptr_t kb; float* out;
    int tid, lane, wave, G, bid;
};
#define LDS_WAIT() asm volatile("s_waitcnt lgkmcnt(0)" ::: "memory")
__device__ __forceinline__ const void* kargp(kptr_t kb, int i) { typedef const void* cvp; typedef __attribute__((address_space(4))) const cvp* tab_t; return ((tab_t)kb)[i]; }
#define KARGP(F, i) kargp((F).kb, (i))
#define FIN(F, i) ((const float*)KARGP(F, i))

__device__ __forceinline__ float wave_sum(float v) {
#pragma unroll
    for (int o = 1; o < 64; o <<= 1) v += __shfl_xor(v, o);
    return v;
}

template <class Map>
__device__ __forceinline__ void transpose_item(const float* W, int K, int N, bf16_t* WT, const Map& map, const float* gain, LAS float* scr, int item, int lane) {
    const int nblk = (N + 31) / 32, kb = item / nblk, nb = item % nblk, k0 = 64 * kb, n0 = 32 * nb;
    const int nn = n0 + (lane & 31);
#pragma unroll 8
    for (int i = 0; i < 32; ++i) { const int kk = 2 * i + (lane >> 5); float v = 0.f; if (nn < N) v = W[(size_t)(k0 + kk) * N + nn]; if (gain) v *= gain[k0 + kk]; scr[kk * 33 + (lane & 31)] = v; }
    LDS_WAIT(); asm volatile("" ::: "memory");
    const int c = lane & 7;
#pragma unroll
    for (int j = 0; j < 4; ++j) { const int n = (lane >> 3) + 8 * j; const LAS float* s = scr + (8 * c) * 33 + n;
        u32x4 o; o.x = pk2(s[0 * 33], s[1 * 33]); o.y = pk2(s[2 * 33], s[3 * 33]); o.z = pk2(s[4 * 33], s[5 * 33]); o.w = pk2(s[6 * 33], s[7 * 33]);
        if (n0 + n < N) *(u32x4*)(WT + (size_t)map(n0 + n) * K + k0 + 8 * c) = o; }
    LDS_WAIT(); asm volatile("" ::: "memory");
}
struct MapId { int off; __device__ int operator()(int n) const { return n + off; } };
struct MapWin { __device__ int operator()(int n) const { return n < 3016 ? n : n + 56; } };
struct MapGU { int up; __device__ int operator()(int n) const { return (n >> 7) * 256 + up * 128 + (n & 127); } };

__device__ __forceinline__ void rms_row_to_bf16(const float* xrow, bf16_t* orow, int lane, f32x4 (&v)[4]) {
    const f32x4* xr = (const f32x4*)xrow + lane; float s = 0.f;
#pragma unroll
    for (int j = 0; j < 4; ++j) { v[j] = xr[64 * j]; s += (v[j].x * v[j].x + v[j].y * v[j].y) + (v[j].z * v[j].z + v[j].w * v[j].w); }
    const float rstd = 1.0f / sqrtf(wave_sum(s) * (1.f / D) + 1e-6f);
    u32x2* o8 = (u32x2*)orow + lane;
#pragma unroll
    for (int j = 0; j < 4; ++j) { v[j] = v[j] * rstd; u32x2 w; w.x = pk2(v[j].x, v[j].y); w.y = pk2(v[j].z, v[j].w); o8[64 * j] = w; }
}

__device__ __forceinline__ void ph_prologue0(Frame& F) {
    LAS float* scr = (LAS float*)(F.lds + F.wave * 16384);
    const int gw = F.bid * NWAVES + F.wave, NGW = F.G * NWAVES;
    bf16_t* wkv = (bf16_t*)(F.ws + WS_WKV);
    constexpr int IT = (D / 64) * (1024 / 32);
    for (int it = gw; it < DEPTH * IT; it += NGW) { const int l = it / IT, r = it % IT;
        transpose_item(FIN(F, I_MWKV) + (size_t)l * D * 1024, D, 1024, wkv, MapId{l * 1024}, FIN(F, I_MEM_TOKN) + l * D, scr, r, F.lane); }
    bf16_t* mh = (bf16_t*)(F.ws + WS_MEMH);
    for (int m = gw; m < MEMROWS; m += NGW) { f32x4 v[4]; rms_row_to_bf16(FIN(F, I_MEM) + (size_t)m * D, mh + (size_t)m * D, F.lane, v); }
}
__device__ __forceinline__ void ph_prologue2(Frame& F) {
    const int gw = F.bid * NWAVES + F.wave, NGW = F.G * NWAVES;
    const bf16_t* kv = (const bf16_t*)(F.ws + PR_KVRAW);
    bf16_t* MK = (bf16_t*)(F.ws + WS_MEMK); bf16_t* MVT = (bf16_t*)(F.ws + WS_MEMVT);
    for (int it = gw; it < MEMROWS * 16; it += NGW) {
        const int row = it >> 4, l = (it >> 2) & 3, hh = it & 3, b = row >> 8, m = row & 255;
        const bf16_t* src = kv + (size_t)row * 4096 + l * 1024;
        const unsigned kk = *(const unsigned*)(src + hh * 128 + 2 * F.lane);
        const float k0 = bf_lo(kk), k1 = bf_hi(kk);
        const float rstd = 1.0f / sqrtf(wave_sum(k0 * k0 + k1 * k1) * (1.f / 128.f) + 1e-6f);
        const float* gk = FIN(F, I_MKN) + l * 128;
        *(unsigned*)(MK + ((((size_t)l * NB + b) * 4 + hh) * 256 + m) * 128 + 2 * F.lane) = pk2(k0 * rstd * gk[2 * F.lane], k1 * rstd * gk[2 * F.lane + 1]);
        const unsigned vv = *(const unsigned*)(src + 512 + hh * 128 + 2 * F.lane);
        bf16_t* vt = MVT + (((size_t)l * NB + b) * 4 + hh) * 128 * 256 + m;
        vt[(size_t)(2 * F.lane) * 256] = (bf16_t)(vv & 0xffffu); vt[(size_t)(2 * F.lane + 1) * 256] = (bf16_t)(vv >> 16);
    }
}
__device__ __forceinline__ void ph_layer0(Frame& F, int l, const float* xin) {
    LAS float* scr = (LAS float*)(F.lds + F.wave * 16384);
    const int gw = F.bid * NWAVES + F.wave, NGW = F.G * NWAVES;
    unsigned char* ws = F.ws;
    constexpr int I_WIN = (D / 64) * ((N_IN + 31) / 32), I_B = (512 / 64) * (D / 32), I_O = (D / 64) * (D / 32), I_Q = (D / 64) * (512 / 32);
    constexpr int I_FG = (D / 64) * (FFN / 32), I_FDN = (FFN / 64) * (D / 32), I_EG = (D / 64) * (EDIM / 32), I_EDN = (EDIM / 64) * (D / 32);
    const bool moe = (l & 1) != 0; const int j = l >> 1;
    const int nff = moe ? NEXP * (2 * I_EG + I_EDN) : (2 * I_FG + I_FDN);
    const int NIT = I_WIN + 2 * I_B + I_O + I_Q + I_B + nff;
    const float* gffn = FIN(F, I_NORM_FFN) + l * D;
    for (int it = gw; it < NIT; it += NGW) {
        int r = it;
        if (r < I_WIN) { transpose_item(FIN(F, I_W_IN) + (size_t)l * D * N_IN, D, N_IN, (bf16_t*)(ws + W_IN), MapWin{}, FIN(F, I_NORM_MIX) + l * D, scr, r, F.lane); continue; } r -= I_WIN;
        if (r < I_B) { transpose_item(FIN(F, I_WBA) + (size_t)l * 512 * D, 512, D, (bf16_t*)(ws + W_BA), MapId{0}, nullptr, scr, r, F.lane); continue; } r -= I_B;
        if (r < I_B) { transpose_item(FIN(F, I_WBB) + (size_t)l * 512 * D, 512, D, (bf16_t*)(ws + W_BB), MapId{0}, nullptr, scr, r, F.lane); continue; } r -= I_B;
        if (r < I_O) { transpose_item(FIN(F, I_WOUT) + (size_t)l * D * D, D, D, (bf16_t*)(ws + W_OUT), MapId{0}, nullptr, scr, r, F.lane); continue; } r -= I_O;
        if (r < I_Q) { transpose_item(FIN(F, I_MWQ) + (size_t)l * D * 512, D, 512, (bf16_t*)(ws + W_MQ), MapId{0}, FIN(F, I_NORM_MEM) + l * D, scr, r, F.lane); continue; } r -= I_Q;
        if (r < I_B) { transpose_item(FIN(F, I_MWO) + (size_t)l * 512 * D, 512, D, (bf16_t*)(ws + W_MO), MapId{0}, nullptr, scr, r, F.lane); continue; } r -= I_B;
        if (!moe) {
            if (r < I_FG) { transpose_item(FIN(F, I_FWG) + (size_t)j * D * FFN, D, FFN, (bf16_t*)(ws + W_FGU), MapGU{0}, gffn, scr, r, F.lane); continue; } r -= I_FG;
            if (r < I_FG) { transpose_item(FIN(F, I_FWU) + (size_t)j * D * FFN, D, FFN, (bf16_t*)(ws + W_FGU), MapGU{1}, gffn, scr, r, F.lane); continue; } r -= I_FG;
            transpose_item(FIN(F, I_FWD) + (size_t)j * FFN * D, FFN, D, (bf16_t*)(ws + W_FD), MapId{0}, nullptr, scr, r, F.lane);
        } else {
            const int per = 2 * I_EG + I_EDN, e = r / per; r -= e * per;
            const size_t eo = (size_t)(j * NEXP + e);
            if (r < I_EG) { transpose_item(FIN(F, I_EWG) + eo * D * EDIM, D, EDIM, (bf16_t*)(ws + W_EGU) + (size_t)e * 2 * EDIM * D, MapGU{0}, gffn, scr, r, F.lane); continue; } r -= I_EG;
            if (r < I_EG) { transpose_item(FIN(F, I_EWU) + eo * D * EDIM, D, EDIM, (bf16_t*)(ws + W_EGU) + (size_t)e * 2 * EDIM * D, MapGU{1}, gffn, scr, r, F.lane); continue; } r -= I_EG;
            transpose_item(FIN(F, I_EWD) + eo * EDIM * D, EDIM, D, (bf16_t*)(ws + W_ED) + (size_t)e * D * EDIM, MapId{0}, nullptr, scr, r, F.lane);
        }
    }
    { u32x4* z = (u32x4*)((bf16_t*)(ws + W_IN) + (size_t)3016 * D); const int n16 = 56 * D * 2 / 16;
      for (int i = F.bid * NTHR + F.tid; i < n16; i += F.G * NTHR) z[i] = (u32x4){0u, 0u, 0u, 0u}; }
    bf16_t* hn = (bf16_t*)(ws + WS_HN);
    for (int m = gw; m < T; m += NGW) { f32x4 v[4]; rms_row_to_bf16(xin + (size_t)m * D, hn + (size_t)m * D, F.lane, v); }
}
__device__ __forceinline__ void ph_norm(Frame& F) {
    const int gw = F.bid * NWAVES + F.wave, NGW = F.G * NWAVES;
    bf16_t* hn = (bf16_t*)(F.ws + WS_HN);
    for (int m = gw; m < T; m += NGW) { f32x4 v[4]; rms_row_to_bf16(F.out + (size_t)m * D, hn + (size_t)m * D, F.lane, v); }
}
__device__ __forceinline__ void ph_norm_ffn(Frame& F, int l) {
    const int gw = F.bid * NWAVES + F.wave, NGW = F.G * NWAVES;
    bf16_t* hn = (bf16_t*)(F.ws + WS_HN);
    const bool moe = (l & 1) != 0; const int j = l >> 1;
    const float* gn = FIN(F, I_NORM_FFN) + l * D;
    const float* rt = FIN(F, I_ROUTER) + (size_t)j * D * NEXP; const float* rb = FIN(F, I_RBIAS) + j * NEXP;
    unsigned short* sele = (unsigned short*)(F.ws + MOE_SELE); f32x2* selw = (f32x2*)(F.ws + MOE_SELW);
    for (int m = gw; m < T; m += NGW) {
        f32x4 v[4]; rms_row_to_bf16(F.out + (size_t)m * D, hn + (size_t)m * D, F.lane, v);
        if (moe) {
            float lg[8];
#pragma unroll
            for (int e = 0; e < 8; ++e) lg[e] = 0.f;
#pragma unroll
            for (int q = 0; q < 4; ++q)
#pragma unroll
                for (int c = 0; c < 4; ++c) { const int k = 256 * q + 4 * F.lane + c; const float h = v[q][c] * gn[k];
                    const f32x4 r0 = *(const f32x4*)(rt + (size_t)k * 8), r1 = *(const f32x4*)(rt + (size_t)k * 8 + 4);
                    lg[0] += h * r0.x; lg[1] += h * r0.y; lg[2] += h * r0.z; lg[3] += h * r0.w; lg[4] += h * r1.x; lg[5] += h * r1.y; lg[6] += h * r1.z; lg[7] += h * r1.w; }
#pragma unroll
            for (int e = 0; e < 8; ++e) lg[e] = wave_sum(lg[e]) + rb[e];
            int e0 = 0; float l0 = lg[0];
#pragma unroll
            for (int e = 1; e < 8; ++e) if (lg[e] > l0) { l0 = lg[e]; e0 = e; }
            int e1 = -1; float l1 = -3.0e38f;
#pragma unroll
            for (int e = 0; e < 8; ++e) if (e != e0 && lg[e] > l1) { l1 = lg[e]; e1 = e; }
            const float w1 = 1.0f / (1.0f + expf(l0 - l1)), w0 = 1.0f - w1;
            if (F.lane == 0) { sele[m] = (unsigned short)(e0 | (e1 << 8)); selw[m] = (f32x2){w0, w1}; }
        }
    }
}

__device__ __forceinline__ float softplusf_(float x) { return fmaxf(x, 0.f) + log1pf(expf(-fabsf(x))); }
__device__ __forceinline__ void ph_rwkv_prep(Frame& F, int l, int half) {
    LAS float* xm = (LAS float*)F.lds;
    LAS float* vm = (LAS float*)(F.lds + 16 * RW_COLS * 4);
    const bf16_t* CA = (const bf16_t*)(F.ws + MX_CA);
    bf16_t* RW = (bf16_t*)(F.ws + MX_RW); constexpr size_t AS_ = (size_t)TH * 512;
    bf16_t* VF = (bf16_t*)(F.ws + WS_VFIRST) + (size_t)half * TH * 512;
    const float* mu = FIN(F, I_MU) + l * RW_COLS;
    const float* w2 = FIN(F, I_W2) + (size_t)l * 64 * 512; const float* a2 = FIN(F, I_A2) + (size_t)l * 64 * 512; const float* g2 = FIN(F, I_G2) + (size_t)l * 128 * 512;
    const int j = F.tid;
    const float w0j = FIN(F, I_W0)[l * 512 + j], a0j = FIN(F, I_A0)[l * 512 + j], kkj = FIN(F, I_KK)[l * 512 + j], kaj = FIN(F, I_KA)[l * 512 + j];
    const float* v1 = l ? FIN(F, I_V1) + (size_t)(l - 1) * 512 * 32 : nullptr; const float* v2 = l ? FIN(F, I_V2) + (size_t)(l - 1) * 32 * 512 : nullptr;
    const float v0j = l ? FIN(F, I_V0)[(l - 1) * 512 + j] : 0.f;
    for (int tile = F.bid; tile < TH / 16; tile += F.G) {
        const int t0 = tile * 16;
        __syncthreads();
        for (int it = F.tid; it < 16 * (RW_COLS / 8); it += NTHR) {
            const int i = it / (RW_COLS / 8), c = (it % (RW_COLS / 8)) * 8; const int t = t0 + i;
            const u32x4 cu = *(const u32x4*)(CA + (size_t)t * RW_COLS + c);
            u32x4 pv = (u32x4){0u, 0u, 0u, 0u}; if ((t & (SEQ - 1)) != 0) pv = *(const u32x4*)(CA + (size_t)(t - 1) * RW_COLS + c);
            float cv[8] = { bf_lo(cu.x), bf_hi(cu.x), bf_lo(cu.y), bf_hi(cu.y), bf_lo(cu.z), bf_hi(cu.z), bf_lo(cu.w), bf_hi(cu.w) };
            const float pp[8] = { bf_lo(pv.x), bf_hi(pv.x), bf_lo(pv.y), bf_hi(pv.y), bf_lo(pv.z), bf_hi(pv.z), bf_lo(pv.w), bf_hi(pv.w) };
#pragma unroll
            for (int q = 0; q < 8; ++q) { float x = cv[q] + (pp[q] - cv[q]) * mu[c + q];
                if (c >= 1536 && c < 1600) x = tanhf(x); else if (c >= 1664) x = sigmoidf_(x);
                xm[i * RW_COLS + c + q] = x; }
        }
        __syncthreads();
        if (l) { const int i = j >> 5, c = j & 31; float s = 0.f; const LAS float* xv = xm + i * RW_COLS + 1024;
            for (int k = 0; k < 512; ++k) s += xv[k] * v1[k * 32 + c];
            vm[i * 32 + c] = s; }
        float wl[16], al[16], gg[16];
#pragma unroll
        for (int i = 0; i < 16; ++i) { wl[i] = 0.f; al[i] = 0.f; gg[i] = 0.f; }
        for (int k = 0; k < 64; ++k) { const float wv = w2[k * 512 + j], av = a2[k * 512 + j];
#pragma unroll
            for (int i = 0; i < 16; ++i) { wl[i] += xm[i * RW_COLS + 1536 + k] * wv; al[i] += xm[i * RW_COLS + 1600 + k] * av; } }
        for (int k = 0; k < 128; ++k) { const float gv = g2[k * 512 + j];
#pragma unroll
            for (int i = 0; i < 16; ++i) gg[i] += xm[i * RW_COLS + 1664 + k] * gv; }
        __syncthreads();
#pragma unroll
        for (int i = 0; i < 16; ++i) {
            const size_t o = (size_t)(t0 + i) * 512 + j;
            const float r = xm[i * RW_COLS + j], k = xm[i * RW_COLS + 512 + j]; float v = xm[i * RW_COLS + 1024 + j];
            if (l) { float s = v0j; for (int c = 0; c < 32; ++c) s += vm[i * 32 + c] * v2[c * 512 + j];
                const float vf = bf2f(VF[o]); v = v + (vf - v) * sigmoidf_(s); }
            else VF[o] = f2bf(v);
            const float kk = k * kkj; const float ss = wave_sum(kk * kk); const float kkn = kk / fmaxf(sqrtf(ss), 1e-12f);
            const float a = sigmoidf_(a0j + al[i]); const float k2 = k * (1.0f + (a - 1.0f) * kaj);
            const float wlog = -softplusf_(-(w0j + wl[i])) - 0.5f; const float e = expf(wlog);
            RW[0 * AS_ + o] = f2bf(r); RW[1 * AS_ + o] = f2bf(e); RW[2 * AS_ + o] = f2bf(k2); RW[3 * AS_ + o] = f2bf(v);
            RW[4 * AS_ + o] = f2bf(kkn); RW[5 * AS_ + o] = f2bf(a); RW[6 * AS_ + o] = f2bf(gg[i]);
        }
    }
}
__device__ __forceinline__ void rwkv_stage_chunk(Frame& F, const bf16_t* RW, int rowbase, int h, int c, LAS float* buf, int first, int nthr) {
    constexpr size_t AS_ = (size_t)TH * 512;
    for (int idx = first; idx < 32 * 64; idx += nthr) {
        const int tt = idx >> 6, d = idx & 63; const size_t o = (size_t)(rowbase + c * 32 + tt) * 512 + h * 64 + d;
        const float r = bf2f(RW[0 * AS_ + o]), e = bf2f(RW[1 * AS_ + o]), k = bf2f(RW[2 * AS_ + o]), v = bf2f(RW[3 * AS_ + o]), kk = bf2f(RW[4 * AS_ + o]), a = bf2f(RW[5 * AS_ + o]);
        buf[0 * 2048 + idx] = r; buf[1 * 2048 + idx] = expf(-e); buf[2 * 2048 + idx] = k; buf[3 * 2048 + idx] = v; buf[4 * 2048 + idx] = -kk; buf[5 * 2048 + idx] = kk * a;
    }
}
__device__ __forceinline__ void ph_rwkv_scan(Frame& F, int pair) {
    const int bl = pair >> 3, h = pair & 7, rowbase = bl * SEQ;
    bf16_t* RW = (bf16_t*)(F.ws + MX_RW); constexpr size_t AS_ = (size_t)TH * 512;
    LAS float* bufs = (LAS float*)F.lds;
    f32x2 S[32];
#pragma unroll
    for (int i = 0; i < 32; ++i) S[i] = (f32x2){0.f, 0.f};
    rwkv_stage_chunk(F, RW, rowbase, h, 0, bufs, F.tid, NTHR);
    __syncthreads();
    for (int c = 0; c < SEQ / 32; ++c) {
        LAS float* cur = bufs + (c & 1) * (6 * 2048);
        if (F.wave > 0) { if (c + 1 < SEQ / 32) rwkv_stage_chunk(F, RW, rowbase, h, c + 1, bufs + ((c + 1) & 1) * (6 * 2048), F.tid - 64, NTHR - 64); }
        else {
            for (int tt = 0; tt < 32; ++tt) {
                const LAS f32x4* pr = (const LAS f32x4*)(cur + 0 * 2048 + tt * 64); const LAS f32x4* pw = (const LAS f32x4*)(cur + 1 * 2048 + tt * 64);
                const LAS f32x4* pk = (const LAS f32x4*)(cur + 2 * 2048 + tt * 64); const LAS f32x4* pa = (const LAS f32x4*)(cur + 4 * 2048 + tt * 64);
                const LAS f32x4* pb = (const LAS f32x4*)(cur + 5 * 2048 + tt * 64);
                const float vv = cur[3 * 2048 + tt * 64 + F.lane];
                f32x2 sa2 = (f32x2){0.f, 0.f};
#pragma unroll
                for (int q = 0; q < 16; ++q) { const f32x4 a4 = pa[q]; sa2 += S[2 * q] * (f32x2){a4.x, a4.y}; sa2 += S[2 * q + 1] * (f32x2){a4.z, a4.w}; }
                const float sa = sa2.x + sa2.y;
                f32x2 y2 = (f32x2){0.f, 0.f};
#pragma unroll
                for (int q = 0; q < 16; ++q) { const f32x4 w4 = pw[q], b4 = pb[q], k4 = pk[q], r4 = pr[q];
                    S[2 * q] = S[2 * q] * (f32x2){w4.x, w4.y} + (f32x2){b4.x, b4.y} * sa + (f32x2){k4.x, k4.y} * vv;
                    S[2 * q + 1] = S[2 * q + 1] * (f32x2){w4.z, w4.w} + (f32x2){b4.z, b4.w} * sa + (f32x2){k4.z, k4.w} * vv;
                    y2 += S[2 * q] * (f32x2){r4.x, r4.y}; y2 += S[2 * q + 1] * (f32x2){r4.z, r4.w}; }
                RW[4 * AS_ + (size_t)(rowbase + c * 32 + tt) * 512 + h * 64 + F.lane] = f2bf(y2.x + y2.y);
            }
        }
        __syncthreads();
    }
}
__device__ __forceinline__ void ph_rwkv_post(Frame& F, int l) {
    bf16_t* RW = (bf16_t*)(F.ws + MX_RW); constexpr size_t AS_ = (size_t)TH * 512;
    const int j = F.tid;
    const float rk = FIN(F, I_RK)[l * 512 + j], lg = FIN(F, I_LNG)[l * 512 + j], lb = FIN(F, I_LNB)[l * 512 + j];
    for (int t = F.bid; t < TH; t += F.G) {
        const size_t o = (size_t)t * 512 + j;
        const float y = bf2f(RW[4 * AS_ + o]), r = bf2f(RW[0 * AS_ + o]), k = bf2f(RW[2 * AS_ + o]), v = bf2f(RW[3 * AS_ + o]), g = bf2f(RW[6 * AS_ + o]);
        const float mean = wave_sum(y) * (1.f / 64.f); const float dv = y - mean; const float var = wave_sum(dv * dv) * (1.f / 64.f);
        const float bonus = wave_sum(r * k * rk) * v;
        RW[1 * AS_ + o] = f2bf((dv * (1.0f / sqrtf(var + 64e-5f)) * lg + lb + bonus) * g);
    }
}

__device__ __forceinline__ float rope_vec(float x, float cs, float sn, int lane) {
    const float p = __shfl_xor(x, 32);
    return lane < 32 ? x * cs - p * sn : x * cs + p * sn;
}
__device__ __forceinline__ void ph_dsa_prep(Frame& F, int l, int half) {
    bf16_t* CB = (bf16_t*)(F.ws + MX_CB); bf16_t* VT = (bf16_t*)(F.ws + MX_VT);
    const int* pos = (const int*)KARGP(F, I_POS) + (size_t)half * TH;
    const int d = F.lane, w = F.wave;
    const float invf = 1.0f / powf(10000.0f, (float)(2 * (d & 31)) / 64.0f);
    const float gq = FIN(F, I_QN)[l * 64 + d], gk = FIN(F, I_KN)[l * 64 + d], gik = FIN(F, I_IKN)[l * 64 + d];
    for (int t = F.bid; t < TH; t += F.G) {
        const float ang = (float)pos[t] * invf; float sn, cs; sincosf(ang, &sn, &cs);
        bf16_t* row = CB + (size_t)t * DS_PAD;
        { float x = bf2f(row[w * 64 + d]); const float rstd = 1.0f / sqrtf(wave_sum(x * x) * (1.f / 64.f) + 1e-6f); x = x * rstd * gq; row[w * 64 + d] = f2bf(rope_vec(x, cs, sn, d)); }
        { const float x = bf2f(row[640 + w * 64 + d]); row[640 + w * 64 + d] = f2bf(rope_vec(x, cs, sn, d)); }
        if (w == 0) { float x = bf2f(row[512 + d]); const float rstd = 1.0f / sqrtf(wave_sum(x * x) * (1.f / 64.f) + 1e-6f); x = x * rstd * gk; row[512 + d] = f2bf(rope_vec(x, cs, sn, d)); }
        if (w == 1) { float x = bf2f(row[1152 + d]); const float rstd = 1.0f / sqrtf(wave_sum(x * x) * (1.f / 64.f) + 1e-6f); x = x * rstd * gik; row[1152 + d] = f2bf(rope_vec(x, cs, sn, d)); }
        if (w == 2) { VT[((size_t)(t >> 11) * 64 + d) * SEQ + (t & (SEQ - 1))] = row[576 + d]; }
    }
}

constexpr int SC_LD = 2052;
__device__ __forceinline__ void lds_inc(LAS unsigned* p) { (void)__hip_atomic_fetch_add(p, 1u, __ATOMIC_RELAXED, __HIP_MEMORY_SCOPE_WORKGROUP); }
__device__ __forceinline__ unsigned okey(float s) { const unsigned u = __builtin_bit_cast(unsigned, s); return (u & 0x80000000u) ? ~u : (u | 0x80000000u); }
#define MFMA16(x, y, c) __builtin_amdgcn_mfma_f32_16x16x32_bf16((x), (y), (c), 0, 0, 0)
__device__ __forceinline__ int hist_find(LAS unsigned* hist, int lane, int& R) {
    const u32x4 c4 = *(const LAS u32x4*)(hist + 4 * lane);
    const unsigned tot = c4.x + c4.y + c4.z + c4.w;
    unsigned suf = tot;
#pragma unroll
    for (int o = 1; o < 64; o <<= 1) { const unsigned v = __shfl_down(suf, o); if (lane + o < 64) suf += v; }
    const unsigned above = suf - tot;
    const bool mine = (above < (unsigned)R) && ((unsigned)R <= suf);
    const unsigned long long bal = __ballot(mine);
    const int src = bal ? (int)__builtin_ctzll(bal) : 0;
    int bin = 0, rr = 1;
    { unsigned a = above; int b = 4 * lane + 3; int r_ = R;
      if ((unsigned)r_ <= a + c4.w) { b = 4 * lane + 3; r_ -= a; } else { a += c4.w;
      if ((unsigned)r_ <= a + c4.z) { b = 4 * lane + 2; r_ -= a; } else { a += c4.z;
      if ((unsigned)r_ <= a + c4.y) { b = 4 * lane + 1; r_ -= a; } else { a += c4.y; b = 4 * lane; r_ -= a; } } }
      bin = b; rr = r_; }
    bin = __shfl(bin, src); rr = __shfl(rr, src);
    R = rr; return bin;
}
__device__ __forceinline__ void ph_dsa(Frame& F, int half, int first, int stride) {
    const bf16_t* CB = (const bf16_t*)(F.ws + MX_CB); const bf16_t* VT = (const bf16_t*)(F.ws + MX_VT);
    bf16_t* YB = (bf16_t*)(F.ws + MX_YB);
    LAS float* sc = (LAS float*)F.lds;
    LAS unsigned* hist = (LAS unsigned*)(F.lds + 16 * SC_LD * 4);
    LAS unsigned* msk = (LAS unsigned*)(F.lds + 16 * SC_LD * 4 + 16 * 256 * 4);
    const int lane = F.lane, w = F.wave, jl = lane & 15, g = lane >> 4;
    for (int u = first; u < TH / 16; u += stride) {
        const int bl = u >> 7, q0 = (u & 127) * 16, L = ((q0 >> 6) + 1) * 64;
        const int rowb = bl * SEQ;
        __syncthreads();
        for (int i = F.tid; i < 16 * 256; i += NTHR) hist[i] = 0u;
        __syncthreads();
        {
            bf16x8 yq[8][2]; float iw[8];
            const bf16_t* qrow = CB + (size_t)(rowb + q0 + jl) * DS_PAD;
#pragma unroll
            for (int h = 0; h < 8; ++h) { iw[h] = bf2f(qrow[1216 + h]);
#pragma unroll
                for (int s = 0; s < 2; ++s) yq[h][s] = *(const bf16x8*)(qrow + 640 + h * 64 + 32 * s + 8 * g); }
            for (int kt = w; kt < L / 16; kt += 8) {
                const bf16_t* krow = CB + (size_t)(rowb + kt * 16 + jl) * DS_PAD + 1152;
                const bf16x8 x0 = *(const bf16x8*)(krow + 8 * g), x1 = *(const bf16x8*)(krow + 32 + 8 * g);
                f32x4 s4 = (f32x4){0.f, 0.f, 0.f, 0.f};
#pragma unroll
                for (int h = 0; h < 8; ++h) { f32x4 a = (f32x4){0.f, 0.f, 0.f, 0.f}; a = MFMA16(x0, yq[h][0], a); a = MFMA16(x1, yq[h][1], a);
#pragma unroll
                    for (int r = 0; r < 4; ++r) s4[r] += iw[h] * fmaxf(a[r], 0.f); }
                *(LAS f32x4*)(sc + jl * SC_LD + kt * 16 + 4 * g) = s4;
                if (L > 256) {
#pragma unroll
                    for (int r = 0; r < 4; ++r) lds_inc(hist + jl * 256 + (okey(s4[r]) >> 24)); }
            }
        }
        __syncthreads();
        for (int qi = 0; qi < 2; ++qi) {
            const int qq = 2 * w + qi; LAS unsigned* hq = hist + qq * 256; const LAS float* sq = sc + qq * SC_LD; LAS unsigned* mq = msk + qq * 64;
            if (L <= 256) { if (lane < 64) mq[lane] = (lane < L / 32) ? 0xffffffffu : 0u; }
            else {
                int R = 256; unsigned prefix = 0u;
                const int b1 = hist_find(hq, lane, R); prefix = (unsigned)b1;
#pragma unroll 1
                for (int pass = 1; pass < 4; ++pass) {
                    const int sh = 24 - 8 * pass;
                    asm volatile("" ::: "memory");
                    *(LAS u32x4*)(hq + 4 * lane) = (u32x4){0u, 0u, 0u, 0u};
                    LDS_WAIT(); asm volatile("" ::: "memory");
                    for (int i = lane; i < L; i += 64) { const unsigned k = okey(sq[i]); if ((k >> (sh + 8)) == prefix) lds_inc(hq + ((k >> sh) & 255u)); }
                    LDS_WAIT(); asm volatile("" ::: "memory");
                    const int b = hist_find(hq, lane, R); prefix = (prefix << 8) | (unsigned)b;
                }
                const unsigned thr = prefix; int taken = 0;
                for (int base = 0; base < SEQ; base += 64) {
                    bool take = false; bool eq = false;
                    if (base < L) { const unsigned k = okey(sq[base + lane]); take = k > thr; eq = (k == thr); }
                    const unsigned long long em = __ballot(eq);
                    const int myr = taken + __popcll(em & ((1ull << lane) - 1ull));
                    take = take || (eq && myr < R);
                    taken += __popcll(em);
                    const unsigned long long tm = __ballot(take);
                    if (lane == 0) { mq[base / 32] = (unsigned)tm; mq[base / 32 + 1] = (unsigned)(tm >> 32); }
                }
            }
        }
        __syncthreads();
        {
            const int qloc = 2 * w + (jl >> 3), hd = jl & 7;
            const bf16_t* qrow = CB + (size_t)(rowb + q0 + qloc) * DS_PAD + hd * 64;
            const bf16x8 yq0 = *(const bf16x8*)(qrow + 8 * g), yq1 = *(const bf16x8*)(qrow + 32 + 8 * g);
            f32x4 O[4];
#pragma unroll
            for (int dt = 0; dt < 4; ++dt) O[dt] = (f32x4){0.f, 0.f, 0.f, 0.f};
            float mrun = -1e30f, lsum = 0.f;
            const bf16_t* vtb = VT + (size_t)bl * 64 * SEQ;
            const LAS unsigned* mq = msk + qloc * 64;
            for (int kb = 0; kb < L; kb += 32) {
                f32x4 s[2];
#pragma unroll
                for (int tl = 0; tl < 2; ++tl) { const bf16_t* krow = CB + (size_t)(rowb + kb + 16 * tl + jl) * DS_PAD + 512;
                    const bf16x8 x0 = *(const bf16x8*)(krow + 8 * g), x1 = *(const bf16x8*)(krow + 32 + 8 * g);
                    f32x4 a = (f32x4){0.f, 0.f, 0.f, 0.f}; a = MFMA16(x0, yq0, a); a = MFMA16(x1, yq1, a); s[tl] = a; }
                const unsigned mw = mq[kb >> 5];
                bool bit[8]; float mx = -1e30f;
#pragma unroll
                for (int tl = 0; tl < 2; ++tl)
#pragma unroll
                    for (int r = 0; r < 4; ++r) { bit[4 * tl + r] = (mw >> (16 * tl + 4 * g + r)) & 1u; s[tl][r] *= 0.125f; if (bit[4 * tl + r]) mx = fmaxf(mx, s[tl][r]); }
                mx = fmaxf(mx, __shfl_xor(mx, 16)); mx = fmaxf(mx, __shfl_xor(mx, 32));
                const float mnew = fmaxf(mrun, mx); const float alpha = __expf(mrun - mnew); mrun = mnew;
                float p[8]; float ps = 0.f;
#pragma unroll
                for (int i = 0; i < 8; ++i) { p[i] = bit[i] ? __expf(s[i >> 2][i & 3] - mnew) : 0.f; ps += p[i]; }
                lsum = lsum * alpha + ps;
                u32x4 pw; pw.x = pk2(p[0], p[1]); pw.y = pk2(p[2], p[3]); pw.z = pk2(p[4], p[5]); pw.w = pk2(p[6], p[7]);
                const bf16x8 pf = __builtin_bit_cast(bf16x8, pw);
#pragma unroll
                for (int dt = 0; dt < 4; ++dt) { const bf16_t* vr = vtb + (size_t)(16 * dt + jl) * SEQ + kb + 4 * g;
                    const u32x2 lo = *(const u32x2*)vr, hi = *(const u32x2*)(vr + 16);
                    const bf16x8 xv = __builtin_bit_cast(bf16x8, (u32x4){lo.x, lo.y, hi.x, hi.y});
                    O[dt] = O[dt] * alpha; O[dt] = MFMA16(xv, pf, O[dt]); }
            }
            lsum += __shfl_xor(lsum, 16); lsum += __shfl_xor(lsum, 32);
            const float inv = 1.0f / lsum;
            bf16_t* orow = YB + (size_t)(rowb + q0 + qloc) * 512 + hd * 64;
#pragma unroll
            for (int dt = 0; dt < 4; ++dt) { u32x2 o; o.x = pk2(O[dt][0] * inv, O[dt][1] * inv); o.y = pk2(O[dt][2] * inv, O[dt][3] * inv); *(u32x2*)(orow + 16 * dt + 4 * g) = o; }
        }
    }
}

__device__ __forceinline__ void ph_mem_attn(Frame& F, int l) {
    const bf16_t* QM = (const bf16_t*)(F.ws + MA_QM); bf16_t* OM = (bf16_t*)(F.ws + MA_OM);
    const bf16_t* MK = (const bf16_t*)(F.ws + WS_MEMK) + (size_t)l * MEMROWS * 512; const bf16_t* MVT = (const bf16_t*)(F.ws + WS_MEMVT) + (size_t)l * MEMROWS * 512;
    const int lane = F.lane, jl = lane & 15, g = lane >> 4;
    const float* gq = FIN(F, I_MQN) + l * 128;
    for (int it = F.bid; it < NB * 4 * 16; it += F.G) {
        const int b = it >> 6, hh = (it >> 4) & 3, sp = it & 15;
        const int t = b * SEQ + sp * 128 + F.wave * 16 + jl;
        const bf16_t* qrow = QM + (size_t)t * 512 + hh * 128;
        float qv[4][8]; float ss = 0.f;
#pragma unroll
        for (int s = 0; s < 4; ++s) { const u32x4 q = *(const u32x4*)(qrow + 32 * s + 8 * g);
            qv[s][0] = bf_lo(q.x); qv[s][1] = bf_hi(q.x); qv[s][2] = bf_lo(q.y); qv[s][3] = bf_hi(q.y); qv[s][4] = bf_lo(q.z); qv[s][5] = bf_hi(q.z); qv[s][6] = bf_lo(q.w); qv[s][7] = bf_hi(q.w);
#pragma unroll
            for (int i = 0; i < 8; ++i) ss += qv[s][i] * qv[s][i]; }
        ss += __shfl_xor(ss, 16); ss += __shfl_xor(ss, 32);
        const float sc = (1.0f / sqrtf(ss * (1.f / 128.f) + 1e-6f)) * 0.08838834764831845f;
        bf16x8 yq[4];
#pragma unroll
        for (int s = 0; s < 4; ++s) { const float* gp = gq + 32 * s + 8 * g; u32x4 pw;
            pw.x = pk2(qv[s][0] * sc * gp[0], qv[s][1] * sc * gp[1]); pw.y = pk2(qv[s][2] * sc * gp[2], qv[s][3] * sc * gp[3]);
            pw.z = pk2(qv[s][4] * sc * gp[4], qv[s][5] * sc * gp[5]); pw.w = pk2(qv[s][6] * sc * gp[6], qv[s][7] * sc * gp[7]); yq[s] = __builtin_bit_cast(bf16x8, pw); }
        const bf16_t* kb_ = MK + ((size_t)b * 4 + hh) * 256 * 128; const bf16_t* vb_ = MVT + ((size_t)b * 4 + hh) * 128 * 256;
        f32x4 S[16];
#pragma unroll
        for (int kt = 0; kt < 16; ++kt) { const bf16_t* kr = kb_ + (size_t)(16 * kt + jl) * 128 + 8 * g; f32x4 a = (f32x4){0.f, 0.f, 0.f, 0.f};
#pragma unroll
            for (int s = 0; s < 4; ++s) a = MFMA16(*(const bf16x8*)(kr + 32 * s), yq[s], a);
            S[kt] = a; }
        float mx = -1e30f;
#pragma unroll
        for (int kt = 0; kt < 16; ++kt)
#pragma unroll
            for (int r = 0; r < 4; ++r) mx = fmaxf(mx, S[kt][r]);
        mx = fmaxf(mx, __shfl_xor(mx, 16)); mx = fmaxf(mx, __shfl_xor(mx, 32));
        float ls = 0.f; bf16x8 pf[8];
#pragma unroll
        for (int ks = 0; ks < 8; ++ks) { float p[8];
#pragma unroll
            for (int i = 0; i < 8; ++i) { p[i] = __expf(S[2 * ks + (i >> 2)][i & 3] - mx); ls += p[i]; }
            u32x4 pw; pw.x = pk2(p[0], p[1]); pw.y = pk2(p[2], p[3]); pw.z = pk2(p[4], p[5]); pw.w = pk2(p[6], p[7]); pf[ks] = __builtin_bit_cast(bf16x8, pw); }
        ls += __shfl_xor(ls, 16); ls += __shfl_xor(ls, 32);
        const float inv = 1.0f / ls;
        bf16_t* orow = OM + (size_t)t * 512 + hh * 128;
#pragma unroll
        for (int dt = 0; dt < 8; ++dt) { f32x4 o = (f32x4){0.f, 0.f, 0.f, 0.f}; const bf16_t* vr = vb_ + (size_t)(16 * dt + jl) * 256 + 4 * g;
#pragma unroll
            for (int ks = 0; ks < 8; ++ks) { const u32x2 lo = *(const u32x2*)(vr + 32 * ks), hi = *(const u32x2*)(vr + 32 * ks + 16);
                o = MFMA16(__builtin_bit_cast(bf16x8, (u32x4){lo.x, lo.y, hi.x, hi.y}), pf[ks], o); }
            u32x2 ov; ov.x = pk2(o[0] * inv, o[1] * inv); ov.y = pk2(o[2] * inv, o[3] * inv); *(u32x2*)(orow + 16 * dt + 4 * g) = ov; }
    }
}

__device__ __forceinline__ void ph_moe_route(Frame& F) {
    const unsigned short* sele = (const unsigned short*)(F.ws + MOE_SELE); const f32x2* selw = (const f32x2*)(F.ws + MOE_SELW);
    int* rowtok = (int*)(F.ws + MOE_ROWTOK); float* roww = (float*)(F.ws + MOE_ROWW); int* tile_e = (int*)(F.ws + MOE_TILEE); int* meta = (int*)(F.ws + MOE_META);
    LAS unsigned long long* pc = (LAS unsigned long long*)F.lds;
    LAS int* tot = (LAS int*)(F.lds + 8192);
    LAS int* pre = tot + 16; LAS int* segb = tot + 32; LAS int* wcnt = tot + 64;
    __syncthreads();
    { unsigned long long c0 = 0ull, c1 = 0ull; const u32x4* sp = (const u32x4*)(sele + (size_t)F.tid * 128);
      for (int i = 0; i < 16; ++i) { const u32x4 v = sp[i]; const unsigned ww[4] = {v.x, v.y, v.z, v.w};
#pragma unroll
        for (int q = 0; q < 4; ++q) { const unsigned a = ww[q] & 0xffffu, b = ww[q] >> 16;
            c0 += 1ull << (8 * (a & 7u)); c1 += 1ull << (8 * ((a >> 8) & 7u)); c0 += 1ull << (8 * (b & 7u)); c1 += 1ull << (8 * ((b >> 8) & 7u)); } }
      pc[F.tid * 2] = c0; pc[F.tid * 2 + 1] = c1; }
    __syncthreads();
    if (F.tid < 32) { const int seg = F.tid & 15, kind = F.tid >> 4; const int slot = seg >> 3, e = seg & 7; const int lim = kind ? 2 * F.bid : 512; int s = 0;
        for (int i = 0; i < lim; ++i) s += (int)((pc[i * 2 + slot] >> (8 * e)) & 0xffull);
        if (kind) pre[seg] = s; else tot[seg] = s; }
    __syncthreads();
    if (F.tid == 0) { int b = 0; for (int s = 0; s < 16; ++s) { segb[s] = b; b += (tot[s] + 255) & ~255; } segb[16] = b; }
    __syncthreads();
    const int t = F.bid * 256 + (F.tid & 255); const unsigned se = sele[t]; const f32x2 sw = selw[t];
    const int myseg[2] = { (int)(se & 7u), 8 + (int)((se >> 8) & 7u) };
    int rank[2] = {0, 0};
    if (F.tid < 256) {
#pragma unroll
        for (int s = 0; s < 16; ++s) { const int k = s >> 3; const unsigned long long m = __ballot(myseg[k] == s);
            if (myseg[k] == s) rank[k] = __popcll(m & ((1ull << F.lane) - 1ull));
            if (F.lane == 0) wcnt[F.wave * 16 + s] = __popcll(m); }
    }
    __syncthreads();
    if (F.tid < 256) {
#pragma unroll
        for (int k = 0; k < 2; ++k) { const int s = myseg[k]; int off = 0; for (int ww = 0; ww < F.wave; ++ww) off += wcnt[ww * 16 + s];
            const int row = segb[s] + pre[s] + off + rank[k]; rowtok[row] = t; roww[row] = k ? sw.y : sw.x; }
    }
    if (F.bid == 0) {
        for (int s = 0; s < 16; ++s) { const int lo = segb[s] + tot[s], hi = segb[s + 1]; for (int r = lo + F.tid; r < hi; r += NTHR) { rowtok[r] = -1; roww[r] = 0.f; } }
        for (int p = F.tid; p < segb[16] / 256; p += NTHR) { int e = 0; for (int s = 0; s < 16; ++s) if (p * 256 >= segb[s]) e = s & 7; tile_e[p] = e; }
        if (F.tid == 0) { meta[0] = segb[8] / 256; meta[1] = segb[16] / 256; }
    }
}

__global__ void __launch_bounds__(NTHR, 2) fwd(Args args) {
    extern __shared__ __attribute__((aligned(16))) unsigned char lds_raw[];
    Frame F;
    F.lds = (LAS unsigned char*)lds_raw; F.ws = args.ws; F.kb = __builtin_amdgcn_kernarg_segment_ptr(); F.out = args.out;
    F.tid = threadIdx.x; F.lane = F.tid & 63; F.wave = __builtin_amdgcn_readfirstlane(F.tid >> 6); F.G = gridDim.x; F.bid = blockIdx.x;
    volatile LAS unsigned* MISC = (volatile LAS unsigned*)(F.lds + LDS_MISC);
    if (F.tid < 64) MISC[F.tid] = 0u;
    __syncthreads();
    const int lo = args.ph_lo, hi = args.ph_hi;
    XcdBarrier bar; bar.bar = (unsigned*)(F.ws + WS_CTL) + 4096; bar.x = 0; bar.st = nullptr;
    if (hi - lo > 1) bar = xcd_barrier_post((unsigned*)(F.ws + WS_CTL) + 4096, MISC + 8);
    int ph = 0;
#ifndef SITE_MASK
#define SITE_MASK 0xffffffffull
#endif
#define PHASE_BEGIN if (((SITE_MASK >> __COUNTER__) & 1ull) && ph >= lo && ph < hi) { { int _t = threadIdx.x; asm volatile("" : "+v"(_t)); F.tid = _t; F.lane = _t & 63; F.wave = __builtin_amdgcn_readfirstlane(_t >> 6); \
      kptr_t _kb = __builtin_amdgcn_kernarg_segment_ptr(); asm volatile("" : "+s"(_kb)); F.kb = _kb; }
#define PHASE_END   if (ph + 1 < hi) xcd_barrier(bar); } ++ph;
    unsigned char* ws = F.ws;
    const bf16_t* HN = (const bf16_t*)(ws + WS_HN);

    PHASE_BEGIN ph_prologue0(F); PHASE_END
    PHASE_BEGIN { pg8::Gemm g{(const bf16_t*)(ws + WS_MEMH), (const bf16_t*)(ws + WS_WKV), D, 0, nullptr}; pg8::StaticOrder S; S.init(MEMROWS, 4096, F.G, F.bid);
        pg8::EpiPlain E{(bf16_t*)(ws + PR_KVRAW), 4096}; pg8::gemm_phase<pg8::EpiPlain, pg8::StaticOrder>(F.lds, g, S, E); } PHASE_END
    PHASE_BEGIN ph_prologue2(F); PHASE_END

#pragma unroll 1
    for (int l = 0; l < DEPTH; ++l) {
        const float* xin = l ? (const float*)F.out : FIN(F, I_X);
        PHASE_BEGIN ph_layer0(F, l, xin); PHASE_END
#pragma unroll 1
        for (int half = 0; half < 2; ++half) {
            const bf16_t* hnh = HN + (size_t)half * TH * D;
            PHASE_BEGIN { pg8::Gemm g{hnh, (const bf16_t*)(ws + W_IN), D, 0, nullptr}; pg8::StaticOrder S; S.init(TH, N_INP, F.G, F.bid);
                pg8::EpiWin E{(bf16_t*)(ws + MX_CA), (bf16_t*)(ws + MX_CB), (bf16_t*)(ws + MX_CG)}; pg8::gemm_phase<pg8::EpiWin, pg8::StaticOrder>(F.lds, g, S, E); } PHASE_END
            PHASE_BEGIN ph_rwkv_prep(F, l, half); ph_dsa_prep(F, l, half); PHASE_END
            PHASE_BEGIN { if (F.G >= 256) { if (F.bid < 128) ph_rwkv_scan(F, F.bid); else ph_dsa(F, half, F.bid - 128, F.G - 128); }
                          else { for (int p = F.bid; p < 128; p += F.G) ph_rwkv_scan(F, p); ph_dsa(F, half, F.bid, F.G); } } PHASE_END
            PHASE_BEGIN ph_rwkv_post(F, l); PHASE_END
            bf16_t* merged = (bf16_t*)(ws + WS_HN) + (size_t)half * TH * D;
            PHASE_BEGIN { pg8::Gemm g{(const bf16_t*)(ws + MX_RW + 1 * RW_ARR), (const bf16_t*)(ws + W_BA), 512, 0, nullptr}; pg8::StaticOrder S; S.init(TH, D, F.G, F.bid);
                pg8::EpiMerge<false> E{merged, (const bf16_t*)(ws + MX_CG), 0}; pg8::gemm_phase<pg8::EpiMerge<false>, pg8::StaticOrder>(F.lds, g, S, E); } PHASE_END
            PHASE_BEGIN { pg8::Gemm g{(const bf16_t*)(ws + MX_YB), (const bf16_t*)(ws + W_BB), 512, 0, nullptr}; pg8::StaticOrder S; S.init(TH, D, F.G, F.bid);
                pg8::EpiMerge<true> E{merged, (const bf16_t*)(ws + MX_CG), 1024}; pg8::gemm_phase<pg8::EpiMerge<true>, pg8::StaticOrder>(F.lds, g, S, E); } PHASE_END
        }
        PHASE_BEGIN { pg8::Gemm g{HN, (const bf16_t*)(ws + W_OUT), D, 0, nullptr}; pg8::StaticOrder S; S.init(T, D, F.G, F.bid);
            pg8::EpiResid E{xin, F.out}; pg8::gemm_phase<pg8::EpiResid, pg8::StaticOrder>(F.lds, g, S, E); } PHASE_END
        PHASE_BEGIN ph_norm(F); PHASE_END
        PHASE_BEGIN { pg8::Gemm g{HN, (const bf16_t*)(ws + W_MQ), D, 0, nullptr}; pg8::StaticOrder S; S.init(T, 512, F.G, F.bid);
            pg8::EpiPlain E{(bf16_t*)(ws + MA_QM), 512}; pg8::gemm_phase<pg8::EpiPlain, pg8::StaticOrder>(F.lds, g, S, E); } PHASE_END
        PHASE_BEGIN ph_mem_attn(F, l); PHASE_END
        PHASE_BEGIN { pg8::Gemm g{(const bf16_t*)(ws + MA_OM), (const bf16_t*)(ws + W_MO), 512, 0, nullptr}; pg8::StaticOrder S; S.init(T, D, F.G, F.bid);
            pg8::EpiResid E{F.out, F.out}; pg8::gemm_phase<pg8::EpiResid, pg8::StaticOrder>(F.lds, g, S, E); } PHASE_END
        PHASE_BEGIN ph_norm_ffn(F, l); PHASE_END
        if ((l & 1) == 0) {
            PHASE_BEGIN { pg8::Gemm g{HN, (const bf16_t*)(ws + W_FGU), D, 0, nullptr}; pg8::StaticOrder S; S.init(T, 2 * FFN, F.G, F.bid);
                pg8::EpiSwiGLU E{(bf16_t*)(ws + FF_GU), FFN}; pg8::gemm_phase<pg8::EpiSwiGLU, pg8::StaticOrder>(F.lds, g, S, E); } PHASE_END
            PHASE_BEGIN { pg8::Gemm g{(const bf16_t*)(ws + FF_GU), (const bf16_t*)(ws + W_FD), FFN, 0, nullptr}; pg8::StaticOrder S; S.init(T, D, F.G, F.bid);
                pg8::EpiResid E{F.out, F.out}; pg8::gemm_phase<pg8::EpiResid, pg8::StaticOrder>(F.lds, g, S, E); } PHASE_END
            ph += 2;
        } else {
            const int* meta = (const int*)(ws + MOE_META); const int* tile_e = (const int*)(ws + MOE_TILEE);
            PHASE_BEGIN ph_moe_route(F); PHASE_END
            PHASE_BEGIN { const int nt1 = __builtin_amdgcn_readfirstlane(meta[1]);
                pg8::Gemm g{HN, (const bf16_t*)(ws + W_EGU), D, (size_t)2 * EDIM * D, (const int*)(ws + MOE_ROWTOK)}; pg8::MoeOrder S; S.init(nt1, 11, F.G, F.bid, 0, tile_e);
                pg8::EpiSwiGLU E{(bf16_t*)(ws + FF_GU), EDIM}; pg8::gemm_phase<pg8::EpiSwiGLU, pg8::MoeOrder, true>(F.lds, g, S, E); } PHASE_END
            PHASE_BEGIN { const int nt0 = __builtin_amdgcn_readfirstlane(meta[0]);
                pg8::Gemm g{(const bf16_t*)(ws + FF_GU), (const bf16_t*)(ws + W_ED), EDIM, (size_t)D * EDIM, nullptr}; pg8::MoeOrder S; S.init(nt0, 4, F.G, F.bid, 0, tile_e);
                pg8::EpiMoeDown E{F.out, (const int*)(ws + MOE_ROWTOK), (const float*)(ws + MOE_ROWW)}; pg8::gemm_phase<pg8::EpiMoeDown, pg8::MoeOrder>(F.lds, g, S, E); } PHASE_END
            PHASE_BEGIN { const int nt0 = __builtin_amdgcn_readfirstlane(meta[0]), nt1 = __builtin_amdgcn_readfirstlane(meta[1]);
                pg8::Gemm g{(const bf16_t*)(ws + FF_GU), (const bf16_t*)(ws + W_ED), EDIM, (size_t)D * EDIM, nullptr}; pg8::MoeOrder S; S.init(nt1 - nt0, 4, F.G, F.bid, nt0, tile_e);
                pg8::EpiMoeDown E{F.out, (const int*)(ws + MOE_ROWTOK), (const float*)(ws + MOE_ROWW)}; pg8::gemm_phase<pg8::EpiMoeDown, pg8::MoeOrder>(F.lds, g, S, E); } PHASE_END
        }
    }
}
constexpr int N_PHASES = 3 + DEPTH * (1 + 2 * 6 + 6 + 4);

extern "C" void kernel_launch(void* const* d_in, const int* in_sizes, int n_in, void* d_out, int out_size, void* d_ws, size_t ws_size, hipStream_t stream) {
    static int grid = 0;
    if (grid == 0) {
        if (n_in != 41 || out_size != T * D || ws_size < WS_END) { fprintf(stderr, "kernel_launch: unexpected shapes (n_in %d, out %d, ws %zu < %zu); nothing launched\n", n_in, out_size, ws_size, (size_t)WS_END); grid = -1; return; }
        int dev = 0, cus = 0, per_cu = 0;
        if (hipGetDevice(&dev) != hipSuccess || hipDeviceGetAttribute(&cus, hipDeviceAttributeMultiprocessorCount, dev) != hipSuccess) { grid = -1; return; }
        if (hipFuncSetAttribute((const void*)fwd, hipFuncAttributeMaxDynamicSharedMemorySize, LDS_BYTES) != hipSuccess) { fprintf(stderr, "kernel_launch: hipFuncSetAttribute failed\n"); grid = -1; return; }
        if (hipOccupancyMaxActiveBlocksPerMultiprocessor(&per_cu, (const void*)fwd, NTHR, LDS_BYTES) != hipSuccess || per_cu < 1) fprintf(stderr, "kernel_launch: occupancy query reports %d\n", per_cu);
        (void)hipGetLastError();
        grid = cus;
    }
    if (grid < 0) return;
    if (hipMemsetAsync((char*)d_ws + WS_CTL, 0, CTL_ZERO_BYTES, stream) != hipSuccess) return;
    Args a{};
    for (int i = 0; i < 41; ++i) a.in[i] = d_in[i];
    a.out = (float*)d_out; a.ws = (unsigned char*)d_ws;
#if MK_ONE_LAUNCH
    a.ph_lo = 0; a.ph_hi = N_PHASES;
    hipLaunchKernelGGL(fwd, dim3(grid), dim3(NTHR), LDS_BYTES, stream, a);
#else
    for (int p = 0; p < N_PHASES; ++p) { a.ph_lo = p; a.ph_hi = p + 1; hipLaunchKernelGGL(fwd, dim3(grid), dim3(NTHR), LDS_BYTES, stream, a); }
#endif
}
```

```cpp
#include <hip/hip_runtime.h>
#include <cstdio>
#include <cstdint>

#ifndef MK_ONE_LAUNCH
#define MK_ONE_LAUNCH 1
#endif

namespace pg8 {
#define PG8_LAS __attribute__((address_space(3)))
typedef unsigned short bf16_t;
typedef short bf16x8 __attribute__((ext_vector_type(8)));
typedef float f32x4 __attribute__((ext_vector_type(4)));
typedef float f32x2 __attribute__((ext_vector_type(2)));
typedef unsigned u32x4 __attribute__((ext_vector_type(4)));
typedef unsigned u32x2 __attribute__((ext_vector_type(2)));
typedef __bf16 bf16x2_t __attribute__((ext_vector_type(2)));
constexpr int BM = 256, BK = 64, HALF = 128, HTB = HALF * BK * 2, STAGE_BYTES = 8 * HTB, NXCD = 8, WGM = 8;

__host__ __device__ __forceinline__ int lds_byte(int r, int c) { const int st = (r >> 4) * 2 + (c >> 5), rr = r & 15, cc = c & 31, ob = rr * 64 + cc * 2; return st * 1024 + (ob ^ (((ob >> 9) & 1) << 5)); }
__host__ __device__ __forceinline__ void stage_rc(int b, int& R, int& C) { const int st = b / 1024, sb = b % 1024, swz = sb ^ (((sb >> 9) & 1) << 5); R = (st >> 1) * 16 + swz / 64; C = (st & 1) * 32 + (swz % 64) / 2; }
__host__ __device__ __forceinline__ int perm32(int rho) { const int n = rho >> 4, i = rho & 15; return 8 * (i >> 2) + 4 * n + (i & 3); }

struct Unit { int pm, pn, e; };
struct Gemm { const bf16_t* A; const bf16_t* Bt; int K; size_t bstride; const int* rowidx; };

struct StaticOrder {
    int nM, nN, nwg, G, c;
    __device__ void init(int M, int N, int G_, int c_) { nM = M / BM; nN = N / BM; nwg = nM * nN; G = G_; c = c_; }
    __device__ bool next(int i, Unit& u) const {
        const long L = (long)i * G + c; if (L >= nwg) return false;
        int wgid = (int)L; { const int q = nwg / NXCD, r = nwg % NXCD, xcd = wgid % NXCD, off = wgid / NXCD; wgid = (xcd < r ? xcd * (q + 1) : r * (q + 1) + (xcd - r) * q) + off; }
        const int nig = WGM * nN, gid = wgid / nig, fm = gid * WGM, gsz = (nM - fm) < WGM ? (nM - fm) : WGM;
        u.pm = fm + ((wgid % nig) % gsz); u.pn = (wgid % nig) / gsz; u.e = 0; return true;
    }
};
struct MoeOrder {
    int nM, nN, nwg, G, c, pm0; const int* tile_e;
    __device__ void init(int nM_, int nN_, int G_, int c_, int pm0_, const int* te) { nM = nM_; nN = nN_; nwg = nM * nN; G = G_; c = c_; pm0 = pm0_; tile_e = te; }
    __device__ bool next(int i, Unit& u) const {
        const long L = (long)i * G + c; if (L >= nwg) return false;
        int wgid = (int)L; { const int q = nwg / NXCD, r = nwg % NXCD, xcd = wgid % NXCD, off = wgid / NXCD; wgid = (xcd < r ? xcd * (q + 1) : r * (q + 1) + (xcd - r) * q) + off; }
        const int nig = WGM * nN, gid = wgid / nig, fm = gid * WGM, gsz = (nM - fm) < WGM ? (nM - fm) : WGM;
        u.pm = pm0 + fm + ((wgid % nig) % gsz); u.pn = (wgid % nig) / gsz; u.e = __builtin_amdgcn_readfirstlane(tile_e[u.pm]); return true;
    }
};

__device__ __forceinline__ unsigned pk2(float lo, float hi) { const bf16x2_t v = __builtin_convertvector((f32x2){lo, hi}, bf16x2_t); return __builtin_bit_cast(unsigned, v); }
__device__ __forceinline__ float bf_lo(unsigned u) { return __builtin_bit_cast(float, u << 16); }
__device__ __forceinline__ float bf_hi(unsigned u) { return __builtin_bit_cast(float, u & 0xffff0000u); }
__device__ __forceinline__ float bf2f(bf16_t b) { return __builtin_bit_cast(float, (unsigned)b << 16); }
__device__ __forceinline__ bf16_t f2bf(float f) { return (bf16_t)(pk2(f, 0.f) & 0xffffu); }
__device__ __forceinline__ float sigmoidf_(float x) { return __builtin_amdgcn_rcpf(1.0f + __expf(-x)); }

struct EpiPlain {
    static constexpr bool PERM = true;
    bf16_t* O; int ldc;
    __device__ __forceinline__ void operator()(const f32x4 (&acc)[2][2][4][2], const Unit& u, int wr, int wc, int fr, int fq) const {
        const int row0 = u.pm * BM + wr * 64 + fr, col0 = u.pn * BM + wc * 32 + 8 * fq;
#pragma unroll
        for (int ai = 0; ai < 2; ++ai)
#pragma unroll
            for (int m = 0; m < 4; ++m) { bf16_t* rowp = O + (size_t)(row0 + ai * HALF + m * 16) * ldc + col0;
#pragma unroll
                for (int bj = 0; bj < 2; ++bj) { const f32x4 v0 = acc[ai][bj][m][0], v1 = acc[ai][bj][m][1];
                    u32x4 w; w.x = pk2(v0[0], v0[1]); w.y = pk2(v0[2], v0[3]); w.z = pk2(v1[0], v1[1]); w.w = pk2(v1[2], v1[3]);
                    *(u32x4*)(rowp + bj * HALF) = w; } }
    }
};
struct EpiWin {
    static constexpr bool PERM = true;
    bf16_t *CA, *CB, *CG;
    __device__ __forceinline__ void operator()(const f32x4 (&acc)[2][2][4][2], const Unit& u, int wr, int wc, int fr, int fq) const {
        const int row0 = u.pm * BM + wr * 64 + fr; const int pn = u.pn;
        bf16_t* base; int ldc, ct; const bool sg = pn >= 12;
        if (pn < 7) { base = CA; ldc = 1792; ct = pn; } else if (pn < 12) { base = CB; ldc = 1280; ct = pn - 7; } else { base = CG; ldc = 2048; ct = pn - 12; }
        const int col0 = ct * BM + wc * 32 + 8 * fq;
#pragma unroll
        for (int ai = 0; ai < 2; ++ai)
#pragma unroll
            for (int m = 0; m < 4; ++m) { bf16_t* rowp = base + (size_t)(row0 + ai * HALF + m * 16) * ldc + col0;
#pragma unroll
                for (int bj = 0; bj < 2; ++bj) { f32x4 v0 = acc[ai][bj][m][0], v1 = acc[ai][bj][m][1];
                    if (sg) {
#pragma unroll
                        for (int j = 0; j < 4; ++j) { v0[j] = sigmoidf_(v0[j]); v1[j] = sigmoidf_(v1[j]); } }
                    u32x4 w; w.x = pk2(v0[0], v0[1]); w.y = pk2(v0[2], v0[3]); w.z = pk2(v1[0], v1[1]); w.w = pk2(v1[2], v1[3]);
                    *(u32x4*)(rowp + bj * HALF) = w; } }
    }
};
template <bool ADD> struct EpiMerge {
    static constexpr bool PERM = true;
    bf16_t* O; const bf16_t* gate; int gcol;
    __device__ __forceinline__ void operator()(const f32x4 (&acc)[2][2][4][2], const Unit& u, int wr, int wc, int fr, int fq) const {
        const int row0 = u.pm * BM + wr * 64 + fr, col0 = u.pn * BM + wc * 32 + 8 * fq;
#pragma unroll
        for (int ai = 0; ai < 2; ++ai)
#pragma unroll
            for (int m = 0; m < 4; ++m) { const size_t row = (size_t)(row0 + ai * HALF + m * 16);
                bf16_t* rowp = O + row * 1024 + col0; const bf16_t* gp = gate + row * 2048 + gcol + col0;
#pragma unroll
                for (int bj = 0; bj < 2; ++bj) { const f32x4 v0 = acc[ai][bj][m][0], v1 = acc[ai][bj][m][1];
                    const u32x4 g = *(const u32x4*)(gp + bj * HALF);
                    float o[8] = { bf_lo(g.x) * v0[0], bf_hi(g.x) * v0[1], bf_lo(g.y) * v0[2], bf_hi(g.y) * v0[3], bf_lo(g.z) * v1[0], bf_hi(g.z) * v1[1], bf_lo(g.w) * v1[2], bf_hi(g.w) * v1[3] };
                    if (ADD) { const u32x4 p = *(const u32x4*)(rowp + bj * HALF);
                        o[0] += bf_lo(p.x); o[1] += bf_hi(p.x); o[2] += bf_lo(p.y); o[3] += bf_hi(p.y); o[4] += bf_lo(p.z); o[5] += bf_hi(p.z); o[6] += bf_lo(p.w); o[7] += bf_hi(p.w); }
                    u32x4 w; w.x = pk2(o[0], o[1]); w.y = pk2(o[2], o[3]); w.z = pk2(o[4], o[5]); w.w = pk2(o[6], o[7]);
                    *(u32x4*)(rowp + bj * HALF) = w; } }
    }
};
struct EpiResid {
    static constexpr bool PERM = false;
    const float* xi; float* xo;
    __device__ __forceinline__ void operator()(const f32x4 (&acc)[2][2][4][2], const Unit& u, int wr, int wc, int fr, int fq) const {
        const int row0 = u.pm * BM + wr * 64 + fr, col0 = u.pn * BM + wc * 32 + 4 * fq;
#pragma unroll
        for (int ai = 0; ai < 2; ++ai)
#pragma unroll
            for (int m = 0; m < 4; ++m) { const size_t o = (size_t)(row0 + ai * HALF + m * 16) * 1024 + col0;
#pragma unroll
                for (int bj = 0; bj < 2; ++bj)
#pragma unroll
                    for (int n = 0; n < 2; ++n) { const f32x4 x = *(const f32x4*)(xi + o + bj * HALF + n * 16); *(f32x4*)(xo + o + bj * HALF + n * 16) = x + acc[ai][bj][m][n]; } }
    }
};
struct EpiSwiGLU {
    static constexpr bool PERM = true;
    bf16_t* O; int ldc;
    __device__ __forceinline__ void operator()(const f32x4 (&acc)[2][2][4][2], const Unit& u, int wr, int wc, int fr, int fq) const {
        const int row0 = u.pm * BM + wr * 64 + fr, col0 = u.pn * HALF + wc * 32 + 8 * fq;
#pragma unroll
        for (int ai = 0; ai < 2; ++ai)
#pragma unroll
            for (int m = 0; m < 4; ++m) { bf16_t* rowp = O + (size_t)(row0 + ai * HALF + m * 16) * ldc + col0;
                float o[8];
#pragma unroll
                for (int n = 0; n < 2; ++n)
#pragma unroll
                    for (int j = 0; j < 4; ++j) { const float g = acc[ai][0][m][n][j], up = acc[ai][1][m][n][j]; o[4 * n + j] = g * sigmoidf_(g) * up; }
                u32x4 w; w.x = pk2(o[0], o[1]); w.y = pk2(o[2], o[3]); w.z = pk2(o[4], o[5]); w.w = pk2(o[6], o[7]);
                *(u32x4*)rowp = w; }
    }
};
struct EpiMoeDown {
    static constexpr bool PERM = false;
    float* x; const int* tok; const float* wgt;
    __device__ __forceinline__ void operator()(const f32x4 (&acc)[2][2][4][2], const Unit& u, int wr, int wc, int fr, int fq) const {
        const int row0 = u.pm * BM + wr * 64 + fr, col0 = u.pn * BM + wc * 32 + 4 * fq;
#pragma unroll
        for (int ai = 0; ai < 2; ++ai)
#pragma unroll
            for (int m = 0; m < 4; ++m) { const int row = row0 + ai * HALF + m * 16; const int t = tok[row]; const float wv = wgt[row];
                if (t >= 0) { float* xp = x + (size_t)t * 1024 + col0;
#pragma unroll
                    for (int bj = 0; bj < 2; ++bj)
#pragma unroll
                        for (int n = 0; n < 2; ++n) { const f32x4 xv = *(const f32x4*)(xp + bj * HALF + n * 16); *(f32x4*)(xp + bj * HALF + n * 16) = xv + acc[ai][bj][m][n] * wv; } } }
    }
};

template <class Epi, class Sched, bool GATHER = false>
__device__ __forceinline__ void gemm_phase(PG8_LAS unsigned char* lds, const Gemm g, const Sched& S, const Epi& E) {
    int tid_ = threadIdx.x; asm volatile("" : "+v"(tid_));
    const int tid = tid_, wid = __builtin_amdgcn_readfirstlane(tid >> 6), lane = tid & 63, wr = wid >> 2, wc = wid & 3, fr = lane & 15, fq = lane >> 4;
    const int K = g.K, nt = K / BK;
    unsigned voffA[2], voffB[2];
#pragma unroll
    for (int i = 0; i < 2; ++i) { int R, C; stage_rc(tid * 16 + i * 8192, R, C); const int Rb = Epi::PERM ? ((R & ~31) + perm32(R & 31)) : R;
        voffA[i] = (unsigned)(R * K + C) * 2u; voffB[i] = (unsigned)(Rb * K + C) * 2u; }
    const size_t kstep = (size_t)(BK * 2);
    const size_t hstep = (size_t)HALF * K * 2;
    const size_t tstep = 2 * hstep;
    const unsigned ldsw = (unsigned)wid * 1024u;
    const int aoff = lds_byte(wr * 64 + fr, fq * 8), boff = lds_byte(wc * 32 + fr, fq * 8);
    unsigned gvo[2][2];
#define PG8_SA(b, h) (((b) * 2 + (h)) * HTB)
#define PG8_SB(b, h) ((4 + (b) * 2 + (h)) * HTB)
#define PG8_STAGE(bufoff, gbase, voff) do { _Pragma("unroll") for (int _i = 0; _i < 2; ++_i) \
        __builtin_amdgcn_global_load_lds((const unsigned*)((const char*)(gbase) + (voff)[_i]), (PG8_LAS unsigned*)(lds + (bufoff) + ldsw + _i * 8192), 16, 0, 0); } while (0)
#define PG8_STAGE_A(bufoff, h, ubase, kb, nx) do { if constexpr (GATHER) { PG8_STAGE(bufoff, (const char*)g.A + (kb), gvo[h]); } \
        else { PG8_STAGE(bufoff, (ubase) + (kb) + (h) * hstep, voffA); } } while (0)
#define PG8_LOADROWS(dst, unit) do { if constexpr (GATHER) { _Pragma("unroll") for (int _i = 0; _i < 2; ++_i) { int _R, _C; stage_rc(tid * 16 + _i * 8192, _R, _C); \
        _Pragma("unroll") for (int _h = 0; _h < 2; ++_h) { int _t = g.rowidx[(unit).pm * BM + _h * HALF + _R]; _t = _t < 0 ? 0 : _t; dst[_h][_i] = (unsigned)(_t * K + _C) * 2u; } } } } while (0)
#define PG8_LDA(dst, b, h) do { _Pragma("unroll") for (int m = 0; m < 4; ++m) _Pragma("unroll") for (int k = 0; k < 2; ++k) dst[m][k] = *(const PG8_LAS bf16x8*)(lds + PG8_SA(b, h) + aoff + m * 2048 + k * 1024); } while (0)
#define PG8_LDB(dst, b, h) do { _Pragma("unroll") for (int n = 0; n < 2; ++n) _Pragma("unroll") for (int k = 0; k < 2; ++k) dst[n][k] = *(const PG8_LAS bf16x8*)(lds + PG8_SB(b, h) + boff + n * 2048 + k * 1024); } while (0)
#define PG8_MMA(ai, bj, At, Bt) do { __builtin_amdgcn_s_setprio(1); _Pragma("unroll") for (int m = 0; m < 4; ++m) _Pragma("unroll") for (int n = 0; n < 2; ++n) _Pragma("unroll") for (int k = 0; k < 2; ++k) \
        acc[ai][bj][m][n] = __builtin_amdgcn_mfma_f32_16x16x32_bf16(Bt[n][k], At[m][k], acc[ai][bj][m][n], 0, 0, 0); __builtin_amdgcn_s_setprio(0); } while (0)
#define PG8_WAIT_V(n) asm volatile("s_waitcnt vmcnt(" #n ")" ::: "memory")
#define PG8_WAIT_L(n) asm volatile("s_waitcnt lgkmcnt(" #n ")" ::: "memory")
#define PG8_BAR __builtin_amdgcn_s_barrier()
#define PG8_SCHED __builtin_amdgcn_sched_barrier(0)
    Unit cur, nxt; int ui = 0;
    if (!S.next(0, cur)) return;
    f32x4 acc[2][2][4][2];
#pragma unroll
    for (int a = 0; a < 2; ++a)
#pragma unroll
        for (int b = 0; b < 2; ++b)
#pragma unroll
            for (int m = 0; m < 4; ++m)
#pragma unroll
                for (int n = 0; n < 2; ++n) acc[a][b][m][n] = (f32x4){0.f, 0.f, 0.f, 0.f};
    bf16x8 At[4][2], B0[2][2], B1[2][2];
    const char* cA = GATHER ? (const char*)g.A : (const char*)g.A + (size_t)cur.pm * tstep;
    const char* cB = (const char*)g.Bt + ((size_t)cur.e * g.bstride) * 2 + (size_t)cur.pn * tstep;
    PG8_LOADROWS(gvo, cur);
    PG8_STAGE(PG8_SB(0, 0), cB, voffB); PG8_STAGE(PG8_SB(0, 1), cB + hstep, voffB); PG8_STAGE_A(PG8_SA(0, 0), 0, cA, 0, false); PG8_STAGE_A(PG8_SA(0, 1), 1, cA, 0, false);
    if (wr == 1) PG8_BAR;
    PG8_WAIT_V(2); PG8_BAR;
    PG8_STAGE(PG8_SB(1, 0), cB + kstep, voffB); PG8_STAGE_A(PG8_SA(1, 0), 0, cA, kstep, false); PG8_STAGE(PG8_SB(1, 1), cB + hstep + kstep, voffB);
    PG8_WAIT_V(6); PG8_BAR;
    for (;;) {
        const bool has_next = S.next(ui + 1, nxt);
        const char* nA = GATHER ? (const char*)g.A : (has_next ? (const char*)g.A + (size_t)nxt.pm * tstep : cA);
        const char* nB = has_next ? (const char*)g.Bt + ((size_t)nxt.e * g.bstride) * 2 + (size_t)nxt.pn * tstep : cB;
        for (int t = 0; t < nt; t += 2) {
            const bool last = (t == nt - 2);
            const size_t k1 = (size_t)(t + 1) * kstep;
            const size_t k2 = last ? 0 : (size_t)(t + 2) * kstep, k3 = k2 + kstep;
            const char* a2b = last ? nA : cA; const char* b2 = (last ? nB : cB) + k2; const char* b3 = b2 + kstep;
            PG8_LDB(B0, 0, 0); PG8_LDB(B1, 0, 1); PG8_SCHED; PG8_LDA(At, 0, 0); PG8_STAGE_A(PG8_SA(1, 1), 1, cA, k1, false);
            if (last && has_next) PG8_LOADROWS(gvo, nxt);
            PG8_WAIT_V(8); PG8_WAIT_L(0); PG8_BAR; PG8_MMA(0, 0, At, B0); PG8_MMA(0, 1, At, B1); PG8_BAR; PG8_SCHED;
            PG8_LDA(At, 0, 1); PG8_STAGE(PG8_SB(0, 0), b2, voffB); PG8_STAGE(PG8_SB(0, 1), b2 + hstep, voffB); PG8_STAGE_A(PG8_SA(0, 0), 0, a2b, k2, last);
            PG8_WAIT_V(8); PG8_WAIT_L(0); PG8_BAR; PG8_MMA(1, 0, At, B0); PG8_MMA(1, 1, At, B1); PG8_BAR; PG8_SCHED;
            PG8_LDB(B0, 1, 0); PG8_LDB(B1, 1, 1); PG8_SCHED; PG8_LDA(At, 1, 0); PG8_STAGE_A(PG8_SA(0, 1), 1, a2b, k2, last);
            PG8_WAIT_V(8); PG8_WAIT_L(0); PG8_BAR; PG8_MMA(0, 0, At, B0); PG8_MMA(0, 1, At, B1); PG8_BAR; PG8_SCHED;
            PG8_LDA(At, 1, 1); PG8_STAGE(PG8_SB(1, 0), b3, voffB); PG8_STAGE(PG8_SB(1, 1), b3 + hstep, voffB); PG8_STAGE_A(PG8_SA(1, 0), 0, a2b, k3, last);
            PG8_WAIT_V(8); PG8_WAIT_L(0); PG8_BAR; PG8_MMA(1, 0, At, B0); PG8_MMA(1, 1, At, B1); PG8_BAR; PG8_SCHED;
        }
        E(acc, cur, wr, wc, fr, fq);
        if (!has_next) break;
#pragma unroll
        for (int a = 0; a < 2; ++a)
#pragma unroll
            for (int b = 0; b < 2; ++b)
#pragma unroll
                for (int m = 0; m < 4; ++m)
#pragma unroll
                    for (int n = 0; n < 2; ++n) acc[a][b][m][n] = (f32x4){0.f, 0.f, 0.f, 0.f};
        cur = nxt; cA = nA; cB = nB; ++ui;
    }
    PG8_WAIT_V(0);
    if (wr == 0) PG8_BAR;
    PG8_BAR;
#undef PG8_SA
#undef PG8_SB
#undef PG8_STAGE
#undef PG8_STAGE_A
#undef PG8_LOADROWS
#undef PG8_LDA
#undef PG8_LDB
#undef PG8_MMA
#undef PG8_WAIT_V
#undef PG8_WAIT_L
#undef PG8_BAR
#undef PG8_SCHED
}
}
using pg8::bf16_t; using pg8::bf16x8; using pg8::f32x4; using pg8::f32x2; using pg8::u32x4; using pg8::u32x2; using pg8::pk2; using pg8::bf2f; using pg8::f2bf; using pg8::bf_lo; using pg8::bf_hi; using pg8::sigmoidf_;

constexpr int NWAVES = 8, NTHR = 512;
constexpr int D = 1024, NB = 32, SEQ = 2048, T = NB * SEQ, TH = T / 2, DEPTH = 4;
constexpr int RW_COLS = 1792, DS_COLS = 1224, DS_PAD = 1280, N_IN = 5064, N_INP = 5120;
constexpr int NMEM = 256, MEMROWS = NB * NMEM;
constexpr int FFN = 2816, NEXP = 8, EDIM = 1408;
constexpr int MOE_ROWS_MAX = 2 * T + 16 * 256;
constexpr int MOE_TILES_MAX = MOE_ROWS_MAX / 256;

constexpr size_t MiB = 1u << 20;
constexpr size_t WS_CTL = 0, CTL_ZERO_BYTES = 1 * MiB;
constexpr size_t WS_MOE = 1 * MiB;
constexpr size_t MOE_SELE = WS_MOE, MOE_SELW = MOE_SELE + (size_t)T * 2, MOE_ROWTOK = MOE_SELW + (size_t)T * 8, MOE_ROWW = MOE_ROWTOK + (size_t)MOE_ROWS_MAX * 4,
                 MOE_TILEE = MOE_ROWW + (size_t)MOE_ROWS_MAX * 4, MOE_META = MOE_TILEE + (size_t)MOE_TILES_MAX * 4, MOE_END = MOE_META + 256;
static_assert(MOE_END <= 4 * MiB, "moe map");
constexpr size_t WS_W = 4 * MiB;
constexpr size_t W_IN = WS_W, W_BA = W_IN + (size_t)N_INP * D * 2, W_BB = W_BA + (size_t)D * 512 * 2, W_OUT = W_BB + (size_t)D * 512 * 2, W_MQ = W_OUT + (size_t)D * D * 2,
                 W_MO = W_MQ + (size_t)512 * D * 2, W_FF = W_MO + (size_t)D * 512 * 2;
constexpr size_t W_RW2 = W_FF, W_RA2 = W_RW2 + 512 * 64 * 2, W_RG2 = W_RA2 + 512 * 64 * 2, W_RV1 = W_RG2 + 512 * 128 * 2, W_RV2 = W_RV1 + 32 * 512 * 2, W_FF2 = W_RV2 + 512 * 32 * 2;
constexpr size_t W_FGU = W_FF2, W_FD = W_FGU + (size_t)2 * FFN * D * 2;
constexpr size_t W_EGU = W_FF2, W_ED = W_EGU + (size_t)NEXP * 2 * EDIM * D * 2, W_END = W_ED + (size_t)NEXP * D * EDIM * 2;
static_assert(W_FD + (size_t)D * FFN * 2 <= W_END, "w map");
constexpr size_t WS_WKV = (W_END + MiB - 1) / MiB * MiB;
constexpr size_t WS_MEMH = WS_WKV + (size_t)4096 * D * 2;
constexpr size_t WS_MEMK = WS_MEMH + (size_t)MEMROWS * D * 2;
constexpr size_t WS_MEMVT = WS_MEMK + (size_t)DEPTH * MEMROWS * 512 * 2;
constexpr size_t WS_VFIRST = WS_MEMVT + (size_t)DEPTH * MEMROWS * 512 * 2;
constexpr size_t WS_HN = WS_VFIRST + (size_t)T * 512 * 2;
constexpr size_t WS_MIX = WS_HN + (size_t)T * D * 2;
constexpr size_t MX_CA = WS_MIX, MX_CB = MX_CA + (size_t)TH * RW_COLS * 2, MX_CG = MX_CB + (size_t)TH * DS_PAD * 2, MX_RW = MX_CG + (size_t)TH * 2048 * 2;
constexpr size_t RW_ARR = (size_t)TH * 512 * 2;
constexpr size_t MX_VT = MX_RW + 7 * RW_ARR, MX_YB = MX_VT + (size_t)(NB / 2) * 64 * SEQ * 2, MX_END = MX_YB + (size_t)TH * 512 * 2;
constexpr size_t MA_QM = WS_MIX, MA_OM = MA_QM + (size_t)T * 512 * 2;
constexpr size_t FF_GU = WS_MIX;
constexpr size_t PR_KVRAW = WS_MIX;
constexpr size_t WS_END = MX_END;
static_assert(FF_GU + (size_t)T * FFN * 2 <= WS_END && FF_GU + (size_t)MOE_ROWS_MAX * EDIM * 2 <= WS_END && MA_OM + (size_t)T * 512 * 2 <= WS_END, "overlay map");
static_assert(WS_END <= 1000 * MiB, "workspace budget");

constexpr int LDS_BYTES = 160 * 1024;
constexpr int LDS_MISC = LDS_BYTES - 256;

#define XB_TMO      128
#define XB_XCNT(j)  (256  + 64 * (j))
#define XB_XSUB(j)  (1280 + 64 * (j))
#define XB_XGEN(j)  (2304 + 64 * (j))
#define XB_TOP      3328
#define XB_TOPGEN   3392
#define XCD_BAR_WORDS 3456
#define XB_SPIN_CAP (1u << 18)
#define LAS __attribute__((address_space(3)))

__device__ __forceinline__ unsigned xb_ld(unsigned* p)              { return __hip_atomic_load(p, __ATOMIC_RELAXED, __HIP_MEMORY_SCOPE_AGENT); }
__device__ __forceinline__ unsigned xb_add(unsigned* p, unsigned v) { return __hip_atomic_fetch_add(p, v, __ATOMIC_RELAXED, __HIP_MEMORY_SCOPE_AGENT); }
__device__ __forceinline__ unsigned xb_xcc_id() { return (unsigned)__builtin_amdgcn_s_getreg((3 << 11) | 20) & 0xFu; }
#define XB_SPIN(cond, bar) do { unsigned _sp = 0; while (cond) { __builtin_amdgcn_s_sleep(1); \
    if ((++_sp & 255u) == 0u) { if (xb_ld(&(bar)[XB_TMO])) break; if (_sp > XB_SPIN_CAP) { atomicAdd(&(bar)[XB_TMO], 1u); break; } } } } while (0)
struct XcdBarrier { unsigned* bar; unsigned x; volatile LAS unsigned* st; };
__device__ __forceinline__ XcdBarrier xcd_barrier_post(unsigned* bar, volatile LAS unsigned* st) {
    XcdBarrier b; b.bar = bar; b.x = xb_xcc_id(); b.st = st;
    if (threadIdx.x == 0) (void)xb_add(&bar[XB_XCNT(b.x)], 1u);
    return b;
}
__device__ __forceinline__ void xcd_barrier_complete(unsigned* bar, unsigned x, unsigned& nloc, unsigned& nx) {
    const unsigned G = gridDim.x * gridDim.y * gridDim.z;
    unsigned sum, cnt, mine, sp = 0u;
    for (;;) {
        sum = 0u; cnt = 0u; mine = 0u;
#pragma unroll
        for (unsigned j = 0; j < 16; ++j) { const unsigned c = xb_ld(&bar[XB_XCNT(j)]); sum += c; cnt += (c > 0u) ? 1u : 0u; mine = (j == x) ? c : mine; }
        if (sum == G) break;
        __builtin_amdgcn_s_sleep(1);
        if ((++sp & 255u) == 0u) { if (xb_ld(&bar[XB_TMO])) break; if (sp > XB_SPIN_CAP) { atomicAdd(&bar[XB_TMO], 1u); break; } }
    }
    nloc = mine > 0u ? mine : 1u; nx = cnt > 0u ? cnt : 1u;
}
__device__ __forceinline__ void xcd_barrier(const XcdBarrier& b) {
    asm volatile("s_waitcnt vmcnt(0)" ::: "memory");
    __syncthreads();
    if (threadIdx.x == 0) {
        unsigned* bar = b.bar;
        __builtin_amdgcn_s_waitcnt(0);
        unsigned nloc = b.st[0], nx = b.st[1];
        if (nloc == 0u) { xcd_barrier_complete(bar, b.x, nloc, nx); b.st[0] = nloc; b.st[1] = nx; }
        const unsigned old = xb_add(&bar[XB_XSUB(b.x)], 1u);
        const unsigned gen = old / nloc;
        if (old + 1u == (gen + 1u) * nloc) {
            __builtin_amdgcn_fence(__ATOMIC_RELEASE, "agent");
            asm volatile("s_waitcnt vmcnt(0)" ::: "memory");
            const unsigned og = xb_add(&bar[XB_TOP], 1u);
            const unsigned tg = og / nx;
            if (og + 1u == (tg + 1u) * nx) xb_add(&bar[XB_TOPGEN], 1u);
            else XB_SPIN(xb_ld(&bar[XB_TOPGEN]) == tg, bar);
            __builtin_amdgcn_fence(__ATOMIC_ACQUIRE, "agent");
            xb_add(&bar[XB_XGEN(b.x)], 1u);
            asm volatile("s_waitcnt vmcnt(0)" ::: "memory");
        } else {
            XB_SPIN(xb_ld(&bar[XB_XGEN(b.x)]) == gen, bar);
            __builtin_amdgcn_fence(__ATOMIC_ACQUIRE, "agent");
            asm volatile("s_waitcnt vmcnt(0)" ::: "memory");
        }
    }
    __syncthreads();
}

struct Args { const void* in[41]; float* out; unsigned char* ws; int ph_lo, ph_hi; };
static_assert(sizeof(Args) == 41 * 8 + 8 + 8 + 8, "Args has no padding");

enum InIdx { I_X = 0, I_MEM, I_POS, I_NORM_MIX, I_W_IN, I_MU, I_W0, I_W2, I_A0, I_A2, I_G2, I_V0, I_V1, I_V2, I_KK, I_KA, I_RK, I_LNG, I_LNB, I_QN, I_KN, I_IKN,
             I_WBA, I_WBB, I_WOUT, I_NORM_MEM, I_MEM_TOKN, I_MWQ, I_MWKV, I_MQN, I_MKN, I_MWO, I_NORM_FFN, I_FWG, I_FWU, I_FWD, I_ROUTER, I_RBIAS, I_EWG, I_EWU, I_EWD };

typedef decltype(__builtin_amdgcn_kernarg_segment_ptr()) kptr_t;
struct Frame {
    LAS unsigned char* lds; unsigned char* ws; kptr_t kb; float* out;
    int tid, lane, wave, G, bid;
};
#define LDS_WAIT() asm volatile("s_waitcnt lgkmcnt(0)" ::: "memory")
__device__ __forceinline__ const void* kargp(kptr_t kb, int i) { typedef const void* cvp; typedef __attribute__((address_space(4))) const cvp* tab_t; return ((tab_t)kb)[i]; }
#define KARGP(F, i) kargp((F).kb, (i))
#define FIN(F, i) ((const float*)KARGP(F, i))

__device__ __forceinline__ float wave_sum(float v) {
#pragma unroll
    for (int o = 1; o < 64; o <<= 1) v += __shfl_xor(v, o);
    return v;
}

template <class Map>
__device__ __forceinline__ void transpose_item(const float* W, int K, int N, bf16_t* WT, const Map& map, const float* gain, LAS float* scr, int item, int lane) {
    const int nblk = (N + 31) / 32, kb = item / nblk, nb = item % nblk, k0 = 64 * kb, n0 = 32 * nb;
    const int nn = n0 + (lane & 31);
#pragma unroll 8
    for (int i = 0; i < 32; ++i) { const int kk = 2 * i + (lane >> 5); float v = 0.f; if (nn < N && k0 + kk < K) { v = W[(size_t)(k0 + kk) * N + nn]; if (gain) v *= gain[k0 + kk]; } scr[kk * 33 + (lane & 31)] = v; }
    LDS_WAIT(); asm volatile("" ::: "memory");
    const int c = lane & 7;
#pragma unroll
    for (int j = 0; j < 4; ++j) { const int n = (lane >> 3) + 8 * j; const LAS float* s = scr + (8 * c) * 33 + n;
        u32x4 o; o.x = pk2(s[0 * 33], s[1 * 33]); o.y = pk2(s[2 * 33], s[3 * 33]); o.z = pk2(s[4 * 33], s[5 * 33]); o.w = pk2(s[6 * 33], s[7 * 33]);
        if (n0 + n < N && k0 + 8 * c < K) *(u32x4*)(WT + (size_t)map(n0 + n) * K + k0 + 8 * c) = o; }
    LDS_WAIT(); asm volatile("" ::: "memory");
}
struct MapId { int off; __device__ int operator()(int n) const { return n + off; } };
struct MapWin { __device__ int operator()(int n) const { return n < 3016 ? n : n + 56; } };
struct MapGU { int up; __device__ int operator()(int n) const { return (n >> 7) * 256 + up * 128 + (n & 127); } };

__device__ __forceinline__ void rms_row_to_bf16(const float* xrow, bf16_t* orow, int lane, f32x4 (&v)[4]) {
    const f32x4* xr = (const f32x4*)xrow + lane; float s = 0.f;
#pragma unroll
    for (int j = 0; j < 4; ++j) { v[j] = xr[64 * j]; s += (v[j].x * v[j].x + v[j].y * v[j].y) + (v[j].z * v[j].z + v[j].w * v[j].w); }
    const float rstd = 1.0f / sqrtf(wave_sum(s) * (1.f / D) + 1e-6f);
    u32x2* o8 = (u32x2*)orow + lane;
#pragma unroll
    for (int j = 0; j < 4; ++j) { v[j] = v[j] * rstd; u32x2 w; w.x = pk2(v[j].x, v[j].y); w.y = pk2(v[j].z, v[j].w); o8[64 * j] = w; }
}

__device__ __forceinline__ void ph_prologue0(Frame& F) {
    LAS float* scr = (LAS float*)(F.lds + F.wave * 16384);
    const int gw = F.bid * NWAVES + F.wave, NGW = F.G * NWAVES;
    bf16_t* wkv = (bf16_t*)(F.ws + WS_WKV);
    constexpr int IT = (D / 64) * (1024 / 32);
    for (int it = gw; it < DEPTH * IT; it += NGW) { const int l = it / IT, r = it % IT;
        transpose_item(FIN(F, I_MWKV) + (size_t)l * D * 1024, D, 1024, wkv, MapId{l * 1024}, FIN(F, I_MEM_TOKN) + l * D, scr, r, F.lane); }
    bf16_t* mh = (bf16_t*)(F.ws + WS_MEMH);
    for (int m = gw; m < MEMROWS; m += NGW) { f32x4 v[4]; rms_row_to_bf16(FIN(F, I_MEM) + (size_t)m * D, mh + (size_t)m * D, F.lane, v); }
}
__device__ __forceinline__ void ph_prologue2(Frame& F) {
    const int gw = F.bid * NWAVES + F.wave, NGW = F.G * NWAVES;
    const bf16_t* kv = (const bf16_t*)(F.ws + PR_KVRAW);
    bf16_t* MK = (bf16_t*)(F.ws + WS_MEMK); bf16_t* MVT = (bf16_t*)(F.ws + WS_MEMVT);
    for (int it = gw; it < MEMROWS * 16; it += NGW) {
        const int row = it >> 4, l = (it >> 2) & 3, hh = it & 3, b = row >> 8, m = row & 255;
        const bf16_t* src = kv + (size_t)row * 4096 + l * 1024;
        const unsigned kk = *(const unsigned*)(src + hh * 128 + 2 * F.lane);
        const float k0 = bf_lo(kk), k1 = bf_hi(kk);
        const float rstd = 1.0f / sqrtf(wave_sum(k0 * k0 + k1 * k1) * (1.f / 128.f) + 1e-6f);
        const float* gk = FIN(F, I_MKN) + l * 128;
        *(unsigned*)(MK + ((((size_t)l * NB + b) * 4 + hh) * 256 + m) * 128 + 2 * F.lane) = pk2(k0 * rstd * gk[2 * F.lane], k1 * rstd * gk[2 * F.lane + 1]);
        const unsigned vv = *(const unsigned*)(src + 512 + hh * 128 + 2 * F.lane);
        bf16_t* vt = MVT + (((size_t)l * NB + b) * 4 + hh) * 128 * 256 + m;
        vt[(size_t)(2 * F.lane) * 256] = (bf16_t)(vv & 0xffffu); vt[(size_t)(2 * F.lane + 1) * 256] = (bf16_t)(vv >> 16);
    }
}
__device__ __forceinline__ void ph_layer0(Frame& F, int l, const float* xin) {
    LAS float* scr = (LAS float*)(F.lds + F.wave * 16384);
    const int gw = F.bid * NWAVES + F.wave, NGW = F.G * NWAVES;
    unsigned char* ws = F.ws;
    constexpr int I_WIN = (D / 64) * ((N_IN + 31) / 32), I_B = (512 / 64) * (D / 32), I_O = (D / 64) * (D / 32), I_Q = (D / 64) * (512 / 32);
    constexpr int I_FG = (D / 64) * (FFN / 32), I_FDN = (FFN / 64) * (D / 32), I_EG = (D / 64) * (EDIM / 32), I_EDN = (EDIM / 64) * (D / 32);
    const bool moe = (l & 1) != 0; const int j = l >> 1;
    const int nff = moe ? NEXP * (2 * I_EG + I_EDN) : (2 * I_FG + I_FDN);
    constexpr int I_R2 = 16, I_RG = 32, I_RV1 = 8, I_RV2 = 16;
    const int nrw = 2 * I_R2 + I_RG + (l ? I_RV1 + I_RV2 : 0);
    const int NIT = I_WIN + 2 * I_B + I_O + I_Q + I_B + nrw + nff;
    const float* gffn = FIN(F, I_NORM_FFN) + l * D;
    for (int it = gw; it < NIT; it += NGW) {
        int r = it;
        if (r < I_WIN) { transpose_item(FIN(F, I_W_IN) + (size_t)l * D * N_IN, D, N_IN, (bf16_t*)(ws + W_IN), MapWin{}, FIN(F, I_NORM_MIX) + l * D, scr, r, F.lane); continue; } r -= I_WIN;
        if (r < I_B) { transpose_item(FIN(F, I_WBA) + (size_t)l * 512 * D, 512, D, (bf16_t*)(ws + W_BA), MapId{0}, nullptr, scr, r, F.lane); continue; } r -= I_B;
        if (r < I_B) { transpose_item(FIN(F, I_WBB) + (size_t)l * 512 * D, 512, D, (bf16_t*)(ws + W_BB), MapId{0}, nullptr, scr, r, F.lane); continue; } r -= I_B;
        if (r < I_O) { transpose_item(FIN(F, I_WOUT) + (size_t)l * D * D, D, D, (bf16_t*)(ws + W_OUT), MapId{0}, nullptr, scr, r, F.lane); continue; } r -= I_O;
        if (r < I_Q) { transpose_item(FIN(F, I_MWQ) + (size_t)l * D * 512, D, 512, (bf16_t*)(ws + W_MQ), MapId{0}, FIN(F, I_NORM_MEM) + l * D, scr, r, F.lane); continue; } r -= I_Q;
        if (r < I_B) { transpose_item(FIN(F, I_MWO) + (size_t)l * 512 * D, 512, D, (bf16_t*)(ws + W_MO), MapId{0}, nullptr, scr, r, F.lane); continue; } r -= I_B;
        if (r < nrw) {
            if (r < I_R2) { transpose_item(FIN(F, I_W2) + (size_t)l * 64 * 512, 64, 512, (bf16_t*)(ws + W_RW2), MapId{0}, nullptr, scr, r, F.lane); continue; } r -= I_R2;
            if (r < I_R2) { transpose_item(FIN(F, I_A2) + (size_t)l * 64 * 512, 64, 512, (bf16_t*)(ws + W_RA2), MapId{0}, nullptr, scr, r, F.lane); continue; } r -= I_R2;
            if (r < I_RG) { transpose_item(FIN(F, I_G2) + (size_t)l * 128 * 512, 128, 512, (bf16_t*)(ws + W_RG2), MapId{0}, nullptr, scr, r, F.lane); continue; } r -= I_RG;
            if (r < I_RV1) { transpose_item(FIN(F, I_V1) + (size_t)(l - 1) * 512 * 32, 512, 32, (bf16_t*)(ws + W_RV1), MapId{0}, nullptr, scr, r, F.lane); continue; } r -= I_RV1;
            transpose_item(FIN(F, I_V2) + (size_t)(l - 1) * 32 * 512, 32, 512, (bf16_t*)(ws + W_RV2), MapId{0}, nullptr, scr, r, F.lane); continue;
        }
        r -= nrw;
        if (!moe) {
            if (r < I_FG) { transpose_item(FIN(F, I_FWG) + (size_t)j * D * FFN, D, FFN, (bf16_t*)(ws + W_FGU), MapGU{0}, gffn, scr, r, F.lane); continue; } r -= I_FG;
            if (r < I_FG) { transpose_item(FIN(F, I_FWU) + (size_t)j * D * FFN, D, FFN, (bf16_t*)(ws + W_FGU), MapGU{1}, gffn, scr, r, F.lane); continue; } r -= I_FG;
            transpose_item(FIN(F, I_FWD) + (size_t)j * FFN * D, FFN, D, (bf16_t*)(ws + W_FD), MapId{0}, nullptr, scr, r, F.lane);
        } else {
            const int per = 2 * I_EG + I_EDN, e = r / per; r -= e * per;
            const size_t eo = (size_t)(j * NEXP + e);
            if (r < I_EG) { transpose_item(FIN(F, I_EWG) + eo * D * EDIM, D, EDIM, (bf16_t*)(ws + W_EGU) + (size_t)e * 2 * EDIM * D, MapGU{0}, gffn, scr, r, F.lane); continue; } r -= I_EG;
            if (r < I_EG) { transpose_item(FIN(F, I_EWU) + eo * D * EDIM, D, EDIM, (bf16_t*)(ws + W_EGU) + (size_t)e * 2 * EDIM * D, MapGU{1}, gffn, scr, r, F.lane); continue; } r -= I_EG;
            transpose_item(FIN(F, I_EWD) + eo * EDIM * D, EDIM, D, (bf16_t*)(ws + W_ED) + (size_t)e * D * EDIM, MapId{0}, nullptr, scr, r, F.lane);
        }
    }
    { u32x4* z = (u32x4*)((bf16_t*)(ws + W_IN) + (size_t)3016 * D); const int n16 = 56 * D * 2 / 16;
      for (int i = F.bid * NTHR + F.tid; i < n16; i += F.G * NTHR) z[i] = (u32x4){0u, 0u, 0u, 0u}; }
    bf16_t* hn = (bf16_t*)(ws + WS_HN);
    for (int m = gw; m < T; m += NGW) { f32x4 v[4]; rms_row_to_bf16(xin + (size_t)m * D, hn + (size_t)m * D, F.lane, v); }
}
__device__ __forceinline__ void ph_norm(Frame& F) {
    const int gw = F.bid * NWAVES + F.wave, NGW = F.G * NWAVES;
    bf16_t* hn = (bf16_t*)(F.ws + WS_HN);
    for (int m = gw; m < T; m += NGW) { f32x4 v[4]; rms_row_to_bf16(F.out + (size_t)m * D, hn + (size_t)m * D, F.lane, v); }
}
__device__ __forceinline__ void ph_norm_ffn(Frame& F, int l) {
    const int gw = F.bid * NWAVES + F.wave, NGW = F.G * NWAVES;
    bf16_t* hn = (bf16_t*)(F.ws + WS_HN);
    const bool moe = (l & 1) != 0; const int j = l >> 1;
    const float* gn = FIN(F, I_NORM_FFN) + l * D;
    const float* rt = FIN(F, I_ROUTER) + (size_t)j * D * NEXP; const float* rb = FIN(F, I_RBIAS) + j * NEXP;
    unsigned short* sele = (unsigned short*)(F.ws + MOE_SELE); f32x2* selw = (f32x2*)(F.ws + MOE_SELW);
    for (int m = gw; m < T; m += NGW) {
        f32x4 v[4]; rms_row_to_bf16(F.out + (size_t)m * D, hn + (size_t)m * D, F.lane, v);
        if (moe) {
            float lg[8];
#pragma unroll
            for (int e = 0; e < 8; ++e) lg[e] = 0.f;
#pragma unroll
            for (int q = 0; q < 4; ++q)
#pragma unroll
                for (int c = 0; c < 4; ++c) { const int k = 256 * q + 4 * F.lane + c; const float h = v[q][c] * gn[k];
                    const f32x4 r0 = *(const f32x4*)(rt + (size_t)k * 8), r1 = *(const f32x4*)(rt + (size_t)k * 8 + 4);
                    lg[0] += h * r0.x; lg[1] += h * r0.y; lg[2] += h * r0.z; lg[3] += h * r0.w; lg[4] += h * r1.x; lg[5] += h * r1.y; lg[6] += h * r1.z; lg[7] += h * r1.w; }
#pragma unroll
            for (int e = 0; e < 8; ++e) lg[e] = wave_sum(lg[e]) + rb[e];
            int e0 = 0; float l0 = lg[0];
#pragma unroll
            for (int e = 1; e < 8; ++e) if (lg[e] > l0) { l0 = lg[e]; e0 = e; }
            int e1 = -1; float l1 = -3.0e38f;
#pragma unroll
            for (int e = 0; e < 8; ++e) if (e != e0 && lg[e] > l1) { l1 = lg[e]; e1 = e; }
            const float w1 = 1.0f / (1.0f + expf(l0 - l1)), w0 = 1.0f - w1;
            if (F.lane == 0) { sele[m] = (unsigned short)(e0 | (e1 << 8)); selw[m] = (f32x2){w0, w1}; }
        }
    }
}

#define MFMA16(x, y, c) __builtin_amdgcn_mfma_f32_16x16x32_bf16((x), (y), (c), 0, 0, 0)
__device__ __forceinline__ float softplusf_(float x) { return fmaxf(x, 0.f) + log1pf(expf(-fabsf(x))); }
typedef __attribute__((address_space(3))) bf16_t lbf;
constexpr int LDP = 72;
constexpr int SLOT = 64 * LDP * 2;
__device__ __forceinline__ f32x4 unpack4(u32x2 u) { return (f32x4){bf_lo(u.x), bf_hi(u.x), bf_lo(u.y), bf_hi(u.y)}; }
__device__ __forceinline__ u32x2 pack4(f32x4 v) { u32x2 o; o.x = pk2(v[0], v[1]); o.y = pk2(v[2], v[3]); return o; }
__device__ __forceinline__ void mm64(const lbf* X, const lbf* Y, int w, int jl, int g, f32x4 (&acc)[2]) {
    const lbf* xr = X + (16 * (w & 3) + jl) * LDP + 8 * g;
    const bf16x8 x0 = *(const LAS bf16x8*)xr, x1 = *(const LAS bf16x8*)(xr + 32);
#pragma unroll
    for (int i = 0; i < 2; ++i) { const lbf* yr = Y + (16 * (2 * (w >> 2) + i) + jl) * LDP + 8 * g;
        const bf16x8 y0 = *(const LAS bf16x8*)yr, y1 = *(const LAS bf16x8*)(yr + 32);
        acc[i] = MFMA16(x0, y0, acc[i]); acc[i] = MFMA16(x1, y1, acc[i]); }
}
__device__ __forceinline__ void st_t(lbf* dst, const f32x4 (&acc)[2], int w, int jl, int g) {
#pragma unroll
    for (int i = 0; i < 2; ++i) *(LAS u32x2*)(dst + (16 * (2 * (w >> 2) + i) + jl) * LDP + 16 * (w & 3) + 4 * g) = pack4(acc[i]);
}
__device__ __forceinline__ void st_n(lbf* dst, const f32x4 (&acc)[2], int w, int jl, int g) {
#pragma unroll
    for (int i = 0; i < 2; ++i)
#pragma unroll
        for (int r = 0; r < 4; ++r) dst[(16 * (w & 3) + 4 * g + r) * LDP + 16 * (2 * (w >> 2) + i) + jl] = f2bf(acc[i][r]);
}
#define ZACC(a) do { a[0] = (f32x4){0.f, 0.f, 0.f, 0.f}; a[1] = (f32x4){0.f, 0.f, 0.f, 0.f}; } while (0)

constexpr int XA_LD = 264, XV_LD = 520, VM_LD = 40;
__device__ __forceinline__ void ph_rwkv_prep(Frame& F, int l, int half) {
    lbf* XA = (lbf*)F.lds;
    lbf* XV = (lbf*)(F.lds + 64 * XA_LD * 2);
    lbf* VM = (lbf*)(F.lds + 64 * XA_LD * 2 + 64 * XV_LD * 2);
    const bf16_t* CA = (const bf16_t*)(F.ws + MX_CA);
    bf16_t* RW = (bf16_t*)(F.ws + MX_RW); constexpr size_t AS_ = (size_t)TH * 512;
    bf16_t* VF = (bf16_t*)(F.ws + WS_VFIRST) + (size_t)half * TH * 512;
    const bf16_t* W2T = (const bf16_t*)(F.ws + W_RW2); const bf16_t* A2T = (const bf16_t*)(F.ws + W_RA2); const bf16_t* G2T = (const bf16_t*)(F.ws + W_RG2);
    const bf16_t* V1T = (const bf16_t*)(F.ws + W_RV1); const bf16_t* V2T = (const bf16_t*)(F.ws + W_RV2);
    const float* mu = FIN(F, I_MU) + l * RW_COLS;
    const int lane = F.lane, w = F.wave, jl = lane & 15, g = lane >> 4;
    for (int tile = F.bid; tile < TH / 64; tile += F.G) {
        const int t0 = tile * 64;
        __syncthreads();
        for (int it = F.tid; it < 64 * 32; it += NTHR) { const int i = it >> 5, c = 1536 + (it & 31) * 8; const int t = t0 + i;
            const u32x4 cu = *(const u32x4*)(CA + (size_t)t * RW_COLS + c);
            u32x4 pv = (u32x4){0u, 0u, 0u, 0u}; if ((t & (SEQ - 1)) != 0) pv = *(const u32x4*)(CA + (size_t)(t - 1) * RW_COLS + c);
            const float cv[8] = { bf_lo(cu.x), bf_hi(cu.x), bf_lo(cu.y), bf_hi(cu.y), bf_lo(cu.z), bf_hi(cu.z), bf_lo(cu.w), bf_hi(cu.w) };
            const float pp[8] = { bf_lo(pv.x), bf_hi(pv.x), bf_lo(pv.y), bf_hi(pv.y), bf_lo(pv.z), bf_hi(pv.z), bf_lo(pv.w), bf_hi(pv.w) };
            float x[8];
#pragma unroll
            for (int q = 0; q < 8; ++q) { x[q] = cv[q] + (pp[q] - cv[q]) * mu[c + q]; if (c < 1600) x[q] = tanhf(x[q]); else if (c >= 1664) x[q] = sigmoidf_(x[q]); }
            u32x4 o; o.x = pk2(x[0], x[1]); o.y = pk2(x[2], x[3]); o.z = pk2(x[4], x[5]); o.w = pk2(x[6], x[7]);
            *(LAS u32x4*)(XA + i * XA_LD + (c - 1536)) = o; }
        if (l) for (int it = F.tid; it < 64 * 64; it += NTHR) { const int i = it >> 6, c = 1024 + (it & 63) * 8; const int t = t0 + i;
            const u32x4 cu = *(const u32x4*)(CA + (size_t)t * RW_COLS + c);
            u32x4 pv = (u32x4){0u, 0u, 0u, 0u}; if ((t & (SEQ - 1)) != 0) pv = *(const u32x4*)(CA + (size_t)(t - 1) * RW_COLS + c);
            const float cv[8] = { bf_lo(cu.x), bf_hi(cu.x), bf_lo(cu.y), bf_hi(cu.y), bf_lo(cu.z), bf_hi(cu.z), bf_lo(cu.w), bf_hi(cu.w) };
            const float pp[8] = { bf_lo(pv.x), bf_hi(pv.x), bf_lo(pv.y), bf_hi(pv.y), bf_lo(pv.z), bf_hi(pv.z), bf_lo(pv.w), bf_hi(pv.w) };
            float x[8];
#pragma unroll
            for (int q = 0; q < 8; ++q) x[q] = cv[q] + (pp[q] - cv[q]) * mu[c + q];
            u32x4 o; o.x = pk2(x[0], x[1]); o.y = pk2(x[2], x[3]); o.z = pk2(x[4], x[5]); o.w = pk2(x[6], x[7]);
            *(LAS u32x4*)(XV + i * XV_LD + (c - 1024)) = o; }
        __syncthreads();
        if (l) { const int tg = w & 3, nt = w >> 2; f32x4 a = (f32x4){0.f, 0.f, 0.f, 0.f};
            const bf16_t* xr = V1T + (size_t)(16 * nt + jl) * 512 + 8 * g; const lbf* yr = XV + (16 * tg + jl) * XV_LD + 8 * g;
#pragma unroll 4
            for (int s = 0; s < 16; ++s) a = MFMA16(*(const bf16x8*)(xr + 32 * s), *(const LAS bf16x8*)(yr + 32 * s), a);
            *(LAS u32x2*)(VM + (16 * tg + jl) * VM_LD + 16 * nt + 4 * g) = pack4(a); }
        __syncthreads();
#pragma unroll 1
        for (int tg = 0; tg < 4; ++tg) {
            const int tl = 16 * tg + jl, t = t0 + tl;
            const lbf* ya = XA + tl * XA_LD + 8 * g;
            f32x4 kkv[4]; float kss = 0.f;
#pragma unroll
            for (int nt = 0; nt < 4; ++nt) {
                const int n0 = 64 * w + 16 * nt;
                f32x4 aw = (f32x4){0.f, 0.f, 0.f, 0.f}, aa = aw, ag = aw, am = aw;
                { const bf16_t* xw = W2T + (size_t)(n0 + jl) * 64 + 8 * g; const bf16_t* xa = A2T + (size_t)(n0 + jl) * 64 + 8 * g; const bf16_t* xg = G2T + (size_t)(n0 + jl) * 128 + 8 * g;
#pragma unroll
                  for (int s = 0; s < 2; ++s) { aw = MFMA16(*(const bf16x8*)(xw + 32 * s), *(const LAS bf16x8*)(ya + 32 * s), aw); aa = MFMA16(*(const bf16x8*)(xa + 32 * s), *(const LAS bf16x8*)(ya + 64 + 32 * s), aa); }
#pragma unroll
                  for (int s = 0; s < 4; ++s) ag = MFMA16(*(const bf16x8*)(xg + 32 * s), *(const LAS bf16x8*)(ya + 128 + 32 * s), ag);
                  if (l) am = MFMA16(*(const bf16x8*)(V2T + (size_t)(n0 + jl) * 32 + 8 * g), *(const LAS bf16x8*)(VM + tl * VM_LD + 8 * g), am); }
                const int n = n0 + 4 * g;
                const bf16_t* crow = CA + (size_t)t * RW_COLS + n; const bool hp = (t & (SEQ - 1)) != 0;
                f32x4 rc = unpack4(*(const u32x2*)crow), kc = unpack4(*(const u32x2*)(crow + 512)), vc = unpack4(*(const u32x2*)(crow + 1024));
                f32x4 rp = (f32x4){0.f, 0.f, 0.f, 0.f}, kp = rp, vp = rp;
                if (hp) { rp = unpack4(*(const u32x2*)(crow - RW_COLS)); kp = unpack4(*(const u32x2*)(crow - RW_COLS + 512)); vp = unpack4(*(const u32x2*)(crow - RW_COLS + 1024)); }
                const f32x4 mr = *(const f32x4*)(mu + n), mk = *(const f32x4*)(mu + 512 + n), mv = *(const f32x4*)(mu + 1024 + n);
                const f32x4 r4 = rc + (rp - rc) * mr, k4 = kc + (kp - kc) * mk; f32x4 v4 = vc + (vp - vc) * mv;
                const f32x4 w0 = *(const f32x4*)(FIN(F, I_W0) + l * 512 + n), a0 = *(const f32x4*)(FIN(F, I_A0) + l * 512 + n), kkw = *(const f32x4*)(FIN(F, I_KK) + l * 512 + n), ka = *(const f32x4*)(FIN(F, I_KA) + l * 512 + n);
                const size_t o = (size_t)t * 512 + n;
                if (l) { const f32x4 v0 = *(const f32x4*)(FIN(F, I_V0) + (l - 1) * 512 + n); const f32x4 vf = unpack4(*(const u32x2*)(VF + o));
#pragma unroll
                    for (int q = 0; q < 4; ++q) v4[q] = v4[q] + (vf[q] - v4[q]) * sigmoidf_(v0[q] + am[q]); }
                else *(u32x2*)(VF + o) = pack4(v4);
                f32x4 e4, as4, k24;
#pragma unroll
                for (int q = 0; q < 4; ++q) { const float a = sigmoidf_(a0[q] + aa[q]); as4[q] = a; k24[q] = k4[q] * (1.0f + (a - 1.0f) * ka[q]);
                    e4[q] = expf(-softplusf_(-(w0[q] + aw[q])) - 0.5f); const float kk = k4[q] * kkw[q]; kkv[nt][q] = kk; kss += kk * kk; }
                *(u32x2*)(RW + 0 * AS_ + o) = pack4(r4); *(u32x2*)(RW + 1 * AS_ + o) = pack4(e4); *(u32x2*)(RW + 2 * AS_ + o) = pack4(k24); *(u32x2*)(RW + 3 * AS_ + o) = pack4(v4);
                *(u32x2*)(RW + 5 * AS_ + o) = pack4(as4); *(u32x2*)(RW + 6 * AS_ + o) = pack4(ag);
            }
            kss += __shfl_xor(kss, 16); kss += __shfl_xor(kss, 32);
            const float inv = 1.0f / fmaxf(sqrtf(kss), 1e-12f);
#pragma unroll
            for (int nt = 0; nt < 4; ++nt) *(u32x2*)(RW + 4 * AS_ + (size_t)t * 512 + 64 * w + 16 * nt + 4 * g) = pack4(kkv[nt] * inv);
        }
    }
}

__device__ __forceinline__ void ph_rwkv_s1(Frame& F) {
    bf16_t* RW = (bf16_t*)(F.ws + MX_RW); constexpr size_t AS_ = (size_t)TH * 512;
    bf16_t* YH = (bf16_t*)(F.ws + MX_CA);
    LAS unsigned char* L = F.lds;
#define SL(i) ((lbf*)(L + (i) * SLOT))
    lbf *AT = SL(0), *BT = SL(1), *KT = SL(2), *RT = SL(3), *ATt = SL(4), *Vt = SL(5), *BPt = SL(6), *KPt = SL(7), *AAK = SL(10), *ARB = SL(11), *ARK = SL(12);
    LAS float* EL = (LAS float*)(L + 8 * SLOT);
    LAS float* SEGT = (LAS float*)(L + 10 * SLOT);
    LAS float* PC = (LAS float*)(L + 16 * SLOT);
    const int lane = F.lane, w = F.wave, jl = lane & 15, g = lane >> 4;
    const int tok = F.tid >> 3, cg = F.tid & 7;
    for (int u = F.bid; u < (TH / 64) * 8; u += F.G) {
        const int h = u & 7, ch = u >> 3, t0 = ch * 64;
        const size_t tb = (size_t)(t0 + tok) * 512 + h * 64 + 8 * cg;
        const u32x4 ur = *(const u32x4*)(RW + 0 * AS_ + tb), ue = *(const u32x4*)(RW + 1 * AS_ + tb), uk = *(const u32x4*)(RW + 2 * AS_ + tb), uv = *(const u32x4*)(RW + 3 * AS_ + tb),
                    ukk = *(const u32x4*)(RW + 4 * AS_ + tb), uas = *(const u32x4*)(RW + 5 * AS_ + tb);
        const float e8[8] = { bf_lo(ue.x), bf_hi(ue.x), bf_lo(ue.y), bf_hi(ue.y), bf_lo(ue.z), bf_hi(ue.z), bf_lo(ue.w), bf_hi(ue.w) };
#pragma unroll
        for (int i = 0; i < 8; ++i) EL[tok * 65 + 8 * cg + i] = e8[i];
        __syncthreads();
        { const int col = F.tid & 63, seg = F.tid >> 6; float p[8]; float run = 0.f;
#pragma unroll
          for (int i = 0; i < 8; ++i) { run += EL[(8 * seg + i) * 65 + col]; p[i] = run; }
          SEGT[seg * 64 + col] = run;
          __syncthreads();
          float off = 0.f; for (int s = 0; s < seg; ++s) off += SEGT[s * 64 + col];
#pragma unroll
          for (int i = 0; i < 8; ++i) EL[(8 * seg + i) * 65 + col] = -(off + p[i]); }
        __syncthreads();
        {
            const float r8[8] = { bf_lo(ur.x), bf_hi(ur.x), bf_lo(ur.y), bf_hi(ur.y), bf_lo(ur.z), bf_hi(ur.z), bf_lo(ur.w), bf_hi(ur.w) };
            const float k8[8] = { bf_lo(uk.x), bf_hi(uk.x), bf_lo(uk.y), bf_hi(uk.y), bf_lo(uk.z), bf_hi(uk.z), bf_lo(uk.w), bf_hi(uk.w) };
            const float kk8[8] = { bf_lo(ukk.x), bf_hi(ukk.x), bf_lo(ukk.y), bf_hi(ukk.y), bf_lo(ukk.z), bf_hi(ukk.z), bf_lo(ukk.w), bf_hi(ukk.w) };
            const float as8[8] = { bf_lo(uas.x), bf_hi(uas.x), bf_lo(uas.y), bf_hi(uas.y), bf_lo(uas.z), bf_hi(uas.z), bf_lo(uas.w), bf_hi(uas.w) };
            const unsigned short v8[8] = { (unsigned short)(uv.x & 0xffffu), (unsigned short)(uv.x >> 16), (unsigned short)(uv.y & 0xffffu), (unsigned short)(uv.y >> 16),
                                           (unsigned short)(uv.z & 0xffffu), (unsigned short)(uv.z >> 16), (unsigned short)(uv.w & 0xffffu), (unsigned short)(uv.w >> 16) };
            float at[8], bt[8], kt[8], rt[8], bp[8], kp[8];
#pragma unroll
            for (int i = 0; i < 8; ++i) { const float cl = EL[tok * 65 + 8 * cg + i], pc = __expf(EL[63 * 65 + 8 * cg + i]);
                const float ecl = __expf(cl), eicl = __expf(-cl);
                at[i] = -kk8[i] * __expf(cl + e8[i]); bt[i] = kk8[i] * as8[i] * eicl; kt[i] = k8[i] * eicl; rt[i] = r8[i] * ecl; bp[i] = bt[i] * pc; kp[i] = kt[i] * pc;
                if (tok == 0) PC[8 * cg + i] = pc; }
            u32x4 o;
            o.x = pk2(at[0], at[1]); o.y = pk2(at[2], at[3]); o.z = pk2(at[4], at[5]); o.w = pk2(at[6], at[7]); *(LAS u32x4*)(AT + tok * LDP + 8 * cg) = o;
            o.x = pk2(bt[0], bt[1]); o.y = pk2(bt[2], bt[3]); o.z = pk2(bt[4], bt[5]); o.w = pk2(bt[6], bt[7]); *(LAS u32x4*)(BT + tok * LDP + 8 * cg) = o;
            o.x = pk2(kt[0], kt[1]); o.y = pk2(kt[2], kt[3]); o.z = pk2(kt[4], kt[5]); o.w = pk2(kt[6], kt[7]); *(LAS u32x4*)(KT + tok * LDP + 8 * cg) = o;
            o.x = pk2(rt[0], rt[1]); o.y = pk2(rt[2], rt[3]); o.z = pk2(rt[4], rt[5]); o.w = pk2(rt[6], rt[7]); *(LAS u32x4*)(RT + tok * LDP + 8 * cg) = o;
#pragma unroll
            for (int i = 0; i < 8; ++i) { const int c = 8 * cg + i; ATt[c * LDP + tok] = f2bf(at[i]); Vt[c * LDP + tok] = v8[i]; BPt[c * LDP + tok] = f2bf(bp[i]); KPt[c * LDP + tok] = f2bf(kp[i]); }
        }
        __syncthreads();
        {
            f32x4 a[2];
            const int s0 = 16 * (w & 3) + 4 * g;
            ZACC(a); mm64(BT, AT, w, jl, g, a);
#pragma unroll
            for (int i = 0; i < 2; ++i) { const int t = 16 * (2 * (w >> 2) + i) + jl;
#pragma unroll
                for (int r = 0; r < 4; ++r) if (!(s0 + r < t)) a[i][r] = 0.f; }
            st_t(SL(8), a, w, jl, g); st_n(SL(9), a, w, jl, g);
            { f32x4 b[2] = { a[0], a[1] };
#pragma unroll
              for (int i = 0; i < 2; ++i) { const int t = 16 * (2 * (w >> 2) + i) + jl;
#pragma unroll
                  for (int r = 0; r < 4; ++r) if (s0 + r == t) b[i][r] = 1.0f; }
              st_t(SL(13), b, w, jl, g); st_n(SL(14), b, w, jl, g); }
            ZACC(a); mm64(KT, AT, w, jl, g, a);
#pragma unroll
            for (int i = 0; i < 2; ++i) { const int t = 16 * (2 * (w >> 2) + i) + jl;
#pragma unroll
                for (int r = 0; r < 4; ++r) if (!(s0 + r < t)) a[i][r] = 0.f; }
            st_t(AAK, a, w, jl, g);
            ZACC(a); mm64(BT, RT, w, jl, g, a);
#pragma unroll
            for (int i = 0; i < 2; ++i) { const int t = 16 * (2 * (w >> 2) + i) + jl;
#pragma unroll
                for (int r = 0; r < 4; ++r) if (!(s0 + r <= t)) a[i][r] = 0.f; }
            st_t(ARB, a, w, jl, g);
            ZACC(a); mm64(KT, RT, w, jl, g, a);
#pragma unroll
            for (int i = 0; i < 2; ++i) { const int t = 16 * (2 * (w >> 2) + i) + jl;
#pragma unroll
                for (int r = 0; r < 4; ++r) if (!(s0 + r <= t)) a[i][r] = 0.f; }
            st_t(ARK, a, w, jl, g);
        }
        __syncthreads();
#define NEU_B(srcB, srcBt, dstB, dstBt) do { f32x4 a[2]; ZACC(a); mm64(SL(srcB), SL(srcBt), w, jl, g, a); st_t(SL(dstBt), a, w, jl, g); st_n(SL(dstB), a, w, jl, g); } while (0)
#define NEU_T(srcT, srcTt, srcBt, dstT, dstTt, last) do { f32x4 a[2]; \
            _Pragma("unroll") for (int i = 0; i < 2; ++i) a[i] = unpack4(*(const LAS u32x2*)(SL(srcTt) + (16 * (2 * (w >> 2) + i) + jl) * LDP + 16 * (w & 3) + 4 * g)); \
            mm64(SL(srcT), SL(srcBt), w, jl, g, a); if (!(last)) st_t(SL(dstTt), a, w, jl, g); st_n(SL(dstT), a, w, jl, g); } while (0)
        NEU_B(8, 9, 0, 1);                                   __syncthreads();
        NEU_T(13, 14, 1, 15, 2, false); NEU_B(0, 1, 8, 9);   __syncthreads();
        NEU_T(15, 2, 9, 13, 14, false); NEU_B(8, 9, 0, 1);   __syncthreads();
        NEU_T(13, 14, 1, 15, 2, false); NEU_B(0, 1, 8, 9);   __syncthreads();
        NEU_T(15, 2, 9, 13, 14, false); NEU_B(8, 9, 0, 1);   __syncthreads();
        NEU_T(13, 14, 1, 15, 2, true);                       __syncthreads();
        lbf* TI = SL(15); lbf* Wt = SL(8); lbf* Xt = SL(9); lbf* Ut = SL(0);
        { f32x4 a[2]; ZACC(a); mm64(TI, ATt, w, jl, g, a); st_t(Wt, a, w, jl, g);
          ZACC(a); mm64(AAK, Vt, w, jl, g, a); st_t(Xt, a, w, jl, g); }
        __syncthreads();
        {
            f32x4 a[2];
            ZACC(a); mm64(TI, Xt, w, jl, g, a); st_t(Ut, a, w, jl, g);
            ZACC(a); mm64(Wt, ARB, w, jl, g, a);
#pragma unroll
            for (int i = 0; i < 2; ++i) { const int t = 16 * (2 * (w >> 2) + i) + jl, k0 = 16 * (w & 3) + 4 * g;
                const f32x4 rr = unpack4(*(const LAS u32x2*)(RT + t * LDP + k0));
                *(u32x2*)(RW + 5 * AS_ + (size_t)(t0 + t) * 512 + h * 64 + k0) = pack4(a[i] + rr); }
            ZACC(a); mm64(Wt, BPt, w, jl, g, a);
#pragma unroll
            for (int i = 0; i < 2; ++i) { const int k = 16 * (2 * (w >> 2) + i) + jl, kp0 = 16 * (w & 3) + 4 * g; const float pc = PC[k];
#pragma unroll
                for (int r = 0; r < 4; ++r) if (kp0 + r == k) a[i][r] += pc;
                *(u32x2*)(RW + 4 * AS_ + (size_t)(t0 + k) * 512 + h * 64 + kp0) = pack4(a[i]); }
        }
        __syncthreads();
        {
            f32x4 a[2];
            ZACC(a); mm64(Ut, ARB, w, jl, g, a); mm64(Vt, ARK, w, jl, g, a);
#pragma unroll
            for (int i = 0; i < 2; ++i) { const int t = 16 * (2 * (w >> 2) + i) + jl, v0 = 16 * (w & 3) + 4 * g;
                *(u32x2*)(YH + (size_t)(t0 + t) * 512 + h * 64 + v0) = pack4(a[i]); }
            ZACC(a); mm64(BPt, Ut, w, jl, g, a); mm64(KPt, Vt, w, jl, g, a);
#pragma unroll
            for (int i = 0; i < 2; ++i) { const int v = 16 * (2 * (w >> 2) + i) + jl, k0 = 16 * (w & 3) + 4 * g;
                *(u32x2*)(RW + 1 * AS_ + (size_t)(t0 + v) * 512 + h * 64 + k0) = pack4(a[i]); }
        }
    }
#undef SL
#undef NEU_B
#undef NEU_T
}

__device__ __forceinline__ void ph_rwkv_s2(Frame& F, int l, int pair) {
    const int bl = pair >> 3, h = pair & 7;
    const bf16_t* RW = (const bf16_t*)(F.ws + MX_RW); constexpr size_t AS_ = (size_t)TH * 512;
    const bf16_t* YH = (const bf16_t*)(F.ws + MX_CA); bf16_t* YA = (bf16_t*)(F.ws + MX_CA) + AS_;
    lbf* HT = (lbf*)F.lds;
    const int lane = F.lane, w = F.wave, jl = lane & 15, g = lane >> 4;
    __syncthreads();
    for (int i = F.tid; i < 64 * LDP / 2; i += NTHR) ((LAS unsigned*)HT)[i] = 0u;
    __syncthreads();
    if (w < 4) {
        for (int c = 0; c < SEQ / 64; ++c) {
            const size_t rb = (size_t)(bl * SEQ + c * 64) * 512 + h * 64;
            const bf16_t* mrow = RW + 4 * AS_ + rb + (size_t)(16 * w + jl) * 512 + 8 * g;
            const bf16x8 m0 = *(const bf16x8*)mrow, m1 = *(const bf16x8*)(mrow + 32);
            f32x4 a[4];
#pragma unroll
            for (int yt = 0; yt < 4; ++yt) a[yt] = unpack4(*(const u32x2*)(RW + 1 * AS_ + rb + (size_t)(16 * yt + jl) * 512 + 16 * w + 4 * g));
#pragma unroll
            for (int yt = 0; yt < 4; ++yt) { const lbf* yr = HT + (16 * yt + jl) * LDP + 8 * g;
                a[yt] = MFMA16(m0, *(const LAS bf16x8*)yr, a[yt]); a[yt] = MFMA16(m1, *(const LAS bf16x8*)(yr + 32), a[yt]); }
            __syncthreads();
#pragma unroll
            for (int yt = 0; yt < 4; ++yt) *(LAS u32x2*)(HT + (16 * yt + jl) * LDP + 16 * w + 4 * g) = pack4(a[yt]);
            __syncthreads();
        }
    } else {
        const int wt = w - 4;
        f32x4 rk[4], lg[4], lb[4];
#pragma unroll
        for (int xt = 0; xt < 4; ++xt) { const int v0 = h * 64 + 16 * xt + 4 * g; rk[xt] = *(const f32x4*)(FIN(F, I_RK) + l * 512 + v0); lg[xt] = *(const f32x4*)(FIN(F, I_LNG) + l * 512 + v0); lb[xt] = *(const f32x4*)(FIN(F, I_LNB) + l * 512 + v0); }
        for (int c = 0; c < SEQ / 64; ++c) {
            const size_t rb = (size_t)(bl * SEQ + c * 64 + 16 * wt + jl) * 512 + h * 64;
            const bf16x8 r0 = *(const bf16x8*)(RW + 5 * AS_ + rb + 8 * g), r1 = *(const bf16x8*)(RW + 5 * AS_ + rb + 32 + 8 * g);
            f32x4 a[4];
#pragma unroll
            for (int xt = 0; xt < 4; ++xt) a[xt] = unpack4(*(const u32x2*)(YH + rb + 16 * xt + 4 * g));
#pragma unroll
            for (int xt = 0; xt < 4; ++xt) { const lbf* xr = HT + (16 * xt + jl) * LDP + 8 * g;
                a[xt] = MFMA16(*(const LAS bf16x8*)xr, r0, a[xt]); a[xt] = MFMA16(*(const LAS bf16x8*)(xr + 32), r1, a[xt]); }
            __syncthreads();
            float s = 0.f, bs = 0.f; f32x4 vv[4], gg[4];
#pragma unroll
            for (int xt = 0; xt < 4; ++xt) { const f32x4 rr = unpack4(*(const u32x2*)(RW + 0 * AS_ + rb + 16 * xt + 4 * g)), kk = unpack4(*(const u32x2*)(RW + 2 * AS_ + rb + 16 * xt + 4 * g));
                vv[xt] = unpack4(*(const u32x2*)(RW + 3 * AS_ + rb + 16 * xt + 4 * g)); gg[xt] = unpack4(*(const u32x2*)(RW + 6 * AS_ + rb + 16 * xt + 4 * g));
#pragma unroll
                for (int r = 0; r < 4; ++r) { s += a[xt][r]; bs += rr[r] * kk[r] * rk[xt][r]; } }
            s += __shfl_xor(s, 16); s += __shfl_xor(s, 32); bs += __shfl_xor(bs, 16); bs += __shfl_xor(bs, 32);
            const float mean = s * (1.f / 64.f); float q = 0.f;
#pragma unroll
            for (int xt = 0; xt < 4; ++xt)
#pragma unroll
                for (int r = 0; r < 4; ++r) { const float d = a[xt][r] - mean; q += d * d; }
            q += __shfl_xor(q, 16); q += __shfl_xor(q, 32);
            const float rstd = 1.0f / sqrtf(q * (1.f / 64.f) + 64e-5f);
#pragma unroll
            for (int xt = 0; xt < 4; ++xt) { f32x4 o;
#pragma unroll
                for (int r = 0; r < 4; ++r) o[r] = ((a[xt][r] - mean) * rstd * lg[xt][r] + lb[xt][r] + bs * vv[xt][r]) * gg[xt][r];
                *(u32x2*)(YA + rb + 16 * xt + 4 * g) = pack4(o); }
            __syncthreads();
        }
    }
}

__device__ __forceinline__ float rope_vec(float x, float cs, float sn, int lane) {
    const float p = __shfl_xor(x, 32);
    return lane < 32 ? x * cs - p * sn : x * cs + p * sn;
}
__device__ __forceinline__ void ph_dsa_prep(Frame& F, int l, int half) {
    bf16_t* CB = (bf16_t*)(F.ws + MX_CB); bf16_t* VT = (bf16_t*)(F.ws + MX_VT);
    const int* pos = (const int*)KARGP(F, I_POS) + (size_t)half * TH;
    const int d = F.lane, w = F.wave;
    const float invf = 1.0f / powf(10000.0f, (float)(2 * (d & 31)) / 64.0f);
    const float gq = FIN(F, I_QN)[l * 64 + d], gk = FIN(F, I_KN)[l * 64 + d], gik = FIN(F, I_IKN)[l * 64 + d];
    for (int t = F.bid; t < TH; t += F.G) {
        const float ang = (float)pos[t] * invf; float sn, cs; sincosf(ang, &sn, &cs);
        bf16_t* row = CB + (size_t)t * DS_PAD;
        { float x = bf2f(row[w * 64 + d]); const float rstd = 1.0f / sqrtf(wave_sum(x * x) * (1.f / 64.f) + 1e-6f); x = x * rstd * gq; row[w * 64 + d] = f2bf(rope_vec(x, cs, sn, d)); }
        { const float x = bf2f(row[640 + w * 64 + d]); row[640 + w * 64 + d] = f2bf(rope_vec(x, cs, sn, d)); }
        if (w == 0) { float x = bf2f(row[512 + d]); const float rstd = 1.0f / sqrtf(wave_sum(x * x) * (1.f / 64.f) + 1e-6f); x = x * rstd * gk; row[512 + d] = f2bf(rope_vec(x, cs, sn, d)); }
        if (w == 1) { float x = bf2f(row[1152 + d]); const float rstd = 1.0f / sqrtf(wave_sum(x * x) * (1.f / 64.f) + 1e-6f); x = x * rstd * gik; row[1152 + d] = f2bf(rope_vec(x, cs, sn, d)); }
        if (w == 2) { VT[((size_t)(t >> 11) * 64 + d) * SEQ + (t & (SEQ - 1))] = row[576 + d]; }
    }
}

constexpr int SC_LD = 2052;
__device__ __forceinline__ void lds_inc(LAS unsigned* p) { (void)__hip_atomic_fetch_add(p, 1u, __ATOMIC_RELAXED, __HIP_MEMORY_SCOPE_WORKGROUP); }
__device__ __forceinline__ unsigned okey(float s) { const unsigned u = __builtin_bit_cast(unsigned, s); return (u & 0x80000000u) ? ~u : (u | 0x80000000u); }
__device__ __forceinline__ int hist_find(LAS unsigned* hist, int lane, int& R) {
    const u32x4 c4 = *(const LAS u32x4*)(hist + 4 * lane);
    const unsigned tot = c4.x + c4.y + c4.z + c4.w;
    unsigned suf = tot;
#pragma unroll
    for (int o = 1; o < 64; o <<= 1) { const unsigned v = __shfl_down(suf, o); if (lane + o < 64) suf += v; }
    const unsigned above = suf - tot;
    const bool mine = (above < (unsigned)R) && ((unsigned)R <= suf);
    const unsigned long long bal = __ballot(mine);
    const int src = bal ? (int)__builtin_ctzll(bal) : 0;
    int bin = 0, rr = 1;
    { unsigned a = above; int b = 4 * lane + 3; int r_ = R;
      if ((unsigned)r_ <= a + c4.w) { b = 4 * lane + 3; r_ -= a; } else { a += c4.w;
      if ((unsigned)r_ <= a + c4.z) { b = 4 * lane + 2; r_ -= a; } else { a += c4.z;
      if ((unsigned)r_ <= a + c4.y) { b = 4 * lane + 1; r_ -= a; } else { a += c4.y; b = 4 * lane; r_ -= a; } } }
      bin = b; rr = r_; }
    bin = __shfl(bin, src); rr = __shfl(rr, src);
    R = rr; return bin;
}
__device__ __forceinline__ void ph_dsa(Frame& F, int half, int first, int stride) {
    const bf16_t* CB = (const bf16_t*)(F.ws + MX_CB); const bf16_t* VT = (const bf16_t*)(F.ws + MX_VT);
    bf16_t* YB = (bf16_t*)(F.ws + MX_YB);
    LAS float* sc = (LAS float*)F.lds;
    LAS unsigned* hist = (LAS unsigned*)(F.lds + 16 * SC_LD * 4);
    LAS unsigned* msk = (LAS unsigned*)(F.lds + 16 * SC_LD * 4 + 16 * 256 * 4);
    const int lane = F.lane, w = F.wave, jl = lane & 15, g = lane >> 4;
    for (int u = first; u < TH / 16; u += stride) {
        const int bl = u >> 7, q0 = (u & 127) * 16, L = ((q0 >> 6) + 1) * 64;
        const int rowb = bl * SEQ;
        __syncthreads();
        for (int i = F.tid; i < 16 * 256; i += NTHR) hist[i] = 0u;
        __syncthreads();
        {
            bf16x8 yq[8][2]; float iw[8];
            const bf16_t* qrow = CB + (size_t)(rowb + q0 + jl) * DS_PAD;
#pragma unroll
            for (int h = 0; h < 8; ++h) { iw[h] = bf2f(qrow[1216 + h]);
#pragma unroll
                for (int s = 0; s < 2; ++s) yq[h][s] = *(const bf16x8*)(qrow + 640 + h * 64 + 32 * s + 8 * g); }
            for (int kt = w; kt < L / 16; kt += 8) {
                const bf16_t* krow = CB + (size_t)(rowb + kt * 16 + jl) * DS_PAD + 1152;
                const bf16x8 x0 = *(const bf16x8*)(krow + 8 * g), x1 = *(const bf16x8*)(krow + 32 + 8 * g);
                f32x4 s4 = (f32x4){0.f, 0.f, 0.f, 0.f};
#pragma unroll
                for (int h = 0; h < 8; ++h) { f32x4 a = (f32x4){0.f, 0.f, 0.f, 0.f}; a = MFMA16(x0, yq[h][0], a); a = MFMA16(x1, yq[h][1], a);
#pragma unroll
                    for (int r = 0; r < 4; ++r) s4[r] += iw[h] * fmaxf(a[r], 0.f); }
                *(LAS f32x4*)(sc + jl * SC_LD + kt * 16 + 4 * g) = s4;
                if (L > 256) {
#pragma unroll
                    for (int r = 0; r < 4; ++r) lds_inc(hist + jl * 256 + (okey(s4[r]) >> 24)); }
            }
        }
        __syncthreads();
        for (int qi = 0; qi < 2; ++qi) {
            const int qq = 2 * w + qi; LAS unsigned* hq = hist + qq * 256; const LAS float* sq = sc + qq * SC_LD; LAS unsigned* mq = msk + qq * 64;
            if (L <= 256) { if (lane < 64) mq[lane] = (lane < L / 32) ? 0xffffffffu : 0u; }
            else {
                int R = 256; unsigned prefix = 0u;
                const int b1 = hist_find(hq, lane, R); prefix = (unsigned)b1;
#pragma unroll 1
                for (int pass = 1; pass < 4; ++pass) {
                    const int sh = 24 - 8 * pass;
                    asm volatile("" ::: "memory");
                    *(LAS u32x4*)(hq + 4 * lane) = (u32x4){0u, 0u, 0u, 0u};
                    LDS_WAIT(); asm volatile("" ::: "memory");
                    for (int i = lane; i < L; i += 64) { const unsigned k = okey(sq[i]); if ((k >> (sh + 8)) == prefix) lds_inc(hq + ((k >> sh) & 255u)); }
                    LDS_WAIT(); asm volatile("" ::: "memory");
                    const int b = hist_find(hq, lane, R); prefix = (prefix << 8) | (unsigned)b;
                }
                const unsigned thr = prefix; int taken = 0;
                for (int base = 0; base < SEQ; base += 64) {
                    bool take = false; bool eq = false;
                    if (base < L) { const unsigned k = okey(sq[base + lane]); take = k > thr; eq = (k == thr); }
                    const unsigned long long em = __ballot(eq);
                    const int myr = taken + __popcll(em & ((1ull << lane) - 1ull));
                    take = take || (eq && myr < R);
                    taken += __popcll(em);
                    const unsigned long long tm = __ballot(take);
                    if (lane == 0) { mq[base / 32] = (unsigned)tm; mq[base / 32 + 1] = (unsigned)(tm >> 32); }
                }
            }
        }
        __syncthreads();
        {
            const int qloc = 2 * w + (jl >> 3), hd = jl & 7;
            const bf16_t* qrow = CB + (size_t)(rowb + q0 + qloc) * DS_PAD + hd * 64;
            const bf16x8 yq0 = *(const bf16x8*)(qrow + 8 * g), yq1 = *(const bf16x8*)(qrow + 32 + 8 * g);
            f32x4 O[4];
#pragma unroll
            for (int dt = 0; dt < 4; ++dt) O[dt] = (f32x4){0.f, 0.f, 0.f, 0.f};
            float mrun = -1e30f, lsum = 0.f;
            const bf16_t* vtb = VT + (size_t)bl * 64 * SEQ;
            const LAS unsigned* mq = msk + qloc * 64;
            for (int kb = 0; kb < L; kb += 32) {
                f32x4 s[2];
#pragma unroll
                for (int tl = 0; tl < 2; ++tl) { const bf16_t* krow = CB + (size_t)(rowb + kb + 16 * tl + jl) * DS_PAD + 512;
                    const bf16x8 x0 = *(const bf16x8*)(krow + 8 * g), x1 = *(const bf16x8*)(krow + 32 + 8 * g);
                    f32x4 a = (f32x4){0.f, 0.f, 0.f, 0.f}; a = MFMA16(x0, yq0, a); a = MFMA16(x1, yq1, a); s[tl] = a; }
                const unsigned mw = mq[kb >> 5];
                bool bit[8]; float mx = -1e30f;
#pragma unroll
                for (int tl = 0; tl < 2; ++tl)
#pragma unroll
                    for (int r = 0; r < 4; ++r) { bit[4 * tl + r] = (mw >> (16 * tl + 4 * g + r)) & 1u; s[tl][r] *= 0.125f; if (bit[4 * tl + r]) mx = fmaxf(mx, s[tl][r]); }
                mx = fmaxf(mx, __shfl_xor(mx, 16)); mx = fmaxf(mx, __shfl_xor(mx, 32));
                const float mnew = fmaxf(mrun, mx); const float alpha = __expf(mrun - mnew); mrun = mnew;
                float p[8]; float ps = 0.f;
#pragma unroll
                for (int i = 0; i < 8; ++i) { p[i] = bit[i] ? __expf(s[i >> 2][i & 3] - mnew) : 0.f; ps += p[i]; }
                lsum = lsum * alpha + ps;
                u32x4 pw; pw.x = pk2(p[0], p[1]); pw.y = pk2(p[2], p[3]); pw.z = pk2(p[4], p[5]); pw.w = pk2(p[6], p[7]);
                const bf16x8 pf = __builtin_bit_cast(bf16x8, pw);
#pragma unroll
                for (int dt = 0; dt < 4; ++dt) { const bf16_t* vr = vtb + (size_t)(16 * dt + jl) * SEQ + kb + 4 * g;
                    const u32x2 lo = *(const u32x2*)vr, hi = *(const u32x2*)(vr + 16);
                    const bf16x8 xv = __builtin_bit_cast(bf16x8, (u32x4){lo.x, lo.y, hi.x, hi.y});
                    O[dt] = O[dt] * alpha; O[dt] = MFMA16(xv, pf, O[dt]); }
            }
            lsum += __shfl_xor(lsum, 16); lsum += __shfl_xor(lsum, 32);
            const float inv = 1.0f / lsum;
            bf16_t* orow = YB + (size_t)(rowb + q0 + qloc) * 512 + hd * 64;
#pragma unroll
            for (int dt = 0; dt < 4; ++dt) { u32x2 o; o.x = pk2(O[dt][0] * inv, O[dt][1] * inv); o.y = pk2(O[dt][2] * inv, O[dt][3] * inv); *(u32x2*)(orow + 16 * dt + 4 * g) = o; }
        }
    }
}

__device__ __forceinline__ void ph_mem_attn(Frame& F, int l) {
    const bf16_t* QM = (const bf16_t*)(F.ws + MA_QM); bf16_t* OM = (bf16_t*)(F.ws + MA_OM);
    const bf16_t* MK = (const bf16_t*)(F.ws + WS_MEMK) + (size_t)l * MEMROWS * 512; const bf16_t* MVT = (const bf16_t*)(F.ws + WS_MEMVT) + (size_t)l * MEMROWS * 512;
    const int lane = F.lane, jl = lane & 15, g = lane >> 4;
    const float* gq = FIN(F, I_MQN) + l * 128;
    for (int it = F.bid; it < NB * 4 * 16; it += F.G) {
        const int b = it >> 6, hh = (it >> 4) & 3, sp = it & 15;
        const int t = b * SEQ + sp * 128 + F.wave * 16 + jl;
        const bf16_t* qrow = QM + (size_t)t * 512 + hh * 128;
        float qv[4][8]; float ss = 0.f;
#pragma unroll
        for (int s = 0; s < 4; ++s) { const u32x4 q = *(const u32x4*)(qrow + 32 * s + 8 * g);
            qv[s][0] = bf_lo(q.x); qv[s][1] = bf_hi(q.x); qv[s][2] = bf_lo(q.y); qv[s][3] = bf_hi(q.y); qv[s][4] = bf_lo(q.z); qv[s][5] = bf_hi(q.z); qv[s][6] = bf_lo(q.w); qv[s][7] = bf_hi(q.w);
#pragma unroll
            for (int i = 0; i < 8; ++i) ss += qv[s][i] * qv[s][i]; }
        ss += __shfl_xor(ss, 16); ss += __shfl_xor(ss, 32);
        const float sc = (1.0f / sqrtf(ss * (1.f / 128.f) + 1e-6f)) * 0.08838834764831845f;
        bf16x8 yq[4];
#pragma unroll
        for (int s = 0; s < 4; ++s) { const float* gp = gq + 32 * s + 8 * g; u32x4 pw;
            pw.x = pk2(qv[s][0] * sc * gp[0], qv[s][1] * sc * gp[1]); pw.y = pk2(qv[s][2] * sc * gp[2], qv[s][3] * sc * gp[3]);
            pw.z = pk2(qv[s][4] * sc * gp[4], qv[s][5] * sc * gp[5]); pw.w = pk2(qv[s][6] * sc * gp[6], qv[s][7] * sc * gp[7]); yq[s] = __builtin_bit_cast(bf16x8, pw); }
        const bf16_t* kb_ = MK + ((size_t)b * 4 + hh) * 256 * 128; const bf16_t* vb_ = MVT + ((size_t)b * 4 + hh) * 128 * 256;
        f32x4 S[16];
#pragma unroll
        for (int kt = 0; kt < 16; ++kt) { const bf16_t* kr = kb_ + (size_t)(16 * kt + jl) * 128 + 8 * g; f32x4 a = (f32x4){0.f, 0.f, 0.f, 0.f};
#pragma unroll
            for (int s = 0; s < 4; ++s) a = MFMA16(*(const bf16x8*)(kr + 32 * s), yq[s], a);
            S[kt] = a; }
        float mx = -1e30f;
#pragma unroll
        for (int kt = 0; kt < 16; ++kt)
#pragma unroll
            for (int r = 0; r < 4; ++r) mx = fmaxf(mx, S[kt][r]);
        mx = fmaxf(mx, __shfl_xor(mx, 16)); mx = fmaxf(mx, __shfl_xor(mx, 32));
        float ls = 0.f; bf16x8 pf[8];
#pragma unroll
        for (int ks = 0; ks < 8; ++ks) { float p[8];
#pragma unroll
            for (int i = 0; i < 8; ++i) { p[i] = __expf(S[2 * ks + (i >> 2)][i & 3] - mx); ls += p[i]; }
            u32x4 pw; pw.x = pk2(p[0], p[1]); pw.y = pk2(p[2], p[3]); pw.z = pk2(p[4], p[5]); pw.w = pk2(p[6], p[7]); pf[ks] = __builtin_bit_cast(bf16x8, pw); }
        ls += __shfl_xor(ls, 16); ls += __shfl_xor(ls, 32);
        const float inv = 1.0f / ls;
        bf16_t* orow = OM + (size_t)t * 512 + hh * 128;
#pragma unroll
        for (int dt = 0; dt < 8; ++dt) { f32x4 o = (f32x4){0.f, 0.f, 0.f, 0.f}; const bf16_t* vr = vb_ + (size_t)(16 * dt + jl) * 256 + 4 * g;
#pragma unroll
            for (int ks = 0; ks < 8; ++ks) { const u32x2 lo = *(const u32x2*)(vr + 32 * ks), hi = *(const u32x2*)(vr + 32 * ks + 16);
                o = MFMA16(__builtin_bit_cast(bf16x8, (u32x4){lo.x, lo.y, hi.x, hi.y}), pf[ks], o); }
            u32x2 ov; ov.x = pk2(o[0] * inv, o[1] * inv); ov.y = pk2(o[2] * inv, o[3] * inv); *(u32x2*)(orow + 16 * dt + 4 * g) = ov; }
    }
}

__device__ __forceinline__ void ph_moe_route(Frame& F) {
    const unsigned short* sele = (const unsigned short*)(F.ws + MOE_SELE); const f32x2* selw = (const f32x2*)(F.ws + MOE_SELW);
    int* rowtok = (int*)(F.ws + MOE_ROWTOK); float* roww = (float*)(F.ws + MOE_ROWW); int* tile_e = (int*)(F.ws + MOE_TILEE); int* meta = (int*)(F.ws + MOE_META);
    LAS unsigned long long* pc = (LAS unsigned long long*)F.lds;
    LAS int* tot = (LAS int*)(F.lds + 8192);
    LAS int* pre = tot + 16; LAS int* segb = tot + 32; LAS int* wcnt = tot + 64;
    __syncthreads();
    { unsigned long long c0 = 0ull, c1 = 0ull; const u32x4* sp = (const u32x4*)(sele + (size_t)F.tid * 128);
      for (int i = 0; i < 16; ++i) { const u32x4 v = sp[i]; const unsigned ww[4] = {v.x, v.y, v.z, v.w};
#pragma unroll
        for (int q = 0; q < 4; ++q) { const unsigned a = ww[q] & 0xffffu, b = ww[q] >> 16;
            c0 += 1ull << (8 * (a & 7u)); c1 += 1ull << (8 * ((a >> 8) & 7u)); c0 += 1ull << (8 * (b & 7u)); c1 += 1ull << (8 * ((b >> 8) & 7u)); } }
      pc[F.tid * 2] = c0; pc[F.tid * 2 + 1] = c1; }
    __syncthreads();
    if (F.tid < 32) { const int seg = F.tid & 15, kind = F.tid >> 4; const int slot = seg >> 3, e = seg & 7; const int lim = kind ? 2 * F.bid : 512; int s = 0;
        for (int i = 0; i < lim; ++i) s += (int)((pc[i * 2 + slot] >> (8 * e)) & 0xffull);
        if (kind) pre[seg] = s; else tot[seg] = s; }
    __syncthreads();
    if (F.tid == 0) { int b = 0; for (int s = 0; s < 16; ++s) { segb[s] = b; b += (tot[s] + 255) & ~255; } segb[16] = b; }
    __syncthreads();
    const int t = F.bid * 256 + (F.tid & 255); const unsigned se = sele[t]; const f32x2 sw = selw[t];
    const int myseg[2] = { (int)(se & 7u), 8 + (int)((se >> 8) & 7u) };
    int rank[2] = {0, 0};
    if (F.tid < 256) {
#pragma unroll
        for (int s = 0; s < 16; ++s) { const int k = s >> 3; const unsigned long long m = __ballot(myseg[k] == s);
            if (myseg[k] == s) rank[k] = __popcll(m & ((1ull << F.lane) - 1ull));
            if (F.lane == 0) wcnt[F.wave * 16 + s] = __popcll(m); }
    }
    __syncthreads();
    if (F.tid < 256) {
#pragma unroll
        for (int k = 0; k < 2; ++k) { const int s = myseg[k]; int off = 0; for (int ww = 0; ww < F.wave; ++ww) off += wcnt[ww * 16 + s];
            const int row = segb[s] + pre[s] + off + rank[k]; rowtok[row] = t; roww[row] = k ? sw.y : sw.x; }
    }
    if (F.bid == 0) {
        for (int s = 0; s < 16; ++s) { const int lo = segb[s] + tot[s], hi = segb[s + 1]; for (int r = lo + F.tid; r < hi; r += NTHR) { rowtok[r] = -1; roww[r] = 0.f; } }
        for (int p = F.tid; p < segb[16] / 256; p += NTHR) { int e = 0; for (int s = 0; s < 16; ++s) if (p * 256 >= segb[s]) e = s & 7; tile_e[p] = e; }
        if (F.tid == 0) { meta[0] = segb[8] / 256; meta[1] = segb[16] / 256; }
    }
}

__global__ void __launch_bounds__(NTHR, 2) fwd(Args args) {
    extern __shared__ __attribute__((aligned(16))) unsigned char lds_raw[];
    Frame F;
    F.lds = (LAS unsigned char*)lds_raw; F.ws = args.ws; F.kb = __builtin_amdgcn_kernarg_segment_ptr(); F.out = args.out;
    F.tid = threadIdx.x; F.lane = F.tid & 63; F.wave = __builtin_amdgcn_readfirstlane(F.tid >> 6); F.G = gridDim.x; F.bid = blockIdx.x;
    volatile LAS unsigned* MISC = (volatile LAS unsigned*)(F.lds + LDS_MISC);
    if (F.tid < 64) MISC[F.tid] = 0u;
    __syncthreads();
    const int lo = args.ph_lo, hi = args.ph_hi;
    XcdBarrier bar; bar.bar = (unsigned*)(F.ws + WS_CTL) + 4096; bar.x = 0; bar.st = nullptr;
    if (hi - lo > 1) bar = xcd_barrier_post((unsigned*)(F.ws + WS_CTL) + 4096, MISC + 8);
    int ph = 0;
#ifndef SITE_MASK
#define SITE_MASK 0xffffffffffffffffull
#endif
#ifndef REP_SITE
#define REP_SITE -1
#endif
#ifndef REP_N
#define REP_N 2
#endif
#define PHASE_BEGIN if (((SITE_MASK >> __COUNTER__) & 1ull) && ph >= lo && ph < hi) { for (int rep_ = 0; rep_ < (((__COUNTER__ - 1) / 2 == REP_SITE) ? REP_N : 1); ++rep_) { { int _t = threadIdx.x; asm volatile("" : "+v"(_t)); F.tid = _t; F.lane = _t & 63; F.wave = __builtin_amdgcn_readfirstlane(_t >> 6); \
      kptr_t _kb = __builtin_amdgcn_kernarg_segment_ptr(); asm volatile("" : "+s"(_kb)); F.kb = _kb; \
      unsigned char* _w = args.ws; asm volatile("" : "+s"(_w)); F.ws = _w; ws = _w; float* _o = args.out; asm volatile("" : "+s"(_o)); F.out = _o; }
#define PHASE_END   } if (ph + 1 < hi) xcd_barrier(bar); } ++ph;
    unsigned char* ws = F.ws;
#define HN ((const bf16_t*)(ws + WS_HN))

    PHASE_BEGIN ph_prologue0(F); PHASE_END
    PHASE_BEGIN { pg8::Gemm g{(const bf16_t*)(ws + WS_MEMH), (const bf16_t*)(ws + WS_WKV), D, 0, nullptr}; pg8::StaticOrder S; S.init(MEMROWS, 4096, F.G, F.bid);
        pg8::EpiPlain E{(bf16_t*)(ws + PR_KVRAW), 4096}; pg8::gemm_phase<pg8::EpiPlain, pg8::StaticOrder>(F.lds, g, S, E); } PHASE_END
    PHASE_BEGIN ph_prologue2(F); PHASE_END

#pragma unroll 1
    for (int l = 0; l < DEPTH; ++l) {

        PHASE_BEGIN ph_layer0(F, l, l ? (const float*)F.out : FIN(F, I_X)); PHASE_END
#pragma unroll 1
        for (int half = 0; half < 2; ++half) {

            PHASE_BEGIN { pg8::Gemm g{HN + (size_t)half * TH * D, (const bf16_t*)(ws + W_IN), D, 0, nullptr}; pg8::StaticOrder S; S.init(TH, N_INP, F.G, F.bid);
                pg8::EpiWin E{(bf16_t*)(ws + MX_CA), (bf16_t*)(ws + MX_CB), (bf16_t*)(ws + MX_CG)}; pg8::gemm_phase<pg8::EpiWin, pg8::StaticOrder>(F.lds, g, S, E); } PHASE_END
                        PHASE_BEGIN ph_rwkv_prep(F, l, half); ph_dsa_prep(F, l, half); PHASE_END
            PHASE_BEGIN ph_rwkv_s1(F); PHASE_END
            PHASE_BEGIN { for (int p = F.bid; p < 128; p += F.G) ph_rwkv_s2(F, l, p); ph_dsa(F, half, F.bid, F.G); } PHASE_END
            PHASE_BEGIN { pg8::Gemm g{(const bf16_t*)(ws + MX_CA + RW_ARR), (const bf16_t*)(ws + W_BA), 512, 0, nullptr}; pg8::StaticOrder S; S.init(TH, D, F.G, F.bid);
                pg8::EpiMerge<false> E{(bf16_t*)(ws + WS_HN) + (size_t)half * TH * D, (const bf16_t*)(ws + MX_CG), 0}; pg8::gemm_phase<pg8::EpiMerge<false>, pg8::StaticOrder>(F.lds, g, S, E); } PHASE_END
            PHASE_BEGIN { pg8::Gemm g{(const bf16_t*)(ws + MX_YB), (const bf16_t*)(ws + W_BB), 512, 0, nullptr}; pg8::StaticOrder S; S.init(TH, D, F.G, F.bid);
                pg8::EpiMerge<true> E{(bf16_t*)(ws + WS_HN) + (size_t)half * TH * D, (const bf16_t*)(ws + MX_CG), 1024}; pg8::gemm_phase<pg8::EpiMerge<true>, pg8::StaticOrder>(F.lds, g, S, E); } PHASE_END
        }
        PHASE_BEGIN { pg8::Gemm g{HN, (const bf16_t*)(ws + W_OUT), D, 0, nullptr}; pg8::StaticOrder S; S.init(T, D, F.G, F.bid);
            pg8::EpiResid E{l ? (const float*)F.out : FIN(F, I_X), F.out}; pg8::gemm_phase<pg8::EpiResid, pg8::StaticOrder>(F.lds, g, S, E); } PHASE_END
        PHASE_BEGIN ph_norm(F); PHASE_END
        PHASE_BEGIN { pg8::Gemm g{HN, (const bf16_t*)(ws + W_MQ), D, 0, nullptr}; pg8::StaticOrder S; S.init(T, 512, F.G, F.bid);
            pg8::EpiPlain E{(bf16_t*)(ws + MA_QM), 512}; pg8::gemm_phase<pg8::EpiPlain, pg8::StaticOrder>(F.lds, g, S, E); } PHASE_END
        PHASE_BEGIN ph_mem_attn(F, l); PHASE_END
        PHASE_BEGIN { pg8::Gemm g{(const bf16_t*)(ws + MA_OM), (const bf16_t*)(ws + W_MO), 512, 0, nullptr}; pg8::StaticOrder S; S.init(T, D, F.G, F.bid);
            pg8::EpiResid E{F.out, F.out}; pg8::gemm_phase<pg8::EpiResid, pg8::StaticOrder>(F.lds, g, S, E); } PHASE_END
        PHASE_BEGIN ph_norm_ffn(F, l); PHASE_END
        if ((l & 1) == 0) {
            PHASE_BEGIN { pg8::Gemm g{HN, (const bf16_t*)(ws + W_FGU), D, 0, nullptr}; pg8::StaticOrder S; S.init(T, 2 * FFN, F.G, F.bid);
                pg8::EpiSwiGLU E{(bf16_t*)(ws + FF_GU), FFN}; pg8::gemm_phase<pg8::EpiSwiGLU, pg8::StaticOrder>(F.lds, g, S, E); } PHASE_END
            PHASE_BEGIN { pg8::Gemm g{(const bf16_t*)(ws + FF_GU), (const bf16_t*)(ws + W_FD), FFN, 0, nullptr}; pg8::StaticOrder S; S.init(T, D, F.G, F.bid);
                pg8::EpiResid E{F.out, F.out}; pg8::gemm_phase<pg8::EpiResid, pg8::StaticOrder>(F.lds, g, S, E); } PHASE_END
            ph += 2;
        } else {
#define meta ((const int*)(ws + MOE_META))
#define tile_e ((const int*)(ws + MOE_TILEE))
            PHASE_BEGIN ph_moe_route(F); PHASE_END
            PHASE_BEGIN { const int nt1 = __builtin_amdgcn_readfirstlane(meta[1]);
                pg8::Gemm g{HN, (const bf16_t*)(ws + W_EGU), D, (size_t)2 * EDIM * D, (const int*)(ws + MOE_ROWTOK)}; pg8::MoeOrder S; S.init(nt1, 11, F.G, F.bid, 0, tile_e);
                pg8::EpiSwiGLU E{(bf16_t*)(ws + FF_GU), EDIM}; pg8::gemm_phase<pg8::EpiSwiGLU, pg8::MoeOrder, true>(F.lds, g, S, E); } PHASE_END
            PHASE_BEGIN { const int nt0 = __builtin_amdgcn_readfirstlane(meta[0]);
                pg8::Gemm g{(const bf16_t*)(ws + FF_GU), (const bf16_t*)(ws + W_ED), EDIM, (size_t)D * EDIM, nullptr}; pg8::MoeOrder S; S.init(nt0, 4, F.G, F.bid, 0, tile_e);
                pg8::EpiMoeDown E{F.out, (const int*)(ws + MOE_ROWTOK), (const float*)(ws + MOE_ROWW)}; pg8::gemm_phase<pg8::EpiMoeDown, pg8::MoeOrder>(F.lds, g, S, E); } PHASE_END
            PHASE_BEGIN { const int nt0 = __builtin_amdgcn_readfirstlane(meta[0]), nt1 = __builtin_amdgcn_readfirstlane(meta[1]);
                pg8::Gemm g{(const bf16_t*)(ws + FF_GU), (const bf16_t*)(ws + W_ED), EDIM, (size_t)D * EDIM, nullptr}; pg8::MoeOrder S; S.init(nt1 - nt0, 4, F.G, F.bid, nt0, tile_e);
                pg8::EpiMoeDown E{F.out, (const int*)(ws + MOE_ROWTOK), (const float*)(ws + MOE_ROWW)}; pg8::gemm_phase<pg8::EpiMoeDown, pg8::MoeOrder>(F.lds, g, S, E); } PHASE_END
        }
    }
}
constexpr int N_PHASES = 3 + DEPTH * (1 + 2 * 6 + 6 + 4);

extern "C" void kernel_launch(void* const* d_in, const int* in_sizes, int n_in, void* d_out, int out_size, void* d_ws, size_t ws_size, hipStream_t stream) {
    static int grid = 0;
    if (grid == 0) {
        if (n_in != 41 || out_size != T * D || ws_size < WS_END) { fprintf(stderr, "kernel_launch: unexpected shapes (n_in %d, out %d, ws %zu < %zu); nothing launched\n", n_in, out_size, ws_size, (size_t)WS_END); grid = -1; return; }
        int dev = 0, cus = 0, per_cu = 0;
        if (hipGetDevice(&dev) != hipSuccess || hipDeviceGetAttribute(&cus, hipDeviceAttributeMultiprocessorCount, dev) != hipSuccess) { grid = -1; return; }
        if (hipFuncSetAttribute((const void*)fwd, hipFuncAttributeMaxDynamicSharedMemorySize, LDS_BYTES) != hipSuccess) { fprintf(stderr, "kernel_launch: hipFuncSetAttribute failed\n"); grid = -1; return; }
        if (hipOccupancyMaxActiveBlocksPerMultiprocessor(&per_cu, (const void*)fwd, NTHR, LDS_BYTES) != hipSuccess || per_cu < 1) fprintf(stderr, "kernel_launch: occupancy query reports %d\n", per_cu);
        (void)hipGetLastError();
        grid = cus;
    }
    if (grid < 0) return;
    if (hipMemsetAsync((char*)d_ws + WS_CTL, 0, CTL_ZERO_BYTES, stream) != hipSuccess) return;
    Args a{};
    for (int i = 0; i < 41; ++i) a.in[i] = d_in[i];
    a.out = (float*)d_out; a.ws = (unsigned char*)d_ws;
#if MK_ONE_LAUNCH
    a.ph_lo = 0; a.ph_hi = N_PHASES;
    hipLaunchKernelGGL(fwd, dim3(grid), dim3(NTHR), LDS_BYTES, stream, a);
#else
    for (int p = 0; p < N_PHASES; ++p) { a.ph_lo = p; a.ph_hi = p + 1; hipLaunchKernelGGL(fwd, dim3(grid), dim3(NTHR), LDS_BYTES, stream, a); }
#endif
}
```

```cpp
#include <hip/hip_runtime.h>
#include <cstdio>
#include <cstdint>

#ifndef MK_ONE_LAUNCH
#define MK_ONE_LAUNCH 1
#endif

namespace pg8 {
#define PG8_LAS __attribute__((address_space(3)))
typedef unsigned short bf16_t;
typedef short bf16x8 __attribute__((ext_vector_type(8)));
typedef float f32x4 __attribute__((ext_vector_type(4)));
typedef float f32x2 __attribute__((ext_vector_type(2)));
typedef unsigned u32x4 __attribute__((ext_vector_type(4)));
typedef unsigned u32x2 __attribute__((ext_vector_type(2)));
typedef __bf16 bf16x2_t __attribute__((ext_vector_type(2)));
constexpr int BM = 256, BK = 64, HALF = 128, HTB = HALF * BK * 2, STAGE_BYTES = 8 * HTB, NXCD = 8, WGM = 8;

__host__ __device__ __forceinline__ int lds_byte(int r, int c) { const int st = (r >> 4) * 2 + (c >> 5), rr = r & 15, cc = c & 31, ob = rr * 64 + cc * 2; return st * 1024 + (ob ^ (((ob >> 9) & 1) << 5)); }
__host__ __device__ __forceinline__ void stage_rc(int b, int& R, int& C) { const int st = b / 1024, sb = b % 1024, swz = sb ^ (((sb >> 9) & 1) << 5); R = (st >> 1) * 16 + swz / 64; C = (st & 1) * 32 + (swz % 64) / 2; }
__host__ __device__ __forceinline__ int perm32(int rho) { const int n = rho >> 4, i = rho & 15; return 8 * (i >> 2) + 4 * n + (i & 3); }

struct Unit { int pm, pn, e; };
struct Gemm { const bf16_t* A; const bf16_t* Bt; int K; size_t bstride; const int* rowidx; };

struct StaticOrder {
    int nM, nN, nwg, G, c;
    __device__ void init(int M, int N, int G_, int c_) { nM = M / BM; nN = N / BM; nwg = nM * nN; G = G_; c = c_; }
    __device__ bool next(int i, Unit& u) const {
        const long L = (long)i * G + c; if (L >= nwg) return false;
        int wgid = (int)L; { const int q = nwg / NXCD, r = nwg % NXCD, xcd = wgid % NXCD, off = wgid / NXCD; wgid = (xcd < r ? xcd * (q + 1) : r * (q + 1) + (xcd - r) * q) + off; }
        const int nig = WGM * nN, gid = wgid / nig, fm = gid * WGM, gsz = (nM - fm) < WGM ? (nM - fm) : WGM;
        u.pm = fm + ((wgid % nig) % gsz); u.pn = (wgid % nig) / gsz; u.e = 0; return true;
    }
};
struct MoeOrder {
    int nM, nN, nwg, G, c, pm0; const int* tile_e;
    __device__ void init(int nM_, int nN_, int G_, int c_, int pm0_, const int* te) { nM = nM_; nN = nN_; nwg = nM * nN; G = G_; c = c_; pm0 = pm0_; tile_e = te; }
    __device__ bool next(int i, Unit& u) const {
        const long L = (long)i * G + c; if (L >= nwg) return false;
        int wgid = (int)L; { const int q = nwg / NXCD, r = nwg % NXCD, xcd = wgid % NXCD, off = wgid / NXCD; wgid = (xcd < r ? xcd * (q + 1) : r * (q + 1) + (xcd - r) * q) + off; }
        const int nig = WGM * nN, gid = wgid / nig, fm = gid * WGM, gsz = (nM - fm) < WGM ? (nM - fm) : WGM;
        u.pm = pm0 + fm + ((wgid % nig) % gsz); u.pn = (wgid % nig) / gsz; u.e = __builtin_amdgcn_readfirstlane(tile_e[u.pm]); return true;
    }
};

__device__ __forceinline__ unsigned pk2(float lo, float hi) { const bf16x2_t v = __builtin_convertvector((f32x2){lo, hi}, bf16x2_t); return __builtin_bit_cast(unsigned, v); }
__device__ __forceinline__ float bf_lo(unsigned u) { return __builtin_bit_cast(float, u << 16); }
__device__ __forceinline__ float bf_hi(unsigned u) { return __builtin_bit_cast(float, u & 0xffff0000u); }
__device__ __forceinline__ float bf2f(bf16_t b) { return __builtin_bit_cast(float, (unsigned)b << 16); }
__device__ __forceinline__ bf16_t f2bf(float f) { return (bf16_t)(pk2(f, 0.f) & 0xffffu); }
__device__ __forceinline__ float sigmoidf_(float x) { return __builtin_amdgcn_rcpf(1.0f + __expf(-x)); }

struct EpiPlain {
    static constexpr bool PERM = true;
    bf16_t* O; int ldc;
    __device__ __forceinline__ void operator()(const f32x4 (&acc)[2][2][4][2], const Unit& u, int wr, int wc, int fr, int fq) const {
        const int row0 = u.pm * BM + wr * 64 + fr, col0 = u.pn * BM + wc * 32 + 8 * fq;
#pragma unroll
        for (int ai = 0; ai < 2; ++ai)
#pragma unroll
            for (int m = 0; m < 4; ++m) { bf16_t* rowp = O + (size_t)(row0 + ai * HALF + m * 16) * ldc + col0;
#pragma unroll
                for (int bj = 0; bj < 2; ++bj) { const f32x4 v0 = acc[ai][bj][m][0], v1 = acc[ai][bj][m][1];
                    u32x4 w; w.x = pk2(v0[0], v0[1]); w.y = pk2(v0[2], v0[3]); w.z = pk2(v1[0], v1[1]); w.w = pk2(v1[2], v1[3]);
                    *(u32x4*)(rowp + bj * HALF) = w; } }
    }
};
struct EpiWin {
    static constexpr bool PERM = true;
    bf16_t *CA, *CB, *CG;
    __device__ __forceinline__ void operator()(const f32x4 (&acc)[2][2][4][2], const Unit& u, int wr, int wc, int fr, int fq) const {
        const int row0 = u.pm * BM + wr * 64 + fr; const int pn = u.pn;
        bf16_t* base; int ldc, ct; const bool sg = pn >= 12;
        if (pn < 7) { base = CA; ldc = 1792; ct = pn; } else if (pn < 12) { base = CB; ldc = 1280; ct = pn - 7; } else { base = CG; ldc = 2048; ct = pn - 12; }
        const int col0 = ct * BM + wc * 32 + 8 * fq;
#pragma unroll
        for (int ai = 0; ai < 2; ++ai)
#pragma unroll
            for (int m = 0; m < 4; ++m) { bf16_t* rowp = base + (size_t)(row0 + ai * HALF + m * 16) * ldc + col0;
#pragma unroll
                for (int bj = 0; bj < 2; ++bj) { f32x4 v0 = acc[ai][bj][m][0], v1 = acc[ai][bj][m][1];
                    if (sg) {
#pragma unroll
                        for (int j = 0; j < 4; ++j) { v0[j] = sigmoidf_(v0[j]); v1[j] = sigmoidf_(v1[j]); } }
                    u32x4 w; w.x = pk2(v0[0], v0[1]); w.y = pk2(v0[2], v0[3]); w.z = pk2(v1[0], v1[1]); w.w = pk2(v1[2], v1[3]);
                    *(u32x4*)(rowp + bj * HALF) = w; } }
    }
};
template <bool ADD> struct EpiMerge {
    static constexpr bool PERM = true;
    bf16_t* O; const bf16_t* gate; int gcol;
    __device__ __forceinline__ void operator()(const f32x4 (&acc)[2][2][4][2], const Unit& u, int wr, int wc, int fr, int fq) const {
        const int row0 = u.pm * BM + wr * 64 + fr, col0 = u.pn * BM + wc * 32 + 8 * fq;
#pragma unroll
        for (int ai = 0; ai < 2; ++ai)
#pragma unroll
            for (int m = 0; m < 4; ++m) { const size_t row = (size_t)(row0 + ai * HALF + m * 16);
                bf16_t* rowp = O + row * 1024 + col0; const bf16_t* gp = gate + row * 2048 + gcol + col0;
#pragma unroll
                for (int bj = 0; bj < 2; ++bj) { const f32x4 v0 = acc[ai][bj][m][0], v1 = acc[ai][bj][m][1];
                    const u32x4 g = *(const u32x4*)(gp + bj * HALF);
                    float o[8] = { bf_lo(g.x) * v0[0], bf_hi(g.x) * v0[1], bf_lo(g.y) * v0[2], bf_hi(g.y) * v0[3], bf_lo(g.z) * v1[0], bf_hi(g.z) * v1[1], bf_lo(g.w) * v1[2], bf_hi(g.w) * v1[3] };
                    if (ADD) { const u32x4 p = *(const u32x4*)(rowp + bj * HALF);
                        o[0] += bf_lo(p.x); o[1] += bf_hi(p.x); o[2] += bf_lo(p.y); o[3] += bf_hi(p.y); o[4] += bf_lo(p.z); o[5] += bf_hi(p.z); o[6] += bf_lo(p.w); o[7] += bf_hi(p.w); }
                    u32x4 w; w.x = pk2(o[0], o[1]); w.y = pk2(o[2], o[3]); w.z = pk2(o[4], o[5]); w.w = pk2(o[6], o[7]);
                    *(u32x4*)(rowp + bj * HALF) = w; } }
    }
};
struct EpiResid {
    static constexpr bool PERM = false;
    const float* xi; float* xo;
    __device__ __forceinline__ void operator()(const f32x4 (&acc)[2][2][4][2], const Unit& u, int wr, int wc, int fr, int fq) const {
        const int row0 = u.pm * BM + wr * 64 + fr, col0 = u.pn * BM + wc * 32 + 4 * fq;
#pragma unroll
        for (int ai = 0; ai < 2; ++ai)
#pragma unroll
            for (int m = 0; m < 4; ++m) { const size_t o = (size_t)(row0 + ai * HALF + m * 16) * 1024 + col0;
#pragma unroll
                for (int bj = 0; bj < 2; ++bj)
#pragma unroll
                    for (int n = 0; n < 2; ++n) { const f32x4 x = *(const f32x4*)(xi + o + bj * HALF + n * 16); *(f32x4*)(xo + o + bj * HALF + n * 16) = x + acc[ai][bj][m][n]; } }
    }
};
struct EpiSwiGLU {
    static constexpr bool PERM = true;
    bf16_t* O; int ldc;
    __device__ __forceinline__ void operator()(const f32x4 (&acc)[2][2][4][2], const Unit& u, int wr, int wc, int fr, int fq) const {
        const int row0 = u.pm * BM + wr * 64 + fr, col0 = u.pn * HALF + wc * 32 + 8 * fq;
#pragma unroll
        for (int ai = 0; ai < 2; ++ai)
#pragma unroll
            for (int m = 0; m < 4; ++m) { bf16_t* rowp = O + (size_t)(row0 + ai * HALF + m * 16) * ldc + col0;
                float o[8];
#pragma unroll
                for (int n = 0; n < 2; ++n)
#pragma unroll
                    for (int j = 0; j < 4; ++j) { const float g = acc[ai][0][m][n][j], up = acc[ai][1][m][n][j]; o[4 * n + j] = g * sigmoidf_(g) * up; }
                u32x4 w; w.x = pk2(o[0], o[1]); w.y = pk2(o[2], o[3]); w.z = pk2(o[4], o[5]); w.w = pk2(o[6], o[7]);
                *(u32x4*)rowp = w; }
    }
};
struct EpiMoeDown {
    static constexpr bool PERM = false;
    float* x; const int* tok; const float* wgt;
    __device__ __forceinline__ void operator()(const f32x4 (&acc)[2][2][4][2], const Unit& u, int wr, int wc, int fr, int fq) const {
        const int row0 = u.pm * BM + wr * 64 + fr, col0 = u.pn * BM + wc * 32 + 4 * fq;
#pragma unroll
        for (int ai = 0; ai < 2; ++ai)
#pragma unroll
            for (int m = 0; m < 4; ++m) { const int row = row0 + ai * HALF + m * 16; const int t = tok[row]; const float wv = wgt[row];
                if (t >= 0) { float* xp = x + (size_t)t * 1024 + col0;
#pragma unroll
                    for (int bj = 0; bj < 2; ++bj)
#pragma unroll
                        for (int n = 0; n < 2; ++n) { const f32x4 xv = *(const f32x4*)(xp + bj * HALF + n * 16); *(f32x4*)(xp + bj * HALF + n * 16) = xv + acc[ai][bj][m][n] * wv; } } }
    }
};

template <class Epi, class Sched, bool GATHER = false>
__device__ __forceinline__ void gemm_phase(PG8_LAS unsigned char* lds, const Gemm g, const Sched& S, const Epi& E) {
    int tid_ = threadIdx.x; asm volatile("" : "+v"(tid_));
    const int tid = tid_, wid = __builtin_amdgcn_readfirstlane(tid >> 6), lane = tid & 63, wr = wid >> 2, wc = wid & 3, fr = lane & 15, fq = lane >> 4;
    const int K = g.K, nt = K / BK;
    unsigned voffA[2], voffB[2];
#pragma unroll
    for (int i = 0; i < 2; ++i) { int R, C; stage_rc(tid * 16 + i * 8192, R, C); const int Rb = Epi::PERM ? ((R & ~31) + perm32(R & 31)) : R;
        voffA[i] = (unsigned)(R * K + C) * 2u; voffB[i] = (unsigned)(Rb * K + C) * 2u; }
    const size_t kstep = (size_t)(BK * 2);
    const size_t hstep = (size_t)HALF * K * 2;
    const size_t tstep = 2 * hstep;
    const unsigned ldsw = (unsigned)wid * 1024u;
    const int aoff = lds_byte(wr * 64 + fr, fq * 8), boff = lds_byte(wc * 32 + fr, fq * 8);
    unsigned gvo[2][2];
#define PG8_SA(b, h) (((b) * 2 + (h)) * HTB)
#define PG8_SB(b, h) ((4 + (b) * 2 + (h)) * HTB)
#define PG8_STAGE(bufoff, gbase, voff) do { _Pragma("unroll") for (int _i = 0; _i < 2; ++_i) \
        __builtin_amdgcn_global_load_lds((const unsigned*)((const char*)(gbase) + (voff)[_i]), (PG8_LAS unsigned*)(lds + (bufoff) + ldsw + _i * 8192), 16, 0, 0); } while (0)
#define PG8_STAGE_A(bufoff, h, ubase, kb, nx) do { if constexpr (GATHER) { PG8_STAGE(bufoff, (const char*)g.A + (kb), gvo[h]); } \
        else { PG8_STAGE(bufoff, (ubase) + (kb) + (h) * hstep, voffA); } } while (0)
#define PG8_LOADROWS(dst, unit) do { if constexpr (GATHER) { _Pragma("unroll") for (int _i = 0; _i < 2; ++_i) { int _R, _C; stage_rc(tid * 16 + _i * 8192, _R, _C); \
        _Pragma("unroll") for (int _h = 0; _h < 2; ++_h) { int _t = g.rowidx[(unit).pm * BM + _h * HALF + _R]; _t = _t < 0 ? 0 : _t; dst[_h][_i] = (unsigned)(_t * K + _C) * 2u; } } } } while (0)
#define PG8_LDA(dst, b, h) do { _Pragma("unroll") for (int m = 0; m < 4; ++m) _Pragma("unroll") for (int k = 0; k < 2; ++k) dst[m][k] = *(const PG8_LAS bf16x8*)(lds + PG8_SA(b, h) + aoff + m * 2048 + k * 1024); } while (0)
#define PG8_LDB(dst, b, h) do { _Pragma("unroll") for (int n = 0; n < 2; ++n) _Pragma("unroll") for (int k = 0; k < 2; ++k) dst[n][k] = *(const PG8_LAS bf16x8*)(lds + PG8_SB(b, h) + boff + n * 2048 + k * 1024); } while (0)
#define PG8_MMA(ai, bj, At, Bt) do { __builtin_amdgcn_s_setprio(1); _Pragma("unroll") for (int m = 0; m < 4; ++m) _Pragma("unroll") for (int n = 0; n < 2; ++n) _Pragma("unroll") for (int k = 0; k < 2; ++k) \
        acc[ai][bj][m][n] = __builtin_amdgcn_mfma_f32_16x16x32_bf16(Bt[n][k], At[m][k], acc[ai][bj][m][n], 0, 0, 0); __builtin_amdgcn_s_setprio(0); } while (0)
#define PG8_WAIT_V(n) asm volatile("s_waitcnt vmcnt(" #n ")" ::: "memory")
#define PG8_WAIT_L(n) asm volatile("s_waitcnt lgkmcnt(" #n ")" ::: "memory")
#define PG8_BAR __builtin_amdgcn_s_barrier()
#define PG8_SCHED __builtin_amdgcn_sched_barrier(0)
    Unit cur, nxt; int ui = 0;
    if (!S.next(0, cur)) return;
    f32x4 acc[2][2][4][2];
#pragma unroll
    for (int a = 0; a < 2; ++a)
#pragma unroll
        for (int b = 0; b < 2; ++b)
#pragma unroll
            for (int m = 0; m < 4; ++m)
#pragma unroll
                for (int n = 0; n < 2; ++n) acc[a][b][m][n] = (f32x4){0.f, 0.f, 0.f, 0.f};
    bf16x8 At[4][2], B0[2][2], B1[2][2];
    const char* cA = GATHER ? (const char*)g.A : (const char*)g.A + (size_t)cur.pm * tstep;
    const char* cB = (const char*)g.Bt + ((size_t)cur.e * g.bstride) * 2 + (size_t)cur.pn * tstep;
    PG8_LOADROWS(gvo, cur);
    PG8_STAGE(PG8_SB(0, 0), cB, voffB); PG8_STAGE(PG8_SB(0, 1), cB + hstep, voffB); PG8_STAGE_A(PG8_SA(0, 0), 0, cA, 0, false); PG8_STAGE_A(PG8_SA(0, 1), 1, cA, 0, false);
    if (wr == 1) PG8_BAR;
    PG8_WAIT_V(2); PG8_BAR;
    PG8_STAGE(PG8_SB(1, 0), cB + kstep, voffB); PG8_STAGE_A(PG8_SA(1, 0), 0, cA, kstep, false); PG8_STAGE(PG8_SB(1, 1), cB + hstep + kstep, voffB);
    PG8_WAIT_V(6); PG8_BAR;
    for (;;) {
        const bool has_next = S.next(ui + 1, nxt);
        const char* nA = GATHER ? (const char*)g.A : (has_next ? (const char*)g.A + (size_t)nxt.pm * tstep : cA);
        const char* nB = has_next ? (const char*)g.Bt + ((size_t)nxt.e * g.bstride) * 2 + (size_t)nxt.pn * tstep : cB;
        for (int t = 0; t < nt; t += 2) {
            const bool last = (t == nt - 2);
            const size_t k1 = (size_t)(t + 1) * kstep;
            const size_t k2 = last ? 0 : (size_t)(t + 2) * kstep, k3 = k2 + kstep;
            const char* a2b = last ? nA : cA; const char* b2 = (last ? nB : cB) + k2; const char* b3 = b2 + kstep;
            PG8_LDB(B0, 0, 0); PG8_LDB(B1, 0, 1); PG8_SCHED; PG8_LDA(At, 0, 0); PG8_STAGE_A(PG8_SA(1, 1), 1, cA, k1, false);
            if (last && has_next) PG8_LOADROWS(gvo, nxt);
            PG8_WAIT_V(8); PG8_WAIT_L(0); PG8_BAR; PG8_MMA(0, 0, At, B0); PG8_MMA(0, 1, At, B1); PG8_BAR; PG8_SCHED;
            PG8_LDA(At, 0, 1); PG8_STAGE(PG8_SB(0, 0), b2, voffB); PG8_STAGE(PG8_SB(0, 1), b2 + hstep, voffB); PG8_STAGE_A(PG8_SA(0, 0), 0, a2b, k2, last);
            PG8_WAIT_V(8); PG8_WAIT_L(0); PG8_BAR; PG8_MMA(1, 0, At, B0); PG8_MMA(1, 1, At, B1); PG8_BAR; PG8_SCHED;
            PG8_LDB(B0, 1, 0); PG8_LDB(B1, 1, 1); PG8_SCHED; PG8_LDA(At, 1, 0); PG8_STAGE_A(PG8_SA(0, 1), 1, a2b, k2, last);
            PG8_WAIT_V(8); PG8_WAIT_L(0); PG8_BAR; PG8_MMA(0, 0, At, B0); PG8_MMA(0, 1, At, B1); PG8_BAR; PG8_SCHED;
            PG8_LDA(At, 1, 1); PG8_STAGE(PG8_SB(1, 0), b3, voffB); PG8_STAGE(PG8_SB(1, 1), b3 + hstep, voffB); PG8_STAGE_A(PG8_SA(1, 0), 0, a2b, k3, last);
            PG8_WAIT_V(8); PG8_WAIT_L(0); PG8_BAR; PG8_MMA(1, 0, At, B0); PG8_MMA(1, 1, At, B1); PG8_BAR; PG8_SCHED;
        }
        E(acc, cur, wr, wc, fr, fq);
        if (!has_next) break;
#pragma unroll
        for (int a = 0; a < 2; ++a)
#pragma unroll
            for (int b = 0; b < 2; ++b)
#pragma unroll
                for (int m = 0; m < 4; ++m)
#pragma unroll
                    for (int n = 0; n < 2; ++n) acc[a][b][m][n] = (f32x4){0.f, 0.f, 0.f, 0.f};
        cur = nxt; cA = nA; cB = nB; ++ui;
    }
    PG8_WAIT_V(0);
    if (wr == 0) PG8_BAR;
    PG8_BAR;
#undef PG8_SA
#undef PG8_SB
#undef PG8_STAGE
#undef PG8_STAGE_A
#undef PG8_LOADROWS
#undef PG8_LDA
#undef PG8_LDB
#undef PG8_MMA
#undef PG8_WAIT_V
#undef PG8_WAIT_L
#undef PG8_BAR
#undef PG8_SCHED
}
}
using pg8::bf16_t; using pg8::bf16x8; using pg8::f32x4; using pg8::f32x2; using pg8::u32x4; using pg8::u32x2; using pg8::pk2; using pg8::bf2f; using pg8::f2bf; using pg8::bf_lo; using pg8::bf_hi; using pg8::sigmoidf_;

constexpr int NWAVES = 8, NTHR = 512;
constexpr int D = 1024, NB = 32, SEQ = 2048, T = NB * SEQ, TH = T / 2, DEPTH = 4;
constexpr int RW_COLS = 1792, DS_COLS = 1224, DS_PAD = 1280, N_IN = 5064, N_INP = 5120;
constexpr int NMEM = 256, MEMROWS = NB * NMEM;
constexpr int FFN = 2816, NEXP = 8, EDIM = 1408;
constexpr int MOE_ROWS_MAX = 2 * T + 16 * 256;
constexpr int MOE_TILES_MAX = MOE_ROWS_MAX / 256;

constexpr size_t MiB = 1u << 20;
constexpr size_t WS_CTL = 0, CTL_ZERO_BYTES = 1 * MiB;
constexpr size_t WS_MOE = 1 * MiB;
constexpr size_t MOE_SELE = WS_MOE, MOE_SELW = MOE_SELE + (size_t)T * 2, MOE_ROWTOK = MOE_SELW + (size_t)T * 8, MOE_ROWW = MOE_ROWTOK + (size_t)MOE_ROWS_MAX * 4,
                 MOE_TILEE = MOE_ROWW + (size_t)MOE_ROWS_MAX * 4, MOE_META = MOE_TILEE + (size_t)MOE_TILES_MAX * 4, MOE_END = MOE_META + 256;
static_assert(MOE_END <= 4 * MiB, "moe map");
constexpr size_t WS_W = 4 * MiB;
constexpr size_t W_IN = WS_W, W_BA = W_IN + (size_t)N_INP * D * 2, W_BB = W_BA + (size_t)D * 512 * 2, W_OUT = W_BB + (size_t)D * 512 * 2, W_MQ = W_OUT + (size_t)D * D * 2,
                 W_MO = W_MQ + (size_t)512 * D * 2, W_FF = W_MO + (size_t)D * 512 * 2;
constexpr size_t W_RW2 = W_FF, W_RA2 = W_RW2 + 512 * 64 * 2, W_RG2 = W_RA2 + 512 * 64 * 2, W_RV1 = W_RG2 + 512 * 128 * 2, W_RV2 = W_RV1 + 32 * 512 * 2, W_FF2 = W_RV2 + 512 * 32 * 2;
constexpr size_t W_FGU = W_FF2, W_FD = W_FGU + (size_t)2 * FFN * D * 2;
constexpr size_t W_EGU = W_FF2, W_ED = W_EGU + (size_t)NEXP * 2 * EDIM * D * 2, W_END = W_ED + (size_t)NEXP * D * EDIM * 2;
static_assert(W_FD + (size_t)D * FFN * 2 <= W_END, "w map");
constexpr size_t WS_WKV = (W_END + MiB - 1) / MiB * MiB;
constexpr size_t WS_MEMH = WS_WKV + (size_t)4096 * D * 2;
constexpr size_t WS_MEMK = WS_MEMH + (size_t)MEMROWS * D * 2;
constexpr size_t WS_MEMVT = WS_MEMK + (size_t)DEPTH * MEMROWS * 512 * 2;
constexpr size_t WS_VFIRST = WS_MEMVT + (size_t)DEPTH * MEMROWS * 512 * 2;
constexpr size_t WS_HN = WS_VFIRST + (size_t)T * 512 * 2;
constexpr size_t WS_MIX = WS_HN + (size_t)T * D * 2;
constexpr size_t MX_CA = WS_MIX, MX_CB = MX_CA + (size_t)TH * RW_COLS * 2, MX_CG = MX_CB + (size_t)TH * DS_PAD * 2, MX_RW = MX_CG + (size_t)TH * 2048 * 2;
constexpr size_t RW_ARR = (size_t)TH * 512 * 2;
constexpr size_t MX_VT = MX_RW + 7 * RW_ARR, MX_YB = MX_VT + (size_t)(NB / 2) * 64 * SEQ * 2, MX_END = MX_YB + (size_t)TH * 512 * 2;
constexpr size_t MA_QM = WS_MIX, MA_OM = MA_QM + (size_t)T * 512 * 2;
constexpr size_t FF_GU = WS_MIX;
constexpr size_t PR_KVRAW = WS_MIX;
constexpr size_t WS_END = MX_END;
static_assert(FF_GU + (size_t)T * FFN * 2 <= WS_END && FF_GU + (size_t)MOE_ROWS_MAX * EDIM * 2 <= WS_END && MA_OM + (size_t)T * 512 * 2 <= WS_END, "overlay map");
static_assert(WS_END <= 1000 * MiB, "workspace budget");

constexpr int LDS_BYTES = 160 * 1024;
constexpr int LDS_MISC = LDS_BYTES - 256;

#define XB_TMO      128
#define XB_XCNT(j)  (256  + 64 * (j))
#define XB_XSUB(j)  (1280 + 64 * (j))
#define XB_XGEN(j)  (2304 + 64 * (j))
#define XB_TOP      3328
#define XB_TOPGEN   3392
#define XCD_BAR_WORDS 3456
#define XB_SPIN_CAP (1u << 18)
#define LAS __attribute__((address_space(3)))

__device__ __forceinline__ unsigned xb_ld(unsigned* p)              { return __hip_atomic_load(p, __ATOMIC_RELAXED, __HIP_MEMORY_SCOPE_AGENT); }
__device__ __forceinline__ unsigned xb_add(unsigned* p, unsigned v) { return __hip_atomic_fetch_add(p, v, __ATOMIC_RELAXED, __HIP_MEMORY_SCOPE_AGENT); }
__device__ __forceinline__ unsigned xb_xcc_id() { return (unsigned)__builtin_amdgcn_s_getreg((3 << 11) | 20) & 0xFu; }
#define XB_SPIN(cond, bar) do { unsigned _sp = 0; while (cond) { __builtin_amdgcn_s_sleep(1); \
    if ((++_sp & 255u) == 0u) { if (xb_ld(&(bar)[XB_TMO])) break; if (_sp > XB_SPIN_CAP) { atomicAdd(&(bar)[XB_TMO], 1u); break; } } } } while (0)
struct XcdBarrier { unsigned* bar; unsigned x; volatile LAS unsigned* st; };
__device__ __forceinline__ XcdBarrier xcd_barrier_post(unsigned* bar, volatile LAS unsigned* st) {
    XcdBarrier b; b.bar = bar; b.x = xb_xcc_id(); b.st = st;
    if (threadIdx.x == 0) (void)xb_add(&bar[XB_XCNT(b.x)], 1u);
    return b;
}
__device__ __forceinline__ void xcd_barrier_complete(unsigned* bar, unsigned x, unsigned& nloc, unsigned& nx) {
    const unsigned G = gridDim.x * gridDim.y * gridDim.z;
    unsigned sum, cnt, mine, sp = 0u;
    for (;;) {
        sum = 0u; cnt = 0u; mine = 0u;
#pragma unroll
        for (unsigned j = 0; j < 16; ++j) { const unsigned c = xb_ld(&bar[XB_XCNT(j)]); sum += c; cnt += (c > 0u) ? 1u : 0u; mine = (j == x) ? c : mine; }
        if (sum == G) break;
        __builtin_amdgcn_s_sleep(1);
        if ((++sp & 255u) == 0u) { if (xb_ld(&bar[XB_TMO])) break; if (sp > XB_SPIN_CAP) { atomicAdd(&bar[XB_TMO], 1u); break; } }
    }
    nloc = mine > 0u ? mine : 1u; nx = cnt > 0u ? cnt : 1u;
}
__device__ __forceinline__ void xcd_barrier(const XcdBarrier& b) {
    asm volatile("s_waitcnt vmcnt(0)" ::: "memory");
    __syncthreads();
    if (threadIdx.x == 0) {
        unsigned* bar = b.bar;
        __builtin_amdgcn_s_waitcnt(0);
        unsigned nloc = b.st[0], nx = b.st[1];
        if (nloc == 0u) { xcd_barrier_complete(bar, b.x, nloc, nx); b.st[0] = nloc; b.st[1] = nx; }
        const unsigned old = xb_add(&bar[XB_XSUB(b.x)], 1u);
        const unsigned gen = old / nloc;
        if (old + 1u == (gen + 1u) * nloc) {
            __builtin_amdgcn_fence(__ATOMIC_RELEASE, "agent");
            asm volatile("s_waitcnt vmcnt(0)" ::: "memory");
            const unsigned og = xb_add(&bar[XB_TOP], 1u);
            const unsigned tg = og / nx;
            if (og + 1u == (tg + 1u) * nx) xb_add(&bar[XB_TOPGEN], 1u);
            else XB_SPIN(xb_ld(&bar[XB_TOPGEN]) == tg, bar);
            __builtin_amdgcn_fence(__ATOMIC_ACQUIRE, "agent");
            xb_add(&bar[XB_XGEN(b.x)], 1u);
            asm volatile("s_waitcnt vmcnt(0)" ::: "memory");
        } else {
            XB_SPIN(xb_ld(&bar[XB_XGEN(b.x)]) == gen, bar);
            __builtin_amdgcn_fence(__ATOMIC_ACQUIRE, "agent");
            asm volatile("s_waitcnt vmcnt(0)" ::: "memory");
        }
    }
    __syncthreads();
}

struct Args { const void* in[41]; float* out; unsigned char* ws; int ph_lo, ph_hi; };
static_assert(sizeof(Args) == 41 * 8 + 8 + 8 + 8, "Args has no padding");

enum InIdx { I_X = 0, I_MEM, I_POS, I_NORM_MIX, I_W_IN, I_MU, I_W0, I_W2, I_A0, I_A2, I_G2, I_V0, I_V1, I_V2, I_KK, I_KA, I_RK, I_LNG, I_LNB, I_QN, I_KN, I_IKN,
             I_WBA, I_WBB, I_WOUT, I_NORM_MEM, I_MEM_TOKN, I_MWQ, I_MWKV, I_MQN, I_MKN, I_MWO, I_NORM_FFN, I_FWG, I_FWU, I_FWD, I_ROUTER, I_RBIAS, I_EWG, I_EWU, I_EWD };

typedef decltype(__builtin_amdgcn_kernarg_segment_ptr()) kptr_t;
struct Frame {
    LAS unsigned char* lds; unsigned char* ws; kptr_t kb; float* out;
    int tid, lane, wave, G, bid;
};
#define LDS_WAIT() asm volatile("s_waitcnt lgkmcnt(0)" ::: "memory")
__device__ __forceinline__ const void* kargp(kptr_t kb, int i) { typedef const void* cvp; typedef __attribute__((address_space(4))) const cvp* tab_t; return ((tab_t)kb)[i]; }
#define KARGP(F, i) kargp((F).kb, (i))
#define FIN(F, i) ((const float*)KARGP(F, i))

__device__ __forceinline__ float wave_sum(float v) {
#pragma unroll
    for (int o = 1; o < 64; o <<= 1) v += __shfl_xor(v, o);
    return v;
}

template <class Map>
__device__ __forceinline__ void transpose_item(const float* W, int K, int N, bf16_t* WT, const Map& map, const float* gain, LAS float* scr, int item, int lane) {
    const int nblk = (N + 31) / 32, kb = item / nblk, nb = item % nblk, k0 = 64 * kb, n0 = 32 * nb;
    const int nn = n0 + (lane & 31);
#pragma unroll 8
    for (int i = 0; i < 32; ++i) { const int kk = 2 * i + (lane >> 5); float v = 0.f; if (nn < N && k0 + kk < K) { v = W[(size_t)(k0 + kk) * N + nn]; if (gain) v *= gain[k0 + kk]; } scr[kk * 33 + (lane & 31)] = v; }
    LDS_WAIT(); asm volatile("" ::: "memory");
    const int c = lane & 7;
#pragma unroll
    for (int j = 0; j < 4; ++j) { const int n = (lane >> 3) + 8 * j; const LAS float* s = scr + (8 * c) * 33 + n;
        u32x4 o; o.x = pk2(s[0 * 33], s[1 * 33]); o.y = pk2(s[2 * 33], s[3 * 33]); o.z = pk2(s[4 * 33], s[5 * 33]); o.w = pk2(s[6 * 33], s[7 * 33]);
        if (n0 + n < N && k0 + 8 * c < K) *(u32x4*)(WT + (size_t)map(n0 + n) * K + k0 + 8 * c) = o; }
    LDS_WAIT(); asm volatile("" ::: "memory");
}
struct MapId { int off; __device__ int operator()(int n) const { return n + off; } };
struct MapWin { __device__ int operator()(int n) const { return n < 3016 ? n : n + 56; } };
struct MapGU { int up; __device__ int operator()(int n) const { return (n >> 7) * 256 + up * 128 + (n & 127); } };

__device__ __forceinline__ void rms_row_to_bf16(const float* xrow, bf16_t* orow, int lane, f32x4 (&v)[4]) {
    const f32x4* xr = (const f32x4*)xrow + lane; float s = 0.f;
#pragma unroll
    for (int j = 0; j < 4; ++j) { v[j] = xr[64 * j]; s += (v[j].x * v[j].x + v[j].y * v[j].y) + (v[j].z * v[j].z + v[j].w * v[j].w); }
    const float rstd = 1.0f / sqrtf(wave_sum(s) * (1.f / D) + 1e-6f);
    u32x2* o8 = (u32x2*)orow + lane;
#pragma unroll
    for (int j = 0; j < 4; ++j) { v[j] = v[j] * rstd; u32x2 w; w.x = pk2(v[j].x, v[j].y); w.y = pk2(v[j].z, v[j].w); o8[64 * j] = w; }
}

__device__ __forceinline__ void ph_prologue0(Frame& F) {
    LAS float* scr = (LAS float*)(F.lds + F.wave * 16384);
    const int gw = F.bid * NWAVES + F.wave, NGW = F.G * NWAVES;
    bf16_t* wkv = (bf16_t*)(F.ws + WS_WKV);
    constexpr int IT = (D / 64) * (1024 / 32);
    for (int it = gw; it < DEPTH * IT; it += NGW) { const int l = it / IT, r = it % IT;
        transpose_item(FIN(F, I_MWKV) + (size_t)l * D * 1024, D, 1024, wkv, MapId{l * 1024}, FIN(F, I_MEM_TOKN) + l * D, scr, r, F.lane); }
    bf16_t* mh = (bf16_t*)(F.ws + WS_MEMH);
    for (int m = gw; m < MEMROWS; m += NGW) { f32x4 v[4]; rms_row_to_bf16(FIN(F, I_MEM) + (size_t)m * D, mh + (size_t)m * D, F.lane, v); }
}
__device__ __forceinline__ void ph_prologue2(Frame& F) {
    const int gw = F.bid * NWAVES + F.wave, NGW = F.G * NWAVES;
    const bf16_t* kv = (const bf16_t*)(F.ws + PR_KVRAW);
    bf16_t* MK = (bf16_t*)(F.ws + WS_MEMK); bf16_t* MVT = (bf16_t*)(F.ws + WS_MEMVT);
    for (int it = gw; it < MEMROWS * 16; it += NGW) {
        const int row = it >> 4, l = (it >> 2) & 3, hh = it & 3, b = row >> 8, m = row & 255;
        const bf16_t* src = kv + (size_t)row * 4096 + l * 1024;
        const unsigned kk = *(const unsigned*)(src + hh * 128 + 2 * F.lane);
        const float k0 = bf_lo(kk), k1 = bf_hi(kk);
        const float rstd = 1.0f / sqrtf(wave_sum(k0 * k0 + k1 * k1) * (1.f / 128.f) + 1e-6f);
        const float* gk = FIN(F, I_MKN) + l * 128;
        *(unsigned*)(MK + ((((size_t)l * NB + b) * 4 + hh) * 256 + m) * 128 + 2 * F.lane) = pk2(k0 * rstd * gk[2 * F.lane], k1 * rstd * gk[2 * F.lane + 1]);
        const unsigned vv = *(const unsigned*)(src + 512 + hh * 128 + 2 * F.lane);
        bf16_t* vt = MVT + (((size_t)l * NB + b) * 4 + hh) * 128 * 256 + m;
        vt[(size_t)(2 * F.lane) * 256] = (bf16_t)(vv & 0xffffu); vt[(size_t)(2 * F.lane + 1) * 256] = (bf16_t)(vv >> 16);
    }
}
__device__ __forceinline__ void ph_layer0(Frame& F, int l, const float* xin) {
    LAS float* scr = (LAS float*)(F.lds + F.wave * 16384);
    const int gw = F.bid * NWAVES + F.wave, NGW = F.G * NWAVES;
    unsigned char* ws = F.ws;
    constexpr int I_WIN = (D / 64) * ((N_IN + 31) / 32), I_B = (512 / 64) * (D / 32), I_O = (D / 64) * (D / 32), I_Q = (D / 64) * (512 / 32);
    constexpr int I_FG = (D / 64) * (FFN / 32), I_FDN = (FFN / 64) * (D / 32), I_EG = (D / 64) * (EDIM / 32), I_EDN = (EDIM / 64) * (D / 32);
    const bool moe = (l & 1) != 0; const int j = l >> 1;
    const int nff = moe ? NEXP * (2 * I_EG + I_EDN) : (2 * I_FG + I_FDN);
    constexpr int I_R2 = 16, I_RG = 32, I_RV1 = 8, I_RV2 = 16;
    const int nrw = 2 * I_R2 + I_RG + (l ? I_RV1 + I_RV2 : 0);
    const int NIT = I_WIN + 2 * I_B + I_O + I_Q + I_B + nrw + nff;
    const float* gffn = FIN(F, I_NORM_FFN) + l * D;
    for (int it = gw; it < NIT; it += NGW) {
        int r = it;
        if (r < I_WIN) { transpose_item(FIN(F, I_W_IN) + (size_t)l * D * N_IN, D, N_IN, (bf16_t*)(ws + W_IN), MapWin{}, FIN(F, I_NORM_MIX) + l * D, scr, r, F.lane); continue; } r -= I_WIN;
        if (r < I_B) { transpose_item(FIN(F, I_WBA) + (size_t)l * 512 * D, 512, D, (bf16_t*)(ws + W_BA), MapId{0}, nullptr, scr, r, F.lane); continue; } r -= I_B;
        if (r < I_B) { transpose_item(FIN(F, I_WBB) + (size_t)l * 512 * D, 512, D, (bf16_t*)(ws + W_BB), MapId{0}, nullptr, scr, r, F.lane); continue; } r -= I_B;
        if (r < I_O) { transpose_item(FIN(F, I_WOUT) + (size_t)l * D * D, D, D, (bf16_t*)(ws + W_OUT), MapId{0}, nullptr, scr, r, F.lane); continue; } r -= I_O;
        if (r < I_Q) { transpose_item(FIN(F, I_MWQ) + (size_t)l * D * 512, D, 512, (bf16_t*)(ws + W_MQ), MapId{0}, FIN(F, I_NORM_MEM) + l * D, scr, r, F.lane); continue; } r -= I_Q;
        if (r < I_B) { transpose_item(FIN(F, I_MWO) + (size_t)l * 512 * D, 512, D, (bf16_t*)(ws + W_MO), MapId{0}, nullptr, scr, r, F.lane); continue; } r -= I_B;
        if (r < nrw) {
            if (r < I_R2) { transpose_item(FIN(F, I_W2) + (size_t)l * 64 * 512, 64, 512, (bf16_t*)(ws + W_RW2), MapId{0}, nullptr, scr, r, F.lane); continue; } r -= I_R2;
            if (r < I_R2) { transpose_item(FIN(F, I_A2) + (size_t)l * 64 * 512, 64, 512, (bf16_t*)(ws + W_RA2), MapId{0}, nullptr, scr, r, F.lane); continue; } r -= I_R2;
            if (r < I_RG) { transpose_item(FIN(F, I_G2) + (size_t)l * 128 * 512, 128, 512, (bf16_t*)(ws + W_RG2), MapId{0}, nullptr, scr, r, F.lane); continue; } r -= I_RG;
            if (r < I_RV1) { transpose_item(FIN(F, I_V1) + (size_t)(l - 1) * 512 * 32, 512, 32, (bf16_t*)(ws + W_RV1), MapId{0}, nullptr, scr, r, F.lane); continue; } r -= I_RV1;
            transpose_item(FIN(F, I_V2) + (size_t)(l - 1) * 32 * 512, 32, 512, (bf16_t*)(ws + W_RV2), MapId{0}, nullptr, scr, r, F.lane); continue;
        }
        r -= nrw;
        if (!moe) {
            if (r < I_FG) { transpose_item(FIN(F, I_FWG) + (size_t)j * D * FFN, D, FFN, (bf16_t*)(ws + W_FGU), MapGU{0}, gffn, scr, r, F.lane); continue; } r -= I_FG;
            if (r < I_FG) { transpose_item(FIN(F, I_FWU) + (size_t)j * D * FFN, D, FFN, (bf16_t*)(ws + W_FGU), MapGU{1}, gffn, scr, r, F.lane); continue; } r -= I_FG;
            transpose_item(FIN(F, I_FWD) + (size_t)j * FFN * D, FFN, D, (bf16_t*)(ws + W_FD), MapId{0}, nullptr, scr, r, F.lane);
        } else {
            const int per = 2 * I_EG + I_EDN, e = r / per; r -= e * per;
            const size_t eo = (size_t)(j * NEXP + e);
            if (r < I_EG) { transpose_item(FIN(F, I_EWG) + eo * D * EDIM, D, EDIM, (bf16_t*)(ws + W_EGU) + (size_t)e * 2 * EDIM * D, MapGU{0}, gffn, scr, r, F.lane); continue; } r -= I_EG;
            if (r < I_EG) { transpose_item(FIN(F, I_EWU) + eo * D * EDIM, D, EDIM, (bf16_t*)(ws + W_EGU) + (size_t)e * 2 * EDIM * D, MapGU{1}, gffn, scr, r, F.lane); continue; } r -= I_EG;
            transpose_item(FIN(F, I_EWD) + eo * EDIM * D, EDIM, D, (bf16_t*)(ws + W_ED) + (size_t)e * D * EDIM, MapId{0}, nullptr, scr, r, F.lane);
        }
    }
    { u32x4* z = (u32x4*)((bf16_t*)(ws + W_IN) + (size_t)3016 * D); const int n16 = 56 * D * 2 / 16;
      for (int i = F.bid * NTHR + F.tid; i < n16; i += F.G * NTHR) z[i] = (u32x4){0u, 0u, 0u, 0u}; }
    bf16_t* hn = (bf16_t*)(ws + WS_HN);
    for (int m = gw; m < T; m += NGW) { f32x4 v[4]; rms_row_to_bf16(xin + (size_t)m * D, hn + (size_t)m * D, F.lane, v); }
}
__device__ __forceinline__ void ph_norm(Frame& F) {
    const int gw = F.bid * NWAVES + F.wave, NGW = F.G * NWAVES;
    bf16_t* hn = (bf16_t*)(F.ws + WS_HN);
    for (int m = gw; m < T; m += NGW) { f32x4 v[4]; rms_row_to_bf16(F.out + (size_t)m * D, hn + (size_t)m * D, F.lane, v); }
}
__device__ __forceinline__ void ph_norm_ffn(Frame& F, int l) {
    const int gw = F.bid * NWAVES + F.wave, NGW = F.G * NWAVES;
    bf16_t* hn = (bf16_t*)(F.ws + WS_HN);
    const bool moe = (l & 1) != 0; const int j = l >> 1;
    const float* gn = FIN(F, I_NORM_FFN) + l * D;
    const float* rt = FIN(F, I_ROUTER) + (size_t)j * D * NEXP; const float* rb = FIN(F, I_RBIAS) + j * NEXP;
    unsigned short* sele = (unsigned short*)(F.ws + MOE_SELE); f32x2* selw = (f32x2*)(F.ws + MOE_SELW);
    for (int m = gw; m < T; m += NGW) {
        f32x4 v[4]; rms_row_to_bf16(F.out + (size_t)m * D, hn + (size_t)m * D, F.lane, v);
        if (moe) {
            float lg[8];
#pragma unroll
            for (int e = 0; e < 8; ++e) lg[e] = 0.f;
#pragma unroll
            for (int q = 0; q < 4; ++q)
#pragma unroll
                for (int c = 0; c < 4; ++c) { const int k = 256 * q + 4 * F.lane + c; const float h = v[q][c] * gn[k];
                    const f32x4 r0 = *(const f32x4*)(rt + (size_t)k * 8), r1 = *(const f32x4*)(rt + (size_t)k * 8 + 4);
                    lg[0] += h * r0.x; lg[1] += h * r0.y; lg[2] += h * r0.z; lg[3] += h * r0.w; lg[4] += h * r1.x; lg[5] += h * r1.y; lg[6] += h * r1.z; lg[7] += h * r1.w; }
#pragma unroll
            for (int e = 0; e < 8; ++e) lg[e] = wave_sum(lg[e]) + rb[e];
            int e0 = 0; float l0 = lg[0];
#pragma unroll
            for (int e = 1; e < 8; ++e) if (lg[e] > l0) { l0 = lg[e]; e0 = e; }
            int e1 = -1; float l1 = -3.0e38f;
#pragma unroll
            for (int e = 0; e < 8; ++e) if (e != e0 && lg[e] > l1) { l1 = lg[e]; e1 = e; }
            const float w1 = 1.0f / (1.0f + expf(l0 - l1)), w0 = 1.0f - w1;
            if (F.lane == 0) { sele[m] = (unsigned short)(e0 | (e1 << 8)); selw[m] = (f32x2){w0, w1}; }
        }
    }
}

#define MFMA16(x, y, c) __builtin_amdgcn_mfma_f32_16x16x32_bf16((x), (y), (c), 0, 0, 0)
__device__ __forceinline__ float softplusf_(float x) { return fmaxf(x, 0.f) + log1pf(expf(-fabsf(x))); }
typedef __attribute__((address_space(3))) bf16_t lbf;
constexpr int LDP = 72;
constexpr int SLOT = 64 * LDP * 2;
__device__ __forceinline__ f32x4 unpack4(u32x2 u) { return (f32x4){bf_lo(u.x), bf_hi(u.x), bf_lo(u.y), bf_hi(u.y)}; }
__device__ __forceinline__ u32x2 pack4(f32x4 v) { u32x2 o; o.x = pk2(v[0], v[1]); o.y = pk2(v[2], v[3]); return o; }
__device__ __forceinline__ void mm64(const lbf* X, const lbf* Y, int w, int jl, int g, f32x4 (&acc)[2]) {
    const lbf* xr = X + (16 * (w & 3) + jl) * LDP + 8 * g;
    const bf16x8 x0 = *(const LAS bf16x8*)xr, x1 = *(const LAS bf16x8*)(xr + 32);
#pragma unroll
    for (int i = 0; i < 2; ++i) { const lbf* yr = Y + (16 * (2 * (w >> 2) + i) + jl) * LDP + 8 * g;
        const bf16x8 y0 = *(const LAS bf16x8*)yr, y1 = *(const LAS bf16x8*)(yr + 32);
        acc[i] = MFMA16(x0, y0, acc[i]); acc[i] = MFMA16(x1, y1, acc[i]); }
}
__device__ __forceinline__ void st_t(lbf* dst, const f32x4 (&acc)[2], int w, int jl, int g) {
#pragma unroll
    for (int i = 0; i < 2; ++i) *(LAS u32x2*)(dst + (16 * (2 * (w >> 2) + i) + jl) * LDP + 16 * (w & 3) + 4 * g) = pack4(acc[i]);
}
__device__ __forceinline__ void st_n(lbf* dst, const f32x4 (&acc)[2], int w, int jl, int g) {
#pragma unroll
    for (int i = 0; i < 2; ++i)
#pragma unroll
        for (int r = 0; r < 4; ++r) dst[(16 * (w & 3) + 4 * g + r) * LDP + 16 * (2 * (w >> 2) + i) + jl] = f2bf(acc[i][r]);
}
#define ZACC(a) do { a[0] = (f32x4){0.f, 0.f, 0.f, 0.f}; a[1] = (f32x4){0.f, 0.f, 0.f, 0.f}; } while (0)

constexpr int XA_LD = 264, XV_LD = 520, VM_LD = 40;
__device__ __forceinline__ void ph_rwkv_prep(Frame& F, int l, int half) {
    lbf* XA = (lbf*)F.lds;
    lbf* XV = (lbf*)(F.lds + 64 * XA_LD * 2);
    lbf* VM = (lbf*)(F.lds + 64 * XA_LD * 2 + 64 * XV_LD * 2);
    const bf16_t* CA = (const bf16_t*)(F.ws + MX_CA);
    bf16_t* RW = (bf16_t*)(F.ws + MX_RW); constexpr size_t AS_ = (size_t)TH * 512;
    bf16_t* VF = (bf16_t*)(F.ws + WS_VFIRST) + (size_t)half * TH * 512;
    const bf16_t* W2T = (const bf16_t*)(F.ws + W_RW2); const bf16_t* A2T = (const bf16_t*)(F.ws + W_RA2); const bf16_t* G2T = (const bf16_t*)(F.ws + W_RG2);
    const bf16_t* V1T = (const bf16_t*)(F.ws + W_RV1); const bf16_t* V2T = (const bf16_t*)(F.ws + W_RV2);
    const float* mu = FIN(F, I_MU) + l * RW_COLS;
    const int lane = F.lane, w = F.wave, jl = lane & 15, g = lane >> 4;
    for (int tile = F.bid; tile < TH / 64; tile += F.G) {
        const int t0 = tile * 64;
        __syncthreads();
        for (int it = F.tid; it < 64 * 32; it += NTHR) { const int i = it >> 5, c = 1536 + (it & 31) * 8; const int t = t0 + i;
            const u32x4 cu = *(const u32x4*)(CA + (size_t)t * RW_COLS + c);
            u32x4 pv = (u32x4){0u, 0u, 0u, 0u}; if ((t & (SEQ - 1)) != 0) pv = *(const u32x4*)(CA + (size_t)(t - 1) * RW_COLS + c);
            const float cv[8] = { bf_lo(cu.x), bf_hi(cu.x), bf_lo(cu.y), bf_hi(cu.y), bf_lo(cu.z), bf_hi(cu.z), bf_lo(cu.w), bf_hi(cu.w) };
            const float pp[8] = { bf_lo(pv.x), bf_hi(pv.x), bf_lo(pv.y), bf_hi(pv.y), bf_lo(pv.z), bf_hi(pv.z), bf_lo(pv.w), bf_hi(pv.w) };
            float x[8];
#pragma unroll
            for (int q = 0; q < 8; ++q) { x[q] = cv[q] + (pp[q] - cv[q]) * mu[c + q]; if (c < 1600) x[q] = tanhf(x[q]); else if (c >= 1664) x[q] = sigmoidf_(x[q]); }
            u32x4 o; o.x = pk2(x[0], x[1]); o.y = pk2(x[2], x[3]); o.z = pk2(x[4], x[5]); o.w = pk2(x[6], x[7]);
            *(LAS u32x4*)(XA + i * XA_LD + (c - 1536)) = o; }
        if (l) for (int it = F.tid; it < 64 * 64; it += NTHR) { const int i = it >> 6, c = 1024 + (it & 63) * 8; const int t = t0 + i;
            const u32x4 cu = *(const u32x4*)(CA + (size_t)t * RW_COLS + c);
            u32x4 pv = (u32x4){0u, 0u, 0u, 0u}; if ((t & (SEQ - 1)) != 0) pv = *(const u32x4*)(CA + (size_t)(t - 1) * RW_COLS + c);
            const float cv[8] = { bf_lo(cu.x), bf_hi(cu.x), bf_lo(cu.y), bf_hi(cu.y), bf_lo(cu.z), bf_hi(cu.z), bf_lo(cu.w), bf_hi(cu.w) };
            const float pp[8] = { bf_lo(pv.x), bf_hi(pv.x), bf_lo(pv.y), bf_hi(pv.y), bf_lo(pv.z), bf_hi(pv.z), bf_lo(pv.w), bf_hi(pv.w) };
            float x[8];
#pragma unroll
            for (int q = 0; q < 8; ++q) x[q] = cv[q] + (pp[q] - cv[q]) * mu[c + q];
            u32x4 o; o.x = pk2(x[0], x[1]); o.y = pk2(x[2], x[3]); o.z = pk2(x[4], x[5]); o.w = pk2(x[6], x[7]);
            *(LAS u32x4*)(XV + i * XV_LD + (c - 1024)) = o; }
        __syncthreads();
        if (l) { const int tg = w & 3, nt = w >> 2; f32x4 a = (f32x4){0.f, 0.f, 0.f, 0.f};
            const bf16_t* xr = V1T + (size_t)(16 * nt + jl) * 512 + 8 * g; const lbf* yr = XV + (16 * tg + jl) * XV_LD + 8 * g;
#pragma unroll 4
            for (int s = 0; s < 16; ++s) a = MFMA16(*(const bf16x8*)(xr + 32 * s), *(const LAS bf16x8*)(yr + 32 * s), a);
            *(LAS u32x2*)(VM + (16 * tg + jl) * VM_LD + 16 * nt + 4 * g) = pack4(a); }
        __syncthreads();
#pragma unroll 1
        for (int tg = 0; tg < 4; ++tg) {
            const int tl = 16 * tg + jl, t = t0 + tl;
            const lbf* ya = XA + tl * XA_LD + 8 * g;
            f32x4 kkv[4]; float kss = 0.f;
#pragma unroll
            for (int nt = 0; nt < 4; ++nt) {
                const int n0 = 64 * w + 16 * nt;
                f32x4 aw = (f32x4){0.f, 0.f, 0.f, 0.f}, aa = aw, ag = aw, am = aw;
                { const bf16_t* xw = W2T + (size_t)(n0 + jl) * 64 + 8 * g; const bf16_t* xa = A2T + (size_t)(n0 + jl) * 64 + 8 * g; const bf16_t* xg = G2T + (size_t)(n0 + jl) * 128 + 8 * g;
#pragma unroll
                  for (int s = 0; s < 2; ++s) { aw = MFMA16(*(const bf16x8*)(xw + 32 * s), *(const LAS bf16x8*)(ya + 32 * s), aw); aa = MFMA16(*(const bf16x8*)(xa + 32 * s), *(const LAS bf16x8*)(ya + 64 + 32 * s), aa); }
#pragma unroll
                  for (int s = 0; s < 4; ++s) ag = MFMA16(*(const bf16x8*)(xg + 32 * s), *(const LAS bf16x8*)(ya + 128 + 32 * s), ag);
                  if (l) am = MFMA16(*(const bf16x8*)(V2T + (size_t)(n0 + jl) * 32 + 8 * g), *(const LAS bf16x8*)(VM + tl * VM_LD + 8 * g), am); }
                const int n = n0 + 4 * g;
                const bf16_t* crow = CA + (size_t)t * RW_COLS + n; const bool hp = (t & (SEQ - 1)) != 0;
                f32x4 rc = unpack4(*(const u32x2*)crow), kc = unpack4(*(const u32x2*)(crow + 512)), vc = unpack4(*(const u32x2*)(crow + 1024));
                f32x4 rp = (f32x4){0.f, 0.f, 0.f, 0.f}, kp = rp, vp = rp;
                if (hp) { rp = unpack4(*(const u32x2*)(crow - RW_COLS)); kp = unpack4(*(const u32x2*)(crow - RW_COLS + 512)); vp = unpack4(*(const u32x2*)(crow - RW_COLS + 1024)); }
                const f32x4 mr = *(const f32x4*)(mu + n), mk = *(const f32x4*)(mu + 512 + n), mv = *(const f32x4*)(mu + 1024 + n);
                const f32x4 r4 = rc + (rp - rc) * mr, k4 = kc + (kp - kc) * mk; f32x4 v4 = vc + (vp - vc) * mv;
                const f32x4 w0 = *(const f32x4*)(FIN(F, I_W0) + l * 512 + n), a0 = *(const f32x4*)(FIN(F, I_A0) + l * 512 + n), kkw = *(const f32x4*)(FIN(F, I_KK) + l * 512 + n), ka = *(const f32x4*)(FIN(F, I_KA) + l * 512 + n);
                const size_t o = (size_t)t * 512 + n;
                if (l) { const f32x4 v0 = *(const f32x4*)(FIN(F, I_V0) + (l - 1) * 512 + n); const f32x4 vf = unpack4(*(const u32x2*)(VF + o));
#pragma unroll
                    for (int q = 0; q < 4; ++q) v4[q] = v4[q] + (vf[q] - v4[q]) * sigmoidf_(v0[q] + am[q]); }
                else *(u32x2*)(VF + o) = pack4(v4);
                f32x4 e4, as4, k24;
#pragma unroll
                for (int q = 0; q < 4; ++q) { const float a = sigmoidf_(a0[q] + aa[q]); as4[q] = a; k24[q] = k4[q] * (1.0f + (a - 1.0f) * ka[q]);
                    e4[q] = expf(-softplusf_(-(w0[q] + aw[q])) - 0.5f); const float kk = k4[q] * kkw[q]; kkv[nt][q] = kk; kss += kk * kk; }
                *(u32x2*)(RW + 0 * AS_ + o) = pack4(r4); *(u32x2*)(RW + 1 * AS_ + o) = pack4(e4); *(u32x2*)(RW + 2 * AS_ + o) = pack4(k24); *(u32x2*)(RW + 3 * AS_ + o) = pack4(v4);
                *(u32x2*)(RW + 5 * AS_ + o) = pack4(as4); *(u32x2*)(RW + 6 * AS_ + o) = pack4(ag);
            }
            kss += __shfl_xor(kss, 16); kss += __shfl_xor(kss, 32);
            const float inv = 1.0f / fmaxf(sqrtf(kss), 1e-12f);
#pragma unroll
            for (int nt = 0; nt < 4; ++nt) *(u32x2*)(RW + 4 * AS_ + (size_t)t * 512 + 64 * w + 16 * nt + 4 * g) = pack4(kkv[nt] * inv);
        }
    }
}

__device__ __forceinline__ void ph_rwkv_s1(Frame& F) {
    bf16_t* RW = (bf16_t*)(F.ws + MX_RW); constexpr size_t AS_ = (size_t)TH * 512;
    bf16_t* YH = (bf16_t*)(F.ws + MX_CA);
    LAS unsigned char* L = F.lds;
#define SL(i) ((lbf*)(L + (i) * SLOT))
    lbf *AT = SL(0), *BT = SL(1), *KT = SL(2), *RT = SL(3), *ATt = SL(4), *Vt = SL(5), *BPt = SL(6), *KPt = SL(7), *AAK = SL(10), *ARB = SL(11), *ARK = SL(12);
    LAS float* EL = (LAS float*)(L + 8 * SLOT);
    LAS float* SEGT = (LAS float*)(L + 10 * SLOT);
    LAS float* PC = (LAS float*)(L + 16 * SLOT);
    const int lane = F.lane, w = F.wave, jl = lane & 15, g = lane >> 4;
    const int tok = F.tid >> 3, cg = F.tid & 7;
    for (int u = F.bid; u < (TH / 64) * 8; u += F.G) {
        const int h = u & 7, ch = u >> 3, t0 = ch * 64;
        const size_t tb = (size_t)(t0 + tok) * 512 + h * 64 + 8 * cg;
        const u32x4 ur = *(const u32x4*)(RW + 0 * AS_ + tb), ue = *(const u32x4*)(RW + 1 * AS_ + tb), uk = *(const u32x4*)(RW + 2 * AS_ + tb), uv = *(const u32x4*)(RW + 3 * AS_ + tb),
                    ukk = *(const u32x4*)(RW + 4 * AS_ + tb), uas = *(const u32x4*)(RW + 5 * AS_ + tb);
        const float e8[8] = { bf_lo(ue.x), bf_hi(ue.x), bf_lo(ue.y), bf_hi(ue.y), bf_lo(ue.z), bf_hi(ue.z), bf_lo(ue.w), bf_hi(ue.w) };
#pragma unroll
        for (int i = 0; i < 8; ++i) EL[tok * 65 + 8 * cg + i] = e8[i];
        __syncthreads();
        { const int col = F.tid & 63, seg = F.tid >> 6; float p[8]; float run = 0.f;
#pragma unroll
          for (int i = 0; i < 8; ++i) { run += EL[(8 * seg + i) * 65 + col]; p[i] = run; }
          SEGT[seg * 64 + col] = run;
          __syncthreads();
          float off = 0.f; for (int s = 0; s < seg; ++s) off += SEGT[s * 64 + col];
#pragma unroll
          for (int i = 0; i < 8; ++i) EL[(8 * seg + i) * 65 + col] = -(off + p[i]); }
        __syncthreads();
        {
            const float r8[8] = { bf_lo(ur.x), bf_hi(ur.x), bf_lo(ur.y), bf_hi(ur.y), bf_lo(ur.z), bf_hi(ur.z), bf_lo(ur.w), bf_hi(ur.w) };
            const float k8[8] = { bf_lo(uk.x), bf_hi(uk.x), bf_lo(uk.y), bf_hi(uk.y), bf_lo(uk.z), bf_hi(uk.z), bf_lo(uk.w), bf_hi(uk.w) };
            const float kk8[8] = { bf_lo(ukk.x), bf_hi(ukk.x), bf_lo(ukk.y), bf_hi(ukk.y), bf_lo(ukk.z), bf_hi(ukk.z), bf_lo(ukk.w), bf_hi(ukk.w) };
            const float as8[8] = { bf_lo(uas.x), bf_hi(uas.x), bf_lo(uas.y), bf_hi(uas.y), bf_lo(uas.z), bf_hi(uas.z), bf_lo(uas.w), bf_hi(uas.w) };
            const unsigned short v8[8] = { (unsigned short)(uv.x & 0xffffu), (unsigned short)(uv.x >> 16), (unsigned short)(uv.y & 0xffffu), (unsigned short)(uv.y >> 16),
                                           (unsigned short)(uv.z & 0xffffu), (unsigned short)(uv.z >> 16), (unsigned short)(uv.w & 0xffffu), (unsigned short)(uv.w >> 16) };
            float at[8], bt[8], kt[8], rt[8], bp[8], kp[8];
#pragma unroll
            for (int i = 0; i < 8; ++i) { const float cl = EL[tok * 65 + 8 * cg + i], pc = __expf(EL[63 * 65 + 8 * cg + i]);
                const float ecl = __expf(cl), eicl = __expf(-cl);
                at[i] = -kk8[i] * __expf(cl + e8[i]); bt[i] = kk8[i] * as8[i] * eicl; kt[i] = k8[i] * eicl; rt[i] = r8[i] * ecl; bp[i] = bt[i] * pc; kp[i] = kt[i] * pc;
                if (tok == 0) PC[8 * cg + i] = pc; }
            u32x4 o;
            o.x = pk2(at[0], at[1]); o.y = pk2(at[2], at[3]); o.z = pk2(at[4], at[5]); o.w = pk2(at[6], at[7]); *(LAS u32x4*)(AT + tok * LDP + 8 * cg) = o;
            o.x = pk2(bt[0], bt[1]); o.y = pk2(bt[2], bt[3]); o.z = pk2(bt[4], bt[5]); o.w = pk2(bt[6], bt[7]); *(LAS u32x4*)(BT + tok * LDP + 8 * cg) = o;
            o.x = pk2(kt[0], kt[1]); o.y = pk2(kt[2], kt[3]); o.z = pk2(kt[4], kt[5]); o.w = pk2(kt[6], kt[7]); *(LAS u32x4*)(KT + tok * LDP + 8 * cg) = o;
            o.x = pk2(rt[0], rt[1]); o.y = pk2(rt[2], rt[3]); o.z = pk2(rt[4], rt[5]); o.w = pk2(rt[6], rt[7]); *(LAS u32x4*)(RT + tok * LDP + 8 * cg) = o;
#pragma unroll
            for (int i = 0; i < 8; ++i) { const int c = 8 * cg + i; ATt[c * LDP + tok] = f2bf(at[i]); Vt[c * LDP + tok] = v8[i]; BPt[c * LDP + tok] = f2bf(bp[i]); KPt[c * LDP + tok] = f2bf(kp[i]); }
        }
        __syncthreads();
        {
            f32x4 a[2];
            const int s0 = 16 * (w & 3) + 4 * g;
            ZACC(a); mm64(BT, AT, w, jl, g, a);
#pragma unroll
            for (int i = 0; i < 2; ++i) { const int t = 16 * (2 * (w >> 2) + i) + jl;
#pragma unroll
                for (int r = 0; r < 4; ++r) if (!(s0 + r < t)) a[i][r] = 0.f; }
            st_t(SL(8), a, w, jl, g); st_n(SL(9), a, w, jl, g);
            { f32x4 b[2] = { a[0], a[1] };
#pragma unroll
              for (int i = 0; i < 2; ++i) { const int t = 16 * (2 * (w >> 2) + i) + jl;
#pragma unroll
                  for (int r = 0; r < 4; ++r) if (s0 + r == t) b[i][r] = 1.0f; }
              st_t(SL(13), b, w, jl, g); st_n(SL(14), b, w, jl, g); }
            ZACC(a); mm64(KT, AT, w, jl, g, a);
#pragma unroll
            for (int i = 0; i < 2; ++i) { const int t = 16 * (2 * (w >> 2) + i) + jl;
#pragma unroll
                for (int r = 0; r < 4; ++r) if (!(s0 + r < t)) a[i][r] = 0.f; }
            st_t(AAK, a, w, jl, g);
            ZACC(a); mm64(BT, RT, w, jl, g, a);
#pragma unroll
            for (int i = 0; i < 2; ++i) { const int t = 16 * (2 * (w >> 2) + i) + jl;
#pragma unroll
                for (int r = 0; r < 4; ++r) if (!(s0 + r <= t)) a[i][r] = 0.f; }
            st_t(ARB, a, w, jl, g);
            ZACC(a); mm64(KT, RT, w, jl, g, a);
#pragma unroll
            for (int i = 0; i < 2; ++i) { const int t = 16 * (2 * (w >> 2) + i) + jl;
#pragma unroll
                for (int r = 0; r < 4; ++r) if (!(s0 + r <= t)) a[i][r] = 0.f; }
            st_t(ARK, a, w, jl, g);
        }
        __syncthreads();
#define NEU_B(srcB, srcBt, dstB, dstBt) do { f32x4 a[2]; ZACC(a); mm64(SL(srcB), SL(srcBt), w, jl, g, a); st_t(SL(dstBt), a, w, jl, g); st_n(SL(dstB), a, w, jl, g); } while (0)
#define NEU_T(srcT, srcTt, srcBt, dstT, dstTt, last) do { f32x4 a[2]; \
            _Pragma("unroll") for (int i = 0; i < 2; ++i) a[i] = unpack4(*(const LAS u32x2*)(SL(srcTt) + (16 * (2 * (w >> 2) + i) + jl) * LDP + 16 * (w & 3) + 4 * g)); \
            mm64(SL(srcT), SL(srcBt), w, jl, g, a); if (!(last)) st_t(SL(dstTt), a, w, jl, g); st_n(SL(dstT), a, w, jl, g); } while (0)
        NEU_B(8, 9, 0, 1);                                   __syncthreads();
        NEU_T(13, 14, 1, 15, 2, false); NEU_B(0, 1, 8, 9);   __syncthreads();
        NEU_T(15, 2, 9, 13, 14, false); NEU_B(8, 9, 0, 1);   __syncthreads();
        NEU_T(13, 14, 1, 15, 2, false); NEU_B(0, 1, 8, 9);   __syncthreads();
        NEU_T(15, 2, 9, 13, 14, false); NEU_B(8, 9, 0, 1);   __syncthreads();
        NEU_T(13, 14, 1, 15, 2, true);                       __syncthreads();
        lbf* TI = SL(15); lbf* Wt = SL(8); lbf* Xt = SL(9); lbf* Ut = SL(0);
        { f32x4 a[2]; ZACC(a); mm64(TI, ATt, w, jl, g, a); st_t(Wt, a, w, jl, g);
          ZACC(a); mm64(AAK, Vt, w, jl, g, a); st_t(Xt, a, w, jl, g); }
        __syncthreads();
        {
            f32x4 a[2];
            ZACC(a); mm64(TI, Xt, w, jl, g, a); st_t(Ut, a, w, jl, g);
            ZACC(a); mm64(Wt, ARB, w, jl, g, a);
#pragma unroll
            for (int i = 0; i < 2; ++i) { const int t = 16 * (2 * (w >> 2) + i) + jl, k0 = 16 * (w & 3) + 4 * g;
                const f32x4 rr = unpack4(*(const LAS u32x2*)(RT + t * LDP + k0));
                *(u32x2*)(RW + 5 * AS_ + (size_t)(t0 + t) * 512 + h * 64 + k0) = pack4(a[i] + rr); }
            ZACC(a); mm64(Wt, BPt, w, jl, g, a);
#pragma unroll
            for (int i = 0; i < 2; ++i) { const int k = 16 * (2 * (w >> 2) + i) + jl, kp0 = 16 * (w & 3) + 4 * g; const float pc = PC[k];
#pragma unroll
                for (int r = 0; r < 4; ++r) if (kp0 + r == k) a[i][r] += pc;
                *(u32x2*)(RW + 4 * AS_ + (size_t)(t0 + k) * 512 + h * 64 + kp0) = pack4(a[i]); }
        }
        __syncthreads();
        {
            f32x4 a[2];
            ZACC(a); mm64(Ut, ARB, w, jl, g, a); mm64(Vt, ARK, w, jl, g, a);
#pragma unroll
            for (int i = 0; i < 2; ++i) { const int t = 16 * (2 * (w >> 2) + i) + jl, v0 = 16 * (w & 3) + 4 * g;
                *(u32x2*)(YH + (size_t)(t0 + t) * 512 + h * 64 + v0) = pack4(a[i]); }
            ZACC(a); mm64(BPt, Ut, w, jl, g, a); mm64(KPt, Vt, w, jl, g, a);
#pragma unroll
            for (int i = 0; i < 2; ++i) { const int v = 16 * (2 * (w >> 2) + i) + jl, k0 = 16 * (w & 3) + 4 * g;
                *(u32x2*)(RW + 1 * AS_ + (size_t)(t0 + v) * 512 + h * 64 + k0) = pack4(a[i]); }
        }
    }
#undef SL
#undef NEU_B
#undef NEU_T
}

__device__ __forceinline__ void ph_rwkv_s2(Frame& F, int l, int pair) {
    const int bl = pair >> 3, h = pair & 7;
    const bf16_t* RW = (const bf16_t*)(F.ws + MX_RW); constexpr size_t AS_ = (size_t)TH * 512;
    const bf16_t* YH = (const bf16_t*)(F.ws + MX_CA); bf16_t* YA = (bf16_t*)(F.ws + MX_CA) + AS_;
    lbf* HT = (lbf*)F.lds;
    const int lane = F.lane, w = F.wave, jl = lane & 15, g = lane >> 4;
    __syncthreads();
    for (int i = F.tid; i < 64 * LDP / 2; i += NTHR) ((LAS unsigned*)HT)[i] = 0u;
    __syncthreads();
    if (w < 4) {
        for (int c = 0; c < SEQ / 64; ++c) {
            const size_t rb = (size_t)(bl * SEQ + c * 64) * 512 + h * 64;
            const bf16_t* mrow = RW + 4 * AS_ + rb + (size_t)(16 * w + jl) * 512 + 8 * g;
            const bf16x8 m0 = *(const bf16x8*)mrow, m1 = *(const bf16x8*)(mrow + 32);
            f32x4 a[4];
#pragma unroll
            for (int yt = 0; yt < 4; ++yt) a[yt] = unpack4(*(const u32x2*)(RW + 1 * AS_ + rb + (size_t)(16 * yt + jl) * 512 + 16 * w + 4 * g));
#pragma unroll
            for (int yt = 0; yt < 4; ++yt) { const lbf* yr = HT + (16 * yt + jl) * LDP + 8 * g;
                a[yt] = MFMA16(m0, *(const LAS bf16x8*)yr, a[yt]); a[yt] = MFMA16(m1, *(const LAS bf16x8*)(yr + 32), a[yt]); }
            __syncthreads();
#pragma unroll
            for (int yt = 0; yt < 4; ++yt) *(LAS u32x2*)(HT + (16 * yt + jl) * LDP + 16 * w + 4 * g) = pack4(a[yt]);
            __syncthreads();
        }
    } else {
        const int wt = w - 4;
        f32x4 rk[4], lg[4], lb[4];
#pragma unroll
        for (int xt = 0; xt < 4; ++xt) { const int v0 = h * 64 + 16 * xt + 4 * g; rk[xt] = *(const f32x4*)(FIN(F, I_RK) + l * 512 + v0); lg[xt] = *(const f32x4*)(FIN(F, I_LNG) + l * 512 + v0); lb[xt] = *(const f32x4*)(FIN(F, I_LNB) + l * 512 + v0); }
        for (int c = 0; c < SEQ / 64; ++c) {
            const size_t rb = (size_t)(bl * SEQ + c * 64 + 16 * wt + jl) * 512 + h * 64;
            const bf16x8 r0 = *(const bf16x8*)(RW + 5 * AS_ + rb + 8 * g), r1 = *(const bf16x8*)(RW + 5 * AS_ + rb + 32 + 8 * g);
            f32x4 a[4];
#pragma unroll
            for (int xt = 0; xt < 4; ++xt) a[xt] = unpack4(*(const u32x2*)(YH + rb + 16 * xt + 4 * g));
#pragma unroll
            for (int xt = 0; xt < 4; ++xt) { const lbf* xr = HT + (16 * xt + jl) * LDP + 8 * g;
                a[xt] = MFMA16(*(const LAS bf16x8*)xr, r0, a[xt]); a[xt] = MFMA16(*(const LAS bf16x8*)(xr + 32), r1, a[xt]); }
            __syncthreads();
            float s = 0.f, bs = 0.f; f32x4 vv[4], gg[4];
#pragma unroll
            for (int xt = 0; xt < 4; ++xt) { const f32x4 rr = unpack4(*(const u32x2*)(RW + 0 * AS_ + rb + 16 * xt + 4 * g)), kk = unpack4(*(const u32x2*)(RW + 2 * AS_ + rb + 16 * xt + 4 * g));
                vv[xt] = unpack4(*(const u32x2*)(RW + 3 * AS_ + rb + 16 * xt + 4 * g)); gg[xt] = unpack4(*(const u32x2*)(RW + 6 * AS_ + rb + 16 * xt + 4 * g));
#pragma unroll
                for (int r = 0; r < 4; ++r) { s += a[xt][r]; bs += rr[r] * kk[r] * rk[xt][r]; } }
            s += __shfl_xor(s, 16); s += __shfl_xor(s, 32); bs += __shfl_xor(bs, 16); bs += __shfl_xor(bs, 32);
            const float mean = s * (1.f / 64.f); float q = 0.f;
#pragma unroll
            for (int xt = 0; xt < 4; ++xt)
#pragma unroll
                for (int r = 0; r < 4; ++r) { const float d = a[xt][r] - mean; q += d * d; }
            q += __shfl_xor(q, 16); q += __shfl_xor(q, 32);
            const float rstd = 1.0f / sqrtf(q * (1.f / 64.f) + 64e-5f);
#pragma unroll
            for (int xt = 0; xt < 4; ++xt) { f32x4 o;
#pragma unroll
                for (int r = 0; r < 4; ++r) o[r] = ((a[xt][r] - mean) * rstd * lg[xt][r] + lb[xt][r] + bs * vv[xt][r]) * gg[xt][r];
                *(u32x2*)(YA + rb + 16 * xt + 4 * g) = pack4(o); }
            __syncthreads();
        }
    }
}

__device__ __forceinline__ float rope_vec(float x, float cs, float sn, int lane) {
    const float p = __shfl_xor(x, 32);
    return lane < 32 ? x * cs - p * sn : x * cs + p * sn;
}
__device__ __forceinline__ void ph_dsa_prep(Frame& F, int l, int half) {
    bf16_t* CB = (bf16_t*)(F.ws + MX_CB); bf16_t* VT = (bf16_t*)(F.ws + MX_VT);
    const int* pos = (const int*)KARGP(F, I_POS) + (size_t)half * TH;
    const int d = F.lane, w = F.wave;
    const float invf = 1.0f / powf(10000.0f, (float)(2 * (d & 31)) / 64.0f);
    const float gq = FIN(F, I_QN)[l * 64 + d], gk = FIN(F, I_KN)[l * 64 + d], gik = FIN(F, I_IKN)[l * 64 + d];
    for (int t = F.bid; t < TH; t += F.G) {
        const float ang = (float)pos[t] * invf; float sn, cs; sincosf(ang, &sn, &cs);
        bf16_t* row = CB + (size_t)t * DS_PAD;
        { float x = bf2f(row[w * 64 + d]); const float rstd = 1.0f / sqrtf(wave_sum(x * x) * (1.f / 64.f) + 1e-6f); x = x * rstd * gq; row[w * 64 + d] = f2bf(rope_vec(x, cs, sn, d)); }
        { const float x = bf2f(row[640 + w * 64 + d]); row[640 + w * 64 + d] = f2bf(rope_vec(x, cs, sn, d)); }
        if (w == 0) { float x = bf2f(row[512 + d]); const float rstd = 1.0f / sqrtf(wave_sum(x * x) * (1.f / 64.f) + 1e-6f); x = x * rstd * gk; row[512 + d] = f2bf(rope_vec(x, cs, sn, d)); }
        if (w == 1) { float x = bf2f(row[1152 + d]); const float rstd = 1.0f / sqrtf(wave_sum(x * x) * (1.f / 64.f) + 1e-6f); x = x * rstd * gik; row[1152 + d] = f2bf(rope_vec(x, cs, sn, d)); }
        if (w == 2) { VT[((size_t)(t >> 11) * 64 + d) * SEQ + (t & (SEQ - 1))] = row[576 + d]; }
    }
}

constexpr int SC_LD = 2052;
__device__ __forceinline__ void lds_inc(LAS unsigned* p) { (void)__hip_atomic_fetch_add(p, 1u, __ATOMIC_RELAXED, __HIP_MEMORY_SCOPE_WORKGROUP); }
__device__ __forceinline__ unsigned okey(float s) { const unsigned u = __builtin_bit_cast(unsigned, s); return (u & 0x80000000u) ? ~u : (u | 0x80000000u); }
__device__ __forceinline__ int hist_find(LAS unsigned* hist, int lane, int& R, int& cnt) {
    const u32x4 c4 = *(const LAS u32x4*)(hist + 4 * lane);
    const unsigned tot = c4.x + c4.y + c4.z + c4.w;
    unsigned suf = tot;
#pragma unroll
    for (int o = 1; o < 64; o <<= 1) { const unsigned v = __shfl_down(suf, o); if (lane + o < 64) suf += v; }
    const unsigned above = suf - tot;
    const bool mine = (above < (unsigned)R) && ((unsigned)R <= suf);
    const unsigned long long bal = __ballot(mine);
    const int src = bal ? (int)__builtin_ctzll(bal) : 0;
    int bin, rr, cc;
    { unsigned a = above; int r_ = R;
      if ((unsigned)r_ <= a + c4.w) { bin = 4 * lane + 3; rr = r_ - (int)a; cc = (int)c4.w; } else { a += c4.w;
      if ((unsigned)r_ <= a + c4.z) { bin = 4 * lane + 2; rr = r_ - (int)a; cc = (int)c4.z; } else { a += c4.z;
      if ((unsigned)r_ <= a + c4.y) { bin = 4 * lane + 1; rr = r_ - (int)a; cc = (int)c4.y; } else { a += c4.y; bin = 4 * lane; rr = r_ - (int)a; cc = (int)c4.x; } } } }
    bin = __shfl(bin, src); rr = __shfl(rr, src); cc = __shfl(cc, src);
    R = rr; cnt = cc; return bin;
}
__device__ __forceinline__ void ph_dsa(Frame& F, int half, int first, int stride) {
    const bf16_t* CB = (const bf16_t*)(F.ws + MX_CB); const bf16_t* VT = (const bf16_t*)(F.ws + MX_VT);
    bf16_t* YB = (bf16_t*)(F.ws + MX_YB);
    LAS float* sc = (LAS float*)F.lds;
    LAS unsigned* hist = (LAS unsigned*)(F.lds + 16 * SC_LD * 4);
    LAS unsigned* msk = (LAS unsigned*)(F.lds + 16 * SC_LD * 4 + 16 * 256 * 4);
    lbf* KB = (lbf*)F.lds;
    lbf* VB = (lbf*)(F.lds + 2 * SLOT);
    const int lane = F.lane, w = F.wave, jl = lane & 15, g = lane >> 4;
    const int srow = F.tid >> 3, sseg = F.tid & 7;
    for (int u = first; u < TH / 16; u += stride) {
        const int bl = u >> 7, q0 = (u & 127) * 16, L = ((q0 >> 6) + 1) * 64;
        const int rowb = bl * SEQ;
        __syncthreads();
        if (L > 256) for (int i = F.tid; i < 16 * 256; i += NTHR) hist[i] = 0u;
        __syncthreads();
        {
            bf16x8 yq[8][2]; float iw[8];
            const bf16_t* qrow = CB + (size_t)(rowb + q0 + jl) * DS_PAD;
#pragma unroll
            for (int h = 0; h < 8; ++h) { iw[h] = bf2f(qrow[1216 + h]);
#pragma unroll
                for (int s = 0; s < 2; ++s) yq[h][s] = *(const bf16x8*)(qrow + 640 + h * 64 + 32 * s + 8 * g); }
            const int nk = L / 16;
            const bf16_t* kbase = CB + (size_t)(rowb + jl) * DS_PAD + 1152 + 8 * g;
            bf16x8 x0 = {0, 0, 0, 0, 0, 0, 0, 0}, x1 = x0;
            if (w < nk) { const bf16_t* kr = kbase + (size_t)(w * 16) * DS_PAD; x0 = *(const bf16x8*)kr; x1 = *(const bf16x8*)(kr + 32); }
            for (int kt = w; kt < nk; kt += 8) {
                bf16x8 n0 = x0, n1 = x1;
                if (kt + 8 < nk) { const bf16_t* kr = kbase + (size_t)((kt + 8) * 16) * DS_PAD; n0 = *(const bf16x8*)kr; n1 = *(const bf16x8*)(kr + 32); }
                f32x4 s4 = (f32x4){0.f, 0.f, 0.f, 0.f};
#pragma unroll
                for (int h = 0; h < 8; ++h) { f32x4 a = (f32x4){0.f, 0.f, 0.f, 0.f}; a = MFMA16(x0, yq[h][0], a); a = MFMA16(x1, yq[h][1], a);
#pragma unroll
                    for (int r = 0; r < 4; ++r) s4[r] += iw[h] * fmaxf(a[r], 0.f); }
                *(LAS f32x4*)(sc + jl * SC_LD + kt * 16 + 4 * g) = s4;
                if (L > 256) {
#pragma unroll
                    for (int r = 0; r < 4; ++r) lds_inc(hist + jl * 256 + (okey(s4[r]) >> 24)); }
                x0 = n0; x1 = n1;
            }
        }
        __syncthreads();
        for (int qi = 0; qi < 2; ++qi) {
            const int qq = 2 * w + qi; LAS unsigned* hq = hist + qq * 256; const LAS float* sq = sc + qq * SC_LD; LAS unsigned* mq = msk + qq * 64;
            if (L <= 256) { mq[lane] = (lane < L / 32) ? 0xffffffffu : 0u; }
            else {
                int R = 256, E = 0; unsigned prefix = (unsigned)hist_find(hq, lane, R, E);
#pragma unroll 1
                for (int pass = 1; pass < 4; ++pass) {
                    const int sh = 24 - 8 * pass;
                    asm volatile("" ::: "memory");
                    *(LAS u32x4*)(hq + 4 * lane) = (u32x4){0u, 0u, 0u, 0u};
                    LDS_WAIT(); asm volatile("" ::: "memory");
                    for (int i = 4 * lane; i < L; i += 256) { const f32x4 s = *(const LAS f32x4*)(sq + i);
#pragma unroll
                        for (int r = 0; r < 4; ++r) { const unsigned k = okey(s[r]); if ((k >> (sh + 8)) == prefix) lds_inc(hq + ((k >> sh) & 255u)); } }
                    LDS_WAIT(); asm volatile("" ::: "memory");
                    const int b = hist_find(hq, lane, R, E); prefix = (prefix << 8) | (unsigned)b;
                }
                const unsigned thr = prefix;
                if (R >= E) {
                    for (int base = 0; base < SEQ; base += 256) {
                        unsigned nib = 0u;
                        if (base + 4 * lane < L) { const f32x4 s = *(const LAS f32x4*)(sq + base + 4 * lane);
#pragma unroll
                            for (int r = 0; r < 4; ++r) nib |= (okey(s[r]) >= thr ? 1u : 0u) << r; }
                        unsigned wv = nib << (4 * (lane & 7));
                        wv |= __shfl_xor(wv, 1); wv |= __shfl_xor(wv, 2); wv |= __shfl_xor(wv, 4);
                        if ((lane & 7) == 0) mq[(base >> 5) + (lane >> 3)] = wv;
                    }
                } else {
                    int taken = 0;
                    for (int base = 0; base < SEQ; base += 64) {
                        bool take = false; bool eq = false;
                        if (base < L) { const unsigned k = okey(sq[base + lane]); take = k > thr; eq = (k == thr); }
                        const unsigned long long em = __ballot(eq);
                        const int myr = taken + __popcll(em & ((1ull << lane) - 1ull));
                        take = take || (eq && myr < R);
                        taken += __popcll(em);
                        const unsigned long long tm = __ballot(take);
                        if (lane == 0) { mq[base / 32] = (unsigned)tm; mq[base / 32 + 1] = (unsigned)(tm >> 32); }
                    }
                }
            }
        }
        __syncthreads();
        {
            const int qloc = 2 * w + (jl >> 3), hd = jl & 7;
            const bf16_t* qrow = CB + (size_t)(rowb + q0 + qloc) * DS_PAD + hd * 64;
            const bf16x8 yq0 = *(const bf16x8*)(qrow + 8 * g), yq1 = *(const bf16x8*)(qrow + 32 + 8 * g);
            f32x4 O[4];
#pragma unroll
            for (int dt = 0; dt < 4; ++dt) O[dt] = (f32x4){0.f, 0.f, 0.f, 0.f};
            float mrun = -1e30f, lsum = 0.f;
            const LAS unsigned* mq = msk + qloc * 64;
            const bf16_t* kg = CB + (size_t)(rowb + srow) * DS_PAD + 512 + 8 * sseg;
            const bf16_t* vg = VT + ((size_t)bl * 64 + srow) * SEQ + 8 * sseg;
            const int ntile = L / 64;
            u32x4 kreg = *(const u32x4*)kg, vreg = *(const u32x4*)vg;
            *(LAS u32x4*)(KB + srow * LDP + 8 * sseg) = kreg; *(LAS u32x4*)(VB + srow * LDP + 8 * sseg) = vreg;
            __syncthreads();
            for (int it = 0; it < ntile; ++it) {
                if (it + 1 < ntile) { kreg = *(const u32x4*)(kg + (size_t)((it + 1) * 64) * DS_PAD); vreg = *(const u32x4*)(vg + (it + 1) * 64); }
                const lbf* Kt = KB + (it & 1) * 64 * LDP; const lbf* Vt = VB + (it & 1) * 64 * LDP;
                f32x4 s[4];
#pragma unroll
                for (int tl = 0; tl < 4; ++tl) { const lbf* xr = Kt + (16 * tl + jl) * LDP + 8 * g;
                    f32x4 a = (f32x4){0.f, 0.f, 0.f, 0.f}; a = MFMA16(*(const LAS bf16x8*)xr, yq0, a); a = MFMA16(*(const LAS bf16x8*)(xr + 32), yq1, a); s[tl] = a; }
                const unsigned mw0 = mq[2 * it], mw1 = mq[2 * it + 1];
                float mx = -1e30f; unsigned bits = 0u;
#pragma unroll
                for (int tl = 0; tl < 4; ++tl) { const unsigned mw = (tl < 2) ? mw0 : mw1; const unsigned nb = (mw >> (16 * (tl & 1) + 4 * g)) & 15u; bits |= nb << (4 * tl);
#pragma unroll
                    for (int r = 0; r < 4; ++r) { s[tl][r] *= 0.125f; if ((nb >> r) & 1u) mx = fmaxf(mx, s[tl][r]); } }
                mx = fmaxf(mx, __shfl_xor(mx, 16)); mx = fmaxf(mx, __shfl_xor(mx, 32));
                const float mnew = fmaxf(mrun, mx); const float alpha = __expf(mrun - mnew); mrun = mnew;
                float p[16]; float ps = 0.f;
#pragma unroll
                for (int i = 0; i < 16; ++i) { p[i] = ((bits >> i) & 1u) ? __expf(s[i >> 2][i & 3] - mnew) : 0.f; ps += p[i]; }
                lsum = lsum * alpha + ps;
                bf16x8 pf[2];
#pragma unroll
                for (int ks = 0; ks < 2; ++ks) { u32x4 pw; pw.x = pk2(p[8 * ks], p[8 * ks + 1]); pw.y = pk2(p[8 * ks + 2], p[8 * ks + 3]); pw.z = pk2(p[8 * ks + 4], p[8 * ks + 5]); pw.w = pk2(p[8 * ks + 6], p[8 * ks + 7]);
                    pf[ks] = __builtin_bit_cast(bf16x8, pw); }
#pragma unroll
                for (int dt = 0; dt < 4; ++dt) { O[dt] = O[dt] * alpha;
#pragma unroll
                    for (int ks = 0; ks < 2; ++ks) { const lbf* vr = Vt + (16 * dt + jl) * LDP + 32 * ks + 4 * g;
                        const u32x2 lo = *(const LAS u32x2*)vr, hi = *(const LAS u32x2*)(vr + 16);
                        O[dt] = MFMA16(__builtin_bit_cast(bf16x8, (u32x4){lo.x, lo.y, hi.x, hi.y}), pf[ks], O[dt]); } }
                if (it + 1 < ntile) { *(LAS u32x4*)(KB + ((it + 1) & 1) * 64 * LDP + srow * LDP + 8 * sseg) = kreg; *(LAS u32x4*)(VB + ((it + 1) & 1) * 64 * LDP + srow * LDP + 8 * sseg) = vreg; }
                __syncthreads();
            }
            lsum += __shfl_xor(lsum, 16); lsum += __shfl_xor(lsum, 32);
            const float inv = 1.0f / lsum;
            bf16_t* orow = YB + (size_t)(rowb + q0 + qloc) * 512 + hd * 64;
#pragma unroll
            for (int dt = 0; dt < 4; ++dt) { u32x2 o; o.x = pk2(O[dt][0] * inv, O[dt][1] * inv); o.y = pk2(O[dt][2] * inv, O[dt][3] * inv); *(u32x2*)(orow + 16 * dt + 4 * g) = o; }
        }
    }
}

__device__ __forceinline__ void ph_mem_attn(Frame& F, int l) {
    const bf16_t* QM = (const bf16_t*)(F.ws + MA_QM); bf16_t* OM = (bf16_t*)(F.ws + MA_OM);
    const bf16_t* MK = (const bf16_t*)(F.ws + WS_MEMK) + (size_t)l * MEMROWS * 512; const bf16_t* MVT = (const bf16_t*)(F.ws + WS_MEMVT) + (size_t)l * MEMROWS * 512;
    const int lane = F.lane, jl = lane & 15, g = lane >> 4;
    const float* gq = FIN(F, I_MQN) + l * 128;
    for (int it = F.bid; it < NB * 4 * 16; it += F.G) {
        const int b = it >> 6, hh = (it >> 4) & 3, sp = it & 15;
        const int t = b * SEQ + sp * 128 + F.wave * 16 + jl;
        const bf16_t* qrow = QM + (size_t)t * 512 + hh * 128;
        float qv[4][8]; float ss = 0.f;
#pragma unroll
        for (int s = 0; s < 4; ++s) { const u32x4 q = *(const u32x4*)(qrow + 32 * s + 8 * g);
            qv[s][0] = bf_lo(q.x); qv[s][1] = bf_hi(q.x); qv[s][2] = bf_lo(q.y); qv[s][3] = bf_hi(q.y); qv[s][4] = bf_lo(q.z); qv[s][5] = bf_hi(q.z); qv[s][6] = bf_lo(q.w); qv[s][7] = bf_hi(q.w);
#pragma unroll
            for (int i = 0; i < 8; ++i) ss += qv[s][i] * qv[s][i]; }
        ss += __shfl_xor(ss, 16); ss += __shfl_xor(ss, 32);
        const float sc = (1.0f / sqrtf(ss * (1.f / 128.f) + 1e-6f)) * 0.08838834764831845f;
        bf16x8 yq[4];
#pragma unroll
        for (int s = 0; s < 4; ++s) { const float* gp = gq + 32 * s + 8 * g; u32x4 pw;
            pw.x = pk2(qv[s][0] * sc * gp[0], qv[s][1] * sc * gp[1]); pw.y = pk2(qv[s][2] * sc * gp[2], qv[s][3] * sc * gp[3]);
            pw.z = pk2(qv[s][4] * sc * gp[4], qv[s][5] * sc * gp[5]); pw.w = pk2(qv[s][6] * sc * gp[6], qv[s][7] * sc * gp[7]); yq[s] = __builtin_bit_cast(bf16x8, pw); }
        const bf16_t* kb_ = MK + ((size_t)b * 4 + hh) * 256 * 128; const bf16_t* vb_ = MVT + ((size_t)b * 4 + hh) * 128 * 256;
        f32x4 S[16];
#pragma unroll
        for (int kt = 0; kt < 16; ++kt) { const bf16_t* kr = kb_ + (size_t)(16 * kt + jl) * 128 + 8 * g; f32x4 a = (f32x4){0.f, 0.f, 0.f, 0.f};
#pragma unroll
            for (int s = 0; s < 4; ++s) a = MFMA16(*(const bf16x8*)(kr + 32 * s), yq[s], a);
            S[kt] = a; }
        float mx = -1e30f;
#pragma unroll
        for (int kt = 0; kt < 16; ++kt)
#pragma unroll
            for (int r = 0; r < 4; ++r) mx = fmaxf(mx, S[kt][r]);
        mx = fmaxf(mx, __shfl_xor(mx, 16)); mx = fmaxf(mx, __shfl_xor(mx, 32));
        float ls = 0.f; bf16x8 pf[8];
#pragma unroll
        for (int ks = 0; ks < 8; ++ks) { float p[8];
#pragma unroll
            for (int i = 0; i < 8; ++i) { p[i] = __expf(S[2 * ks + (i >> 2)][i & 3] - mx); ls += p[i]; }
            u32x4 pw; pw.x = pk2(p[0], p[1]); pw.y = pk2(p[2], p[3]); pw.z = pk2(p[4], p[5]); pw.w = pk2(p[6], p[7]); pf[ks] = __builtin_bit_cast(bf16x8, pw); }
        ls += __shfl_xor(ls, 16); ls += __shfl_xor(ls, 32);
        const float inv = 1.0f / ls;
        bf16_t* orow = OM + (size_t)t * 512 + hh * 128;
#pragma unroll
        for (int dt = 0; dt < 8; ++dt) { f32x4 o = (f32x4){0.f, 0.f, 0.f, 0.f}; const bf16_t* vr = vb_ + (size_t)(16 * dt + jl) * 256 + 4 * g;
#pragma unroll
            for (int ks = 0; ks < 8; ++ks) { const u32x2 lo = *(const u32x2*)(vr + 32 * ks), hi = *(const u32x2*)(vr + 32 * ks + 16);
                o = MFMA16(__builtin_bit_cast(bf16x8, (u32x4){lo.x, lo.y, hi.x, hi.y}), pf[ks], o); }
            u32x2 ov; ov.x = pk2(o[0] * inv, o[1] * inv); ov.y = pk2(o[2] * inv, o[3] * inv); *(u32x2*)(orow + 16 * dt + 4 * g) = ov; }
    }
}

__device__ __forceinline__ void ph_moe_route(Frame& F) {
    const unsigned short* sele = (const unsigned short*)(F.ws + MOE_SELE); const f32x2* selw = (const f32x2*)(F.ws + MOE_SELW);
    int* rowtok = (int*)(F.ws + MOE_ROWTOK); float* roww = (float*)(F.ws + MOE_ROWW); int* tile_e = (int*)(F.ws + MOE_TILEE); int* meta = (int*)(F.ws + MOE_META);
    LAS unsigned long long* pc = (LAS unsigned long long*)F.lds;
    LAS int* tot = (LAS int*)(F.lds + 8192);
    LAS int* pre = tot + 16; LAS int* segb = tot + 32; LAS int* wcnt = tot + 64;
    __syncthreads();
    { unsigned long long c0 = 0ull, c1 = 0ull; const u32x4* sp = (const u32x4*)(sele + (size_t)F.tid * 128);
      for (int i = 0; i < 16; ++i) { const u32x4 v = sp[i]; const unsigned ww[4] = {v.x, v.y, v.z, v.w};
#pragma unroll
        for (int q = 0; q < 4; ++q) { const unsigned a = ww[q] & 0xffffu, b = ww[q] >> 16;
            c0 += 1ull << (8 * (a & 7u)); c1 += 1ull << (8 * ((a >> 8) & 7u)); c0 += 1ull << (8 * (b & 7u)); c1 += 1ull << (8 * ((b >> 8) & 7u)); } }
      pc[F.tid * 2] = c0; pc[F.tid * 2 + 1] = c1; }
    __syncthreads();
    if (F.tid < 32) { const int seg = F.tid & 15, kind = F.tid >> 4; const int slot = seg >> 3, e = seg & 7; const int lim = kind ? 2 * F.bid : 512; int s = 0;
        for (int i = 0; i < lim; ++i) s += (int)((pc[i * 2 + slot] >> (8 * e)) & 0xffull);
        if (kind) pre[seg] = s; else tot[seg] = s; }
    __syncthreads();
    if (F.tid == 0) { int b = 0; for (int s = 0; s < 16; ++s) { segb[s] = b; b += (tot[s] + 255) & ~255; } segb[16] = b; }
    __syncthreads();
    const int t = F.bid * 256 + (F.tid & 255); const unsigned se = sele[t]; const f32x2 sw = selw[t];
    const int myseg[2] = { (int)(se & 7u), 8 + (int)((se >> 8) & 7u) };
    int rank[2] = {0, 0};
    if (F.tid < 256) {
#pragma unroll
        for (int s = 0; s < 16; ++s) { const int k = s >> 3; const unsigned long long m = __ballot(myseg[k] == s);
            if (myseg[k] == s) rank[k] = __popcll(m & ((1ull << F.lane) - 1ull));
            if (F.lane == 0) wcnt[F.wave * 16 + s] = __popcll(m); }
    }
    __syncthreads();
    if (F.tid < 256) {
#pragma unroll
        for (int k = 0; k < 2; ++k) { const int s = myseg[k]; int off = 0; for (int ww = 0; ww < F.wave; ++ww) off += wcnt[ww * 16 + s];
            const int row = segb[s] + pre[s] + off + rank[k]; rowtok[row] = t; roww[row] = k ? sw.y : sw.x; }
    }
    if (F.bid == 0) {
        for (int s = 0; s < 16; ++s) { const int lo = segb[s] + tot[s], hi = segb[s + 1]; for (int r = lo + F.tid; r < hi; r += NTHR) { rowtok[r] = -1; roww[r] = 0.f; } }
        for (int p = F.tid; p < segb[16] / 256; p += NTHR) { int e = 0; for (int s = 0; s < 16; ++s) if (p * 256 >= segb[s]) e = s & 7; tile_e[p] = e; }
        if (F.tid == 0) { meta[0] = segb[8] / 256; meta[1] = segb[16] / 256; }
    }
}

__global__ void __launch_bounds__(NTHR, 2) fwd(Args args) {
    extern __shared__ __attribute__((aligned(16))) unsigned char lds_raw[];
    Frame F;
    F.lds = (LAS unsigned char*)lds_raw; F.ws = args.ws; F.kb = __builtin_amdgcn_kernarg_segment_ptr(); F.out = args.out;
    F.tid = threadIdx.x; F.lane = F.tid & 63; F.wave = __builtin_amdgcn_readfirstlane(F.tid >> 6); F.G = gridDim.x; F.bid = blockIdx.x;
    volatile LAS unsigned* MISC = (volatile LAS unsigned*)(F.lds + LDS_MISC);
    if (F.tid < 64) MISC[F.tid] = 0u;
    __syncthreads();
    const int lo = args.ph_lo, hi = args.ph_hi;
    XcdBarrier bar; bar.bar = (unsigned*)(F.ws + WS_CTL) + 4096; bar.x = 0; bar.st = nullptr;
    if (hi - lo > 1) bar = xcd_barrier_post((unsigned*)(F.ws + WS_CTL) + 4096, MISC + 8);
    int ph = 0;
#ifndef SITE_MASK
#define SITE_MASK 0xffffffffffffffffull
#endif
#ifndef REP_SITE
#define REP_SITE -1
#endif
#ifndef REP_N
#define REP_N 2
#endif
#define PHASE_BEGIN if (((SITE_MASK >> __COUNTER__) & 1ull) && ph >= lo && ph < hi) { for (int rep_ = 0; rep_ < (((__COUNTER__ - 1) / 2 == REP_SITE) ? REP_N : 1); ++rep_) { { int _t = threadIdx.x; asm volatile("" : "+v"(_t)); F.tid = _t; F.lane = _t & 63; F.wave = __builtin_amdgcn_readfirstlane(_t >> 6); \
      kptr_t _kb = __builtin_amdgcn_kernarg_segment_ptr(); asm volatile("" : "+s"(_kb)); F.kb = _kb; \
      unsigned char* _w = args.ws; asm volatile("" : "+s"(_w)); F.ws = _w; ws = _w; float* _o = args.out; asm volatile("" : "+s"(_o)); F.out = _o; }
#define PHASE_END   } if (ph + 1 < hi) xcd_barrier(bar); } ++ph;
    unsigned char* ws = F.ws;
#define HN ((const bf16_t*)(ws + WS_HN))

    PHASE_BEGIN ph_prologue0(F); PHASE_END
    PHASE_BEGIN { pg8::Gemm g{(const bf16_t*)(ws + WS_MEMH), (const bf16_t*)(ws + WS_WKV), D, 0, nullptr}; pg8::StaticOrder S; S.init(MEMROWS, 4096, F.G, F.bid);
        pg8::EpiPlain E{(bf16_t*)(ws + PR_KVRAW), 4096}; pg8::gemm_phase<pg8::EpiPlain, pg8::StaticOrder>(F.lds, g, S, E); } PHASE_END
    PHASE_BEGIN ph_prologue2(F); PHASE_END

#pragma unroll 1
    for (int l = 0; l < DEPTH; ++l) {

        PHASE_BEGIN ph_layer0(F, l, l ? (const float*)F.out : FIN(F, I_X)); PHASE_END
#pragma unroll 1
        for (int half = 0; half < 2; ++half) {

            PHASE_BEGIN { pg8::Gemm g{HN + (size_t)half * TH * D, (const bf16_t*)(ws + W_IN), D, 0, nullptr}; pg8::StaticOrder S; S.init(TH, N_INP, F.G, F.bid);
                pg8::EpiWin E{(bf16_t*)(ws + MX_CA), (bf16_t*)(ws + MX_CB), (bf16_t*)(ws + MX_CG)}; pg8::gemm_phase<pg8::EpiWin, pg8::StaticOrder>(F.lds, g, S, E); } PHASE_END
                        PHASE_BEGIN ph_rwkv_prep(F, l, half); ph_dsa_prep(F, l, half); PHASE_END
            PHASE_BEGIN ph_rwkv_s1(F); PHASE_END
            PHASE_BEGIN { for (int p = F.bid; p < 128; p += F.G) ph_rwkv_s2(F, l, p); ph_dsa(F, half, F.bid, F.G); } PHASE_END
            PHASE_BEGIN { pg8::Gemm g{(const bf16_t*)(ws + MX_CA + RW_ARR), (const bf16_t*)(ws + W_BA), 512, 0, nullptr}; pg8::StaticOrder S; S.init(TH, D, F.G, F.bid);
                pg8::EpiMerge<false> E{(bf16_t*)(ws + WS_HN) + (size_t)half * TH * D, (const bf16_t*)(ws + MX_CG), 0}; pg8::gemm_phase<pg8::EpiMerge<false>, pg8::StaticOrder>(F.lds, g, S, E); } PHASE_END
            PHASE_BEGIN { pg8::Gemm g{(const bf16_t*)(ws + MX_YB), (const bf16_t*)(ws + W_BB), 512, 0, nullptr}; pg8::StaticOrder S; S.init(TH, D, F.G, F.bid);
                pg8::EpiMerge<true> E{(bf16_t*)(ws + WS_HN) + (size_t)half * TH * D, (const bf16_t*)(ws + MX_CG), 1024}; pg8::gemm_phase<pg8::EpiMerge<true>, pg8::StaticOrder>(F.lds, g, S, E); } PHASE_END
        }
        PHASE_BEGIN { pg8::Gemm g{HN, (const bf16_t*)(ws + W_OUT), D, 0, nullptr}; pg8::StaticOrder S; S.init(T, D, F.G, F.bid);
            pg8::EpiResid E{l ? (const float*)F.out : FIN(F, I_X), F.out}; pg8::gemm_phase<pg8::EpiResid, pg8::StaticOrder>(F.lds, g, S, E); } PHASE_END
        PHASE_BEGIN ph_norm(F); PHASE_END
        PHASE_BEGIN { pg8::Gemm g{HN, (const bf16_t*)(ws + W_MQ), D, 0, nullptr}; pg8::StaticOrder S; S.init(T, 512, F.G, F.bid);
            pg8::EpiPlain E{(bf16_t*)(ws + MA_QM), 512}; pg8::gemm_phase<pg8::EpiPlain, pg8::StaticOrder>(F.lds, g, S, E); } PHASE_END
        PHASE_BEGIN ph_mem_attn(F, l); PHASE_END
        PHASE_BEGIN { pg8::Gemm g{(const bf16_t*)(ws + MA_OM), (const bf16_t*)(ws + W_MO), 512, 0, nullptr}; pg8::StaticOrder S; S.init(T, D, F.G, F.bid);
            pg8::EpiResid E{F.out, F.out}; pg8::gemm_phase<pg8::EpiResid, pg8::StaticOrder>(F.lds, g, S, E); } PHASE_END
        PHASE_BEGIN ph_norm_ffn(F, l); PHASE_END
        if ((l & 1) == 0) {
            PHASE_BEGIN { pg8::Gemm g{HN, (const bf16_t*)(ws + W_FGU), D, 0, nullptr}; pg8::StaticOrder S; S.init(T, 2 * FFN, F.G, F.bid);
                pg8::EpiSwiGLU E{(bf16_t*)(ws + FF_GU), FFN}; pg8::gemm_phase<pg8::EpiSwiGLU, pg8::StaticOrder>(F.lds, g, S, E); } PHASE_END
            PHASE_BEGIN { pg8::Gemm g{(const bf16_t*)(ws + FF_GU), (const bf16_t*)(ws + W_FD), FFN, 0, nullptr}; pg8::StaticOrder S; S.init(T, D, F.G, F.bid);
                pg8::EpiResid E{F.out, F.out}; pg8::gemm_phase<pg8::EpiResid, pg8::StaticOrder>(F.lds, g, S, E); } PHASE_END
            ph += 2;
        } else {
#define meta ((const int*)(ws + MOE_META))
#define tile_e ((const int*)(ws + MOE_TILEE))
            PHASE_BEGIN ph_moe_route(F); PHASE_END
            PHASE_BEGIN { const int nt1 = __builtin_amdgcn_readfirstlane(meta[1]);
                pg8::Gemm g{HN, (const bf16_t*)(ws + W_EGU), D, (size_t)2 * EDIM * D, (const int*)(ws + MOE_ROWTOK)}; pg8::MoeOrder S; S.init(nt1, 11, F.G, F.bid, 0, tile_e);
                pg8::EpiSwiGLU E{(bf16_t*)(ws + FF_GU), EDIM}; pg8::gemm_phase<pg8::EpiSwiGLU, pg8::MoeOrder, true>(F.lds, g, S, E); } PHASE_END
            PHASE_BEGIN { const int nt0 = __builtin_amdgcn_readfirstlane(meta[0]);
                pg8::Gemm g{(const bf16_t*)(ws + FF_GU), (const bf16_t*)(ws + W_ED), EDIM, (size_t)D * EDIM, nullptr}; pg8::MoeOrder S; S.init(nt0, 4, F.G, F.bid, 0, tile_e);
                pg8::EpiMoeDown E{F.out, (const int*)(ws + MOE_ROWTOK), (const float*)(ws + MOE_ROWW)}; pg8::gemm_phase<pg8::EpiMoeDown, pg8::MoeOrder>(F.lds, g, S, E); } PHASE_END
            PHASE_BEGIN { const int nt0 = __builtin_amdgcn_readfirstlane(meta[0]), nt1 = __builtin_amdgcn_readfirstlane(meta[1]);
                pg8::Gemm g{(const bf16_t*)(ws + FF_GU), (const bf16_t*)(ws + W_ED), EDIM, (size_t)D * EDIM, nullptr}; pg8::MoeOrder S; S.init(nt1 - nt0, 4, F.G, F.bid, nt0, tile_e);
                pg8::EpiMoeDown E{F.out, (const int*)(ws + MOE_ROWTOK), (const float*)(ws + MOE_ROWW)}; pg8::gemm_phase<pg8::EpiMoeDown, pg8::MoeOrder>(F.lds, g, S, E); } PHASE_END
        }
    }
}
constexpr int N_PHASES = 3 + DEPTH * (1 + 2 * 6 + 6 + 4);

extern "C" void kernel_launch(void* const* d_in, const int* in_sizes, int n_in, void* d_out, int out_size, void* d_ws, size_t ws_size, hipStream_t stream) {
    static int grid = 0;
    if (grid == 0) {
        if (n_in != 41 || out_size != T * D || ws_size < WS_END) { fprintf(stderr, "kernel_launch: unexpected shapes (n_in %d, out %d, ws %zu < %zu); nothing launched\n", n_in, out_size, ws_size, (size_t)WS_END); grid = -1; return; }
        int dev = 0, cus = 0, per_cu = 0;
        if (hipGetDevice(&dev) != hipSuccess || hipDeviceGetAttribute(&cus, hipDeviceAttributeMultiprocessorCount, dev) != hipSuccess) { grid = -1; return; }
        if (hipFuncSetAttribute((const void*)fwd, hipFuncAttributeMaxDynamicSharedMemorySize, LDS_BYTES) != hipSuccess) { fprintf(stderr, "kernel_launch: hipFuncSetAttribute failed\n"); grid = -1; return; }
        if (hipOccupancyMaxActiveBlocksPerMultiprocessor(&per_cu, (const void*)fwd, NTHR, LDS_BYTES) != hipSuccess || per_cu < 1) fprintf(stderr, "kernel_launch: occupancy query reports %d\n", per_cu);
        (void)hipGetLastError();
        grid = cus;
    }
    if (grid < 0) return;
    if (hipMemsetAsync((char*)d_ws + WS_CTL, 0, CTL_ZERO_BYTES, stream) != hipSuccess) return;
    Args a{};
    for (int i = 0; i < 41; ++i) a.in[i] = d_in[i];
    a.out = (float*)d_out; a.ws = (unsigned char*)d_ws;
#if MK_ONE_LAUNCH
    a.ph_lo = 0; a.ph_hi = N_PHASES;
    hipLaunchKernelGGL(fwd, dim3(grid), dim3(NTHR), LDS_BYTES, stream, a);
#else
    for (int p = 0; p < N_PHASES; ++p) { a.ph_lo = p; a.ph_hi = p + 1; hipLaunchKernelGGL(fwd, dim3(grid), dim3(NTHR), LDS_BYTES, stream, a); }
#endif
}
```

```cpp
#include <hip/hip_runtime.h>
#include <cstdio>
#include <cstdint>

#ifndef MK_ONE_LAUNCH
#define MK_ONE_LAUNCH 1
#endif

namespace pg8 {
#define PG8_LAS __attribute__((address_space(3)))
typedef unsigned short bf16_t;
typedef short bf16x8 __attribute__((ext_vector_type(8)));
typedef float f32x4 __attribute__((ext_vector_type(4)));
typedef float f32x2 __attribute__((ext_vector_type(2)));
typedef unsigned u32x4 __attribute__((ext_vector_type(4)));
typedef unsigned u32x2 __attribute__((ext_vector_type(2)));
typedef __bf16 bf16x2_t __attribute__((ext_vector_type(2)));
constexpr int BM = 256, BK = 64, HALF = 128, HTB = HALF * BK * 2, STAGE_BYTES = 8 * HTB, NXCD = 8, WGM = 8;

__host__ __device__ __forceinline__ int lds_byte(int r, int c) { const int st = (r >> 4) * 2 + (c >> 5), rr = r & 15, cc = c & 31, ob = rr * 64 + cc * 2; return st * 1024 + (ob ^ (((ob >> 9) & 1) << 5)); }
__host__ __device__ __forceinline__ void stage_rc(int b, int& R, int& C) { const int st = b / 1024, sb = b % 1024, swz = sb ^ (((sb >> 9) & 1) << 5); R = (st >> 1) * 16 + swz / 64; C = (st & 1) * 32 + (swz % 64) / 2; }
__host__ __device__ __forceinline__ int perm32(int rho) { const int n = rho >> 4, i = rho & 15; return 8 * (i >> 2) + 4 * n + (i & 3); }

struct Unit { int pm, pn, e; };
struct Gemm { const bf16_t* A; const bf16_t* Bt; int K; size_t bstride; const int* rowidx; };

struct StaticOrder {
    int nM, nN, nwg, G, c;
    __device__ void init(int M, int N, int G_, int c_) { nM = M / BM; nN = N / BM; nwg = nM * nN; G = G_; c = c_; }
    __device__ bool next(int i, Unit& u) const {
        const long L = (long)i * G + c; if (L >= nwg) return false;
        int wgid = (int)L; { const int q = nwg / NXCD, r = nwg % NXCD, xcd = wgid % NXCD, off = wgid / NXCD; wgid = (xcd < r ? xcd * (q + 1) : r * (q + 1) + (xcd - r) * q) + off; }
        const int nig = WGM * nN, gid = wgid / nig, fm = gid * WGM, gsz = (nM - fm) < WGM ? (nM - fm) : WGM;
        u.pm = fm + ((wgid % nig) % gsz); u.pn = (wgid % nig) / gsz; u.e = 0; return true;
    }
};
struct MoeOrder {
    int nM, nN, nwg, G, c, pm0; const int* tile_e;
    __device__ void init(int nM_, int nN_, int G_, int c_, int pm0_, const int* te) { nM = nM_; nN = nN_; nwg = nM * nN; G = G_; c = c_; pm0 = pm0_; tile_e = te; }
    __device__ bool next(int i, Unit& u) const {
        const long L = (long)i * G + c; if (L >= nwg) return false;
        int wgid = (int)L; { const int q = nwg / NXCD, r = nwg % NXCD, xcd = wgid % NXCD, off = wgid / NXCD; wgid = (xcd < r ? xcd * (q + 1) : r * (q + 1) + (xcd - r) * q) + off; }
        const int nig = WGM * nN, gid = wgid / nig, fm = gid * WGM, gsz = (nM - fm) < WGM ? (nM - fm) : WGM;
        u.pm = pm0 + fm + ((wgid % nig) % gsz); u.pn = (wgid % nig) / gsz; u.e = __builtin_amdgcn_readfirstlane(tile_e[u.pm]); return true;
    }
};

__device__ __forceinline__ unsigned pk2(float lo, float hi) { const bf16x2_t v = __builtin_convertvector((f32x2){lo, hi}, bf16x2_t); return __builtin_bit_cast(unsigned, v); }
__device__ __forceinline__ float bf_lo(unsigned u) { return __builtin_bit_cast(float, u << 16); }
__device__ __forceinline__ float bf_hi(unsigned u) { return __builtin_bit_cast(float, u & 0xffff0000u); }
__device__ __forceinline__ float bf2f(bf16_t b) { return __builtin_bit_cast(float, (unsigned)b << 16); }
__device__ __forceinline__ bf16_t f2bf(float f) { return (bf16_t)(pk2(f, 0.f) & 0xffffu); }
__device__ __forceinline__ float sigmoidf_(float x) { return __builtin_amdgcn_rcpf(1.0f + __expf(-x)); }

struct EpiPlain {
    static constexpr bool PERM = true;
    bf16_t* O; int ldc;
    __device__ __forceinline__ void operator()(const f32x4 (&acc)[2][2][4][2], const Unit& u, int wr, int wc, int fr, int fq) const {
        const int row0 = u.pm * BM + wr * 64 + fr, col0 = u.pn * BM + wc * 32 + 8 * fq;
#pragma unroll
        for (int ai = 0; ai < 2; ++ai)
#pragma unroll
            for (int m = 0; m < 4; ++m) { bf16_t* rowp = O + (size_t)(row0 + ai * HALF + m * 16) * ldc + col0;
#pragma unroll
                for (int bj = 0; bj < 2; ++bj) { const f32x4 v0 = acc[ai][bj][m][0], v1 = acc[ai][bj][m][1];
                    u32x4 w; w.x = pk2(v0[0], v0[1]); w.y = pk2(v0[2], v0[3]); w.z = pk2(v1[0], v1[1]); w.w = pk2(v1[2], v1[3]);
                    *(u32x4*)(rowp + bj * HALF) = w; } }
    }
};
struct EpiWin {
    static constexpr bool PERM = true;
    bf16_t *CA, *CB, *CG;
    __device__ __forceinline__ void operator()(const f32x4 (&acc)[2][2][4][2], const Unit& u, int wr, int wc, int fr, int fq) const {
        const int row0 = u.pm * BM + wr * 64 + fr; const int pn = u.pn;
        bf16_t* base; int ldc, ct; const bool sg = pn >= 12;
        if (pn < 7) { base = CA; ldc = 1792; ct = pn; } else if (pn < 12) { base = CB; ldc = 1280; ct = pn - 7; } else { base = CG; ldc = 2048; ct = pn - 12; }
        const int col0 = ct * BM + wc * 32 + 8 * fq;
#pragma unroll
        for (int ai = 0; ai < 2; ++ai)
#pragma unroll
            for (int m = 0; m < 4; ++m) { bf16_t* rowp = base + (size_t)(row0 + ai * HALF + m * 16) * ldc + col0;
#pragma unroll
                for (int bj = 0; bj < 2; ++bj) { f32x4 v0 = acc[ai][bj][m][0], v1 = acc[ai][bj][m][1];
                    if (sg) {
#pragma unroll
                        for (int j = 0; j < 4; ++j) { v0[j] = sigmoidf_(v0[j]); v1[j] = sigmoidf_(v1[j]); } }
                    u32x4 w; w.x = pk2(v0[0], v0[1]); w.y = pk2(v0[2], v0[3]); w.z = pk2(v1[0], v1[1]); w.w = pk2(v1[2], v1[3]);
                    *(u32x4*)(rowp + bj * HALF) = w; } }
    }
};
template <bool ADD> struct EpiMerge {
    static constexpr bool PERM = true;
    bf16_t* O; const bf16_t* gate; int gcol;
    __device__ __forceinline__ void operator()(const f32x4 (&acc)[2][2][4][2], const Unit& u, int wr, int wc, int fr, int fq) const {
        const int row0 = u.pm * BM + wr * 64 + fr, col0 = u.pn * BM + wc * 32 + 8 * fq;
#pragma unroll
        for (int ai = 0; ai < 2; ++ai) {
            u32x4 gv[4][2], pv[4][2];
#pragma unroll
            for (int m = 0; m < 4; ++m) { const size_t row = (size_t)(row0 + ai * HALF + m * 16);
#pragma unroll
                for (int bj = 0; bj < 2; ++bj) { gv[m][bj] = *(const u32x4*)(gate + row * 2048 + gcol + col0 + bj * HALF); if (ADD) pv[m][bj] = *(const u32x4*)(O + row * 1024 + col0 + bj * HALF); } }
#pragma unroll
            for (int m = 0; m < 4; ++m) { const size_t row = (size_t)(row0 + ai * HALF + m * 16);
#pragma unroll
                for (int bj = 0; bj < 2; ++bj) { const f32x4 v0 = acc[ai][bj][m][0], v1 = acc[ai][bj][m][1]; const u32x4 g = gv[m][bj];
                    float o[8] = { bf_lo(g.x) * v0[0], bf_hi(g.x) * v0[1], bf_lo(g.y) * v0[2], bf_hi(g.y) * v0[3], bf_lo(g.z) * v1[0], bf_hi(g.z) * v1[1], bf_lo(g.w) * v1[2], bf_hi(g.w) * v1[3] };
                    if (ADD) { const u32x4 p = pv[m][bj];
                        o[0] += bf_lo(p.x); o[1] += bf_hi(p.x); o[2] += bf_lo(p.y); o[3] += bf_hi(p.y); o[4] += bf_lo(p.z); o[5] += bf_hi(p.z); o[6] += bf_lo(p.w); o[7] += bf_hi(p.w); }
                    u32x4 w; w.x = pk2(o[0], o[1]); w.y = pk2(o[2], o[3]); w.z = pk2(o[4], o[5]); w.w = pk2(o[6], o[7]);
                    *(u32x4*)(O + row * 1024 + col0 + bj * HALF) = w; } }
        }
    }
};
struct EpiResid {
    static constexpr bool PERM = false;
    const float* xi; float* xo;
    __device__ __forceinline__ void operator()(const f32x4 (&acc)[2][2][4][2], const Unit& u, int wr, int wc, int fr, int fq) const {
        const int row0 = u.pm * BM + wr * 64 + fr, col0 = u.pn * BM + wc * 32 + 4 * fq;
#pragma unroll
        for (int ai = 0; ai < 2; ++ai) {
            f32x4 xv[4][2][2];
#pragma unroll
            for (int m = 0; m < 4; ++m) { const size_t o = (size_t)(row0 + ai * HALF + m * 16) * 1024 + col0;
#pragma unroll
                for (int bj = 0; bj < 2; ++bj)
#pragma unroll
                    for (int n = 0; n < 2; ++n) xv[m][bj][n] = *(const f32x4*)(xi + o + bj * HALF + n * 16); }
#pragma unroll
            for (int m = 0; m < 4; ++m) { const size_t o = (size_t)(row0 + ai * HALF + m * 16) * 1024 + col0;
#pragma unroll
                for (int bj = 0; bj < 2; ++bj)
#pragma unroll
                    for (int n = 0; n < 2; ++n) *(f32x4*)(xo + o + bj * HALF + n * 16) = xv[m][bj][n] + acc[ai][bj][m][n]; }
        }
    }
};
struct EpiSwiGLU {
    static constexpr bool PERM = true;
    bf16_t* O; int ldc;
    __device__ __forceinline__ void operator()(const f32x4 (&acc)[2][2][4][2], const Unit& u, int wr, int wc, int fr, int fq) const {
        const int row0 = u.pm * BM + wr * 64 + fr, col0 = u.pn * HALF + wc * 32 + 8 * fq;
#pragma unroll
        for (int ai = 0; ai < 2; ++ai)
#pragma unroll
            for (int m = 0; m < 4; ++m) { const int row = row0 + ai * HALF + m * 16;
                bf16_t* rowp = O + ((size_t)((row >> 6) * (ldc >> 4) + (col0 >> 4)) << 10) + (((row & 63) << 4) + (col0 & 15));
                float o[8];
#pragma unroll
                for (int n = 0; n < 2; ++n)
#pragma unroll
                    for (int j = 0; j < 4; ++j) { const float g = acc[ai][0][m][n][j], up = acc[ai][1][m][n][j]; o[4 * n + j] = g * sigmoidf_(g) * up; }
                u32x4 w; w.x = pk2(o[0], o[1]); w.y = pk2(o[2], o[3]); w.z = pk2(o[4], o[5]); w.w = pk2(o[6], o[7]);
                *(u32x4*)rowp = w; }
    }
};
struct EpiMoeDown {
    static constexpr bool PERM = false;
    float* x; const int* tok; const float* wgt;
    __device__ __forceinline__ void operator()(const f32x4 (&acc)[2][2][4][2], const Unit& u, int wr, int wc, int fr, int fq) const {
        const int row0 = u.pm * BM + wr * 64 + fr, col0 = u.pn * BM + wc * 32 + 4 * fq;
        int tk[2][4]; float wv[2][4];
#pragma unroll
        for (int ai = 0; ai < 2; ++ai)
#pragma unroll
            for (int m = 0; m < 4; ++m) { const int row = row0 + ai * HALF + m * 16; tk[ai][m] = tok[row]; wv[ai][m] = wgt[row]; }
#pragma unroll
        for (int ai = 0; ai < 2; ++ai) {
            f32x4 xv[4][2][2];
#pragma unroll
            for (int m = 0; m < 4; ++m) { const int t = tk[ai][m] < 0 ? 0 : tk[ai][m]; const float* xp = x + (size_t)t * 1024 + col0;
#pragma unroll
                for (int bj = 0; bj < 2; ++bj)
#pragma unroll
                    for (int n = 0; n < 2; ++n) xv[m][bj][n] = *(const f32x4*)(xp + bj * HALF + n * 16); }
#pragma unroll
            for (int m = 0; m < 4; ++m) if (tk[ai][m] >= 0) { float* xp = x + (size_t)tk[ai][m] * 1024 + col0;
#pragma unroll
                for (int bj = 0; bj < 2; ++bj)
#pragma unroll
                    for (int n = 0; n < 2; ++n) *(f32x4*)(xp + bj * HALF + n * 16) = xv[m][bj][n] + acc[ai][bj][m][n] * wv[ai][m]; }
        }
    }
};

template <class Epi, class Sched, bool GATHER = false, bool ABLK = false>
__device__ __forceinline__ void gemm_phase(PG8_LAS unsigned char* lds, const Gemm g, const Sched& S, const Epi& E) {
    int tid_ = threadIdx.x; asm volatile("" : "+v"(tid_));
    const int tid = tid_, wid = __builtin_amdgcn_readfirstlane(tid >> 6), lane = tid & 63, wr = wid >> 2, wc = wid & 3, fr = lane & 15, fq = lane >> 4;
    const int K = g.K, nt = K / BK;
    unsigned voffA[2], voffB[2];
#pragma unroll
    for (int i = 0; i < 2; ++i) { int R, C; stage_rc(tid * 16 + i * 8192, R, C); const int Rb = Epi::PERM ? ((R & ~31) + perm32(R & 31)) : R;
        voffA[i] = ABLK ? (unsigned)(((R >> 6) * (K >> 4) + (C >> 4)) * 2048 + (((R & 63) << 4) + (C & 15)) * 2) : (unsigned)(R * K + C) * 2u; voffB[i] = (unsigned)(Rb * K + C) * 2u; }
    const size_t kstep = (size_t)(BK * 2);
    const size_t hstep = (size_t)HALF * K * 2;
    const size_t tstep = 2 * hstep;
    const size_t hstepA = ABLK ? (size_t)2 * (K >> 4) * 2048 : hstep, tstepA = 2 * hstepA; constexpr size_t AKM = ABLK ? 64 : 1;
    const unsigned ldsw = (unsigned)wid * 1024u;
    const int aoff = lds_byte(wr * 64 + fr, fq * 8), boff = lds_byte(wc * 32 + fr, fq * 8);
    unsigned gvo[2][2];
#define PG8_SA(b, h) (((b) * 2 + (h)) * HTB)
#define PG8_SB(b, h) ((4 + (b) * 2 + (h)) * HTB)
#define PG8_STAGE(bufoff, gbase, voff) do { _Pragma("unroll") for (int _i = 0; _i < 2; ++_i) \
        __builtin_amdgcn_global_load_lds((const unsigned*)((const char*)(gbase) + (voff)[_i]), (PG8_LAS unsigned*)(lds + (bufoff) + ldsw + _i * 8192), 16, 0, 0); } while (0)
#define PG8_STAGE_A(bufoff, h, ubase, kb, nx) do { if constexpr (GATHER) { PG8_STAGE(bufoff, (const char*)g.A + (kb), gvo[h]); } \
        else { PG8_STAGE(bufoff, (ubase) + (kb) * AKM + (h) * hstepA, voffA); } } while (0)
#define PG8_LOADROWS(dst, unit) do { if constexpr (GATHER) { _Pragma("unroll") for (int _i = 0; _i < 2; ++_i) { int _R, _C; stage_rc(tid * 16 + _i * 8192, _R, _C); \
        _Pragma("unroll") for (int _h = 0; _h < 2; ++_h) { int _t = g.rowidx[(unit).pm * BM + _h * HALF + _R]; _t = _t < 0 ? 0 : _t; dst[_h][_i] = (unsigned)(_t * K + _C) * 2u; } } } } while (0)
#define PG8_LDA(dst, b, h) do { _Pragma("unroll") for (int m = 0; m < 4; ++m) _Pragma("unroll") for (int k = 0; k < 2; ++k) dst[m][k] = *(const PG8_LAS bf16x8*)(lds + PG8_SA(b, h) + aoff + m * 2048 + k * 1024); } while (0)
#define PG8_LDB(dst, b, h) do { _Pragma("unroll") for (int n = 0; n < 2; ++n) _Pragma("unroll") for (int k = 0; k < 2; ++k) dst[n][k] = *(const PG8_LAS bf16x8*)(lds + PG8_SB(b, h) + boff + n * 2048 + k * 1024); } while (0)
#define PG8_MMA(ai, bj, At, Bt) do { __builtin_amdgcn_s_setprio(1); _Pragma("unroll") for (int m = 0; m < 4; ++m) _Pragma("unroll") for (int n = 0; n < 2; ++n) _Pragma("unroll") for (int k = 0; k < 2; ++k) \
        acc[ai][bj][m][n] = __builtin_amdgcn_mfma_f32_16x16x32_bf16(Bt[n][k], At[m][k], acc[ai][bj][m][n], 0, 0, 0); __builtin_amdgcn_s_setprio(0); } while (0)
#define PG8_WAIT_V(n) asm volatile("s_waitcnt vmcnt(" #n ")" ::: "memory")
#define PG8_WAIT_L(n) asm volatile("s_waitcnt lgkmcnt(" #n ")" ::: "memory")
#define PG8_BAR __builtin_amdgcn_s_barrier()
#define PG8_SCHED __builtin_amdgcn_sched_barrier(0)
    Unit cur, nxt; int ui = 0;
    if (!S.next(0, cur)) return;
    f32x4 acc[2][2][4][2];
#pragma unroll
    for (int a = 0; a < 2; ++a)
#pragma unroll
        for (int b = 0; b < 2; ++b)
#pragma unroll
            for (int m = 0; m < 4; ++m)
#pragma unroll
                for (int n = 0; n < 2; ++n) acc[a][b][m][n] = (f32x4){0.f, 0.f, 0.f, 0.f};
    bf16x8 At[4][2], B0[2][2], B1[2][2];
    const char* cA = GATHER ? (const char*)g.A : (const char*)g.A + (size_t)cur.pm * tstepA;
    const char* cB = (const char*)g.Bt + ((size_t)cur.e * g.bstride) * 2 + (size_t)cur.pn * tstep;
    PG8_LOADROWS(gvo, cur);
    PG8_STAGE(PG8_SB(0, 0), cB, voffB); PG8_STAGE(PG8_SB(0, 1), cB + hstep, voffB); PG8_STAGE_A(PG8_SA(0, 0), 0, cA, 0, false); PG8_STAGE_A(PG8_SA(0, 1), 1, cA, 0, false);
    if (wr == 1) PG8_BAR;
    PG8_WAIT_V(2); PG8_BAR;
    PG8_STAGE(PG8_SB(1, 0), cB + kstep, voffB); PG8_STAGE_A(PG8_SA(1, 0), 0, cA, kstep, false); PG8_STAGE(PG8_SB(1, 1), cB + hstep + kstep, voffB);
    PG8_WAIT_V(6); PG8_BAR;
    for (;;) {
        const bool has_next = S.next(ui + 1, nxt);
        const char* nA = GATHER ? (const char*)g.A : (has_next ? (const char*)g.A + (size_t)nxt.pm * tstepA : cA);
        const char* nB = has_next ? (const char*)g.Bt + ((size_t)nxt.e * g.bstride) * 2 + (size_t)nxt.pn * tstep : cB;
        for (int t = 0; t < nt; t += 2) {
            const bool last = (t == nt - 2);
            const size_t k1 = (size_t)(t + 1) * kstep;
            const size_t k2 = last ? 0 : (size_t)(t + 2) * kstep, k3 = k2 + kstep;
            const char* a2b = last ? nA : cA; const char* b2 = (last ? nB : cB) + k2; const char* b3 = b2 + kstep;
            PG8_LDB(B0, 0, 0); PG8_LDB(B1, 0, 1); PG8_SCHED; PG8_LDA(At, 0, 0); PG8_STAGE_A(PG8_SA(1, 1), 1, cA, k1, false);
            if (last && has_next) PG8_LOADROWS(gvo, nxt);
            PG8_WAIT_V(8); PG8_WAIT_L(0); PG8_BAR; PG8_MMA(0, 0, At, B0); PG8_MMA(0, 1, At, B1); PG8_BAR; PG8_SCHED;
            PG8_LDA(At, 0, 1); PG8_STAGE(PG8_SB(0, 0), b2, voffB); PG8_STAGE(PG8_SB(0, 1), b2 + hstep, voffB); PG8_STAGE_A(PG8_SA(0, 0), 0, a2b, k2, last);
            PG8_WAIT_V(8); PG8_WAIT_L(0); PG8_BAR; PG8_MMA(1, 0, At, B0); PG8_MMA(1, 1, At, B1); PG8_BAR; PG8_SCHED;
            PG8_LDB(B0, 1, 0); PG8_LDB(B1, 1, 1); PG8_SCHED; PG8_LDA(At, 1, 0); PG8_STAGE_A(PG8_SA(0, 1), 1, a2b, k2, last);
            PG8_WAIT_V(8); PG8_WAIT_L(0); PG8_BAR; PG8_MMA(0, 0, At, B0); PG8_MMA(0, 1, At, B1); PG8_BAR; PG8_SCHED;
            PG8_LDA(At, 1, 1); PG8_STAGE(PG8_SB(1, 0), b3, voffB); PG8_STAGE(PG8_SB(1, 1), b3 + hstep, voffB); PG8_STAGE_A(PG8_SA(1, 0), 0, a2b, k3, last);
            PG8_WAIT_V(8); PG8_WAIT_L(0); PG8_BAR; PG8_MMA(1, 0, At, B0); PG8_MMA(1, 1, At, B1); PG8_BAR; PG8_SCHED;
        }
        if (wr == 0) PG8_BAR;
        E(acc, cur, wr, wc, fr, fq);
        if (!has_next) break;
#pragma unroll
        for (int a = 0; a < 2; ++a)
#pragma unroll
            for (int b = 0; b < 2; ++b)
#pragma unroll
                for (int m = 0; m < 4; ++m)
#pragma unroll
                    for (int n = 0; n < 2; ++n) acc[a][b][m][n] = (f32x4){0.f, 0.f, 0.f, 0.f};
        cur = nxt; cA = nA; cB = nB; ++ui;
        if (wr == 1) PG8_BAR;
    }
    PG8_WAIT_V(0);
    PG8_BAR;
#undef PG8_SA
#undef PG8_SB
#undef PG8_STAGE
#undef PG8_STAGE_A
#undef PG8_LOADROWS
#undef PG8_LDA
#undef PG8_LDB
#undef PG8_MMA
#undef PG8_WAIT_V
#undef PG8_WAIT_L
#undef PG8_BAR
#undef PG8_SCHED
}
}
using pg8::bf16_t; using pg8::bf16x8; using pg8::f32x4; using pg8::f32x2; using pg8::u32x4; using pg8::u32x2; using pg8::pk2; using pg8::bf2f; using pg8::f2bf; using pg8::bf_lo; using pg8::bf_hi; using pg8::sigmoidf_;

constexpr int NWAVES = 8, NTHR = 512;
constexpr int D = 1024, NB = 32, SEQ = 2048, T = NB * SEQ, TH = T / 2, DEPTH = 4;
constexpr int RW_COLS = 1792, DS_COLS = 1224, DS_PAD = 1280, N_IN = 5064, N_INP = 5120;
constexpr int NMEM = 256, MEMROWS = NB * NMEM;
constexpr int FFN = 2816, NEXP = 8, EDIM = 1408;
constexpr int MOE_ROWS_MAX = 2 * T + 16 * 256;
constexpr int MOE_TILES_MAX = MOE_ROWS_MAX / 256;

constexpr size_t MiB = 1u << 20;
constexpr size_t WS_CTL = 0, CTL_ZERO_BYTES = 1 * MiB;
constexpr size_t WS_MOE = 1 * MiB;
constexpr size_t MOE_SELE = WS_MOE, MOE_SELW = MOE_SELE + (size_t)T * 2, MOE_ROWTOK = MOE_SELW + (size_t)T * 8, MOE_ROWW = MOE_ROWTOK + (size_t)MOE_ROWS_MAX * 4,
                 MOE_TILEE = MOE_ROWW + (size_t)MOE_ROWS_MAX * 4, MOE_META = MOE_TILEE + (size_t)MOE_TILES_MAX * 4, MOE_END = MOE_META + 256;
static_assert(MOE_END <= 4 * MiB, "moe map");
constexpr size_t WS_W = 4 * MiB;
constexpr size_t W_IN = WS_W, W_BA = W_IN + (size_t)N_INP * D * 2, W_BB = W_BA + (size_t)D * 512 * 2, W_OUT = W_BB + (size_t)D * 512 * 2, W_MQ = W_OUT + (size_t)D * D * 2,
                 W_MO = W_MQ + (size_t)512 * D * 2, W_FF = W_MO + (size_t)D * 512 * 2;
constexpr size_t W_RW2 = W_FF, W_RA2 = W_RW2 + 512 * 64 * 2, W_RG2 = W_RA2 + 512 * 64 * 2, W_RV1 = W_RG2 + 512 * 128 * 2, W_RV2 = W_RV1 + 32 * 512 * 2, W_FF2 = W_RV2 + 512 * 32 * 2;
constexpr size_t W_FGU = W_FF2, W_FD = W_FGU + (size_t)2 * FFN * D * 2;
constexpr size_t W_EGU = W_FF2, W_ED = W_EGU + (size_t)NEXP * 2 * EDIM * D * 2, W_END = W_ED + (size_t)NEXP * D * EDIM * 2;
static_assert(W_FD + (size_t)D * FFN * 2 <= W_END, "w map");
constexpr size_t WS_WKV = (W_END + MiB - 1) / MiB * MiB;
constexpr size_t WS_MEMH = WS_WKV + (size_t)4096 * D * 2;
constexpr size_t WS_MEMK = WS_MEMH + (size_t)MEMROWS * D * 2;
constexpr size_t WS_MEMVT = WS_MEMK + (size_t)DEPTH * MEMROWS * 512 * 2;
constexpr size_t WS_VFIRST = WS_MEMVT + (size_t)DEPTH * MEMROWS * 512 * 2;
constexpr size_t WS_HN = WS_VFIRST + (size_t)T * 512 * 2;
constexpr size_t WS_MIX = WS_HN + (size_t)T * D * 2;
constexpr size_t MX_CA = WS_MIX, MX_CB = MX_CA + (size_t)TH * RW_COLS * 2, MX_CG = MX_CB + (size_t)TH * DS_PAD * 2, MX_RW = MX_CG + (size_t)TH * 2048 * 2;
constexpr size_t RW_ARR = (size_t)TH * 512 * 2;
constexpr size_t MX_VT = MX_RW + 7 * RW_ARR, MX_YB = MX_VT + (size_t)(NB / 2) * 64 * SEQ * 2, MX_END = MX_YB + (size_t)TH * 512 * 2;
constexpr size_t MA_QM = WS_MIX, MA_OM = MA_QM + (size_t)T * 512 * 2;
constexpr size_t FF_GU = WS_MIX;
constexpr size_t PR_KVRAW = WS_MIX;
constexpr size_t MX_BS = MX_END;
constexpr size_t WS_END = MX_BS + (size_t)TH * 8 * 4;
static_assert(FF_GU + (size_t)T * FFN * 2 <= WS_END && FF_GU + (size_t)MOE_ROWS_MAX * EDIM * 2 <= WS_END && MA_OM + (size_t)T * 512 * 2 <= WS_END, "overlay map");
static_assert(WS_END <= 1000 * MiB, "workspace budget");

constexpr int LDS_BYTES = 160 * 1024;
constexpr int LDS_MISC = LDS_BYTES - 256;

#define XB_TMO      128
#define XB_XCNT(j)  (256  + 64 * (j))
#define XB_XSUB(j)  (1280 + 64 * (j))
#define XB_XGEN(j)  (2304 + 64 * (j))
#define XB_TOP      3328
#define XB_TOPGEN   3392
#define XCD_BAR_WORDS 3456
#define XB_SPIN_CAP (1u << 18)
#define LAS __attribute__((address_space(3)))

__device__ __forceinline__ unsigned xb_ld(unsigned* p)              { return __hip_atomic_load(p, __ATOMIC_RELAXED, __HIP_MEMORY_SCOPE_AGENT); }
__device__ __forceinline__ unsigned xb_add(unsigned* p, unsigned v) { return __hip_atomic_fetch_add(p, v, __ATOMIC_RELAXED, __HIP_MEMORY_SCOPE_AGENT); }
__device__ __forceinline__ unsigned xb_xcc_id() { return (unsigned)__builtin_amdgcn_s_getreg((3 << 11) | 20) & 0xFu; }
#define XB_SPIN(cond, bar) do { unsigned _sp = 0; while (cond) { __builtin_amdgcn_s_sleep(1); \
    if ((++_sp & 255u) == 0u) { if (xb_ld(&(bar)[XB_TMO])) break; if (_sp > XB_SPIN_CAP) { atomicAdd(&(bar)[XB_TMO], 1u); break; } } } } while (0)
struct XcdBarrier { unsigned* bar; unsigned x; volatile LAS unsigned* st; };
__device__ __forceinline__ XcdBarrier xcd_barrier_post(unsigned* bar, volatile LAS unsigned* st) {
    XcdBarrier b; b.bar = bar; b.x = xb_xcc_id(); b.st = st;
    if (threadIdx.x == 0) (void)xb_add(&bar[XB_XCNT(b.x)], 1u);
    return b;
}
__device__ __forceinline__ void xcd_barrier_complete(unsigned* bar, unsigned x, unsigned& nloc, unsigned& nx) {
    const unsigned G = gridDim.x * gridDim.y * gridDim.z;
    unsigned sum, cnt, mine, sp = 0u;
    for (;;) {
        sum = 0u; cnt = 0u; mine = 0u;
#pragma unroll
        for (unsigned j = 0; j < 16; ++j) { const unsigned c = xb_ld(&bar[XB_XCNT(j)]); sum += c; cnt += (c > 0u) ? 1u : 0u; mine = (j == x) ? c : mine; }
        if (sum == G) break;
        __builtin_amdgcn_s_sleep(1);
        if ((++sp & 255u) == 0u) { if (xb_ld(&bar[XB_TMO])) break; if (sp > XB_SPIN_CAP) { atomicAdd(&bar[XB_TMO], 1u); break; } }
    }
    nloc = mine > 0u ? mine : 1u; nx = cnt > 0u ? cnt : 1u;
}
__device__ __forceinline__ void xcd_barrier(const XcdBarrier& b) {
    asm volatile("s_waitcnt vmcnt(0)" ::: "memory");
    __syncthreads();
    if (threadIdx.x == 0) {
        unsigned* bar = b.bar;
        __builtin_amdgcn_s_waitcnt(0);
        unsigned nloc = b.st[0], nx = b.st[1];
        if (nloc == 0u) { xcd_barrier_complete(bar, b.x, nloc, nx); b.st[0] = nloc; b.st[1] = nx; }
        const unsigned old = xb_add(&bar[XB_XSUB(b.x)], 1u);
        const unsigned gen = old / nloc;
        if (old + 1u == (gen + 1u) * nloc) {
            __builtin_amdgcn_fence(__ATOMIC_RELEASE, "agent");
            asm volatile("s_waitcnt vmcnt(0)" ::: "memory");
            const unsigned og = xb_add(&bar[XB_TOP], 1u);
            const unsigned tg = og / nx;
            if (og + 1u == (tg + 1u) * nx) xb_add(&bar[XB_TOPGEN], 1u);
            else XB_SPIN(xb_ld(&bar[XB_TOPGEN]) == tg, bar);
            __builtin_amdgcn_fence(__ATOMIC_ACQUIRE, "agent");
            xb_add(&bar[XB_XGEN(b.x)], 1u);
            asm volatile("s_waitcnt vmcnt(0)" ::: "memory");
        } else {
            XB_SPIN(xb_ld(&bar[XB_XGEN(b.x)]) == gen, bar);
            __builtin_amdgcn_fence(__ATOMIC_ACQUIRE, "agent");
            asm volatile("s_waitcnt vmcnt(0)" ::: "memory");
        }
    }
    __syncthreads();
}

struct Args { const void* in[41]; float* out; unsigned char* ws; int ph_lo, ph_hi; };
static_assert(sizeof(Args) == 41 * 8 + 8 + 8 + 8, "Args has no padding");

enum InIdx { I_X = 0, I_MEM, I_POS, I_NORM_MIX, I_W_IN, I_MU, I_W0, I_W2, I_A0, I_A2, I_G2, I_V0, I_V1, I_V2, I_KK, I_KA, I_RK, I_LNG, I_LNB, I_QN, I_KN, I_IKN,
             I_WBA, I_WBB, I_WOUT, I_NORM_MEM, I_MEM_TOKN, I_MWQ, I_MWKV, I_MQN, I_MKN, I_MWO, I_NORM_FFN, I_FWG, I_FWU, I_FWD, I_ROUTER, I_RBIAS, I_EWG, I_EWU, I_EWD };

typedef decltype(__builtin_amdgcn_kernarg_segment_ptr()) kptr_t;
struct Frame {
    LAS unsigned char* lds; unsigned char* ws; kptr_t kb; float* out;
    int tid, lane, wave, G, bid;
};
#define LDS_WAIT() asm volatile("s_waitcnt lgkmcnt(0)" ::: "memory")
__device__ __forceinline__ const void* kargp(kptr_t kb, int i) { typedef const void* cvp; typedef __attribute__((address_space(4))) const cvp* tab_t; return (const void*)(const __attribute__((address_space(1))) void*)(((tab_t)kb)[i]); }
#define KARGP(F, i) kargp((F).kb, (i))
#define FIN(F, i) ((const float*)KARGP(F, i))
__device__ __forceinline__ void lds_barrier() { asm volatile("s_waitcnt lgkmcnt(0)" ::: "memory"); __builtin_amdgcn_s_barrier(); asm volatile("" ::: "memory"); }

__device__ __forceinline__ float wave_sum(float v) {
#pragma unroll
    for (int o = 1; o < 64; o <<= 1) v += __shfl_xor(v, o);
    return v;
}

template <class Map>
__device__ __forceinline__ void transpose_item(const float* W, int K, int N, bf16_t* WT, const Map& map, const float* gain, LAS float* scr, int item, int lane) {
    const int nblk = (N + 31) / 32, kb = item / nblk, nb = item % nblk, k0 = 64 * kb, n0 = 32 * nb;
    const int nn = n0 + (lane & 31);
    float vv[32], gg[32];
#pragma unroll
    for (int i = 0; i < 32; ++i) { const int kk = 2 * i + (lane >> 5); vv[i] = 0.f; gg[i] = 1.f; if (nn < N && k0 + kk < K) { vv[i] = W[(size_t)(k0 + kk) * N + nn]; if (gain) gg[i] = gain[k0 + kk]; } }
#pragma unroll
    for (int i = 0; i < 32; ++i) { const int kk = 2 * i + (lane >> 5); scr[kk * 33 + (lane & 31)] = vv[i] * gg[i]; }
    LDS_WAIT(); asm volatile("" ::: "memory");
    const int c = lane & 7;
#pragma unroll
    for (int j = 0; j < 4; ++j) { const int n = (lane >> 3) + 8 * j; const LAS float* s = scr + (8 * c) * 33 + n;
        u32x4 o; o.x = pk2(s[0 * 33], s[1 * 33]); o.y = pk2(s[2 * 33], s[3 * 33]); o.z = pk2(s[4 * 33], s[5 * 33]); o.w = pk2(s[6 * 33], s[7 * 33]);
        if (n0 + n < N && k0 + 8 * c < K) *(u32x4*)(WT + (size_t)map(n0 + n) * K + k0 + 8 * c) = o; }
    LDS_WAIT(); asm volatile("" ::: "memory");
}
struct MapId { int off; __device__ int operator()(int n) const { return n + off; } };
struct MapWin { __device__ int operator()(int n) const { return n < 3016 ? n : n + 56; } };
struct MapGU { int up; __device__ int operator()(int n) const { return (n >> 7) * 256 + up * 128 + (n & 127); } };

__device__ __forceinline__ void rms_row_to_bf16(const float* xrow, bf16_t* orow, int lane, f32x4 (&v)[4]) {
    const f32x4* xr = (const f32x4*)xrow + lane; float s = 0.f;
#pragma unroll
    for (int j = 0; j < 4; ++j) { v[j] = xr[64 * j]; s += (v[j].x * v[j].x + v[j].y * v[j].y) + (v[j].z * v[j].z + v[j].w * v[j].w); }
    const float rstd = 1.0f / sqrtf(wave_sum(s) * (1.f / D) + 1e-6f);
    u32x2* o8 = (u32x2*)orow + lane;
#pragma unroll
    for (int j = 0; j < 4; ++j) { v[j] = v[j] * rstd; u32x2 w; w.x = pk2(v[j].x, v[j].y); w.y = pk2(v[j].z, v[j].w); o8[64 * j] = w; }
}

__device__ __forceinline__ void rms_pass_to_bf16(const float* x, bf16_t* o, int first, int stride, int lane) {
    f32x4 v[4][4], n[4][4];
#pragma unroll
    for (int r = 0; r < 4; ++r) { const f32x4* xr = (const f32x4*)(x + (size_t)(first + r * stride) * D) + lane;
#pragma unroll
        for (int j = 0; j < 4; ++j) n[r][j] = xr[64 * j]; }
#pragma unroll 1
    for (int m0 = first; m0 < T; m0 += 4 * stride) {
#pragma unroll
        for (int r = 0; r < 4; ++r)
#pragma unroll
            for (int j = 0; j < 4; ++j) { v[r][j] = n[r][j]; asm volatile("" : "+v"(v[r][j])); }
        { const int mn = (m0 + 4 * stride < T) ? m0 + 4 * stride : m0;
#pragma unroll
          for (int r = 0; r < 4; ++r) { const f32x4* xr = (const f32x4*)(x + (size_t)(mn + r * stride) * D) + lane;
#pragma unroll
              for (int j = 0; j < 4; ++j) n[r][j] = xr[64 * j]; }
          asm volatile("" ::: "memory"); }
        float s[4];
#pragma unroll
        for (int r = 0; r < 4; ++r) { s[r] = 0.f;
#pragma unroll
            for (int j = 0; j < 4; ++j) s[r] += (v[r][j].x * v[r][j].x + v[r][j].y * v[r][j].y) + (v[r][j].z * v[r][j].z + v[r][j].w * v[r][j].w); }
#pragma unroll
        for (int o_ = 1; o_ < 64; o_ <<= 1) {
#pragma unroll
            for (int r = 0; r < 4; ++r) s[r] += __shfl_xor(s[r], o_); }
#pragma unroll
        for (int r = 0; r < 4; ++r) { const float rstd = 1.0f / sqrtf(s[r] * (1.f / D) + 1e-6f); u32x2* o8 = (u32x2*)(o + (size_t)(m0 + r * stride) * D) + lane;
#pragma unroll
            for (int j = 0; j < 4; ++j) { const f32x4 t = v[r][j] * rstd; u32x2 w; w.x = pk2(t.x, t.y); w.y = pk2(t.z, t.w); o8[64 * j] = w; } }
    }
}
__device__ __forceinline__ void ph_prologue0(Frame& F) {
    LAS float* scr = (LAS float*)(F.lds + F.wave * 16384);
    const int gw = F.bid * NWAVES + F.wave, NGW = F.G * NWAVES;
    bf16_t* wkv = (bf16_t*)(F.ws + WS_WKV);
    constexpr int IT = (D / 64) * (1024 / 32);
    for (int it = gw; it < DEPTH * IT; it += NGW) { const int l = it / IT, r = it % IT;
        transpose_item(FIN(F, I_MWKV) + (size_t)l * D * 1024, D, 1024, wkv, MapId{l * 1024}, FIN(F, I_MEM_TOKN) + l * D, scr, r, F.lane); }
    bf16_t* mh = (bf16_t*)(F.ws + WS_MEMH);
    for (int m = gw; m < MEMROWS; m += NGW) { f32x4 v[4]; rms_row_to_bf16(FIN(F, I_MEM) + (size_t)m * D, mh + (size_t)m * D, F.lane, v); }
}
__device__ __forceinline__ void ph_prologue2(Frame& F) {
    const int gw = F.bid * NWAVES + F.wave, NGW = F.G * NWAVES;
    const bf16_t* kv = (const bf16_t*)(F.ws + PR_KVRAW);
    bf16_t* MK = (bf16_t*)(F.ws + WS_MEMK); bf16_t* MVT = (bf16_t*)(F.ws + WS_MEMVT);
    for (int it = gw; it < MEMROWS * 16; it += NGW) {
        const int row = it >> 4, l = (it >> 2) & 3, hh = it & 3, b = row >> 8, m = row & 255;
        const bf16_t* src = kv + (size_t)row * 4096 + l * 1024;
        const unsigned kk = *(const unsigned*)(src + hh * 128 + 2 * F.lane);
        const float k0 = bf_lo(kk), k1 = bf_hi(kk);
        const float rstd = 1.0f / sqrtf(wave_sum(k0 * k0 + k1 * k1) * (1.f / 128.f) + 1e-6f);
        const float* gk = FIN(F, I_MKN) + l * 128;
        *(unsigned*)(MK + ((((size_t)l * NB + b) * 4 + hh) * 256 + m) * 128 + 2 * F.lane) = pk2(k0 * rstd * gk[2 * F.lane], k1 * rstd * gk[2 * F.lane + 1]);
        const unsigned vv = *(const unsigned*)(src + 512 + hh * 128 + 2 * F.lane);
        bf16_t* vt = MVT + (((size_t)l * NB + b) * 4 + hh) * 128 * 256 + m;
        vt[(size_t)(2 * F.lane) * 256] = (bf16_t)(vv & 0xffffu); vt[(size_t)(2 * F.lane + 1) * 256] = (bf16_t)(vv >> 16);
    }
}
__device__ __forceinline__ void ph_layer0(Frame& F, int l, const float* xin) {
    LAS float* scr = (LAS float*)(F.lds + F.wave * 16384);
    const int gw = F.bid * NWAVES + F.wave, NGW = F.G * NWAVES;
    unsigned char* ws = F.ws;
    constexpr int I_WIN = (D / 64) * ((N_IN + 31) / 32), I_B = (512 / 64) * (D / 32), I_O = (D / 64) * (D / 32), I_Q = (D / 64) * (512 / 32);
    constexpr int I_FG = (D / 64) * (FFN / 32), I_FDN = (FFN / 64) * (D / 32), I_EG = (D / 64) * (EDIM / 32), I_EDN = (EDIM / 64) * (D / 32);
    const bool moe = (l & 1) != 0; const int j = l >> 1;
    const int nff = moe ? NEXP * (2 * I_EG + I_EDN) : (2 * I_FG + I_FDN);
    constexpr int I_R2 = 16, I_RG = 32, I_RV1 = 8, I_RV2 = 16;
    const int nrw = 2 * I_R2 + I_RG + (l ? I_RV1 + I_RV2 : 0);
    const int NIT = I_WIN + 2 * I_B + I_O + I_Q + I_B + nrw + nff;
    const float* gffn = FIN(F, I_NORM_FFN) + l * D;
    for (int it = gw; it < NIT; it += NGW) {
        int r = it;
        if (r < I_WIN) { transpose_item(FIN(F, I_W_IN) + (size_t)l * D * N_IN, D, N_IN, (bf16_t*)(ws + W_IN), MapWin{}, FIN(F, I_NORM_MIX) + l * D, scr, r, F.lane); continue; } r -= I_WIN;
        if (r < I_B) { transpose_item(FIN(F, I_WBA) + (size_t)l * 512 * D, 512, D, (bf16_t*)(ws + W_BA), MapId{0}, nullptr, scr, r, F.lane); continue; } r -= I_B;
        if (r < I_B) { transpose_item(FIN(F, I_WBB) + (size_t)l * 512 * D, 512, D, (bf16_t*)(ws + W_BB), MapId{0}, nullptr, scr, r, F.lane); continue; } r -= I_B;
        if (r < I_O) { transpose_item(FIN(F, I_WOUT) + (size_t)l * D * D, D, D, (bf16_t*)(ws + W_OUT), MapId{0}, nullptr, scr, r, F.lane); continue; } r -= I_O;
        if (r < I_Q) { transpose_item(FIN(F, I_MWQ) + (size_t)l * D * 512, D, 512, (bf16_t*)(ws + W_MQ), MapId{0}, FIN(F, I_NORM_MEM) + l * D, scr, r, F.lane); continue; } r -= I_Q;
        if (r < I_B) { transpose_item(FIN(F, I_MWO) + (size_t)l * 512 * D, 512, D, (bf16_t*)(ws + W_MO), MapId{0}, nullptr, scr, r, F.lane); continue; } r -= I_B;
        if (r < nrw) {
            if (r < I_R2) { transpose_item(FIN(F, I_W2) + (size_t)l * 64 * 512, 64, 512, (bf16_t*)(ws + W_RW2), MapId{0}, nullptr, scr, r, F.lane); continue; } r -= I_R2;
            if (r < I_R2) { transpose_item(FIN(F, I_A2) + (size_t)l * 64 * 512, 64, 512, (bf16_t*)(ws + W_RA2), MapId{0}, nullptr, scr, r, F.lane); continue; } r -= I_R2;
            if (r < I_RG) { transpose_item(FIN(F, I_G2) + (size_t)l * 128 * 512, 128, 512, (bf16_t*)(ws + W_RG2), MapId{0}, nullptr, scr, r, F.lane); continue; } r -= I_RG;
            if (r < I_RV1) { transpose_item(FIN(F, I_V1) + (size_t)(l - 1) * 512 * 32, 512, 32, (bf16_t*)(ws + W_RV1), MapId{0}, nullptr, scr, r, F.lane); continue; } r -= I_RV1;
            transpose_item(FIN(F, I_V2) + (size_t)(l - 1) * 32 * 512, 32, 512, (bf16_t*)(ws + W_RV2), MapId{0}, nullptr, scr, r, F.lane); continue;
        }
        r -= nrw;
        if (!moe) {
            if (r < I_FG) { transpose_item(FIN(F, I_FWG) + (size_t)j * D * FFN, D, FFN, (bf16_t*)(ws + W_FGU), MapGU{0}, gffn, scr, r, F.lane); continue; } r -= I_FG;
            if (r < I_FG) { transpose_item(FIN(F, I_FWU) + (size_t)j * D * FFN, D, FFN, (bf16_t*)(ws + W_FGU), MapGU{1}, gffn, scr, r, F.lane); continue; } r -= I_FG;
            transpose_item(FIN(F, I_FWD) + (size_t)j * FFN * D, FFN, D, (bf16_t*)(ws + W_FD), MapId{0}, nullptr, scr, r, F.lane);
        } else {
            const int per = 2 * I_EG + I_EDN, e = r / per; r -= e * per;
            const size_t eo = (size_t)(j * NEXP + e);
            if (r < I_EG) { transpose_item(FIN(F, I_EWG) + eo * D * EDIM, D, EDIM, (bf16_t*)(ws + W_EGU) + (size_t)e * 2 * EDIM * D, MapGU{0}, gffn, scr, r, F.lane); continue; } r -= I_EG;
            if (r < I_EG) { transpose_item(FIN(F, I_EWU) + eo * D * EDIM, D, EDIM, (bf16_t*)(ws + W_EGU) + (size_t)e * 2 * EDIM * D, MapGU{1}, gffn, scr, r, F.lane); continue; } r -= I_EG;
            transpose_item(FIN(F, I_EWD) + eo * EDIM * D, EDIM, D, (bf16_t*)(ws + W_ED) + (size_t)e * D * EDIM, MapId{0}, nullptr, scr, r, F.lane);
        }
    }
    { u32x4* z = (u32x4*)((bf16_t*)(ws + W_IN) + (size_t)3016 * D); const int n16 = 56 * D * 2 / 16;
      for (int i = F.bid * NTHR + F.tid; i < n16; i += F.G * NTHR) z[i] = (u32x4){0u, 0u, 0u, 0u}; }
    bf16_t* hn = (bf16_t*)(ws + WS_HN);
    rms_pass_to_bf16(xin, hn, gw, NGW, F.lane);
}
__device__ __forceinline__ void ph_norm(Frame& F) {
    const int gw = F.bid * NWAVES + F.wave, NGW = F.G * NWAVES;
    bf16_t* hn = (bf16_t*)(F.ws + WS_HN);
    rms_pass_to_bf16(F.out, hn, gw, NGW, F.lane);
}
__device__ __forceinline__ void ph_norm_ffn(Frame& F, int l) {
    const int gw = F.bid * NWAVES + F.wave, NGW = F.G * NWAVES;
    bf16_t* hn = (bf16_t*)(F.ws + WS_HN);
    const bool moe = (l & 1) != 0; const int j = l >> 1;
    const float* gn = FIN(F, I_NORM_FFN) + l * D;
    const float* rt = FIN(F, I_ROUTER) + (size_t)j * D * NEXP; const float* rb = FIN(F, I_RBIAS) + j * NEXP;
    unsigned short* sele = (unsigned short*)(F.ws + MOE_SELE); f32x2* selw = (f32x2*)(F.ws + MOE_SELW);
    if (!moe) { rms_pass_to_bf16(F.out, hn, gw, NGW, F.lane); return; }
    for (int m = gw; m < T; m += NGW) {
        f32x4 v[4]; rms_row_to_bf16(F.out + (size_t)m * D, hn + (size_t)m * D, F.lane, v);
        if (moe) {
            float lg[8];
#pragma unroll
            for (int e = 0; e < 8; ++e) lg[e] = 0.f;
#pragma unroll
            for (int q = 0; q < 4; ++q)
#pragma unroll
                for (int c = 0; c < 4; ++c) { const int k = 256 * q + 4 * F.lane + c; const float h = v[q][c] * gn[k];
                    const f32x4 r0 = *(const f32x4*)(rt + (size_t)k * 8), r1 = *(const f32x4*)(rt + (size_t)k * 8 + 4);
                    lg[0] += h * r0.x; lg[1] += h * r0.y; lg[2] += h * r0.z; lg[3] += h * r0.w; lg[4] += h * r1.x; lg[5] += h * r1.y; lg[6] += h * r1.z; lg[7] += h * r1.w; }
#pragma unroll
            for (int e = 0; e < 8; ++e) lg[e] = wave_sum(lg[e]) + rb[e];
            int e0 = 0; float l0 = lg[0];
#pragma unroll
            for (int e = 1; e < 8; ++e) if (lg[e] > l0) { l0 = lg[e]; e0 = e; }
            int e1 = -1; float l1 = -3.0e38f;
#pragma unroll
            for (int e = 0; e < 8; ++e) if (e != e0 && lg[e] > l1) { l1 = lg[e]; e1 = e; }
            const float w1 = 1.0f / (1.0f + __expf(l0 - l1)), w0 = 1.0f - w1;
            if (F.lane == 0) { sele[m] = (unsigned short)(e0 | (e1 << 8)); selw[m] = (f32x2){w0, w1}; }
        }
    }
}

#define MFMA16(x, y, c) __builtin_amdgcn_mfma_f32_16x16x32_bf16((x), (y), (c), 0, 0, 0)
__device__ __forceinline__ float softplusf_(float x) { return fmaxf(x, 0.f) + log1pf(expf(-fabsf(x))); }
typedef __attribute__((address_space(3))) bf16_t lbf;
constexpr int LDP = 72;
constexpr int SLOT = 64 * LDP * 2;
__device__ __forceinline__ f32x4 unpack4(u32x2 u) { return (f32x4){bf_lo(u.x), bf_hi(u.x), bf_lo(u.y), bf_hi(u.y)}; }
__device__ __forceinline__ u32x2 pack4(f32x4 v) { u32x2 o; o.x = pk2(v[0], v[1]); o.y = pk2(v[2], v[3]); return o; }
__device__ __forceinline__ size_t rwo(int t, int col) { return ((size_t)((t >> 6) * 32 + (col >> 4)) << 10) + (size_t)(((t & 63) << 4) + (col & 15)); }
__device__ __forceinline__ void mm64(const lbf* X, const lbf* Y, int w, int jl, int g, f32x4 (&acc)[2]) {
    const lbf* xr = X + (16 * (w & 3) + jl) * LDP + 8 * g;
    const lbf* yr = Y + (16 * (2 * (w >> 2)) + jl) * LDP + 8 * g;
    const bf16x8 x0 = *(const LAS bf16x8*)xr, x1 = *(const LAS bf16x8*)(xr + 32);
    const bf16x8 y00 = *(const LAS bf16x8*)yr, y01 = *(const LAS bf16x8*)(yr + 32), y10 = *(const LAS bf16x8*)(yr + 16 * LDP), y11 = *(const LAS bf16x8*)(yr + 16 * LDP + 32);
    acc[0] = MFMA16(x0, y00, acc[0]); acc[1] = MFMA16(x0, y10, acc[1]); acc[0] = MFMA16(x1, y01, acc[0]); acc[1] = MFMA16(x1, y11, acc[1]);
}
struct FrX { bf16x8 k0, k1; }; struct FrY { bf16x8 a0, a1, b0, b1; };
__device__ __forceinline__ FrX ldx64(const lbf* X, int w, int jl, int g) { const lbf* xr = X + (16 * (w & 3) + jl) * LDP + 8 * g; FrX f; f.k0 = *(const LAS bf16x8*)xr; f.k1 = *(const LAS bf16x8*)(xr + 32); return f; }
__device__ __forceinline__ FrY ldy64(const lbf* Y, int w, int jl, int g) { const lbf* yr = Y + (16 * (2 * (w >> 2)) + jl) * LDP + 8 * g; FrY f;
    f.a0 = *(const LAS bf16x8*)yr; f.a1 = *(const LAS bf16x8*)(yr + 32); f.b0 = *(const LAS bf16x8*)(yr + 16 * LDP); f.b1 = *(const LAS bf16x8*)(yr + 16 * LDP + 32); return f; }
__device__ __forceinline__ void mma64(const FrX& x, const FrY& y, f32x4 (&acc)[2]) {
    acc[0] = MFMA16(x.k0, y.a0, acc[0]); acc[1] = MFMA16(x.k0, y.b0, acc[1]); acc[0] = MFMA16(x.k1, y.a1, acc[0]); acc[1] = MFMA16(x.k1, y.b1, acc[1]); }
__device__ __forceinline__ void st_t(lbf* dst, const f32x4 (&acc)[2], int w, int jl, int g) {
#pragma unroll
    for (int i = 0; i < 2; ++i) *(LAS u32x2*)(dst + (16 * (2 * (w >> 2) + i) + jl) * LDP + 16 * (w & 3) + 4 * g) = pack4(acc[i]);
}
__device__ __forceinline__ void st_n(lbf* dst, const f32x4 (&acc)[2], int w, int jl, int g) {
#pragma unroll
    for (int i = 0; i < 2; ++i)
#pragma unroll
        for (int r = 0; r < 4; ++r) dst[(16 * (w & 3) + 4 * g + r) * LDP + 16 * (2 * (w >> 2) + i) + jl] = f2bf(acc[i][r]);
}
#define ZACC(a) do { a[0] = (f32x4){0.f, 0.f, 0.f, 0.f}; a[1] = (f32x4){0.f, 0.f, 0.f, 0.f}; } while (0)

constexpr int XA_LD = 264, XV_LD = 520, VM_LD = 40;
__device__ __forceinline__ void ph_rwkv_prep(Frame& F, int l, int half) {
    lbf* XA = (lbf*)F.lds;
    lbf* XV = (lbf*)(F.lds + 64 * XA_LD * 2);
    lbf* VM = (lbf*)(F.lds + 64 * XA_LD * 2 + 64 * XV_LD * 2);
    const bf16_t* CA = (const bf16_t*)(F.ws + MX_CA);
    bf16_t* RW = (bf16_t*)(F.ws + MX_RW); constexpr size_t AS_ = (size_t)TH * 512;
    bf16_t* VF = (bf16_t*)(F.ws + WS_VFIRST) + (size_t)half * TH * 512;
    const bf16_t* W2T = (const bf16_t*)(F.ws + W_RW2); const bf16_t* A2T = (const bf16_t*)(F.ws + W_RA2); const bf16_t* G2T = (const bf16_t*)(F.ws + W_RG2);
    const bf16_t* V1T = (const bf16_t*)(F.ws + W_RV1); const bf16_t* V2T = (const bf16_t*)(F.ws + W_RV2);
    const float* mu = FIN(F, I_MU) + l * RW_COLS;
    const int lane = F.lane, w = F.wave, jl = lane & 15, g = lane >> 4;
    for (int tile = F.bid; tile < TH / 64; tile += F.G) {
        const int t0 = tile * 64;
        lds_barrier();
        for (int it = F.tid; it < 64 * 32; it += NTHR) { const int i = it >> 5, c = 1536 + (it & 31) * 8; const int t = t0 + i;
            const u32x4 cu = *(const u32x4*)(CA + (size_t)t * RW_COLS + c);
            u32x4 pv = (u32x4){0u, 0u, 0u, 0u}; if ((t & (SEQ - 1)) != 0) pv = *(const u32x4*)(CA + (size_t)(t - 1) * RW_COLS + c);
            const float cv[8] = { bf_lo(cu.x), bf_hi(cu.x), bf_lo(cu.y), bf_hi(cu.y), bf_lo(cu.z), bf_hi(cu.z), bf_lo(cu.w), bf_hi(cu.w) };
            const float pp[8] = { bf_lo(pv.x), bf_hi(pv.x), bf_lo(pv.y), bf_hi(pv.y), bf_lo(pv.z), bf_hi(pv.z), bf_lo(pv.w), bf_hi(pv.w) };
            float x[8];
#pragma unroll
            for (int q = 0; q < 8; ++q) { x[q] = cv[q] + (pp[q] - cv[q]) * mu[c + q]; if (c < 1600) x[q] = 1.0f - 2.0f * __builtin_amdgcn_rcpf(1.0f + __expf(2.0f * x[q])); else if (c >= 1664) x[q] = sigmoidf_(x[q]); }
            u32x4 o; o.x = pk2(x[0], x[1]); o.y = pk2(x[2], x[3]); o.z = pk2(x[4], x[5]); o.w = pk2(x[6], x[7]);
            *(LAS u32x4*)(XA + i * XA_LD + (c - 1536)) = o; }
        if (l) for (int it = F.tid; it < 64 * 64; it += NTHR) { const int i = it >> 6, c = 1024 + (it & 63) * 8; const int t = t0 + i;
            const u32x4 cu = *(const u32x4*)(CA + (size_t)t * RW_COLS + c);
            u32x4 pv = (u32x4){0u, 0u, 0u, 0u}; if ((t & (SEQ - 1)) != 0) pv = *(const u32x4*)(CA + (size_t)(t - 1) * RW_COLS + c);
            const float cv[8] = { bf_lo(cu.x), bf_hi(cu.x), bf_lo(cu.y), bf_hi(cu.y), bf_lo(cu.z), bf_hi(cu.z), bf_lo(cu.w), bf_hi(cu.w) };
            const float pp[8] = { bf_lo(pv.x), bf_hi(pv.x), bf_lo(pv.y), bf_hi(pv.y), bf_lo(pv.z), bf_hi(pv.z), bf_lo(pv.w), bf_hi(pv.w) };
            float x[8];
#pragma unroll
            for (int q = 0; q < 8; ++q) x[q] = cv[q] + (pp[q] - cv[q]) * mu[c + q];
            u32x4 o; o.x = pk2(x[0], x[1]); o.y = pk2(x[2], x[3]); o.z = pk2(x[4], x[5]); o.w = pk2(x[6], x[7]);
            *(LAS u32x4*)(XV + i * XV_LD + (c - 1024)) = o; }
        lds_barrier();
        if (l) { const int tg = w & 3, nt = w >> 2; f32x4 a = (f32x4){0.f, 0.f, 0.f, 0.f};
            const bf16_t* xr = V1T + (size_t)(16 * nt + jl) * 512 + 8 * g; const lbf* yr = XV + (16 * tg + jl) * XV_LD + 8 * g;
#pragma unroll 4
            for (int s = 0; s < 16; ++s) a = MFMA16(*(const bf16x8*)(xr + 32 * s), *(const LAS bf16x8*)(yr + 32 * s), a);
            *(LAS u32x2*)(VM + (16 * tg + jl) * VM_LD + 16 * nt + 4 * g) = pack4(a); }
        lds_barrier();
        u32x2 irc, ikc, ivc, irp, ikp, ivp, ivf;
#define PREP_LOAD(nt_, tg_) do { const int t_ = t0 + 16 * (tg_) + jl; const bf16_t* cr_ = CA + (size_t)t_ * RW_COLS + 64 * w + 16 * (nt_) + 4 * g; const bool hp_ = (t_ & (SEQ - 1)) != 0; \
            irc = *(const u32x2*)cr_; ikc = *(const u32x2*)(cr_ + 512); ivc = *(const u32x2*)(cr_ + 1024); irp = (u32x2){0u, 0u}; ikp = irp; ivp = irp; ivf = irp; \
            if (hp_) { irp = *(const u32x2*)(cr_ - RW_COLS); ikp = *(const u32x2*)(cr_ - RW_COLS + 512); ivp = *(const u32x2*)(cr_ - RW_COLS + 1024); } \
            if (l) ivf = *(const u32x2*)(VF + rwo(t_, 64 * w + 16 * (nt_) + 4 * g)); } while (0)
        PREP_LOAD(0, 0);
#pragma unroll 1
        for (int nt = 0; nt < 4; ++nt) {
            const int n0 = 64 * w + 16 * nt, n = n0 + 4 * g;
            bf16x8 xw[2], xa[2], xg[4], xm = {0, 0, 0, 0, 0, 0, 0, 0};
            { const bf16_t* pw = W2T + (size_t)(n0 + jl) * 64 + 8 * g; const bf16_t* pa = A2T + (size_t)(n0 + jl) * 64 + 8 * g; const bf16_t* pg = G2T + (size_t)(n0 + jl) * 128 + 8 * g;
#pragma unroll
              for (int s2 = 0; s2 < 2; ++s2) { xw[s2] = *(const bf16x8*)(pw + 32 * s2); xa[s2] = *(const bf16x8*)(pa + 32 * s2); }
#pragma unroll
              for (int s2 = 0; s2 < 4; ++s2) xg[s2] = *(const bf16x8*)(pg + 32 * s2);
              if (l) xm = *(const bf16x8*)(V2T + (size_t)(n0 + jl) * 32 + 8 * g); }
            const f32x4 mr = *(const f32x4*)(mu + n), mk = *(const f32x4*)(mu + 512 + n), mv = *(const f32x4*)(mu + 1024 + n);
            const f32x4 w0 = *(const f32x4*)(FIN(F, I_W0) + l * 512 + n), a0 = *(const f32x4*)(FIN(F, I_A0) + l * 512 + n), kkw = *(const f32x4*)(FIN(F, I_KK) + l * 512 + n), ka = *(const f32x4*)(FIN(F, I_KA) + l * 512 + n);
            f32x4 v0 = (f32x4){0.f, 0.f, 0.f, 0.f}; if (l) v0 = *(const f32x4*)(FIN(F, I_V0) + (l - 1) * 512 + n);
#pragma unroll 1
            for (int tg = 0; tg < 4; ++tg) {
                const int tl = 16 * tg + jl, t = t0 + tl;
                const f32x4 rc = unpack4(irc), kc = unpack4(ikc), vc = unpack4(ivc), rp = unpack4(irp), kp = unpack4(ikp), vp = unpack4(ivp), vf = unpack4(ivf);
                { const int nn_ = (tg == 3) ? (nt < 3 ? nt + 1 : nt) : nt, tn_ = (tg == 3) ? (nt < 3 ? 0 : 3) : tg + 1; PREP_LOAD(nn_, tn_); asm volatile("" ::: "memory"); }
                const lbf* ya = XA + tl * XA_LD + 8 * g;
                bf16x8 yf[9];
#pragma unroll
                for (int s2 = 0; s2 < 8; ++s2) yf[s2] = *(const LAS bf16x8*)(ya + 32 * s2);
                yf[8] = *(const LAS bf16x8*)(VM + tl * VM_LD + 8 * g);
                f32x4 aw = (f32x4){0.f, 0.f, 0.f, 0.f}, aa = aw, ag = aw, am = aw;
#pragma unroll
                for (int s2 = 0; s2 < 2; ++s2) { aw = MFMA16(xw[s2], yf[s2], aw); aa = MFMA16(xa[s2], yf[2 + s2], aa); }
#pragma unroll
                for (int s2 = 0; s2 < 4; ++s2) ag = MFMA16(xg[s2], yf[4 + s2], ag);
                if (l) am = MFMA16(xm, yf[8], am);
                const f32x4 r4 = rc + (rp - rc) * mr, k4 = kc + (kp - kc) * mk; f32x4 v4 = vc + (vp - vc) * mv;
                const size_t o = rwo(t, n);
                if (l) {
#pragma unroll
                    for (int q = 0; q < 4; ++q) v4[q] = v4[q] + (vf[q] - v4[q]) * sigmoidf_(v0[q] + am[q]); }
                else *(u32x2*)(VF + o) = pack4(v4);
                f32x4 e4, as4, k24, kk4;
#pragma unroll
                for (int q = 0; q < 4; ++q) { const float a = sigmoidf_(a0[q] + aa[q]); as4[q] = a; k24[q] = k4[q] * (1.0f + (a - 1.0f) * ka[q]);
                    e4[q] = 0.6065306597f * sigmoidf_(w0[q] + aw[q]);
                    kk4[q] = k4[q] * kkw[q]; }
                *(u32x2*)(RW + 0 * AS_ + o) = pack4(r4); *(u32x2*)(RW + 1 * AS_ + o) = pack4(e4); *(u32x2*)(RW + 2 * AS_ + o) = pack4(k24); *(u32x2*)(RW + 3 * AS_ + o) = pack4(v4);
                *(u32x2*)(RW + 4 * AS_ + o) = pack4(kk4); *(u32x2*)(RW + 5 * AS_ + o) = pack4(as4); *(u32x2*)(RW + 6 * AS_ + o) = pack4(ag);
            }
        }
#undef PREP_LOAD
    }
}

__device__ __forceinline__ void ph_rwkv_s1(Frame& F, int l) {
    bf16_t* RW = (bf16_t*)(F.ws + MX_RW); constexpr size_t AS_ = (size_t)TH * 512;
    float* BSW = (float*)(F.ws + MX_BS); const float* rkw = FIN(F, I_RK) + l * 512;
    bf16_t* YH = (bf16_t*)(F.ws + MX_CA);
    LAS unsigned char* L = F.lds;
#define SL(i) ((lbf*)(L + (i) * SLOT))
    lbf *AT = SL(0), *BT = SL(1), *KT = SL(2), *RT = SL(3), *ATt = SL(4), *Vt = SL(5), *BPt = SL(6), *KPt = SL(7), *AAK = SL(10), *ARB = SL(11), *ARK = SL(12);
    LAS float* EL = (LAS float*)(L + 8 * SLOT);
    LAS float* SEGT = (LAS float*)(L + 10 * SLOT);
    LAS float* PC = (LAS float*)(L + 16 * SLOT);
    const int lane = F.lane, w = F.wave, jl = lane & 15, g = lane >> 4;
    const int tok = F.tid >> 3, cg = F.tid & 7;
    u32x4 nr, ne, nk, nv, nkk, nas;
#define S1_LOAD(u_) do { const int uu_ = (u_) < (TH / 64) * 8 ? (u_) : F.bid; const size_t tb_ = rwo((uu_ >> 3) * 64 + tok, (uu_ & 7) * 64 + 8 * cg); \
        nr = *(const u32x4*)(RW + 0 * AS_ + tb_); ne = *(const u32x4*)(RW + 1 * AS_ + tb_); nk = *(const u32x4*)(RW + 2 * AS_ + tb_); nv = *(const u32x4*)(RW + 3 * AS_ + tb_); \
        nkk = *(const u32x4*)(RW + 4 * AS_ + tb_); nas = *(const u32x4*)(RW + 5 * AS_ + tb_); } while (0)
    S1_LOAD(F.bid);
    for (int u = F.bid; u < (TH / 64) * 8; u += F.G) {
        const int h = u & 7, ch = u >> 3, t0 = ch * 64;
        u32x4 ur = nr, ue = ne, uk = nk, uv = nv, ukk = nkk, uas = nas;
        asm volatile("" : "+v"(ur), "+v"(ue), "+v"(uk), "+v"(uv), "+v"(ukk), "+v"(uas));
        S1_LOAD(u + F.G); asm volatile("" ::: "memory");
        const float e8[8] = { bf_lo(ue.x), bf_hi(ue.x), bf_lo(ue.y), bf_hi(ue.y), bf_lo(ue.z), bf_hi(ue.z), bf_lo(ue.w), bf_hi(ue.w) };
#pragma unroll
        for (int i = 0; i < 8; ++i) EL[tok * 65 + 8 * cg + i] = e8[i];
        lds_barrier();
        { const int col = F.tid & 63, seg = F.tid >> 6; float p[8]; float run = 0.f;
#pragma unroll
          for (int i = 0; i < 8; ++i) { run += EL[(8 * seg + i) * 65 + col]; p[i] = run; }
          SEGT[seg * 64 + col] = run;
          lds_barrier();
          float off = 0.f; for (int s = 0; s < seg; ++s) off += SEGT[s * 64 + col];
#pragma unroll
          for (int i = 0; i < 8; ++i) EL[(8 * seg + i) * 65 + col] = -(off + p[i]); }
        lds_barrier();
        {
            const float r8[8] = { bf_lo(ur.x), bf_hi(ur.x), bf_lo(ur.y), bf_hi(ur.y), bf_lo(ur.z), bf_hi(ur.z), bf_lo(ur.w), bf_hi(ur.w) };
            const float k8[8] = { bf_lo(uk.x), bf_hi(uk.x), bf_lo(uk.y), bf_hi(uk.y), bf_lo(uk.z), bf_hi(uk.z), bf_lo(uk.w), bf_hi(uk.w) };
            float kk8[8] = { bf_lo(ukk.x), bf_hi(ukk.x), bf_lo(ukk.y), bf_hi(ukk.y), bf_lo(ukk.z), bf_hi(ukk.z), bf_lo(ukk.w), bf_hi(ukk.w) };
            { float ss = 0.f;
#pragma unroll
              for (int i = 0; i < 8; ++i) ss += kk8[i] * kk8[i];
              ss += __shfl_xor(ss, 1); ss += __shfl_xor(ss, 2); ss += __shfl_xor(ss, 4);
              const float inv = 1.0f / fmaxf(sqrtf(ss), 1e-12f);
#pragma unroll
              for (int i = 0; i < 8; ++i) kk8[i] *= inv; }
            const float as8[8] = { bf_lo(uas.x), bf_hi(uas.x), bf_lo(uas.y), bf_hi(uas.y), bf_lo(uas.z), bf_hi(uas.z), bf_lo(uas.w), bf_hi(uas.w) };
            const unsigned short v8[8] = { (unsigned short)(uv.x & 0xffffu), (unsigned short)(uv.x >> 16), (unsigned short)(uv.y & 0xffffu), (unsigned short)(uv.y >> 16),
                                           (unsigned short)(uv.z & 0xffffu), (unsigned short)(uv.z >> 16), (unsigned short)(uv.w & 0xffffu), (unsigned short)(uv.w >> 16) };
            { const float* rkp = rkw + h * 64 + 8 * cg; float b = 0.f;
#pragma unroll
              for (int i = 0; i < 8; ++i) b += r8[i] * k8[i] * rkp[i];
              b += __shfl_xor(b, 1); b += __shfl_xor(b, 2); b += __shfl_xor(b, 4);
              if (cg == 0) BSW[(size_t)(t0 + tok) * 8 + h] = b; }
            float at[8], bt[8], kt[8], rt[8], bp[8], kp[8];
#pragma unroll
            for (int i = 0; i < 8; ++i) { const float cl = EL[tok * 65 + 8 * cg + i], pc = __expf(EL[63 * 65 + 8 * cg + i]);
                const float ecl = __expf(cl), eicl = __expf(-cl);
                at[i] = -kk8[i] * __expf(cl + e8[i]); bt[i] = kk8[i] * as8[i] * eicl; kt[i] = k8[i] * eicl; rt[i] = r8[i] * ecl; bp[i] = bt[i] * pc; kp[i] = kt[i] * pc;
                if (tok == 0) PC[8 * cg + i] = pc; }
            u32x4 o;
            o.x = pk2(at[0], at[1]); o.y = pk2(at[2], at[3]); o.z = pk2(at[4], at[5]); o.w = pk2(at[6], at[7]); *(LAS u32x4*)(AT + tok * LDP + 8 * cg) = o;
            o.x = pk2(bt[0], bt[1]); o.y = pk2(bt[2], bt[3]); o.z = pk2(bt[4], bt[5]); o.w = pk2(bt[6], bt[7]); *(LAS u32x4*)(BT + tok * LDP + 8 * cg) = o;
            o.x = pk2(kt[0], kt[1]); o.y = pk2(kt[2], kt[3]); o.z = pk2(kt[4], kt[5]); o.w = pk2(kt[6], kt[7]); *(LAS u32x4*)(KT + tok * LDP + 8 * cg) = o;
            o.x = pk2(rt[0], rt[1]); o.y = pk2(rt[2], rt[3]); o.z = pk2(rt[4], rt[5]); o.w = pk2(rt[6], rt[7]); *(LAS u32x4*)(RT + tok * LDP + 8 * cg) = o;
#pragma unroll
            for (int i = 0; i < 8; ++i) { const int c = 8 * cg + i; ATt[c * LDP + tok] = f2bf(at[i]); Vt[c * LDP + tok] = v8[i]; BPt[c * LDP + tok] = f2bf(bp[i]); KPt[c * LDP + tok] = f2bf(kp[i]); }
        }
        lds_barrier();
        {
            const FrX xb = ldx64(BT, w, jl, g), xk = ldx64(KT, w, jl, g); const FrY ya = ldy64(AT, w, jl, g), yr_ = ldy64(RT, w, jl, g);
            f32x4 a1[2], a2[2], a3[2], a4[2]; ZACC(a1); ZACC(a2); ZACC(a3); ZACC(a4);
            mma64(xb, ya, a1); mma64(xk, ya, a2); mma64(xb, yr_, a3); mma64(xk, yr_, a4);
            const int s0 = 16 * (w & 3) + 4 * g;
            f32x4 b[2];
#pragma unroll
            for (int i = 0; i < 2; ++i) { const int t = 16 * (2 * (w >> 2) + i) + jl;
#pragma unroll
                for (int r = 0; r < 4; ++r) { const bool lt = s0 + r < t, le = s0 + r <= t; if (!lt) { a1[i][r] = 0.f; a2[i][r] = 0.f; } if (!le) { a3[i][r] = 0.f; a4[i][r] = 0.f; } b[i][r] = (s0 + r == t) ? 1.0f : a1[i][r]; } }
            st_t(SL(8), a1, w, jl, g); st_n(SL(9), a1, w, jl, g);
            st_t(SL(13), b, w, jl, g); st_n(SL(14), b, w, jl, g);
            st_t(AAK, a2, w, jl, g); st_t(ARB, a3, w, jl, g); st_t(ARK, a4, w, jl, g);
        }
        lds_barrier();
#define NEU_B(srcB, srcBt, dstB, dstBt) do { f32x4 a[2]; ZACC(a); mm64(SL(srcB), SL(srcBt), w, jl, g, a); st_t(SL(dstBt), a, w, jl, g); st_n(SL(dstB), a, w, jl, g); } while (0)
#define NEU_TB(srcT, srcTt, srcB, srcBt, dstT, dstTt, dstB, dstBt) do { f32x4 at[2], ab[2]; ZACC(ab); \
            const FrX xt_ = ldx64(SL(srcT), w, jl, g), xb_ = ldx64(SL(srcB), w, jl, g); const FrY yb_ = ldy64(SL(srcBt), w, jl, g); \
            _Pragma("unroll") for (int i = 0; i < 2; ++i) at[i] = unpack4(*(const LAS u32x2*)(SL(srcTt) + (16 * (2 * (w >> 2) + i) + jl) * LDP + 16 * (w & 3) + 4 * g)); \
            mma64(xt_, yb_, at); mma64(xb_, yb_, ab); \
            st_t(SL(dstTt), at, w, jl, g); st_n(SL(dstT), at, w, jl, g); st_t(SL(dstBt), ab, w, jl, g); st_n(SL(dstB), ab, w, jl, g); } while (0)
#define NEU_T(srcT, srcTt, srcBt, dstT, dstTt, last) do { f32x4 a[2]; \
            _Pragma("unroll") for (int i = 0; i < 2; ++i) a[i] = unpack4(*(const LAS u32x2*)(SL(srcTt) + (16 * (2 * (w >> 2) + i) + jl) * LDP + 16 * (w & 3) + 4 * g)); \
            mm64(SL(srcT), SL(srcBt), w, jl, g, a); if (!(last)) st_t(SL(dstTt), a, w, jl, g); st_n(SL(dstT), a, w, jl, g); } while (0)
        NEU_B(8, 9, 0, 1);                                   lds_barrier();
        NEU_TB(13, 14, 0, 1, 15, 2, 8, 9);                   lds_barrier();
        NEU_TB(15, 2, 8, 9, 13, 14, 0, 1);                   lds_barrier();
        NEU_TB(13, 14, 0, 1, 15, 2, 8, 9);                   lds_barrier();
        NEU_TB(15, 2, 8, 9, 13, 14, 0, 1);                   lds_barrier();
        NEU_T(13, 14, 1, 15, 2, true);                       lds_barrier();
        lbf* TI = SL(15); lbf* Wt = SL(8); lbf* Xt = SL(9); lbf* Ut = SL(0);
        {
            const FrX x1 = ldx64(TI, w, jl, g), x2 = ldx64(AAK, w, jl, g); const FrY y1 = ldy64(ATt, w, jl, g), y2 = ldy64(Vt, w, jl, g);
            f32x4 a[2], b[2]; ZACC(a); ZACC(b); mma64(x1, y1, a); mma64(x2, y2, b); st_t(Wt, a, w, jl, g); st_t(Xt, b, w, jl, g); }
        lds_barrier();
        {
            const FrX xti = ldx64(TI, w, jl, g), xw = ldx64(Wt, w, jl, g); const FrY yx = ldy64(Xt, w, jl, g), yar = ldy64(ARB, w, jl, g), ybp = ldy64(BPt, w, jl, g);
            f32x4 rr[2]; float pcv[2];
#pragma unroll
            for (int i = 0; i < 2; ++i) { const int t = 16 * (2 * (w >> 2) + i) + jl; rr[i] = unpack4(*(const LAS u32x2*)(RT + t * LDP + 16 * (w & 3) + 4 * g)); pcv[i] = PC[t]; }
            f32x4 au[2], ar[2], am[2]; ZACC(au); ZACC(ar); ZACC(am);
            mma64(xti, yx, au); mma64(xw, yar, ar); mma64(xw, ybp, am);
            st_t(Ut, au, w, jl, g);
#pragma unroll
            for (int i = 0; i < 2; ++i) { const int t = 16 * (2 * (w >> 2) + i) + jl, k0 = 16 * (w & 3) + 4 * g;
                *(u32x2*)(RW + 5 * AS_ + rwo(t0 + t, h * 64 + k0)) = pack4(ar[i] + rr[i]);
#pragma unroll
                for (int r = 0; r < 4; ++r) if (k0 + r == t) am[i][r] += pcv[i];
                *(u32x2*)(RW + 4 * AS_ + rwo(t0 + t, h * 64 + k0)) = pack4(am[i]); }
        }
        lds_barrier();
        {
            const FrX xu = ldx64(Ut, w, jl, g), xv = ldx64(Vt, w, jl, g), xbp = ldx64(BPt, w, jl, g), xkp = ldx64(KPt, w, jl, g);
            const FrY yar = ldy64(ARB, w, jl, g), yak = ldy64(ARK, w, jl, g), yu = ldy64(Ut, w, jl, g), yv = ldy64(Vt, w, jl, g);
            f32x4 ay[2], an[2]; ZACC(ay); ZACC(an);
            mma64(xu, yar, ay); mma64(xbp, yu, an); mma64(xv, yak, ay); mma64(xkp, yv, an);
#pragma unroll
            for (int i = 0; i < 2; ++i) { const int t = 16 * (2 * (w >> 2) + i) + jl, c0 = 16 * (w & 3) + 4 * g;
                *(u32x2*)(YH + rwo(t0 + t, h * 64 + c0)) = pack4(ay[i]);
                *(u32x2*)(RW + 1 * AS_ + rwo(t0 + t, h * 64 + c0)) = pack4(an[i]); }
        }
    }
#undef S1_LOAD
#undef SL
#undef NEU_B
#undef NEU_T
#undef NEU_TB
}

__device__ __forceinline__ void ph_rwkv_s2(Frame& F, int l, int pair) {
    const int bl = pair >> 3, h = pair & 7;
    const bf16_t* RW = (const bf16_t*)(F.ws + MX_RW); constexpr size_t AS_ = (size_t)TH * 512;
    const bf16_t* YH = (const bf16_t*)(F.ws + MX_CA); bf16_t* YA = (bf16_t*)(F.ws + MX_CA) + AS_;
    lbf* HT = (lbf*)F.lds;
    const int lane = F.lane, w = F.wave, jl = lane & 15, g = lane >> 4;
    lds_barrier();
    for (int i = F.tid; i < 64 * LDP / 2; i += NTHR) ((LAS unsigned*)HT)[i] = 0u;
    if (F.tid < 128) ((LAS float*)(F.lds + SLOT))[F.tid] = (F.tid < 64 ? FIN(F, I_LNG) : FIN(F, I_LNB))[l * 512 + h * 64 + (F.tid & 63)];
    lds_barrier();
    if (w < 4) {
        bf16x8 m0[4], m1[4]; u32x2 nn[4][4];
#define S2A_LOAD(j, c) do { const int cc_ = (c) < SEQ / 64 ? (c) : SEQ / 64 - 1; const int tb_ = bl * SEQ + cc_ * 64; \
        m0[j] = *(const bf16x8*)(RW + 4 * AS_ + rwo(tb_ + 16 * w + jl, h * 64 + 8 * g)); m1[j] = *(const bf16x8*)(RW + 4 * AS_ + rwo(tb_ + 16 * w + jl, h * 64 + 32 + 8 * g)); \
        _Pragma("unroll") for (int yt = 0; yt < 4; ++yt) nn[j][yt] = *(const u32x2*)(RW + 1 * AS_ + rwo(tb_ + 16 * yt + jl, h * 64 + 16 * w + 4 * g)); } while (0)
        S2A_LOAD(0, 0); S2A_LOAD(1, 1); S2A_LOAD(2, 2);
#pragma unroll 1
        for (int c4 = 0; c4 < SEQ / 64; c4 += 4) {
#pragma unroll
            for (int j = 0; j < 4; ++j) {
                asm volatile("" : "+v"(m0[j]), "+v"(m1[j]));
#pragma unroll
                for (int yt = 0; yt < 4; ++yt) asm volatile("" : "+v"(nn[j][yt]));
                S2A_LOAD((j + 3) & 3, c4 + j + 3);
                asm volatile("" ::: "memory");
                f32x4 a[4]; bf16x8 hf[4][2];
#pragma unroll
                for (int yt = 0; yt < 4; ++yt) { const lbf* yr = HT + (16 * yt + jl) * LDP + 8 * g; hf[yt][0] = *(const LAS bf16x8*)yr; hf[yt][1] = *(const LAS bf16x8*)(yr + 32); a[yt] = unpack4(nn[j][yt]); }
#pragma unroll
                for (int yt = 0; yt < 4; ++yt) a[yt] = MFMA16(m0[j], hf[yt][0], a[yt]);
#pragma unroll
                for (int yt = 0; yt < 4; ++yt) a[yt] = MFMA16(m1[j], hf[yt][1], a[yt]);
                lds_barrier();
#pragma unroll
                for (int yt = 0; yt < 4; ++yt) *(LAS u32x2*)(HT + (16 * yt + jl) * LDP + 16 * w + 4 * g) = pack4(a[yt]);
                lds_barrier();
            }
        }
#undef S2A_LOAD
    } else {
        const int wt = w - 4;
        const LAS float* lgl = (const LAS float*)(F.lds + SLOT) + 4 * g; const LAS float* lbl = lgl + 64;
        lbf* ystg = (lbf*)(F.lds + 2 * SLOT) + wt * 16 * LDP;
        const float* bsp = (const float*)(F.ws + MX_BS) + (size_t)(bl * SEQ + 16 * wt + jl) * 8 + h;
        bf16x8 r0[4], r1[4]; u32x2 yh[4][4], uv[4][4], ug[4][4]; float bsv[4];
#define S2B_LOAD(j, c) do { const int cc_ = (c) < SEQ / 64 ? (c) : SEQ / 64 - 1; const int tk_ = bl * SEQ + cc_ * 64 + 16 * wt + jl; \
        r0[j] = *(const bf16x8*)(RW + 5 * AS_ + rwo(tk_, h * 64 + 8 * g)); r1[j] = *(const bf16x8*)(RW + 5 * AS_ + rwo(tk_, h * 64 + 32 + 8 * g)); \
        bsv[j] = bsp[(size_t)(cc_ * 64) * 8]; \
        _Pragma("unroll") for (int xt = 0; xt < 4; ++xt) { yh[j][xt] = *(const u32x2*)(YH + rwo(tk_, h * 64 + 16 * xt + 4 * g)); uv[j][xt] = *(const u32x2*)(RW + 3 * AS_ + rwo(tk_, h * 64 + 16 * xt + 4 * g)); ug[j][xt] = *(const u32x2*)(RW + 6 * AS_ + rwo(tk_, h * 64 + 16 * xt + 4 * g)); } } while (0)
        S2B_LOAD(0, 0); S2B_LOAD(1, 1); S2B_LOAD(2, 2);
#pragma unroll 1
        for (int c4 = 0; c4 < SEQ / 64; c4 += 4) {
#pragma unroll
            for (int j = 0; j < 4; ++j) {
                asm volatile("" : "+v"(r0[j]), "+v"(r1[j]), "+v"(bsv[j]));
#pragma unroll
                for (int xt = 0; xt < 4; ++xt) asm volatile("" : "+v"(yh[j][xt]), "+v"(uv[j][xt]), "+v"(ug[j][xt]));
                S2B_LOAD((j + 3) & 3, c4 + j + 3);
                asm volatile("" ::: "memory");
                f32x4 a[4]; bf16x8 hf[4][2];
#pragma unroll
                for (int xt = 0; xt < 4; ++xt) { const lbf* xr = HT + (16 * xt + jl) * LDP + 8 * g; hf[xt][0] = *(const LAS bf16x8*)xr; hf[xt][1] = *(const LAS bf16x8*)(xr + 32); a[xt] = unpack4(yh[j][xt]); }
#pragma unroll
                for (int xt = 0; xt < 4; ++xt) a[xt] = MFMA16(hf[xt][0], r0[j], a[xt]);
#pragma unroll
                for (int xt = 0; xt < 4; ++xt) a[xt] = MFMA16(hf[xt][1], r1[j], a[xt]);
                lds_barrier();
                float s = 0.f; const float bs = bsv[j];
#pragma unroll
                for (int xt = 0; xt < 4; ++xt)
#pragma unroll
                    for (int r = 0; r < 4; ++r) s += a[xt][r];
                s += __shfl_xor(s, 16); s += __shfl_xor(s, 32);
                const float mean = s * (1.f / 64.f); float q = 0.f;
#pragma unroll
                for (int xt = 0; xt < 4; ++xt)
#pragma unroll
                    for (int r = 0; r < 4; ++r) { const float d = a[xt][r] - mean; q += d * d; }
                q += __shfl_xor(q, 16); q += __shfl_xor(q, 32);
                const float rstd = 1.0f / sqrtf(q * (1.f / 64.f) + 64e-5f);
#pragma unroll
                for (int xt = 0; xt < 4; ++xt) { const f32x4 vv = unpack4(uv[j][xt]), gg = unpack4(ug[j][xt]), lg4 = *(const LAS f32x4*)(lgl + 16 * xt), lb4 = *(const LAS f32x4*)(lbl + 16 * xt); f32x4 o;
#pragma unroll
                    for (int r = 0; r < 4; ++r) o[r] = ((a[xt][r] - mean) * rstd * lg4[r] + lb4[r] + bs * vv[r]) * gg[r];
                    *(LAS u32x2*)(ystg + jl * LDP + 16 * xt + 4 * g) = pack4(o); }
#pragma unroll
                for (int p = 0; p < 2; ++p) { const int rr_ = (lane >> 3) + 8 * p; const u32x4 vrow = *(const LAS u32x4*)(ystg + rr_ * LDP + 8 * (lane & 7));
                    *(u32x4*)(YA + (size_t)(bl * SEQ + (c4 + j) * 64 + 16 * wt + rr_) * 512 + h * 64 + 8 * (lane & 7)) = vrow; }
                lds_barrier();
            }
        }
#undef S2B_LOAD
    }
}

__device__ __forceinline__ void ph_dsa_prep(Frame& F, int l, int half) {
    bf16_t* CB = (bf16_t*)(F.ws + MX_CB); bf16_t* VT = (bf16_t*)(F.ws + MX_VT);
    const int* pos = (const int*)KARGP(F, I_POS) + (size_t)half * TH;
    const int lane = F.lane, j = lane & 7;
    float invf[4]; f32x4 gq[2], gk[2], gik[2];
#pragma unroll
    for (int i = 0; i < 4; ++i) invf[i] = __builtin_amdgcn_exp2f(-(float)(2 * (4 * j + i)) * (13.287712379549449f / 64.0f));
#pragma unroll
    for (int hf = 0; hf < 2; ++hf) { gq[hf] = *(const f32x4*)(FIN(F, I_QN) + l * 64 + 32 * hf + 4 * j); gk[hf] = *(const f32x4*)(FIN(F, I_KN) + l * 64 + 32 * hf + 4 * j); gik[hf] = *(const f32x4*)(FIN(F, I_IKN) + l * 64 + 32 * hf + 4 * j); }
    lbf* vst = (lbf*)F.lds;
    for (int tile = F.bid; tile < TH / 64; tile += F.G) {
        lds_barrier();
#pragma unroll 2
        for (int k8 = 0; k8 < 8; ++k8) {
        const int tk = 8 * F.wave + k8, t = tile * 64 + tk;
        const float p = (float)pos[t];
        f32x4 cs, sn;
#pragma unroll
        for (int i = 0; i < 4; ++i) { float rev = p * invf[i] * 0.15915494309189535f; rev = rev - floorf(rev); cs[i] = __builtin_amdgcn_cosf(rev); sn[i] = __builtin_amdgcn_sinf(rev); }
        bf16_t* row = CB + (size_t)t * DS_PAD;
#pragma unroll
        for (int ps = 0; ps < 3; ++ps) {
            const int vec = 8 * ps + (lane >> 3);
            if (vec < 19) {
                bf16_t* vp = row + vec * 64 + 4 * j;
                const u32x2 u1 = *(const u32x2*)vp, u2 = *(const u32x2*)(vp + 32);
                f32x4 x1 = unpack4(u1), x2 = unpack4(u2);
                if (vec == 9) {
                    vst[(4 * j + 0) * LDP + tk] = (bf16_t)(u1.x & 0xffffu); vst[(4 * j + 1) * LDP + tk] = (bf16_t)(u1.x >> 16); vst[(4 * j + 2) * LDP + tk] = (bf16_t)(u1.y & 0xffffu); vst[(4 * j + 3) * LDP + tk] = (bf16_t)(u1.y >> 16);
                    vst[(32 + 4 * j + 0) * LDP + tk] = (bf16_t)(u2.x & 0xffffu); vst[(32 + 4 * j + 1) * LDP + tk] = (bf16_t)(u2.x >> 16); vst[(32 + 4 * j + 2) * LDP + tk] = (bf16_t)(u2.y & 0xffffu); vst[(32 + 4 * j + 3) * LDP + tk] = (bf16_t)(u2.y >> 16);
                } else {
                    const bool nrm = (vec < 9) || (vec == 18);
                    float ss = (x1[0] * x1[0] + x1[1] * x1[1]) + (x1[2] * x1[2] + x1[3] * x1[3]) + (x2[0] * x2[0] + x2[1] * x2[1]) + (x2[2] * x2[2] + x2[3] * x2[3]);
                    ss += __shfl_xor(ss, 1); ss += __shfl_xor(ss, 2); ss += __shfl_xor(ss, 4);
                    if (nrm) { float rstd = 1.0f / sqrtf(ss * (1.f / 64.f) + 1e-6f); if (vec < 8) rstd *= 0.125f * 1.4426950409f;
                        const f32x4 g1 = vec < 8 ? gq[0] : (vec == 8 ? gk[0] : gik[0]), g2 = vec < 8 ? gq[1] : (vec == 8 ? gk[1] : gik[1]);
                        x1 = x1 * rstd * g1; x2 = x2 * rstd * g2; }
                    const f32x4 o1 = x1 * cs - x2 * sn, o2 = x2 * cs + x1 * sn;
                    *(u32x2*)vp = pack4(o1); *(u32x2*)(vp + 32) = pack4(o2);
                }
            }
        }
        }
        lds_barrier();
        { const int dim = F.tid >> 3, ch = F.tid & 7; const int t0 = tile * 64;
          *(u32x4*)(VT + ((size_t)(t0 >> 11) * 64 + dim) * SEQ + (t0 & (SEQ - 1)) + 8 * ch) = *(const LAS u32x4*)(vst + dim * LDP + 8 * ch); }
    }
}

constexpr int SC_LD = 2052;
__device__ __forceinline__ void lds_inc(LAS unsigned* p) { (void)__hip_atomic_fetch_add(p, 1u, __ATOMIC_RELAXED, __HIP_MEMORY_SCOPE_WORKGROUP); }
__device__ __forceinline__ unsigned okey(float s) { const unsigned u = __builtin_bit_cast(unsigned, s); return (u & 0x80000000u) ? ~u : (u | 0x80000000u); }
__device__ __forceinline__ int hist_find(LAS unsigned* hist, int lane, int& R, int& cnt) {
    const u32x4 c4 = *(const LAS u32x4*)(hist + 4 * lane);
    const unsigned tot = c4.x + c4.y + c4.z + c4.w;
    unsigned suf = tot;
#pragma unroll
    for (int o = 1; o < 64; o <<= 1) { const unsigned v = __shfl_down(suf, o); if (lane + o < 64) suf += v; }
    const unsigned above = suf - tot;
    const bool mine = (above < (unsigned)R) && ((unsigned)R <= suf);
    const unsigned long long bal = __ballot(mine);
    const int src = bal ? (int)__builtin_ctzll(bal) : 0;
    int bin, rr, cc;
    { unsigned a = above; int r_ = R;
      if ((unsigned)r_ <= a + c4.w) { bin = 4 * lane + 3; rr = r_ - (int)a; cc = (int)c4.w; } else { a += c4.w;
      if ((unsigned)r_ <= a + c4.z) { bin = 4 * lane + 2; rr = r_ - (int)a; cc = (int)c4.z; } else { a += c4.z;
      if ((unsigned)r_ <= a + c4.y) { bin = 4 * lane + 1; rr = r_ - (int)a; cc = (int)c4.y; } else { a += c4.y; bin = 4 * lane; rr = r_ - (int)a; cc = (int)c4.x; } } } }
    bin = __shfl(bin, src); rr = __shfl(rr, src); cc = __shfl(cc, src);
    R = rr; cnt = cc; return bin;
}
__device__ __forceinline__ void ph_dsa(Frame& F, int half, unsigned* qctr) {
    const bf16_t* CB = (const bf16_t*)(F.ws + MX_CB); const bf16_t* VT = (const bf16_t*)(F.ws + MX_VT);
    bf16_t* YB = (bf16_t*)(F.ws + MX_YB);
    LAS float* sc = (LAS float*)F.lds;
    LAS unsigned* hist = (LAS unsigned*)(F.lds + 16 * SC_LD * 4);
    LAS unsigned* msk = (LAS unsigned*)(F.lds + 16 * SC_LD * 4 + 16 * 256 * 4);
    lbf* KB = (lbf*)F.lds;
    lbf* VB = (lbf*)(F.lds + 2 * SLOT);
    const int lane = F.lane, w = F.wave, jl = lane & 15, g = lane >> 4;
    const int srow = F.tid >> 3, sseg = F.tid & 7;
    volatile LAS unsigned* qslot = (volatile LAS unsigned*)(F.lds + LDS_MISC + 64);
    for (;;) {
        if (F.tid == 0) *qslot = __hip_atomic_fetch_add(qctr, 1u, __ATOMIC_RELAXED, __HIP_MEMORY_SCOPE_AGENT);
        lds_barrier();
        const int ui = (int)*qslot; if (ui >= TH / 16) break;
        const int bl = ui & 15, q0 = (127 - (ui >> 4)) * 16, L = ((q0 >> 6) + 1) * 64;
        const int rowb = bl * SEQ;
        if (L > 256) for (int i = F.tid; i < 16 * 256; i += NTHR) hist[i] = 0u;
        lds_barrier();
        {
            bf16x8 yq[8][2]; float iw[8];
            const bf16_t* qrow = CB + (size_t)(rowb + q0 + jl) * DS_PAD;
#pragma unroll
            for (int h = 0; h < 8; ++h) { iw[h] = bf2f(qrow[1216 + h]);
#pragma unroll
                for (int s = 0; s < 2; ++s) yq[h][s] = *(const bf16x8*)(qrow + 640 + h * 64 + 32 * s + 8 * g); }
            const int nk = L / 16;
            const bf16_t* kbase = CB + (size_t)(rowb + jl) * DS_PAD + 1152 + 8 * g;
            bf16x8 x0 = {0, 0, 0, 0, 0, 0, 0, 0}, x1 = x0;
            if (w < nk) { const bf16_t* kr = kbase + (size_t)(w * 16) * DS_PAD; x0 = *(const bf16x8*)kr; x1 = *(const bf16x8*)(kr + 32); }
            for (int kt = w; kt < nk; kt += 8) {
                bf16x8 n0 = x0, n1 = x1;
                if (kt + 8 < nk) { const bf16_t* kr = kbase + (size_t)((kt + 8) * 16) * DS_PAD; n0 = *(const bf16x8*)kr; n1 = *(const bf16x8*)(kr + 32); }
                f32x4 s4 = (f32x4){0.f, 0.f, 0.f, 0.f};
#pragma unroll
                for (int h = 0; h < 8; ++h) { f32x4 a = (f32x4){0.f, 0.f, 0.f, 0.f}; a = MFMA16(x0, yq[h][0], a); a = MFMA16(x1, yq[h][1], a);
#pragma unroll
                    for (int r = 0; r < 4; ++r) s4[r] += iw[h] * fmaxf(a[r], 0.f); }
                *(LAS f32x4*)(sc + jl * SC_LD + kt * 16 + 4 * g) = s4;
                if (L > 256) {
#pragma unroll
                    for (int r = 0; r < 4; ++r) lds_inc(hist + jl * 256 + (okey(s4[r]) >> 24)); }
                x0 = n0; x1 = n1;
            }
        }
        lds_barrier();
        for (int qi = 0; qi < 2; ++qi) {
            const int qq = 2 * w + qi; LAS unsigned* hq = hist + qq * 256; const LAS float* sq = sc + qq * SC_LD; LAS unsigned* mq = msk + qq * 64;
            if (L <= 256) { mq[lane] = (lane < L / 32) ? 0xffffffffu : 0u; }
            else {
                int R = 256, E = 0; unsigned prefix = (unsigned)hist_find(hq, lane, R, E);
#pragma unroll 1
                for (int pass = 1; pass < 4; ++pass) {
                    const int sh = 24 - 8 * pass;
                    asm volatile("" ::: "memory");
                    *(LAS u32x4*)(hq + 4 * lane) = (u32x4){0u, 0u, 0u, 0u};
                    LDS_WAIT(); asm volatile("" ::: "memory");
                    for (int i = 4 * lane; i < L; i += 256) { const f32x4 s = *(const LAS f32x4*)(sq + i);
#pragma unroll
                        for (int r = 0; r < 4; ++r) { const unsigned k = okey(s[r]); if ((k >> (sh + 8)) == prefix) lds_inc(hq + ((k >> sh) & 255u)); } }
                    LDS_WAIT(); asm volatile("" ::: "memory");
                    const int b = hist_find(hq, lane, R, E); prefix = (prefix << 8) | (unsigned)b;
                }
                const unsigned thr = prefix;
                if (R >= E) {
                    for (int base = 0; base < SEQ; base += 256) {
                        unsigned nib = 0u;
                        if (base + 4 * lane < L) { const f32x4 s = *(const LAS f32x4*)(sq + base + 4 * lane);
#pragma unroll
                            for (int r = 0; r < 4; ++r) nib |= (okey(s[r]) >= thr ? 1u : 0u) << r; }
                        unsigned wv = nib << (4 * (lane & 7));
                        wv |= __shfl_xor(wv, 1); wv |= __shfl_xor(wv, 2); wv |= __shfl_xor(wv, 4);
                        if ((lane & 7) == 0) mq[(base >> 5) + (lane >> 3)] = wv;
                    }
                } else {
                    int taken = 0;
                    for (int base = 0; base < SEQ; base += 64) {
                        bool take = false; bool eq = false;
                        if (base < L) { const unsigned k = okey(sq[base + lane]); take = k > thr; eq = (k == thr); }
                        const unsigned long long em = __ballot(eq);
                        const int myr = taken + __popcll(em & ((1ull << lane) - 1ull));
                        take = take || (eq && myr < R);
                        taken += __popcll(em);
                        const unsigned long long tm = __ballot(take);
                        if (lane == 0) { mq[base / 32] = (unsigned)tm; mq[base / 32 + 1] = (unsigned)(tm >> 32); }
                    }
                }
            }
        }
        lds_barrier();
        {
            const int qloc = 2 * w + (jl >> 3), hd = jl & 7;
            const bf16_t* qrow = CB + (size_t)(rowb + q0 + qloc) * DS_PAD + hd * 64;
            const bf16x8 yq0 = *(const bf16x8*)(qrow + 8 * g), yq1 = *(const bf16x8*)(qrow + 32 + 8 * g);
            f32x4 O[4];
#pragma unroll
            for (int dt = 0; dt < 4; ++dt) O[dt] = (f32x4){0.f, 0.f, 0.f, 0.f};
            float mrun = -1e30f, lsum = 0.f;
            const LAS unsigned* mq = msk + qloc * 64;
            const bf16_t* kg = CB + (size_t)(rowb + srow) * DS_PAD + 512 + 8 * sseg;
            const bf16_t* vg = VT + ((size_t)bl * 64 + srow) * SEQ + 8 * sseg;
            const int ntile = L / 64;
            u32x4 kreg = *(const u32x4*)kg, vreg = *(const u32x4*)vg;
            *(LAS u32x4*)(KB + srow * LDP + 8 * sseg) = kreg; *(LAS u32x4*)(VB + srow * LDP + 8 * sseg) = vreg;
            lds_barrier();
            for (int it = 0; it < ntile; ++it) {
                { const int itn = (it + 1 < ntile) ? it + 1 : it; kreg = *(const u32x4*)(kg + (size_t)(itn * 64) * DS_PAD); vreg = *(const u32x4*)(vg + itn * 64); asm volatile("" ::: "memory"); }
                const lbf* Kt = KB + (it & 1) * 64 * LDP; const lbf* Vt = VB + (it & 1) * 64 * LDP;
                f32x4 s[4]; bf16x8 kf[4][2];
#pragma unroll
                for (int tl = 0; tl < 4; ++tl) { const lbf* xr = Kt + (16 * tl + jl) * LDP + 8 * g; kf[tl][0] = *(const LAS bf16x8*)xr; kf[tl][1] = *(const LAS bf16x8*)(xr + 32); }
                u32x2 vlo[4][2], vhi[4][2];
#pragma unroll
                for (int dt = 0; dt < 4; ++dt)
#pragma unroll
                    for (int ks = 0; ks < 2; ++ks) { const lbf* vr = Vt + (16 * dt + jl) * LDP + 32 * ks + 4 * g; vlo[dt][ks] = *(const LAS u32x2*)vr; vhi[dt][ks] = *(const LAS u32x2*)(vr + 16); }
#pragma unroll
                for (int tl = 0; tl < 4; ++tl) s[tl] = MFMA16(kf[tl][0], yq0, ((f32x4){0.f, 0.f, 0.f, 0.f}));
#pragma unroll
                for (int tl = 0; tl < 4; ++tl) s[tl] = MFMA16(kf[tl][1], yq1, s[tl]);
                const unsigned mw0 = mq[2 * it], mw1 = mq[2 * it + 1];
                float mx = -1e30f;
#pragma unroll
                for (int tl = 0; tl < 4; ++tl)
#pragma unroll
                    for (int r = 0; r < 4; ++r) mx = fmaxf(mx, s[tl][r]);
                mx = fmaxf(mx, __shfl_xor(mx, 16)); mx = fmaxf(mx, __shfl_xor(mx, 32));
                const float mnew = fmaxf(mrun, mx); const float alpha = __builtin_amdgcn_exp2f(mrun - mnew); mrun = mnew;
                float p[16]; float ps = 0.f;
#pragma unroll
                for (int i = 0; i < 16; ++i) { const int tl = i >> 2, r = i & 3; const unsigned mw = (tl < 2) ? mw0 : mw1;
                    const int sel = __builtin_amdgcn_sbfe((int)mw, 16 * (tl & 1) + 4 * g + r, 1);
                    p[i] = __builtin_bit_cast(float, __builtin_bit_cast(int, __builtin_amdgcn_exp2f(s[tl][r] - mnew)) & sel); ps += p[i]; }
                lsum = lsum * alpha + ps;
                bf16x8 pf[2];
#pragma unroll
                for (int ks = 0; ks < 2; ++ks) { u32x4 pw; pw.x = pk2(p[8 * ks], p[8 * ks + 1]); pw.y = pk2(p[8 * ks + 2], p[8 * ks + 3]); pw.z = pk2(p[8 * ks + 4], p[8 * ks + 5]); pw.w = pk2(p[8 * ks + 6], p[8 * ks + 7]);
                    pf[ks] = __builtin_bit_cast(bf16x8, pw); }
#pragma unroll
                for (int dt = 0; dt < 4; ++dt) O[dt] = O[dt] * alpha;
#pragma unroll
                for (int ks = 0; ks < 2; ++ks)
#pragma unroll
                    for (int dt = 0; dt < 4; ++dt) O[dt] = MFMA16(__builtin_bit_cast(bf16x8, (u32x4){vlo[dt][ks].x, vlo[dt][ks].y, vhi[dt][ks].x, vhi[dt][ks].y}), pf[ks], O[dt]);
                if (it + 1 < ntile) { *(LAS u32x4*)(KB + ((it + 1) & 1) * 64 * LDP + srow * LDP + 8 * sseg) = kreg; *(LAS u32x4*)(VB + ((it + 1) & 1) * 64 * LDP + srow * LDP + 8 * sseg) = vreg; }
                lds_barrier();
            }
            lsum += __shfl_xor(lsum, 16); lsum += __shfl_xor(lsum, 32);
            const float inv = 1.0f / lsum;
            lbf* ostg = (lbf*)(F.lds + 4 * SLOT) + w * 16 * LDP;
#pragma unroll
            for (int dt = 0; dt < 4; ++dt) { u32x2 o; o.x = pk2(O[dt][0] * inv, O[dt][1] * inv); o.y = pk2(O[dt][2] * inv, O[dt][3] * inv); *(LAS u32x2*)(ostg + jl * LDP + 16 * dt + 4 * g) = o; }
#pragma unroll
            for (int p = 0; p < 2; ++p) { const int rr_ = (lane >> 3) + 8 * p; const u32x4 vrow = *(const LAS u32x4*)(ostg + rr_ * LDP + 8 * (lane & 7));
                *(u32x4*)(YB + (size_t)(rowb + q0 + 2 * w + (rr_ >> 3)) * 512 + (rr_ & 7) * 64 + 8 * (lane & 7)) = vrow; }
        }
    }
}

constexpr int MK_LD = 136, MV_LD = 264;
__device__ __forceinline__ void ph_mem_attn(Frame& F, int l) {
    const bf16_t* QM = (const bf16_t*)(F.ws + MA_QM); bf16_t* OM = (bf16_t*)(F.ws + MA_OM);
    const bf16_t* MK = (const bf16_t*)(F.ws + WS_MEMK) + (size_t)l * MEMROWS * 512; const bf16_t* MVT = (const bf16_t*)(F.ws + WS_MEMVT) + (size_t)l * MEMROWS * 512;
    lbf* KS = (lbf*)F.lds; lbf* VS = (lbf*)(F.lds + 256 * MK_LD * 2);
    const int lane = F.lane, jl = lane & 15, g = lane >> 4;
    const float* gq = FIN(F, I_MQN) + l * 128;
    for (int it = F.bid; it < NB * 4 * 2; it += F.G) {
        const int pair = it >> 1, b = pair >> 2, hh = pair & 3, sp0 = (it & 1) * 8;
        const bf16_t* kb_ = MK + ((size_t)b * 4 + hh) * 256 * 128; const bf16_t* vb_ = MVT + ((size_t)b * 4 + hh) * 128 * 256;
        lds_barrier();
#pragma unroll
        for (int i = 0; i < 8; ++i) { const int id = F.tid + NTHR * i;
            *(LAS u32x4*)(KS + (id >> 4) * MK_LD + 8 * (id & 15)) = *(const u32x4*)(kb_ + (size_t)(id >> 4) * 128 + 8 * (id & 15));
            *(LAS u32x4*)(VS + (id >> 5) * MV_LD + 8 * (id & 31)) = *(const u32x4*)(vb_ + (size_t)(id >> 5) * 256 + 8 * (id & 31)); }
        lds_barrier();
#pragma unroll 1
        for (int sp = 0; sp < 8; ++sp) {
        const int t = b * SEQ + (sp0 + sp) * 128 + F.wave * 16 + jl;
        const bf16_t* qrow = QM + (size_t)t * 512 + hh * 128;
        float qv[4][8]; float ss = 0.f;
#pragma unroll
        for (int s2 = 0; s2 < 4; ++s2) { const u32x4 q = *(const u32x4*)(qrow + 32 * s2 + 8 * g);
            qv[s2][0] = bf_lo(q.x); qv[s2][1] = bf_hi(q.x); qv[s2][2] = bf_lo(q.y); qv[s2][3] = bf_hi(q.y); qv[s2][4] = bf_lo(q.z); qv[s2][5] = bf_hi(q.z); qv[s2][6] = bf_lo(q.w); qv[s2][7] = bf_hi(q.w);
#pragma unroll
            for (int i = 0; i < 8; ++i) ss += qv[s2][i] * qv[s2][i]; }
        ss += __shfl_xor(ss, 16); ss += __shfl_xor(ss, 32);
        const float sc = (1.0f / sqrtf(ss * (1.f / 128.f) + 1e-6f)) * (0.08838834764831845f * 1.4426950409f);
        bf16x8 yq[4];
#pragma unroll
        for (int s2 = 0; s2 < 4; ++s2) { const float* gp = gq + 32 * s2 + 8 * g; u32x4 pw;
            pw.x = pk2(qv[s2][0] * sc * gp[0], qv[s2][1] * sc * gp[1]); pw.y = pk2(qv[s2][2] * sc * gp[2], qv[s2][3] * sc * gp[3]);
            pw.z = pk2(qv[s2][4] * sc * gp[4], qv[s2][5] * sc * gp[5]); pw.w = pk2(qv[s2][6] * sc * gp[6], qv[s2][7] * sc * gp[7]); yq[s2] = __builtin_bit_cast(bf16x8, pw); }
        f32x4 O[8];
#pragma unroll
        for (int dt = 0; dt < 8; ++dt) O[dt] = (f32x4){0.f, 0.f, 0.f, 0.f};
        float mrun = -1e30f, ls = 0.f;
#pragma unroll 1
        for (int hk = 0; hk < 2; ++hk) {
            f32x4 S[8];
#pragma unroll
            for (int kt = 0; kt < 8; ++kt) { const lbf* kr = KS + (128 * hk + 16 * kt + jl) * MK_LD + 8 * g; f32x4 a = (f32x4){0.f, 0.f, 0.f, 0.f};
#pragma unroll
                for (int s2 = 0; s2 < 4; ++s2) a = MFMA16(*(const LAS bf16x8*)(kr + 32 * s2), yq[s2], a);
                S[kt] = a; }
            float mx = -1e30f;
#pragma unroll
            for (int kt = 0; kt < 8; ++kt)
#pragma unroll
                for (int r = 0; r < 4; ++r) mx = fmaxf(mx, S[kt][r]);
            mx = fmaxf(mx, __shfl_xor(mx, 16)); mx = fmaxf(mx, __shfl_xor(mx, 32));
            const float mnew = fmaxf(mrun, mx), alpha = __builtin_amdgcn_exp2f(mrun - mnew); mrun = mnew;
            float ps = 0.f; bf16x8 pf[4];
#pragma unroll
            for (int ks = 0; ks < 4; ++ks) { float p[8];
#pragma unroll
                for (int i = 0; i < 8; ++i) { p[i] = __builtin_amdgcn_exp2f(S[2 * ks + (i >> 2)][i & 3] - mnew); ps += p[i]; }
                u32x4 pw; pw.x = pk2(p[0], p[1]); pw.y = pk2(p[2], p[3]); pw.z = pk2(p[4], p[5]); pw.w = pk2(p[6], p[7]); pf[ks] = __builtin_bit_cast(bf16x8, pw); }
            ls = ls * alpha + ps;
#pragma unroll
            for (int dt = 0; dt < 8; ++dt) { f32x4 o = O[dt] * alpha; const lbf* vr = VS + (16 * dt + jl) * MV_LD + 128 * hk + 4 * g;
#pragma unroll
                for (int ks = 0; ks < 4; ++ks) { const u32x2 lo = *(const LAS u32x2*)(vr + 32 * ks), hi = *(const LAS u32x2*)(vr + 32 * ks + 16);
                    o = MFMA16(__builtin_bit_cast(bf16x8, (u32x4){lo.x, lo.y, hi.x, hi.y}), pf[ks], o); }
                O[dt] = o; }
        }
        ls += __shfl_xor(ls, 16); ls += __shfl_xor(ls, 32);
        const float inv = 1.0f / ls;
        lbf* ostg = (lbf*)(F.lds + 256 * MK_LD * 2 + 128 * MV_LD * 2) + F.wave * 16 * LDP;
        const int t0w = b * SEQ + (sp0 + sp) * 128 + F.wave * 16;
#pragma unroll
        for (int hf2 = 0; hf2 < 2; ++hf2) {
#pragma unroll
            for (int d4 = 0; d4 < 4; ++d4) { const int dt = 4 * hf2 + d4; u32x2 ov; ov.x = pk2(O[dt][0] * inv, O[dt][1] * inv); ov.y = pk2(O[dt][2] * inv, O[dt][3] * inv); *(LAS u32x2*)(ostg + jl * LDP + 16 * d4 + 4 * g) = ov; }
#pragma unroll
            for (int p = 0; p < 2; ++p) { const int rr_ = (lane >> 3) + 8 * p; const u32x4 vrow = *(const LAS u32x4*)(ostg + rr_ * LDP + 8 * (lane & 7));
                *(u32x4*)(OM + (size_t)(t0w + rr_) * 512 + hh * 128 + 64 * hf2 + 8 * (lane & 7)) = vrow; }
        }
        }
    }
}

__device__ __forceinline__ void ph_moe_route(Frame& F) {
    const unsigned short* sele = (const unsigned short*)(F.ws + MOE_SELE); const f32x2* selw = (const f32x2*)(F.ws + MOE_SELW);
    int* rowtok = (int*)(F.ws + MOE_ROWTOK); float* roww = (float*)(F.ws + MOE_ROWW); int* tile_e = (int*)(F.ws + MOE_TILEE); int* meta = (int*)(F.ws + MOE_META);
    LAS unsigned long long* pc = (LAS unsigned long long*)F.lds;
    LAS int* tot = (LAS int*)(F.lds + 8192);
    LAS int* pre = tot + 16; LAS int* segb = tot + 32; LAS int* wcnt = tot + 64;
    __syncthreads();
    { unsigned long long c0 = 0ull, c1 = 0ull; const u32x4* sp = (const u32x4*)(sele + (size_t)F.tid * 128);
      for (int i = 0; i < 16; ++i) { const u32x4 v = sp[i]; const unsigned ww[4] = {v.x, v.y, v.z, v.w};
#pragma unroll
        for (int q = 0; q < 4; ++q) { const unsigned a = ww[q] & 0xffffu, b = ww[q] >> 16;
            c0 += 1ull << (8 * (a & 7u)); c1 += 1ull << (8 * ((a >> 8) & 7u)); c0 += 1ull << (8 * (b & 7u)); c1 += 1ull << (8 * ((b >> 8) & 7u)); } }
      pc[F.tid * 2] = c0; pc[F.tid * 2 + 1] = c1; }
    __syncthreads();
    if (F.tid < 32) { const int seg = F.tid & 15, kind = F.tid >> 4; const int slot = seg >> 3, e = seg & 7; const int lim = kind ? 2 * F.bid : 512; int s = 0;
        for (int i = 0; i < lim; ++i) s += (int)((pc[i * 2 + slot] >> (8 * e)) & 0xffull);
        if (kind) pre[seg] = s; else tot[seg] = s; }
    __syncthreads();
    if (F.tid == 0) { int b = 0; for (int s = 0; s < 16; ++s) { segb[s] = b; b += (tot[s] + 255) & ~255; } segb[16] = b; }
    __syncthreads();
    const int t = F.bid * 256 + (F.tid & 255); const unsigned se = sele[t]; const f32x2 sw = selw[t];
    const int myseg[2] = { (int)(se & 7u), 8 + (int)((se >> 8) & 7u) };
    int rank[2] = {0, 0};
    if (F.tid < 256) {
#pragma unroll
        for (int s = 0; s < 16; ++s) { const int k = s >> 3; const unsigned long long m = __ballot(myseg[k] == s);
            if (myseg[k] == s) rank[k] = __popcll(m & ((1ull << F.lane) - 1ull));
            if (F.lane == 0) wcnt[F.wave * 16 + s] = __popcll(m); }
    }
    __syncthreads();
    if (F.tid < 256) {
#pragma unroll
        for (int k = 0; k < 2; ++k) { const int s = myseg[k]; int off = 0; for (int ww = 0; ww < F.wave; ++ww) off += wcnt[ww * 16 + s];
            const int row = segb[s] + pre[s] + off + rank[k]; rowtok[row] = t; roww[row] = k ? sw.y : sw.x; }
    }
    if (F.bid == 0) {
        for (int s = 0; s < 16; ++s) { const int lo = segb[s] + tot[s], hi = segb[s + 1]; for (int r = lo + F.tid; r < hi; r += NTHR) { rowtok[r] = -1; roww[r] = 0.f; } }
        for (int p = F.tid; p < segb[16] / 256; p += NTHR) { int e = 0; for (int s = 0; s < 16; ++s) if (p * 256 >= segb[s]) e = s & 7; tile_e[p] = e; }
        if (F.tid == 0) { meta[0] = segb[8] / 256; meta[1] = segb[16] / 256; }
    }
}

__global__ void __launch_bounds__(NTHR, 2) fwd(Args args) {
    extern __shared__ __attribute__((aligned(16))) unsigned char lds_raw[];
    Frame F;
    F.lds = (LAS unsigned char*)lds_raw; F.ws = args.ws; F.kb = __builtin_amdgcn_kernarg_segment_ptr(); F.out = args.out;
    F.tid = threadIdx.x; F.lane = F.tid & 63; F.wave = __builtin_amdgcn_readfirstlane(F.tid >> 6); F.G = gridDim.x; F.bid = blockIdx.x;
    volatile LAS unsigned* MISC = (volatile LAS unsigned*)(F.lds + LDS_MISC);
    if (F.tid < 64) MISC[F.tid] = 0u;
    __syncthreads();
    const int lo = args.ph_lo, hi = args.ph_hi;
    XcdBarrier bar; bar.bar = (unsigned*)(F.ws + WS_CTL) + 4096; bar.x = 0; bar.st = nullptr;
    if (hi - lo > 1) bar = xcd_barrier_post((unsigned*)(F.ws + WS_CTL) + 4096, MISC + 8);
    int ph = 0;
#ifndef SITE_MASK
#define SITE_MASK 0xffffffffffffffffull
#endif
#ifndef PROBE_T_MASK
#define PROBE_T_MASK 0ull
#endif
#ifndef PROBE_T_FACTOR
#define PROBE_T_FACTOR 20ull
#endif
    unsigned long long tacc_ = 0ull, t0_ = 0ull;
#ifndef SITE_MASK
#define SITE_MASK 0xffffffffffffffffull
#endif
#define PHASE_BEGIN { constexpr int site_ = __COUNTER__; if (((SITE_MASK >> site_) & 1ull) && ph >= lo && ph < hi) { if (((PROBE_T_MASK >> site_) & 1ull) && F.bid == 0) t0_ = __builtin_amdgcn_s_memrealtime(); \
      { int _t = threadIdx.x; asm volatile("" : "+v"(_t)); F.tid = _t; F.lane = _t & 63; F.wave = __builtin_amdgcn_readfirstlane(_t >> 6); \
      kptr_t _kb = __builtin_amdgcn_kernarg_segment_ptr(); asm volatile("" : "+s"(_kb)); F.kb = _kb; \
      __attribute__((address_space(1))) unsigned char* _w = (__attribute__((address_space(1))) unsigned char*)args.ws; asm volatile("" : "+s"(_w)); F.ws = (unsigned char*)_w; ws = F.ws; __attribute__((address_space(1))) float* _o = (__attribute__((address_space(1))) float*)args.out; asm volatile("" : "+s"(_o)); F.out = (float*)_o; }
#define PHASE_END   if (ph + 1 < hi) xcd_barrier(bar); if (((PROBE_T_MASK >> site_) & 1ull) && F.bid == 0) tacc_ += __builtin_amdgcn_s_memrealtime() - t0_; } ++ph; }
    unsigned char* ws = F.ws;
#define HN ((const bf16_t*)(ws + WS_HN))

    PHASE_BEGIN ph_prologue0(F); PHASE_END
    PHASE_BEGIN { pg8::Gemm g{(const bf16_t*)(ws + WS_MEMH), (const bf16_t*)(ws + WS_WKV), D, 0, nullptr}; pg8::StaticOrder S; S.init(MEMROWS, 4096, F.G, F.bid);
        pg8::EpiPlain E{(bf16_t*)(ws + PR_KVRAW), 4096}; pg8::gemm_phase<pg8::EpiPlain, pg8::StaticOrder>(F.lds, g, S, E); } PHASE_END
    PHASE_BEGIN ph_prologue2(F); PHASE_END

#pragma unroll 1
    for (int l = 0; l < DEPTH; ++l) {

        PHASE_BEGIN ph_layer0(F, l, l ? (const float*)F.out : FIN(F, I_X)); PHASE_END
#pragma unroll 1
        for (int half = 0; half < 2; ++half) {

            PHASE_BEGIN { pg8::Gemm g{HN + (size_t)half * TH * D, (const bf16_t*)(ws + W_IN), D, 0, nullptr}; pg8::StaticOrder S; S.init(TH, N_INP, F.G, F.bid);
                pg8::EpiWin E{(bf16_t*)(ws + MX_CA), (bf16_t*)(ws + MX_CB), (bf16_t*)(ws + MX_CG)}; pg8::gemm_phase<pg8::EpiWin, pg8::StaticOrder>(F.lds, g, S, E); } PHASE_END
                        #ifndef PROBE_RPREP
#define PROBE_RPREP 1
#endif
#ifndef PROBE_S2
#define PROBE_S2 1
#endif
#ifndef PROBE_DSA
#define PROBE_DSA 1
#endif
            PHASE_BEGIN for (int r_ = 0; r_ < PROBE_RPREP; ++r_) ph_rwkv_prep(F, l, half); ph_dsa_prep(F, l, half); PHASE_END
            PHASE_BEGIN ph_rwkv_s1(F, l); PHASE_END
            PHASE_BEGIN { for (int r_ = 0; r_ < PROBE_S2; ++r_) for (int p = F.bid; p < 128; p += F.G) ph_rwkv_s2(F, l, p); ph_dsa(F, half, (unsigned*)(ws + WS_CTL) + 8192 + 64 * (2 * l + half)); } PHASE_END
            PHASE_BEGIN { pg8::Gemm g{(const bf16_t*)(ws + MX_CA + RW_ARR), (const bf16_t*)(ws + W_BA), 512, 0, nullptr}; pg8::StaticOrder S; S.init(TH, D, F.G, F.bid);
                pg8::EpiMerge<false> E{(bf16_t*)(ws + WS_HN) + (size_t)half * TH * D, (const bf16_t*)(ws + MX_CG), 0}; pg8::gemm_phase<pg8::EpiMerge<false>, pg8::StaticOrder>(F.lds, g, S, E); } PHASE_END
            PHASE_BEGIN { pg8::Gemm g{(const bf16_t*)(ws + MX_YB), (const bf16_t*)(ws + W_BB), 512, 0, nullptr}; pg8::StaticOrder S; S.init(TH, D, F.G, F.bid);
                pg8::EpiMerge<true> E{(bf16_t*)(ws + WS_HN) + (size_t)half * TH * D, (const bf16_t*)(ws + MX_CG), 1024}; pg8::gemm_phase<pg8::EpiMerge<true>, pg8::StaticOrder>(F.lds, g, S, E); } PHASE_END
        }
        PHASE_BEGIN { pg8::Gemm g{HN, (const bf16_t*)(ws + W_OUT), D, 0, nullptr}; pg8::StaticOrder S; S.init(T, D, F.G, F.bid);
            pg8::EpiResid E{l ? (const float*)F.out : FIN(F, I_X), F.out}; pg8::gemm_phase<pg8::EpiResid, pg8::StaticOrder>(F.lds, g, S, E); } PHASE_END
        PHASE_BEGIN ph_norm(F); PHASE_END
        PHASE_BEGIN { pg8::Gemm g{HN, (const bf16_t*)(ws + W_MQ), D, 0, nullptr}; pg8::StaticOrder S; S.init(T, 512, F.G, F.bid);
            pg8::EpiPlain E{(bf16_t*)(ws + MA_QM), 512}; pg8::gemm_phase<pg8::EpiPlain, pg8::StaticOrder>(F.lds, g, S, E); } PHASE_END
        PHASE_BEGIN ph_mem_attn(F, l); PHASE_END
        PHASE_BEGIN { pg8::Gemm g{(const bf16_t*)(ws + MA_OM), (const bf16_t*)(ws + W_MO), 512, 0, nullptr}; pg8::StaticOrder S; S.init(T, D, F.G, F.bid);
            pg8::EpiResid E{F.out, F.out}; pg8::gemm_phase<pg8::EpiResid, pg8::StaticOrder>(F.lds, g, S, E); } PHASE_END
        PHASE_BEGIN ph_norm_ffn(F, l); PHASE_END
        if ((l & 1) == 0) {
            PHASE_BEGIN { pg8::Gemm g{HN, (const bf16_t*)(ws + W_FGU), D, 0, nullptr}; pg8::StaticOrder S; S.init(T, 2 * FFN, F.G, F.bid);
                pg8::EpiSwiGLU E{(bf16_t*)(ws + FF_GU), FFN}; pg8::gemm_phase<pg8::EpiSwiGLU, pg8::StaticOrder>(F.lds, g, S, E); } PHASE_END
            PHASE_BEGIN { pg8::Gemm g{(const bf16_t*)(ws + FF_GU), (const bf16_t*)(ws + W_FD), FFN, 0, nullptr}; pg8::StaticOrder S; S.init(T, D, F.G, F.bid);
                pg8::EpiResid E{F.out, F.out}; pg8::gemm_phase<pg8::EpiResid, pg8::StaticOrder, false, true>(F.lds, g, S, E); } PHASE_END
            ph += 2;
        } else {
#define meta ((const int*)(ws + MOE_META))
#define tile_e ((const int*)(ws + MOE_TILEE))
            PHASE_BEGIN ph_moe_route(F); PHASE_END
            PHASE_BEGIN { const int nt1 = __builtin_amdgcn_readfirstlane(meta[1]);
                pg8::Gemm g{HN, (const bf16_t*)(ws + W_EGU), D, (size_t)2 * EDIM * D, (const int*)(ws + MOE_ROWTOK)}; pg8::MoeOrder S; S.init(nt1, 11, F.G, F.bid, 0, tile_e);
                pg8::EpiSwiGLU E{(bf16_t*)(ws + FF_GU), EDIM}; pg8::gemm_phase<pg8::EpiSwiGLU, pg8::MoeOrder, true>(F.lds, g, S, E); } PHASE_END
            PHASE_BEGIN { const int nt0 = __builtin_amdgcn_readfirstlane(meta[0]);
                pg8::Gemm g{(const bf16_t*)(ws + FF_GU), (const bf16_t*)(ws + W_ED), EDIM, (size_t)D * EDIM, nullptr}; pg8::MoeOrder S; S.init(nt0, 4, F.G, F.bid, 0, tile_e);
                pg8::EpiMoeDown E{F.out, (const int*)(ws + MOE_ROWTOK), (const float*)(ws + MOE_ROWW)}; pg8::gemm_phase<pg8::EpiMoeDown, pg8::MoeOrder, false, true>(F.lds, g, S, E); } PHASE_END
            PHASE_BEGIN { const int nt0 = __builtin_amdgcn_readfirstlane(meta[0]), nt1 = __builtin_amdgcn_readfirstlane(meta[1]);
                pg8::Gemm g{(const bf16_t*)(ws + FF_GU), (const bf16_t*)(ws + W_ED), EDIM, (size_t)D * EDIM, nullptr}; pg8::MoeOrder S; S.init(nt1 - nt0, 4, F.G, F.bid, nt0, tile_e);
                pg8::EpiMoeDown E{F.out, (const int*)(ws + MOE_ROWTOK), (const float*)(ws + MOE_ROWW)}; pg8::gemm_phase<pg8::EpiMoeDown, pg8::MoeOrder, false, true>(F.lds, g, S, E); } PHASE_END
        }
    }
    if (PROBE_T_MASK != 0ull && F.bid == 0) { const unsigned long long te_ = __builtin_amdgcn_s_memrealtime() + PROBE_T_FACTOR * tacc_; while (__builtin_amdgcn_s_memrealtime() < te_) __builtin_amdgcn_s_sleep(32); }
}
constexpr int N_PHASES = 3 + DEPTH * (1 + 2 * 6 + 6 + 4);

extern "C" void kernel_launch(void* const* d_in, const int* in_sizes, int n_in, void* d_out, int out_size, void* d_ws, size_t ws_size, hipStream_t stream) {
    static int grid = 0;
    if (grid == 0) {
        if (n_in != 41 || out_size != T * D || ws_size < WS_END) { fprintf(stderr, "kernel_launch: unexpected shapes (n_in %d, out %d, ws %zu < %zu); nothing launched\n", n_in, out_size, ws_size, (size_t)WS_END); grid = -1; return; }
        int dev = 0, cus = 0, per_cu = 0;
        if (hipGetDevice(&dev) != hipSuccess || hipDeviceGetAttribute(&cus, hipDeviceAttributeMultiprocessorCount, dev) != hipSuccess) { grid = -1; return; }
        if (hipFuncSetAttribute((const void*)fwd, hipFuncAttributeMaxDynamicSharedMemorySize, LDS_BYTES) != hipSuccess) { fprintf(stderr, "kernel_launch: hipFuncSetAttribute failed\n"); grid = -1; return; }
        if (hipOccupancyMaxActiveBlocksPerMultiprocessor(&per_cu, (const void*)fwd, NTHR, LDS_BYTES) != hipSuccess || per_cu < 1) fprintf(stderr, "kernel_launch: occupancy query reports %d\n", per_cu);
        (void)hipGetLastError();
        grid = cus;
    }
    if (grid < 0) return;
    if (hipMemsetAsync((char*)d_ws + WS_CTL, 0, CTL_ZERO_BYTES, stream) != hipSuccess) return;
    Args a{};
    for (int i = 0; i < 41; ++i) a.in[i] = d_in[i];
    a.out = (float*)d_out; a.ws = (unsigned char*)d_ws;
#if MK_ONE_LAUNCH
    a.ph_lo = 0; a.ph_hi = N_PHASES;
    hipLaunchKernelGGL(fwd, dim3(grid), dim3(NTHR), LDS_BYTES, stream, a);
#else
    for (int p = 0; p < N_PHASES; ++p) { a.ph_lo = p; a.ph_hi = p + 1; hipLaunchKernelGGL(fwd, dim3(grid), dim3(NTHR), LDS_BYTES, stream, a); }
#endif
}
```

```cpp
#include <hip/hip_runtime.h>
#include <cstdio>
#include <cstdint>

#ifndef MK_ONE_LAUNCH
#define MK_ONE_LAUNCH 1
#endif

namespace pg8 {
#define PG8_LAS __attribute__((address_space(3)))
typedef unsigned short bf16_t;
typedef short bf16x8 __attribute__((ext_vector_type(8)));
typedef float f32x4 __attribute__((ext_vector_type(4)));
typedef float f32x2 __attribute__((ext_vector_type(2)));
typedef unsigned u32x4 __attribute__((ext_vector_type(4)));
typedef unsigned u32x2 __attribute__((ext_vector_type(2)));
typedef __bf16 bf16x2_t __attribute__((ext_vector_type(2)));
constexpr int BM = 256, BK = 64, HALF = 128, HTB = HALF * BK * 2, STAGE_BYTES = 8 * HTB, NXCD = 8, WGM = 8;

__host__ __device__ __forceinline__ int lds_byte(int r, int c) { const int st = (r >> 4) * 2 + (c >> 5), rr = r & 15, cc = c & 31, ob = rr * 64 + cc * 2; return st * 1024 + (ob ^ (((ob >> 9) & 1) << 5)); }
__host__ __device__ __forceinline__ void stage_rc(int b, int& R, int& C) { const int st = b / 1024, sb = b % 1024, swz = sb ^ (((sb >> 9) & 1) << 5); R = (st >> 1) * 16 + swz / 64; C = (st & 1) * 32 + (swz % 64) / 2; }
__host__ __device__ __forceinline__ int perm32(int rho) { const int n = rho >> 4, i = rho & 15; return 8 * (i >> 2) + 4 * n + (i & 3); }

struct Unit { int pm, pn, e; };
struct Gemm { const bf16_t* A; const bf16_t* Bt; int K; size_t bstride; const int* rowidx; };

struct StaticOrder {
    int nM, nN, nwg, G, c;
    __device__ void init(int M, int N, int G_, int c_) { nM = M / BM; nN = N / BM; nwg = nM * nN; G = G_; c = c_; }
    __device__ bool next(int i, Unit& u) const {
        const long L = (long)i * G + c; if (L >= nwg) return false;
        int wgid = (int)L; { const int q = nwg / NXCD, r = nwg % NXCD, xcd = wgid % NXCD, off = wgid / NXCD; wgid = (xcd < r ? xcd * (q + 1) : r * (q + 1) + (xcd - r) * q) + off; }
        const int nig = WGM * nN, gid = wgid / nig, fm = gid * WGM, gsz = (nM - fm) < WGM ? (nM - fm) : WGM;
        u.pm = fm + ((wgid % nig) % gsz); u.pn = (wgid % nig) / gsz; u.e = 0; return true;
    }
};
struct MoeOrder {
    int nM, nN, nwg, G, c, pm0; const int* tile_e;
    __device__ void init(int nM_, int nN_, int G_, int c_, int pm0_, const int* te) { nM = nM_; nN = nN_; nwg = nM * nN; G = G_; c = c_; pm0 = pm0_; tile_e = te; }
    __device__ bool next(int i, Unit& u) const {
        const long L = (long)i * G + c; if (L >= nwg) return false;
        int wgid = (int)L; { const int q = nwg / NXCD, r = nwg % NXCD, xcd = wgid % NXCD, off = wgid / NXCD; wgid = (xcd < r ? xcd * (q + 1) : r * (q + 1) + (xcd - r) * q) + off; }
        const int nig = WGM * nN, gid = wgid / nig, fm = gid * WGM, gsz = (nM - fm) < WGM ? (nM - fm) : WGM;
        u.pm = pm0 + fm + ((wgid % nig) % gsz); u.pn = (wgid % nig) / gsz; u.e = __builtin_amdgcn_readfirstlane(tile_e[u.pm]); return true;
    }
};

__device__ __forceinline__ unsigned pk2(float lo, float hi) { const bf16x2_t v = __builtin_convertvector((f32x2){lo, hi}, bf16x2_t); return __builtin_bit_cast(unsigned, v); }
__device__ __forceinline__ float bf_lo(unsigned u) { return __builtin_bit_cast(float, u << 16); }
__device__ __forceinline__ float bf_hi(unsigned u) { return __builtin_bit_cast(float, u & 0xffff0000u); }
__device__ __forceinline__ float bf2f(bf16_t b) { return __builtin_bit_cast(float, (unsigned)b << 16); }
__device__ __forceinline__ bf16_t f2bf(float f) { return (bf16_t)(pk2(f, 0.f) & 0xffffu); }
__device__ __forceinline__ float sigmoidf_(float x) { return __builtin_amdgcn_rcpf(1.0f + __expf(-x)); }

struct EpiPlain {
    static constexpr bool PERM = true;
    bf16_t* O; int ldc;
    __device__ __forceinline__ void operator()(const f32x4 (&acc)[2][2][4][2], const Unit& u, int wr, int wc, int fr, int fq) const {
        const int row0 = u.pm * BM + wr * 64 + fr, col0 = u.pn * BM + wc * 32 + 8 * fq;
#pragma unroll
        for (int ai = 0; ai < 2; ++ai)
#pragma unroll
            for (int m = 0; m < 4; ++m) { bf16_t* rowp = O + (size_t)(row0 + ai * HALF + m * 16) * ldc + col0;
#pragma unroll
                for (int bj = 0; bj < 2; ++bj) { const f32x4 v0 = acc[ai][bj][m][0], v1 = acc[ai][bj][m][1];
                    u32x4 w; w.x = pk2(v0[0], v0[1]); w.y = pk2(v0[2], v0[3]); w.z = pk2(v1[0], v1[1]); w.w = pk2(v1[2], v1[3]);
                    *(u32x4*)(rowp + bj * HALF) = w; } }
    }
};
struct EpiWin {
    static constexpr bool PERM = true;
    bf16_t *CA, *CB, *CG;
    __device__ __forceinline__ void operator()(const f32x4 (&acc)[2][2][4][2], const Unit& u, int wr, int wc, int fr, int fq) const {
        const int row0 = u.pm * BM + wr * 64 + fr; const int pn = u.pn;
        bf16_t* base; int ldc, ct; const bool sg = pn >= 12;
        if (pn < 7) { base = CA; ldc = 1792; ct = pn; } else if (pn < 12) { base = CB; ldc = 1280; ct = pn - 7; } else { base = CG; ldc = 2048; ct = pn - 12; }
        const int col0 = ct * BM + wc * 32 + 8 * fq;
#pragma unroll
        for (int ai = 0; ai < 2; ++ai)
#pragma unroll
            for (int m = 0; m < 4; ++m) { bf16_t* rowp = base + (size_t)(row0 + ai * HALF + m * 16) * ldc + col0;
#pragma unroll
                for (int bj = 0; bj < 2; ++bj) { f32x4 v0 = acc[ai][bj][m][0], v1 = acc[ai][bj][m][1];
                    if (sg) {
#pragma unroll
                        for (int j = 0; j < 4; ++j) { v0[j] = sigmoidf_(v0[j]); v1[j] = sigmoidf_(v1[j]); } }
                    u32x4 w; w.x = pk2(v0[0], v0[1]); w.y = pk2(v0[2], v0[3]); w.z = pk2(v1[0], v1[1]); w.w = pk2(v1[2], v1[3]);
                    *(u32x4*)(rowp + bj * HALF) = w; } }
    }
};
template <bool ADD> struct EpiMerge {
    static constexpr bool PERM = true;
    bf16_t* O; const bf16_t* gate; int gcol;
    __device__ __forceinline__ void operator()(const f32x4 (&acc)[2][2][4][2], const Unit& u, int wr, int wc, int fr, int fq) const {
        const int row0 = u.pm * BM + wr * 64 + fr, col0 = u.pn * BM + wc * 32 + 8 * fq;
#pragma unroll
        for (int ai = 0; ai < 2; ++ai) {
            u32x4 gv[4][2], pv[4][2];
#pragma unroll
            for (int m = 0; m < 4; ++m) { const size_t row = (size_t)(row0 + ai * HALF + m * 16);
#pragma unroll
                for (int bj = 0; bj < 2; ++bj) { gv[m][bj] = *(const u32x4*)(gate + row * 2048 + gcol + col0 + bj * HALF); if (ADD) pv[m][bj] = *(const u32x4*)(O + row * 1024 + col0 + bj * HALF); } }
#pragma unroll
            for (int m = 0; m < 4; ++m) { const size_t row = (size_t)(row0 + ai * HALF + m * 16);
#pragma unroll
                for (int bj = 0; bj < 2; ++bj) { const f32x4 v0 = acc[ai][bj][m][0], v1 = acc[ai][bj][m][1]; const u32x4 g = gv[m][bj];
                    float o[8] = { bf_lo(g.x) * v0[0], bf_hi(g.x) * v0[1], bf_lo(g.y) * v0[2], bf_hi(g.y) * v0[3], bf_lo(g.z) * v1[0], bf_hi(g.z) * v1[1], bf_lo(g.w) * v1[2], bf_hi(g.w) * v1[3] };
                    if (ADD) { const u32x4 p = pv[m][bj];
                        o[0] += bf_lo(p.x); o[1] += bf_hi(p.x); o[2] += bf_lo(p.y); o[3] += bf_hi(p.y); o[4] += bf_lo(p.z); o[5] += bf_hi(p.z); o[6] += bf_lo(p.w); o[7] += bf_hi(p.w); }
                    u32x4 w; w.x = pk2(o[0], o[1]); w.y = pk2(o[2], o[3]); w.z = pk2(o[4], o[5]); w.w = pk2(o[6], o[7]);
                    *(u32x4*)(O + row * 1024 + col0 + bj * HALF) = w; } }
        }
    }
};
struct EpiResid {
    static constexpr bool PERM = false;
    const float* xi; float* xo;
    __device__ __forceinline__ void operator()(const f32x4 (&acc)[2][2][4][2], const Unit& u, int wr, int wc, int fr, int fq) const {
        const int row0 = u.pm * BM + wr * 64 + fr, col0 = u.pn * BM + wc * 32 + 4 * fq;
#pragma unroll
        for (int ai = 0; ai < 2; ++ai) {
            f32x4 xv[4][2][2];
#pragma unroll
            for (int m = 0; m < 4; ++m) { const size_t o = (size_t)(row0 + ai * HALF + m * 16) * 1024 + col0;
#pragma unroll
                for (int bj = 0; bj < 2; ++bj)
#pragma unroll
                    for (int n = 0; n < 2; ++n) xv[m][bj][n] = *(const f32x4*)(xi + o + bj * HALF + n * 16); }
#pragma unroll
            for (int m = 0; m < 4; ++m) { const size_t o = (size_t)(row0 + ai * HALF + m * 16) * 1024 + col0;
#pragma unroll
                for (int bj = 0; bj < 2; ++bj)
#pragma unroll
                    for (int n = 0; n < 2; ++n) *(f32x4*)(xo + o + bj * HALF + n * 16) = xv[m][bj][n] + acc[ai][bj][m][n]; }
        }
    }
};
struct EpiSwiGLU {
    static constexpr bool PERM = true;
    bf16_t* O; int ldc;
    __device__ __forceinline__ void operator()(const f32x4 (&acc)[2][2][4][2], const Unit& u, int wr, int wc, int fr, int fq) const {
        const int row0 = u.pm * BM + wr * 64 + fr, col0 = u.pn * HALF + wc * 32 + 8 * fq;
#pragma unroll
        for (int ai = 0; ai < 2; ++ai)
#pragma unroll
            for (int m = 0; m < 4; ++m) { const int row = row0 + ai * HALF + m * 16;
                bf16_t* rowp = O + ((size_t)((row >> 6) * (ldc >> 4) + (col0 >> 4)) << 10) + (((row & 63) << 4) + (col0 & 15));
                float o[8];
#pragma unroll
                for (int n = 0; n < 2; ++n)
#pragma unroll
                    for (int j = 0; j < 4; ++j) { const float g = acc[ai][0][m][n][j], up = acc[ai][1][m][n][j]; o[4 * n + j] = g * sigmoidf_(g) * up; }
                u32x4 w; w.x = pk2(o[0], o[1]); w.y = pk2(o[2], o[3]); w.z = pk2(o[4], o[5]); w.w = pk2(o[6], o[7]);
                *(u32x4*)rowp = w; }
    }
};
struct EpiMoeDown {
    static constexpr bool PERM = false;
    float* x; const int* tok; const float* wgt;
    __device__ __forceinline__ void operator()(const f32x4 (&acc)[2][2][4][2], const Unit& u, int wr, int wc, int fr, int fq) const {
        const int row0 = u.pm * BM + wr * 64 + fr, col0 = u.pn * BM + wc * 32 + 4 * fq;
        int tk[2][4]; float wv[2][4];
#pragma unroll
        for (int ai = 0; ai < 2; ++ai)
#pragma unroll
            for (int m = 0; m < 4; ++m) { const int row = row0 + ai * HALF + m * 16; tk[ai][m] = tok[row]; wv[ai][m] = wgt[row]; }
#pragma unroll
        for (int ai = 0; ai < 2; ++ai) {
            f32x4 xv[4][2][2];
#pragma unroll
            for (int m = 0; m < 4; ++m) { const int t = tk[ai][m] < 0 ? 0 : tk[ai][m]; const float* xp = x + (size_t)t * 1024 + col0;
#pragma unroll
                for (int bj = 0; bj < 2; ++bj)
#pragma unroll
                    for (int n = 0; n < 2; ++n) xv[m][bj][n] = *(const f32x4*)(xp + bj * HALF + n * 16); }
#pragma unroll
            for (int m = 0; m < 4; ++m) if (tk[ai][m] >= 0) { float* xp = x + (size_t)tk[ai][m] * 1024 + col0;
#pragma unroll
                for (int bj = 0; bj < 2; ++bj)
#pragma unroll
                    for (int n = 0; n < 2; ++n) *(f32x4*)(xp + bj * HALF + n * 16) = xv[m][bj][n] + acc[ai][bj][m][n] * wv[ai][m]; }
        }
    }
};

template <class Epi, class Sched, bool GATHER = false, bool ABLK = false>
__device__ __forceinline__ void gemm_phase(PG8_LAS unsigned char* lds, const Gemm g, const Sched& S, const Epi& E, int tid_) {
    asm volatile("" : "+v"(tid_));
    const int tid = tid_, wid = __builtin_amdgcn_readfirstlane(tid >> 6), lane = tid & 63, wr = wid >> 2, wc = wid & 3, fr = lane & 15, fq = lane >> 4;
    const int K = g.K, nt = K / BK;
    unsigned voffA[2], voffB[2];
#pragma unroll
    for (int i = 0; i < 2; ++i) { int R, C; stage_rc(tid * 16 + i * 8192, R, C); const int Rb = Epi::PERM ? ((R & ~31) + perm32(R & 31)) : R;
        voffA[i] = ABLK ? (unsigned)(((R >> 6) * (K >> 4) + (C >> 4)) * 2048 + (((R & 63) << 4) + (C & 15)) * 2) : (unsigned)(R * K + C) * 2u; voffB[i] = (unsigned)(Rb * K + C) * 2u; }
    const size_t kstep = (size_t)(BK * 2);
    const size_t hstep = (size_t)HALF * K * 2;
    const size_t tstep = 2 * hstep;
    const size_t hstepA = ABLK ? (size_t)2 * (K >> 4) * 2048 : hstep, tstepA = 2 * hstepA; constexpr size_t AKM = ABLK ? 64 : 1;
    const unsigned ldsw = (unsigned)wid * 1024u;
    const int aoff = lds_byte(wr * 64 + fr, fq * 8), boff = lds_byte(wc * 32 + fr, fq * 8);
    unsigned gvo[2][2];
#define PG8_SA(b, h) (((b) * 2 + (h)) * HTB)
#define PG8_SB(b, h) ((4 + (b) * 2 + (h)) * HTB)
#define PG8_STAGE(bufoff, gbase, voff) do { _Pragma("unroll") for (int _i = 0; _i < 2; ++_i) \
        __builtin_amdgcn_global_load_lds((const unsigned*)((const char*)(gbase) + (voff)[_i]), (PG8_LAS unsigned*)(lds + (bufoff) + ldsw + _i * 8192), 16, 0, 0); } while (0)
#define PG8_STAGE_A(bufoff, h, ubase, kb, nx) do { if constexpr (GATHER) { PG8_STAGE(bufoff, (const char*)g.A + (kb), gvo[h]); } \
        else { PG8_STAGE(bufoff, (ubase) + (kb) * AKM + (h) * hstepA, voffA); } } while (0)
#define PG8_LOADROWS(dst, unit) do { if constexpr (GATHER) { _Pragma("unroll") for (int _i = 0; _i < 2; ++_i) { int _R, _C; stage_rc(tid * 16 + _i * 8192, _R, _C); \
        _Pragma("unroll") for (int _h = 0; _h < 2; ++_h) { int _t = g.rowidx[(unit).pm * BM + _h * HALF + _R]; _t = _t < 0 ? 0 : _t; dst[_h][_i] = (unsigned)(_t * K + _C) * 2u; } } } } while (0)
#define PG8_LDA(dst, b, h) do { _Pragma("unroll") for (int m = 0; m < 4; ++m) _Pragma("unroll") for (int k = 0; k < 2; ++k) dst[m][k] = *(const PG8_LAS bf16x8*)(lds + PG8_SA(b, h) + aoff + m * 2048 + k * 1024); } while (0)
#define PG8_LDB(dst, b, h) do { _Pragma("unroll") for (int n = 0; n < 2; ++n) _Pragma("unroll") for (int k = 0; k < 2; ++k) dst[n][k] = *(const PG8_LAS bf16x8*)(lds + PG8_SB(b, h) + boff + n * 2048 + k * 1024); } while (0)
#define PG8_MMA(ai, bj, At, Bt) do { __builtin_amdgcn_s_setprio(1); _Pragma("unroll") for (int m = 0; m < 4; ++m) _Pragma("unroll") for (int n = 0; n < 2; ++n) _Pragma("unroll") for (int k = 0; k < 2; ++k) \
        acc[ai][bj][m][n] = __builtin_amdgcn_mfma_f32_16x16x32_bf16(Bt[n][k], At[m][k], acc[ai][bj][m][n], 0, 0, 0); __builtin_amdgcn_s_setprio(0); } while (0)
#define PG8_WAIT_V(n) asm volatile("s_waitcnt vmcnt(" #n ")" ::: "memory")
#define PG8_WAIT_L(n) asm volatile("s_waitcnt lgkmcnt(" #n ")" ::: "memory")
#define PG8_BAR __builtin_amdgcn_s_barrier()
#define PG8_SCHED __builtin_amdgcn_sched_barrier(0)
    Unit cur, nxt; int ui = 0;
    if (!S.next(0, cur)) return;
    f32x4 acc[2][2][4][2];
#pragma unroll
    for (int a = 0; a < 2; ++a)
#pragma unroll
        for (int b = 0; b < 2; ++b)
#pragma unroll
            for (int m = 0; m < 4; ++m)
#pragma unroll
                for (int n = 0; n < 2; ++n) acc[a][b][m][n] = (f32x4){0.f, 0.f, 0.f, 0.f};
    bf16x8 At[4][2], B0[2][2], B1[2][2];
    const char* cA = GATHER ? (const char*)g.A : (const char*)g.A + (size_t)cur.pm * tstepA;
    const char* cB = (const char*)g.Bt + ((size_t)cur.e * g.bstride) * 2 + (size_t)cur.pn * tstep;
    PG8_LOADROWS(gvo, cur);
    PG8_STAGE(PG8_SB(0, 0), cB, voffB); PG8_STAGE(PG8_SB(0, 1), cB + hstep, voffB); PG8_STAGE_A(PG8_SA(0, 0), 0, cA, 0, false); PG8_STAGE_A(PG8_SA(0, 1), 1, cA, 0, false);
    if (wr == 1) PG8_BAR;
    PG8_WAIT_V(2); PG8_BAR;
    PG8_STAGE(PG8_SB(1, 0), cB + kstep, voffB); PG8_STAGE_A(PG8_SA(1, 0), 0, cA, kstep, false); PG8_STAGE(PG8_SB(1, 1), cB + hstep + kstep, voffB);
    PG8_WAIT_V(6); PG8_BAR;
    for (;;) {
        const bool has_next = S.next(ui + 1, nxt);
        const char* nA = GATHER ? (const char*)g.A : (has_next ? (const char*)g.A + (size_t)nxt.pm * tstepA : cA);
        const char* nB = has_next ? (const char*)g.Bt + ((size_t)nxt.e * g.bstride) * 2 + (size_t)nxt.pn * tstep : cB;
        for (int t = 0; t < nt; t += 2) {
            const bool last = (t == nt - 2);
            const size_t k1 = (size_t)(t + 1) * kstep;
            const size_t k2 = last ? 0 : (size_t)(t + 2) * kstep, k3 = k2 + kstep;
            const char* a2b = last ? nA : cA; const char* b2 = (last ? nB : cB) + k2; const char* b3 = b2 + kstep;
            PG8_LDB(B0, 0, 0); PG8_LDB(B1, 0, 1); PG8_SCHED; PG8_LDA(At, 0, 0); PG8_STAGE_A(PG8_SA(1, 1), 1, cA, k1, false);
            if (last && has_next) PG8_LOADROWS(gvo, nxt);
            PG8_WAIT_V(8); PG8_WAIT_L(0); PG8_BAR; PG8_MMA(0, 0, At, B0); PG8_MMA(0, 1, At, B1); PG8_BAR; PG8_SCHED;
            PG8_LDA(At, 0, 1); PG8_STAGE(PG8_SB(0, 0), b2, voffB); PG8_STAGE(PG8_SB(0, 1), b2 + hstep, voffB); PG8_STAGE_A(PG8_SA(0, 0), 0, a2b, k2, last);
            PG8_WAIT_V(8); PG8_WAIT_L(0); PG8_BAR; PG8_MMA(1, 0, At, B0); PG8_MMA(1, 1, At, B1); PG8_BAR; PG8_SCHED;
            PG8_LDB(B0, 1, 0); PG8_LDB(B1, 1, 1); PG8_SCHED; PG8_LDA(At, 1, 0); PG8_STAGE_A(PG8_SA(0, 1), 1, a2b, k2, last);
            PG8_WAIT_V(8); PG8_WAIT_L(0); PG8_BAR; PG8_MMA(0, 0, At, B0); PG8_MMA(0, 1, At, B1); PG8_BAR; PG8_SCHED;
            PG8_LDA(At, 1, 1); PG8_STAGE(PG8_SB(1, 0), b3, voffB); PG8_STAGE(PG8_SB(1, 1), b3 + hstep, voffB); PG8_STAGE_A(PG8_SA(1, 0), 0, a2b, k3, last);
            PG8_WAIT_V(8); PG8_WAIT_L(0); PG8_BAR; PG8_MMA(1, 0, At, B0); PG8_MMA(1, 1, At, B1); PG8_BAR; PG8_SCHED;
        }
        if (wr == 0) PG8_BAR;
        E(acc, cur, wr, wc, fr, fq);
        if (!has_next) break;
#pragma unroll
        for (int a = 0; a < 2; ++a)
#pragma unroll
            for (int b = 0; b < 2; ++b)
#pragma unroll
                for (int m = 0; m < 4; ++m)
#pragma unroll
                    for (int n = 0; n < 2; ++n) acc[a][b][m][n] = (f32x4){0.f, 0.f, 0.f, 0.f};
        cur = nxt; cA = nA; cB = nB; ++ui;
        if (wr == 1) PG8_BAR;
    }
    PG8_WAIT_V(0);
    PG8_BAR;
#undef PG8_SA
#undef PG8_SB
#undef PG8_STAGE
#undef PG8_STAGE_A
#undef PG8_LOADROWS
#undef PG8_LDA
#undef PG8_LDB
#undef PG8_MMA
#undef PG8_WAIT_V
#undef PG8_WAIT_L
#undef PG8_BAR
#undef PG8_SCHED
}
}
using pg8::bf16_t; using pg8::bf16x8; using pg8::f32x4; using pg8::f32x2; using pg8::u32x4; using pg8::u32x2; using pg8::pk2; using pg8::bf2f; using pg8::f2bf; using pg8::bf_lo; using pg8::bf_hi; using pg8::sigmoidf_;

constexpr int NWAVES = 8, NTHR = 512;
constexpr int D = 1024, NB = 32, SEQ = 2048, T = NB * SEQ, TH = T / 2, DEPTH = 4;
constexpr int RW_COLS = 1792, DS_COLS = 1224, DS_PAD = 1280, N_IN = 5064, N_INP = 5120;
constexpr int NMEM = 256, MEMROWS = NB * NMEM;
constexpr int FFN = 2816, NEXP = 8, EDIM = 1408;
constexpr int MOE_ROWS_MAX = 2 * T + 16 * 256;
constexpr int MOE_TILES_MAX = MOE_ROWS_MAX / 256;

constexpr size_t MiB = 1u << 20;
constexpr size_t WS_CTL = 0, CTL_ZERO_BYTES = 1 * MiB;
constexpr size_t WS_MOE = 1 * MiB;
constexpr size_t MOE_SELE = WS_MOE, MOE_SELW = MOE_SELE + (size_t)T * 2, MOE_ROWTOK = MOE_SELW + (size_t)T * 8, MOE_ROWW = MOE_ROWTOK + (size_t)MOE_ROWS_MAX * 4,
                 MOE_TILEE = MOE_ROWW + (size_t)MOE_ROWS_MAX * 4, MOE_META = MOE_TILEE + (size_t)MOE_TILES_MAX * 4, MOE_END = MOE_META + 256;
static_assert(MOE_END <= 4 * MiB, "moe map");
constexpr size_t WS_W = 4 * MiB;
constexpr size_t W_IN = WS_W, W_BA = W_IN + (size_t)N_INP * D * 2, W_BB = W_BA + (size_t)D * 512 * 2, W_OUT = W_BB + (size_t)D * 512 * 2, W_MQ = W_OUT + (size_t)D * D * 2,
                 W_MO = W_MQ + (size_t)512 * D * 2, W_FF = W_MO + (size_t)D * 512 * 2;
constexpr size_t W_RW2 = W_FF, W_RA2 = W_RW2 + 512 * 64 * 2, W_RG2 = W_RA2 + 512 * 64 * 2, W_RV1 = W_RG2 + 512 * 128 * 2, W_RV2 = W_RV1 + 32 * 512 * 2, W_FF2 = W_RV2 + 512 * 32 * 2;
constexpr size_t W_FGU = W_FF2, W_FD = W_FGU + (size_t)2 * FFN * D * 2;
constexpr size_t W_EGU = W_FF2, W_ED = W_EGU + (size_t)NEXP * 2 * EDIM * D * 2, W_END = W_ED + (size_t)NEXP * D * EDIM * 2;
static_assert(W_FD + (size_t)D * FFN * 2 <= W_END, "w map");
constexpr size_t WS_WKV = (W_END + MiB - 1) / MiB * MiB;
constexpr size_t WS_MEMH = WS_WKV + (size_t)4096 * D * 2;
constexpr size_t WS_MEMK = WS_MEMH + (size_t)MEMROWS * D * 2;
constexpr size_t WS_MEMVT = WS_MEMK + (size_t)DEPTH * MEMROWS * 512 * 2;
constexpr size_t WS_VFIRST = WS_MEMVT + (size_t)DEPTH * MEMROWS * 512 * 2;
constexpr size_t WS_HN = WS_VFIRST + (size_t)T * 512 * 2;
constexpr size_t WS_MIX = WS_HN + (size_t)T * D * 2;
constexpr size_t MX_CA = WS_MIX, MX_CB = MX_CA + (size_t)TH * RW_COLS * 2, MX_CG = MX_CB + (size_t)TH * DS_PAD * 2, MX_RW = MX_CG + (size_t)TH * 2048 * 2;
constexpr size_t RW_ARR = (size_t)TH * 512 * 2;
constexpr size_t MX_VT = MX_RW + 7 * RW_ARR, MX_YB = MX_VT + (size_t)(NB / 2) * 64 * SEQ * 2, MX_END = MX_YB + (size_t)TH * 512 * 2;
constexpr size_t MA_QM = WS_MIX, MA_OM = MA_QM + (size_t)T * 512 * 2;
constexpr size_t FF_GU = WS_MIX;
constexpr size_t PR_KVRAW = WS_MIX;
constexpr size_t MX_BS = MX_END;
constexpr size_t WS_END = MX_BS + (size_t)TH * 8 * 4;
static_assert(FF_GU + (size_t)T * FFN * 2 <= WS_END && FF_GU + (size_t)MOE_ROWS_MAX * EDIM * 2 <= WS_END && MA_OM + (size_t)T * 512 * 2 <= WS_END, "overlay map");
static_assert(WS_END <= 1000 * MiB, "workspace budget");

constexpr int LDS_BYTES = 160 * 1024;
constexpr int LDS_MISC = LDS_BYTES - 256;

#define XB_TMO      128
#define XB_XCNT(j)  (256  + 64 * (j))
#define XB_XSUB(j)  (1280 + 64 * (j))
#define XB_XGEN(j)  (2304 + 64 * (j))
#define XB_TOP      3328
#define XB_TOPGEN   3392
#define XCD_BAR_WORDS 3456
#define XB_SPIN_CAP (1u << 18)
#define LAS __attribute__((address_space(3)))

__device__ __forceinline__ unsigned xb_ld(unsigned* p)              { return __hip_atomic_load(p, __ATOMIC_RELAXED, __HIP_MEMORY_SCOPE_AGENT); }
__device__ __forceinline__ unsigned xb_add(unsigned* p, unsigned v) { return __hip_atomic_fetch_add(p, v, __ATOMIC_RELAXED, __HIP_MEMORY_SCOPE_AGENT); }
__device__ __forceinline__ unsigned xb_xcc_id() { return (unsigned)__builtin_amdgcn_s_getreg((3 << 11) | 20) & 0xFu; }
#define XB_SPIN(cond, bar) do { unsigned _sp = 0; while (cond) { __builtin_amdgcn_s_sleep(1); \
    if ((++_sp & 255u) == 0u) { if (xb_ld(&(bar)[XB_TMO])) break; if (_sp > XB_SPIN_CAP) { atomicAdd(&(bar)[XB_TMO], 1u); break; } } } } while (0)
struct XcdBarrier { unsigned* bar; unsigned x; volatile LAS unsigned* st; };
__device__ __forceinline__ XcdBarrier xcd_barrier_post(unsigned* bar, volatile LAS unsigned* st) {
    XcdBarrier b; b.bar = bar; b.x = xb_xcc_id(); b.st = st;
    if (threadIdx.x == 0) (void)xb_add(&bar[XB_XCNT(b.x)], 1u);
    return b;
}
__device__ __forceinline__ void xcd_barrier_complete(unsigned* bar, unsigned x, unsigned& nloc, unsigned& nx) {
    const unsigned G = gridDim.x * gridDim.y * gridDim.z;
    unsigned sum, cnt, mine, sp = 0u;
    for (;;) {
        sum = 0u; cnt = 0u; mine = 0u;
#pragma unroll
        for (unsigned j = 0; j < 16; ++j) { const unsigned c = xb_ld(&bar[XB_XCNT(j)]); sum += c; cnt += (c > 0u) ? 1u : 0u; mine = (j == x) ? c : mine; }
        if (sum == G) break;
        __builtin_amdgcn_s_sleep(1);
        if ((++sp & 255u) == 0u) { if (xb_ld(&bar[XB_TMO])) break; if (sp > XB_SPIN_CAP) { atomicAdd(&bar[XB_TMO], 1u); break; } }
    }
    nloc = mine > 0u ? mine : 1u; nx = cnt > 0u ? cnt : 1u;
}
__device__ __forceinline__ void xcd_barrier(const XcdBarrier& b, int tid) {
    asm volatile("s_waitcnt vmcnt(0)" ::: "memory");
    __syncthreads();
    if (tid == 0) {
        unsigned* bar = b.bar; asm volatile("" : "+s"(bar));
        __builtin_amdgcn_s_waitcnt(0);
        unsigned nloc = b.st[0], nx = b.st[1];
        if (nloc == 0u) { xcd_barrier_complete(bar, b.x, nloc, nx); b.st[0] = nloc; b.st[1] = nx; }
        const unsigned old = xb_add(&bar[XB_XSUB(b.x)], 1u);
        const unsigned gen = old / nloc;
        if (old + 1u == (gen + 1u) * nloc) {
            __builtin_amdgcn_fence(__ATOMIC_RELEASE, "agent");
            asm volatile("s_waitcnt vmcnt(0)" ::: "memory");
            const unsigned og = xb_add(&bar[XB_TOP], 1u);
            const unsigned tg = og / nx;
            if (og + 1u == (tg + 1u) * nx) xb_add(&bar[XB_TOPGEN], 1u);
            else XB_SPIN(xb_ld(&bar[XB_TOPGEN]) == tg, bar);
            __builtin_amdgcn_fence(__ATOMIC_ACQUIRE, "agent");
            xb_add(&bar[XB_XGEN(b.x)], 1u);
            asm volatile("s_waitcnt vmcnt(0)" ::: "memory");
        } else {
            XB_SPIN(xb_ld(&bar[XB_XGEN(b.x)]) == gen, bar);
            __builtin_amdgcn_fence(__ATOMIC_ACQUIRE, "agent");
            asm volatile("s_waitcnt vmcnt(0)" ::: "memory");
        }
    }
    __syncthreads();
}

struct Args { const void* in[41]; float* out; unsigned char* ws; int ph_lo, ph_hi; };
static_assert(sizeof(Args) == 41 * 8 + 8 + 8 + 8, "Args has no padding");

enum InIdx { I_X = 0, I_MEM, I_POS, I_NORM_MIX, I_W_IN, I_MU, I_W0, I_W2, I_A0, I_A2, I_G2, I_V0, I_V1, I_V2, I_KK, I_KA, I_RK, I_LNG, I_LNB, I_QN, I_KN, I_IKN,
             I_WBA, I_WBB, I_WOUT, I_NORM_MEM, I_MEM_TOKN, I_MWQ, I_MWKV, I_MQN, I_MKN, I_MWO, I_NORM_FFN, I_FWG, I_FWU, I_FWD, I_ROUTER, I_RBIAS, I_EWG, I_EWU, I_EWD };

typedef decltype(__builtin_amdgcn_kernarg_segment_ptr()) kptr_t;
struct Frame {
    LAS unsigned char* lds; unsigned char* ws; kptr_t kb; float* out;
    int tid, lane, wave, G, bid;
};
#define LDS_WAIT() asm volatile("s_waitcnt lgkmcnt(0)" ::: "memory")
__device__ __forceinline__ const void* kargp(kptr_t kb, int i) { typedef const void* cvp; typedef __attribute__((address_space(4))) const cvp* tab_t; return (const void*)(const __attribute__((address_space(1))) void*)(((tab_t)kb)[i]); }
#define KARGP(F, i) kargp((F).kb, (i))
#define FIN(F, i) ((const float*)KARGP(F, i))
__device__ __forceinline__ void lds_barrier() { asm volatile("s_waitcnt lgkmcnt(0)" ::: "memory"); __builtin_amdgcn_s_barrier(); asm volatile("" ::: "memory"); }

__device__ __forceinline__ float wave_sum(float v) {
#pragma unroll
    for (int o = 1; o < 64; o <<= 1) v += __shfl_xor(v, o);
    return v;
}

template <class Map>
__device__ __forceinline__ void transpose_item(const float* W, int K, int N, bf16_t* WT, const Map& map, const float* gain, LAS float* scr, int item, int lane) {
    const int nblk = (N + 31) / 32, kb = item / nblk, nb = item % nblk, k0 = 64 * kb, n0 = 32 * nb;
    const int nn = n0 + (lane & 31);
    float vv[32], gg[32];
#pragma unroll
    for (int i = 0; i < 32; ++i) { const int kk = 2 * i + (lane >> 5); vv[i] = 0.f; gg[i] = 1.f; if (nn < N && k0 + kk < K) { vv[i] = W[(size_t)(k0 + kk) * N + nn]; if (gain) gg[i] = gain[k0 + kk]; } }
#pragma unroll
    for (int i = 0; i < 32; ++i) { const int kk = 2 * i + (lane >> 5); scr[kk * 33 + (lane & 31)] = vv[i] * gg[i]; }
    LDS_WAIT(); asm volatile("" ::: "memory");
    const int c = lane & 7;
#pragma unroll
    for (int j = 0; j < 4; ++j) { const int n = (lane >> 3) + 8 * j; const LAS float* s = scr + (8 * c) * 33 + n;
        u32x4 o; o.x = pk2(s[0 * 33], s[1 * 33]); o.y = pk2(s[2 * 33], s[3 * 33]); o.z = pk2(s[4 * 33], s[5 * 33]); o.w = pk2(s[6 * 33], s[7 * 33]);
        if (n0 + n < N && k0 + 8 * c < K) *(u32x4*)(WT + (size_t)map(n0 + n) * K + k0 + 8 * c) = o; }
    LDS_WAIT(); asm volatile("" ::: "memory");
}
struct MapId { int off; __device__ int operator()(int n) const { return n + off; } };
struct MapWin { __device__ int operator()(int n) const { return n < 3016 ? n : n + 56; } };
struct MapGU { int up; __device__ int operator()(int n) const { return (n >> 7) * 256 + up * 128 + (n & 127); } };

__device__ __forceinline__ void rms_row_to_bf16(const float* xrow, bf16_t* orow, int lane, f32x4 (&v)[4]) {
    const f32x4* xr = (const f32x4*)xrow + lane; float s = 0.f;
#pragma unroll
    for (int j = 0; j < 4; ++j) { v[j] = xr[64 * j]; s += (v[j].x * v[j].x + v[j].y * v[j].y) + (v[j].z * v[j].z + v[j].w * v[j].w); }
    const float rstd = 1.0f / sqrtf(wave_sum(s) * (1.f / D) + 1e-6f);
    u32x2* o8 = (u32x2*)orow + lane;
#pragma unroll
    for (int j = 0; j < 4; ++j) { v[j] = v[j] * rstd; u32x2 w; w.x = pk2(v[j].x, v[j].y); w.y = pk2(v[j].z, v[j].w); o8[64 * j] = w; }
}

__device__ __forceinline__ void rms_pass_to_bf16(const float* x, bf16_t* o, int first, int stride, int lane) {
    f32x4 v[4][4], n[4][4];
#pragma unroll
    for (int r = 0; r < 4; ++r) { const f32x4* xr = (const f32x4*)(x + (size_t)(first + r * stride) * D) + lane;
#pragma unroll
        for (int j = 0; j < 4; ++j) n[r][j] = xr[64 * j]; }
#pragma unroll 1
    for (int m0 = first; m0 < T; m0 += 4 * stride) {
#pragma unroll
        for (int r = 0; r < 4; ++r)
#pragma unroll
            for (int j = 0; j < 4; ++j) { v[r][j] = n[r][j]; asm volatile("" : "+v"(v[r][j])); }
        { const int mn = (m0 + 4 * stride < T) ? m0 + 4 * stride : m0;
#pragma unroll
          for (int r = 0; r < 4; ++r) { const f32x4* xr = (const f32x4*)(x + (size_t)(mn + r * stride) * D) + lane;
#pragma unroll
              for (int j = 0; j < 4; ++j) n[r][j] = xr[64 * j]; }
          asm volatile("" ::: "memory"); }
        float s[4];
#pragma unroll
        for (int r = 0; r < 4; ++r) { s[r] = 0.f;
#pragma unroll
            for (int j = 0; j < 4; ++j) s[r] += (v[r][j].x * v[r][j].x + v[r][j].y * v[r][j].y) + (v[r][j].z * v[r][j].z + v[r][j].w * v[r][j].w); }
#pragma unroll
        for (int o_ = 1; o_ < 64; o_ <<= 1) {
#pragma unroll
            for (int r = 0; r < 4; ++r) s[r] += __shfl_xor(s[r], o_); }
#pragma unroll
        for (int r = 0; r < 4; ++r) { const float rstd = 1.0f / sqrtf(s[r] * (1.f / D) + 1e-6f); u32x2* o8 = (u32x2*)(o + (size_t)(m0 + r * stride) * D) + lane;
#pragma unroll
            for (int j = 0; j < 4; ++j) { const f32x4 t = v[r][j] * rstd; u32x2 w; w.x = pk2(t.x, t.y); w.y = pk2(t.z, t.w); o8[64 * j] = w; } }
    }
}
__device__ __forceinline__ void ph_prologue0(Frame& F) {
    LAS float* scr = (LAS float*)(F.lds + F.wave * 16384);
    const int gw = F.bid * NWAVES + F.wave, NGW = F.G * NWAVES;
    bf16_t* wkv = (bf16_t*)(F.ws + WS_WKV);
    constexpr int IT = (D / 64) * (1024 / 32);
    for (int it = gw; it < DEPTH * IT; it += NGW) { const int l = it / IT, r = it % IT;
        transpose_item(FIN(F, I_MWKV) + (size_t)l * D * 1024, D, 1024, wkv, MapId{l * 1024}, FIN(F, I_MEM_TOKN) + l * D, scr, r, F.lane); }
    bf16_t* mh = (bf16_t*)(F.ws + WS_MEMH);
    for (int m = gw; m < MEMROWS; m += NGW) { f32x4 v[4]; rms_row_to_bf16(FIN(F, I_MEM) + (size_t)m * D, mh + (size_t)m * D, F.lane, v); }
}
__device__ __forceinline__ void ph_prologue2(Frame& F) {
    const int gw = F.bid * NWAVES + F.wave, NGW = F.G * NWAVES;
    const bf16_t* kv = (const bf16_t*)(F.ws + PR_KVRAW);
    bf16_t* MK = (bf16_t*)(F.ws + WS_MEMK); bf16_t* MVT = (bf16_t*)(F.ws + WS_MEMVT);
    for (int it = gw; it < MEMROWS * 16; it += NGW) {
        const int row = it >> 4, l = (it >> 2) & 3, hh = it & 3, b = row >> 8, m = row & 255;
        const bf16_t* src = kv + (size_t)row * 4096 + l * 1024;
        const unsigned kk = *(const unsigned*)(src + hh * 128 + 2 * F.lane);
        const float k0 = bf_lo(kk), k1 = bf_hi(kk);
        const float rstd = 1.0f / sqrtf(wave_sum(k0 * k0 + k1 * k1) * (1.f / 128.f) + 1e-6f);
        const float* gk = FIN(F, I_MKN) + l * 128;
        *(unsigned*)(MK + ((((size_t)l * NB + b) * 4 + hh) * 256 + m) * 128 + 2 * F.lane) = pk2(k0 * rstd * gk[2 * F.lane], k1 * rstd * gk[2 * F.lane + 1]);
        const unsigned vv = *(const unsigned*)(src + 512 + hh * 128 + 2 * F.lane);
        bf16_t* vt = MVT + (((size_t)l * NB + b) * 4 + hh) * 128 * 256 + m;
        vt[(size_t)(2 * F.lane) * 256] = (bf16_t)(vv & 0xffffu); vt[(size_t)(2 * F.lane + 1) * 256] = (bf16_t)(vv >> 16);
    }
}
__device__ __forceinline__ void ph_layer0(Frame& F, int l, const float* xin) {
    LAS float* scr = (LAS float*)(F.lds + F.wave * 16384);
    const int gw = F.bid * NWAVES + F.wave, NGW = F.G * NWAVES;
    unsigned char* ws = F.ws;
    constexpr int I_WIN = (D / 64) * ((N_IN + 31) / 32), I_B = (512 / 64) * (D / 32), I_O = (D / 64) * (D / 32), I_Q = (D / 64) * (512 / 32);
    constexpr int I_FG = (D / 64) * (FFN / 32), I_FDN = (FFN / 64) * (D / 32), I_EG = (D / 64) * (EDIM / 32), I_EDN = (EDIM / 64) * (D / 32);
    const bool moe = (l & 1) != 0; const int j = l >> 1;
    const int nff = moe ? NEXP * (2 * I_EG + I_EDN) : (2 * I_FG + I_FDN);
    constexpr int I_R2 = 16, I_RG = 32, I_RV1 = 8, I_RV2 = 16;
    const int nrw = 2 * I_R2 + I_RG + (l ? I_RV1 + I_RV2 : 0);
    const int NIT = I_WIN + 2 * I_B + I_O + I_Q + I_B + nrw + nff;
    const float* gffn = FIN(F, I_NORM_FFN) + l * D;
    for (int it = gw; it < NIT; it += NGW) {
        int r = it;
        if (r < I_WIN) { transpose_item(FIN(F, I_W_IN) + (size_t)l * D * N_IN, D, N_IN, (bf16_t*)(ws + W_IN), MapWin{}, FIN(F, I_NORM_MIX) + l * D, scr, r, F.lane); continue; } r -= I_WIN;
        if (r < I_B) { transpose_item(FIN(F, I_WBA) + (size_t)l * 512 * D, 512, D, (bf16_t*)(ws + W_BA), MapId{0}, nullptr, scr, r, F.lane); continue; } r -= I_B;
        if (r < I_B) { transpose_item(FIN(F, I_WBB) + (size_t)l * 512 * D, 512, D, (bf16_t*)(ws + W_BB), MapId{0}, nullptr, scr, r, F.lane); continue; } r -= I_B;
        if (r < I_O) { transpose_item(FIN(F, I_WOUT) + (size_t)l * D * D, D, D, (bf16_t*)(ws + W_OUT), MapId{0}, nullptr, scr, r, F.lane); continue; } r -= I_O;
        if (r < I_Q) { transpose_item(FIN(F, I_MWQ) + (size_t)l * D * 512, D, 512, (bf16_t*)(ws + W_MQ), MapId{0}, FIN(F, I_NORM_MEM) + l * D, scr, r, F.lane); continue; } r -= I_Q;
        if (r < I_B) { transpose_item(FIN(F, I_MWO) + (size_t)l * 512 * D, 512, D, (bf16_t*)(ws + W_MO), MapId{0}, nullptr, scr, r, F.lane); continue; } r -= I_B;
        if (r < nrw) {
            if (r < I_R2) { transpose_item(FIN(F, I_W2) + (size_t)l * 64 * 512, 64, 512, (bf16_t*)(ws + W_RW2), MapId{0}, nullptr, scr, r, F.lane); continue; } r -= I_R2;
            if (r < I_R2) { transpose_item(FIN(F, I_A2) + (size_t)l * 64 * 512, 64, 512, (bf16_t*)(ws + W_RA2), MapId{0}, nullptr, scr, r, F.lane); continue; } r -= I_R2;
            if (r < I_RG) { transpose_item(FIN(F, I_G2) + (size_t)l * 128 * 512, 128, 512, (bf16_t*)(ws + W_RG2), MapId{0}, nullptr, scr, r, F.lane); continue; } r -= I_RG;
            if (r < I_RV1) { transpose_item(FIN(F, I_V1) + (size_t)(l - 1) * 512 * 32, 512, 32, (bf16_t*)(ws + W_RV1), MapId{0}, nullptr, scr, r, F.lane); continue; } r -= I_RV1;
            transpose_item(FIN(F, I_V2) + (size_t)(l - 1) * 32 * 512, 32, 512, (bf16_t*)(ws + W_RV2), MapId{0}, nullptr, scr, r, F.lane); continue;
        }
        r -= nrw;
        if (!moe) {
            if (r < I_FG) { transpose_item(FIN(F, I_FWG) + (size_t)j * D * FFN, D, FFN, (bf16_t*)(ws + W_FGU), MapGU{0}, gffn, scr, r, F.lane); continue; } r -= I_FG;
            if (r < I_FG) { transpose_item(FIN(F, I_FWU) + (size_t)j * D * FFN, D, FFN, (bf16_t*)(ws + W_FGU), MapGU{1}, gffn, scr, r, F.lane); continue; } r -= I_FG;
            transpose_item(FIN(F, I_FWD) + (size_t)j * FFN * D, FFN, D, (bf16_t*)(ws + W_FD), MapId{0}, nullptr, scr, r, F.lane);
        } else {
            const int per = 2 * I_EG + I_EDN, e = r / per; r -= e * per;
            const size_t eo = (size_t)(j * NEXP + e);
            if (r < I_EG) { transpose_item(FIN(F, I_EWG) + eo * D * EDIM, D, EDIM, (bf16_t*)(ws + W_EGU) + (size_t)e * 2 * EDIM * D, MapGU{0}, gffn, scr, r, F.lane); continue; } r -= I_EG;
            if (r < I_EG) { transpose_item(FIN(F, I_EWU) + eo * D * EDIM, D, EDIM, (bf16_t*)(ws + W_EGU) + (size_t)e * 2 * EDIM * D, MapGU{1}, gffn, scr, r, F.lane); continue; } r -= I_EG;
            transpose_item(FIN(F, I_EWD) + eo * EDIM * D, EDIM, D, (bf16_t*)(ws + W_ED) + (size_t)e * D * EDIM, MapId{0}, nullptr, scr, r, F.lane);
        }
    }
    { u32x4* z = (u32x4*)((bf16_t*)(ws + W_IN) + (size_t)3016 * D); const int n16 = 56 * D * 2 / 16;
      for (int i = F.bid * NTHR + F.tid; i < n16; i += F.G * NTHR) z[i] = (u32x4){0u, 0u, 0u, 0u}; }
    bf16_t* hn = (bf16_t*)(ws + WS_HN);
    rms_pass_to_bf16(xin, hn, gw, NGW, F.lane);
}
__device__ __forceinline__ void ph_norm(Frame& F) {
    const int gw = F.bid * NWAVES + F.wave, NGW = F.G * NWAVES;
    bf16_t* hn = (bf16_t*)(F.ws + WS_HN);
    rms_pass_to_bf16(F.out, hn, gw, NGW, F.lane);
}
__device__ __forceinline__ void ph_norm_ffn(Frame& F, int l) {
    const int gw = F.bid * NWAVES + F.wave, NGW = F.G * NWAVES;
    bf16_t* hn = (bf16_t*)(F.ws + WS_HN);
    const bool moe = (l & 1) != 0; const int j = l >> 1;
    const float* gn = FIN(F, I_NORM_FFN) + l * D;
    const float* rt = FIN(F, I_ROUTER) + (size_t)j * D * NEXP; const float* rb = FIN(F, I_RBIAS) + j * NEXP;
    unsigned short* sele = (unsigned short*)(F.ws + MOE_SELE); f32x2* selw = (f32x2*)(F.ws + MOE_SELW);
    if (!moe) { rms_pass_to_bf16(F.out, hn, gw, NGW, F.lane); return; }
    for (int m = gw; m < T; m += NGW) {
        f32x4 v[4]; rms_row_to_bf16(F.out + (size_t)m * D, hn + (size_t)m * D, F.lane, v);
        if (moe) {
            float lg[8];
#pragma unroll
            for (int e = 0; e < 8; ++e) lg[e] = 0.f;
#pragma unroll
            for (int q = 0; q < 4; ++q)
#pragma unroll
                for (int c = 0; c < 4; ++c) { const int k = 256 * q + 4 * F.lane + c; const float h = v[q][c] * gn[k];
                    const f32x4 r0 = *(const f32x4*)(rt + (size_t)k * 8), r1 = *(const f32x4*)(rt + (size_t)k * 8 + 4);
                    lg[0] += h * r0.x; lg[1] += h * r0.y; lg[2] += h * r0.z; lg[3] += h * r0.w; lg[4] += h * r1.x; lg[5] += h * r1.y; lg[6] += h * r1.z; lg[7] += h * r1.w; }
#pragma unroll
            for (int e = 0; e < 8; ++e) lg[e] = wave_sum(lg[e]) + rb[e];
            int e0 = 0; float l0 = lg[0];
#pragma unroll
            for (int e = 1; e < 8; ++e) if (lg[e] > l0) { l0 = lg[e]; e0 = e; }
            int e1 = -1; float l1 = -3.0e38f;
#pragma unroll
            for (int e = 0; e < 8; ++e) if (e != e0 && lg[e] > l1) { l1 = lg[e]; e1 = e; }
            const float w1 = 1.0f / (1.0f + __expf(l0 - l1)), w0 = 1.0f - w1;
            if (F.lane == 0) { sele[m] = (unsigned short)(e0 | (e1 << 8)); selw[m] = (f32x2){w0, w1}; }
        }
    }
}

#define MFMA16(x, y, c) __builtin_amdgcn_mfma_f32_16x16x32_bf16((x), (y), (c), 0, 0, 0)
__device__ __forceinline__ float softplusf_(float x) { return fmaxf(x, 0.f) + log1pf(expf(-fabsf(x))); }
typedef __attribute__((address_space(3))) bf16_t lbf;
constexpr int LDP = 72;
constexpr int SLOT = 64 * LDP * 2;
__device__ __forceinline__ f32x4 unpack4(u32x2 u) { return (f32x4){bf_lo(u.x), bf_hi(u.x), bf_lo(u.y), bf_hi(u.y)}; }
__device__ __forceinline__ u32x2 pack4(f32x4 v) { u32x2 o; o.x = pk2(v[0], v[1]); o.y = pk2(v[2], v[3]); return o; }
__device__ __forceinline__ size_t rwo(int t, int col) { return ((size_t)((t >> 6) * 32 + (col >> 4)) << 10) + (size_t)(((t & 63) << 4) + (col & 15)); }
__device__ __forceinline__ void mm64(const lbf* X, const lbf* Y, int w, int jl, int g, f32x4 (&acc)[2]) {
    const lbf* xr = X + (16 * (w & 3) + jl) * LDP + 8 * g;
    const lbf* yr = Y + (16 * (2 * (w >> 2)) + jl) * LDP + 8 * g;
    const bf16x8 x0 = *(const LAS bf16x8*)xr, x1 = *(const LAS bf16x8*)(xr + 32);
    const bf16x8 y00 = *(const LAS bf16x8*)yr, y01 = *(const LAS bf16x8*)(yr + 32), y10 = *(const LAS bf16x8*)(yr + 16 * LDP), y11 = *(const LAS bf16x8*)(yr + 16 * LDP + 32);
    acc[0] = MFMA16(x0, y00, acc[0]); acc[1] = MFMA16(x0, y10, acc[1]); acc[0] = MFMA16(x1, y01, acc[0]); acc[1] = MFMA16(x1, y11, acc[1]);
}
struct FrX { bf16x8 k0, k1; }; struct FrY { bf16x8 a0, a1, b0, b1; };
__device__ __forceinline__ FrX ldx64(const lbf* X, int w, int jl, int g) { const lbf* xr = X + (16 * (w & 3) + jl) * LDP + 8 * g; FrX f; f.k0 = *(const LAS bf16x8*)xr; f.k1 = *(const LAS bf16x8*)(xr + 32); return f; }
__device__ __forceinline__ FrY ldy64(const lbf* Y, int w, int jl, int g) { const lbf* yr = Y + (16 * (2 * (w >> 2)) + jl) * LDP + 8 * g; FrY f;
    f.a0 = *(const LAS bf16x8*)yr; f.a1 = *(const LAS bf16x8*)(yr + 32); f.b0 = *(const LAS bf16x8*)(yr + 16 * LDP); f.b1 = *(const LAS bf16x8*)(yr + 16 * LDP + 32); return f; }
__device__ __forceinline__ void mma64(const FrX& x, const FrY& y, f32x4 (&acc)[2]) {
    acc[0] = MFMA16(x.k0, y.a0, acc[0]); acc[1] = MFMA16(x.k0, y.b0, acc[1]); acc[0] = MFMA16(x.k1, y.a1, acc[0]); acc[1] = MFMA16(x.k1, y.b1, acc[1]); }
__device__ __forceinline__ void st_t(lbf* dst, const f32x4 (&acc)[2], int w, int jl, int g) {
#pragma unroll
    for (int i = 0; i < 2; ++i) *(LAS u32x2*)(dst + (16 * (2 * (w >> 2) + i) + jl) * LDP + 16 * (w & 3) + 4 * g) = pack4(acc[i]);
}
__device__ __forceinline__ void st_n(lbf* dst, const f32x4 (&acc)[2], int w, int jl, int g) {
#pragma unroll
    for (int i = 0; i < 2; ++i)
#pragma unroll
        for (int r = 0; r < 4; ++r) dst[(16 * (w & 3) + 4 * g + r) * LDP + 16 * (2 * (w >> 2) + i) + jl] = f2bf(acc[i][r]);
}
#define ZACC(a) do { a[0] = (f32x4){0.f, 0.f, 0.f, 0.f}; a[1] = (f32x4){0.f, 0.f, 0.f, 0.f}; } while (0)

constexpr int XA_LD = 264, XV_LD = 520, VM_LD = 40;
__device__ __forceinline__ void ph_rwkv_pre(Frame& F, int l, int half) {
    lbf* XA = (lbf*)F.lds;
    lbf* XV = (lbf*)(F.lds + 64 * XA_LD * 2);
    lbf* VM = (lbf*)(F.lds + 64 * XA_LD * 2 + 64 * XV_LD * 2);
    const bf16_t* CA = (const bf16_t*)(F.ws + MX_CA);
    bf16_t* RW = (bf16_t*)(F.ws + MX_RW); constexpr size_t AS_ = (size_t)TH * 512;
    bf16_t* VF = (bf16_t*)(F.ws + WS_VFIRST) + (size_t)half * TH * 512;
    const bf16_t* W2T = (const bf16_t*)(F.ws + W_RW2); const bf16_t* A2T = (const bf16_t*)(F.ws + W_RA2); const bf16_t* G2T = (const bf16_t*)(F.ws + W_RG2);
    const bf16_t* V1T = (const bf16_t*)(F.ws + W_RV1); const bf16_t* V2T = (const bf16_t*)(F.ws + W_RV2);
    const float* mu = FIN(F, I_MU) + l * RW_COLS;
    const int lane = F.lane, w = F.wave, jl = lane & 15, g = lane >> 4;
    for (int tile = F.bid; tile < TH / 64; tile += F.G) {
        const int t0 = tile * 64;
        lds_barrier();
        for (int it = F.tid; it < 64 * 32; it += NTHR) { const int i = it >> 5, c = 1536 + (it & 31) * 8; const int t = t0 + i;
            const u32x4 cu = *(const u32x4*)(CA + (size_t)t * RW_COLS + c);
            u32x4 pv = (u32x4){0u, 0u, 0u, 0u}; if ((t & (SEQ - 1)) != 0) pv = *(const u32x4*)(CA + (size_t)(t - 1) * RW_COLS + c);
            const float cv[8] = { bf_lo(cu.x), bf_hi(cu.x), bf_lo(cu.y), bf_hi(cu.y), bf_lo(cu.z), bf_hi(cu.z), bf_lo(cu.w), bf_hi(cu.w) };
            const float pp[8] = { bf_lo(pv.x), bf_hi(pv.x), bf_lo(pv.y), bf_hi(pv.y), bf_lo(pv.z), bf_hi(pv.z), bf_lo(pv.w), bf_hi(pv.w) };
            float x[8];
#pragma unroll
            for (int q = 0; q < 8; ++q) { x[q] = cv[q] + (pp[q] - cv[q]) * mu[c + q]; if (c < 1600) x[q] = 1.0f - 2.0f * __builtin_amdgcn_rcpf(1.0f + __expf(2.0f * x[q])); else if (c >= 1664) x[q] = sigmoidf_(x[q]); }
            u32x4 o; o.x = pk2(x[0], x[1]); o.y = pk2(x[2], x[3]); o.z = pk2(x[4], x[5]); o.w = pk2(x[6], x[7]);
            *(LAS u32x4*)(XA + i * XA_LD + (c - 1536)) = o; }
        if (l) for (int it = F.tid; it < 64 * 64; it += NTHR) { const int i = it >> 6, c = 1024 + (it & 63) * 8; const int t = t0 + i;
            const u32x4 cu = *(const u32x4*)(CA + (size_t)t * RW_COLS + c);
            u32x4 pv = (u32x4){0u, 0u, 0u, 0u}; if ((t & (SEQ - 1)) != 0) pv = *(const u32x4*)(CA + (size_t)(t - 1) * RW_COLS + c);
            const float cv[8] = { bf_lo(cu.x), bf_hi(cu.x), bf_lo(cu.y), bf_hi(cu.y), bf_lo(cu.z), bf_hi(cu.z), bf_lo(cu.w), bf_hi(cu.w) };
            const float pp[8] = { bf_lo(pv.x), bf_hi(pv.x), bf_lo(pv.y), bf_hi(pv.y), bf_lo(pv.z), bf_hi(pv.z), bf_lo(pv.w), bf_hi(pv.w) };
            float x[8];
#pragma unroll
            for (int q = 0; q < 8; ++q) x[q] = cv[q] + (pp[q] - cv[q]) * mu[c + q];
            u32x4 o; o.x = pk2(x[0], x[1]); o.y = pk2(x[2], x[3]); o.z = pk2(x[4], x[5]); o.w = pk2(x[6], x[7]);
            *(LAS u32x4*)(XV + i * XV_LD + (c - 1024)) = o; }
        lds_barrier();
        if (l) { const int tg = w & 3, nt = w >> 2; f32x4 a = (f32x4){0.f, 0.f, 0.f, 0.f};
            const bf16_t* xr = V1T + (size_t)(16 * nt + jl) * 512 + 8 * g; const lbf* yr = XV + (16 * tg + jl) * XV_LD + 8 * g;
#pragma unroll 4
            for (int s = 0; s < 16; ++s) a = MFMA16(*(const bf16x8*)(xr + 32 * s), *(const LAS bf16x8*)(yr + 32 * s), a);
            *(LAS u32x2*)(VM + (16 * tg + jl) * VM_LD + 16 * nt + 4 * g) = pack4(a); }
        lds_barrier();
        { bf16_t* XAG = RW + 0 * AS_; bf16_t* VMG = RW + 2 * AS_;
#pragma unroll
          for (int i = 0; i < 4; ++i) { const int id = F.tid + NTHR * i, row = id >> 5, c16 = id & 31; *(u32x4*)(XAG + (size_t)(t0 + row) * 256 + 8 * c16) = *(const LAS u32x4*)(XA + row * XA_LD + 8 * c16); }
          if (l && F.tid < 256) { const int row = F.tid >> 2, c8 = F.tid & 3; *(u32x4*)(VMG + (size_t)(t0 + row) * 32 + 8 * c8) = *(const LAS u32x4*)(VM + row * VM_LD + 8 * c8); } }
    }
}

__device__ __forceinline__ void ph_rwkv_s1(Frame& F, int l, int half) {
    bf16_t* RW = (bf16_t*)(F.ws + MX_RW); constexpr size_t AS_ = (size_t)TH * 512;
    float* BSW = (float*)(F.ws + MX_BS); const float* rkw = FIN(F, I_RK) + l * 512;
    bf16_t* YH = (bf16_t*)(F.ws + MX_CA);
    LAS unsigned char* L = F.lds;
#define SL(i) ((lbf*)(L + (i) * SLOT))
    lbf *AT = SL(0), *BT = SL(1), *KT = SL(2), *RT = SL(3), *ATt = SL(4), *Vt = SL(5), *BPt = SL(6), *KPt = SL(7), *AAK = SL(10), *ARB = SL(11), *ARK = SL(12);
    LAS float* EL = (LAS float*)(L + 8 * SLOT);
    LAS float* SEGT = (LAS float*)(L + 10 * SLOT);
    LAS float* PC = (LAS float*)(L + 16 * SLOT);
    const int lane = F.lane, w = F.wave, jl = lane & 15, g = lane >> 4;
    const int tok = F.tid >> 3, cg = F.tid & 7;
    const bf16_t* CA = (const bf16_t*)(F.ws + MX_CA); bf16_t* VF = (bf16_t*)(F.ws + WS_VFIRST) + (size_t)half * TH * 512;
    const bf16_t* XAG = RW + 0 * AS_; const bf16_t* VMG = RW + 2 * AS_;
    const bf16_t* W2T = (const bf16_t*)(F.ws + W_RW2); const bf16_t* A2T = (const bf16_t*)(F.ws + W_RA2); const bf16_t* G2T = (const bf16_t*)(F.ws + W_RG2); const bf16_t* V2T = (const bf16_t*)(F.ws + W_RV2);
    const float* mu = FIN(F, I_MU) + l * RW_COLS;
    lbf* XAs = (lbf*)L; lbf* VMs = SL(4);
    const int h = F.bid & 7, nt = w & 3, n0 = 64 * h + 16 * nt, n = n0 + 4 * g;
    LAS float* PRM = (LAS float*)(L + 16 * SLOT + 256);
    lds_barrier();
    { const int a_ = F.tid >> 6, c_ = F.tid & 63, col = 64 * h + c_; float v_ = 0.f;
      if (a_ < 3) v_ = mu[512 * a_ + col]; else if (a_ == 3) v_ = FIN(F, I_W0)[l * 512 + col]; else if (a_ == 4) v_ = FIN(F, I_A0)[l * 512 + col]; else if (a_ == 5) v_ = FIN(F, I_KK)[l * 512 + col];
      else if (a_ == 6) v_ = FIN(F, I_KA)[l * 512 + col]; else if (l) v_ = FIN(F, I_V0)[(l - 1) * 512 + col];
      PRM[F.tid] = v_; }
    u32x4 cxa[4]; u32x2 cvm = (u32x2){0u, 0u}; u32x2 crc[2], ckc[2], cvc[2], crp[2], ckp[2], cvp[2], cvf[2]; bf16x8 xw[2], xa[2], xg[4], xm = {0, 0, 0, 0, 0, 0, 0, 0};
#define A0_LOAD(u_) do { const int uu_ = (u_) < (TH / 64) * 8 ? (u_) : F.bid; const int tz_ = (uu_ >> 3) * 64; \
        _Pragma("unroll") for (int i = 0; i < 4; ++i) { const int id = F.tid + NTHR * i; cxa[i] = *(const u32x4*)(XAG + (size_t)(tz_ + (id >> 5)) * 256 + 8 * (id & 31)); } \
        if (l) cvm = *(const u32x2*)(VMG + (size_t)(tz_ + (F.tid >> 3)) * 32 + 4 * (F.tid & 7)); \
        _Pragma("unroll") for (int tgi = 0; tgi < 2; ++tgi) { const int t_ = tz_ + 16 * (2 * (w >> 2) + tgi) + jl; const bf16_t* cr_ = CA + (size_t)t_ * RW_COLS + n; const bool hp_ = (t_ & (SEQ - 1)) != 0; \
            crc[tgi] = *(const u32x2*)cr_; ckc[tgi] = *(const u32x2*)(cr_ + 512); cvc[tgi] = *(const u32x2*)(cr_ + 1024); crp[tgi] = (u32x2){0u, 0u}; ckp[tgi] = crp[tgi]; cvp[tgi] = crp[tgi]; cvf[tgi] = crp[tgi]; \
            if (hp_) { crp[tgi] = *(const u32x2*)(cr_ - RW_COLS); ckp[tgi] = *(const u32x2*)(cr_ - RW_COLS + 512); cvp[tgi] = *(const u32x2*)(cr_ - RW_COLS + 1024); } \
            if (l) cvf[tgi] = *(const u32x2*)(VF + rwo(t_, n)); } \
        { const bf16_t* pw = W2T + (size_t)(n0 + jl) * 64 + 8 * g; const bf16_t* pa = A2T + (size_t)(n0 + jl) * 64 + 8 * g; const bf16_t* pg = G2T + (size_t)(n0 + jl) * 128 + 8 * g; \
          _Pragma("unroll") for (int s2 = 0; s2 < 2; ++s2) { xw[s2] = *(const bf16x8*)(pw + 32 * s2); xa[s2] = *(const bf16x8*)(pa + 32 * s2); } \
          _Pragma("unroll") for (int s2 = 0; s2 < 4; ++s2) xg[s2] = *(const bf16x8*)(pg + 32 * s2); \
          if (l) xm = *(const bf16x8*)(V2T + (size_t)(n0 + jl) * 32 + 8 * g); } } while (0)
    A0_LOAD(F.bid);
    for (int u = F.bid; u < (TH / 64) * 8; u += F.G) {
        const int ch = u >> 3, t0 = ch * 64;
        lds_barrier();
#pragma unroll
        for (int i = 0; i < 4; ++i) { const int id = F.tid + NTHR * i; *(LAS u32x4*)(XAs + (id >> 5) * XA_LD + 8 * (id & 31)) = cxa[i]; }
        if (l) *(LAS u32x2*)(VMs + (F.tid >> 3) * VM_LD + 4 * (F.tid & 7)) = cvm;
        lds_barrier();
        {
            const LAS f32x4* pp_ = (const LAS f32x4*)(PRM + 16 * nt + 4 * g);
            const f32x4 mr = pp_[0], mk = pp_[16], mv = pp_[32], w0 = pp_[48], a0 = pp_[64], kkw = pp_[80], ka = pp_[96], v0 = pp_[112];
#pragma unroll
            for (int tgi = 0; tgi < 2; ++tgi) {
                const int tl = 16 * (2 * (w >> 2) + tgi) + jl, t = t0 + tl;
                const f32x4 rc = unpack4(crc[tgi]), kc = unpack4(ckc[tgi]), vc = unpack4(cvc[tgi]), rp = unpack4(crp[tgi]), kp = unpack4(ckp[tgi]), vp = unpack4(cvp[tgi]), vf = unpack4(cvf[tgi]);
                const size_t o = rwo(t, n);
                const lbf* ya = XAs + tl * XA_LD + 8 * g;
                bf16x8 yf[9];
#pragma unroll
                for (int s2 = 0; s2 < 8; ++s2) yf[s2] = *(const LAS bf16x8*)(ya + 32 * s2);
                yf[8] = *(const LAS bf16x8*)(VMs + tl * VM_LD + 8 * g);
                f32x4 aw = (f32x4){0.f, 0.f, 0.f, 0.f}, aa = aw, ag = aw, am = aw;
#pragma unroll
                for (int s2 = 0; s2 < 2; ++s2) { aw = MFMA16(xw[s2], yf[s2], aw); aa = MFMA16(xa[s2], yf[2 + s2], aa); }
#pragma unroll
                for (int s2 = 0; s2 < 4; ++s2) ag = MFMA16(xg[s2], yf[4 + s2], ag);
                if (l) am = MFMA16(xm, yf[8], am);
                const f32x4 r4 = rc + (rp - rc) * mr, k4 = kc + (kp - kc) * mk; f32x4 v4 = vc + (vp - vc) * mv;
                if (l) {
#pragma unroll
                    for (int q = 0; q < 4; ++q) v4[q] = v4[q] + (vf[q] - v4[q]) * sigmoidf_(v0[q] + am[q]); }
                else *(u32x2*)(VF + o) = pack4(v4);
                f32x4 e4, as4, k24, kk4;
#pragma unroll
                for (int q = 0; q < 4; ++q) { const float a = sigmoidf_(a0[q] + aa[q]); as4[q] = a; k24[q] = k4[q] * (1.0f + (a - 1.0f) * ka[q]);
                    e4[q] = 0.6065306597f * sigmoidf_(w0[q] + aw[q]);
                    kk4[q] = k4[q] * kkw[q]; }
                const int lo_ = tl * LDP + 16 * nt + 4 * g;
                *(LAS u32x2*)(SL(10) + lo_) = pack4(r4); *(LAS u32x2*)(SL(11) + lo_) = pack4(e4); *(LAS u32x2*)(SL(12) + lo_) = pack4(k24); *(LAS u32x2*)(SL(13) + lo_) = pack4(v4);
                *(LAS u32x2*)(SL(14) + lo_) = pack4(kk4); *(LAS u32x2*)(SL(15) + lo_) = pack4(as4);
                *(u32x2*)(RW + 3 * AS_ + o) = pack4(v4); *(u32x2*)(RW + 6 * AS_ + o) = pack4(ag);
                __builtin_amdgcn_sched_barrier(0);
            }
        }
        lds_barrier();
        const int lt_ = tok * LDP + 8 * cg;
        const u32x4 ur = *(const LAS u32x4*)(SL(10) + lt_), ue = *(const LAS u32x4*)(SL(11) + lt_), uk = *(const LAS u32x4*)(SL(12) + lt_), uv = *(const LAS u32x4*)(SL(13) + lt_),
                    ukk = *(const LAS u32x4*)(SL(14) + lt_), uas = *(const LAS u32x4*)(SL(15) + lt_);
        const float e8[8] = { bf_lo(ue.x), bf_hi(ue.x), bf_lo(ue.y), bf_hi(ue.y), bf_lo(ue.z), bf_hi(ue.z), bf_lo(ue.w), bf_hi(ue.w) };
#pragma unroll
        for (int i = 0; i < 8; ++i) EL[tok * 65 + 8 * cg + i] = e8[i];
        lds_barrier();
        { const int col = F.tid & 63, seg = F.tid >> 6; float p[8]; float run = 0.f;
#pragma unroll
          for (int i = 0; i < 8; ++i) { run += EL[(8 * seg + i) * 65 + col]; p[i] = run; }
          SEGT[seg * 64 + col] = run;
          lds_barrier();
          float off = 0.f; for (int s = 0; s < seg; ++s) off += SEGT[s * 64 + col];
#pragma unroll
          for (int i = 0; i < 8; ++i) EL[(8 * seg + i) * 65 + col] = -(off + p[i]); }
        lds_barrier();
        {
            const float r8[8] = { bf_lo(ur.x), bf_hi(ur.x), bf_lo(ur.y), bf_hi(ur.y), bf_lo(ur.z), bf_hi(ur.z), bf_lo(ur.w), bf_hi(ur.w) };
            const float k8[8] = { bf_lo(uk.x), bf_hi(uk.x), bf_lo(uk.y), bf_hi(uk.y), bf_lo(uk.z), bf_hi(uk.z), bf_lo(uk.w), bf_hi(uk.w) };
            float kk8[8] = { bf_lo(ukk.x), bf_hi(ukk.x), bf_lo(ukk.y), bf_hi(ukk.y), bf_lo(ukk.z), bf_hi(ukk.z), bf_lo(ukk.w), bf_hi(ukk.w) };
            { float ss = 0.f;
#pragma unroll
              for (int i = 0; i < 8; ++i) ss += kk8[i] * kk8[i];
              ss += __shfl_xor(ss, 1); ss += __shfl_xor(ss, 2); ss += __shfl_xor(ss, 4);
              const float inv = 1.0f / fmaxf(sqrtf(ss), 1e-12f);
#pragma unroll
              for (int i = 0; i < 8; ++i) kk8[i] *= inv; }
            const float as8[8] = { bf_lo(uas.x), bf_hi(uas.x), bf_lo(uas.y), bf_hi(uas.y), bf_lo(uas.z), bf_hi(uas.z), bf_lo(uas.w), bf_hi(uas.w) };
            const unsigned short v8[8] = { (unsigned short)(uv.x & 0xffffu), (unsigned short)(uv.x >> 16), (unsigned short)(uv.y & 0xffffu), (unsigned short)(uv.y >> 16),
                                           (unsigned short)(uv.z & 0xffffu), (unsigned short)(uv.z >> 16), (unsigned short)(uv.w & 0xffffu), (unsigned short)(uv.w >> 16) };
            { const float* rkp = rkw + h * 64 + 8 * cg; float b = 0.f;
#pragma unroll
              for (int i = 0; i < 8; ++i) b += r8[i] * k8[i] * rkp[i];
              b += __shfl_xor(b, 1); b += __shfl_xor(b, 2); b += __shfl_xor(b, 4);
              if (cg == 0) BSW[(size_t)(t0 + tok) * 8 + h] = b; }
            float at[8], bt[8], kt[8], rt[8], bp[8], kp[8];
#pragma unroll
            for (int i = 0; i < 8; ++i) { const float cl = EL[tok * 65 + 8 * cg + i], pc = __expf(EL[63 * 65 + 8 * cg + i]);
                const float ecl = __expf(cl), eicl = __expf(-cl);
                at[i] = -kk8[i] * __expf(cl + e8[i]); bt[i] = kk8[i] * as8[i] * eicl; kt[i] = k8[i] * eicl; rt[i] = r8[i] * ecl; bp[i] = bt[i] * pc; kp[i] = kt[i] * pc;
                if (tok == 0) PC[8 * cg + i] = pc; }
            u32x4 o;
            o.x = pk2(at[0], at[1]); o.y = pk2(at[2], at[3]); o.z = pk2(at[4], at[5]); o.w = pk2(at[6], at[7]); *(LAS u32x4*)(AT + tok * LDP + 8 * cg) = o;
            o.x = pk2(bt[0], bt[1]); o.y = pk2(bt[2], bt[3]); o.z = pk2(bt[4], bt[5]); o.w = pk2(bt[6], bt[7]); *(LAS u32x4*)(BT + tok * LDP + 8 * cg) = o;
            o.x = pk2(kt[0], kt[1]); o.y = pk2(kt[2], kt[3]); o.z = pk2(kt[4], kt[5]); o.w = pk2(kt[6], kt[7]); *(LAS u32x4*)(KT + tok * LDP + 8 * cg) = o;
            o.x = pk2(rt[0], rt[1]); o.y = pk2(rt[2], rt[3]); o.z = pk2(rt[4], rt[5]); o.w = pk2(rt[6], rt[7]); *(LAS u32x4*)(RT + tok * LDP + 8 * cg) = o;
#pragma unroll
            for (int i = 0; i < 8; ++i) { const int c = 8 * cg + i; ATt[c * LDP + tok] = f2bf(at[i]); Vt[c * LDP + tok] = v8[i]; BPt[c * LDP + tok] = f2bf(bp[i]); KPt[c * LDP + tok] = f2bf(kp[i]); }
        }
        lds_barrier();
        {
            const FrX xb = ldx64(BT, w, jl, g), xk = ldx64(KT, w, jl, g); const FrY ya = ldy64(AT, w, jl, g), yr_ = ldy64(RT, w, jl, g);
            f32x4 a1[2], a2[2], a3[2], a4[2]; ZACC(a1); ZACC(a2); ZACC(a3); ZACC(a4);
            mma64(xb, ya, a1); mma64(xk, ya, a2); mma64(xb, yr_, a3); mma64(xk, yr_, a4);
            const int s0 = 16 * (w & 3) + 4 * g;
            f32x4 b[2];
#pragma unroll
            for (int i = 0; i < 2; ++i) { const int t = 16 * (2 * (w >> 2) + i) + jl;
#pragma unroll
                for (int r = 0; r < 4; ++r) { const bool lt = s0 + r < t, le = s0 + r <= t; if (!lt) { a1[i][r] = 0.f; a2[i][r] = 0.f; } if (!le) { a3[i][r] = 0.f; a4[i][r] = 0.f; } b[i][r] = (s0 + r == t) ? 1.0f : a1[i][r]; } }
            st_t(SL(8), a1, w, jl, g); st_n(SL(9), a1, w, jl, g);
            st_t(SL(13), b, w, jl, g); st_n(SL(14), b, w, jl, g);
            st_t(AAK, a2, w, jl, g); st_t(ARB, a3, w, jl, g); st_t(ARK, a4, w, jl, g);
        }
        lds_barrier();
#define NEU_B(srcB, srcBt, dstB, dstBt) do { f32x4 a[2]; ZACC(a); mm64(SL(srcB), SL(srcBt), w, jl, g, a); st_t(SL(dstBt), a, w, jl, g); st_n(SL(dstB), a, w, jl, g); } while (0)
#define NEU_TB(srcT, srcTt, srcB, srcBt, dstT, dstTt, dstB, dstBt) do { f32x4 at[2], ab[2]; ZACC(ab); \
            const FrX xt_ = ldx64(SL(srcT), w, jl, g), xb_ = ldx64(SL(srcB), w, jl, g); const FrY yb_ = ldy64(SL(srcBt), w, jl, g); \
            _Pragma("unroll") for (int i = 0; i < 2; ++i) at[i] = unpack4(*(const LAS u32x2*)(SL(srcTt) + (16 * (2 * (w >> 2) + i) + jl) * LDP + 16 * (w & 3) + 4 * g)); \
            mma64(xt_, yb_, at); mma64(xb_, yb_, ab); \
            st_t(SL(dstTt), at, w, jl, g); st_n(SL(dstT), at, w, jl, g); st_t(SL(dstBt), ab, w, jl, g); st_n(SL(dstB), ab, w, jl, g); } while (0)
#define NEU_T(srcT, srcTt, srcBt, dstT, dstTt, last) do { f32x4 a[2]; \
            _Pragma("unroll") for (int i = 0; i < 2; ++i) a[i] = unpack4(*(const LAS u32x2*)(SL(srcTt) + (16 * (2 * (w >> 2) + i) + jl) * LDP + 16 * (w & 3) + 4 * g)); \
            mm64(SL(srcT), SL(srcBt), w, jl, g, a); if (!(last)) st_t(SL(dstTt), a, w, jl, g); st_n(SL(dstT), a, w, jl, g); } while (0)
        NEU_B(8, 9, 0, 1);                                   lds_barrier();
        NEU_TB(13, 14, 0, 1, 15, 2, 8, 9);                   lds_barrier();
        NEU_TB(15, 2, 8, 9, 13, 14, 0, 1);                   lds_barrier();
        NEU_TB(13, 14, 0, 1, 15, 2, 8, 9);                   lds_barrier();
        NEU_TB(15, 2, 8, 9, 13, 14, 0, 1);                   lds_barrier();
        NEU_T(13, 14, 1, 15, 2, true);                       lds_barrier();
        lbf* TI = SL(15); lbf* Wt = SL(8); lbf* Xt = SL(9); lbf* Ut = SL(0);
        {
            const FrX x1 = ldx64(TI, w, jl, g), x2 = ldx64(AAK, w, jl, g); const FrY y1 = ldy64(ATt, w, jl, g), y2 = ldy64(Vt, w, jl, g);
            f32x4 a[2], b[2]; ZACC(a); ZACC(b); mma64(x1, y1, a); mma64(x2, y2, b); st_t(Wt, a, w, jl, g); st_t(Xt, b, w, jl, g); }
        lds_barrier();
        {
            const FrX xti = ldx64(TI, w, jl, g), xw = ldx64(Wt, w, jl, g); const FrY yx = ldy64(Xt, w, jl, g), yar = ldy64(ARB, w, jl, g), ybp = ldy64(BPt, w, jl, g);
            f32x4 rr[2]; float pcv[2];
#pragma unroll
            for (int i = 0; i < 2; ++i) { const int t = 16 * (2 * (w >> 2) + i) + jl; rr[i] = unpack4(*(const LAS u32x2*)(RT + t * LDP + 16 * (w & 3) + 4 * g)); pcv[i] = PC[t]; }
            f32x4 au[2], ar[2], am[2]; ZACC(au); ZACC(ar); ZACC(am);
            mma64(xti, yx, au); mma64(xw, yar, ar); mma64(xw, ybp, am);
            st_t(Ut, au, w, jl, g);
#pragma unroll
            for (int i = 0; i < 2; ++i) { const int t = 16 * (2 * (w >> 2) + i) + jl, k0 = 16 * (w & 3) + 4 * g;
                *(u32x2*)(RW + 5 * AS_ + rwo(t0 + t, h * 64 + k0)) = pack4(ar[i] + rr[i]);
#pragma unroll
                for (int r = 0; r < 4; ++r) if (k0 + r == t) am[i][r] += pcv[i];
                *(u32x2*)(RW + 4 * AS_ + rwo(t0 + t, h * 64 + k0)) = pack4(am[i]); }
        }
        lds_barrier();
        {
            A0_LOAD(u + F.G); asm volatile("" ::: "memory");
            f32x4 ay[2], an[2]; ZACC(ay); ZACC(an);
            { const FrX xu = ldx64(Ut, w, jl, g), xbp = ldx64(BPt, w, jl, g); const FrY yar = ldy64(ARB, w, jl, g), yu = ldy64(Ut, w, jl, g); mma64(xu, yar, ay); mma64(xbp, yu, an); }
            { const FrX xv = ldx64(Vt, w, jl, g), xkp = ldx64(KPt, w, jl, g); const FrY yak = ldy64(ARK, w, jl, g), yv = ldy64(Vt, w, jl, g); mma64(xv, yak, ay); mma64(xkp, yv, an); }
#pragma unroll
            for (int i = 0; i < 2; ++i) { const int t = 16 * (2 * (w >> 2) + i) + jl, c0 = 16 * (w & 3) + 4 * g;
                *(u32x2*)(YH + rwo(t0 + t, h * 64 + c0)) = pack4(ay[i]);
                *(u32x2*)(RW + 1 * AS_ + rwo(t0 + t, h * 64 + c0)) = pack4(an[i]); }
        }
    }
#undef A0_LOAD
#undef SL
#undef NEU_B
#undef NEU_T
#undef NEU_TB
}

__device__ __forceinline__ void ph_rwkv_s2(Frame& F, int l, int pair) {
    const int bl = pair >> 3, h = pair & 7;
    const bf16_t* RW = (const bf16_t*)(F.ws + MX_RW); constexpr size_t AS_ = (size_t)TH * 512;
    const bf16_t* YH = (const bf16_t*)(F.ws + MX_CA); bf16_t* YA = (bf16_t*)(F.ws + MX_CA) + AS_;
    lbf* HT = (lbf*)F.lds;
    const int lane = F.lane, w = F.wave, jl = lane & 15, g = lane >> 4;
    lds_barrier();
    for (int i = F.tid; i < 64 * LDP / 2; i += NTHR) ((LAS unsigned*)HT)[i] = 0u;
    if (F.tid < 128) ((LAS float*)(F.lds + SLOT))[F.tid] = (F.tid < 64 ? FIN(F, I_LNG) : FIN(F, I_LNB))[l * 512 + h * 64 + (F.tid & 63)];
    lds_barrier();
    if (w < 4) {
        bf16x8 m0[4], m1[4]; u32x2 nn[4][4];
#define S2A_LOAD(j, c) do { const int cc_ = (c) < SEQ / 64 ? (c) : SEQ / 64 - 1; const int tb_ = bl * SEQ + cc_ * 64; \
        m0[j] = *(const bf16x8*)(RW + 4 * AS_ + rwo(tb_ + 16 * w + jl, h * 64 + 8 * g)); m1[j] = *(const bf16x8*)(RW + 4 * AS_ + rwo(tb_ + 16 * w + jl, h * 64 + 32 + 8 * g)); \
        _Pragma("unroll") for (int yt = 0; yt < 4; ++yt) nn[j][yt] = *(const u32x2*)(RW + 1 * AS_ + rwo(tb_ + 16 * yt + jl, h * 64 + 16 * w + 4 * g)); } while (0)
        S2A_LOAD(0, 0); S2A_LOAD(1, 1); S2A_LOAD(2, 2);
#pragma unroll 1
        for (int c4 = 0; c4 < SEQ / 64; c4 += 4) {
#pragma unroll
            for (int j = 0; j < 4; ++j) {
                asm volatile("" : "+v"(m0[j]), "+v"(m1[j]));
#pragma unroll
                for (int yt = 0; yt < 4; ++yt) asm volatile("" : "+v"(nn[j][yt]));
                S2A_LOAD((j + 3) & 3, c4 + j + 3);
                asm volatile("" ::: "memory");
                f32x4 a[4]; bf16x8 hf[4][2];
#pragma unroll
                for (int yt = 0; yt < 4; ++yt) { const lbf* yr = HT + (16 * yt + jl) * LDP + 8 * g; hf[yt][0] = *(const LAS bf16x8*)yr; hf[yt][1] = *(const LAS bf16x8*)(yr + 32); a[yt] = unpack4(nn[j][yt]); }
#pragma unroll
                for (int yt = 0; yt < 4; ++yt) a[yt] = MFMA16(m0[j], hf[yt][0], a[yt]);
#pragma unroll
                for (int yt = 0; yt < 4; ++yt) a[yt] = MFMA16(m1[j], hf[yt][1], a[yt]);
                lds_barrier();
#pragma unroll
                for (int yt = 0; yt < 4; ++yt) *(LAS u32x2*)(HT + (16 * yt + jl) * LDP + 16 * w + 4 * g) = pack4(a[yt]);
                lds_barrier();
            }
        }
#undef S2A_LOAD
    } else {
        const int wt = w - 4;
        const LAS float* lgl = (const LAS float*)(F.lds + SLOT) + 4 * g; const LAS float* lbl = lgl + 64;
        lbf* ystg = (lbf*)(F.lds + 2 * SLOT) + wt * 16 * LDP;
        const float* bsp = (const float*)(F.ws + MX_BS) + (size_t)(bl * SEQ + 16 * wt + jl) * 8 + h;
        bf16x8 r0[4], r1[4]; u32x2 yh[4][4], uv[4][4], ug[4][4]; float bsv[4];
#define S2B_LOAD(j, c) do { const int cc_ = (c) < SEQ / 64 ? (c) : SEQ / 64 - 1; const int tk_ = bl * SEQ + cc_ * 64 + 16 * wt + jl; \
        r0[j] = *(const bf16x8*)(RW + 5 * AS_ + rwo(tk_, h * 64 + 8 * g)); r1[j] = *(const bf16x8*)(RW + 5 * AS_ + rwo(tk_, h * 64 + 32 + 8 * g)); \
        bsv[j] = bsp[(size_t)(cc_ * 64) * 8]; \
        _Pragma("unroll") for (int xt = 0; xt < 4; ++xt) { yh[j][xt] = *(const u32x2*)(YH + rwo(tk_, h * 64 + 16 * xt + 4 * g)); uv[j][xt] = *(const u32x2*)(RW + 3 * AS_ + rwo(tk_, h * 64 + 16 * xt + 4 * g)); ug[j][xt] = *(const u32x2*)(RW + 6 * AS_ + rwo(tk_, h * 64 + 16 * xt + 4 * g)); } } while (0)
        S2B_LOAD(0, 0); S2B_LOAD(1, 1); S2B_LOAD(2, 2);
#pragma unroll 1
        for (int c4 = 0; c4 < SEQ / 64; c4 += 4) {
#pragma unroll
            for (int j = 0; j < 4; ++j) {
                asm volatile("" : "+v"(r0[j]), "+v"(r1[j]), "+v"(bsv[j]));
#pragma unroll
                for (int xt = 0; xt < 4; ++xt) asm volatile("" : "+v"(yh[j][xt]), "+v"(uv[j][xt]), "+v"(ug[j][xt]));
                S2B_LOAD((j + 3) & 3, c4 + j + 3);
                asm volatile("" ::: "memory");
                f32x4 a[4]; bf16x8 hf[4][2];
#pragma unroll
                for (int xt = 0; xt < 4; ++xt) { const lbf* xr = HT + (16 * xt + jl) * LDP + 8 * g; hf[xt][0] = *(const LAS bf16x8*)xr; hf[xt][1] = *(const LAS bf16x8*)(xr + 32); a[xt] = unpack4(yh[j][xt]); }
#pragma unroll
                for (int xt = 0; xt < 4; ++xt) a[xt] = MFMA16(hf[xt][0], r0[j], a[xt]);
#pragma unroll
                for (int xt = 0; xt < 4; ++xt) a[xt] = MFMA16(hf[xt][1], r1[j], a[xt]);
                lds_barrier();
                float s = 0.f; const float bs = bsv[j];
#pragma unroll
                for (int xt = 0; xt < 4; ++xt)
#pragma unroll
                    for (int r = 0; r < 4; ++r) s += a[xt][r];
                s += __shfl_xor(s, 16); s += __shfl_xor(s, 32);
                const float mean = s * (1.f / 64.f); float q = 0.f;
#pragma unroll
                for (int xt = 0; xt < 4; ++xt)
#pragma unroll
                    for (int r = 0; r < 4; ++r) { const float d = a[xt][r] - mean; q += d * d; }
                q += __shfl_xor(q, 16); q += __shfl_xor(q, 32);
                const float rstd = 1.0f / sqrtf(q * (1.f / 64.f) + 64e-5f);
#pragma unroll
                for (int xt = 0; xt < 4; ++xt) { const f32x4 vv = unpack4(uv[j][xt]), gg = unpack4(ug[j][xt]), lg4 = *(const LAS f32x4*)(lgl + 16 * xt), lb4 = *(const LAS f32x4*)(lbl + 16 * xt); f32x4 o;
#pragma unroll
                    for (int r = 0; r < 4; ++r) o[r] = ((a[xt][r] - mean) * rstd * lg4[r] + lb4[r] + bs * vv[r]) * gg[r];
                    *(LAS u32x2*)(ystg + jl * LDP + 16 * xt + 4 * g) = pack4(o); }
#pragma unroll
                for (int p = 0; p < 2; ++p) { const int rr_ = (lane >> 3) + 8 * p; const u32x4 vrow = *(const LAS u32x4*)(ystg + rr_ * LDP + 8 * (lane & 7));
                    *(u32x4*)(YA + (size_t)(bl * SEQ + (c4 + j) * 64 + 16 * wt + rr_) * 512 + h * 64 + 8 * (lane & 7)) = vrow; }
                lds_barrier();
            }
        }
#undef S2B_LOAD
    }
}

__device__ __forceinline__ void ph_dsa_prep(Frame& F, int l, int half) {
    bf16_t* CB = (bf16_t*)(F.ws + MX_CB); bf16_t* VT = (bf16_t*)(F.ws + MX_VT);
    const int* pos = (const int*)KARGP(F, I_POS) + (size_t)half * TH;
    const int lane = F.lane, j = lane & 7;
    float invf[4]; f32x4 gq[2], gk[2], gik[2];
#pragma unroll
    for (int i = 0; i < 4; ++i) invf[i] = __builtin_amdgcn_exp2f(-(float)(2 * (4 * j + i)) * (13.287712379549449f / 64.0f));
#pragma unroll
    for (int hf = 0; hf < 2; ++hf) { gq[hf] = *(const f32x4*)(FIN(F, I_QN) + l * 64 + 32 * hf + 4 * j); gk[hf] = *(const f32x4*)(FIN(F, I_KN) + l * 64 + 32 * hf + 4 * j); gik[hf] = *(const f32x4*)(FIN(F, I_IKN) + l * 64 + 32 * hf + 4 * j); }
    lbf* vst = (lbf*)F.lds;
    for (int tile = F.bid; tile < TH / 64; tile += F.G) {
        lds_barrier();
#pragma unroll 2
        for (int k8 = 0; k8 < 8; ++k8) {
        const int tk = 8 * F.wave + k8, t = tile * 64 + tk;
        const float p = (float)pos[t];
        f32x4 cs, sn;
#pragma unroll
        for (int i = 0; i < 4; ++i) { float rev = p * invf[i] * 0.15915494309189535f; rev = rev - floorf(rev); cs[i] = __builtin_amdgcn_cosf(rev); sn[i] = __builtin_amdgcn_sinf(rev); }
        bf16_t* row = CB + (size_t)t * DS_PAD;
#pragma unroll
        for (int ps = 0; ps < 3; ++ps) {
            const int vec = 8 * ps + (lane >> 3);
            if (vec < 19) {
                bf16_t* vp = row + vec * 64 + 4 * j;
                const u32x2 u1 = *(const u32x2*)vp, u2 = *(const u32x2*)(vp + 32);
                f32x4 x1 = unpack4(u1), x2 = unpack4(u2);
                if (vec == 9) {
                    vst[(4 * j + 0) * LDP + tk] = (bf16_t)(u1.x & 0xffffu); vst[(4 * j + 1) * LDP + tk] = (bf16_t)(u1.x >> 16); vst[(4 * j + 2) * LDP + tk] = (bf16_t)(u1.y & 0xffffu); vst[(4 * j + 3) * LDP + tk] = (bf16_t)(u1.y >> 16);
                    vst[(32 + 4 * j + 0) * LDP + tk] = (bf16_t)(u2.x & 0xffffu); vst[(32 + 4 * j + 1) * LDP + tk] = (bf16_t)(u2.x >> 16); vst[(32 + 4 * j + 2) * LDP + tk] = (bf16_t)(u2.y & 0xffffu); vst[(32 + 4 * j + 3) * LDP + tk] = (bf16_t)(u2.y >> 16);
                } else {
                    const bool nrm = (vec < 9) || (vec == 18);
                    float ss = (x1[0] * x1[0] + x1[1] * x1[1]) + (x1[2] * x1[2] + x1[3] * x1[3]) + (x2[0] * x2[0] + x2[1] * x2[1]) + (x2[2] * x2[2] + x2[3] * x2[3]);
                    ss += __shfl_xor(ss, 1); ss += __shfl_xor(ss, 2); ss += __shfl_xor(ss, 4);
                    if (nrm) { float rstd = 1.0f / sqrtf(ss * (1.f / 64.f) + 1e-6f); if (vec < 8) rstd *= 0.125f * 1.4426950409f;
                        const f32x4 g1 = vec < 8 ? gq[0] : (vec == 8 ? gk[0] : gik[0]), g2 = vec < 8 ? gq[1] : (vec == 8 ? gk[1] : gik[1]);
                        x1 = x1 * rstd * g1; x2 = x2 * rstd * g2; }
                    const f32x4 o1 = x1 * cs - x2 * sn, o2 = x2 * cs + x1 * sn;
                    *(u32x2*)vp = pack4(o1); *(u32x2*)(vp + 32) = pack4(o2);
                }
            }
        }
        }
        lds_barrier();
        { const int dim = F.tid >> 3, ch = F.tid & 7; const int t0 = tile * 64;
          *(u32x4*)(VT + ((size_t)(t0 >> 11) * 64 + dim) * SEQ + (t0 & (SEQ - 1)) + 8 * ch) = *(const LAS u32x4*)(vst + dim * LDP + 8 * ch); }
    }
}

constexpr int SC_LD = 2052;
__device__ __forceinline__ void lds_inc(LAS unsigned* p) { (void)__hip_atomic_fetch_add(p, 1u, __ATOMIC_RELAXED, __HIP_MEMORY_SCOPE_WORKGROUP); }
__device__ __forceinline__ unsigned okey(float s) { const unsigned u = __builtin_bit_cast(unsigned, s); return (u & 0x80000000u) ? ~u : (u | 0x80000000u); }
__device__ __forceinline__ int hist_find(LAS unsigned* hist, int lane, int& R, int& cnt) {
    const u32x4 c4 = *(const LAS u32x4*)(hist + 4 * lane);
    const unsigned tot = c4.x + c4.y + c4.z + c4.w;
    unsigned suf = tot;
#pragma unroll
    for (int o = 1; o < 64; o <<= 1) { const unsigned v = __shfl_down(suf, o); if (lane + o < 64) suf += v; }
    const unsigned above = suf - tot;
    const bool mine = (above < (unsigned)R) && ((unsigned)R <= suf);
    const unsigned long long bal = __ballot(mine);
    const int src = bal ? (int)__builtin_ctzll(bal) : 0;
    int bin, rr, cc;
    { unsigned a = above; int r_ = R;
      if ((unsigned)r_ <= a + c4.w) { bin = 4 * lane + 3; rr = r_ - (int)a; cc = (int)c4.w; } else { a += c4.w;
      if ((unsigned)r_ <= a + c4.z) { bin = 4 * lane + 2; rr = r_ - (int)a; cc = (int)c4.z; } else { a += c4.z;
      if ((unsigned)r_ <= a + c4.y) { bin = 4 * lane + 1; rr = r_ - (int)a; cc = (int)c4.y; } else { a += c4.y; bin = 4 * lane; rr = r_ - (int)a; cc = (int)c4.x; } } } }
    bin = __shfl(bin, src); rr = __shfl(rr, src); cc = __shfl(cc, src);
    R = rr; cnt = cc; return bin;
}
__device__ __forceinline__ void ph_dsa(Frame& F, int half, unsigned* qctr) {
    const bf16_t* CB = (const bf16_t*)(F.ws + MX_CB); const bf16_t* VT = (const bf16_t*)(F.ws + MX_VT);
    bf16_t* YB = (bf16_t*)(F.ws + MX_YB);
    LAS float* sc = (LAS float*)F.lds;
    LAS unsigned* hist = (LAS unsigned*)(F.lds + 16 * SC_LD * 4);
    LAS unsigned* msk = (LAS unsigned*)(F.lds + 16 * SC_LD * 4 + 16 * 256 * 4);
    lbf* KB = (lbf*)F.lds;
    lbf* VB = (lbf*)(F.lds + 2 * SLOT);
    const int lane = F.lane, w = F.wave, jl = lane & 15, g = lane >> 4;
    const int srow = F.tid >> 3, sseg = F.tid & 7;
    volatile LAS unsigned* qslot = (volatile LAS unsigned*)(F.lds + LDS_MISC + 64);
    for (;;) {
        if (F.tid == 0) *qslot = __hip_atomic_fetch_add(qctr, 1u, __ATOMIC_RELAXED, __HIP_MEMORY_SCOPE_AGENT);
        lds_barrier();
        const int ui = (int)*qslot; if (ui >= TH / 16) break;
        const int bl = ui & 15, q0 = (127 - (ui >> 4)) * 16, L = ((q0 >> 6) + 1) * 64;
        const int rowb = bl * SEQ;
        if (L > 256) for (int i = F.tid; i < 16 * 256; i += NTHR) hist[i] = 0u;
        lds_barrier();
        {
            bf16x8 yq[8][2]; float iw[8];
            const bf16_t* qrow = CB + (size_t)(rowb + q0 + jl) * DS_PAD;
#pragma unroll
            for (int h = 0; h < 8; ++h) { iw[h] = bf2f(qrow[1216 + h]);
#pragma unroll
                for (int s = 0; s < 2; ++s) yq[h][s] = *(const bf16x8*)(qrow + 640 + h * 64 + 32 * s + 8 * g); }
            const int nk = L / 16;
            const bf16_t* kbase = CB + (size_t)(rowb + jl) * DS_PAD + 1152 + 8 * g;
            bf16x8 x0 = {0, 0, 0, 0, 0, 0, 0, 0}, x1 = x0;
            if (w < nk) { const bf16_t* kr = kbase + (size_t)(w * 16) * DS_PAD; x0 = *(const bf16x8*)kr; x1 = *(const bf16x8*)(kr + 32); }
            for (int kt = w; kt < nk; kt += 8) {
                bf16x8 n0 = x0, n1 = x1;
                if (kt + 8 < nk) { const bf16_t* kr = kbase + (size_t)((kt + 8) * 16) * DS_PAD; n0 = *(const bf16x8*)kr; n1 = *(const bf16x8*)(kr + 32); }
                f32x4 s4 = (f32x4){0.f, 0.f, 0.f, 0.f};
#pragma unroll
                for (int h = 0; h < 8; ++h) { f32x4 a = (f32x4){0.f, 0.f, 0.f, 0.f}; a = MFMA16(x0, yq[h][0], a); a = MFMA16(x1, yq[h][1], a);
#pragma unroll
                    for (int r = 0; r < 4; ++r) s4[r] += iw[h] * fmaxf(a[r], 0.f); }
                *(LAS f32x4*)(sc + jl * SC_LD + kt * 16 + 4 * g) = s4;
                if (L > 256) {
#pragma unroll
                    for (int r = 0; r < 4; ++r) lds_inc(hist + jl * 256 + (okey(s4[r]) >> 24)); }
                x0 = n0; x1 = n1;
            }
        }
        lds_barrier();
        for (int qi = 0; qi < 2; ++qi) {
            const int qq = 2 * w + qi; LAS unsigned* hq = hist + qq * 256; const LAS float* sq = sc + qq * SC_LD; LAS unsigned* mq = msk + qq * 64;
            if (L <= 256) { mq[lane] = (lane < L / 32) ? 0xffffffffu : 0u; }
            else {
                int R = 256, E = 0; unsigned prefix = (unsigned)hist_find(hq, lane, R, E);
#pragma unroll 1
                for (int pass = 1; pass < 4; ++pass) {
                    const int sh = 24 - 8 * pass;
                    asm volatile("" ::: "memory");
                    *(LAS u32x4*)(hq + 4 * lane) = (u32x4){0u, 0u, 0u, 0u};
                    LDS_WAIT(); asm volatile("" ::: "memory");
                    for (int i = 4 * lane; i < L; i += 256) { const f32x4 s = *(const LAS f32x4*)(sq + i);
#pragma unroll
                        for (int r = 0; r < 4; ++r) { const unsigned k = okey(s[r]); if ((k >> (sh + 8)) == prefix) lds_inc(hq + ((k >> sh) & 255u)); } }
                    LDS_WAIT(); asm volatile("" ::: "memory");
                    const int b = hist_find(hq, lane, R, E); prefix = (prefix << 8) | (unsigned)b;
                }
                const unsigned thr = prefix;
                if (R >= E) {
                    for (int base = 0; base < SEQ; base += 256) {
                        unsigned nib = 0u;
                        if (base + 4 * lane < L) { const f32x4 s = *(const LAS f32x4*)(sq + base + 4 * lane);
#pragma unroll
                            for (int r = 0; r < 4; ++r) nib |= (okey(s[r]) >= thr ? 1u : 0u) << r; }
                        unsigned wv = nib << (4 * (lane & 7));
                        wv |= __shfl_xor(wv, 1); wv |= __shfl_xor(wv, 2); wv |= __shfl_xor(wv, 4);
                        if ((lane & 7) == 0) mq[(base >> 5) + (lane >> 3)] = wv;
                    }
                } else {
                    int taken = 0;
                    for (int base = 0; base < SEQ; base += 64) {
                        bool take = false; bool eq = false;
                        if (base < L) { const unsigned k = okey(sq[base + lane]); take = k > thr; eq = (k == thr); }
                        const unsigned long long em = __ballot(eq);
                        const int myr = taken + __popcll(em & ((1ull << lane) - 1ull));
                        take = take || (eq && myr < R);
                        taken += __popcll(em);
                        const unsigned long long tm = __ballot(take);
                        if (lane == 0) { mq[base / 32] = (unsigned)tm; mq[base / 32 + 1] = (unsigned)(tm >> 32); }
                    }
                }
            }
        }
        lds_barrier();
        {
            const int qloc = 2 * w + (jl >> 3), hd = jl & 7;
            const bf16_t* qrow = CB + (size_t)(rowb + q0 + qloc) * DS_PAD + hd * 64;
            const bf16x8 yq0 = *(const bf16x8*)(qrow + 8 * g), yq1 = *(const bf16x8*)(qrow + 32 + 8 * g);
            f32x4 O[4];
#pragma unroll
            for (int dt = 0; dt < 4; ++dt) O[dt] = (f32x4){0.f, 0.f, 0.f, 0.f};
            float mrun = -1e30f, lsum = 0.f;
            const LAS unsigned* mq = msk + qloc * 64;
            const bf16_t* kg = CB + (size_t)(rowb + srow) * DS_PAD + 512 + 8 * sseg;
            const bf16_t* vg = VT + ((size_t)bl * 64 + srow) * SEQ + 8 * sseg;
            const int ntile = L / 64;
            u32x4 kreg = *(const u32x4*)kg, vreg = *(const u32x4*)vg;
            *(LAS u32x4*)(KB + srow * LDP + 8 * sseg) = kreg; *(LAS u32x4*)(VB + srow * LDP + 8 * sseg) = vreg;
            lds_barrier();
            for (int it = 0; it < ntile; ++it) {
                { const int itn = (it + 1 < ntile) ? it + 1 : it; kreg = *(const u32x4*)(kg + (size_t)(itn * 64) * DS_PAD); vreg = *(const u32x4*)(vg + itn * 64); asm volatile("" ::: "memory"); }
                const lbf* Kt = KB + (it & 1) * 64 * LDP; const lbf* Vt = VB + (it & 1) * 64 * LDP;
                f32x4 s[4]; bf16x8 kf[4][2];
#pragma unroll
                for (int tl = 0; tl < 4; ++tl) { const lbf* xr = Kt + (16 * tl + jl) * LDP + 8 * g; kf[tl][0] = *(const LAS bf16x8*)xr; kf[tl][1] = *(const LAS bf16x8*)(xr + 32); }
                u32x2 vlo[4][2], vhi[4][2];
#pragma unroll
                for (int dt = 0; dt < 4; ++dt)
#pragma unroll
                    for (int ks = 0; ks < 2; ++ks) { const lbf* vr = Vt + (16 * dt + jl) * LDP + 32 * ks + 4 * g; vlo[dt][ks] = *(const LAS u32x2*)vr; vhi[dt][ks] = *(const LAS u32x2*)(vr + 16); }
#pragma unroll
                for (int tl = 0; tl < 4; ++tl) s[tl] = MFMA16(kf[tl][0], yq0, ((f32x4){0.f, 0.f, 0.f, 0.f}));
#pragma unroll
                for (int tl = 0; tl < 4; ++tl) s[tl] = MFMA16(kf[tl][1], yq1, s[tl]);
                const unsigned mw0 = mq[2 * it], mw1 = mq[2 * it + 1];
                float mx = -1e30f;
#pragma unroll
                for (int tl = 0; tl < 4; ++tl)
#pragma unroll
                    for (int r = 0; r < 4; ++r) mx = fmaxf(mx, s[tl][r]);
                mx = fmaxf(mx, __shfl_xor(mx, 16)); mx = fmaxf(mx, __shfl_xor(mx, 32));
                const float mnew = fmaxf(mrun, mx); const float alpha = __builtin_amdgcn_exp2f(mrun - mnew); mrun = mnew;
                float p[16]; float ps = 0.f;
#pragma unroll
                for (int i = 0; i < 16; ++i) { const int tl = i >> 2, r = i & 3; const unsigned mw = (tl < 2) ? mw0 : mw1;
                    const int sel = __builtin_amdgcn_sbfe((int)mw, 16 * (tl & 1) + 4 * g + r, 1);
                    p[i] = __builtin_bit_cast(float, __builtin_bit_cast(int, __builtin_amdgcn_exp2f(s[tl][r] - mnew)) & sel); ps += p[i]; }
                lsum = lsum * alpha + ps;
                bf16x8 pf[2];
#pragma unroll
                for (int ks = 0; ks < 2; ++ks) { u32x4 pw; pw.x = pk2(p[8 * ks], p[8 * ks + 1]); pw.y = pk2(p[8 * ks + 2], p[8 * ks + 3]); pw.z = pk2(p[8 * ks + 4], p[8 * ks + 5]); pw.w = pk2(p[8 * ks + 6], p[8 * ks + 7]);
                    pf[ks] = __builtin_bit_cast(bf16x8, pw); }
#pragma unroll
                for (int dt = 0; dt < 4; ++dt) O[dt] = O[dt] * alpha;
#pragma unroll
                for (int ks = 0; ks < 2; ++ks)
#pragma unroll
                    for (int dt = 0; dt < 4; ++dt) O[dt] = MFMA16(__builtin_bit_cast(bf16x8, (u32x4){vlo[dt][ks].x, vlo[dt][ks].y, vhi[dt][ks].x, vhi[dt][ks].y}), pf[ks], O[dt]);
                if (it + 1 < ntile) { *(LAS u32x4*)(KB + ((it + 1) & 1) * 64 * LDP + srow * LDP + 8 * sseg) = kreg; *(LAS u32x4*)(VB + ((it + 1) & 1) * 64 * LDP + srow * LDP + 8 * sseg) = vreg; }
                lds_barrier();
            }
            lsum += __shfl_xor(lsum, 16); lsum += __shfl_xor(lsum, 32);
            const float inv = 1.0f / lsum;
            lbf* ostg = (lbf*)(F.lds + 4 * SLOT) + w * 16 * LDP;
#pragma unroll
            for (int dt = 0; dt < 4; ++dt) { u32x2 o; o.x = pk2(O[dt][0] * inv, O[dt][1] * inv); o.y = pk2(O[dt][2] * inv, O[dt][3] * inv); *(LAS u32x2*)(ostg + jl * LDP + 16 * dt + 4 * g) = o; }
#pragma unroll
            for (int p = 0; p < 2; ++p) { const int rr_ = (lane >> 3) + 8 * p; const u32x4 vrow = *(const LAS u32x4*)(ostg + rr_ * LDP + 8 * (lane & 7));
                *(u32x4*)(YB + (size_t)(rowb + q0 + 2 * w + (rr_ >> 3)) * 512 + (rr_ & 7) * 64 + 8 * (lane & 7)) = vrow; }
        }
    }
}

constexpr int MK_LD = 136, MV_LD = 264;
__device__ __forceinline__ void ph_mem_attn(Frame& F, int l) {
    const bf16_t* QM = (const bf16_t*)(F.ws + MA_QM); bf16_t* OM = (bf16_t*)(F.ws + MA_OM);
    const bf16_t* MK = (const bf16_t*)(F.ws + WS_MEMK) + (size_t)l * MEMROWS * 512; const bf16_t* MVT = (const bf16_t*)(F.ws + WS_MEMVT) + (size_t)l * MEMROWS * 512;
    lbf* KS = (lbf*)F.lds; lbf* VS = (lbf*)(F.lds + 256 * MK_LD * 2);
    const int lane = F.lane, jl = lane & 15, g = lane >> 4;
    const float* gq = FIN(F, I_MQN) + l * 128;
    for (int it = F.bid; it < NB * 4 * 2; it += F.G) {
        const int pair = it >> 1, b = pair >> 2, hh = pair & 3, sp0 = (it & 1) * 8;
        const bf16_t* kb_ = MK + ((size_t)b * 4 + hh) * 256 * 128; const bf16_t* vb_ = MVT + ((size_t)b * 4 + hh) * 128 * 256;
        lds_barrier();
#pragma unroll
        for (int i = 0; i < 8; ++i) { const int id = F.tid + NTHR * i;
            *(LAS u32x4*)(KS + (id >> 4) * MK_LD + 8 * (id & 15)) = *(const u32x4*)(kb_ + (size_t)(id >> 4) * 128 + 8 * (id & 15));
            *(LAS u32x4*)(VS + (id >> 5) * MV_LD + 8 * (id & 31)) = *(const u32x4*)(vb_ + (size_t)(id >> 5) * 256 + 8 * (id & 31)); }
        lds_barrier();
#pragma unroll 1
        for (int sp = 0; sp < 8; ++sp) {
        const int t = b * SEQ + (sp0 + sp) * 128 + F.wave * 16 + jl;
        const bf16_t* qrow = QM + (size_t)t * 512 + hh * 128;
        float qv[4][8]; float ss = 0.f;
#pragma unroll
        for (int s2 = 0; s2 < 4; ++s2) { const u32x4 q = *(const u32x4*)(qrow + 32 * s2 + 8 * g);
            qv[s2][0] = bf_lo(q.x); qv[s2][1] = bf_hi(q.x); qv[s2][2] = bf_lo(q.y); qv[s2][3] = bf_hi(q.y); qv[s2][4] = bf_lo(q.z); qv[s2][5] = bf_hi(q.z); qv[s2][6] = bf_lo(q.w); qv[s2][7] = bf_hi(q.w);
#pragma unroll
            for (int i = 0; i < 8; ++i) ss += qv[s2][i] * qv[s2][i]; }
        ss += __shfl_xor(ss, 16); ss += __shfl_xor(ss, 32);
        const float sc = (1.0f / sqrtf(ss * (1.f / 128.f) + 1e-6f)) * (0.08838834764831845f * 1.4426950409f);
        bf16x8 yq[4];
#pragma unroll
        for (int s2 = 0; s2 < 4; ++s2) { const float* gp = gq + 32 * s2 + 8 * g; u32x4 pw;
            pw.x = pk2(qv[s2][0] * sc * gp[0], qv[s2][1] * sc * gp[1]); pw.y = pk2(qv[s2][2] * sc * gp[2], qv[s2][3] * sc * gp[3]);
            pw.z = pk2(qv[s2][4] * sc * gp[4], qv[s2][5] * sc * gp[5]); pw.w = pk2(qv[s2][6] * sc * gp[6], qv[s2][7] * sc * gp[7]); yq[s2] = __builtin_bit_cast(bf16x8, pw); }
        f32x4 O[8];
#pragma unroll
        for (int dt = 0; dt < 8; ++dt) O[dt] = (f32x4){0.f, 0.f, 0.f, 0.f};
        float mrun = -1e30f, ls = 0.f;
#pragma unroll 1
        for (int hk = 0; hk < 2; ++hk) {
            f32x4 S[8];
#pragma unroll
            for (int kt = 0; kt < 8; ++kt) { const lbf* kr = KS + (128 * hk + 16 * kt + jl) * MK_LD + 8 * g; f32x4 a = (f32x4){0.f, 0.f, 0.f, 0.f};
#pragma unroll
                for (int s2 = 0; s2 < 4; ++s2) a = MFMA16(*(const LAS bf16x8*)(kr + 32 * s2), yq[s2], a);
                S[kt] = a; }
            float mx = -1e30f;
#pragma unroll
            for (int kt = 0; kt < 8; ++kt)
#pragma unroll
                for (int r = 0; r < 4; ++r) mx = fmaxf(mx, S[kt][r]);
            mx = fmaxf(mx, __shfl_xor(mx, 16)); mx = fmaxf(mx, __shfl_xor(mx, 32));
            const float mnew = fmaxf(mrun, mx), alpha = __builtin_amdgcn_exp2f(mrun - mnew); mrun = mnew;
            float ps = 0.f; bf16x8 pf[4];
#pragma unroll
            for (int ks = 0; ks < 4; ++ks) { float p[8];
#pragma unroll
                for (int i = 0; i < 8; ++i) { p[i] = __builtin_amdgcn_exp2f(S[2 * ks + (i >> 2)][i & 3] - mnew); ps += p[i]; }
                u32x4 pw; pw.x = pk2(p[0], p[1]); pw.y = pk2(p[2], p[3]); pw.z = pk2(p[4], p[5]); pw.w = pk2(p[6], p[7]); pf[ks] = __builtin_bit_cast(bf16x8, pw); }
            ls = ls * alpha + ps;
#pragma unroll
            for (int dt = 0; dt < 8; ++dt) { f32x4 o = O[dt] * alpha; const lbf* vr = VS + (16 * dt + jl) * MV_LD + 128 * hk + 4 * g;
#pragma unroll
                for (int ks = 0; ks < 4; ++ks) { const u32x2 lo = *(const LAS u32x2*)(vr + 32 * ks), hi = *(const LAS u32x2*)(vr + 32 * ks + 16);
                    o = MFMA16(__builtin_bit_cast(bf16x8, (u32x4){lo.x, lo.y, hi.x, hi.y}), pf[ks], o); }
                O[dt] = o; }
        }
        ls += __shfl_xor(ls, 16); ls += __shfl_xor(ls, 32);
        const float inv = 1.0f / ls;
        lbf* ostg = (lbf*)(F.lds + 256 * MK_LD * 2 + 128 * MV_LD * 2) + F.wave * 16 * LDP;
        const int t0w = b * SEQ + (sp0 + sp) * 128 + F.wave * 16;
#pragma unroll
        for (int hf2 = 0; hf2 < 2; ++hf2) {
#pragma unroll
            for (int d4 = 0; d4 < 4; ++d4) { const int dt = 4 * hf2 + d4; u32x2 ov; ov.x = pk2(O[dt][0] * inv, O[dt][1] * inv); ov.y = pk2(O[dt][2] * inv, O[dt][3] * inv); *(LAS u32x2*)(ostg + jl * LDP + 16 * d4 + 4 * g) = ov; }
#pragma unroll
            for (int p = 0; p < 2; ++p) { const int rr_ = (lane >> 3) + 8 * p; const u32x4 vrow = *(const LAS u32x4*)(ostg + rr_ * LDP + 8 * (lane & 7));
                *(u32x4*)(OM + (size_t)(t0w + rr_) * 512 + hh * 128 + 64 * hf2 + 8 * (lane & 7)) = vrow; }
        }
        }
    }
}

__device__ __forceinline__ void ph_moe_route(Frame& F) {
    const unsigned short* sele = (const unsigned short*)(F.ws + MOE_SELE); const f32x2* selw = (const f32x2*)(F.ws + MOE_SELW);
    int* rowtok = (int*)(F.ws + MOE_ROWTOK); float* roww = (float*)(F.ws + MOE_ROWW); int* tile_e = (int*)(F.ws + MOE_TILEE); int* meta = (int*)(F.ws + MOE_META);
    LAS unsigned long long* pc = (LAS unsigned long long*)F.lds;
    LAS int* tot = (LAS int*)(F.lds + 8192);
    LAS int* pre = tot + 16; LAS int* segb = tot + 32; LAS int* wcnt = tot + 64;
    __syncthreads();
    { unsigned long long c0 = 0ull, c1 = 0ull; const u32x4* sp = (const u32x4*)(sele + (size_t)F.tid * 128);
      for (int i = 0; i < 16; ++i) { const u32x4 v = sp[i]; const unsigned ww[4] = {v.x, v.y, v.z, v.w};
#pragma unroll
        for (int q = 0; q < 4; ++q) { const unsigned a = ww[q] & 0xffffu, b = ww[q] >> 16;
            c0 += 1ull << (8 * (a & 7u)); c1 += 1ull << (8 * ((a >> 8) & 7u)); c0 += 1ull << (8 * (b & 7u)); c1 += 1ull << (8 * ((b >> 8) & 7u)); } }
      pc[F.tid * 2] = c0; pc[F.tid * 2 + 1] = c1; }
    __syncthreads();
    if (F.tid < 32) { const int seg = F.tid & 15, kind = F.tid >> 4; const int slot = seg >> 3, e = seg & 7; const int lim = kind ? 2 * F.bid : 512; int s = 0;
        for (int i = 0; i < lim; ++i) s += (int)((pc[i * 2 + slot] >> (8 * e)) & 0xffull);
        if (kind) pre[seg] = s; else tot[seg] = s; }
    __syncthreads();
    if (F.tid == 0) { int b = 0; for (int s = 0; s < 16; ++s) { segb[s] = b; b += (tot[s] + 255) & ~255; } segb[16] = b; }
    __syncthreads();
    const int t = F.bid * 256 + (F.tid & 255); const unsigned se = sele[t]; const f32x2 sw = selw[t];
    const int myseg[2] = { (int)(se & 7u), 8 + (int)((se >> 8) & 7u) };
    int rank[2] = {0, 0};
    if (F.tid < 256) {
#pragma unroll
        for (int s = 0; s < 16; ++s) { const int k = s >> 3; const unsigned long long m = __ballot(myseg[k] == s);
            if (myseg[k] == s) rank[k] = __popcll(m & ((1ull << F.lane) - 1ull));
            if (F.lane == 0) wcnt[F.wave * 16 + s] = __popcll(m); }
    }
    __syncthreads();
    if (F.tid < 256) {
#pragma unroll
        for (int k = 0; k < 2; ++k) { const int s = myseg[k]; int off = 0; for (int ww = 0; ww < F.wave; ++ww) off += wcnt[ww * 16 + s];
            const int row = segb[s] + pre[s] + off + rank[k]; rowtok[row] = t; roww[row] = k ? sw.y : sw.x; }
    }
    if (F.bid == 0) {
        for (int s = 0; s < 16; ++s) { const int lo = segb[s] + tot[s], hi = segb[s + 1]; for (int r = lo + F.tid; r < hi; r += NTHR) { rowtok[r] = -1; roww[r] = 0.f; } }
        for (int p = F.tid; p < segb[16] / 256; p += NTHR) { int e = 0; for (int s = 0; s < 16; ++s) if (p * 256 >= segb[s]) e = s & 7; tile_e[p] = e; }
        if (F.tid == 0) { meta[0] = segb[8] / 256; meta[1] = segb[16] / 256; }
    }
}

__global__ void __launch_bounds__(NTHR, 2) fwd(Args args) {
    extern __shared__ __attribute__((aligned(16))) unsigned char lds_raw[];
    Frame F;
    F.lds = (LAS unsigned char*)lds_raw; F.ws = args.ws; F.kb = __builtin_amdgcn_kernarg_segment_ptr(); F.out = args.out;
    F.tid = threadIdx.x; F.lane = F.tid & 63; F.wave = __builtin_amdgcn_readfirstlane(F.tid >> 6); F.G = gridDim.x; F.bid = blockIdx.x;
    volatile LAS unsigned* MISC = (volatile LAS unsigned*)(F.lds + LDS_MISC);
    if (F.tid < 64) MISC[F.tid] = 0u;
    __syncthreads();
    const int lo = args.ph_lo, hi = args.ph_hi;
    XcdBarrier bar; bar.bar = (unsigned*)(F.ws + WS_CTL) + 4096; bar.x = 0; bar.st = nullptr;
    if (hi - lo > 1) bar = xcd_barrier_post((unsigned*)(F.ws + WS_CTL) + 4096, MISC + 8);
    int ph = 0;
    const int wave_s_ = __builtin_amdgcn_readfirstlane((int)threadIdx.x >> 6);
#ifndef SITE_MASK
#define SITE_MASK 0xffffffffffffffffull
#endif
#ifndef PROBE_T_MASK
#define PROBE_T_MASK 0ull
#endif
#ifndef PROBE_T_FACTOR
#define PROBE_T_FACTOR 20ull
#endif
    unsigned long long tacc_ = 0ull, t0_ = 0ull;
#ifndef SITE_MASK
#define SITE_MASK 0xffffffffffffffffull
#endif
#define PHASE_BEGIN { constexpr int site_ = __COUNTER__; if (((SITE_MASK >> site_) & 1ull) && ph >= lo && ph < hi) { if (((PROBE_T_MASK >> site_) & 1ull) && F.bid == 0) t0_ = __builtin_amdgcn_s_memrealtime(); \
      { unsigned _m = ~0u; asm volatile("" : "+s"(_m)); int _t = wave_s_ * 64 + (int)__builtin_amdgcn_mbcnt_hi(_m, __builtin_amdgcn_mbcnt_lo(_m, 0u)); asm volatile("" : "+v"(_t)); F.tid = _t; F.lane = _t & 63; F.wave = wave_s_; { int _b = blockIdx.x, _g = gridDim.x; asm volatile("" : "+s"(_b), "+s"(_g)); F.bid = _b; F.G = _g; } \
      kptr_t _kb = __builtin_amdgcn_kernarg_segment_ptr(); asm volatile("" : "+s"(_kb)); F.kb = _kb; \
      __attribute__((address_space(1))) unsigned char* _w = (__attribute__((address_space(1))) unsigned char*)args.ws; asm volatile("" : "+s"(_w)); F.ws = (unsigned char*)_w; ws = F.ws; __attribute__((address_space(1))) float* _o = (__attribute__((address_space(1))) float*)args.out; asm volatile("" : "+s"(_o)); F.out = (float*)_o; }
#define PHASE_END   if (ph + 1 < hi) xcd_barrier(bar, F.tid); if (((PROBE_T_MASK >> site_) & 1ull) && F.bid == 0) tacc_ += __builtin_amdgcn_s_memrealtime() - t0_; } ++ph; }
    unsigned char* ws = F.ws;
#define HN ((const bf16_t*)(ws + WS_HN))

    PHASE_BEGIN ph_prologue0(F); PHASE_END
    PHASE_BEGIN { pg8::Gemm g{(const bf16_t*)(ws + WS_MEMH), (const bf16_t*)(ws + WS_WKV), D, 0, nullptr}; pg8::StaticOrder S; S.init(MEMROWS, 4096, F.G, F.bid);
        pg8::EpiPlain E{(bf16_t*)(ws + PR_KVRAW), 4096}; pg8::gemm_phase<pg8::EpiPlain, pg8::StaticOrder>(F.lds, g, S, E, F.tid); } PHASE_END
    PHASE_BEGIN ph_prologue2(F); PHASE_END

#pragma unroll 1
    for (int l = 0; l < DEPTH; ++l) {

        PHASE_BEGIN ph_layer0(F, l, l ? (const float*)F.out : FIN(F, I_X)); PHASE_END
#pragma unroll 1
        for (int half = 0; half < 2; ++half) {

            PHASE_BEGIN { pg8::Gemm g{HN + (size_t)half * TH * D, (const bf16_t*)(ws + W_IN), D, 0, nullptr}; pg8::StaticOrder S; S.init(TH, N_INP, F.G, F.bid);
                pg8::EpiWin E{(bf16_t*)(ws + MX_CA), (bf16_t*)(ws + MX_CB), (bf16_t*)(ws + MX_CG)}; pg8::gemm_phase<pg8::EpiWin, pg8::StaticOrder>(F.lds, g, S, E, F.tid); } PHASE_END
                        #ifndef PROBE_RPREP
#define PROBE_RPREP 1
#endif
#ifndef PROBE_S2
#define PROBE_S2 1
#endif
#ifndef PROBE_DSA
#define PROBE_DSA 1
#endif
            PHASE_BEGIN ph_rwkv_pre(F, l, half); ph_dsa_prep(F, l, half); PHASE_END
            PHASE_BEGIN ph_rwkv_s1(F, l, half); PHASE_END
            PHASE_BEGIN { for (int r_ = 0; r_ < PROBE_S2; ++r_) for (int p = F.bid; p < 128; p += F.G) ph_rwkv_s2(F, l, p); ph_dsa(F, half, (unsigned*)(ws + WS_CTL) + 8192 + 64 * (2 * l + half)); } PHASE_END
            PHASE_BEGIN { pg8::Gemm g{(const bf16_t*)(ws + MX_CA + RW_ARR), (const bf16_t*)(ws + W_BA), 512, 0, nullptr}; pg8::StaticOrder S; S.init(TH, D, F.G, F.bid);
                pg8::EpiMerge<false> E{(bf16_t*)(ws + WS_HN) + (size_t)half * TH * D, (const bf16_t*)(ws + MX_CG), 0}; pg8::gemm_phase<pg8::EpiMerge<false>, pg8::StaticOrder>(F.lds, g, S, E, F.tid); } PHASE_END
            PHASE_BEGIN { pg8::Gemm g{(const bf16_t*)(ws + MX_YB), (const bf16_t*)(ws + W_BB), 512, 0, nullptr}; pg8::StaticOrder S; S.init(TH, D, F.G, F.bid);
                pg8::EpiMerge<true> E{(bf16_t*)(ws + WS_HN) + (size_t)half * TH * D, (const bf16_t*)(ws + MX_CG), 1024}; pg8::gemm_phase<pg8::EpiMerge<true>, pg8::StaticOrder>(F.lds, g, S, E, F.tid); } PHASE_END
        }
        PHASE_BEGIN { pg8::Gemm g{HN, (const bf16_t*)(ws + W_OUT), D, 0, nullptr}; pg8::StaticOrder S; S.init(T, D, F.G, F.bid);
            pg8::EpiResid E{l ? (const float*)F.out : FIN(F, I_X), F.out}; pg8::gemm_phase<pg8::EpiResid, pg8::StaticOrder>(F.lds, g, S, E, F.tid); } PHASE_END
        PHASE_BEGIN ph_norm(F); PHASE_END
        PHASE_BEGIN { pg8::Gemm g{HN, (const bf16_t*)(ws + W_MQ), D, 0, nullptr}; pg8::StaticOrder S; S.init(T, 512, F.G, F.bid);
            pg8::EpiPlain E{(bf16_t*)(ws + MA_QM), 512}; pg8::gemm_phase<pg8::EpiPlain, pg8::StaticOrder>(F.lds, g, S, E, F.tid); } PHASE_END
        PHASE_BEGIN ph_mem_attn(F, l); PHASE_END
        PHASE_BEGIN { pg8::Gemm g{(const bf16_t*)(ws + MA_OM), (const bf16_t*)(ws + W_MO), 512, 0, nullptr}; pg8::StaticOrder S; S.init(T, D, F.G, F.bid);
            pg8::EpiResid E{F.out, F.out}; pg8::gemm_phase<pg8::EpiResid, pg8::StaticOrder>(F.lds, g, S, E, F.tid); } PHASE_END
        PHASE_BEGIN ph_norm_ffn(F, l); PHASE_END
        if ((l & 1) == 0) {
            PHASE_BEGIN { pg8::Gemm g{HN, (const bf16_t*)(ws + W_FGU), D, 0, nullptr}; pg8::StaticOrder S; S.init(T, 2 * FFN, F.G, F.bid);
                pg8::EpiSwiGLU E{(bf16_t*)(ws + FF_GU), FFN}; pg8::gemm_phase<pg8::EpiSwiGLU, pg8::StaticOrder>(F.lds, g, S, E, F.tid); } PHASE_END
            PHASE_BEGIN { pg8::Gemm g{(const bf16_t*)(ws + FF_GU), (const bf16_t*)(ws + W_FD), FFN, 0, nullptr}; pg8::StaticOrder S; S.init(T, D, F.G, F.bid);
                pg8::EpiResid E{F.out, F.out}; pg8::gemm_phase<pg8::EpiResid, pg8::StaticOrder, false, true>(F.lds, g, S, E, F.tid); } PHASE_END
            ph += 2;
        } else {
#define meta ((const int*)(ws + MOE_META))
#define tile_e ((const int*)(ws + MOE_TILEE))
            PHASE_BEGIN ph_moe_route(F); PHASE_END
            PHASE_BEGIN { const int nt1 = __builtin_amdgcn_readfirstlane(meta[1]);
                pg8::Gemm g{HN, (const bf16_t*)(ws + W_EGU), D, (size_t)2 * EDIM * D, (const int*)(ws + MOE_ROWTOK)}; pg8::MoeOrder S; S.init(nt1, 11, F.G, F.bid, 0, tile_e);
                pg8::EpiSwiGLU E{(bf16_t*)(ws + FF_GU), EDIM}; pg8::gemm_phase<pg8::EpiSwiGLU, pg8::MoeOrder, true>(F.lds, g, S, E, F.tid); } PHASE_END
            PHASE_BEGIN { const int nt0 = __builtin_amdgcn_readfirstlane(meta[0]);
                pg8::Gemm g{(const bf16_t*)(ws + FF_GU), (const bf16_t*)(ws + W_ED), EDIM, (size_t)D * EDIM, nullptr}; pg8::MoeOrder S; S.init(nt0, 4, F.G, F.bid, 0, tile_e);
                pg8::EpiMoeDown E{F.out, (const int*)(ws + MOE_ROWTOK), (const float*)(ws + MOE_ROWW)}; pg8::gemm_phase<pg8::EpiMoeDown, pg8::MoeOrder, false, true>(F.lds, g, S, E, F.tid); } PHASE_END
            PHASE_BEGIN { const int nt0 = __builtin_amdgcn_readfirstlane(meta[0]), nt1 = __builtin_amdgcn_readfirstlane(meta[1]);
                pg8::Gemm g{(const bf16_t*)(ws + FF_GU), (const bf16_t*)(ws + W_ED), EDIM, (size_t)D * EDIM, nullptr}; pg8::MoeOrder S; S.init(nt1 - nt0, 4, F.G, F.bid, nt0, tile_e);
                pg8::EpiMoeDown E{F.out, (const int*)(ws + MOE_ROWTOK), (const float*)(ws + MOE_ROWW)}; pg8::gemm_phase<pg8::EpiMoeDown, pg8::MoeOrder, false, true>(F.lds, g, S, E, F.tid); } PHASE_END
        }
    }
    if (PROBE_T_MASK != 0ull && F.bid == 0) { const unsigned long long te_ = __builtin_amdgcn_s_memrealtime() + PROBE_T_FACTOR * tacc_; while (__builtin_amdgcn_s_memrealtime() < te_) __builtin_amdgcn_s_sleep(32); }
}
constexpr int N_PHASES = 3 + DEPTH * (1 + 2 * 6 + 6 + 4);

extern "C" void kernel_launch(void* const* d_in, const int* in_sizes, int n_in, void* d_out, int out_size, void* d_ws, size_t ws_size, hipStream_t stream) {
    static int grid = 0;
    if (grid == 0) {
        if (n_in != 41 || out_size != T * D || ws_size < WS_END) { fprintf(stderr, "kernel_launch: unexpected shapes (n_in %d, out %d, ws %zu < %zu); nothing launched\n", n_in, out_size, ws_size, (size_t)WS_END); grid = -1; return; }
        int dev = 0, cus = 0, per_cu = 0;
        if (hipGetDevice(&dev) != hipSuccess || hipDeviceGetAttribute(&cus, hipDeviceAttributeMultiprocessorCount, dev) != hipSuccess) { grid = -1; return; }
        if (hipFuncSetAttribute((const void*)fwd, hipFuncAttributeMaxDynamicSharedMemorySize, LDS_BYTES) != hipSuccess) { fprintf(stderr, "kernel_launch: hipFuncSetAttribute failed\n"); grid = -1; return; }
        if (hipOccupancyMaxActiveBlocksPerMultiprocessor(&per_cu, (const void*)fwd, NTHR, LDS_BYTES) != hipSuccess || per_cu < 1) fprintf(stderr, "kernel_launch: occupancy query reports %d\n", per_cu);
        (void)hipGetLastError();
        grid = cus;
    }
    if (grid < 0) return;
    if (hipMemsetAsync((char*)d_ws + WS_CTL, 0, CTL_ZERO_BYTES, stream) != hipSuccess) return;
    Args a{};
    for (int i = 0; i < 41; ++i) a.in[i] = d_in[i];
    a.out = (float*)d_out; a.ws = (unsigned char*)d_ws;
#if MK_ONE_LAUNCH
    a.ph_lo = 0; a.ph_hi = N_PHASES;
    hipLaunchKernelGGL(fwd, dim3(grid), dim3(NTHR), LDS_BYTES, stream, a);
#else
    for (int p = 0; p < N_PHASES; ++p) { a.ph_lo = p; a.ph_hi = p + 1; hipLaunchKernelGGL(fwd, dim3(grid), dim3(NTHR), LDS_BYTES, stream, a); }
#endif
}
```

```cpp
#include <hip/hip_runtime.h>
#include <cstdio>
#include <cstdint>

#ifndef MK_ONE_LAUNCH
#define MK_ONE_LAUNCH 1
#endif

namespace pg8 {
#define PG8_LAS __attribute__((address_space(3)))
typedef unsigned short bf16_t;
typedef short bf16x8 __attribute__((ext_vector_type(8)));
typedef float f32x4 __attribute__((ext_vector_type(4)));
typedef float f32x2 __attribute__((ext_vector_type(2)));
typedef unsigned u32x4 __attribute__((ext_vector_type(4)));
typedef unsigned u32x2 __attribute__((ext_vector_type(2)));
typedef __bf16 bf16x2_t __attribute__((ext_vector_type(2)));
constexpr int BM = 256, BK = 64, HALF = 128, HTB = HALF * BK * 2, STAGE_BYTES = 8 * HTB, NXCD = 8, WGM = 8;

__host__ __device__ __forceinline__ int lds_byte(int r, int c) { const int st = (r >> 4) * 2 + (c >> 5), rr = r & 15, cc = c & 31, ob = rr * 64 + cc * 2; return st * 1024 + (ob ^ (((ob >> 9) & 1) << 5)); }
__host__ __device__ __forceinline__ void stage_rc(int b, int& R, int& C) { const int st = b / 1024, sb = b % 1024, swz = sb ^ (((sb >> 9) & 1) << 5); R = (st >> 1) * 16 + swz / 64; C = (st & 1) * 32 + (swz % 64) / 2; }
__host__ __device__ __forceinline__ int perm32(int rho) { const int n = rho >> 4, i = rho & 15; return 8 * (i >> 2) + 4 * n + (i & 3); }

struct Unit { int pm, pn, e; };
struct Gemm { const bf16_t* A; const bf16_t* Bt; int K; size_t bstride; const int* rowidx; };

struct StaticOrder {
    int nM, nN, nwg, G, c;
    __device__ void init(int M, int N, int G_, int c_) { nM = M / BM; nN = N / BM; nwg = nM * nN; G = G_; c = c_; }
    __device__ bool next(int i, Unit& u) const {
        const long L = (long)i * G + c; if (L >= nwg) return false;
        int wgid = (int)L; { const int q = nwg / NXCD, r = nwg % NXCD, xcd = wgid % NXCD, off = wgid / NXCD; wgid = (xcd < r ? xcd * (q + 1) : r * (q + 1) + (xcd - r) * q) + off; }
        const int nig = WGM * nN, gid = wgid / nig, fm = gid * WGM, gsz = (nM - fm) < WGM ? (nM - fm) : WGM;
        u.pm = fm + ((wgid % nig) % gsz); u.pn = (wgid % nig) / gsz; u.e = 0; return true;
    }
};
struct MoeOrder {
    int nM, nN, nwg, G, c, pm0; const int* tile_e;
    __device__ void init(int nM_, int nN_, int G_, int c_, int pm0_, const int* te) { nM = nM_; nN = nN_; nwg = nM * nN; G = G_; c = c_; pm0 = pm0_; tile_e = te; }
    __device__ bool next(int i, Unit& u) const {
        const long L = (long)i * G + c; if (L >= nwg) return false;
        int wgid = (int)L; { const int q = nwg / NXCD, r = nwg % NXCD, xcd = wgid % NXCD, off = wgid / NXCD; wgid = (xcd < r ? xcd * (q + 1) : r * (q + 1) + (xcd - r) * q) + off; }
        const int nig = WGM * nN, gid = wgid / nig, fm = gid * WGM, gsz = (nM - fm) < WGM ? (nM - fm) : WGM;
        u.pm = pm0 + fm + ((wgid % nig) % gsz); u.pn = (wgid % nig) / gsz; u.e = __builtin_amdgcn_readfirstlane(tile_e[u.pm]); return true;
    }
};

__device__ __forceinline__ unsigned pk2(float lo, float hi) { const bf16x2_t v = __builtin_convertvector((f32x2){lo, hi}, bf16x2_t); return __builtin_bit_cast(unsigned, v); }
__device__ __forceinline__ float bf_lo(unsigned u) { return __builtin_bit_cast(float, u << 16); }
__device__ __forceinline__ float bf_hi(unsigned u) { return __builtin_bit_cast(float, u & 0xffff0000u); }
__device__ __forceinline__ float bf2f(bf16_t b) { return __builtin_bit_cast(float, (unsigned)b << 16); }
__device__ __forceinline__ bf16_t f2bf(float f) { return (bf16_t)(pk2(f, 0.f) & 0xffffu); }
__device__ __forceinline__ float sigmoidf_(float x) { return __builtin_amdgcn_rcpf(1.0f + __expf(-x)); }

struct EpiPlain {
    static constexpr bool PERM = true;
    bf16_t* O; int ldc;
    __device__ __forceinline__ void operator()(const f32x4 (&acc)[2][2][4][2], const Unit& u, int wr, int wc, int fr, int fq) const {
        const int row0 = u.pm * BM + wr * 64 + fr, col0 = u.pn * BM + wc * 32 + 8 * fq;
#pragma unroll
        for (int ai = 0; ai < 2; ++ai)
#pragma unroll
            for (int m = 0; m < 4; ++m) { bf16_t* rowp = O + (size_t)(row0 + ai * HALF + m * 16) * ldc + col0;
#pragma unroll
                for (int bj = 0; bj < 2; ++bj) { const f32x4 v0 = acc[ai][bj][m][0], v1 = acc[ai][bj][m][1];
                    u32x4 w; w.x = pk2(v0[0], v0[1]); w.y = pk2(v0[2], v0[3]); w.z = pk2(v1[0], v1[1]); w.w = pk2(v1[2], v1[3]);
                    *(u32x4*)(rowp + bj * HALF) = w; } }
    }
};
struct EpiWin {
    static constexpr bool PERM = true;
    bf16_t *CA, *CB, *CG;
    __device__ __forceinline__ void operator()(const f32x4 (&acc)[2][2][4][2], const Unit& u, int wr, int wc, int fr, int fq) const {
        const int row0 = u.pm * BM + wr * 64 + fr; const int pn = u.pn;
        bf16_t* base; int ldc, ct; const bool sg = pn >= 12;
        if (pn < 7) { base = CA; ldc = 1792; ct = pn; } else if (pn < 12) { base = CB; ldc = 1280; ct = pn - 7; } else { base = CG; ldc = 2048; ct = pn - 12; }
        const int col0 = ct * BM + wc * 32 + 8 * fq;
#pragma unroll
        for (int ai = 0; ai < 2; ++ai)
#pragma unroll
            for (int m = 0; m < 4; ++m) { bf16_t* rowp = base + (size_t)(row0 + ai * HALF + m * 16) * ldc + col0;
#pragma unroll
                for (int bj = 0; bj < 2; ++bj) { f32x4 v0 = acc[ai][bj][m][0], v1 = acc[ai][bj][m][1];
                    if (sg) {
#pragma unroll
                        for (int j = 0; j < 4; ++j) { v0[j] = sigmoidf_(v0[j]); v1[j] = sigmoidf_(v1[j]); } }
                    u32x4 w; w.x = pk2(v0[0], v0[1]); w.y = pk2(v0[2], v0[3]); w.z = pk2(v1[0], v1[1]); w.w = pk2(v1[2], v1[3]);
                    *(u32x4*)(rowp + bj * HALF) = w; } }
    }
};
template <bool ADD> struct EpiMerge {
    static constexpr bool PERM = true;
    bf16_t* O; const bf16_t* gate; int gcol;
    __device__ __forceinline__ void operator()(const f32x4 (&acc)[2][2][4][2], const Unit& u, int wr, int wc, int fr, int fq) const {
        const int row0 = u.pm * BM + wr * 64 + fr, col0 = u.pn * BM + wc * 32 + 8 * fq;
#pragma unroll
        for (int ai = 0; ai < 2; ++ai) {
            u32x4 gv[4][2], pv[4][2];
#pragma unroll
            for (int m = 0; m < 4; ++m) { const size_t row = (size_t)(row0 + ai * HALF + m * 16);
#pragma unroll
                for (int bj = 0; bj < 2; ++bj) { gv[m][bj] = *(const u32x4*)(gate + row * 2048 + gcol + col0 + bj * HALF); if (ADD) pv[m][bj] = *(const u32x4*)(O + row * 1024 + col0 + bj * HALF); } }
#pragma unroll
            for (int m = 0; m < 4; ++m) { const size_t row = (size_t)(row0 + ai * HALF + m * 16);
#pragma unroll
                for (int bj = 0; bj < 2; ++bj) { const f32x4 v0 = acc[ai][bj][m][0], v1 = acc[ai][bj][m][1]; const u32x4 g = gv[m][bj];
                    float o[8] = { bf_lo(g.x) * v0[0], bf_hi(g.x) * v0[1], bf_lo(g.y) * v0[2], bf_hi(g.y) * v0[3], bf_lo(g.z) * v1[0], bf_hi(g.z) * v1[1], bf_lo(g.w) * v1[2], bf_hi(g.w) * v1[3] };
                    if (ADD) { const u32x4 p = pv[m][bj];
                        o[0] += bf_lo(p.x); o[1] += bf_hi(p.x); o[2] += bf_lo(p.y); o[3] += bf_hi(p.y); o[4] += bf_lo(p.z); o[5] += bf_hi(p.z); o[6] += bf_lo(p.w); o[7] += bf_hi(p.w); }
                    u32x4 w; w.x = pk2(o[0], o[1]); w.y = pk2(o[2], o[3]); w.z = pk2(o[4], o[5]); w.w = pk2(o[6], o[7]);
                    *(u32x4*)(O + row * 1024 + col0 + bj * HALF) = w; } }
        }
    }
};
struct EpiResid {
    static constexpr bool PERM = false;
    const float* xi; float* xo;
    __device__ __forceinline__ void operator()(const f32x4 (&acc)[2][2][4][2], const Unit& u, int wr, int wc, int fr, int fq) const {
        const int row0 = u.pm * BM + wr * 64 + fr, col0 = u.pn * BM + wc * 32 + 4 * fq;
#pragma unroll
        for (int ai = 0; ai < 2; ++ai) {
            f32x4 xv[4][2][2];
#pragma unroll
            for (int m = 0; m < 4; ++m) { const size_t o = (size_t)(row0 + ai * HALF + m * 16) * 1024 + col0;
#pragma unroll
                for (int bj = 0; bj < 2; ++bj)
#pragma unroll
                    for (int n = 0; n < 2; ++n) xv[m][bj][n] = *(const f32x4*)(xi + o + bj * HALF + n * 16); }
#pragma unroll
            for (int m = 0; m < 4; ++m) { const size_t o = (size_t)(row0 + ai * HALF + m * 16) * 1024 + col0;
#pragma unroll
                for (int bj = 0; bj < 2; ++bj)
#pragma unroll
                    for (int n = 0; n < 2; ++n) *(f32x4*)(xo + o + bj * HALF + n * 16) = xv[m][bj][n] + acc[ai][bj][m][n]; }
        }
    }
};
struct EpiSwiGLU {
    static constexpr bool PERM = true;
    bf16_t* O; int ldc;
    __device__ __forceinline__ void operator()(const f32x4 (&acc)[2][2][4][2], const Unit& u, int wr, int wc, int fr, int fq) const {
        const int row0 = u.pm * BM + wr * 64 + fr, col0 = u.pn * HALF + wc * 32 + 8 * fq;
#pragma unroll
        for (int ai = 0; ai < 2; ++ai)
#pragma unroll
            for (int m = 0; m < 4; ++m) { const int row = row0 + ai * HALF + m * 16;
                bf16_t* rowp = O + ((size_t)((row >> 6) * (ldc >> 4) + (col0 >> 4)) << 10) + (((row & 63) << 4) + (col0 & 15));
                float o[8];
#pragma unroll
                for (int n = 0; n < 2; ++n)
#pragma unroll
                    for (int j = 0; j < 4; ++j) { const float g = acc[ai][0][m][n][j], up = acc[ai][1][m][n][j]; o[4 * n + j] = g * sigmoidf_(g) * up; }
                u32x4 w; w.x = pk2(o[0], o[1]); w.y = pk2(o[2], o[3]); w.z = pk2(o[4], o[5]); w.w = pk2(o[6], o[7]);
                *(u32x4*)rowp = w; }
    }
};
struct EpiMoeDown {
    static constexpr bool PERM = false;
    float* x; const int* tok; const float* wgt;
    __device__ __forceinline__ void operator()(const f32x4 (&acc)[2][2][4][2], const Unit& u, int wr, int wc, int fr, int fq) const {
        const int row0 = u.pm * BM + wr * 64 + fr, col0 = u.pn * BM + wc * 32 + 4 * fq;
        int tk[2][4]; float wv[2][4];
#pragma unroll
        for (int ai = 0; ai < 2; ++ai)
#pragma unroll
            for (int m = 0; m < 4; ++m) { const int row = row0 + ai * HALF + m * 16; tk[ai][m] = tok[row]; wv[ai][m] = wgt[row]; }
#pragma unroll
        for (int ai = 0; ai < 2; ++ai) {
            f32x4 xv[4][2][2];
#pragma unroll
            for (int m = 0; m < 4; ++m) { const int t = tk[ai][m] < 0 ? 0 : tk[ai][m]; const float* xp = x + (size_t)t * 1024 + col0;
#pragma unroll
                for (int bj = 0; bj < 2; ++bj)
#pragma unroll
                    for (int n = 0; n < 2; ++n) xv[m][bj][n] = *(const f32x4*)(xp + bj * HALF + n * 16); }
#pragma unroll
            for (int m = 0; m < 4; ++m) if (tk[ai][m] >= 0) { float* xp = x + (size_t)tk[ai][m] * 1024 + col0;
#pragma unroll
                for (int bj = 0; bj < 2; ++bj)
#pragma unroll
                    for (int n = 0; n < 2; ++n) *(f32x4*)(xp + bj * HALF + n * 16) = xv[m][bj][n] + acc[ai][bj][m][n] * wv[ai][m]; }
        }
    }
};

template <class Epi, class Sched, bool GATHER = false, bool ABLK = false>
__device__ __forceinline__ void gemm_phase(PG8_LAS unsigned char* lds, const Gemm g, const Sched& S, const Epi& E, int tid_) {
    asm volatile("" : "+v"(tid_));
    const int tid = tid_, wid = __builtin_amdgcn_readfirstlane(tid >> 6), lane = tid & 63, wr = wid >> 2, wc = wid & 3, fr = lane & 15, fq = lane >> 4;
    const int K = g.K, nt = K / BK;
    unsigned voffA[2], voffB[2];
#pragma unroll
    for (int i = 0; i < 2; ++i) { int R, C; stage_rc(tid * 16 + i * 8192, R, C); const int Rb = Epi::PERM ? ((R & ~31) + perm32(R & 31)) : R;
        voffA[i] = ABLK ? (unsigned)(((R >> 6) * (K >> 4) + (C >> 4)) * 2048 + (((R & 63) << 4) + (C & 15)) * 2) : (unsigned)(R * K + C) * 2u; voffB[i] = (unsigned)(Rb * K + C) * 2u; }
    const size_t kstep = (size_t)(BK * 2);
    const size_t hstep = (size_t)HALF * K * 2;
    const size_t tstep = 2 * hstep;
    const size_t hstepA = ABLK ? (size_t)2 * (K >> 4) * 2048 : hstep, tstepA = 2 * hstepA; constexpr size_t AKM = ABLK ? 64 : 1;
    const unsigned ldsw = (unsigned)wid * 1024u;
    const int aoff = lds_byte(wr * 64 + fr, fq * 8), boff = lds_byte(wc * 32 + fr, fq * 8);
    unsigned gvo[2][2];
#define PG8_SA(b, h) (((b) * 2 + (h)) * HTB)
#define PG8_SB(b, h) ((4 + (b) * 2 + (h)) * HTB)
#define PG8_STAGE(bufoff, gbase, voff) do { _Pragma("unroll") for (int _i = 0; _i < 2; ++_i) \
        __builtin_amdgcn_global_load_lds((const unsigned*)((const char*)(gbase) + (voff)[_i]), (PG8_LAS unsigned*)(lds + (bufoff) + ldsw + _i * 8192), 16, 0, 0); } while (0)
#define PG8_STAGE_A(bufoff, h, ubase, kb, nx) do { if constexpr (GATHER) { PG8_STAGE(bufoff, (const char*)g.A + (kb), gvo[h]); } \
        else { PG8_STAGE(bufoff, (ubase) + (kb) * AKM + (h) * hstepA, voffA); } } while (0)
#define PG8_LOADROWS(dst, unit) do { if constexpr (GATHER) { _Pragma("unroll") for (int _i = 0; _i < 2; ++_i) { int _R, _C; stage_rc(tid * 16 + _i * 8192, _R, _C); \
        _Pragma("unroll") for (int _h = 0; _h < 2; ++_h) { int _t = g.rowidx[(unit).pm * BM + _h * HALF + _R]; _t = _t < 0 ? 0 : _t; dst[_h][_i] = (unsigned)(_t * K + _C) * 2u; } } } } while (0)
#define PG8_LDA(dst, b, h) do { _Pragma("unroll") for (int m = 0; m < 4; ++m) _Pragma("unroll") for (int k = 0; k < 2; ++k) dst[m][k] = *(const PG8_LAS bf16x8*)(lds + PG8_SA(b, h) + aoff + m * 2048 + k * 1024); } while (0)
#define PG8_LDB(dst, b, h) do { _Pragma("unroll") for (int n = 0; n < 2; ++n) _Pragma("unroll") for (int k = 0; k < 2; ++k) dst[n][k] = *(const PG8_LAS bf16x8*)(lds + PG8_SB(b, h) + boff + n * 2048 + k * 1024); } while (0)
#define PG8_MMA(ai, bj, At, Bt) do { __builtin_amdgcn_s_setprio(1); _Pragma("unroll") for (int m = 0; m < 4; ++m) _Pragma("unroll") for (int n = 0; n < 2; ++n) _Pragma("unroll") for (int k = 0; k < 2; ++k) \
        acc[ai][bj][m][n] = __builtin_amdgcn_mfma_f32_16x16x32_bf16(Bt[n][k], At[m][k], acc[ai][bj][m][n], 0, 0, 0); __builtin_amdgcn_s_setprio(0); } while (0)
#define PG8_WAIT_V(n) asm volatile("s_waitcnt vmcnt(" #n ")" ::: "memory")
#define PG8_WAIT_L(n) asm volatile("s_waitcnt lgkmcnt(" #n ")" ::: "memory")
#define PG8_BAR __builtin_amdgcn_s_barrier()
#define PG8_SCHED __builtin_amdgcn_sched_barrier(0)
    Unit cur, nxt; int ui = 0;
    if (!S.next(0, cur)) return;
    f32x4 acc[2][2][4][2];
#pragma unroll
    for (int a = 0; a < 2; ++a)
#pragma unroll
        for (int b = 0; b < 2; ++b)
#pragma unroll
            for (int m = 0; m < 4; ++m)
#pragma unroll
                for (int n = 0; n < 2; ++n) acc[a][b][m][n] = (f32x4){0.f, 0.f, 0.f, 0.f};
    bf16x8 At[4][2], B0[2][2], B1[2][2];
    const char* cA = GATHER ? (const char*)g.A : (const char*)g.A + (size_t)cur.pm * tstepA;
    const char* cB = (const char*)g.Bt + ((size_t)cur.e * g.bstride) * 2 + (size_t)cur.pn * tstep;
    PG8_LOADROWS(gvo, cur);
    PG8_STAGE(PG8_SB(0, 0), cB, voffB); PG8_STAGE(PG8_SB(0, 1), cB + hstep, voffB); PG8_STAGE_A(PG8_SA(0, 0), 0, cA, 0, false); PG8_STAGE_A(PG8_SA(0, 1), 1, cA, 0, false);
    if (wr == 1) PG8_BAR;
    PG8_WAIT_V(2); PG8_BAR;
    PG8_STAGE(PG8_SB(1, 0), cB + kstep, voffB); PG8_STAGE_A(PG8_SA(1, 0), 0, cA, kstep, false); PG8_STAGE(PG8_SB(1, 1), cB + hstep + kstep, voffB);
    PG8_WAIT_V(6); PG8_BAR;
    for (;;) {
        const bool has_next = S.next(ui + 1, nxt);
        const char* nA = GATHER ? (const char*)g.A : (has_next ? (const char*)g.A + (size_t)nxt.pm * tstepA : cA);
        const char* nB = has_next ? (const char*)g.Bt + ((size_t)nxt.e * g.bstride) * 2 + (size_t)nxt.pn * tstep : cB;
        for (int t = 0; t < nt; t += 2) {
            const bool last = (t == nt - 2);
            const size_t k1 = (size_t)(t + 1) * kstep;
            const size_t k2 = last ? 0 : (size_t)(t + 2) * kstep, k3 = k2 + kstep;
            const char* a2b = last ? nA : cA; const char* b2 = (last ? nB : cB) + k2; const char* b3 = b2 + kstep;
            PG8_LDB(B0, 0, 0); PG8_LDB(B1, 0, 1); PG8_SCHED; PG8_LDA(At, 0, 0); PG8_STAGE_A(PG8_SA(1, 1), 1, cA, k1, false);
            if (last && has_next) PG8_LOADROWS(gvo, nxt);
            PG8_WAIT_V(8); PG8_WAIT_L(0); PG8_BAR; PG8_MMA(0, 0, At, B0); PG8_MMA(0, 1, At, B1); PG8_BAR; PG8_SCHED;
            PG8_LDA(At, 0, 1); PG8_STAGE(PG8_SB(0, 0), b2, voffB); PG8_STAGE(PG8_SB(0, 1), b2 + hstep, voffB); PG8_STAGE_A(PG8_SA(0, 0), 0, a2b, k2, last);
            PG8_WAIT_V(8); PG8_WAIT_L(0); PG8_BAR; PG8_MMA(1, 0, At, B0); PG8_MMA(1, 1, At, B1); PG8_BAR; PG8_SCHED;
            PG8_LDB(B0, 1, 0); PG8_LDB(B1, 1, 1); PG8_SCHED; PG8_LDA(At, 1, 0); PG8_STAGE_A(PG8_SA(0, 1), 1, a2b, k2, last);
            PG8_WAIT_V(8); PG8_WAIT_L(0); PG8_BAR; PG8_MMA(0, 0, At, B0); PG8_MMA(0, 1, At, B1); PG8_BAR; PG8_SCHED;
            PG8_LDA(At, 1, 1); PG8_STAGE(PG8_SB(1, 0), b3, voffB); PG8_STAGE(PG8_SB(1, 1), b3 + hstep, voffB); PG8_STAGE_A(PG8_SA(1, 0), 0, a2b, k3, last);
            PG8_WAIT_V(8); PG8_WAIT_L(0); PG8_BAR; PG8_MMA(1, 0, At, B0); PG8_MMA(1, 1, At, B1); PG8_BAR; PG8_SCHED;
        }
        if (wr == 0) PG8_BAR;
        E(acc, cur, wr, wc, fr, fq);
        if (!has_next) break;
#pragma unroll
        for (int a = 0; a < 2; ++a)
#pragma unroll
            for (int b = 0; b < 2; ++b)
#pragma unroll
                for (int m = 0; m < 4; ++m)
#pragma unroll
                    for (int n = 0; n < 2; ++n) acc[a][b][m][n] = (f32x4){0.f, 0.f, 0.f, 0.f};
        cur = nxt; cA = nA; cB = nB; ++ui;
        if (wr == 1) PG8_BAR;
    }
    PG8_WAIT_V(0);
    PG8_BAR;
#undef PG8_SA
#undef PG8_SB
#undef PG8_STAGE
#undef PG8_STAGE_A
#undef PG8_LOADROWS
#undef PG8_LDA
#undef PG8_LDB
#undef PG8_MMA
#undef PG8_WAIT_V
#undef PG8_WAIT_L
#undef PG8_BAR
#undef PG8_SCHED
}
}
using pg8::bf16_t; using pg8::bf16x8; using pg8::f32x4; using pg8::f32x2; using pg8::u32x4; using pg8::u32x2; using pg8::pk2; using pg8::bf2f; using pg8::f2bf; using pg8::bf_lo; using pg8::bf_hi; using pg8::sigmoidf_;

constexpr int NWAVES = 8, NTHR = 512;
constexpr int D = 1024, NB = 32, SEQ = 2048, T = NB * SEQ, TH = T / 2, DEPTH = 4;
constexpr int RW_COLS = 1792, DS_COLS = 1224, DS_PAD = 1280, N_IN = 5064, N_INP = 5120;
constexpr int NMEM = 256, MEMROWS = NB * NMEM;
constexpr int FFN = 2816, NEXP = 8, EDIM = 1408;
constexpr int MOE_ROWS_MAX = 2 * T + 16 * 256;
constexpr int MOE_TILES_MAX = MOE_ROWS_MAX / 256;

constexpr size_t MiB = 1u << 20;
constexpr size_t WS_CTL = 0, CTL_ZERO_BYTES = 1 * MiB;
constexpr size_t WS_MOE = 1 * MiB;
constexpr size_t MOE_SELE = WS_MOE, MOE_SELW = MOE_SELE + (size_t)T * 2, MOE_ROWTOK = MOE_SELW + (size_t)T * 8, MOE_ROWW = MOE_ROWTOK + (size_t)MOE_ROWS_MAX * 4,
                 MOE_TILEE = MOE_ROWW + (size_t)MOE_ROWS_MAX * 4, MOE_META = MOE_TILEE + (size_t)MOE_TILES_MAX * 4, MOE_END = MOE_META + 256;
static_assert(MOE_END <= 4 * MiB, "moe map");
constexpr size_t WS_W = 4 * MiB;
constexpr size_t W_IN = WS_W, W_BA = W_IN + (size_t)N_INP * D * 2, W_BB = W_BA + (size_t)D * 512 * 2, W_OUT = W_BB + (size_t)D * 512 * 2, W_MQ = W_OUT + (size_t)D * D * 2,
                 W_MO = W_MQ + (size_t)512 * D * 2, W_FF = W_MO + (size_t)D * 512 * 2;
constexpr size_t W_RW2 = W_FF, W_RA2 = W_RW2 + 512 * 64 * 2, W_RG2 = W_RA2 + 512 * 64 * 2, W_RV1 = W_RG2 + 512 * 128 * 2, W_RV2 = W_RV1 + 32 * 512 * 2, W_FF2 = W_RV2 + 512 * 32 * 2;
constexpr size_t W_FGU = W_FF2, W_FD = W_FGU + (size_t)2 * FFN * D * 2;
constexpr size_t W_EGU = W_FF2, W_ED = W_EGU + (size_t)NEXP * 2 * EDIM * D * 2, W_END = W_ED + (size_t)NEXP * D * EDIM * 2;
static_assert(W_FD + (size_t)D * FFN * 2 <= W_END, "w map");
constexpr size_t WS_WKV = (W_END + MiB - 1) / MiB * MiB;
constexpr size_t WS_MEMH = WS_WKV + (size_t)4096 * D * 2;
constexpr size_t WS_MEMK = WS_MEMH + (size_t)MEMROWS * D * 2;
constexpr size_t WS_MEMVT = WS_MEMK + (size_t)DEPTH * MEMROWS * 512 * 2;
constexpr size_t WS_VFIRST = WS_MEMVT + (size_t)DEPTH * MEMROWS * 512 * 2;
constexpr size_t WS_HN = WS_VFIRST + (size_t)T * 512 * 2;
constexpr size_t WS_MIX = WS_HN + (size_t)T * D * 2;
constexpr size_t MX_CA = WS_MIX, MX_CB = MX_CA + (size_t)TH * RW_COLS * 2, MX_CG = MX_CB + (size_t)TH * DS_PAD * 2, MX_RW = MX_CG + (size_t)TH * 2048 * 2;
constexpr size_t RW_ARR = (size_t)TH * 512 * 2;
constexpr size_t MX_VT = MX_RW + 7 * RW_ARR, MX_YB = MX_VT + (size_t)(NB / 2) * 64 * SEQ * 2, MX_END = MX_YB + (size_t)TH * 512 * 2;
constexpr size_t MA_QM = WS_MIX, MA_OM = MA_QM + (size_t)T * 512 * 2;
constexpr size_t FF_GU = WS_MIX;
constexpr size_t PR_KVRAW = WS_MIX;
constexpr size_t MX_BS = MX_END;
constexpr size_t WS_END = MX_BS + (size_t)TH * 8 * 4;
static_assert(FF_GU + (size_t)T * FFN * 2 <= WS_END && FF_GU + (size_t)MOE_ROWS_MAX * EDIM * 2 <= WS_END && MA_OM + (size_t)T * 512 * 2 <= WS_END, "overlay map");
static_assert(WS_END <= 1000 * MiB, "workspace budget");

constexpr int LDS_BYTES = 160 * 1024;
constexpr int LDS_MISC = LDS_BYTES - 256;

#define XB_TMO      128
#define XB_XCNT(j)  (256  + 64 * (j))
#define XB_XSUB(j)  (1280 + 64 * (j))
#define XB_XGEN(j)  (2304 + 64 * (j))
#define XB_TOP      3328
#define XB_TOPGEN   3392
#define XCD_BAR_WORDS 3456
#define XB_SPIN_CAP (1u << 18)
#define LAS __attribute__((address_space(3)))

__device__ __forceinline__ unsigned xb_ld(unsigned* p)              { return __hip_atomic_load(p, __ATOMIC_RELAXED, __HIP_MEMORY_SCOPE_AGENT); }
__device__ __forceinline__ unsigned xb_add(unsigned* p, unsigned v) { return __hip_atomic_fetch_add(p, v, __ATOMIC_RELAXED, __HIP_MEMORY_SCOPE_AGENT); }
__device__ __forceinline__ unsigned xb_xcc_id() { return (unsigned)__builtin_amdgcn_s_getreg((3 << 11) | 20) & 0xFu; }
#define XB_SPIN(cond, bar) do { unsigned _sp = 0; while (cond) { __builtin_amdgcn_s_sleep(1); \
    if ((++_sp & 255u) == 0u) { if (xb_ld(&(bar)[XB_TMO])) break; if (_sp > XB_SPIN_CAP) { atomicAdd(&(bar)[XB_TMO], 1u); break; } } } } while (0)
struct XcdBarrier { unsigned* bar; unsigned x; volatile LAS unsigned* st; };
__device__ __forceinline__ XcdBarrier xcd_barrier_post(unsigned* bar, volatile LAS unsigned* st) {
    XcdBarrier b; b.bar = bar; b.x = xb_xcc_id(); b.st = st;
    if (threadIdx.x == 0) (void)xb_add(&bar[XB_XCNT(b.x)], 1u);
    return b;
}
__device__ __forceinline__ void xcd_barrier_complete(unsigned* bar, unsigned x, unsigned& nloc, unsigned& nx) {
    const unsigned G = gridDim.x * gridDim.y * gridDim.z;
    unsigned sum, cnt, mine, sp = 0u;
    for (;;) {
        sum = 0u; cnt = 0u; mine = 0u;
#pragma unroll
        for (unsigned j = 0; j < 16; ++j) { const unsigned c = xb_ld(&bar[XB_XCNT(j)]); sum += c; cnt += (c > 0u) ? 1u : 0u; mine = (j == x) ? c : mine; }
        if (sum == G) break;
        __builtin_amdgcn_s_sleep(1);
        if ((++sp & 255u) == 0u) { if (xb_ld(&bar[XB_TMO])) break; if (sp > XB_SPIN_CAP) { atomicAdd(&bar[XB_TMO], 1u); break; } }
    }
    nloc = mine > 0u ? mine : 1u; nx = cnt > 0u ? cnt : 1u;
}
__device__ __forceinline__ void xcd_barrier(const XcdBarrier& b, int tid) {
    asm volatile("s_waitcnt vmcnt(0)" ::: "memory");
    __syncthreads();
    if (tid == 0) {
        unsigned* bar = b.bar; asm volatile("" : "+s"(bar));
        __builtin_amdgcn_s_waitcnt(0);
        unsigned nloc = b.st[0], nx = b.st[1];
        if (nloc == 0u) { xcd_barrier_complete(bar, b.x, nloc, nx); b.st[0] = nloc; b.st[1] = nx; }
        const unsigned old = xb_add(&bar[XB_XSUB(b.x)], 1u);
        const unsigned gen = old / nloc;
        if (old + 1u == (gen + 1u) * nloc) {
            __builtin_amdgcn_fence(__ATOMIC_RELEASE, "agent");
            asm volatile("s_waitcnt vmcnt(0)" ::: "memory");
            const unsigned og = xb_add(&bar[XB_TOP], 1u);
            const unsigned tg = og / nx;
            if (og + 1u == (tg + 1u) * nx) xb_add(&bar[XB_TOPGEN], 1u);
            else XB_SPIN(xb_ld(&bar[XB_TOPGEN]) == tg, bar);
            __builtin_amdgcn_fence(__ATOMIC_ACQUIRE, "agent");
            xb_add(&bar[XB_XGEN(b.x)], 1u);
            asm volatile("s_waitcnt vmcnt(0)" ::: "memory");
        } else {
            XB_SPIN(xb_ld(&bar[XB_XGEN(b.x)]) == gen, bar);
            __builtin_amdgcn_fence(__ATOMIC_ACQUIRE, "agent");
            asm volatile("s_waitcnt vmcnt(0)" ::: "memory");
        }
    }
    __syncthreads();
}

struct Args { const void* in[41]; float* out; unsigned char* ws; int ph_lo, ph_hi; };
static_assert(sizeof(Args) == 41 * 8 + 8 + 8 + 8, "Args has no padding");

enum InIdx { I_X = 0, I_MEM, I_POS, I_NORM_MIX, I_W_IN, I_MU, I_W0, I_W2, I_A0, I_A2, I_G2, I_V0, I_V1, I_V2, I_KK, I_KA, I_RK, I_LNG, I_LNB, I_QN, I_KN, I_IKN,
             I_WBA, I_WBB, I_WOUT, I_NORM_MEM, I_MEM_TOKN, I_MWQ, I_MWKV, I_MQN, I_MKN, I_MWO, I_NORM_FFN, I_FWG, I_FWU, I_FWD, I_ROUTER, I_RBIAS, I_EWG, I_EWU, I_EWD };

typedef decltype(__builtin_amdgcn_kernarg_segment_ptr()) kptr_t;
struct Frame {
    LAS unsigned char* lds; unsigned char* ws; kptr_t kb; float* out;
    int tid, lane, wave, G, bid;
};
#define LDS_WAIT() asm volatile("s_waitcnt lgkmcnt(0)" ::: "memory")
__device__ __forceinline__ const void* kargp(kptr_t kb, int i) { typedef const void* cvp; typedef __attribute__((address_space(4))) const cvp* tab_t; return (const void*)(const __attribute__((address_space(1))) void*)(((tab_t)kb)[i]); }
#define KARGP(F, i) kargp((F).kb, (i))
#define FIN(F, i) ((const float*)KARGP(F, i))
__device__ __forceinline__ void lds_barrier() { asm volatile("s_waitcnt lgkmcnt(0)" ::: "memory"); __builtin_amdgcn_s_barrier(); asm volatile("" ::: "memory"); }

__device__ __forceinline__ float wave_sum(float v) {
#pragma unroll
    for (int o = 1; o < 64; o <<= 1) v += __shfl_xor(v, o);
    return v;
}

template <class Map>
__device__ __forceinline__ void transpose_item(const float* W, int K, int N, bf16_t* WT, const Map& map, const float* gain, LAS float* scr, int item, int lane) {
    const int nblk = (N + 31) / 32, kb = item / nblk, nb = item % nblk, k0 = 64 * kb, n0 = 32 * nb;
    const int nn = n0 + (lane & 31);
    float vv[32], gg[32];
#pragma unroll
    for (int i = 0; i < 32; ++i) { const int kk = 2 * i + (lane >> 5); vv[i] = 0.f; gg[i] = 1.f; if (nn < N && k0 + kk < K) { vv[i] = W[(size_t)(k0 + kk) * N + nn]; if (gain) gg[i] = gain[k0 + kk]; } }
#pragma unroll
    for (int i = 0; i < 32; ++i) { const int kk = 2 * i + (lane >> 5); scr[kk * 33 + (lane & 31)] = vv[i] * gg[i]; }
    LDS_WAIT(); asm volatile("" ::: "memory");
    const int c = lane & 7;
#pragma unroll
    for (int j = 0; j < 4; ++j) { const int n = (lane >> 3) + 8 * j; const LAS float* s = scr + (8 * c) * 33 + n;
        u32x4 o; o.x = pk2(s[0 * 33], s[1 * 33]); o.y = pk2(s[2 * 33], s[3 * 33]); o.z = pk2(s[4 * 33], s[5 * 33]); o.w = pk2(s[6 * 33], s[7 * 33]);
        if (n0 + n < N && k0 + 8 * c < K) *(u32x4*)(WT + (size_t)map(n0 + n) * K + k0 + 8 * c) = o; }
    LDS_WAIT(); asm volatile("" ::: "memory");
}
struct MapId { int off; __device__ int operator()(int n) const { return n + off; } };
struct MapWin { __device__ int operator()(int n) const { return n < 3016 ? n : n + 56; } };
struct MapGU { int up; __device__ int operator()(int n) const { return (n >> 7) * 256 + up * 128 + (n & 127); } };

__device__ __forceinline__ void rms_row_to_bf16(const float* xrow, bf16_t* orow, int lane, f32x4 (&v)[4]) {
    const f32x4* xr = (const f32x4*)xrow + lane; float s = 0.f;
#pragma unroll
    for (int j = 0; j < 4; ++j) { v[j] = xr[64 * j]; s += (v[j].x * v[j].x + v[j].y * v[j].y) + (v[j].z * v[j].z + v[j].w * v[j].w); }
    const float rstd = 1.0f / sqrtf(wave_sum(s) * (1.f / D) + 1e-6f);
    u32x2* o8 = (u32x2*)orow + lane;
#pragma unroll
    for (int j = 0; j < 4; ++j) { v[j] = v[j] * rstd; u32x2 w; w.x = pk2(v[j].x, v[j].y); w.y = pk2(v[j].z, v[j].w); o8[64 * j] = w; }
}

__device__ __forceinline__ void rms_pass_to_bf16(const float* x, bf16_t* o, int first, int stride, int lane) {
    f32x4 v[4][4], n[4][4];
#pragma unroll
    for (int r = 0; r < 4; ++r) { const f32x4* xr = (const f32x4*)(x + (size_t)(first + r * stride) * D) + lane;
#pragma unroll
        for (int j = 0; j < 4; ++j) n[r][j] = xr[64 * j]; }
#pragma unroll 1
    for (int m0 = first; m0 < T; m0 += 4 * stride) {
#pragma unroll
        for (int r = 0; r < 4; ++r)
#pragma unroll
            for (int j = 0; j < 4; ++j) { v[r][j] = n[r][j]; asm volatile("" : "+v"(v[r][j])); }
        { const int mn = (m0 + 4 * stride < T) ? m0 + 4 * stride : m0;
#pragma unroll
          for (int r = 0; r < 4; ++r) { const f32x4* xr = (const f32x4*)(x + (size_t)(mn + r * stride) * D) + lane;
#pragma unroll
              for (int j = 0; j < 4; ++j) n[r][j] = xr[64 * j]; }
          asm volatile("" ::: "memory"); }
        float s[4];
#pragma unroll
        for (int r = 0; r < 4; ++r) { s[r] = 0.f;
#pragma unroll
            for (int j = 0; j < 4; ++j) s[r] += (v[r][j].x * v[r][j].x + v[r][j].y * v[r][j].y) + (v[r][j].z * v[r][j].z + v[r][j].w * v[r][j].w); }
#pragma unroll
        for (int o_ = 1; o_ < 64; o_ <<= 1) {
#pragma unroll
            for (int r = 0; r < 4; ++r) s[r] += __shfl_xor(s[r], o_); }
#pragma unroll
        for (int r = 0; r < 4; ++r) { const float rstd = 1.0f / sqrtf(s[r] * (1.f / D) + 1e-6f); u32x2* o8 = (u32x2*)(o + (size_t)(m0 + r * stride) * D) + lane;
#pragma unroll
            for (int j = 0; j < 4; ++j) { const f32x4 t = v[r][j] * rstd; u32x2 w; w.x = pk2(t.x, t.y); w.y = pk2(t.z, t.w); o8[64 * j] = w; } }
    }
}
__device__ __forceinline__ void ph_prologue0(Frame& F) {
    LAS float* scr = (LAS float*)(F.lds + F.wave * 16384);
    const int gw = F.bid * NWAVES + F.wave, NGW = F.G * NWAVES;
    bf16_t* wkv = (bf16_t*)(F.ws + WS_WKV);
    constexpr int IT = (D / 64) * (1024 / 32);
    for (int it = gw; it < DEPTH * IT; it += NGW) { const int l = it / IT, r = it % IT;
        transpose_item(FIN(F, I_MWKV) + (size_t)l * D * 1024, D, 1024, wkv, MapId{l * 1024}, FIN(F, I_MEM_TOKN) + l * D, scr, r, F.lane); }
    bf16_t* mh = (bf16_t*)(F.ws + WS_MEMH);
    for (int m = gw; m < MEMROWS; m += NGW) { f32x4 v[4]; rms_row_to_bf16(FIN(F, I_MEM) + (size_t)m * D, mh + (size_t)m * D, F.lane, v); }
}
__device__ __forceinline__ void ph_prologue2(Frame& F) {
    const int gw = F.bid * NWAVES + F.wave, NGW = F.G * NWAVES;
    const bf16_t* kv = (const bf16_t*)(F.ws + PR_KVRAW);
    bf16_t* MK = (bf16_t*)(F.ws + WS_MEMK); bf16_t* MVT = (bf16_t*)(F.ws + WS_MEMVT);
    for (int it = gw; it < MEMROWS * 16; it += NGW) {
        const int row = it >> 4, l = (it >> 2) & 3, hh = it & 3, b = row >> 8, m = row & 255;
        const bf16_t* src = kv + (size_t)row * 4096 + l * 1024;
        const unsigned kk = *(const unsigned*)(src + hh * 128 + 2 * F.lane);
        const float k0 = bf_lo(kk), k1 = bf_hi(kk);
        const float rstd = 1.0f / sqrtf(wave_sum(k0 * k0 + k1 * k1) * (1.f / 128.f) + 1e-6f);
        const float* gk = FIN(F, I_MKN) + l * 128;
        *(unsigned*)(MK + ((((size_t)l * NB + b) * 4 + hh) * 256 + m) * 128 + 2 * F.lane) = pk2(k0 * rstd * gk[2 * F.lane], k1 * rstd * gk[2 * F.lane + 1]);
        const unsigned vv = *(const unsigned*)(src + 512 + hh * 128 + 2 * F.lane);
        bf16_t* vt = MVT + (((size_t)l * NB + b) * 4 + hh) * 128 * 256 + m;
        vt[(size_t)(2 * F.lane) * 256] = (bf16_t)(vv & 0xffffu); vt[(size_t)(2 * F.lane + 1) * 256] = (bf16_t)(vv >> 16);
    }
}
__device__ __forceinline__ void ph_layer0(Frame& F, int l, const float* xin) {
    LAS float* scr = (LAS float*)(F.lds + F.wave * 16384);
    const int gw = F.bid * NWAVES + F.wave, NGW = F.G * NWAVES;
    unsigned char* ws = F.ws;
    constexpr int I_WIN = (D / 64) * ((N_IN + 31) / 32), I_B = (512 / 64) * (D / 32), I_O = (D / 64) * (D / 32), I_Q = (D / 64) * (512 / 32);
    constexpr int I_FG = (D / 64) * (FFN / 32), I_FDN = (FFN / 64) * (D / 32), I_EG = (D / 64) * (EDIM / 32), I_EDN = (EDIM / 64) * (D / 32);
    const bool moe = (l & 1) != 0; const int j = l >> 1;
    const int nff = moe ? NEXP * (2 * I_EG + I_EDN) : (2 * I_FG + I_FDN);
    constexpr int I_R2 = 16, I_RG = 32, I_RV1 = 8, I_RV2 = 16;
    const int nrw = 2 * I_R2 + I_RG + (l ? I_RV1 + I_RV2 : 0);
    const int NIT = I_WIN + 2 * I_B + I_O + I_Q + I_B + nrw + nff;
    const float* gffn = FIN(F, I_NORM_FFN) + l * D;
    for (int it = gw; it < NIT; it += NGW) {
        int r = it;
        if (r < I_WIN) { transpose_item(FIN(F, I_W_IN) + (size_t)l * D * N_IN, D, N_IN, (bf16_t*)(ws + W_IN), MapWin{}, FIN(F, I_NORM_MIX) + l * D, scr, r, F.lane); continue; } r -= I_WIN;
        if (r < I_B) { transpose_item(FIN(F, I_WBA) + (size_t)l * 512 * D, 512, D, (bf16_t*)(ws + W_BA), MapId{0}, nullptr, scr, r, F.lane); continue; } r -= I_B;
        if (r < I_B) { transpose_item(FIN(F, I_WBB) + (size_t)l * 512 * D, 512, D, (bf16_t*)(ws + W_BB), MapId{0}, nullptr, scr, r, F.lane); continue; } r -= I_B;
        if (r < I_O) { transpose_item(FIN(F, I_WOUT) + (size_t)l * D * D, D, D, (bf16_t*)(ws + W_OUT), MapId{0}, nullptr, scr, r, F.lane); continue; } r -= I_O;
        if (r < I_Q) { transpose_item(FIN(F, I_MWQ) + (size_t)l * D * 512, D, 512, (bf16_t*)(ws + W_MQ), MapId{0}, FIN(F, I_NORM_MEM) + l * D, scr, r, F.lane); continue; } r -= I_Q;
        if (r < I_B) { transpose_item(FIN(F, I_MWO) + (size_t)l * 512 * D, 512, D, (bf16_t*)(ws + W_MO), MapId{0}, nullptr, scr, r, F.lane); continue; } r -= I_B;
        if (r < nrw) {
            if (r < I_R2) { transpose_item(FIN(F, I_W2) + (size_t)l * 64 * 512, 64, 512, (bf16_t*)(ws + W_RW2), MapId{0}, nullptr, scr, r, F.lane); continue; } r -= I_R2;
            if (r < I_R2) { transpose_item(FIN(F, I_A2) + (size_t)l * 64 * 512, 64, 512, (bf16_t*)(ws + W_RA2), MapId{0}, nullptr, scr, r, F.lane); continue; } r -= I_R2;
            if (r < I_RG) { transpose_item(FIN(F, I_G2) + (size_t)l * 128 * 512, 128, 512, (bf16_t*)(ws + W_RG2), MapId{0}, nullptr, scr, r, F.lane); continue; } r -= I_RG;
            if (r < I_RV1) { transpose_item(FIN(F, I_V1) + (size_t)(l - 1) * 512 * 32, 512, 32, (bf16_t*)(ws + W_RV1), MapId{0}, nullptr, scr, r, F.lane); continue; } r -= I_RV1;
            transpose_item(FIN(F, I_V2) + (size_t)(l - 1) * 32 * 512, 32, 512, (bf16_t*)(ws + W_RV2), MapId{0}, nullptr, scr, r, F.lane); continue;
        }
        r -= nrw;
        if (!moe) {
            if (r < I_FG) { transpose_item(FIN(F, I_FWG) + (size_t)j * D * FFN, D, FFN, (bf16_t*)(ws + W_FGU), MapGU{0}, gffn, scr, r, F.lane); continue; } r -= I_FG;
            if (r < I_FG) { transpose_item(FIN(F, I_FWU) + (size_t)j * D * FFN, D, FFN, (bf16_t*)(ws + W_FGU), MapGU{1}, gffn, scr, r, F.lane); continue; } r -= I_FG;
            transpose_item(FIN(F, I_FWD) + (size_t)j * FFN * D, FFN, D, (bf16_t*)(ws + W_FD), MapId{0}, nullptr, scr, r, F.lane);
        } else {
            const int per = 2 * I_EG + I_EDN, e = r / per; r -= e * per;
            const size_t eo = (size_t)(j * NEXP + e);
            if (r < I_EG) { transpose_item(FIN(F, I_EWG) + eo * D * EDIM, D, EDIM, (bf16_t*)(ws + W_EGU) + (size_t)e * 2 * EDIM * D, MapGU{0}, gffn, scr, r, F.lane); continue; } r -= I_EG;
            if (r < I_EG) { transpose_item(FIN(F, I_EWU) + eo * D * EDIM, D, EDIM, (bf16_t*)(ws + W_EGU) + (size_t)e * 2 * EDIM * D, MapGU{1}, gffn, scr, r, F.lane); continue; } r -= I_EG;
            transpose_item(FIN(F, I_EWD) + eo * EDIM * D, EDIM, D, (bf16_t*)(ws + W_ED) + (size_t)e * D * EDIM, MapId{0}, nullptr, scr, r, F.lane);
        }
    }
    { u32x4* z = (u32x4*)((bf16_t*)(ws + W_IN) + (size_t)3016 * D); const int n16 = 56 * D * 2 / 16;
      for (int i = F.bid * NTHR + F.tid; i < n16; i += F.G * NTHR) z[i] = (u32x4){0u, 0u, 0u, 0u}; }
    bf16_t* hn = (bf16_t*)(ws + WS_HN);
    rms_pass_to_bf16(xin, hn, gw, NGW, F.lane);
}
__device__ __forceinline__ void ph_norm(Frame& F) {
    const int gw = F.bid * NWAVES + F.wave, NGW = F.G * NWAVES;
    bf16_t* hn = (bf16_t*)(F.ws + WS_HN);
    rms_pass_to_bf16(F.out, hn, gw, NGW, F.lane);
}
__device__ __forceinline__ void ph_norm_ffn(Frame& F, int l) {
    const int gw = F.bid * NWAVES + F.wave, NGW = F.G * NWAVES;
    bf16_t* hn = (bf16_t*)(F.ws + WS_HN);
    const bool moe = (l & 1) != 0; const int j = l >> 1;
    const float* gn = FIN(F, I_NORM_FFN) + l * D;
    const float* rt = FIN(F, I_ROUTER) + (size_t)j * D * NEXP; const float* rb = FIN(F, I_RBIAS) + j * NEXP;
    unsigned short* sele = (unsigned short*)(F.ws + MOE_SELE); f32x2* selw = (f32x2*)(F.ws + MOE_SELW);
    if (!moe) { rms_pass_to_bf16(F.out, hn, gw, NGW, F.lane); return; }
    for (int m = gw; m < T; m += NGW) {
        f32x4 v[4]; rms_row_to_bf16(F.out + (size_t)m * D, hn + (size_t)m * D, F.lane, v);
        if (moe) {
            float lg[8];
#pragma unroll
            for (int e = 0; e < 8; ++e) lg[e] = 0.f;
#pragma unroll
            for (int q = 0; q < 4; ++q)
#pragma unroll
                for (int c = 0; c < 4; ++c) { const int k = 256 * q + 4 * F.lane + c; const float h = v[q][c] * gn[k];
                    const f32x4 r0 = *(const f32x4*)(rt + (size_t)k * 8), r1 = *(const f32x4*)(rt + (size_t)k * 8 + 4);
                    lg[0] += h * r0.x; lg[1] += h * r0.y; lg[2] += h * r0.z; lg[3] += h * r0.w; lg[4] += h * r1.x; lg[5] += h * r1.y; lg[6] += h * r1.z; lg[7] += h * r1.w; }
#pragma unroll
            for (int e = 0; e < 8; ++e) lg[e] = wave_sum(lg[e]) + rb[e];
            int e0 = 0; float l0 = lg[0];
#pragma unroll
            for (int e = 1; e < 8; ++e) if (lg[e] > l0) { l0 = lg[e]; e0 = e; }
            int e1 = -1; float l1 = -3.0e38f;
#pragma unroll
            for (int e = 0; e < 8; ++e) if (e != e0 && lg[e] > l1) { l1 = lg[e]; e1 = e; }
            const float w1 = 1.0f / (1.0f + __expf(l0 - l1)), w0 = 1.0f - w1;
            if (F.lane == 0) { sele[m] = (unsigned short)(e0 | (e1 << 8)); selw[m] = (f32x2){w0, w1}; }
        }
    }
}

#define MFMA16(x, y, c) __builtin_amdgcn_mfma_f32_16x16x32_bf16((x), (y), (c), 0, 0, 0)
__device__ __forceinline__ float softplusf_(float x) { return fmaxf(x, 0.f) + log1pf(expf(-fabsf(x))); }
typedef __attribute__((address_space(3))) bf16_t lbf;
constexpr int LDP = 72;
constexpr int SLOT = 64 * LDP * 2;
__device__ __forceinline__ f32x4 unpack4(u32x2 u) { return (f32x4){bf_lo(u.x), bf_hi(u.x), bf_lo(u.y), bf_hi(u.y)}; }
__device__ __forceinline__ u32x2 pack4(f32x4 v) { u32x2 o; o.x = pk2(v[0], v[1]); o.y = pk2(v[2], v[3]); return o; }
__device__ __forceinline__ size_t rwo(int t, int col) { return ((size_t)((t >> 6) * 32 + (col >> 4)) << 10) + (size_t)(((t & 63) << 4) + (col & 15)); }
__device__ __forceinline__ void mm64(const lbf* X, const lbf* Y, int w, int jl, int g, f32x4 (&acc)[2]) {
    const lbf* xr = X + (16 * (w & 3) + jl) * LDP + 8 * g;
    const lbf* yr = Y + (16 * (2 * (w >> 2)) + jl) * LDP + 8 * g;
    const bf16x8 x0 = *(const LAS bf16x8*)xr, x1 = *(const LAS bf16x8*)(xr + 32);
    const bf16x8 y00 = *(const LAS bf16x8*)yr, y01 = *(const LAS bf16x8*)(yr + 32), y10 = *(const LAS bf16x8*)(yr + 16 * LDP), y11 = *(const LAS bf16x8*)(yr + 16 * LDP + 32);
    acc[0] = MFMA16(x0, y00, acc[0]); acc[1] = MFMA16(x0, y10, acc[1]); acc[0] = MFMA16(x1, y01, acc[0]); acc[1] = MFMA16(x1, y11, acc[1]);
}
struct FrX { bf16x8 k0, k1; }; struct FrY { bf16x8 a0, a1, b0, b1; };
__device__ __forceinline__ FrX ldx64(const lbf* X, int w, int jl, int g) { const lbf* xr = X + (16 * (w & 3) + jl) * LDP + 8 * g; FrX f; f.k0 = *(const LAS bf16x8*)xr; f.k1 = *(const LAS bf16x8*)(xr + 32); return f; }
__device__ __forceinline__ FrY ldy64(const lbf* Y, int w, int jl, int g) { const lbf* yr = Y + (16 * (2 * (w >> 2)) + jl) * LDP + 8 * g; FrY f;
    f.a0 = *(const LAS bf16x8*)yr; f.a1 = *(const LAS bf16x8*)(yr + 32); f.b0 = *(const LAS bf16x8*)(yr + 16 * LDP); f.b1 = *(const LAS bf16x8*)(yr + 16 * LDP + 32); return f; }
__device__ __forceinline__ void mma64(const FrX& x, const FrY& y, f32x4 (&acc)[2]) {
    acc[0] = MFMA16(x.k0, y.a0, acc[0]); acc[1] = MFMA16(x.k0, y.b0, acc[1]); acc[0] = MFMA16(x.k1, y.a1, acc[0]); acc[1] = MFMA16(x.k1, y.b1, acc[1]); }
__device__ __forceinline__ void st_t(lbf* dst, const f32x4 (&acc)[2], int w, int jl, int g) {
#pragma unroll
    for (int i = 0; i < 2; ++i) *(LAS u32x2*)(dst + (16 * (2 * (w >> 2) + i) + jl) * LDP + 16 * (w & 3) + 4 * g) = pack4(acc[i]);
}
__device__ __forceinline__ void st_n(lbf* dst, const f32x4 (&acc)[2], int w, int jl, int g) {
#pragma unroll
    for (int i = 0; i < 2; ++i)
#pragma unroll
        for (int r = 0; r < 4; ++r) dst[(16 * (w & 3) + 4 * g + r) * LDP + 16 * (2 * (w >> 2) + i) + jl] = f2bf(acc[i][r]);
}
#define ZACC(a) do { a[0] = (f32x4){0.f, 0.f, 0.f, 0.f}; a[1] = (f32x4){0.f, 0.f, 0.f, 0.f}; } while (0)

constexpr int XA_LD = 264, XV_LD = 520, VM_LD = 40;
__device__ __forceinline__ void ph_rwkv_pre(Frame& F, int l, int half) {
    lbf* XA = (lbf*)F.lds;
    lbf* XV = (lbf*)(F.lds + 64 * XA_LD * 2);
    lbf* VM = (lbf*)(F.lds + 64 * XA_LD * 2 + 64 * XV_LD * 2);
    const bf16_t* CA = (const bf16_t*)(F.ws + MX_CA);
    bf16_t* RW = (bf16_t*)(F.ws + MX_RW); constexpr size_t AS_ = (size_t)TH * 512;
    bf16_t* VF = (bf16_t*)(F.ws + WS_VFIRST) + (size_t)half * TH * 512;
    const bf16_t* W2T = (const bf16_t*)(F.ws + W_RW2); const bf16_t* A2T = (const bf16_t*)(F.ws + W_RA2); const bf16_t* G2T = (const bf16_t*)(F.ws + W_RG2);
    const bf16_t* V1T = (const bf16_t*)(F.ws + W_RV1); const bf16_t* V2T = (const bf16_t*)(F.ws + W_RV2);
    const float* mu = FIN(F, I_MU) + l * RW_COLS;
    const int lane = F.lane, w = F.wave, jl = lane & 15, g = lane >> 4;
    for (int tile = F.bid; tile < TH / 64; tile += F.G) {
        const int t0 = tile * 64;
        lds_barrier();
        for (int it = F.tid; it < 64 * 32; it += NTHR) { const int i = it >> 5, c = 1536 + (it & 31) * 8; const int t = t0 + i;
            const u32x4 cu = *(const u32x4*)(CA + (size_t)t * RW_COLS + c);
            u32x4 pv = (u32x4){0u, 0u, 0u, 0u}; if ((t & (SEQ - 1)) != 0) pv = *(const u32x4*)(CA + (size_t)(t - 1) * RW_COLS + c);
            const float cv[8] = { bf_lo(cu.x), bf_hi(cu.x), bf_lo(cu.y), bf_hi(cu.y), bf_lo(cu.z), bf_hi(cu.z), bf_lo(cu.w), bf_hi(cu.w) };
            const float pp[8] = { bf_lo(pv.x), bf_hi(pv.x), bf_lo(pv.y), bf_hi(pv.y), bf_lo(pv.z), bf_hi(pv.z), bf_lo(pv.w), bf_hi(pv.w) };
            float x[8];
#pragma unroll
            for (int q = 0; q < 8; ++q) { x[q] = cv[q] + (pp[q] - cv[q]) * mu[c + q]; if (c < 1600) x[q] = 1.0f - 2.0f * __builtin_amdgcn_rcpf(1.0f + __expf(2.0f * x[q])); else if (c >= 1664) x[q] = sigmoidf_(x[q]); }
            u32x4 o; o.x = pk2(x[0], x[1]); o.y = pk2(x[2], x[3]); o.z = pk2(x[4], x[5]); o.w = pk2(x[6], x[7]);
            *(LAS u32x4*)(XA + i * XA_LD + (c - 1536)) = o; }
        if (l) for (int it = F.tid; it < 64 * 64; it += NTHR) { const int i = it >> 6, c = 1024 + (it & 63) * 8; const int t = t0 + i;
            const u32x4 cu = *(const u32x4*)(CA + (size_t)t * RW_COLS + c);
            u32x4 pv = (u32x4){0u, 0u, 0u, 0u}; if ((t & (SEQ - 1)) != 0) pv = *(const u32x4*)(CA + (size_t)(t - 1) * RW_COLS + c);
            const float cv[8] = { bf_lo(cu.x), bf_hi(cu.x), bf_lo(cu.y), bf_hi(cu.y), bf_lo(cu.z), bf_hi(cu.z), bf_lo(cu.w), bf_hi(cu.w) };
            const float pp[8] = { bf_lo(pv.x), bf_hi(pv.x), bf_lo(pv.y), bf_hi(pv.y), bf_lo(pv.z), bf_hi(pv.z), bf_lo(pv.w), bf_hi(pv.w) };
            float x[8];
#pragma unroll
            for (int q = 0; q < 8; ++q) x[q] = cv[q] + (pp[q] - cv[q]) * mu[c + q];
            u32x4 o; o.x = pk2(x[0], x[1]); o.y = pk2(x[2], x[3]); o.z = pk2(x[4], x[5]); o.w = pk2(x[6], x[7]);
            *(LAS u32x4*)(XV + i * XV_LD + (c - 1024)) = o; }
        lds_barrier();
        if (l) { const int tg = w & 3, nt = w >> 2; f32x4 a = (f32x4){0.f, 0.f, 0.f, 0.f};
            const bf16_t* xr = V1T + (size_t)(16 * nt + jl) * 512 + 8 * g; const lbf* yr = XV + (16 * tg + jl) * XV_LD + 8 * g;
#pragma unroll 4
            for (int s = 0; s < 16; ++s) a = MFMA16(*(const bf16x8*)(xr + 32 * s), *(const LAS bf16x8*)(yr + 32 * s), a);
            *(LAS u32x2*)(VM + (16 * tg + jl) * VM_LD + 16 * nt + 4 * g) = pack4(a); }
        lds_barrier();
        { bf16_t* XAG = RW + 0 * AS_; bf16_t* VMG = RW + 2 * AS_;
#pragma unroll
          for (int i = 0; i < 4; ++i) { const int id = F.tid + NTHR * i, row = id >> 5, c16 = id & 31; *(u32x4*)(XAG + (size_t)(t0 + row) * 256 + 8 * c16) = *(const LAS u32x4*)(XA + row * XA_LD + 8 * c16); }
          if (l && F.tid < 256) { const int row = F.tid >> 2, c8 = F.tid & 3; *(u32x4*)(VMG + (size_t)(t0 + row) * 32 + 8 * c8) = *(const LAS u32x4*)(VM + row * VM_LD + 8 * c8); } }
    }
}

__device__ __forceinline__ void ph_rwkv_s1(Frame& F, int l, int half) {
    bf16_t* RW = (bf16_t*)(F.ws + MX_RW); constexpr size_t AS_ = (size_t)TH * 512;
    float* BSW = (float*)(F.ws + MX_BS); const float* rkw = FIN(F, I_RK) + l * 512;
    bf16_t* YH = (bf16_t*)(F.ws + MX_CA);
    LAS unsigned char* L = F.lds;
#define SL(i) ((lbf*)(L + (i) * SLOT))
    lbf *AT = SL(0), *BT = SL(1), *KT = SL(2), *RT = SL(3), *ATt = SL(4), *Vt = SL(5), *BPt = SL(6), *KPt = SL(7), *AAK = SL(10), *ARB = SL(11), *ARK = SL(12);
    LAS float* EL = (LAS float*)(L + 8 * SLOT);
    LAS float* SEGT = (LAS float*)(L + 10 * SLOT);
    LAS float* PC = (LAS float*)(L + 16 * SLOT);
    const int lane = F.lane, w = F.wave, jl = lane & 15, g = lane >> 4;
    const int tok = F.tid >> 3, cg = F.tid & 7;
    const bf16_t* CA = (const bf16_t*)(F.ws + MX_CA); bf16_t* VF = (bf16_t*)(F.ws + WS_VFIRST) + (size_t)half * TH * 512;
    const bf16_t* XAG = RW + 0 * AS_; const bf16_t* VMG = RW + 2 * AS_;
    const bf16_t* W2T = (const bf16_t*)(F.ws + W_RW2); const bf16_t* A2T = (const bf16_t*)(F.ws + W_RA2); const bf16_t* G2T = (const bf16_t*)(F.ws + W_RG2); const bf16_t* V2T = (const bf16_t*)(F.ws + W_RV2);
    const float* mu = FIN(F, I_MU) + l * RW_COLS;
    lbf* XAs = (lbf*)L; lbf* VMs = SL(4);
    const int h = F.bid & 7, nt = w & 3, n0 = 64 * h + 16 * nt, n = n0 + 4 * g;
    LAS float* PRM = (LAS float*)(L + 16 * SLOT + 256);
    lds_barrier();
    { const int a_ = F.tid >> 6, c_ = F.tid & 63, col = 64 * h + c_; float v_ = 0.f;
      if (a_ < 3) v_ = mu[512 * a_ + col]; else if (a_ == 3) v_ = FIN(F, I_W0)[l * 512 + col]; else if (a_ == 4) v_ = FIN(F, I_A0)[l * 512 + col]; else if (a_ == 5) v_ = FIN(F, I_KK)[l * 512 + col];
      else if (a_ == 6) v_ = FIN(F, I_KA)[l * 512 + col]; else if (l) v_ = FIN(F, I_V0)[(l - 1) * 512 + col];
      PRM[F.tid] = v_; }
    u32x4 cxa[4]; u32x2 cvm = (u32x2){0u, 0u}; u32x2 crc[2], ckc[2], cvc[2], crp[2], ckp[2], cvp[2], cvf[2]; bf16x8 xw[2], xa[2], xg[4], xm = {0, 0, 0, 0, 0, 0, 0, 0};
#define A0_LOAD(u_) do { const int uu_ = (u_) < (TH / 64) * 8 ? (u_) : F.bid; const int tz_ = (uu_ >> 3) * 64; \
        _Pragma("unroll") for (int i = 0; i < 4; ++i) { const int id = F.tid + NTHR * i; cxa[i] = *(const u32x4*)(XAG + (size_t)(tz_ + (id >> 5)) * 256 + 8 * (id & 31)); } \
        if (l) cvm = *(const u32x2*)(VMG + (size_t)(tz_ + (F.tid >> 3)) * 32 + 4 * (F.tid & 7)); \
        _Pragma("unroll") for (int tgi = 0; tgi < 2; ++tgi) { const int t_ = tz_ + 16 * (2 * (w >> 2) + tgi) + jl; const bf16_t* cr_ = CA + (size_t)t_ * RW_COLS + n; const bool hp_ = (t_ & (SEQ - 1)) != 0; \
            crc[tgi] = *(const u32x2*)cr_; ckc[tgi] = *(const u32x2*)(cr_ + 512); cvc[tgi] = *(const u32x2*)(cr_ + 1024); crp[tgi] = (u32x2){0u, 0u}; ckp[tgi] = crp[tgi]; cvp[tgi] = crp[tgi]; cvf[tgi] = crp[tgi]; \
            if (hp_) { crp[tgi] = *(const u32x2*)(cr_ - RW_COLS); ckp[tgi] = *(const u32x2*)(cr_ - RW_COLS + 512); cvp[tgi] = *(const u32x2*)(cr_ - RW_COLS + 1024); } \
            if (l) cvf[tgi] = *(const u32x2*)(VF + rwo(t_, n)); } } while (0)
#define A0_LOADX() do { \
        { const bf16_t* pw = W2T + (size_t)(n0 + jl) * 64 + 8 * g; const bf16_t* pa = A2T + (size_t)(n0 + jl) * 64 + 8 * g; const bf16_t* pg = G2T + (size_t)(n0 + jl) * 128 + 8 * g; \
          _Pragma("unroll") for (int s2 = 0; s2 < 2; ++s2) { xw[s2] = *(const bf16x8*)(pw + 32 * s2); xa[s2] = *(const bf16x8*)(pa + 32 * s2); } \
          _Pragma("unroll") for (int s2 = 0; s2 < 4; ++s2) xg[s2] = *(const bf16x8*)(pg + 32 * s2); \
          if (l) xm = *(const bf16x8*)(V2T + (size_t)(n0 + jl) * 32 + 8 * g); } } while (0)
    A0_LOAD(F.bid); A0_LOADX();
    for (int u = F.bid; u < (TH / 64) * 8; u += F.G) {
        const int ch = u >> 3, t0 = ch * 64;
        lds_barrier();
#pragma unroll
        for (int i = 0; i < 4; ++i) { const int id = F.tid + NTHR * i; *(LAS u32x4*)(XAs + (id >> 5) * XA_LD + 8 * (id & 31)) = cxa[i]; }
        if (l) *(LAS u32x2*)(VMs + (F.tid >> 3) * VM_LD + 4 * (F.tid & 7)) = cvm;
        lds_barrier();
        {
            const LAS f32x4* pp_ = (const LAS f32x4*)(PRM + 16 * nt + 4 * g);
            const f32x4 mr = pp_[0], mk = pp_[16], mv = pp_[32], w0 = pp_[48], a0 = pp_[64], kkw = pp_[80], ka = pp_[96], v0 = pp_[112];
#pragma unroll
            for (int tgi = 0; tgi < 2; ++tgi) {
                const int tl = 16 * (2 * (w >> 2) + tgi) + jl, t = t0 + tl;
                const f32x4 rc = unpack4(crc[tgi]), kc = unpack4(ckc[tgi]), vc = unpack4(cvc[tgi]), rp = unpack4(crp[tgi]), kp = unpack4(ckp[tgi]), vp = unpack4(cvp[tgi]), vf = unpack4(cvf[tgi]);
                const size_t o = rwo(t, n);
                const lbf* ya = XAs + tl * XA_LD + 8 * g;
                bf16x8 yf[9];
#pragma unroll
                for (int s2 = 0; s2 < 8; ++s2) yf[s2] = *(const LAS bf16x8*)(ya + 32 * s2);
                yf[8] = *(const LAS bf16x8*)(VMs + tl * VM_LD + 8 * g);
                f32x4 aw = (f32x4){0.f, 0.f, 0.f, 0.f}, aa = aw, ag = aw, am = aw;
#pragma unroll
                for (int s2 = 0; s2 < 2; ++s2) { aw = MFMA16(xw[s2], yf[s2], aw); aa = MFMA16(xa[s2], yf[2 + s2], aa); }
#pragma unroll
                for (int s2 = 0; s2 < 4; ++s2) ag = MFMA16(xg[s2], yf[4 + s2], ag);
                if (l) am = MFMA16(xm, yf[8], am);
                const f32x4 r4 = rc + (rp - rc) * mr, k4 = kc + (kp - kc) * mk; f32x4 v4 = vc + (vp - vc) * mv;
                if (l) {
#pragma unroll
                    for (int q = 0; q < 4; ++q) v4[q] = v4[q] + (vf[q] - v4[q]) * sigmoidf_(v0[q] + am[q]); }
                else *(u32x2*)(VF + o) = pack4(v4);
                f32x4 e4, as4, k24, kk4;
#pragma unroll
                for (int q = 0; q < 4; ++q) { const float a = sigmoidf_(a0[q] + aa[q]); as4[q] = a; k24[q] = k4[q] * (1.0f + (a - 1.0f) * ka[q]);
                    e4[q] = 0.6065306597f * sigmoidf_(w0[q] + aw[q]);
                    kk4[q] = k4[q] * kkw[q]; }
                const int lo_ = tl * LDP + 16 * nt + 4 * g;
                *(LAS u32x2*)(SL(10) + lo_) = pack4(r4); *(LAS u32x2*)(SL(11) + lo_) = pack4(e4); *(LAS u32x2*)(SL(12) + lo_) = pack4(k24); *(LAS u32x2*)(SL(13) + lo_) = pack4(v4);
                *(LAS u32x2*)(SL(14) + lo_) = pack4(kk4); *(LAS u32x2*)(SL(15) + lo_) = pack4(as4);
                *(u32x2*)(RW + 3 * AS_ + o) = pack4(v4); *(u32x2*)(RW + 6 * AS_ + o) = pack4(ag);
                __builtin_amdgcn_sched_barrier(0);
            }
        }
        lds_barrier();
        const int lt_ = tok * LDP + 8 * cg;
        const u32x4 ur = *(const LAS u32x4*)(SL(10) + lt_), ue = *(const LAS u32x4*)(SL(11) + lt_), uk = *(const LAS u32x4*)(SL(12) + lt_), uv = *(const LAS u32x4*)(SL(13) + lt_),
                    ukk = *(const LAS u32x4*)(SL(14) + lt_), uas = *(const LAS u32x4*)(SL(15) + lt_);
        const float e8[8] = { bf_lo(ue.x), bf_hi(ue.x), bf_lo(ue.y), bf_hi(ue.y), bf_lo(ue.z), bf_hi(ue.z), bf_lo(ue.w), bf_hi(ue.w) };
#pragma unroll
        for (int i = 0; i < 8; ++i) EL[tok * 65 + 8 * cg + i] = e8[i];
        lds_barrier();
        { const int col = F.tid & 63, seg = F.tid >> 6; float p[8]; float run = 0.f;
#pragma unroll
          for (int i = 0; i < 8; ++i) { run += EL[(8 * seg + i) * 65 + col]; p[i] = run; }
          SEGT[seg * 64 + col] = run;
          lds_barrier();
          float off = 0.f; for (int s = 0; s < seg; ++s) off += SEGT[s * 64 + col];
#pragma unroll
          for (int i = 0; i < 8; ++i) EL[(8 * seg + i) * 65 + col] = -(off + p[i]); }
        lds_barrier();
        {
            const float r8[8] = { bf_lo(ur.x), bf_hi(ur.x), bf_lo(ur.y), bf_hi(ur.y), bf_lo(ur.z), bf_hi(ur.z), bf_lo(ur.w), bf_hi(ur.w) };
            const float k8[8] = { bf_lo(uk.x), bf_hi(uk.x), bf_lo(uk.y), bf_hi(uk.y), bf_lo(uk.z), bf_hi(uk.z), bf_lo(uk.w), bf_hi(uk.w) };
            float kk8[8] = { bf_lo(ukk.x), bf_hi(ukk.x), bf_lo(ukk.y), bf_hi(ukk.y), bf_lo(ukk.z), bf_hi(ukk.z), bf_lo(ukk.w), bf_hi(ukk.w) };
            { float ss = 0.f;
#pragma unroll
              for (int i = 0; i < 8; ++i) ss += kk8[i] * kk8[i];
              ss += __shfl_xor(ss, 1); ss += __shfl_xor(ss, 2); ss += __shfl_xor(ss, 4);
              const float inv = 1.0f / fmaxf(sqrtf(ss), 1e-12f);
#pragma unroll
              for (int i = 0; i < 8; ++i) kk8[i] *= inv; }
            const float as8[8] = { bf_lo(uas.x), bf_hi(uas.x), bf_lo(uas.y), bf_hi(uas.y), bf_lo(uas.z), bf_hi(uas.z), bf_lo(uas.w), bf_hi(uas.w) };
            const unsigned short v8[8] = { (unsigned short)(uv.x & 0xffffu), (unsigned short)(uv.x >> 16), (unsigned short)(uv.y & 0xffffu), (unsigned short)(uv.y >> 16),
                                           (unsigned short)(uv.z & 0xffffu), (unsigned short)(uv.z >> 16), (unsigned short)(uv.w & 0xffffu), (unsigned short)(uv.w >> 16) };
            { const float* rkp = rkw + h * 64 + 8 * cg; float b = 0.f;
#pragma unroll
              for (int i = 0; i < 8; ++i) b += r8[i] * k8[i] * rkp[i];
              b += __shfl_xor(b, 1); b += __shfl_xor(b, 2); b += __shfl_xor(b, 4);
              if (cg == 0) BSW[(size_t)(t0 + tok) * 8 + h] = b; }
            float at[8], bt[8], kt[8], rt[8], bp[8], kp[8];
#pragma unroll
            for (int i = 0; i < 8; ++i) { const float cl = EL[tok * 65 + 8 * cg + i], pc = __expf(EL[63 * 65 + 8 * cg + i]);
                const float ecl = __expf(cl), eicl = __expf(-cl);
                at[i] = -kk8[i] * __expf(cl + e8[i]); bt[i] = kk8[i] * as8[i] * eicl; kt[i] = k8[i] * eicl; rt[i] = r8[i] * ecl; bp[i] = bt[i] * pc; kp[i] = kt[i] * pc;
                if (tok == 0) PC[8 * cg + i] = pc; }
            u32x4 o;
            o.x = pk2(at[0], at[1]); o.y = pk2(at[2], at[3]); o.z = pk2(at[4], at[5]); o.w = pk2(at[6], at[7]); *(LAS u32x4*)(AT + tok * LDP + 8 * cg) = o;
            o.x = pk2(bt[0], bt[1]); o.y = pk2(bt[2], bt[3]); o.z = pk2(bt[4], bt[5]); o.w = pk2(bt[6], bt[7]); *(LAS u32x4*)(BT + tok * LDP + 8 * cg) = o;
            o.x = pk2(kt[0], kt[1]); o.y = pk2(kt[2], kt[3]); o.z = pk2(kt[4], kt[5]); o.w = pk2(kt[6], kt[7]); *(LAS u32x4*)(KT + tok * LDP + 8 * cg) = o;
            o.x = pk2(rt[0], rt[1]); o.y = pk2(rt[2], rt[3]); o.z = pk2(rt[4], rt[5]); o.w = pk2(rt[6], rt[7]); *(LAS u32x4*)(RT + tok * LDP + 8 * cg) = o;
#pragma unroll
            for (int i = 0; i < 8; ++i) { const int c = 8 * cg + i; ATt[c * LDP + tok] = f2bf(at[i]); Vt[c * LDP + tok] = v8[i]; BPt[c * LDP + tok] = f2bf(bp[i]); KPt[c * LDP + tok] = f2bf(kp[i]); }
        }
        lds_barrier();
        {
            const FrX xb = ldx64(BT, w, jl, g), xk = ldx64(KT, w, jl, g); const FrY ya = ldy64(AT, w, jl, g), yr_ = ldy64(RT, w, jl, g);
            f32x4 a1[2], a2[2], a3[2], a4[2]; ZACC(a1); ZACC(a2); ZACC(a3); ZACC(a4);
            mma64(xb, ya, a1); mma64(xk, ya, a2); mma64(xb, yr_, a3); mma64(xk, yr_, a4);
            const int s0 = 16 * (w & 3) + 4 * g;
            f32x4 b[2];
#pragma unroll
            for (int i = 0; i < 2; ++i) { const int t = 16 * (2 * (w >> 2) + i) + jl;
#pragma unroll
                for (int r = 0; r < 4; ++r) { const bool lt = s0 + r < t, le = s0 + r <= t; if (!lt) { a1[i][r] = 0.f; a2[i][r] = 0.f; } if (!le) { a3[i][r] = 0.f; a4[i][r] = 0.f; } b[i][r] = (s0 + r == t) ? 1.0f : a1[i][r]; } }
            st_t(SL(8), a1, w, jl, g); st_n(SL(9), a1, w, jl, g);
            st_t(SL(13), b, w, jl, g); st_n(SL(14), b, w, jl, g);
            st_t(AAK, a2, w, jl, g); st_t(ARB, a3, w, jl, g); st_t(ARK, a4, w, jl, g);
        }
        lds_barrier();
#define NEU_B(srcB, srcBt, dstB, dstBt) do { f32x4 a[2]; ZACC(a); mm64(SL(srcB), SL(srcBt), w, jl, g, a); st_t(SL(dstBt), a, w, jl, g); st_n(SL(dstB), a, w, jl, g); } while (0)
#define NEU_TB(srcT, srcTt, srcB, srcBt, dstT, dstTt, dstB, dstBt) do { f32x4 at[2], ab[2]; ZACC(ab); \
            const FrX xt_ = ldx64(SL(srcT), w, jl, g), xb_ = ldx64(SL(srcB), w, jl, g); const FrY yb_ = ldy64(SL(srcBt), w, jl, g); \
            _Pragma("unroll") for (int i = 0; i < 2; ++i) at[i] = unpack4(*(const LAS u32x2*)(SL(srcTt) + (16 * (2 * (w >> 2) + i) + jl) * LDP + 16 * (w & 3) + 4 * g)); \
            mma64(xt_, yb_, at); mma64(xb_, yb_, ab); \
            st_t(SL(dstTt), at, w, jl, g); st_n(SL(dstT), at, w, jl, g); st_t(SL(dstBt), ab, w, jl, g); st_n(SL(dstB), ab, w, jl, g); } while (0)
#define NEU_T(srcT, srcTt, srcBt, dstT, dstTt, last) do { f32x4 a[2]; \
            _Pragma("unroll") for (int i = 0; i < 2; ++i) a[i] = unpack4(*(const LAS u32x2*)(SL(srcTt) + (16 * (2 * (w >> 2) + i) + jl) * LDP + 16 * (w & 3) + 4 * g)); \
            mm64(SL(srcT), SL(srcBt), w, jl, g, a); if (!(last)) st_t(SL(dstTt), a, w, jl, g); st_n(SL(dstT), a, w, jl, g); } while (0)
        NEU_B(8, 9, 0, 1);                                   lds_barrier();
        NEU_TB(13, 14, 0, 1, 15, 2, 8, 9);                   lds_barrier();
        NEU_TB(15, 2, 8, 9, 13, 14, 0, 1);                   lds_barrier();
        NEU_TB(13, 14, 0, 1, 15, 2, 8, 9);                   lds_barrier();
        NEU_TB(15, 2, 8, 9, 13, 14, 0, 1);                   lds_barrier();
        NEU_T(13, 14, 1, 15, 2, true);                       lds_barrier();
        lbf* TI = SL(15); lbf* Wt = SL(8); lbf* Xt = SL(9); lbf* Ut = SL(0);
        {
            const FrX x1 = ldx64(TI, w, jl, g), x2 = ldx64(AAK, w, jl, g); const FrY y1 = ldy64(ATt, w, jl, g), y2 = ldy64(Vt, w, jl, g);
            f32x4 a[2], b[2]; ZACC(a); ZACC(b); mma64(x1, y1, a); mma64(x2, y2, b); st_t(Wt, a, w, jl, g); st_t(Xt, b, w, jl, g); }
        lds_barrier();
        A0_LOAD(u + F.G); asm volatile("" ::: "memory");
        {
            const FrX xti = ldx64(TI, w, jl, g), xw = ldx64(Wt, w, jl, g); const FrY yx = ldy64(Xt, w, jl, g), yar = ldy64(ARB, w, jl, g), ybp = ldy64(BPt, w, jl, g);
            f32x4 rr[2]; float pcv[2];
#pragma unroll
            for (int i = 0; i < 2; ++i) { const int t = 16 * (2 * (w >> 2) + i) + jl; rr[i] = unpack4(*(const LAS u32x2*)(RT + t * LDP + 16 * (w & 3) + 4 * g)); pcv[i] = PC[t]; }
            f32x4 au[2], ar[2], am[2]; ZACC(au); ZACC(ar); ZACC(am);
            mma64(xti, yx, au); mma64(xw, yar, ar); mma64(xw, ybp, am);
            st_t(Ut, au, w, jl, g);
#pragma unroll
            for (int i = 0; i < 2; ++i) { const int t = 16 * (2 * (w >> 2) + i) + jl, k0 = 16 * (w & 3) + 4 * g;
                *(u32x2*)(RW + 5 * AS_ + rwo(t0 + t, h * 64 + k0)) = pack4(ar[i] + rr[i]);
#pragma unroll
                for (int r = 0; r < 4; ++r) if (k0 + r == t) am[i][r] += pcv[i];
                *(u32x2*)(RW + 4 * AS_ + rwo(t0 + t, h * 64 + k0)) = pack4(am[i]); }
        }
        lds_barrier();
        {
            A0_LOADX(); asm volatile("" ::: "memory");
            f32x4 ay[2], an[2]; ZACC(ay); ZACC(an);
            { const FrX xu = ldx64(Ut, w, jl, g), xbp = ldx64(BPt, w, jl, g); const FrY yar = ldy64(ARB, w, jl, g), yu = ldy64(Ut, w, jl, g); mma64(xu, yar, ay); mma64(xbp, yu, an); }
            { const FrX xv = ldx64(Vt, w, jl, g), xkp = ldx64(KPt, w, jl, g); const FrY yak = ldy64(ARK, w, jl, g), yv = ldy64(Vt, w, jl, g); mma64(xv, yak, ay); mma64(xkp, yv, an); }
#pragma unroll
            for (int i = 0; i < 2; ++i) { const int t = 16 * (2 * (w >> 2) + i) + jl, c0 = 16 * (w & 3) + 4 * g;
                *(u32x2*)(YH + rwo(t0 + t, h * 64 + c0)) = pack4(ay[i]);
                *(u32x2*)(RW + 1 * AS_ + rwo(t0 + t, h * 64 + c0)) = pack4(an[i]); }
        }
    }
#undef A0_LOAD
#undef A0_LOADX
#undef SL
#undef NEU_B
#undef NEU_T
#undef NEU_TB
}

__device__ __forceinline__ void ph_rwkv_s2(Frame& F, int l, int pair) {
    const int bl = pair >> 3, h = pair & 7;
    const bf16_t* RW = (const bf16_t*)(F.ws + MX_RW); constexpr size_t AS_ = (size_t)TH * 512;
    const bf16_t* YH = (const bf16_t*)(F.ws + MX_CA); bf16_t* YA = (bf16_t*)(F.ws + MX_CA) + AS_;
    lbf* HT = (lbf*)F.lds;
    const int lane = F.lane, w = F.wave, jl = lane & 15, g = lane >> 4;
    lds_barrier();
    for (int i = F.tid; i < 64 * LDP / 2; i += NTHR) ((LAS unsigned*)HT)[i] = 0u;
    if (F.tid < 128) ((LAS float*)(F.lds + SLOT))[F.tid] = (F.tid < 64 ? FIN(F, I_LNG) : FIN(F, I_LNB))[l * 512 + h * 64 + (F.tid & 63)];
    lds_barrier();
    if (w < 4) {
        bf16x8 m0[4], m1[4]; u32x2 nn[4][4];
#define S2A_LOAD(j, c) do { const int cc_ = (c) < SEQ / 64 ? (c) : SEQ / 64 - 1; const int tb_ = bl * SEQ + cc_ * 64; \
        m0[j] = *(const bf16x8*)(RW + 4 * AS_ + rwo(tb_ + 16 * w + jl, h * 64 + 8 * g)); m1[j] = *(const bf16x8*)(RW + 4 * AS_ + rwo(tb_ + 16 * w + jl, h * 64 + 32 + 8 * g)); \
        _Pragma("unroll") for (int yt = 0; yt < 4; ++yt) nn[j][yt] = *(const u32x2*)(RW + 1 * AS_ + rwo(tb_ + 16 * yt + jl, h * 64 + 16 * w + 4 * g)); } while (0)
        S2A_LOAD(0, 0); S2A_LOAD(1, 1); S2A_LOAD(2, 2);
#pragma unroll 1
        for (int c4 = 0; c4 < SEQ / 64; c4 += 4) {
#pragma unroll
            for (int j = 0; j < 4; ++j) {
                asm volatile("" : "+v"(m0[j]), "+v"(m1[j]));
#pragma unroll
                for (int yt = 0; yt < 4; ++yt) asm volatile("" : "+v"(nn[j][yt]));
                S2A_LOAD((j + 3) & 3, c4 + j + 3);
                asm volatile("" ::: "memory");
                f32x4 a[4]; bf16x8 hf[4][2];
#pragma unroll
                for (int yt = 0; yt < 4; ++yt) { const lbf* yr = HT + (16 * yt + jl) * LDP + 8 * g; hf[yt][0] = *(const LAS bf16x8*)yr; hf[yt][1] = *(const LAS bf16x8*)(yr + 32); a[yt] = unpack4(nn[j][yt]); }
#pragma unroll
                for (int yt = 0; yt < 4; ++yt) a[yt] = MFMA16(m0[j], hf[yt][0], a[yt]);
#pragma unroll
                for (int yt = 0; yt < 4; ++yt) a[yt] = MFMA16(m1[j], hf[yt][1], a[yt]);
                lds_barrier();
#pragma unroll
                for (int yt = 0; yt < 4; ++yt) *(LAS u32x2*)(HT + (16 * yt + jl) * LDP + 16 * w + 4 * g) = pack4(a[yt]);
                lds_barrier();
            }
        }
#undef S2A_LOAD
    } else {
        const int wt = w - 4;
        const LAS float* lgl = (const LAS float*)(F.lds + SLOT) + 4 * g; const LAS float* lbl = lgl + 64;
        lbf* ystg = (lbf*)(F.lds + 2 * SLOT) + wt * 16 * LDP;
        const float* bsp = (const float*)(F.ws + MX_BS) + (size_t)(bl * SEQ + 16 * wt + jl) * 8 + h;
        bf16x8 r0[4], r1[4]; u32x2 yh[4][4], uv[4][4], ug[4][4]; float bsv[4];
#define S2B_LOAD(j, c) do { const int cc_ = (c) < SEQ / 64 ? (c) : SEQ / 64 - 1; const int tk_ = bl * SEQ + cc_ * 64 + 16 * wt + jl; \
        r0[j] = *(const bf16x8*)(RW + 5 * AS_ + rwo(tk_, h * 64 + 8 * g)); r1[j] = *(const bf16x8*)(RW + 5 * AS_ + rwo(tk_, h * 64 + 32 + 8 * g)); \
        bsv[j] = bsp[(size_t)(cc_ * 64) * 8]; \
        _Pragma("unroll") for (int xt = 0; xt < 4; ++xt) { yh[j][xt] = *(const u32x2*)(YH + rwo(tk_, h * 64 + 16 * xt + 4 * g)); uv[j][xt] = *(const u32x2*)(RW + 3 * AS_ + rwo(tk_, h * 64 + 16 * xt + 4 * g)); ug[j][xt] = *(const u32x2*)(RW + 6 * AS_ + rwo(tk_, h * 64 + 16 * xt + 4 * g)); } } while (0)
        S2B_LOAD(0, 0); S2B_LOAD(1, 1); S2B_LOAD(2, 2);
#pragma unroll 1
        for (int c4 = 0; c4 < SEQ / 64; c4 += 4) {
#pragma unroll
            for (int j = 0; j < 4; ++j) {
                asm volatile("" : "+v"(r0[j]), "+v"(r1[j]), "+v"(bsv[j]));
#pragma unroll
                for (int xt = 0; xt < 4; ++xt) asm volatile("" : "+v"(yh[j][xt]), "+v"(uv[j][xt]), "+v"(ug[j][xt]));
                S2B_LOAD((j + 3) & 3, c4 + j + 3);
                asm volatile("" ::: "memory");
                f32x4 a[4]; bf16x8 hf[4][2];
#pragma unroll
                for (int xt = 0; xt < 4; ++xt) { const lbf* xr = HT + (16 * xt + jl) * LDP + 8 * g; hf[xt][0] = *(const LAS bf16x8*)xr; hf[xt][1] = *(const LAS bf16x8*)(xr + 32); a[xt] = unpack4(yh[j][xt]); }
#pragma unroll
                for (int xt = 0; xt < 4; ++xt) a[xt] = MFMA16(hf[xt][0], r0[j], a[xt]);
#pragma unroll
                for (int xt = 0; xt < 4; ++xt) a[xt] = MFMA16(hf[xt][1], r1[j], a[xt]);
                lds_barrier();
                float s = 0.f; const float bs = bsv[j];
#pragma unroll
                for (int xt = 0; xt < 4; ++xt)
#pragma unroll
                    for (int r = 0; r < 4; ++r) s += a[xt][r];
                s += __shfl_xor(s, 16); s += __shfl_xor(s, 32);
                const float mean = s * (1.f / 64.f); float q = 0.f;
#pragma unroll
                for (int xt = 0; xt < 4; ++xt)
#pragma unroll
                    for (int r = 0; r < 4; ++r) { const float d = a[xt][r] - mean; q += d * d; }
                q += __shfl_xor(q, 16); q += __shfl_xor(q, 32);
                const float rstd = 1.0f / sqrtf(q * (1.f / 64.f) + 64e-5f);
#pragma unroll
                for (int xt = 0; xt < 4; ++xt) { const f32x4 vv = unpack4(uv[j][xt]), gg = unpack4(ug[j][xt]), lg4 = *(const LAS f32x4*)(lgl + 16 * xt), lb4 = *(const LAS f32x4*)(lbl + 16 * xt); f32x4 o;
#pragma unroll
                    for (int r = 0; r < 4; ++r) o[r] = ((a[xt][r] - mean) * rstd * lg4[r] + lb4[r] + bs * vv[r]) * gg[r];
                    *(LAS u32x2*)(ystg + jl * LDP + 16 * xt + 4 * g) = pack4(o); }
#pragma unroll
                for (int p = 0; p < 2; ++p) { const int rr_ = (lane >> 3) + 8 * p; const u32x4 vrow = *(const LAS u32x4*)(ystg + rr_ * LDP + 8 * (lane & 7));
                    *(u32x4*)(YA + (size_t)(bl * SEQ + (c4 + j) * 64 + 16 * wt + rr_) * 512 + h * 64 + 8 * (lane & 7)) = vrow; }
                lds_barrier();
            }
        }
#undef S2B_LOAD
    }
}

__device__ __forceinline__ void ph_dsa_prep(Frame& F, int l, int half) {
    bf16_t* CB = (bf16_t*)(F.ws + MX_CB); bf16_t* VT = (bf16_t*)(F.ws + MX_VT);
    const int* pos = (const int*)KARGP(F, I_POS) + (size_t)half * TH;
    const int lane = F.lane, j = lane & 7;
    float invf[4]; f32x4 gq[2], gk[2], gik[2];
#pragma unroll
    for (int i = 0; i < 4; ++i) invf[i] = __builtin_amdgcn_exp2f(-(float)(2 * (4 * j + i)) * (13.287712379549449f / 64.0f));
#pragma unroll
    for (int hf = 0; hf < 2; ++hf) { gq[hf] = *(const f32x4*)(FIN(F, I_QN) + l * 64 + 32 * hf + 4 * j); gk[hf] = *(const f32x4*)(FIN(F, I_KN) + l * 64 + 32 * hf + 4 * j); gik[hf] = *(const f32x4*)(FIN(F, I_IKN) + l * 64 + 32 * hf + 4 * j); }
    lbf* vst = (lbf*)F.lds;
    for (int tile = F.bid; tile < TH / 64; tile += F.G) {
        lds_barrier();
#pragma unroll 2
        for (int k8 = 0; k8 < 8; ++k8) {
        const int tk = 8 * F.wave + k8, t = tile * 64 + tk;
        const float p = (float)pos[t];
        f32x4 cs, sn;
#pragma unroll
        for (int i = 0; i < 4; ++i) { float rev = p * invf[i] * 0.15915494309189535f; rev = rev - floorf(rev); cs[i] = __builtin_amdgcn_cosf(rev); sn[i] = __builtin_amdgcn_sinf(rev); }
        bf16_t* row = CB + (size_t)t * DS_PAD;
#pragma unroll
        for (int ps = 0; ps < 3; ++ps) {
            const int vec = 8 * ps + (lane >> 3);
            if (vec < 19) {
                bf16_t* vp = row + vec * 64 + 4 * j;
                const u32x2 u1 = *(const u32x2*)vp, u2 = *(const u32x2*)(vp + 32);
                f32x4 x1 = unpack4(u1), x2 = unpack4(u2);
                if (vec == 9) {
                    vst[(4 * j + 0) * LDP + tk] = (bf16_t)(u1.x & 0xffffu); vst[(4 * j + 1) * LDP + tk] = (bf16_t)(u1.x >> 16); vst[(4 * j + 2) * LDP + tk] = (bf16_t)(u1.y & 0xffffu); vst[(4 * j + 3) * LDP + tk] = (bf16_t)(u1.y >> 16);
                    vst[(32 + 4 * j + 0) * LDP + tk] = (bf16_t)(u2.x & 0xffffu); vst[(32 + 4 * j + 1) * LDP + tk] = (bf16_t)(u2.x >> 16); vst[(32 + 4 * j + 2) * LDP + tk] = (bf16_t)(u2.y & 0xffffu); vst[(32 + 4 * j + 3) * LDP + tk] = (bf16_t)(u2.y >> 16);
                } else {
                    const bool nrm = (vec < 9) || (vec == 18);
                    float ss = (x1[0] * x1[0] + x1[1] * x1[1]) + (x1[2] * x1[2] + x1[3] * x1[3]) + (x2[0] * x2[0] + x2[1] * x2[1]) + (x2[2] * x2[2] + x2[3] * x2[3]);
                    ss += __shfl_xor(ss, 1); ss += __shfl_xor(ss, 2); ss += __shfl_xor(ss, 4);
                    if (nrm) { float rstd = 1.0f / sqrtf(ss * (1.f / 64.f) + 1e-6f); if (vec < 8) rstd *= 0.125f * 1.4426950409f;
                        const f32x4 g1 = vec < 8 ? gq[0] : (vec == 8 ? gk[0] : gik[0]), g2 = vec < 8 ? gq[1] : (vec == 8 ? gk[1] : gik[1]);
                        x1 = x1 * rstd * g1; x2 = x2 * rstd * g2; }
                    const f32x4 o1 = x1 * cs - x2 * sn, o2 = x2 * cs + x1 * sn;
                    *(u32x2*)vp = pack4(o1); *(u32x2*)(vp + 32) = pack4(o2);
                }
            }
        }
        }
        lds_barrier();
        { const int dim = F.tid >> 3, ch = F.tid & 7; const int t0 = tile * 64;
          *(u32x4*)(VT + ((size_t)(t0 >> 11) * 64 + dim) * SEQ + (t0 & (SEQ - 1)) + 8 * ch) = *(const LAS u32x4*)(vst + dim * LDP + 8 * ch); }
    }
}

constexpr int SC_LD = 2052;
__device__ __forceinline__ void lds_inc(LAS unsigned* p) { (void)__hip_atomic_fetch_add(p, 1u, __ATOMIC_RELAXED, __HIP_MEMORY_SCOPE_WORKGROUP); }
__device__ __forceinline__ unsigned okey(float s) { const unsigned u = __builtin_bit_cast(unsigned, s); return (u & 0x80000000u) ? ~u : (u | 0x80000000u); }
__device__ __forceinline__ int hist_find(LAS unsigned* hist, int lane, int& R, int& cnt) {
    const u32x4 c4 = *(const LAS u32x4*)(hist + 4 * lane);
    const unsigned tot = c4.x + c4.y + c4.z + c4.w;
    unsigned suf = tot;
#pragma unroll
    for (int o = 1; o < 64; o <<= 1) { const unsigned v = __shfl_down(suf, o); if (lane + o < 64) suf += v; }
    const unsigned above = suf - tot;
    const bool mine = (above < (unsigned)R) && ((unsigned)R <= suf);
    const unsigned long long bal = __ballot(mine);
    const int src = bal ? (int)__builtin_ctzll(bal) : 0;
    int bin, rr, cc;
    { unsigned a = above; int r_ = R;
      if ((unsigned)r_ <= a + c4.w) { bin = 4 * lane + 3; rr = r_ - (int)a; cc = (int)c4.w; } else { a += c4.w;
      if ((unsigned)r_ <= a + c4.z) { bin = 4 * lane + 2; rr = r_ - (int)a; cc = (int)c4.z; } else { a += c4.z;
      if ((unsigned)r_ <= a + c4.y) { bin = 4 * lane + 1; rr = r_ - (int)a; cc = (int)c4.y; } else { a += c4.y; bin = 4 * lane; rr = r_ - (int)a; cc = (int)c4.x; } } } }
    bin = __shfl(bin, src); rr = __shfl(rr, src); cc = __shfl(cc, src);
    R = rr; cnt = cc; return bin;
}
__device__ __forceinline__ void ph_dsa(Frame& F, int half, unsigned* qctr) {
    const bf16_t* CB = (const bf16_t*)(F.ws + MX_CB); const bf16_t* VT = (const bf16_t*)(F.ws + MX_VT);
    bf16_t* YB = (bf16_t*)(F.ws + MX_YB);
    LAS float* sc = (LAS float*)F.lds;
    LAS unsigned* hist = (LAS unsigned*)(F.lds + 16 * SC_LD * 4);
    LAS unsigned* msk = (LAS unsigned*)(F.lds + 16 * SC_LD * 4 + 16 * 256 * 4);
    lbf* KB = (lbf*)F.lds;
    lbf* VB = (lbf*)(F.lds + 2 * SLOT);
    const int lane = F.lane, w = F.wave, jl = lane & 15, g = lane >> 4;
    const int srow = F.tid >> 3, sseg = F.tid & 7;
    volatile LAS unsigned* qslot = (volatile LAS unsigned*)(F.lds + LDS_MISC + 64);
    for (;;) {
        if (F.tid == 0) *qslot = __hip_atomic_fetch_add(qctr, 1u, __ATOMIC_RELAXED, __HIP_MEMORY_SCOPE_AGENT);
        lds_barrier();
        const int ui = (int)*qslot; if (ui >= TH / 16) break;
        const int bl = ui & 15, q0 = (127 - (ui >> 4)) * 16, L = ((q0 >> 6) + 1) * 64;
        const int rowb = bl * SEQ;
        if (L > 256) for (int i = F.tid; i < 16 * 256; i += NTHR) hist[i] = 0u;
        lds_barrier();
        {
            bf16x8 yq[8][2]; float iw[8];
            const bf16_t* qrow = CB + (size_t)(rowb + q0 + jl) * DS_PAD;
#pragma unroll
            for (int h = 0; h < 8; ++h) { iw[h] = bf2f(qrow[1216 + h]);
#pragma unroll
                for (int s = 0; s < 2; ++s) yq[h][s] = *(const bf16x8*)(qrow + 640 + h * 64 + 32 * s + 8 * g); }
            const int nk = L / 16;
            const bf16_t* kbase = CB + (size_t)(rowb + jl) * DS_PAD + 1152 + 8 * g;
            bf16x8 x0 = {0, 0, 0, 0, 0, 0, 0, 0}, x1 = x0;
            if (w < nk) { const bf16_t* kr = kbase + (size_t)(w * 16) * DS_PAD; x0 = *(const bf16x8*)kr; x1 = *(const bf16x8*)(kr + 32); }
            for (int kt = w; kt < nk; kt += 8) {
                bf16x8 n0 = x0, n1 = x1;
                if (kt + 8 < nk) { const bf16_t* kr = kbase + (size_t)((kt + 8) * 16) * DS_PAD; n0 = *(const bf16x8*)kr; n1 = *(const bf16x8*)(kr + 32); }
                f32x4 s4 = (f32x4){0.f, 0.f, 0.f, 0.f};
#pragma unroll
                for (int h = 0; h < 8; ++h) { f32x4 a = (f32x4){0.f, 0.f, 0.f, 0.f}; a = MFMA16(x0, yq[h][0], a); a = MFMA16(x1, yq[h][1], a);
#pragma unroll
                    for (int r = 0; r < 4; ++r) s4[r] += iw[h] * fmaxf(a[r], 0.f); }
                *(LAS f32x4*)(sc + jl * SC_LD + kt * 16 + 4 * g) = s4;
                if (L > 256) {
#pragma unroll
                    for (int r = 0; r < 4; ++r) lds_inc(hist + jl * 256 + (okey(s4[r]) >> 24)); }
                x0 = n0; x1 = n1;
            }
        }
        lds_barrier();
        for (int qi = 0; qi < 2; ++qi) {
            const int qq = 2 * w + qi; LAS unsigned* hq = hist + qq * 256; const LAS float* sq = sc + qq * SC_LD; LAS unsigned* mq = msk + qq * 64;
            if (L <= 256) { mq[lane] = (lane < L / 32) ? 0xffffffffu : 0u; }
            else {
                int R = 256, E = 0; unsigned prefix = (unsigned)hist_find(hq, lane, R, E);
#pragma unroll 1
                for (int pass = 1; pass < 4; ++pass) {
                    const int sh = 24 - 8 * pass;
                    asm volatile("" ::: "memory");
                    *(LAS u32x4*)(hq + 4 * lane) = (u32x4){0u, 0u, 0u, 0u};
                    LDS_WAIT(); asm volatile("" ::: "memory");
                    for (int i = 4 * lane; i < L; i += 256) { const f32x4 s = *(const LAS f32x4*)(sq + i);
#pragma unroll
                        for (int r = 0; r < 4; ++r) { const unsigned k = okey(s[r]); if ((k >> (sh + 8)) == prefix) lds_inc(hq + ((k >> sh) & 255u)); } }
                    LDS_WAIT(); asm volatile("" ::: "memory");
                    const int b = hist_find(hq, lane, R, E); prefix = (prefix << 8) | (unsigned)b;
                }
                const unsigned thr = prefix;
                if (R >= E) {
                    for (int base = 0; base < SEQ; base += 256) {
                        unsigned nib = 0u;
                        if (base + 4 * lane < L) { const f32x4 s = *(const LAS f32x4*)(sq + base + 4 * lane);
#pragma unroll
                            for (int r = 0; r < 4; ++r) nib |= (okey(s[r]) >= thr ? 1u : 0u) << r; }
                        unsigned wv = nib << (4 * (lane & 7));
                        wv |= __shfl_xor(wv, 1); wv |= __shfl_xor(wv, 2); wv |= __shfl_xor(wv, 4);
                        if ((lane & 7) == 0) mq[(base >> 5) + (lane >> 3)] = wv;
                    }
                } else {
                    int taken = 0;
                    for (int base = 0; base < SEQ; base += 64) {
                        bool take = false; bool eq = false;
                        if (base < L) { const unsigned k = okey(sq[base + lane]); take = k > thr; eq = (k == thr); }
                        const unsigned long long em = __ballot(eq);
                        const int myr = taken + __popcll(em & ((1ull << lane) - 1ull));
                        take = take || (eq && myr < R);
                        taken += __popcll(em);
                        const unsigned long long tm = __ballot(take);
                        if (lane == 0) { mq[base / 32] = (unsigned)tm; mq[base / 32 + 1] = (unsigned)(tm >> 32); }
                    }
                }
            }
        }
        lds_barrier();
        {
            const int qloc = 2 * w + (jl >> 3), hd = jl & 7;
            const bf16_t* qrow = CB + (size_t)(rowb + q0 + qloc) * DS_PAD + hd * 64;
            const bf16x8 yq0 = *(const bf16x8*)(qrow + 8 * g), yq1 = *(const bf16x8*)(qrow + 32 + 8 * g);
            f32x4 O[4];
#pragma unroll
            for (int dt = 0; dt < 4; ++dt) O[dt] = (f32x4){0.f, 0.f, 0.f, 0.f};
            float mrun = -1e30f, lsum = 0.f;
            const LAS unsigned* mq = msk + qloc * 64;
            const bf16_t* kg = CB + (size_t)(rowb + srow) * DS_PAD + 512 + 8 * sseg;
            const bf16_t* vg = VT + ((size_t)bl * 64 + srow) * SEQ + 8 * sseg;
            const int ntile = L / 64;
            u32x4 kreg = *(const u32x4*)kg, vreg = *(const u32x4*)vg;
            *(LAS u32x4*)(KB + srow * LDP + 8 * sseg) = kreg; *(LAS u32x4*)(VB + srow * LDP + 8 * sseg) = vreg;
            lds_barrier();
            for (int it = 0; it < ntile; ++it) {
                { const int itn = (it + 1 < ntile) ? it + 1 : it; kreg = *(const u32x4*)(kg + (size_t)(itn * 64) * DS_PAD); vreg = *(const u32x4*)(vg + itn * 64); asm volatile("" ::: "memory"); }
                const lbf* Kt = KB + (it & 1) * 64 * LDP; const lbf* Vt = VB + (it & 1) * 64 * LDP;
                f32x4 s[4]; bf16x8 kf[4][2];
#pragma unroll
                for (int tl = 0; tl < 4; ++tl) { const lbf* xr = Kt + (16 * tl + jl) * LDP + 8 * g; kf[tl][0] = *(const LAS bf16x8*)xr; kf[tl][1] = *(const LAS bf16x8*)(xr + 32); }
                u32x2 vlo[4][2], vhi[4][2];
#pragma unroll
                for (int dt = 0; dt < 4; ++dt)
#pragma unroll
                    for (int ks = 0; ks < 2; ++ks) { const lbf* vr = Vt + (16 * dt + jl) * LDP + 32 * ks + 4 * g; vlo[dt][ks] = *(const LAS u32x2*)vr; vhi[dt][ks] = *(const LAS u32x2*)(vr + 16); }
#pragma unroll
                for (int tl = 0; tl < 4; ++tl) s[tl] = MFMA16(kf[tl][0], yq0, ((f32x4){0.f, 0.f, 0.f, 0.f}));
#pragma unroll
                for (int tl = 0; tl < 4; ++tl) s[tl] = MFMA16(kf[tl][1], yq1, s[tl]);
                const unsigned mw0 = mq[2 * it], mw1 = mq[2 * it + 1];
                float mx = -1e30f;
#pragma unroll
                for (int tl = 0; tl < 4; ++tl)
#pragma unroll
                    for (int r = 0; r < 4; ++r) mx = fmaxf(mx, s[tl][r]);
                mx = fmaxf(mx, __shfl_xor(mx, 16)); mx = fmaxf(mx, __shfl_xor(mx, 32));
                const float mnew = fmaxf(mrun, mx); const float alpha = __builtin_amdgcn_exp2f(mrun - mnew); mrun = mnew;
                float p[16]; float ps = 0.f;
#pragma unroll
                for (int i = 0; i < 16; ++i) { const int tl = i >> 2, r = i & 3; const unsigned mw = (tl < 2) ? mw0 : mw1;
                    const int sel = __builtin_amdgcn_sbfe((int)mw, 16 * (tl & 1) + 4 * g + r, 1);
                    p[i] = __builtin_bit_cast(float, __builtin_bit_cast(int, __builtin_amdgcn_exp2f(s[tl][r] - mnew)) & sel); ps += p[i]; }
                lsum = lsum * alpha + ps;
                bf16x8 pf[2];
#pragma unroll
                for (int ks = 0; ks < 2; ++ks) { u32x4 pw; pw.x = pk2(p[8 * ks], p[8 * ks + 1]); pw.y = pk2(p[8 * ks + 2], p[8 * ks + 3]); pw.z = pk2(p[8 * ks + 4], p[8 * ks + 5]); pw.w = pk2(p[8 * ks + 6], p[8 * ks + 7]);
                    pf[ks] = __builtin_bit_cast(bf16x8, pw); }
#pragma unroll
                for (int dt = 0; dt < 4; ++dt) O[dt] = O[dt] * alpha;
#pragma unroll
                for (int ks = 0; ks < 2; ++ks)
#pragma unroll
                    for (int dt = 0; dt < 4; ++dt) O[dt] = MFMA16(__builtin_bit_cast(bf16x8, (u32x4){vlo[dt][ks].x, vlo[dt][ks].y, vhi[dt][ks].x, vhi[dt][ks].y}), pf[ks], O[dt]);
                if (it + 1 < ntile) { *(LAS u32x4*)(KB + ((it + 1) & 1) * 64 * LDP + srow * LDP + 8 * sseg) = kreg; *(LAS u32x4*)(VB + ((it + 1) & 1) * 64 * LDP + srow * LDP + 8 * sseg) = vreg; }
                lds_barrier();
            }
            lsum += __shfl_xor(lsum, 16); lsum += __shfl_xor(lsum, 32);
            const float inv = 1.0f / lsum;
            lbf* ostg = (lbf*)(F.lds + 4 * SLOT) + w * 16 * LDP;
#pragma unroll
            for (int dt = 0; dt < 4; ++dt) { u32x2 o; o.x = pk2(O[dt][0] * inv, O[dt][1] * inv); o.y = pk2(O[dt][2] * inv, O[dt][3] * inv); *(LAS u32x2*)(ostg + jl * LDP + 16 * dt + 4 * g) = o; }
#pragma unroll
            for (int p = 0; p < 2; ++p) { const int rr_ = (lane >> 3) + 8 * p; const u32x4 vrow = *(const LAS u32x4*)(ostg + rr_ * LDP + 8 * (lane & 7));
                *(u32x4*)(YB + (size_t)(rowb + q0 + 2 * w + (rr_ >> 3)) * 512 + (rr_ & 7) * 64 + 8 * (lane & 7)) = vrow; }
        }
    }
}

constexpr int MK_LD = 136, MV_LD = 264;
__device__ __forceinline__ void ph_mem_attn(Frame& F, int l) {
    const bf16_t* QM = (const bf16_t*)(F.ws + MA_QM); bf16_t* OM = (bf16_t*)(F.ws + MA_OM);
    const bf16_t* MK = (const bf16_t*)(F.ws + WS_MEMK) + (size_t)l * MEMROWS * 512; const bf16_t* MVT = (const bf16_t*)(F.ws + WS_MEMVT) + (size_t)l * MEMROWS * 512;
    lbf* KS = (lbf*)F.lds; lbf* VS = (lbf*)(F.lds + 256 * MK_LD * 2);
    const int lane = F.lane, jl = lane & 15, g = lane >> 4;
    const float* gq = FIN(F, I_MQN) + l * 128;
    for (int it = F.bid; it < NB * 4 * 2; it += F.G) {
        const int pair = it >> 1, b = pair >> 2, hh = pair & 3, sp0 = (it & 1) * 8;
        const bf16_t* kb_ = MK + ((size_t)b * 4 + hh) * 256 * 128; const bf16_t* vb_ = MVT + ((size_t)b * 4 + hh) * 128 * 256;
        lds_barrier();
#pragma unroll
        for (int i = 0; i < 8; ++i) { const int id = F.tid + NTHR * i;
            *(LAS u32x4*)(KS + (id >> 4) * MK_LD + 8 * (id & 15)) = *(const u32x4*)(kb_ + (size_t)(id >> 4) * 128 + 8 * (id & 15));
            *(LAS u32x4*)(VS + (id >> 5) * MV_LD + 8 * (id & 31)) = *(const u32x4*)(vb_ + (size_t)(id >> 5) * 256 + 8 * (id & 31)); }
        lds_barrier();
#pragma unroll 1
        for (int sp = 0; sp < 8; ++sp) {
        const int t = b * SEQ + (sp0 + sp) * 128 + F.wave * 16 + jl;
        const bf16_t* qrow = QM + (size_t)t * 512 + hh * 128;
        float qv[4][8]; float ss = 0.f;
#pragma unroll
        for (int s2 = 0; s2 < 4; ++s2) { const u32x4 q = *(const u32x4*)(qrow + 32 * s2 + 8 * g);
            qv[s2][0] = bf_lo(q.x); qv[s2][1] = bf_hi(q.x); qv[s2][2] = bf_lo(q.y); qv[s2][3] = bf_hi(q.y); qv[s2][4] = bf_lo(q.z); qv[s2][5] = bf_hi(q.z); qv[s2][6] = bf_lo(q.w); qv[s2][7] = bf_hi(q.w);
#pragma unroll
            for (int i = 0; i < 8; ++i) ss += qv[s2][i] * qv[s2][i]; }
        ss += __shfl_xor(ss, 16); ss += __shfl_xor(ss, 32);
        const float sc = (1.0f / sqrtf(ss * (1.f / 128.f) + 1e-6f)) * (0.08838834764831845f * 1.4426950409f);
        bf16x8 yq[4];
#pragma unroll
        for (int s2 = 0; s2 < 4; ++s2) { const float* gp = gq + 32 * s2 + 8 * g; u32x4 pw;
            pw.x = pk2(qv[s2][0] * sc * gp[0], qv[s2][1] * sc * gp[1]); pw.y = pk2(qv[s2][2] * sc * gp[2], qv[s2][3] * sc * gp[3]);
            pw.z = pk2(qv[s2][4] * sc * gp[4], qv[s2][5] * sc * gp[5]); pw.w = pk2(qv[s2][6] * sc * gp[6], qv[s2][7] * sc * gp[7]); yq[s2] = __builtin_bit_cast(bf16x8, pw); }
        f32x4 O[8];
#pragma unroll
        for (int dt = 0; dt < 8; ++dt) O[dt] = (f32x4){0.f, 0.f, 0.f, 0.f};
        float mrun = -1e30f, ls = 0.f;
#pragma unroll 1
        for (int hk = 0; hk < 2; ++hk) {
            f32x4 S[8];
#pragma unroll
            for (int kt = 0; kt < 8; ++kt) { const lbf* kr = KS + (128 * hk + 16 * kt + jl) * MK_LD + 8 * g; f32x4 a = (f32x4){0.f, 0.f, 0.f, 0.f};
#pragma unroll
                for (int s2 = 0; s2 < 4; ++s2) a = MFMA16(*(const LAS bf16x8*)(kr + 32 * s2), yq[s2], a);
                S[kt] = a; }
            float mx = -1e30f;
#pragma unroll
            for (int kt = 0; kt < 8; ++kt)
#pragma unroll
                for (int r = 0; r < 4; ++r) mx = fmaxf(mx, S[kt][r]);
            mx = fmaxf(mx, __shfl_xor(mx, 16)); mx = fmaxf(mx, __shfl_xor(mx, 32));
            const float mnew = fmaxf(mrun, mx), alpha = __builtin_amdgcn_exp2f(mrun - mnew); mrun = mnew;
            float ps = 0.f; bf16x8 pf[4];
#pragma unroll
            for (int ks = 0; ks < 4; ++ks) { float p[8];
#pragma unroll
                for (int i = 0; i < 8; ++i) { p[i] = __builtin_amdgcn_exp2f(S[2 * ks + (i >> 2)][i & 3] - mnew); ps += p[i]; }
                u32x4 pw; pw.x = pk2(p[0], p[1]); pw.y = pk2(p[2], p[3]); pw.z = pk2(p[4], p[5]); pw.w = pk2(p[6], p[7]); pf[ks] = __builtin_bit_cast(bf16x8, pw); }
            ls = ls * alpha + ps;
#pragma unroll
            for (int dt = 0; dt < 8; ++dt) { f32x4 o = O[dt] * alpha; const lbf* vr = VS + (16 * dt + jl) * MV_LD + 128 * hk + 4 * g;
#pragma unroll
                for (int ks = 0; ks < 4; ++ks) { const u32x2 lo = *(const LAS u32x2*)(vr + 32 * ks), hi = *(const LAS u32x2*)(vr + 32 * ks + 16);
                    o = MFMA16(__builtin_bit_cast(bf16x8, (u32x4){lo.x, lo.y, hi.x, hi.y}), pf[ks], o); }
                O[dt] = o; }
        }
        ls += __shfl_xor(ls, 16); ls += __shfl_xor(ls, 32);
        const float inv = 1.0f / ls;
        lbf* ostg = (lbf*)(F.lds + 256 * MK_LD * 2 + 128 * MV_LD * 2) + F.wave * 16 * LDP;
        const int t0w = b * SEQ + (sp0 + sp) * 128 + F.wave * 16;
#pragma unroll
        for (int hf2 = 0; hf2 < 2; ++hf2) {
#pragma unroll
            for (int d4 = 0; d4 < 4; ++d4) { const int dt = 4 * hf2 + d4; u32x2 ov; ov.x = pk2(O[dt][0] * inv, O[dt][1] * inv); ov.y = pk2(O[dt][2] * inv, O[dt][3] * inv); *(LAS u32x2*)(ostg + jl * LDP + 16 * d4 + 4 * g) = ov; }
#pragma unroll
            for (int p = 0; p < 2; ++p) { const int rr_ = (lane >> 3) + 8 * p; const u32x4 vrow = *(const LAS u32x4*)(ostg + rr_ * LDP + 8 * (lane & 7));
                *(u32x4*)(OM + (size_t)(t0w + rr_) * 512 + hh * 128 + 64 * hf2 + 8 * (lane & 7)) = vrow; }
        }
        }
    }
}

__device__ __forceinline__ void ph_moe_route(Frame& F) {
    const unsigned short* sele = (const unsigned short*)(F.ws + MOE_SELE); const f32x2* selw = (const f32x2*)(F.ws + MOE_SELW);
    int* rowtok = (int*)(F.ws + MOE_ROWTOK); float* roww = (float*)(F.ws + MOE_ROWW); int* tile_e = (int*)(F.ws + MOE_TILEE); int* meta = (int*)(F.ws + MOE_META);
    LAS unsigned long long* pc = (LAS unsigned long long*)F.lds;
    LAS int* tot = (LAS int*)(F.lds + 8192);
    LAS int* pre = tot + 16; LAS int* segb = tot + 32; LAS int* wcnt = tot + 64;
    __syncthreads();
    { unsigned long long c0 = 0ull, c1 = 0ull; const u32x4* sp = (const u32x4*)(sele + (size_t)F.tid * 128);
      for (int i = 0; i < 16; ++i) { const u32x4 v = sp[i]; const unsigned ww[4] = {v.x, v.y, v.z, v.w};
#pragma unroll
        for (int q = 0; q < 4; ++q) { const unsigned a = ww[q] & 0xffffu, b = ww[q] >> 16;
            c0 += 1ull << (8 * (a & 7u)); c1 += 1ull << (8 * ((a >> 8) & 7u)); c0 += 1ull << (8 * (b & 7u)); c1 += 1ull << (8 * ((b >> 8) & 7u)); } }
      pc[F.tid * 2] = c0; pc[F.tid * 2 + 1] = c1; }
    __syncthreads();
    if (F.tid < 32) { const int seg = F.tid & 15, kind = F.tid >> 4; const int slot = seg >> 3, e = seg & 7; const int lim = kind ? 2 * F.bid : 512; int s = 0;
        for (int i = 0; i < lim; ++i) s += (int)((pc[i * 2 + slot] >> (8 * e)) & 0xffull);
        if (kind) pre[seg] = s; else tot[seg] = s; }
    __syncthreads();
    if (F.tid == 0) { int b = 0; for (int s = 0; s < 16; ++s) { segb[s] = b; b += (tot[s] + 255) & ~255; } segb[16] = b; }
    __syncthreads();
    const int t = F.bid * 256 + (F.tid & 255); const unsigned se = sele[t]; const f32x2 sw = selw[t];
    const int myseg[2] = { (int)(se & 7u), 8 + (int)((se >> 8) & 7u) };
    int rank[2] = {0, 0};
    if (F.tid < 256) {
#pragma unroll
        for (int s = 0; s < 16; ++s) { const int k = s >> 3; const unsigned long long m = __ballot(myseg[k] == s);
            if (myseg[k] == s) rank[k] = __popcll(m & ((1ull << F.lane) - 1ull));
            if (F.lane == 0) wcnt[F.wave * 16 + s] = __popcll(m); }
    }
    __syncthreads();
    if (F.tid < 256) {
#pragma unroll
        for (int k = 0; k < 2; ++k) { const int s = myseg[k]; int off = 0; for (int ww = 0; ww < F.wave; ++ww) off += wcnt[ww * 16 + s];
            const int row = segb[s] + pre[s] + off + rank[k]; rowtok[row] = t; roww[row] = k ? sw.y : sw.x; }
    }
    if (F.bid == 0) {
        for (int s = 0; s < 16; ++s) { const int lo = segb[s] + tot[s], hi = segb[s + 1]; for (int r = lo + F.tid; r < hi; r += NTHR) { rowtok[r] = -1; roww[r] = 0.f; } }
        for (int p = F.tid; p < segb[16] / 256; p += NTHR) { int e = 0; for (int s = 0; s < 16; ++s) if (p * 256 >= segb[s]) e = s & 7; tile_e[p] = e; }
        if (F.tid == 0) { meta[0] = segb[8] / 256; meta[1] = segb[16] / 256; }
    }
}

__global__ void __launch_bounds__(NTHR, 2) fwd(Args args) {
    extern __shared__ __attribute__((aligned(16))) unsigned char lds_raw[];
    Frame F;
    F.lds = (LAS unsigned char*)lds_raw; F.ws = args.ws; F.kb = __builtin_amdgcn_kernarg_segment_ptr(); F.out = args.out;
    F.tid = threadIdx.x; F.lane = F.tid & 63; F.wave = __builtin_amdgcn_readfirstlane(F.tid >> 6); F.G = gridDim.x; F.bid = blockIdx.x;
    volatile LAS unsigned* MISC = (volatile LAS unsigned*)(F.lds + LDS_MISC);
    if (F.tid < 64) MISC[F.tid] = 0u;
    __syncthreads();
    const int lo = args.ph_lo, hi = args.ph_hi;
    XcdBarrier bar; bar.bar = (unsigned*)(F.ws + WS_CTL) + 4096; bar.x = 0; bar.st = nullptr;
    if (hi - lo > 1) bar = xcd_barrier_post((unsigned*)(F.ws + WS_CTL) + 4096, MISC + 8);
    int ph = 0;
    const int wave_s_ = __builtin_amdgcn_readfirstlane((int)threadIdx.x >> 6);
#ifndef SITE_MASK
#define SITE_MASK 0xffffffffffffffffull
#endif
#ifndef PROBE_T_MASK
#define PROBE_T_MASK 0ull
#endif
#ifndef PROBE_T_FACTOR
#define PROBE_T_FACTOR 20ull
#endif
    unsigned long long tacc_ = 0ull, t0_ = 0ull;
#ifndef SITE_MASK
#define SITE_MASK 0xffffffffffffffffull
#endif
#define PHASE_BEGIN { constexpr int site_ = __COUNTER__; if (((SITE_MASK >> site_) & 1ull) && ph >= lo && ph < hi) { if (((PROBE_T_MASK >> site_) & 1ull) && F.bid == 0) t0_ = __builtin_amdgcn_s_memrealtime(); \
      { unsigned _m = ~0u; int _wv = wave_s_; asm volatile("" : "+s"(_m), "+s"(_wv)); int _t = _wv * 64 + (int)__builtin_amdgcn_mbcnt_hi(_m, __builtin_amdgcn_mbcnt_lo(_m, 0u)); asm volatile("" : "+v"(_t)); F.tid = _t; F.lane = _t & 63; F.wave = _wv; { int _b = blockIdx.x, _g = gridDim.x; asm volatile("" : "+s"(_b), "+s"(_g)); F.bid = _b; F.G = _g; } \
      kptr_t _kb = __builtin_amdgcn_kernarg_segment_ptr(); asm volatile("" : "+s"(_kb)); F.kb = _kb; \
      __attribute__((address_space(1))) unsigned char* _w = (__attribute__((address_space(1))) unsigned char*)args.ws; asm volatile("" : "+s"(_w)); F.ws = (unsigned char*)_w; ws = F.ws; __attribute__((address_space(1))) float* _o = (__attribute__((address_space(1))) float*)args.out; asm volatile("" : "+s"(_o)); F.out = (float*)_o; }
#define PHASE_END   if (ph + 1 < hi) xcd_barrier(bar, F.tid); if (((PROBE_T_MASK >> site_) & 1ull) && F.bid == 0) tacc_ += __builtin_amdgcn_s_memrealtime() - t0_; } ++ph; }
    unsigned char* ws = F.ws;
#define HN ((const bf16_t*)(ws + WS_HN))

    PHASE_BEGIN ph_prologue0(F); PHASE_END
    PHASE_BEGIN { pg8::Gemm g{(const bf16_t*)(ws + WS_MEMH), (const bf16_t*)(ws + WS_WKV), D, 0, nullptr}; pg8::StaticOrder S; S.init(MEMROWS, 4096, F.G, F.bid);
        pg8::EpiPlain E{(bf16_t*)(ws + PR_KVRAW), 4096}; pg8::gemm_phase<pg8::EpiPlain, pg8::StaticOrder>(F.lds, g, S, E, F.tid); } PHASE_END
    PHASE_BEGIN ph_prologue2(F); PHASE_END

#pragma unroll 1
    for (int l = 0; l < DEPTH; ++l) {

        PHASE_BEGIN ph_layer0(F, l, l ? (const float*)F.out : FIN(F, I_X)); PHASE_END
#pragma unroll 1
        for (int half = 0; half < 2; ++half) {

            PHASE_BEGIN { pg8::Gemm g{HN + (size_t)half * TH * D, (const bf16_t*)(ws + W_IN), D, 0, nullptr}; pg8::StaticOrder S; S.init(TH, N_INP, F.G, F.bid);
                pg8::EpiWin E{(bf16_t*)(ws + MX_CA), (bf16_t*)(ws + MX_CB), (bf16_t*)(ws + MX_CG)}; pg8::gemm_phase<pg8::EpiWin, pg8::StaticOrder>(F.lds, g, S, E, F.tid); } PHASE_END
                        #ifndef PROBE_RPREP
#define PROBE_RPREP 1
#endif
#ifndef PROBE_S2
#define PROBE_S2 1
#endif
#ifndef PROBE_DSA
#define PROBE_DSA 1
#endif
            PHASE_BEGIN ph_rwkv_pre(F, l, half); ph_dsa_prep(F, l, half); PHASE_END
            PHASE_BEGIN ph_rwkv_s1(F, l, half); PHASE_END
            PHASE_BEGIN { for (int r_ = 0; r_ < PROBE_S2; ++r_) for (int p = F.bid; p < 128; p += F.G) ph_rwkv_s2(F, l, p); ph_dsa(F, half, (unsigned*)(ws + WS_CTL) + 8192 + 64 * (2 * l + half)); } PHASE_END
            PHASE_BEGIN { pg8::Gemm g{(const bf16_t*)(ws + MX_CA + RW_ARR), (const bf16_t*)(ws + W_BA), 512, 0, nullptr}; pg8::StaticOrder S; S.init(TH, D, F.G, F.bid);
                pg8::EpiMerge<false> E{(bf16_t*)(ws + WS_HN) + (size_t)half * TH * D, (const bf16_t*)(ws + MX_CG), 0}; pg8::gemm_phase<pg8::EpiMerge<false>, pg8::StaticOrder>(F.lds, g, S, E, F.tid); } PHASE_END
            PHASE_BEGIN { pg8::Gemm g{(const bf16_t*)(ws + MX_YB), (const bf16_t*)(ws + W_BB), 512, 0, nullptr}; pg8::StaticOrder S; S.init(TH, D, F.G, F.bid);
                pg8::EpiMerge<true> E{(bf16_t*)(ws + WS_HN) + (size_t)half * TH * D, (const bf16_t*)(ws + MX_CG), 1024}; pg8::gemm_phase<pg8::EpiMerge<true>, pg8::StaticOrder>(F.lds, g, S, E, F.tid); } PHASE_END
        }
        PHASE_BEGIN { pg8::Gemm g{HN, (const bf16_t*)(ws + W_OUT), D, 0, nullptr}; pg8::StaticOrder S; S.init(T, D, F.G, F.bid);
            pg8::EpiResid E{l ? (const float*)F.out : FIN(F, I_X), F.out}; pg8::gemm_phase<pg8::EpiResid, pg8::StaticOrder>(F.lds, g, S, E, F.tid); } PHASE_END
        PHASE_BEGIN ph_norm(F); PHASE_END
        PHASE_BEGIN { pg8::Gemm g{HN, (const bf16_t*)(ws + W_MQ), D, 0, nullptr}; pg8::StaticOrder S; S.init(T, 512, F.G, F.bid);
            pg8::EpiPlain E{(bf16_t*)(ws + MA_QM), 512}; pg8::gemm_phase<pg8::EpiPlain, pg8::StaticOrder>(F.lds, g, S, E, F.tid); } PHASE_END
        PHASE_BEGIN ph_mem_attn(F, l); PHASE_END
        PHASE_BEGIN { pg8::Gemm g{(const bf16_t*)(ws + MA_OM), (const bf16_t*)(ws + W_MO), 512, 0, nullptr}; pg8::StaticOrder S; S.init(T, D, F.G, F.bid);
            pg8::EpiResid E{F.out, F.out}; pg8::gemm_phase<pg8::EpiResid, pg8::StaticOrder>(F.lds, g, S, E, F.tid); } PHASE_END
        PHASE_BEGIN ph_norm_ffn(F, l); PHASE_END
        if ((l & 1) == 0) {
            PHASE_BEGIN { pg8::Gemm g{HN, (const bf16_t*)(ws + W_FGU), D, 0, nullptr}; pg8::StaticOrder S; S.init(T, 2 * FFN, F.G, F.bid);
                pg8::EpiSwiGLU E{(bf16_t*)(ws + FF_GU), FFN}; pg8::gemm_phase<pg8::EpiSwiGLU, pg8::StaticOrder>(F.lds, g, S, E, F.tid); } PHASE_END
            PHASE_BEGIN { pg8::Gemm g{(const bf16_t*)(ws + FF_GU), (const bf16_t*)(ws + W_FD), FFN, 0, nullptr}; pg8::StaticOrder S; S.init(T, D, F.G, F.bid);
                pg8::EpiResid E{F.out, F.out}; pg8::gemm_phase<pg8::EpiResid, pg8::StaticOrder, false, true>(F.lds, g, S, E, F.tid); } PHASE_END
            ph += 2;
        } else {
#define meta ((const int*)(ws + MOE_META))
#define tile_e ((const int*)(ws + MOE_TILEE))
            PHASE_BEGIN ph_moe_route(F); PHASE_END
            PHASE_BEGIN { const int nt1 = __builtin_amdgcn_readfirstlane(meta[1]);
                pg8::Gemm g{HN, (const bf16_t*)(ws + W_EGU), D, (size_t)2 * EDIM * D, (const int*)(ws + MOE_ROWTOK)}; pg8::MoeOrder S; S.init(nt1, 11, F.G, F.bid, 0, tile_e);
                pg8::EpiSwiGLU E{(bf16_t*)(ws + FF_GU), EDIM}; pg8::gemm_phase<pg8::EpiSwiGLU, pg8::MoeOrder, true>(F.lds, g, S, E, F.tid); } PHASE_END
            PHASE_BEGIN { const int nt0 = __builtin_amdgcn_readfirstlane(meta[0]);
                pg8::Gemm g{(const bf16_t*)(ws + FF_GU), (const bf16_t*)(ws + W_ED), EDIM, (size_t)D * EDIM, nullptr}; pg8::MoeOrder S; S.init(nt0, 4, F.G, F.bid, 0, tile_e);
                pg8::EpiMoeDown E{F.out, (const int*)(ws + MOE_ROWTOK), (const float*)(ws + MOE_ROWW)}; pg8::gemm_phase<pg8::EpiMoeDown, pg8::MoeOrder, false, true>(F.lds, g, S, E, F.tid); } PHASE_END
            PHASE_BEGIN { const int nt0 = __builtin_amdgcn_readfirstlane(meta[0]), nt1 = __builtin_amdgcn_readfirstlane(meta[1]);
                pg8::Gemm g{(const bf16_t*)(ws + FF_GU), (const bf16_t*)(ws + W_ED), EDIM, (size_t)D * EDIM, nullptr}; pg8::MoeOrder S; S.init(nt1 - nt0, 4, F.G, F.bid, nt0, tile_e);
                pg8::EpiMoeDown E{F.out, (const int*)(ws + MOE_ROWTOK), (const float*)(ws + MOE_ROWW)}; pg8::gemm_phase<pg8::EpiMoeDown, pg8::MoeOrder, false, true>(F.lds, g, S, E, F.tid); } PHASE_END
        }
    }
    if (PROBE_T_MASK != 0ull && F.bid == 0) { const unsigned long long te_ = __builtin_amdgcn_s_memrealtime() + PROBE_T_FACTOR * tacc_; while (__builtin_amdgcn_s_memrealtime() < te_) __builtin_amdgcn_s_sleep(32); }
}
constexpr int N_PHASES = 3 + DEPTH * (1 + 2 * 6 + 6 + 4);

extern "C" void kernel_launch(void* const* d_in, const int* in_sizes, int n_in, void* d_out, int out_size, void* d_ws, size_t ws_size, hipStream_t stream) {
    static int grid = 0;
    if (grid == 0) {
        if (n_in != 41 || out_size != T * D || ws_size < WS_END) { fprintf(stderr, "kernel_launch: unexpected shapes (n_in %d, out %d, ws %zu < %zu); nothing launched\n", n_in, out_size, ws_size, (size_t)WS_END); grid = -1; return; }
        int dev = 0, cus = 0, per_cu = 0;
        if (hipGetDevice(&dev) != hipSuccess || hipDeviceGetAttribute(&cus, hipDeviceAttributeMultiprocessorCount, dev) != hipSuccess) { grid = -1; return; }
        if (hipFuncSetAttribute((const void*)fwd, hipFuncAttributeMaxDynamicSharedMemorySize, LDS_BYTES) != hipSuccess) { fprintf(stderr, "kernel_launch: hipFuncSetAttribute failed\n"); grid = -1; return; }
        if (hipOccupancyMaxActiveBlocksPerMultiprocessor(&per_cu, (const void*)fwd, NTHR, LDS_BYTES) != hipSuccess || per_cu < 1) fprintf(stderr, "kernel_launch: occupancy query reports %d\n", per_cu);
        (void)hipGetLastError();
        grid = cus;
    }
    if (grid < 0) return;
    if (hipMemsetAsync((char*)d_ws + WS_CTL, 0, CTL_ZERO_BYTES, stream) != hipSuccess) return;
    Args a{};
    for (int i = 0; i < 41; ++i) a.in[i] = d_in[i];
    a.out = (float*)d_out; a.ws = (unsigned char*)d_ws;
#if MK_ONE_LAUNCH
    a.ph_lo = 0; a.ph_hi = N_PHASES;
    hipLaunchKernelGGL(fwd, dim3(grid), dim3(NTHR), LDS_BYTES, stream, a);
#else
    for (int p = 0; p < N_PHASES; ++p) { a.ph_lo = p; a.ph_hi = p + 1; hipLaunchKernelGGL(fwd, dim3(grid), dim3(NTHR), LDS_BYTES, stream, a); }
#endif
}
```

```cpp
#include <hip/hip_runtime.h>
#include <cstdio>
#include <cstdint>

#ifndef MK_ONE_LAUNCH
#define MK_ONE_LAUNCH 1
#endif

namespace pg8 {
#define PG8_LAS __attribute__((address_space(3)))
typedef unsigned short bf16_t;
typedef short bf16x8 __attribute__((ext_vector_type(8)));
typedef float f32x4 __attribute__((ext_vector_type(4)));
typedef float f32x2 __attribute__((ext_vector_type(2)));
typedef unsigned u32x4 __attribute__((ext_vector_type(4)));
typedef unsigned u32x2 __attribute__((ext_vector_type(2)));
typedef __bf16 bf16x2_t __attribute__((ext_vector_type(2)));
constexpr int BM = 256, BK = 64, HALF = 128, HTB = HALF * BK * 2, STAGE_BYTES = 8 * HTB, NXCD = 8, WGM = 8;

__host__ __device__ __forceinline__ int lds_byte(int r, int c) { const int st = (r >> 4) * 2 + (c >> 5), rr = r & 15, cc = c & 31, ob = rr * 64 + cc * 2; return st * 1024 + (ob ^ (((ob >> 9) & 1) << 5)); }
__host__ __device__ __forceinline__ void stage_rc(int b, int& R, int& C) { const int st = b / 1024, sb = b % 1024, swz = sb ^ (((sb >> 9) & 1) << 5); R = (st >> 1) * 16 + swz / 64; C = (st & 1) * 32 + (swz % 64) / 2; }
__host__ __device__ __forceinline__ int perm32(int rho) { const int n = rho >> 4, i = rho & 15; return 8 * (i >> 2) + 4 * n + (i & 3); }

struct Unit { int pm, pn, e; };
struct Gemm { const bf16_t* A; const bf16_t* Bt; int K; size_t bstride; const int* rowidx; };

struct StaticOrder {
    int nM, nN, nwg, G, c;
    __device__ void init(int M, int N, int G_, int c_) { nM = M / BM; nN = N / BM; nwg = nM * nN; G = G_; c = c_; }
    __device__ bool next(int i, Unit& u) const {
        const long L = (long)i * G + c; if (L >= nwg) return false;
        int wgid = (int)L; { const int q = nwg / NXCD, r = nwg % NXCD, xcd = wgid % NXCD, off = wgid / NXCD; wgid = (xcd < r ? xcd * (q + 1) : r * (q + 1) + (xcd - r) * q) + off; }
        const int nig = WGM * nN, gid = wgid / nig, fm = gid * WGM, gsz = (nM - fm) < WGM ? (nM - fm) : WGM;
        u.pm = fm + ((wgid % nig) % gsz); u.pn = (wgid % nig) / gsz; u.e = 0; return true;
    }
};
struct MoeOrder {
    int nM, nN, nwg, G, c, pm0; const int* tile_e;
    __device__ void init(int nM_, int nN_, int G_, int c_, int pm0_, const int* te) { nM = nM_; nN = nN_; nwg = nM * nN; G = G_; c = c_; pm0 = pm0_; tile_e = te; }
    __device__ bool next(int i, Unit& u) const {
        const long L = (long)i * G + c; if (L >= nwg) return false;
        int wgid = (int)L; { const int q = nwg / NXCD, r = nwg % NXCD, xcd = wgid % NXCD, off = wgid / NXCD; wgid = (xcd < r ? xcd * (q + 1) : r * (q + 1) + (xcd - r) * q) + off; }
        const int nig = WGM * nN, gid = wgid / nig, fm = gid * WGM, gsz = (nM - fm) < WGM ? (nM - fm) : WGM;
        u.pm = pm0 + fm + ((wgid % nig) % gsz); u.pn = (wgid % nig) / gsz; u.e = __builtin_amdgcn_readfirstlane(tile_e[u.pm]); return true;
    }
};

__device__ __forceinline__ unsigned pk2(float lo, float hi) { const bf16x2_t v = __builtin_convertvector((f32x2){lo, hi}, bf16x2_t); return __builtin_bit_cast(unsigned, v); }
__device__ __forceinline__ float bf_lo(unsigned u) { return __builtin_bit_cast(float, u << 16); }
__device__ __forceinline__ float bf_hi(unsigned u) { return __builtin_bit_cast(float, u & 0xffff0000u); }
__device__ __forceinline__ float bf2f(bf16_t b) { return __builtin_bit_cast(float, (unsigned)b << 16); }
__device__ __forceinline__ bf16_t f2bf(float f) { return (bf16_t)(pk2(f, 0.f) & 0xffffu); }
__device__ __forceinline__ float sigmoidf_(float x) { return __builtin_amdgcn_rcpf(1.0f + __expf(-x)); }

struct EpiPlain {
    static constexpr bool PERM = true;
    bf16_t* O; int ldc;
    __device__ __forceinline__ void operator()(const f32x4 (&acc)[2][2][4][2], const Unit& u, int wr, int wc, int fr, int fq) const {
        const int row0 = u.pm * BM + wr * 64 + fr, col0 = u.pn * BM + wc * 32 + 8 * fq;
#pragma unroll
        for (int ai = 0; ai < 2; ++ai)
#pragma unroll
            for (int m = 0; m < 4; ++m) { bf16_t* rowp = O + (size_t)(row0 + ai * HALF + m * 16) * ldc + col0;
#pragma unroll
                for (int bj = 0; bj < 2; ++bj) { const f32x4 v0 = acc[ai][bj][m][0], v1 = acc[ai][bj][m][1];
                    u32x4 w; w.x = pk2(v0[0], v0[1]); w.y = pk2(v0[2], v0[3]); w.z = pk2(v1[0], v1[1]); w.w = pk2(v1[2], v1[3]);
                    *(u32x4*)(rowp + bj * HALF) = w; } }
    }
};
struct EpiWin {
    static constexpr bool PERM = true;
    bf16_t *CA, *CB, *CG;
    __device__ __forceinline__ void operator()(const f32x4 (&acc)[2][2][4][2], const Unit& u, int wr, int wc, int fr, int fq) const {
        const int row0 = u.pm * BM + wr * 64 + fr; const int pn = u.pn;
        bf16_t* base; int ldc, ct; const bool sg = pn >= 12;
        if (pn < 7) { base = CA; ldc = 1792; ct = pn; } else if (pn < 12) { base = CB; ldc = 1280; ct = pn - 7; } else { base = CG; ldc = 2048; ct = pn - 12; }
        const int col0 = ct * BM + wc * 32 + 8 * fq;
#pragma unroll
        for (int ai = 0; ai < 2; ++ai)
#pragma unroll
            for (int m = 0; m < 4; ++m) { bf16_t* rowp = base + (size_t)(row0 + ai * HALF + m * 16) * ldc + col0;
#pragma unroll
                for (int bj = 0; bj < 2; ++bj) { f32x4 v0 = acc[ai][bj][m][0], v1 = acc[ai][bj][m][1];
                    if (sg) {
#pragma unroll
                        for (int j = 0; j < 4; ++j) { v0[j] = sigmoidf_(v0[j]); v1[j] = sigmoidf_(v1[j]); } }
                    u32x4 w; w.x = pk2(v0[0], v0[1]); w.y = pk2(v0[2], v0[3]); w.z = pk2(v1[0], v1[1]); w.w = pk2(v1[2], v1[3]);
                    *(u32x4*)(rowp + bj * HALF) = w; } }
    }
};
template <bool ADD> struct EpiMerge {
    static constexpr bool PERM = true;
    bf16_t* O; const bf16_t* gate; int gcol;
    __device__ __forceinline__ void operator()(const f32x4 (&acc)[2][2][4][2], const Unit& u, int wr, int wc, int fr, int fq) const {
        const int row0 = u.pm * BM + wr * 64 + fr, col0 = u.pn * BM + wc * 32 + 8 * fq;
#pragma unroll
        for (int ai = 0; ai < 2; ++ai) {
            u32x4 gv[4][2], pv[4][2];
#pragma unroll
            for (int m = 0; m < 4; ++m) { const size_t row = (size_t)(row0 + ai * HALF + m * 16);
#pragma unroll
                for (int bj = 0; bj < 2; ++bj) { gv[m][bj] = *(const u32x4*)(gate + row * 2048 + gcol + col0 + bj * HALF); if (ADD) pv[m][bj] = *(const u32x4*)(O + row * 1024 + col0 + bj * HALF); } }
#pragma unroll
            for (int m = 0; m < 4; ++m) { const size_t row = (size_t)(row0 + ai * HALF + m * 16);
#pragma unroll
                for (int bj = 0; bj < 2; ++bj) { const f32x4 v0 = acc[ai][bj][m][0], v1 = acc[ai][bj][m][1]; const u32x4 g = gv[m][bj];
                    float o[8] = { bf_lo(g.x) * v0[0], bf_hi(g.x) * v0[1], bf_lo(g.y) * v0[2], bf_hi(g.y) * v0[3], bf_lo(g.z) * v1[0], bf_hi(g.z) * v1[1], bf_lo(g.w) * v1[2], bf_hi(g.w) * v1[3] };
                    if (ADD) { const u32x4 p = pv[m][bj];
                        o[0] += bf_lo(p.x); o[1] += bf_hi(p.x); o[2] += bf_lo(p.y); o[3] += bf_hi(p.y); o[4] += bf_lo(p.z); o[5] += bf_hi(p.z); o[6] += bf_lo(p.w); o[7] += bf_hi(p.w); }
                    u32x4 w; w.x = pk2(o[0], o[1]); w.y = pk2(o[2], o[3]); w.z = pk2(o[4], o[5]); w.w = pk2(o[6], o[7]);
                    *(u32x4*)(O + row * 1024 + col0 + bj * HALF) = w; } }
        }
    }
};
struct EpiResid {
    static constexpr bool PERM = false;
    const float* xi; float* xo;
    __device__ __forceinline__ void operator()(const f32x4 (&acc)[2][2][4][2], const Unit& u, int wr, int wc, int fr, int fq) const {
        const int row0 = u.pm * BM + wr * 64 + fr, col0 = u.pn * BM + wc * 32 + 4 * fq;
#pragma unroll
        for (int ai = 0; ai < 2; ++ai) {
            f32x4 xv[4][2][2];
#pragma unroll
            for (int m = 0; m < 4; ++m) { const size_t o = (size_t)(row0 + ai * HALF + m * 16) * 1024 + col0;
#pragma unroll
                for (int bj = 0; bj < 2; ++bj)
#pragma unroll
                    for (int n = 0; n < 2; ++n) xv[m][bj][n] = *(const f32x4*)(xi + o + bj * HALF + n * 16); }
#pragma unroll
            for (int m = 0; m < 4; ++m) { const size_t o = (size_t)(row0 + ai * HALF + m * 16) * 1024 + col0;
#pragma unroll
                for (int bj = 0; bj < 2; ++bj)
#pragma unroll
                    for (int n = 0; n < 2; ++n) *(f32x4*)(xo + o + bj * HALF + n * 16) = xv[m][bj][n] + acc[ai][bj][m][n]; }
        }
    }
};
struct EpiSwiGLU {
    static constexpr bool PERM = true;
    bf16_t* O; int ldc;
    __device__ __forceinline__ void operator()(const f32x4 (&acc)[2][2][4][2], const Unit& u, int wr, int wc, int fr, int fq) const {
        const int row0 = u.pm * BM + wr * 64 + fr, col0 = u.pn * HALF + wc * 32 + 8 * fq;
#pragma unroll
        for (int ai = 0; ai < 2; ++ai)
#pragma unroll
            for (int m = 0; m < 4; ++m) { const int row = row0 + ai * HALF + m * 16;
                bf16_t* rowp = O + ((size_t)((row >> 6) * (ldc >> 4) + (col0 >> 4)) << 10) + (((row & 63) << 4) + (col0 & 15));
                float o[8];
#pragma unroll
                for (int n = 0; n < 2; ++n)
#pragma unroll
                    for (int j = 0; j < 4; ++j) { const float g = acc[ai][0][m][n][j], up = acc[ai][1][m][n][j]; o[4 * n + j] = g * sigmoidf_(g) * up; }
                u32x4 w; w.x = pk2(o[0], o[1]); w.y = pk2(o[2], o[3]); w.z = pk2(o[4], o[5]); w.w = pk2(o[6], o[7]);
                *(u32x4*)rowp = w; }
    }
};
struct EpiMoeDown {
    static constexpr bool PERM = false;
    float* x; const int* tok; const float* wgt;
    __device__ __forceinline__ void operator()(const f32x4 (&acc)[2][2][4][2], const Unit& u, int wr, int wc, int fr, int fq) const {
        const int row0 = u.pm * BM + wr * 64 + fr, col0 = u.pn * BM + wc * 32 + 4 * fq;
        int tk[2][4]; float wv[2][4];
#pragma unroll
        for (int ai = 0; ai < 2; ++ai)
#pragma unroll
            for (int m = 0; m < 4; ++m) { const int row = row0 + ai * HALF + m * 16; tk[ai][m] = tok[row]; wv[ai][m] = wgt[row]; }
#pragma unroll
        for (int ai = 0; ai < 2; ++ai) {
            f32x4 xv[4][2][2];
#pragma unroll
            for (int m = 0; m < 4; ++m) { const int t = tk[ai][m] < 0 ? 0 : tk[ai][m]; const float* xp = x + (size_t)t * 1024 + col0;
#pragma unroll
                for (int bj = 0; bj < 2; ++bj)
#pragma unroll
                    for (int n = 0; n < 2; ++n) xv[m][bj][n] = *(const f32x4*)(xp + bj * HALF + n * 16); }
#pragma unroll
            for (int m = 0; m < 4; ++m) if (tk[ai][m] >= 0) { float* xp = x + (size_t)tk[ai][m] * 1024 + col0;
#pragma unroll
                for (int bj = 0; bj < 2; ++bj)
#pragma unroll
                    for (int n = 0; n < 2; ++n) *(f32x4*)(xp + bj * HALF + n * 16) = xv[m][bj][n] + acc[ai][bj][m][n] * wv[ai][m]; }
        }
    }
};

template <class Epi, class Sched, bool GATHER = false, bool ABLK = false>
__device__ __forceinline__ void gemm_phase(PG8_LAS unsigned char* lds, const Gemm g, const Sched& S, const Epi& E, int tid_) {
    asm volatile("" : "+v"(tid_));
    const int tid = tid_, wid = __builtin_amdgcn_readfirstlane(tid >> 6), lane = tid & 63, wr = wid >> 2, wc = wid & 3, fr = lane & 15, fq = lane >> 4;
    const int K = g.K, nt = K / BK;
    unsigned voffA[2], voffB[2];
#pragma unroll
    for (int i = 0; i < 2; ++i) { int R, C; stage_rc(tid * 16 + i * 8192, R, C); const int Rb = Epi::PERM ? ((R & ~31) + perm32(R & 31)) : R;
        voffA[i] = ABLK ? (unsigned)(((R >> 6) * (K >> 4) + (C >> 4)) * 2048 + (((R & 63) << 4) + (C & 15)) * 2) : (unsigned)(R * K + C) * 2u; voffB[i] = (unsigned)(Rb * K + C) * 2u; }
    const size_t kstep = (size_t)(BK * 2);
    const size_t hstep = (size_t)HALF * K * 2;
    const size_t tstep = 2 * hstep;
    const size_t hstepA = ABLK ? (size_t)2 * (K >> 4) * 2048 : hstep, tstepA = 2 * hstepA; constexpr size_t AKM = ABLK ? 64 : 1;
    const unsigned ldsw = (unsigned)wid * 1024u;
    const int aoff = lds_byte(wr * 64 + fr, fq * 8), boff = lds_byte(wc * 32 + fr, fq * 8);
    unsigned gvo[2][2];
#define PG8_SA(b, h) (((b) * 2 + (h)) * HTB)
#define PG8_SB(b, h) ((4 + (b) * 2 + (h)) * HTB)
#define PG8_STAGE(bufoff, gbase, voff) do { _Pragma("unroll") for (int _i = 0; _i < 2; ++_i) \
        __builtin_amdgcn_global_load_lds((const unsigned*)((const char*)(gbase) + (voff)[_i]), (PG8_LAS unsigned*)(lds + (bufoff) + ldsw + _i * 8192), 16, 0, 0); } while (0)
#define PG8_STAGE_A(bufoff, h, ubase, kb, nx) do { if constexpr (GATHER) { PG8_STAGE(bufoff, (const char*)g.A + (kb), gvo[h]); } \
        else { PG8_STAGE(bufoff, (ubase) + (kb) * AKM + (h) * hstepA, voffA); } } while (0)
#define PG8_LOADROWS(dst, unit) do { if constexpr (GATHER) { _Pragma("unroll") for (int _i = 0; _i < 2; ++_i) { int _R, _C; stage_rc(tid * 16 + _i * 8192, _R, _C); \
        _Pragma("unroll") for (int _h = 0; _h < 2; ++_h) { int _t = g.rowidx[(unit).pm * BM + _h * HALF + _R]; _t = _t < 0 ? 0 : _t; dst[_h][_i] = (unsigned)(_t * K + _C) * 2u; } } } } while (0)
#define PG8_LDA(dst, b, h) do { _Pragma("unroll") for (int m = 0; m < 4; ++m) _Pragma("unroll") for (int k = 0; k < 2; ++k) dst[m][k] = *(const PG8_LAS bf16x8*)(lds + PG8_SA(b, h) + aoff + m * 2048 + k * 1024); } while (0)
#define PG8_LDB(dst, b, h) do { _Pragma("unroll") for (int n = 0; n < 2; ++n) _Pragma("unroll") for (int k = 0; k < 2; ++k) dst[n][k] = *(const PG8_LAS bf16x8*)(lds + PG8_SB(b, h) + boff + n * 2048 + k * 1024); } while (0)
#define PG8_MMA(ai, bj, At, Bt) do { __builtin_amdgcn_s_setprio(1); _Pragma("unroll") for (int m = 0; m < 4; ++m) _Pragma("unroll") for (int n = 0; n < 2; ++n) _Pragma("unroll") for (int k = 0; k < 2; ++k) \
        acc[ai][bj][m][n] = __builtin_amdgcn_mfma_f32_16x16x32_bf16(Bt[n][k], At[m][k], acc[ai][bj][m][n], 0, 0, 0); __builtin_amdgcn_s_setprio(0); } while (0)
#define PG8_WAIT_V(n) asm volatile("s_waitcnt vmcnt(" #n ")" ::: "memory")
#define PG8_WAIT_L(n) asm volatile("s_waitcnt lgkmcnt(" #n ")" ::: "memory")
#define PG8_BAR __builtin_amdgcn_s_barrier()
#define PG8_SCHED __builtin_amdgcn_sched_barrier(0)
    Unit cur, nxt; int ui = 0;
    if (!S.next(0, cur)) return;
    f32x4 acc[2][2][4][2];
#pragma unroll
    for (int a = 0; a < 2; ++a)
#pragma unroll
        for (int b = 0; b < 2; ++b)
#pragma unroll
            for (int m = 0; m < 4; ++m)
#pragma unroll
                for (int n = 0; n < 2; ++n) acc[a][b][m][n] = (f32x4){0.f, 0.f, 0.f, 0.f};
    bf16x8 At[4][2], B0[2][2], B1[2][2];
    const char* cA = GATHER ? (const char*)g.A : (const char*)g.A + (size_t)cur.pm * tstepA;
    const char* cB = (const char*)g.Bt + ((size_t)cur.e * g.bstride) * 2 + (size_t)cur.pn * tstep;
    PG8_LOADROWS(gvo, cur);
    PG8_STAGE(PG8_SB(0, 0), cB, voffB); PG8_STAGE(PG8_SB(0, 1), cB + hstep, voffB); PG8_STAGE_A(PG8_SA(0, 0), 0, cA, 0, false); PG8_STAGE_A(PG8_SA(0, 1), 1, cA, 0, false);
    if (wr == 1) PG8_BAR;
    PG8_WAIT_V(2); PG8_BAR;
    PG8_STAGE(PG8_SB(1, 0), cB + kstep, voffB); PG8_STAGE_A(PG8_SA(1, 0), 0, cA, kstep, false); PG8_STAGE(PG8_SB(1, 1), cB + hstep + kstep, voffB);
    PG8_WAIT_V(6); PG8_BAR;
    for (;;) {
        const bool has_next = S.next(ui + 1, nxt);
        const char* nA = GATHER ? (const char*)g.A : (has_next ? (const char*)g.A + (size_t)nxt.pm * tstepA : cA);
        const char* nB = has_next ? (const char*)g.Bt + ((size_t)nxt.e * g.bstride) * 2 + (size_t)nxt.pn * tstep : cB;
        for (int t = 0; t < nt; t += 2) {
            const bool last = (t == nt - 2);
            const size_t k1 = (size_t)(t + 1) * kstep;
            const size_t k2 = last ? 0 : (size_t)(t + 2) * kstep, k3 = k2 + kstep;
            const char* a2b = last ? nA : cA; const char* b2 = (last ? nB : cB) + k2; const char* b3 = b2 + kstep;
            PG8_LDB(B0, 0, 0); PG8_LDB(B1, 0, 1); PG8_SCHED; PG8_LDA(At, 0, 0); PG8_STAGE_A(PG8_SA(1, 1), 1, cA, k1, false);
            if (last && has_next) PG8_LOADROWS(gvo, nxt);
            PG8_WAIT_V(8); PG8_WAIT_L(0); PG8_BAR; PG8_MMA(0, 0, At, B0); PG8_MMA(0, 1, At, B1); PG8_BAR; PG8_SCHED;
            PG8_LDA(At, 0, 1); PG8_STAGE(PG8_SB(0, 0), b2, voffB); PG8_STAGE(PG8_SB(0, 1), b2 + hstep, voffB); PG8_STAGE_A(PG8_SA(0, 0), 0, a2b, k2, last);
            PG8_WAIT_V(8); PG8_WAIT_L(0); PG8_BAR; PG8_MMA(1, 0, At, B0); PG8_MMA(1, 1, At, B1); PG8_BAR; PG8_SCHED;
            PG8_LDB(B0, 1, 0); PG8_LDB(B1, 1, 1); PG8_SCHED; PG8_LDA(At, 1, 0); PG8_STAGE_A(PG8_SA(0, 1), 1, a2b, k2, last);
            PG8_WAIT_V(8); PG8_WAIT_L(0); PG8_BAR; PG8_MMA(0, 0, At, B0); PG8_MMA(0, 1, At, B1); PG8_BAR; PG8_SCHED;
            PG8_LDA(At, 1, 1); PG8_STAGE(PG8_SB(1, 0), b3, voffB); PG8_STAGE(PG8_SB(1, 1), b3 + hstep, voffB); PG8_STAGE_A(PG8_SA(1, 0), 0, a2b, k3, last);
            PG8_WAIT_V(8); PG8_WAIT_L(0); PG8_BAR; PG8_MMA(1, 0, At, B0); PG8_MMA(1, 1, At, B1); PG8_BAR; PG8_SCHED;
        }
        if (wr == 0) PG8_BAR;
        E(acc, cur, wr, wc, fr, fq);
        if (!has_next) break;
#pragma unroll
        for (int a = 0; a < 2; ++a)
#pragma unroll
            for (int b = 0; b < 2; ++b)
#pragma unroll
                for (int m = 0; m < 4; ++m)
#pragma unroll
                    for (int n = 0; n < 2; ++n) acc[a][b][m][n] = (f32x4){0.f, 0.f, 0.f, 0.f};
        cur = nxt; cA = nA; cB = nB; ++ui;
        if (wr == 1) PG8_BAR;
    }
    PG8_WAIT_V(0);
    PG8_BAR;
#undef PG8_SA
#undef PG8_SB
#undef PG8_STAGE
#undef PG8_STAGE_A
#undef PG8_LOADROWS
#undef PG8_LDA
#undef PG8_LDB
#undef PG8_MMA
#undef PG8_WAIT_V
#undef PG8_WAIT_L
#undef PG8_BAR
#undef PG8_SCHED
}
}
using pg8::bf16_t; using pg8::bf16x8; using pg8::f32x4; using pg8::f32x2; using pg8::u32x4; using pg8::u32x2; using pg8::pk2; using pg8::bf2f; using pg8::f2bf; using pg8::bf_lo; using pg8::bf_hi; using pg8::sigmoidf_;

constexpr int NWAVES = 8, NTHR = 512;
constexpr int D = 1024, NB = 32, SEQ = 2048, T = NB * SEQ, TH = T / 2, DEPTH = 4;
constexpr int RW_COLS = 1792, DS_COLS = 1224, DS_PAD = 1280, N_IN = 5064, N_INP = 5120;
constexpr int NMEM = 256, MEMROWS = NB * NMEM;
constexpr int FFN = 2816, NEXP = 8, EDIM = 1408;
constexpr int MOE_ROWS_MAX = 2 * T + 16 * 256;
constexpr int MOE_TILES_MAX = MOE_ROWS_MAX / 256;

constexpr size_t MiB = 1u << 20;
constexpr size_t WS_CTL = 0, CTL_ZERO_BYTES = 1 * MiB;
constexpr size_t WS_MOE = 1 * MiB;
constexpr size_t MOE_SELE = WS_MOE, MOE_SELW = MOE_SELE + (size_t)T * 2, MOE_ROWTOK = MOE_SELW + (size_t)T * 8, MOE_ROWW = MOE_ROWTOK + (size_t)MOE_ROWS_MAX * 4,
                 MOE_TILEE = MOE_ROWW + (size_t)MOE_ROWS_MAX * 4, MOE_META = MOE_TILEE + (size_t)MOE_TILES_MAX * 4, MOE_END = MOE_META + 256;
static_assert(MOE_END <= 4 * MiB, "moe map");
constexpr size_t WS_W = 4 * MiB;
constexpr size_t W_IN = WS_W, W_BA = W_IN + (size_t)N_INP * D * 2, W_BB = W_BA + (size_t)D * 512 * 2, W_OUT = W_BB + (size_t)D * 512 * 2, W_MQ = W_OUT + (size_t)D * D * 2,
                 W_MO = W_MQ + (size_t)512 * D * 2, W_FF = W_MO + (size_t)D * 512 * 2;
constexpr size_t W_RW2 = W_FF, W_RA2 = W_RW2 + 512 * 64 * 2, W_RG2 = W_RA2 + 512 * 64 * 2, W_RV1 = W_RG2 + 512 * 128 * 2, W_RV2 = W_RV1 + 32 * 512 * 2, W_FF2 = W_RV2 + 512 * 32 * 2;
constexpr size_t W_FGU = W_FF2, W_FD = W_FGU + (size_t)2 * FFN * D * 2;
constexpr size_t W_EGU = W_FF2, W_ED = W_EGU + (size_t)NEXP * 2 * EDIM * D * 2, W_END = W_ED + (size_t)NEXP * D * EDIM * 2;
static_assert(W_FD + (size_t)D * FFN * 2 <= W_END, "w map");
constexpr size_t WS_WKV = (W_END + MiB - 1) / MiB * MiB;
constexpr size_t WS_MEMH = WS_WKV + (size_t)4096 * D * 2;
constexpr size_t WS_MEMK = WS_MEMH + (size_t)MEMROWS * D * 2;
constexpr size_t WS_MEMVT = WS_MEMK + (size_t)DEPTH * MEMROWS * 512 * 2;
constexpr size_t WS_VFIRST = WS_MEMVT + (size_t)DEPTH * MEMROWS * 512 * 2;
constexpr size_t WS_HN = WS_VFIRST + (size_t)T * 512 * 2;
constexpr size_t WS_MIX = WS_HN + (size_t)T * D * 2;
constexpr size_t MX_CA = WS_MIX, MX_CB = MX_CA + (size_t)TH * RW_COLS * 2, MX_CG = MX_CB + (size_t)TH * DS_PAD * 2, MX_RW = MX_CG + (size_t)TH * 2048 * 2;
constexpr size_t RW_ARR = (size_t)TH * 512 * 2;
constexpr size_t MX_VT = MX_RW + 7 * RW_ARR, MX_YB = MX_VT + (size_t)(NB / 2) * 64 * SEQ * 2, MX_END = MX_YB + (size_t)TH * 512 * 2;
constexpr size_t MA_QM = WS_MIX, MA_OM = MA_QM + (size_t)T * 512 * 2;
constexpr size_t FF_GU = WS_MIX;
constexpr size_t PR_KVRAW = WS_MIX;
constexpr size_t MX_BS = MX_END;
constexpr size_t WS_END = MX_BS + (size_t)TH * 8 * 4;
static_assert(FF_GU + (size_t)T * FFN * 2 <= WS_END && FF_GU + (size_t)MOE_ROWS_MAX * EDIM * 2 <= WS_END && MA_OM + (size_t)T * 512 * 2 <= WS_END, "overlay map");
static_assert(WS_END <= 1000 * MiB, "workspace budget");

constexpr int LDS_BYTES = 160 * 1024;
constexpr int LDS_MISC = LDS_BYTES - 256;

#define XB_TMO      128
#define XB_XCNT(j)  (256  + 64 * (j))
#define XB_XSUB(j)  (1280 + 64 * (j))
#define XB_XGEN(j)  (2304 + 64 * (j))
#define XB_TOP      3328
#define XB_TOPGEN   3392
#define XCD_BAR_WORDS 3456
#define XB_SPIN_CAP (1u << 18)
#define LAS __attribute__((address_space(3)))

__device__ __forceinline__ unsigned xb_ld(unsigned* p)              { return __hip_atomic_load(p, __ATOMIC_RELAXED, __HIP_MEMORY_SCOPE_AGENT); }
__device__ __forceinline__ unsigned xb_add(unsigned* p, unsigned v) { return __hip_atomic_fetch_add(p, v, __ATOMIC_RELAXED, __HIP_MEMORY_SCOPE_AGENT); }
__device__ __forceinline__ unsigned xb_xcc_id() { return (unsigned)__builtin_amdgcn_s_getreg((3 << 11) | 20) & 0xFu; }
#define XB_SPIN(cond, bar) do { unsigned _sp = 0; while (cond) { __builtin_amdgcn_s_sleep(1); \
    if ((++_sp & 255u) == 0u) { if (xb_ld(&(bar)[XB_TMO])) break; if (_sp > XB_SPIN_CAP) { atomicAdd(&(bar)[XB_TMO], 1u); break; } } } } while (0)
struct XcdBarrier { unsigned* bar; unsigned x; volatile LAS unsigned* st; };
__device__ __forceinline__ XcdBarrier xcd_barrier_post(unsigned* bar, volatile LAS unsigned* st) {
    XcdBarrier b; b.bar = bar; b.x = xb_xcc_id(); b.st = st;
    if (threadIdx.x == 0) (void)xb_add(&bar[XB_XCNT(b.x)], 1u);
    return b;
}
__device__ __forceinline__ void xcd_barrier_complete(unsigned* bar, unsigned x, unsigned& nloc, unsigned& nx) {
    const unsigned G = gridDim.x * gridDim.y * gridDim.z;
    unsigned sum, cnt, mine, sp = 0u;
    for (;;) {
        sum = 0u; cnt = 0u; mine = 0u;
#pragma unroll
        for (unsigned j = 0; j < 16; ++j) { const unsigned c = xb_ld(&bar[XB_XCNT(j)]); sum += c; cnt += (c > 0u) ? 1u : 0u; mine = (j == x) ? c : mine; }
        if (sum == G) break;
        __builtin_amdgcn_s_sleep(1);
        if ((++sp & 255u) == 0u) { if (xb_ld(&bar[XB_TMO])) break; if (sp > XB_SPIN_CAP) { atomicAdd(&bar[XB_TMO], 1u); break; } }
    }
    nloc = mine > 0u ? mine : 1u; nx = cnt > 0u ? cnt : 1u;
}
__device__ __forceinline__ void xcd_barrier(const XcdBarrier& b, int tid) {
    asm volatile("s_waitcnt vmcnt(0)" ::: "memory");
    __syncthreads();
    if (tid == 0) {
        unsigned* bar = b.bar; asm volatile("" : "+s"(bar));
        __builtin_amdgcn_s_waitcnt(0);
        unsigned nloc = b.st[0], nx = b.st[1];
        if (nloc == 0u) { xcd_barrier_complete(bar, b.x, nloc, nx); b.st[0] = nloc; b.st[1] = nx; }
        const unsigned old = xb_add(&bar[XB_XSUB(b.x)], 1u);
        const unsigned gen = old / nloc;
        if (old + 1u == (gen + 1u) * nloc) {
            __builtin_amdgcn_fence(__ATOMIC_RELEASE, "agent");
            asm volatile("s_waitcnt vmcnt(0)" ::: "memory");
            const unsigned og = xb_add(&bar[XB_TOP], 1u);
            const unsigned tg = og / nx;
            if (og + 1u == (tg + 1u) * nx) xb_add(&bar[XB_TOPGEN], 1u);
            else XB_SPIN(xb_ld(&bar[XB_TOPGEN]) == tg, bar);
            __builtin_amdgcn_fence(__ATOMIC_ACQUIRE, "agent");
            xb_add(&bar[XB_XGEN(b.x)], 1u);
            asm volatile("s_waitcnt vmcnt(0)" ::: "memory");
        } else {
            XB_SPIN(xb_ld(&bar[XB_XGEN(b.x)]) == gen, bar);
            __builtin_amdgcn_fence(__ATOMIC_ACQUIRE, "agent");
            asm volatile("s_waitcnt vmcnt(0)" ::: "memory");
        }
    }
    __syncthreads();
}

struct Args { const void* in[41]; float* out; unsigned char* ws; int ph_lo, ph_hi; };
static_assert(sizeof(Args) == 41 * 8 + 8 + 8 + 8, "Args has no padding");

enum InIdx { I_X = 0, I_MEM, I_POS, I_NORM_MIX, I_W_IN, I_MU, I_W0, I_W2, I_A0, I_A2, I_G2, I_V0, I_V1, I_V2, I_KK, I_KA, I_RK, I_LNG, I_LNB, I_QN, I_KN, I_IKN,
             I_WBA, I_WBB, I_WOUT, I_NORM_MEM, I_MEM_TOKN, I_MWQ, I_MWKV, I_MQN, I_MKN, I_MWO, I_NORM_FFN, I_FWG, I_FWU, I_FWD, I_ROUTER, I_RBIAS, I_EWG, I_EWU, I_EWD };

typedef decltype(__builtin_amdgcn_kernarg_segment_ptr()) kptr_t;
struct Frame {
    LAS unsigned char* lds; unsigned char* ws; kptr_t kb; float* out;
    int tid, lane, wave, G, bid;
};
#define LDS_WAIT() asm volatile("s_waitcnt lgkmcnt(0)" ::: "memory")
__device__ __forceinline__ const void* kargp(kptr_t kb, int i) { typedef const void* cvp; typedef __attribute__((address_space(4))) const cvp* tab_t; return (const void*)(const __attribute__((address_space(1))) void*)(((tab_t)kb)[i]); }
#define KARGP(F, i) kargp((F).kb, (i))
#define FIN(F, i) ((const float*)KARGP(F, i))
__device__ __forceinline__ void lds_barrier() { asm volatile("s_waitcnt lgkmcnt(0)" ::: "memory"); __builtin_amdgcn_s_barrier(); asm volatile("" ::: "memory"); }

__device__ __forceinline__ float wave_sum(float v) {
#pragma unroll
    for (int o = 1; o < 64; o <<= 1) v += __shfl_xor(v, o);
    return v;
}

template <class Map>
__device__ __forceinline__ void transpose_item(const float* W, int K, int N, bf16_t* WT, const Map& map, const float* gain, LAS float* scr, int item, int lane) {
    const int nblk = (N + 31) / 32, kb = item / nblk, nb = item % nblk, k0 = 64 * kb, n0 = 32 * nb;
    const int nn = n0 + (lane & 31);
    float vv[32], gg[32];
#pragma unroll
    for (int i = 0; i < 32; ++i) { const int kk = 2 * i + (lane >> 5); vv[i] = 0.f; gg[i] = 1.f; if (nn < N && k0 + kk < K) { vv[i] = W[(size_t)(k0 + kk) * N + nn]; if (gain) gg[i] = gain[k0 + kk]; } }
#pragma unroll
    for (int i = 0; i < 32; ++i) { const int kk = 2 * i + (lane >> 5); scr[kk * 33 + (lane & 31)] = vv[i] * gg[i]; }
    LDS_WAIT(); asm volatile("" ::: "memory");
    const int c = lane & 7;
#pragma unroll
    for (int j = 0; j < 4; ++j) { const int n = (lane >> 3) + 8 * j; const LAS float* s = scr + (8 * c) * 33 + n;
        u32x4 o; o.x = pk2(s[0 * 33], s[1 * 33]); o.y = pk2(s[2 * 33], s[3 * 33]); o.z = pk2(s[4 * 33], s[5 * 33]); o.w = pk2(s[6 * 33], s[7 * 33]);
        if (n0 + n < N && k0 + 8 * c < K) *(u32x4*)(WT + (size_t)map(n0 + n) * K + k0 + 8 * c) = o; }
    LDS_WAIT(); asm volatile("" ::: "memory");
}
struct MapId { int off; __device__ int operator()(int n) const { return n + off; } };
struct MapWin { __device__ int operator()(int n) const { return n < 3016 ? n : n + 56; } };
struct MapGU { int up; __device__ int operator()(int n) const { return (n >> 7) * 256 + up * 128 + (n & 127); } };

__device__ __forceinline__ void rms_row_to_bf16(const float* xrow, bf16_t* orow, int lane, f32x4 (&v)[4]) {
    const f32x4* xr = (const f32x4*)xrow + lane; float s = 0.f;
#pragma unroll
    for (int j = 0; j < 4; ++j) { v[j] = xr[64 * j]; s += (v[j].x * v[j].x + v[j].y * v[j].y) + (v[j].z * v[j].z + v[j].w * v[j].w); }
    const float rstd = 1.0f / sqrtf(wave_sum(s) * (1.f / D) + 1e-6f);
    u32x2* o8 = (u32x2*)orow + lane;
#pragma unroll
    for (int j = 0; j < 4; ++j) { v[j] = v[j] * rstd; u32x2 w; w.x = pk2(v[j].x, v[j].y); w.y = pk2(v[j].z, v[j].w); o8[64 * j] = w; }
}

__device__ __forceinline__ void rms_pass_to_bf16(const float* x, bf16_t* o, int first, int stride, int lane) {
    f32x4 v[4][4], n[4][4];
#pragma unroll
    for (int r = 0; r < 4; ++r) { const f32x4* xr = (const f32x4*)(x + (size_t)(first + r * stride) * D) + lane;
#pragma unroll
        for (int j = 0; j < 4; ++j) n[r][j] = xr[64 * j]; }
#pragma unroll 1
    for (int m0 = first; m0 < T; m0 += 4 * stride) {
#pragma unroll
        for (int r = 0; r < 4; ++r)
#pragma unroll
            for (int j = 0; j < 4; ++j) { v[r][j] = n[r][j]; asm volatile("" : "+v"(v[r][j])); }
        { const int mn = (m0 + 4 * stride < T) ? m0 + 4 * stride : m0;
#pragma unroll
          for (int r = 0; r < 4; ++r) { const f32x4* xr = (const f32x4*)(x + (size_t)(mn + r * stride) * D) + lane;
#pragma unroll
              for (int j = 0; j < 4; ++j) n[r][j] = xr[64 * j]; }
          asm volatile("" ::: "memory"); }
        float s[4];
#pragma unroll
        for (int r = 0; r < 4; ++r) { s[r] = 0.f;
#pragma unroll
            for (int j = 0; j < 4; ++j) s[r] += (v[r][j].x * v[r][j].x + v[r][j].y * v[r][j].y) + (v[r][j].z * v[r][j].z + v[r][j].w * v[r][j].w); }
#pragma unroll
        for (int o_ = 1; o_ < 64; o_ <<= 1) {
#pragma unroll
            for (int r = 0; r < 4; ++r) s[r] += __shfl_xor(s[r], o_); }
#pragma unroll
        for (int r = 0; r < 4; ++r) { const float rstd = 1.0f / sqrtf(s[r] * (1.f / D) + 1e-6f); u32x2* o8 = (u32x2*)(o + (size_t)(m0 + r * stride) * D) + lane;
#pragma unroll
            for (int j = 0; j < 4; ++j) { const f32x4 t = v[r][j] * rstd; u32x2 w; w.x = pk2(t.x, t.y); w.y = pk2(t.z, t.w); o8[64 * j] = w; } }
    }
}
__device__ __forceinline__ void ph_prologue0(Frame& F) {
    LAS float* scr = (LAS float*)(F.lds + F.wave * 16384);
    const int gw = F.bid * NWAVES + F.wave, NGW = F.G * NWAVES;
    bf16_t* wkv = (bf16_t*)(F.ws + WS_WKV);
    constexpr int IT = (D / 64) * (1024 / 32);
    for (int it = gw; it < DEPTH * IT; it += NGW) { const int l = it / IT, r = it % IT;
        transpose_item(FIN(F, I_MWKV) + (size_t)l * D * 1024, D, 1024, wkv, MapId{l * 1024}, FIN(F, I_MEM_TOKN) + l * D, scr, r, F.lane); }
    bf16_t* mh = (bf16_t*)(F.ws + WS_MEMH);
    for (int m = gw; m < MEMROWS; m += NGW) { f32x4 v[4]; rms_row_to_bf16(FIN(F, I_MEM) + (size_t)m * D, mh + (size_t)m * D, F.lane, v); }
}
__device__ __forceinline__ void ph_prologue2(Frame& F) {
    const int gw = F.bid * NWAVES + F.wave, NGW = F.G * NWAVES;
    const bf16_t* kv = (const bf16_t*)(F.ws + PR_KVRAW);
    bf16_t* MK = (bf16_t*)(F.ws + WS_MEMK); bf16_t* MVT = (bf16_t*)(F.ws + WS_MEMVT);
    for (int it = gw; it < MEMROWS * 16; it += NGW) {
        const int row = it >> 4, l = (it >> 2) & 3, hh = it & 3, b = row >> 8, m = row & 255;
        const bf16_t* src = kv + (size_t)row * 4096 + l * 1024;
        const unsigned kk = *(const unsigned*)(src + hh * 128 + 2 * F.lane);
        const float k0 = bf_lo(kk), k1 = bf_hi(kk);
        const float rstd = 1.0f / sqrtf(wave_sum(k0 * k0 + k1 * k1) * (1.f / 128.f) + 1e-6f);
        const float* gk = FIN(F, I_MKN) + l * 128;
        *(unsigned*)(MK + ((((size_t)l * NB + b) * 4 + hh) * 256 + m) * 128 + 2 * F.lane) = pk2(k0 * rstd * gk[2 * F.lane], k1 * rstd * gk[2 * F.lane + 1]);
        const unsigned vv = *(const unsigned*)(src + 512 + hh * 128 + 2 * F.lane);
        bf16_t* vt = MVT + (((size_t)l * NB + b) * 4 + hh) * 128 * 256 + m;
        vt[(size_t)(2 * F.lane) * 256] = (bf16_t)(vv & 0xffffu); vt[(size_t)(2 * F.lane + 1) * 256] = (bf16_t)(vv >> 16);
    }
}
__device__ __forceinline__ void ph_layer0(Frame& F, int l, const float* xin) {
    LAS float* scr = (LAS float*)(F.lds + F.wave * 16384);
    const int gw = F.bid * NWAVES + F.wave, NGW = F.G * NWAVES;
    unsigned char* ws = F.ws;
    constexpr int I_WIN = (D / 64) * ((N_IN + 31) / 32), I_B = (512 / 64) * (D / 32), I_O = (D / 64) * (D / 32), I_Q = (D / 64) * (512 / 32);
    constexpr int I_FG = (D / 64) * (FFN / 32), I_FDN = (FFN / 64) * (D / 32), I_EG = (D / 64) * (EDIM / 32), I_EDN = (EDIM / 64) * (D / 32);
    const bool moe = (l & 1) != 0; const int j = l >> 1;
    const int nff = moe ? NEXP * (2 * I_EG + I_EDN) : (2 * I_FG + I_FDN);
    constexpr int I_R2 = 16, I_RG = 32, I_RV1 = 8, I_RV2 = 16;
    const int nrw = 2 * I_R2 + I_RG + (l ? I_RV1 + I_RV2 : 0);
    const int NIT = I_WIN + 2 * I_B + I_O + I_Q + I_B + nrw + nff;
    const float* gffn = FIN(F, I_NORM_FFN) + l * D;
    for (int it = gw; it < NIT; it += NGW) {
        int r = it;
        if (r < I_WIN) { transpose_item(FIN(F, I_W_IN) + (size_t)l * D * N_IN, D, N_IN, (bf16_t*)(ws + W_IN), MapWin{}, FIN(F, I_NORM_MIX) + l * D, scr, r, F.lane); continue; } r -= I_WIN;
        if (r < I_B) { transpose_item(FIN(F, I_WBA) + (size_t)l * 512 * D, 512, D, (bf16_t*)(ws + W_BA), MapId{0}, nullptr, scr, r, F.lane); continue; } r -= I_B;
        if (r < I_B) { transpose_item(FIN(F, I_WBB) + (size_t)l * 512 * D, 512, D, (bf16_t*)(ws + W_BB), MapId{0}, nullptr, scr, r, F.lane); continue; } r -= I_B;
        if (r < I_O) { transpose_item(FIN(F, I_WOUT) + (size_t)l * D * D, D, D, (bf16_t*)(ws + W_OUT), MapId{0}, nullptr, scr, r, F.lane); continue; } r -= I_O;
        if (r < I_Q) { transpose_item(FIN(F, I_MWQ) + (size_t)l * D * 512, D, 512, (bf16_t*)(ws + W_MQ), MapId{0}, FIN(F, I_NORM_MEM) + l * D, scr, r, F.lane); continue; } r -= I_Q;
        if (r < I_B) { transpose_item(FIN(F, I_MWO) + (size_t)l * 512 * D, 512, D, (bf16_t*)(ws + W_MO), MapId{0}, nullptr, scr, r, F.lane); continue; } r -= I_B;
        if (r < nrw) {
            if (r < I_R2) { transpose_item(FIN(F, I_W2) + (size_t)l * 64 * 512, 64, 512, (bf16_t*)(ws + W_RW2), MapId{0}, nullptr, scr, r, F.lane); continue; } r -= I_R2;
            if (r < I_R2) { transpose_item(FIN(F, I_A2) + (size_t)l * 64 * 512, 64, 512, (bf16_t*)(ws + W_RA2), MapId{0}, nullptr, scr, r, F.lane); continue; } r -= I_R2;
            if (r < I_RG) { transpose_item(FIN(F, I_G2) + (size_t)l * 128 * 512, 128, 512, (bf16_t*)(ws + W_RG2), MapId{0}, nullptr, scr, r, F.lane); continue; } r -= I_RG;
            if (r < I_RV1) { transpose_item(FIN(F, I_V1) + (size_t)(l - 1) * 512 * 32, 512, 32, (bf16_t*)(ws + W_RV1), MapId{0}, nullptr, scr, r, F.lane); continue; } r -= I_RV1;
            transpose_item(FIN(F, I_V2) + (size_t)(l - 1) * 32 * 512, 32, 512, (bf16_t*)(ws + W_RV2), MapId{0}, nullptr, scr, r, F.lane); continue;
        }
        r -= nrw;
        if (!moe) {
            if (r < I_FG) { transpose_item(FIN(F, I_FWG) + (size_t)j * D * FFN, D, FFN, (bf16_t*)(ws + W_FGU), MapGU{0}, gffn, scr, r, F.lane); continue; } r -= I_FG;
            if (r < I_FG) { transpose_item(FIN(F, I_FWU) + (size_t)j * D * FFN, D, FFN, (bf16_t*)(ws + W_FGU), MapGU{1}, gffn, scr, r, F.lane); continue; } r -= I_FG;
            transpose_item(FIN(F, I_FWD) + (size_t)j * FFN * D, FFN, D, (bf16_t*)(ws + W_FD), MapId{0}, nullptr, scr, r, F.lane);
        } else {
            const int per = 2 * I_EG + I_EDN, e = r / per; r -= e * per;
            const size_t eo = (size_t)(j * NEXP + e);
            if (r < I_EG) { transpose_item(FIN(F, I_EWG) + eo * D * EDIM, D, EDIM, (bf16_t*)(ws + W_EGU) + (size_t)e * 2 * EDIM * D, MapGU{0}, gffn, scr, r, F.lane); continue; } r -= I_EG;
            if (r < I_EG) { transpose_item(FIN(F, I_EWU) + eo * D * EDIM, D, EDIM, (bf16_t*)(ws + W_EGU) + (size_t)e * 2 * EDIM * D, MapGU{1}, gffn, scr, r, F.lane); continue; } r -= I_EG;
            transpose_item(FIN(F, I_EWD) + eo * EDIM * D, EDIM, D, (bf16_t*)(ws + W_ED) + (size_t)e * D * EDIM, MapId{0}, nullptr, scr, r, F.lane);
        }
    }
    { u32x4* z = (u32x4*)((bf16_t*)(ws + W_IN) + (size_t)3016 * D); const int n16 = 56 * D * 2 / 16;
      for (int i = F.bid * NTHR + F.tid; i < n16; i += F.G * NTHR) z[i] = (u32x4){0u, 0u, 0u, 0u}; }
    bf16_t* hn = (bf16_t*)(ws + WS_HN);
    rms_pass_to_bf16(xin, hn, gw, NGW, F.lane);
}
__device__ __forceinline__ void ph_norm(Frame& F) {
    const int gw = F.bid * NWAVES + F.wave, NGW = F.G * NWAVES;
    bf16_t* hn = (bf16_t*)(F.ws + WS_HN);
    rms_pass_to_bf16(F.out, hn, gw, NGW, F.lane);
}
__device__ __forceinline__ void ph_norm_ffn(Frame& F, int l) {
    const int gw = F.bid * NWAVES + F.wave, NGW = F.G * NWAVES;
    bf16_t* hn = (bf16_t*)(F.ws + WS_HN);
    const bool moe = (l & 1) != 0; const int j = l >> 1;
    const float* gn = FIN(F, I_NORM_FFN) + l * D;
    const float* rt = FIN(F, I_ROUTER) + (size_t)j * D * NEXP; const float* rb = FIN(F, I_RBIAS) + j * NEXP;
    unsigned short* sele = (unsigned short*)(F.ws + MOE_SELE); f32x2* selw = (f32x2*)(F.ws + MOE_SELW);
    if (!moe) { rms_pass_to_bf16(F.out, hn, gw, NGW, F.lane); return; }
    for (int m = gw; m < T; m += NGW) {
        f32x4 v[4]; rms_row_to_bf16(F.out + (size_t)m * D, hn + (size_t)m * D, F.lane, v);
        if (moe) {
            float lg[8];
#pragma unroll
            for (int e = 0; e < 8; ++e) lg[e] = 0.f;
#pragma unroll
            for (int q = 0; q < 4; ++q)
#pragma unroll
                for (int c = 0; c < 4; ++c) { const int k = 256 * q + 4 * F.lane + c; const float h = v[q][c] * gn[k];
                    const f32x4 r0 = *(const f32x4*)(rt + (size_t)k * 8), r1 = *(const f32x4*)(rt + (size_t)k * 8 + 4);
                    lg[0] += h * r0.x; lg[1] += h * r0.y; lg[2] += h * r0.z; lg[3] += h * r0.w; lg[4] += h * r1.x; lg[5] += h * r1.y; lg[6] += h * r1.z; lg[7] += h * r1.w; }
#pragma unroll
            for (int e = 0; e < 8; ++e) lg[e] = wave_sum(lg[e]) + rb[e];
            int e0 = 0; float l0 = lg[0];
#pragma unroll
            for (int e = 1; e < 8; ++e) if (lg[e] > l0) { l0 = lg[e]; e0 = e; }
            int e1 = -1; float l1 = -3.0e38f;
#pragma unroll
            for (int e = 0; e < 8; ++e) if (e != e0 && lg[e] > l1) { l1 = lg[e]; e1 = e; }
            const float w1 = 1.0f / (1.0f + __expf(l0 - l1)), w0 = 1.0f - w1;
            if (F.lane == 0) { sele[m] = (unsigned short)(e0 | (e1 << 8)); selw[m] = (f32x2){w0, w1}; }
        }
    }
}

#define MFMA16(x, y, c) __builtin_amdgcn_mfma_f32_16x16x32_bf16((x), (y), (c), 0, 0, 0)
__device__ __forceinline__ float softplusf_(float x) { return fmaxf(x, 0.f) + log1pf(expf(-fabsf(x))); }
typedef __attribute__((address_space(3))) bf16_t lbf;
constexpr int LDP = 72;
constexpr int SLOT = 64 * LDP * 2;
__device__ __forceinline__ f32x4 unpack4(u32x2 u) { return (f32x4){bf_lo(u.x), bf_hi(u.x), bf_lo(u.y), bf_hi(u.y)}; }
__device__ __forceinline__ u32x2 pack4(f32x4 v) { u32x2 o; o.x = pk2(v[0], v[1]); o.y = pk2(v[2], v[3]); return o; }
__device__ __forceinline__ size_t rwo(int t, int col) { return ((size_t)((t >> 6) * 32 + (col >> 4)) << 10) + (size_t)(((t & 63) << 4) + (col & 15)); }
__device__ __forceinline__ void mm64(const lbf* X, const lbf* Y, int w, int jl, int g, f32x4 (&acc)[2]) {
    const lbf* xr = X + (16 * (w & 3) + jl) * LDP + 8 * g;
    const lbf* yr = Y + (16 * (2 * (w >> 2)) + jl) * LDP + 8 * g;
    const bf16x8 x0 = *(const LAS bf16x8*)xr, x1 = *(const LAS bf16x8*)(xr + 32);
    const bf16x8 y00 = *(const LAS bf16x8*)yr, y01 = *(const LAS bf16x8*)(yr + 32), y10 = *(const LAS bf16x8*)(yr + 16 * LDP), y11 = *(const LAS bf16x8*)(yr + 16 * LDP + 32);
    acc[0] = MFMA16(x0, y00, acc[0]); acc[1] = MFMA16(x0, y10, acc[1]); acc[0] = MFMA16(x1, y01, acc[0]); acc[1] = MFMA16(x1, y11, acc[1]);
}
struct FrX { bf16x8 k0, k1; }; struct FrY { bf16x8 a0, a1, b0, b1; };
__device__ __forceinline__ FrX ldx64(const lbf* X, int w, int jl, int g) { const lbf* xr = X + (16 * (w & 3) + jl) * LDP + 8 * g; FrX f; f.k0 = *(const LAS bf16x8*)xr; f.k1 = *(const LAS bf16x8*)(xr + 32); return f; }
__device__ __forceinline__ FrY ldy64(const lbf* Y, int w, int jl, int g) { const lbf* yr = Y + (16 * (2 * (w >> 2)) + jl) * LDP + 8 * g; FrY f;
    f.a0 = *(const LAS bf16x8*)yr; f.a1 = *(const LAS bf16x8*)(yr + 32); f.b0 = *(const LAS bf16x8*)(yr + 16 * LDP); f.b1 = *(const LAS bf16x8*)(yr + 16 * LDP + 32); return f; }
__device__ __forceinline__ void mma64(const FrX& x, const FrY& y, f32x4 (&acc)[2]) {
    acc[0] = MFMA16(x.k0, y.a0, acc[0]); acc[1] = MFMA16(x.k0, y.b0, acc[1]); acc[0] = MFMA16(x.k1, y.a1, acc[0]); acc[1] = MFMA16(x.k1, y.b1, acc[1]); }
__device__ __forceinline__ void st_t(lbf* dst, const f32x4 (&acc)[2], int w, int jl, int g) {
#pragma unroll
    for (int i = 0; i < 2; ++i) *(LAS u32x2*)(dst + (16 * (2 * (w >> 2) + i) + jl) * LDP + 16 * (w & 3) + 4 * g) = pack4(acc[i]);
}
__device__ __forceinline__ void st_n(lbf* dst, const f32x4 (&acc)[2], int w, int jl, int g) {
#pragma unroll
    for (int i = 0; i < 2; ++i)
#pragma unroll
        for (int r = 0; r < 4; ++r) dst[(16 * (w & 3) + 4 * g + r) * LDP + 16 * (2 * (w >> 2) + i) + jl] = f2bf(acc[i][r]);
}
#define ZACC(a) do { a[0] = (f32x4){0.f, 0.f, 0.f, 0.f}; a[1] = (f32x4){0.f, 0.f, 0.f, 0.f}; } while (0)

constexpr int XA_LD = 264, XV_LD = 520, VM_LD = 40;
__device__ __forceinline__ void ph_rwkv_pre(Frame& F, int l, int half) {
    lbf* XA = (lbf*)F.lds;
    lbf* XV = (lbf*)(F.lds + 64 * XA_LD * 2);
    lbf* VM = (lbf*)(F.lds + 64 * XA_LD * 2 + 64 * XV_LD * 2);
    const bf16_t* CA = (const bf16_t*)(F.ws + MX_CA);
    bf16_t* RW = (bf16_t*)(F.ws + MX_RW); constexpr size_t AS_ = (size_t)TH * 512;
    bf16_t* VF = (bf16_t*)(F.ws + WS_VFIRST) + (size_t)half * TH * 512;
    const bf16_t* W2T = (const bf16_t*)(F.ws + W_RW2); const bf16_t* A2T = (const bf16_t*)(F.ws + W_RA2); const bf16_t* G2T = (const bf16_t*)(F.ws + W_RG2);
    const bf16_t* V1T = (const bf16_t*)(F.ws + W_RV1); const bf16_t* V2T = (const bf16_t*)(F.ws + W_RV2);
    const float* mu = FIN(F, I_MU) + l * RW_COLS;
    const int lane = F.lane, w = F.wave, jl = lane & 15, g = lane >> 4;
    for (int tile = F.bid; tile < TH / 64; tile += F.G) {
        const int t0 = tile * 64;
        lds_barrier();
        for (int it = F.tid; it < 64 * 32; it += NTHR) { const int i = it >> 5, c = 1536 + (it & 31) * 8; const int t = t0 + i;
            const u32x4 cu = *(const u32x4*)(CA + (size_t)t * RW_COLS + c);
            u32x4 pv = (u32x4){0u, 0u, 0u, 0u}; if ((t & (SEQ - 1)) != 0) pv = *(const u32x4*)(CA + (size_t)(t - 1) * RW_COLS + c);
            const float cv[8] = { bf_lo(cu.x), bf_hi(cu.x), bf_lo(cu.y), bf_hi(cu.y), bf_lo(cu.z), bf_hi(cu.z), bf_lo(cu.w), bf_hi(cu.w) };
            const float pp[8] = { bf_lo(pv.x), bf_hi(pv.x), bf_lo(pv.y), bf_hi(pv.y), bf_lo(pv.z), bf_hi(pv.z), bf_lo(pv.w), bf_hi(pv.w) };
            float x[8];
#pragma unroll
            for (int q = 0; q < 8; ++q) { x[q] = cv[q] + (pp[q] - cv[q]) * mu[c + q]; if (c < 1600) x[q] = 1.0f - 2.0f * __builtin_amdgcn_rcpf(1.0f + __expf(2.0f * x[q])); else if (c >= 1664) x[q] = sigmoidf_(x[q]); }
            u32x4 o; o.x = pk2(x[0], x[1]); o.y = pk2(x[2], x[3]); o.z = pk2(x[4], x[5]); o.w = pk2(x[6], x[7]);
            *(LAS u32x4*)(XA + i * XA_LD + (c - 1536)) = o; }
        if (l) for (int it = F.tid; it < 64 * 64; it += NTHR) { const int i = it >> 6, c = 1024 + (it & 63) * 8; const int t = t0 + i;
            const u32x4 cu = *(const u32x4*)(CA + (size_t)t * RW_COLS + c);
            u32x4 pv = (u32x4){0u, 0u, 0u, 0u}; if ((t & (SEQ - 1)) != 0) pv = *(const u32x4*)(CA + (size_t)(t - 1) * RW_COLS + c);
            const float cv[8] = { bf_lo(cu.x), bf_hi(cu.x), bf_lo(cu.y), bf_hi(cu.y), bf_lo(cu.z), bf_hi(cu.z), bf_lo(cu.w), bf_hi(cu.w) };
            const float pp[8] = { bf_lo(pv.x), bf_hi(pv.x), bf_lo(pv.y), bf_hi(pv.y), bf_lo(pv.z), bf_hi(pv.z), bf_lo(pv.w), bf_hi(pv.w) };
            float x[8];
#pragma unroll
            for (int q = 0; q < 8; ++q) x[q] = cv[q] + (pp[q] - cv[q]) * mu[c + q];
            u32x4 o; o.x = pk2(x[0], x[1]); o.y = pk2(x[2], x[3]); o.z = pk2(x[4], x[5]); o.w = pk2(x[6], x[7]);
            *(LAS u32x4*)(XV + i * XV_LD + (c - 1024)) = o; }
        lds_barrier();
        if (l) { const int tg = w & 3, nt = w >> 2; f32x4 a = (f32x4){0.f, 0.f, 0.f, 0.f};
            const bf16_t* xr = V1T + (size_t)(16 * nt + jl) * 512 + 8 * g; const lbf* yr = XV + (16 * tg + jl) * XV_LD + 8 * g;
#pragma unroll 4
            for (int s = 0; s < 16; ++s) a = MFMA16(*(const bf16x8*)(xr + 32 * s), *(const LAS bf16x8*)(yr + 32 * s), a);
            *(LAS u32x2*)(VM + (16 * tg + jl) * VM_LD + 16 * nt + 4 * g) = pack4(a); }
        lds_barrier();
        { bf16_t* XAG = RW + 0 * AS_; bf16_t* VMG = RW + 2 * AS_;
#pragma unroll
          for (int i = 0; i < 4; ++i) { const int id = F.tid + NTHR * i, row = id >> 5, c16 = id & 31; *(u32x4*)(XAG + (size_t)(t0 + row) * 256 + 8 * c16) = *(const LAS u32x4*)(XA + row * XA_LD + 8 * c16); }
          if (l && F.tid < 256) { const int row = F.tid >> 2, c8 = F.tid & 3; *(u32x4*)(VMG + (size_t)(t0 + row) * 32 + 8 * c8) = *(const LAS u32x4*)(VM + row * VM_LD + 8 * c8); } }
    }
}

__device__ __forceinline__ void ph_rwkv_s1(Frame& F, int l, int half) {
    bf16_t* RW = (bf16_t*)(F.ws + MX_RW); constexpr size_t AS_ = (size_t)TH * 512;
    float* BSW = (float*)(F.ws + MX_BS); const float* rkw = FIN(F, I_RK) + l * 512;
    bf16_t* YH = (bf16_t*)(F.ws + MX_CA);
    LAS unsigned char* L = F.lds;
#define SL(i) ((lbf*)(L + (i) * SLOT))
    lbf *AT = SL(0), *BT = SL(1), *KT = SL(2), *RT = SL(3), *ATt = SL(4), *Vt = SL(5), *BPt = SL(6), *KPt = SL(7), *AAK = SL(10), *ARB = SL(11), *ARK = SL(12);
    LAS float* EL = (LAS float*)(L + 8 * SLOT);
    LAS float* SEGT = (LAS float*)(L + 10 * SLOT);
    LAS float* PC = (LAS float*)(L + 16 * SLOT);
    const int lane = F.lane, w = F.wave, jl = lane & 15, g = lane >> 4;
    const int tok = F.tid >> 3, cg = F.tid & 7;
    const bf16_t* CA = (const bf16_t*)(F.ws + MX_CA); bf16_t* VF = (bf16_t*)(F.ws + WS_VFIRST) + (size_t)half * TH * 512;
    const bf16_t* XAG = RW + 0 * AS_; const bf16_t* VMG = RW + 2 * AS_;
    const bf16_t* W2T = (const bf16_t*)(F.ws + W_RW2); const bf16_t* A2T = (const bf16_t*)(F.ws + W_RA2); const bf16_t* G2T = (const bf16_t*)(F.ws + W_RG2); const bf16_t* V2T = (const bf16_t*)(F.ws + W_RV2);
    const float* mu = FIN(F, I_MU) + l * RW_COLS;
    lbf* XAs = (lbf*)L; lbf* VMs = SL(4);
    const int h = F.bid & 7, nt = w & 3, n0 = 64 * h + 16 * nt, n = n0 + 4 * g;
    LAS float* PRM = (LAS float*)(L + 16 * SLOT + 256);
    lds_barrier();
    { const int a_ = F.tid >> 6, c_ = F.tid & 63, col = 64 * h + c_; float v_ = 0.f;
      if (a_ < 3) v_ = mu[512 * a_ + col]; else if (a_ == 3) v_ = FIN(F, I_W0)[l * 512 + col]; else if (a_ == 4) v_ = FIN(F, I_A0)[l * 512 + col]; else if (a_ == 5) v_ = FIN(F, I_KK)[l * 512 + col];
      else if (a_ == 6) v_ = FIN(F, I_KA)[l * 512 + col]; else if (l) v_ = FIN(F, I_V0)[(l - 1) * 512 + col];
      PRM[F.tid] = v_; }
    u32x4 cxa[4]; u32x2 cvm = (u32x2){0u, 0u}; u32x2 crc[2], ckc[2], cvc[2], crp[2], ckp[2], cvp[2], cvf[2]; bf16x8 xw[2], xa[2], xg[4], xm = {0, 0, 0, 0, 0, 0, 0, 0};
#define A0_LOAD(u_) do { const int uu_ = (u_) < (TH / 64) * 8 ? (u_) : F.bid; const int tz_ = (uu_ >> 3) * 64; \
        _Pragma("unroll") for (int i = 0; i < 4; ++i) { const int id = F.tid + NTHR * i; cxa[i] = *(const u32x4*)(XAG + (size_t)(tz_ + (id >> 5)) * 256 + 8 * (id & 31)); } \
        if (l) cvm = *(const u32x2*)(VMG + (size_t)(tz_ + (F.tid >> 3)) * 32 + 4 * (F.tid & 7)); \
        _Pragma("unroll") for (int tgi = 0; tgi < 2; ++tgi) { const int t_ = tz_ + 16 * (2 * (w >> 2) + tgi) + jl; const bf16_t* cr_ = CA + (size_t)t_ * RW_COLS + n; const bool hp_ = (t_ & (SEQ - 1)) != 0; \
            crc[tgi] = *(const u32x2*)cr_; ckc[tgi] = *(const u32x2*)(cr_ + 512); cvc[tgi] = *(const u32x2*)(cr_ + 1024); crp[tgi] = (u32x2){0u, 0u}; ckp[tgi] = crp[tgi]; cvp[tgi] = crp[tgi]; cvf[tgi] = crp[tgi]; \
            if (hp_) { crp[tgi] = *(const u32x2*)(cr_ - RW_COLS); ckp[tgi] = *(const u32x2*)(cr_ - RW_COLS + 512); cvp[tgi] = *(const u32x2*)(cr_ - RW_COLS + 1024); } \
            if (l) cvf[tgi] = *(const u32x2*)(VF + rwo(t_, n)); } } while (0)
#define A0_LOADX() do { \
        { const bf16_t* pw = W2T + (size_t)(n0 + jl) * 64 + 8 * g; const bf16_t* pa = A2T + (size_t)(n0 + jl) * 64 + 8 * g; const bf16_t* pg = G2T + (size_t)(n0 + jl) * 128 + 8 * g; \
          _Pragma("unroll") for (int s2 = 0; s2 < 2; ++s2) { xw[s2] = *(const bf16x8*)(pw + 32 * s2); xa[s2] = *(const bf16x8*)(pa + 32 * s2); } \
          _Pragma("unroll") for (int s2 = 0; s2 < 4; ++s2) xg[s2] = *(const bf16x8*)(pg + 32 * s2); \
          if (l) xm = *(const bf16x8*)(V2T + (size_t)(n0 + jl) * 32 + 8 * g); } } while (0)
    A0_LOAD(F.bid); A0_LOADX();
    for (int u = F.bid; u < (TH / 64) * 8; u += F.G) {
        const int ch = u >> 3, t0 = ch * 64;
        lds_barrier();
#pragma unroll
        for (int i = 0; i < 4; ++i) { const int id = F.tid + NTHR * i; *(LAS u32x4*)(XAs + (id >> 5) * XA_LD + 8 * (id & 31)) = cxa[i]; }
        if (l) *(LAS u32x2*)(VMs + (F.tid >> 3) * VM_LD + 4 * (F.tid & 7)) = cvm;
        lds_barrier();
        {
            const LAS f32x4* pp_ = (const LAS f32x4*)(PRM + 16 * nt + 4 * g);
            const f32x4 mr = pp_[0], mk = pp_[16], mv = pp_[32], w0 = pp_[48], a0 = pp_[64], kkw = pp_[80], ka = pp_[96], v0 = pp_[112];
#pragma unroll
            for (int tgi = 0; tgi < 2; ++tgi) {
                const int tl = 16 * (2 * (w >> 2) + tgi) + jl, t = t0 + tl;
                const f32x4 rc = unpack4(crc[tgi]), kc = unpack4(ckc[tgi]), vc = unpack4(cvc[tgi]), rp = unpack4(crp[tgi]), kp = unpack4(ckp[tgi]), vp = unpack4(cvp[tgi]), vf = unpack4(cvf[tgi]);
                const size_t o = rwo(t, n);
                const lbf* ya = XAs + tl * XA_LD + 8 * g;
                bf16x8 yf[9];
#pragma unroll
                for (int s2 = 0; s2 < 8; ++s2) yf[s2] = *(const LAS bf16x8*)(ya + 32 * s2);
                yf[8] = *(const LAS bf16x8*)(VMs + tl * VM_LD + 8 * g);
                f32x4 aw = (f32x4){0.f, 0.f, 0.f, 0.f}, aa = aw, ag = aw, am = aw;
#pragma unroll
                for (int s2 = 0; s2 < 2; ++s2) { aw = MFMA16(xw[s2], yf[s2], aw); aa = MFMA16(xa[s2], yf[2 + s2], aa); }
#pragma unroll
                for (int s2 = 0; s2 < 4; ++s2) ag = MFMA16(xg[s2], yf[4 + s2], ag);
                if (l) am = MFMA16(xm, yf[8], am);
                const f32x4 r4 = rc + (rp - rc) * mr, k4 = kc + (kp - kc) * mk; f32x4 v4 = vc + (vp - vc) * mv;
                if (l) {
#pragma unroll
                    for (int q = 0; q < 4; ++q) v4[q] = v4[q] + (vf[q] - v4[q]) * sigmoidf_(v0[q] + am[q]); }
                else *(u32x2*)(VF + o) = pack4(v4);
                f32x4 e4, as4, k24, kk4;
#pragma unroll
                for (int q = 0; q < 4; ++q) { const float a = sigmoidf_(a0[q] + aa[q]); as4[q] = a; k24[q] = k4[q] * (1.0f + (a - 1.0f) * ka[q]);
                    e4[q] = 0.6065306597f * sigmoidf_(w0[q] + aw[q]);
                    kk4[q] = k4[q] * kkw[q]; }
                const int lo_ = tl * LDP + 16 * nt + 4 * g;
                *(LAS u32x2*)(SL(10) + lo_) = pack4(r4); *(LAS u32x2*)(SL(11) + lo_) = pack4(e4); *(LAS u32x2*)(SL(12) + lo_) = pack4(k24); *(LAS u32x2*)(SL(13) + lo_) = pack4(v4);
                *(LAS u32x2*)(SL(14) + lo_) = pack4(kk4); *(LAS u32x2*)(SL(15) + lo_) = pack4(as4);
                *(u32x2*)(RW + 3 * AS_ + o) = pack4(v4); *(u32x2*)(RW + 6 * AS_ + o) = pack4(ag);
                __builtin_amdgcn_sched_barrier(0);
            }
        }
        lds_barrier();
        const int lt_ = tok * LDP + 8 * cg;
        const u32x4 ur = *(const LAS u32x4*)(SL(10) + lt_), ue = *(const LAS u32x4*)(SL(11) + lt_), uk = *(const LAS u32x4*)(SL(12) + lt_), uv = *(const LAS u32x4*)(SL(13) + lt_),
                    ukk = *(const LAS u32x4*)(SL(14) + lt_), uas = *(const LAS u32x4*)(SL(15) + lt_);
        const float e8[8] = { bf_lo(ue.x), bf_hi(ue.x), bf_lo(ue.y), bf_hi(ue.y), bf_lo(ue.z), bf_hi(ue.z), bf_lo(ue.w), bf_hi(ue.w) };
#pragma unroll
        for (int i = 0; i < 8; ++i) EL[tok * 65 + 8 * cg + i] = e8[i];
        lds_barrier();
        { const int col = F.tid & 63, seg = F.tid >> 6; float p[8]; float run = 0.f;
#pragma unroll
          for (int i = 0; i < 8; ++i) { run += EL[(8 * seg + i) * 65 + col]; p[i] = run; }
          SEGT[seg * 64 + col] = run;
          lds_barrier();
          float off = 0.f; for (int s = 0; s < seg; ++s) off += SEGT[s * 64 + col];
#pragma unroll
          for (int i = 0; i < 8; ++i) EL[(8 * seg + i) * 65 + col] = -(off + p[i]); }
        lds_barrier();
        {
            const float r8[8] = { bf_lo(ur.x), bf_hi(ur.x), bf_lo(ur.y), bf_hi(ur.y), bf_lo(ur.z), bf_hi(ur.z), bf_lo(ur.w), bf_hi(ur.w) };
            const float k8[8] = { bf_lo(uk.x), bf_hi(uk.x), bf_lo(uk.y), bf_hi(uk.y), bf_lo(uk.z), bf_hi(uk.z), bf_lo(uk.w), bf_hi(uk.w) };
            float kk8[8] = { bf_lo(ukk.x), bf_hi(ukk.x), bf_lo(ukk.y), bf_hi(ukk.y), bf_lo(ukk.z), bf_hi(ukk.z), bf_lo(ukk.w), bf_hi(ukk.w) };
            { float ss = 0.f;
#pragma unroll
              for (int i = 0; i < 8; ++i) ss += kk8[i] * kk8[i];
              ss += __shfl_xor(ss, 1); ss += __shfl_xor(ss, 2); ss += __shfl_xor(ss, 4);
              const float inv = 1.0f / fmaxf(sqrtf(ss), 1e-12f);
#pragma unroll
              for (int i = 0; i < 8; ++i) kk8[i] *= inv; }
            const float as8[8] = { bf_lo(uas.x), bf_hi(uas.x), bf_lo(uas.y), bf_hi(uas.y), bf_lo(uas.z), bf_hi(uas.z), bf_lo(uas.w), bf_hi(uas.w) };
            const unsigned short v8[8] = { (unsigned short)(uv.x & 0xffffu), (unsigned short)(uv.x >> 16), (unsigned short)(uv.y & 0xffffu), (unsigned short)(uv.y >> 16),
                                           (unsigned short)(uv.z & 0xffffu), (unsigned short)(uv.z >> 16), (unsigned short)(uv.w & 0xffffu), (unsigned short)(uv.w >> 16) };
            { const float* rkp = rkw + h * 64 + 8 * cg; float b = 0.f;
#pragma unroll
              for (int i = 0; i < 8; ++i) b += r8[i] * k8[i] * rkp[i];
              b += __shfl_xor(b, 1); b += __shfl_xor(b, 2); b += __shfl_xor(b, 4);
              if (cg == 0) BSW[(size_t)(t0 + tok) * 8 + h] = b; }
            float at[8], bt[8], kt[8], rt[8], bp[8], kp[8];
#pragma unroll
            for (int i = 0; i < 8; ++i) { const float cl = EL[tok * 65 + 8 * cg + i], pc = __expf(EL[63 * 65 + 8 * cg + i]);
                const float ecl = __expf(cl), eicl = __expf(-cl);
                at[i] = -kk8[i] * __expf(cl + e8[i]); bt[i] = kk8[i] * as8[i] * eicl; kt[i] = k8[i] * eicl; rt[i] = r8[i] * ecl; bp[i] = bt[i] * pc; kp[i] = kt[i] * pc;
                if (tok == 0) PC[8 * cg + i] = pc; }
            u32x4 o;
            o.x = pk2(at[0], at[1]); o.y = pk2(at[2], at[3]); o.z = pk2(at[4], at[5]); o.w = pk2(at[6], at[7]); *(LAS u32x4*)(AT + tok * LDP + 8 * cg) = o;
            o.x = pk2(bt[0], bt[1]); o.y = pk2(bt[2], bt[3]); o.z = pk2(bt[4], bt[5]); o.w = pk2(bt[6], bt[7]); *(LAS u32x4*)(BT + tok * LDP + 8 * cg) = o;
            o.x = pk2(kt[0], kt[1]); o.y = pk2(kt[2], kt[3]); o.z = pk2(kt[4], kt[5]); o.w = pk2(kt[6], kt[7]); *(LAS u32x4*)(KT + tok * LDP + 8 * cg) = o;
            o.x = pk2(rt[0], rt[1]); o.y = pk2(rt[2], rt[3]); o.z = pk2(rt[4], rt[5]); o.w = pk2(rt[6], rt[7]); *(LAS u32x4*)(RT + tok * LDP + 8 * cg) = o;
#pragma unroll
            for (int i = 0; i < 8; ++i) { const int c = 8 * cg + i; ATt[c * LDP + tok] = f2bf(at[i]); Vt[c * LDP + tok] = v8[i]; BPt[c * LDP + tok] = f2bf(bp[i]); KPt[c * LDP + tok] = f2bf(kp[i]); }
        }
        lds_barrier();
        {
            const FrX xb = ldx64(BT, w, jl, g), xk = ldx64(KT, w, jl, g); const FrY ya = ldy64(AT, w, jl, g), yr_ = ldy64(RT, w, jl, g);
            f32x4 a1[2], a2[2], a3[2], a4[2]; ZACC(a1); ZACC(a2); ZACC(a3); ZACC(a4);
            mma64(xb, ya, a1); mma64(xk, ya, a2); mma64(xb, yr_, a3); mma64(xk, yr_, a4);
            const int s0 = 16 * (w & 3) + 4 * g;
            f32x4 b[2];
#pragma unroll
            for (int i = 0; i < 2; ++i) { const int t = 16 * (2 * (w >> 2) + i) + jl;
#pragma unroll
                for (int r = 0; r < 4; ++r) { const bool lt = s0 + r < t, le = s0 + r <= t; if (!lt) { a1[i][r] = 0.f; a2[i][r] = 0.f; } if (!le) { a3[i][r] = 0.f; a4[i][r] = 0.f; } b[i][r] = (s0 + r == t) ? 1.0f : a1[i][r]; } }
            st_t(SL(8), a1, w, jl, g); st_n(SL(9), a1, w, jl, g);
            st_t(SL(13), b, w, jl, g); st_n(SL(14), b, w, jl, g);
            st_t(AAK, a2, w, jl, g); st_t(ARB, a3, w, jl, g); st_t(ARK, a4, w, jl, g);
        }
        lds_barrier();
#define NEU_B(srcB, srcBt, dstB, dstBt) do { f32x4 a[2]; ZACC(a); mm64(SL(srcB), SL(srcBt), w, jl, g, a); st_t(SL(dstBt), a, w, jl, g); st_n(SL(dstB), a, w, jl, g); } while (0)
#define NEU_TB(srcT, srcTt, srcB, srcBt, dstT, dstTt, dstB, dstBt) do { f32x4 at[2], ab[2]; ZACC(ab); \
            const FrX xt_ = ldx64(SL(srcT), w, jl, g), xb_ = ldx64(SL(srcB), w, jl, g); const FrY yb_ = ldy64(SL(srcBt), w, jl, g); \
            _Pragma("unroll") for (int i = 0; i < 2; ++i) at[i] = unpack4(*(const LAS u32x2*)(SL(srcTt) + (16 * (2 * (w >> 2) + i) + jl) * LDP + 16 * (w & 3) + 4 * g)); \
            mma64(xt_, yb_, at); mma64(xb_, yb_, ab); \
            st_t(SL(dstTt), at, w, jl, g); st_n(SL(dstT), at, w, jl, g); st_t(SL(dstBt), ab, w, jl, g); st_n(SL(dstB), ab, w, jl, g); } while (0)
#define NEU_T(srcT, srcTt, srcBt, dstT, dstTt, last) do { f32x4 a[2]; \
            _Pragma("unroll") for (int i = 0; i < 2; ++i) a[i] = unpack4(*(const LAS u32x2*)(SL(srcTt) + (16 * (2 * (w >> 2) + i) + jl) * LDP + 16 * (w & 3) + 4 * g)); \
            mm64(SL(srcT), SL(srcBt), w, jl, g, a); if (!(last)) st_t(SL(dstTt), a, w, jl, g); st_n(SL(dstT), a, w, jl, g); } while (0)
        NEU_B(8, 9, 0, 1);                                   lds_barrier();
        NEU_TB(13, 14, 0, 1, 15, 2, 8, 9);                   lds_barrier();
        NEU_TB(15, 2, 8, 9, 13, 14, 0, 1);                   lds_barrier();
        NEU_TB(13, 14, 0, 1, 15, 2, 8, 9);                   lds_barrier();
        NEU_TB(15, 2, 8, 9, 13, 14, 0, 1);                   lds_barrier();
        NEU_T(13, 14, 1, 15, 2, true);                       lds_barrier();
        lbf* TI = SL(15); lbf* Wt = SL(8); lbf* Xt = SL(9); lbf* Ut = SL(0);
        A0_LOAD(u + F.G); asm volatile("" ::: "memory");
        {
            const FrX x1 = ldx64(TI, w, jl, g), x2 = ldx64(AAK, w, jl, g); const FrY y1 = ldy64(ATt, w, jl, g), y2 = ldy64(Vt, w, jl, g);
            f32x4 a[2], b[2]; ZACC(a); ZACC(b); mma64(x1, y1, a); mma64(x2, y2, b); st_t(Wt, a, w, jl, g); st_t(Xt, b, w, jl, g); }
        lds_barrier();
        {
            const FrX xti = ldx64(TI, w, jl, g), xw = ldx64(Wt, w, jl, g); const FrY yx = ldy64(Xt, w, jl, g), yar = ldy64(ARB, w, jl, g), ybp = ldy64(BPt, w, jl, g);
            f32x4 rr[2]; float pcv[2];
#pragma unroll
            for (int i = 0; i < 2; ++i) { const int t = 16 * (2 * (w >> 2) + i) + jl; rr[i] = unpack4(*(const LAS u32x2*)(RT + t * LDP + 16 * (w & 3) + 4 * g)); pcv[i] = PC[t]; }
            f32x4 au[2], ar[2], am[2]; ZACC(au); ZACC(ar); ZACC(am);
            mma64(xti, yx, au); mma64(xw, yar, ar); mma64(xw, ybp, am);
            st_t(Ut, au, w, jl, g);
#pragma unroll
            for (int i = 0; i < 2; ++i) { const int t = 16 * (2 * (w >> 2) + i) + jl, k0 = 16 * (w & 3) + 4 * g;
                *(u32x2*)(RW + 5 * AS_ + rwo(t0 + t, h * 64 + k0)) = pack4(ar[i] + rr[i]);
#pragma unroll
                for (int r = 0; r < 4; ++r) if (k0 + r == t) am[i][r] += pcv[i];
                *(u32x2*)(RW + 4 * AS_ + rwo(t0 + t, h * 64 + k0)) = pack4(am[i]); }
        }
        lds_barrier();
        {
            A0_LOADX(); asm volatile("" ::: "memory");
            f32x4 ay[2], an[2]; ZACC(ay); ZACC(an);
            { const FrX xu = ldx64(Ut, w, jl, g), xbp = ldx64(BPt, w, jl, g); const FrY yar = ldy64(ARB, w, jl, g), yu = ldy64(Ut, w, jl, g); mma64(xu, yar, ay); mma64(xbp, yu, an); }
            { const FrX xv = ldx64(Vt, w, jl, g), xkp = ldx64(KPt, w, jl, g); const FrY yak = ldy64(ARK, w, jl, g), yv = ldy64(Vt, w, jl, g); mma64(xv, yak, ay); mma64(xkp, yv, an); }
#pragma unroll
            for (int i = 0; i < 2; ++i) { const int t = 16 * (2 * (w >> 2) + i) + jl, c0 = 16 * (w & 3) + 4 * g;
                *(u32x2*)(YH + rwo(t0 + t, h * 64 + c0)) = pack4(ay[i]);
                *(u32x2*)(RW + 1 * AS_ + rwo(t0 + t, h * 64 + c0)) = pack4(an[i]); }
        }
    }
#undef A0_LOAD
#undef A0_LOADX
#undef SL
#undef NEU_B
#undef NEU_T
#undef NEU_TB
}

__device__ __forceinline__ void ph_rwkv_s2(Frame& F, int l, int pair) {
    const int bl = pair >> 3, h = pair & 7;
    const bf16_t* RW = (const bf16_t*)(F.ws + MX_RW); constexpr size_t AS_ = (size_t)TH * 512;
    const bf16_t* YH = (const bf16_t*)(F.ws + MX_CA); bf16_t* YA = (bf16_t*)(F.ws + MX_CA) + AS_;
    lbf* HT = (lbf*)F.lds;
    const int lane = F.lane, w = F.wave, jl = lane & 15, g = lane >> 4;
    lds_barrier();
    for (int i = F.tid; i < 64 * LDP / 2; i += NTHR) ((LAS unsigned*)HT)[i] = 0u;
    if (F.tid < 128) ((LAS float*)(F.lds + SLOT))[F.tid] = (F.tid < 64 ? FIN(F, I_LNG) : FIN(F, I_LNB))[l * 512 + h * 64 + (F.tid & 63)];
    lds_barrier();
    if (w < 4) {
        bf16x8 m0[4], m1[4]; u32x2 nn[4][4];
#define S2A_LOAD(j, c) do { const int cc_ = (c) < SEQ / 64 ? (c) : SEQ / 64 - 1; const int tb_ = bl * SEQ + cc_ * 64; \
        m0[j] = *(const bf16x8*)(RW + 4 * AS_ + rwo(tb_ + 16 * w + jl, h * 64 + 8 * g)); m1[j] = *(const bf16x8*)(RW + 4 * AS_ + rwo(tb_ + 16 * w + jl, h * 64 + 32 + 8 * g)); \
        _Pragma("unroll") for (int yt = 0; yt < 4; ++yt) nn[j][yt] = *(const u32x2*)(RW + 1 * AS_ + rwo(tb_ + 16 * yt + jl, h * 64 + 16 * w + 4 * g)); } while (0)
        S2A_LOAD(0, 0); S2A_LOAD(1, 1); S2A_LOAD(2, 2);
#pragma unroll 1
        for (int c4 = 0; c4 < SEQ / 64; c4 += 4) {
#pragma unroll
            for (int j = 0; j < 4; ++j) {
                asm volatile("" : "+v"(m0[j]), "+v"(m1[j]));
#pragma unroll
                for (int yt = 0; yt < 4; ++yt) asm volatile("" : "+v"(nn[j][yt]));
                S2A_LOAD((j + 3) & 3, c4 + j + 3);
                asm volatile("" ::: "memory");
                f32x4 a[4]; bf16x8 hf[4][2];
#pragma unroll
                for (int yt = 0; yt < 4; ++yt) { const lbf* yr = HT + (16 * yt + jl) * LDP + 8 * g; hf[yt][0] = *(const LAS bf16x8*)yr; hf[yt][1] = *(const LAS bf16x8*)(yr + 32); a[yt] = unpack4(nn[j][yt]); }
#pragma unroll
                for (int yt = 0; yt < 4; ++yt) a[yt] = MFMA16(m0[j], hf[yt][0], a[yt]);
#pragma unroll
                for (int yt = 0; yt < 4; ++yt) a[yt] = MFMA16(m1[j], hf[yt][1], a[yt]);
                lds_barrier();
#pragma unroll
                for (int yt = 0; yt < 4; ++yt) *(LAS u32x2*)(HT + (16 * yt + jl) * LDP + 16 * w + 4 * g) = pack4(a[yt]);
                lds_barrier();
            }
        }
#undef S2A_LOAD
    } else {
        const int wt = w - 4;
        const LAS float* lgl = (const LAS float*)(F.lds + SLOT) + 4 * g; const LAS float* lbl = lgl + 64;
        lbf* ystg = (lbf*)(F.lds + 2 * SLOT) + wt * 16 * LDP;
        const float* bsp = (const float*)(F.ws + MX_BS) + (size_t)(bl * SEQ + 16 * wt + jl) * 8 + h;
        bf16x8 r0[4], r1[4]; u32x2 yh[4][4], uv[4][4], ug[4][4]; float bsv[4];
#define S2B_LOAD(j, c) do { const int cc_ = (c) < SEQ / 64 ? (c) : SEQ / 64 - 1; const int tk_ = bl * SEQ + cc_ * 64 + 16 * wt + jl; \
        r0[j] = *(const bf16x8*)(RW + 5 * AS_ + rwo(tk_, h * 64 + 8 * g)); r1[j] = *(const bf16x8*)(RW + 5 * AS_ + rwo(tk_, h * 64 + 32 + 8 * g)); \
        bsv[j] = bsp[(size_t)(cc_ * 64) * 8]; \
        _Pragma("unroll") for (int xt = 0; xt < 4; ++xt) { yh[j][xt] = *(const u32x2*)(YH + rwo(tk_, h * 64 + 16 * xt + 4 * g)); uv[j][xt] = *(const u32x2*)(RW + 3 * AS_ + rwo(tk_, h * 64 + 16 * xt + 4 * g)); ug[j][xt] = *(const u32x2*)(RW + 6 * AS_ + rwo(tk_, h * 64 + 16 * xt + 4 * g)); } } while (0)
        S2B_LOAD(0, 0); S2B_LOAD(1, 1); S2B_LOAD(2, 2);
#pragma unroll 1
        for (int c4 = 0; c4 < SEQ / 64; c4 += 4) {
#pragma unroll
            for (int j = 0; j < 4; ++j) {
                asm volatile("" : "+v"(r0[j]), "+v"(r1[j]), "+v"(bsv[j]));
#pragma unroll
                for (int xt = 0; xt < 4; ++xt) asm volatile("" : "+v"(yh[j][xt]), "+v"(uv[j][xt]), "+v"(ug[j][xt]));
                S2B_LOAD((j + 3) & 3, c4 + j + 3);
                asm volatile("" ::: "memory");
                f32x4 a[4]; bf16x8 hf[4][2];
#pragma unroll
                for (int xt = 0; xt < 4; ++xt) { const lbf* xr = HT + (16 * xt + jl) * LDP + 8 * g; hf[xt][0] = *(const LAS bf16x8*)xr; hf[xt][1] = *(const LAS bf16x8*)(xr + 32); a[xt] = unpack4(yh[j][xt]); }
#pragma unroll
                for (int xt = 0; xt < 4; ++xt) a[xt] = MFMA16(hf[xt][0], r0[j], a[xt]);
#pragma unroll
                for (int xt = 0; xt < 4; ++xt) a[xt] = MFMA16(hf[xt][1], r1[j], a[xt]);
                lds_barrier();
                float s = 0.f; const float bs = bsv[j];
#pragma unroll
                for (int xt = 0; xt < 4; ++xt)
#pragma unroll
                    for (int r = 0; r < 4; ++r) s += a[xt][r];
                s += __shfl_xor(s, 16); s += __shfl_xor(s, 32);
                const float mean = s * (1.f / 64.f); float q = 0.f;
#pragma unroll
                for (int xt = 0; xt < 4; ++xt)
#pragma unroll
                    for (int r = 0; r < 4; ++r) { const float d = a[xt][r] - mean; q += d * d; }
                q += __shfl_xor(q, 16); q += __shfl_xor(q, 32);
                const float rstd = 1.0f / sqrtf(q * (1.f / 64.f) + 64e-5f);
#pragma unroll
                for (int xt = 0; xt < 4; ++xt) { const f32x4 vv = unpack4(uv[j][xt]), gg = unpack4(ug[j][xt]), lg4 = *(const LAS f32x4*)(lgl + 16 * xt), lb4 = *(const LAS f32x4*)(lbl + 16 * xt); f32x4 o;
#pragma unroll
                    for (int r = 0; r < 4; ++r) o[r] = ((a[xt][r] - mean) * rstd * lg4[r] + lb4[r] + bs * vv[r]) * gg[r];
                    *(LAS u32x2*)(ystg + jl * LDP + 16 * xt + 4 * g) = pack4(o); }
#pragma unroll
                for (int p = 0; p < 2; ++p) { const int rr_ = (lane >> 3) + 8 * p; const u32x4 vrow = *(const LAS u32x4*)(ystg + rr_ * LDP + 8 * (lane & 7));
                    *(u32x4*)(YA + (size_t)(bl * SEQ + (c4 + j) * 64 + 16 * wt + rr_) * 512 + h * 64 + 8 * (lane & 7)) = vrow; }
                lds_barrier();
            }
        }
#undef S2B_LOAD
    }
}

__device__ __forceinline__ void ph_dsa_prep(Frame& F, int l, int half) {
    bf16_t* CB = (bf16_t*)(F.ws + MX_CB); bf16_t* VT = (bf16_t*)(F.ws + MX_VT);
    const int* pos = (const int*)KARGP(F, I_POS) + (size_t)half * TH;
    const int lane = F.lane, j = lane & 7;
    float invf[4]; f32x4 gq[2], gk[2], gik[2];
#pragma unroll
    for (int i = 0; i < 4; ++i) invf[i] = __builtin_amdgcn_exp2f(-(float)(2 * (4 * j + i)) * (13.287712379549449f / 64.0f));
#pragma unroll
    for (int hf = 0; hf < 2; ++hf) { gq[hf] = *(const f32x4*)(FIN(F, I_QN) + l * 64 + 32 * hf + 4 * j); gk[hf] = *(const f32x4*)(FIN(F, I_KN) + l * 64 + 32 * hf + 4 * j); gik[hf] = *(const f32x4*)(FIN(F, I_IKN) + l * 64 + 32 * hf + 4 * j); }
    lbf* vst = (lbf*)F.lds;
    for (int tile = F.bid; tile < TH / 64; tile += F.G) {
        lds_barrier();
#pragma unroll 2
        for (int k8 = 0; k8 < 8; ++k8) {
        const int tk = 8 * F.wave + k8, t = tile * 64 + tk;
        const float p = (float)pos[t];
        f32x4 cs, sn;
#pragma unroll
        for (int i = 0; i < 4; ++i) { float rev = p * invf[i] * 0.15915494309189535f; rev = rev - floorf(rev); cs[i] = __builtin_amdgcn_cosf(rev); sn[i] = __builtin_amdgcn_sinf(rev); }
        bf16_t* row = CB + (size_t)t * DS_PAD;
#pragma unroll
        for (int ps = 0; ps < 3; ++ps) {
            const int vec = 8 * ps + (lane >> 3);
            if (vec < 19) {
                bf16_t* vp = row + vec * 64 + 4 * j;
                const u32x2 u1 = *(const u32x2*)vp, u2 = *(const u32x2*)(vp + 32);
                f32x4 x1 = unpack4(u1), x2 = unpack4(u2);
                if (vec == 9) {
                    vst[(4 * j + 0) * LDP + tk] = (bf16_t)(u1.x & 0xffffu); vst[(4 * j + 1) * LDP + tk] = (bf16_t)(u1.x >> 16); vst[(4 * j + 2) * LDP + tk] = (bf16_t)(u1.y & 0xffffu); vst[(4 * j + 3) * LDP + tk] = (bf16_t)(u1.y >> 16);
                    vst[(32 + 4 * j + 0) * LDP + tk] = (bf16_t)(u2.x & 0xffffu); vst[(32 + 4 * j + 1) * LDP + tk] = (bf16_t)(u2.x >> 16); vst[(32 + 4 * j + 2) * LDP + tk] = (bf16_t)(u2.y & 0xffffu); vst[(32 + 4 * j + 3) * LDP + tk] = (bf16_t)(u2.y >> 16);
                } else {
                    const bool nrm = (vec < 9) || (vec == 18);
                    float ss = (x1[0] * x1[0] + x1[1] * x1[1]) + (x1[2] * x1[2] + x1[3] * x1[3]) + (x2[0] * x2[0] + x2[1] * x2[1]) + (x2[2] * x2[2] + x2[3] * x2[3]);
                    ss += __shfl_xor(ss, 1); ss += __shfl_xor(ss, 2); ss += __shfl_xor(ss, 4);
                    if (nrm) { float rstd = 1.0f / sqrtf(ss * (1.f / 64.f) + 1e-6f); if (vec < 8) rstd *= 0.125f * 1.4426950409f;
                        const f32x4 g1 = vec < 8 ? gq[0] : (vec == 8 ? gk[0] : gik[0]), g2 = vec < 8 ? gq[1] : (vec == 8 ? gk[1] : gik[1]);
                        x1 = x1 * rstd * g1; x2 = x2 * rstd * g2; }
                    const f32x4 o1 = x1 * cs - x2 * sn, o2 = x2 * cs + x1 * sn;
                    *(u32x2*)vp = pack4(o1); *(u32x2*)(vp + 32) = pack4(o2);
                }
            }
        }
        }
        lds_barrier();
        { const int dim = F.tid >> 3, ch = F.tid & 7; const int t0 = tile * 64;
          *(u32x4*)(VT + ((size_t)(t0 >> 11) * 64 + dim) * SEQ + (t0 & (SEQ - 1)) + 8 * ch) = *(const LAS u32x4*)(vst + dim * LDP + 8 * ch); }
    }
}

constexpr int SC_LD = 2052;
__device__ __forceinline__ void lds_inc(LAS unsigned* p) { (void)__hip_atomic_fetch_add(p, 1u, __ATOMIC_RELAXED, __HIP_MEMORY_SCOPE_WORKGROUP); }
__device__ __forceinline__ unsigned okey(float s) { const unsigned u = __builtin_bit_cast(unsigned, s); return (u & 0x80000000u) ? ~u : (u | 0x80000000u); }
__device__ __forceinline__ int hist_find(LAS unsigned* hist, int lane, int& R, int& cnt) {
    const u32x4 c4 = *(const LAS u32x4*)(hist + 4 * lane);
    const unsigned tot = c4.x + c4.y + c4.z + c4.w;
    unsigned suf = tot;
#pragma unroll
    for (int o = 1; o < 64; o <<= 1) { const unsigned v = __shfl_down(suf, o); if (lane + o < 64) suf += v; }
    const unsigned above = suf - tot;
    const bool mine = (above < (unsigned)R) && ((unsigned)R <= suf);
    const unsigned long long bal = __ballot(mine);
    const int src = bal ? (int)__builtin_ctzll(bal) : 0;
    int bin, rr, cc;
    { unsigned a = above; int r_ = R;
      if ((unsigned)r_ <= a + c4.w) { bin = 4 * lane + 3; rr = r_ - (int)a; cc = (int)c4.w; } else { a += c4.w;
      if ((unsigned)r_ <= a + c4.z) { bin = 4 * lane + 2; rr = r_ - (int)a; cc = (int)c4.z; } else { a += c4.z;
      if ((unsigned)r_ <= a + c4.y) { bin = 4 * lane + 1; rr = r_ - (int)a; cc = (int)c4.y; } else { a += c4.y; bin = 4 * lane; rr = r_ - (int)a; cc = (int)c4.x; } } } }
    bin = __shfl(bin, src); rr = __shfl(rr, src); cc = __shfl(cc, src);
    R = rr; cnt = cc; return bin;
}
__device__ __forceinline__ void ph_dsa(Frame& F, int half, unsigned* qctr) {
    const bf16_t* CB = (const bf16_t*)(F.ws + MX_CB); const bf16_t* VT = (const bf16_t*)(F.ws + MX_VT);
    bf16_t* YB = (bf16_t*)(F.ws + MX_YB);
    LAS float* sc = (LAS float*)F.lds;
    LAS unsigned* hist = (LAS unsigned*)(F.lds + 16 * SC_LD * 4);
    LAS unsigned* msk = (LAS unsigned*)(F.lds + 16 * SC_LD * 4 + 16 * 256 * 4);
    lbf* KB = (lbf*)F.lds;
    lbf* VB = (lbf*)(F.lds + 2 * SLOT);
    const int lane = F.lane, w = F.wave, jl = lane & 15, g = lane >> 4;
    const int srow = F.tid >> 3, sseg = F.tid & 7;
    volatile LAS unsigned* qslot = (volatile LAS unsigned*)(F.lds + LDS_MISC + 64);
    for (;;) {
        if (F.tid == 0) *qslot = __hip_atomic_fetch_add(qctr, 1u, __ATOMIC_RELAXED, __HIP_MEMORY_SCOPE_AGENT);
        lds_barrier();
        const int ui = (int)*qslot; if (ui >= TH / 16) break;
        const int bl = ui & 15, q0 = (127 - (ui >> 4)) * 16, L = ((q0 >> 6) + 1) * 64;
        const int rowb = bl * SEQ;
        if (L > 256) for (int i = F.tid; i < 16 * 256; i += NTHR) hist[i] = 0u;
        lds_barrier();
        {
            bf16x8 yq[8][2]; float iw[8];
            const bf16_t* qrow = CB + (size_t)(rowb + q0 + jl) * DS_PAD;
#pragma unroll
            for (int h = 0; h < 8; ++h) { iw[h] = bf2f(qrow[1216 + h]);
#pragma unroll
                for (int s = 0; s < 2; ++s) yq[h][s] = *(const bf16x8*)(qrow + 640 + h * 64 + 32 * s + 8 * g); }
            const int nk = L / 16;
            const bf16_t* kbase = CB + (size_t)(rowb + jl) * DS_PAD + 1152 + 8 * g;
            bf16x8 x0 = {0, 0, 0, 0, 0, 0, 0, 0}, x1 = x0;
            if (w < nk) { const bf16_t* kr = kbase + (size_t)(w * 16) * DS_PAD; x0 = *(const bf16x8*)kr; x1 = *(const bf16x8*)(kr + 32); }
            for (int kt = w; kt < nk; kt += 8) {
                bf16x8 n0 = x0, n1 = x1;
                if (kt + 8 < nk) { const bf16_t* kr = kbase + (size_t)((kt + 8) * 16) * DS_PAD; n0 = *(const bf16x8*)kr; n1 = *(const bf16x8*)(kr + 32); }
                f32x4 s4 = (f32x4){0.f, 0.f, 0.f, 0.f};
#pragma unroll
                for (int h = 0; h < 8; ++h) { f32x4 a = (f32x4){0.f, 0.f, 0.f, 0.f}; a = MFMA16(x0, yq[h][0], a); a = MFMA16(x1, yq[h][1], a);
#pragma unroll
                    for (int r = 0; r < 4; ++r) s4[r] += iw[h] * fmaxf(a[r], 0.f); }
                *(LAS f32x4*)(sc + jl * SC_LD + kt * 16 + 4 * g) = s4;
                if (L > 256) {
#pragma unroll
                    for (int r = 0; r < 4; ++r) lds_inc(hist + jl * 256 + (okey(s4[r]) >> 24)); }
                x0 = n0; x1 = n1;
            }
        }
        lds_barrier();
        for (int qi = 0; qi < 2; ++qi) {
            const int qq = 2 * w + qi; LAS unsigned* hq = hist + qq * 256; const LAS float* sq = sc + qq * SC_LD; LAS unsigned* mq = msk + qq * 64;
            if (L <= 256) { mq[lane] = (lane < L / 32) ? 0xffffffffu : 0u; }
            else {
                int R = 256, E = 0; unsigned prefix = (unsigned)hist_find(hq, lane, R, E);
#pragma unroll 1
                for (int pass = 1; pass < 4; ++pass) {
                    const int sh = 24 - 8 * pass;
                    asm volatile("" ::: "memory");
                    *(LAS u32x4*)(hq + 4 * lane) = (u32x4){0u, 0u, 0u, 0u};
                    LDS_WAIT(); asm volatile("" ::: "memory");
                    for (int i = 4 * lane; i < L; i += 256) { const f32x4 s = *(const LAS f32x4*)(sq + i);
#pragma unroll
                        for (int r = 0; r < 4; ++r) { const unsigned k = okey(s[r]); if ((k >> (sh + 8)) == prefix) lds_inc(hq + ((k >> sh) & 255u)); } }
                    LDS_WAIT(); asm volatile("" ::: "memory");
                    const int b = hist_find(hq, lane, R, E); prefix = (prefix << 8) | (unsigned)b;
                }
                const unsigned thr = prefix;
                if (R >= E) {
                    for (int base = 0; base < SEQ; base += 256) {
                        unsigned nib = 0u;
                        if (base + 4 * lane < L) { const f32x4 s = *(const LAS f32x4*)(sq + base + 4 * lane);
#pragma unroll
                            for (int r = 0; r < 4; ++r) nib |= (okey(s[r]) >= thr ? 1u : 0u) << r; }
                        unsigned wv = nib << (4 * (lane & 7));
                        wv |= __shfl_xor(wv, 1); wv |= __shfl_xor(wv, 2); wv |= __shfl_xor(wv, 4);
                        if ((lane & 7) == 0) mq[(base >> 5) + (lane >> 3)] = wv;
                    }
                } else {
                    int taken = 0;
                    for (int base = 0; base < SEQ; base += 64) {
                        bool take = false; bool eq = false;
                        if (base < L) { const unsigned k = okey(sq[base + lane]); take = k > thr; eq = (k == thr); }
                        const unsigned long long em = __ballot(eq);
                        const int myr = taken + __popcll(em & ((1ull << lane) - 1ull));
                        take = take || (eq && myr < R);
                        taken += __popcll(em);
                        const unsigned long long tm = __ballot(take);
                        if (lane == 0) { mq[base / 32] = (unsigned)tm; mq[base / 32 + 1] = (unsigned)(tm >> 32); }
                    }
                }
            }
        }
        lds_barrier();
        {
            const int qloc = 2 * w + (jl >> 3), hd = jl & 7;
            const bf16_t* qrow = CB + (size_t)(rowb + q0 + qloc) * DS_PAD + hd * 64;
            const bf16x8 yq0 = *(const bf16x8*)(qrow + 8 * g), yq1 = *(const bf16x8*)(qrow + 32 + 8 * g);
            f32x4 O[4];
#pragma unroll
            for (int dt = 0; dt < 4; ++dt) O[dt] = (f32x4){0.f, 0.f, 0.f, 0.f};
            float mrun = -1e30f, lsum = 0.f;
            const LAS unsigned* mq = msk + qloc * 64;
            const bf16_t* kg = CB + (size_t)(rowb + srow) * DS_PAD + 512 + 8 * sseg;
            const bf16_t* vg = VT + ((size_t)bl * 64 + srow) * SEQ + 8 * sseg;
            const int ntile = L / 64;
            u32x4 kreg = *(const u32x4*)kg, vreg = *(const u32x4*)vg;
            *(LAS u32x4*)(KB + srow * LDP + 8 * sseg) = kreg; *(LAS u32x4*)(VB + srow * LDP + 8 * sseg) = vreg;
            lds_barrier();
            for (int it = 0; it < ntile; ++it) {
                { const int itn = (it + 1 < ntile) ? it + 1 : it; kreg = *(const u32x4*)(kg + (size_t)(itn * 64) * DS_PAD); vreg = *(const u32x4*)(vg + itn * 64); asm volatile("" ::: "memory"); }
                const lbf* Kt = KB + (it & 1) * 64 * LDP; const lbf* Vt = VB + (it & 1) * 64 * LDP;
                f32x4 s[4]; bf16x8 kf[4][2];
#pragma unroll
                for (int tl = 0; tl < 4; ++tl) { const lbf* xr = Kt + (16 * tl + jl) * LDP + 8 * g; kf[tl][0] = *(const LAS bf16x8*)xr; kf[tl][1] = *(const LAS bf16x8*)(xr + 32); }
                u32x2 vlo[4][2], vhi[4][2];
#pragma unroll
                for (int dt = 0; dt < 4; ++dt)
#pragma unroll
                    for (int ks = 0; ks < 2; ++ks) { const lbf* vr = Vt + (16 * dt + jl) * LDP + 32 * ks + 4 * g; vlo[dt][ks] = *(const LAS u32x2*)vr; vhi[dt][ks] = *(const LAS u32x2*)(vr + 16); }
#pragma unroll
                for (int tl = 0; tl < 4; ++tl) s[tl] = MFMA16(kf[tl][0], yq0, ((f32x4){0.f, 0.f, 0.f, 0.f}));
#pragma unroll
                for (int tl = 0; tl < 4; ++tl) s[tl] = MFMA16(kf[tl][1], yq1, s[tl]);
                const unsigned mw0 = mq[2 * it], mw1 = mq[2 * it + 1];
                float mx = -1e30f;
#pragma unroll
                for (int tl = 0; tl < 4; ++tl)
#pragma unroll
                    for (int r = 0; r < 4; ++r) mx = fmaxf(mx, s[tl][r]);
                mx = fmaxf(mx, __shfl_xor(mx, 16)); mx = fmaxf(mx, __shfl_xor(mx, 32));
                const float mnew = fmaxf(mrun, mx); const float alpha = __builtin_amdgcn_exp2f(mrun - mnew); mrun = mnew;
                float p[16]; float ps = 0.f;
#pragma unroll
                for (int i = 0; i < 16; ++i) { const int tl = i >> 2, r = i & 3; const unsigned mw = (tl < 2) ? mw0 : mw1;
                    const int sel = __builtin_amdgcn_sbfe((int)mw, 16 * (tl & 1) + 4 * g + r, 1);
                    p[i] = __builtin_bit_cast(float, __builtin_bit_cast(int, __builtin_amdgcn_exp2f(s[tl][r] - mnew)) & sel); ps += p[i]; }
                lsum = lsum * alpha + ps;
                bf16x8 pf[2];
#pragma unroll
                for (int ks = 0; ks < 2; ++ks) { u32x4 pw; pw.x = pk2(p[8 * ks], p[8 * ks + 1]); pw.y = pk2(p[8 * ks + 2], p[8 * ks + 3]); pw.z = pk2(p[8 * ks + 4], p[8 * ks + 5]); pw.w = pk2(p[8 * ks + 6], p[8 * ks + 7]);
                    pf[ks] = __builtin_bit_cast(bf16x8, pw); }
#pragma unroll
                for (int dt = 0; dt < 4; ++dt) O[dt] = O[dt] * alpha;
#pragma unroll
                for (int ks = 0; ks < 2; ++ks)
#pragma unroll
                    for (int dt = 0; dt < 4; ++dt) O[dt] = MFMA16(__builtin_bit_cast(bf16x8, (u32x4){vlo[dt][ks].x, vlo[dt][ks].y, vhi[dt][ks].x, vhi[dt][ks].y}), pf[ks], O[dt]);
                if (it + 1 < ntile) { *(LAS u32x4*)(KB + ((it + 1) & 1) * 64 * LDP + srow * LDP + 8 * sseg) = kreg; *(LAS u32x4*)(VB + ((it + 1) & 1) * 64 * LDP + srow * LDP + 8 * sseg) = vreg; }
                lds_barrier();
            }
            lsum += __shfl_xor(lsum, 16); lsum += __shfl_xor(lsum, 32);
            const float inv = 1.0f / lsum;
            lbf* ostg = (lbf*)(F.lds + 4 * SLOT) + w * 16 * LDP;
#pragma unroll
            for (int dt = 0; dt < 4; ++dt) { u32x2 o; o.x = pk2(O[dt][0] * inv, O[dt][1] * inv); o.y = pk2(O[dt][2] * inv, O[dt][3] * inv); *(LAS u32x2*)(ostg + jl * LDP + 16 * dt + 4 * g) = o; }
#pragma unroll
            for (int p = 0; p < 2; ++p) { const int rr_ = (lane >> 3) + 8 * p; const u32x4 vrow = *(const LAS u32x4*)(ostg + rr_ * LDP + 8 * (lane & 7));
                *(u32x4*)(YB + (size_t)(rowb + q0 + 2 * w + (rr_ >> 3)) * 512 + (rr_ & 7) * 64 + 8 * (lane & 7)) = vrow; }
        }
    }
}

constexpr int MK_LD = 136, MV_LD = 264;
__device__ __forceinline__ void ph_mem_attn(Frame& F, int l) {
    const bf16_t* QM = (const bf16_t*)(F.ws + MA_QM); bf16_t* OM = (bf16_t*)(F.ws + MA_OM);
    const bf16_t* MK = (const bf16_t*)(F.ws + WS_MEMK) + (size_t)l * MEMROWS * 512; const bf16_t* MVT = (const bf16_t*)(F.ws + WS_MEMVT) + (size_t)l * MEMROWS * 512;
    lbf* KS = (lbf*)F.lds; lbf* VS = (lbf*)(F.lds + 256 * MK_LD * 2);
    const int lane = F.lane, jl = lane & 15, g = lane >> 4;
    const float* gq = FIN(F, I_MQN) + l * 128;
    for (int it = F.bid; it < NB * 4 * 2; it += F.G) {
        const int pair = it >> 1, b = pair >> 2, hh = pair & 3, sp0 = (it & 1) * 8;
        const bf16_t* kb_ = MK + ((size_t)b * 4 + hh) * 256 * 128; const bf16_t* vb_ = MVT + ((size_t)b * 4 + hh) * 128 * 256;
        lds_barrier();
#pragma unroll
        for (int i = 0; i < 8; ++i) { const int id = F.tid + NTHR * i;
            *(LAS u32x4*)(KS + (id >> 4) * MK_LD + 8 * (id & 15)) = *(const u32x4*)(kb_ + (size_t)(id >> 4) * 128 + 8 * (id & 15));
            *(LAS u32x4*)(VS + (id >> 5) * MV_LD + 8 * (id & 31)) = *(const u32x4*)(vb_ + (size_t)(id >> 5) * 256 + 8 * (id & 31)); }
        lds_barrier();
#pragma unroll 1
        for (int sp = 0; sp < 8; ++sp) {
        const int t = b * SEQ + (sp0 + sp) * 128 + F.wave * 16 + jl;
        const bf16_t* qrow = QM + (size_t)t * 512 + hh * 128;
        float qv[4][8]; float ss = 0.f;
#pragma unroll
        for (int s2 = 0; s2 < 4; ++s2) { const u32x4 q = *(const u32x4*)(qrow + 32 * s2 + 8 * g);
            qv[s2][0] = bf_lo(q.x); qv[s2][1] = bf_hi(q.x); qv[s2][2] = bf_lo(q.y); qv[s2][3] = bf_hi(q.y); qv[s2][4] = bf_lo(q.z); qv[s2][5] = bf_hi(q.z); qv[s2][6] = bf_lo(q.w); qv[s2][7] = bf_hi(q.w);
#pragma unroll
            for (int i = 0; i < 8; ++i) ss += qv[s2][i] * qv[s2][i]; }
        ss += __shfl_xor(ss, 16); ss += __shfl_xor(ss, 32);
        const float sc = (1.0f / sqrtf(ss * (1.f / 128.f) + 1e-6f)) * (0.08838834764831845f * 1.4426950409f);
        bf16x8 yq[4];
#pragma unroll
        for (int s2 = 0; s2 < 4; ++s2) { const float* gp = gq + 32 * s2 + 8 * g; u32x4 pw;
            pw.x = pk2(qv[s2][0] * sc * gp[0], qv[s2][1] * sc * gp[1]); pw.y = pk2(qv[s2][2] * sc * gp[2], qv[s2][3] * sc * gp[3]);
            pw.z = pk2(qv[s2][4] * sc * gp[4], qv[s2][5] * sc * gp[5]); pw.w = pk2(qv[s2][6] * sc * gp[6], qv[s2][7] * sc * gp[7]); yq[s2] = __builtin_bit_cast(bf16x8, pw); }
        f32x4 O[8];
#pragma unroll
        for (int dt = 0; dt < 8; ++dt) O[dt] = (f32x4){0.f, 0.f, 0.f, 0.f};
        float mrun = -1e30f, ls = 0.f;
#pragma unroll 1
        for (int hk = 0; hk < 2; ++hk) {
            f32x4 S[8];
#pragma unroll
            for (int kt = 0; kt < 8; ++kt) { const lbf* kr = KS + (128 * hk + 16 * kt + jl) * MK_LD + 8 * g; f32x4 a = (f32x4){0.f, 0.f, 0.f, 0.f};
#pragma unroll
                for (int s2 = 0; s2 < 4; ++s2) a = MFMA16(*(const LAS bf16x8*)(kr + 32 * s2), yq[s2], a);
                S[kt] = a; }
            float mx = -1e30f;
#pragma unroll
            for (int kt = 0; kt < 8; ++kt)
#pragma unroll
                for (int r = 0; r < 4; ++r) mx = fmaxf(mx, S[kt][r]);
            mx = fmaxf(mx, __shfl_xor(mx, 16)); mx = fmaxf(mx, __shfl_xor(mx, 32));
            const float mnew = fmaxf(mrun, mx), alpha = __builtin_amdgcn_exp2f(mrun - mnew); mrun = mnew;
            float ps = 0.f; bf16x8 pf[4];
#pragma unroll
            for (int ks = 0; ks < 4; ++ks) { float p[8];
#pragma unroll
                for (int i = 0; i < 8; ++i) { p[i] = __builtin_amdgcn_exp2f(S[2 * ks + (i >> 2)][i & 3] - mnew); ps += p[i]; }
                u32x4 pw; pw.x = pk2(p[0], p[1]); pw.y = pk2(p[2], p[3]); pw.z = pk2(p[4], p[5]); pw.w = pk2(p[6], p[7]); pf[ks] = __builtin_bit_cast(bf16x8, pw); }
            ls = ls * alpha + ps;
#pragma unroll
            for (int dt = 0; dt < 8; ++dt) { f32x4 o = O[dt] * alpha; const lbf* vr = VS + (16 * dt + jl) * MV_LD + 128 * hk + 4 * g;
#pragma unroll
                for (int ks = 0; ks < 4; ++ks) { const u32x2 lo = *(const LAS u32x2*)(vr + 32 * ks), hi = *(const LAS u32x2*)(vr + 32 * ks + 16);
                    o = MFMA16(__builtin_bit_cast(bf16x8, (u32x4){lo.x, lo.y, hi.x, hi.y}), pf[ks], o); }
                O[dt] = o; }
        }
        ls += __shfl_xor(ls, 16); ls += __shfl_xor(ls, 32);
        const float inv = 1.0f / ls;
        lbf* ostg = (lbf*)(F.lds + 256 * MK_LD * 2 + 128 * MV_LD * 2) + F.wave * 16 * LDP;
        const int t0w = b * SEQ + (sp0 + sp) * 128 + F.wave * 16;
#pragma unroll
        for (int hf2 = 0; hf2 < 2; ++hf2) {
#pragma unroll
            for (int d4 = 0; d4 < 4; ++d4) { const int dt = 4 * hf2 + d4; u32x2 ov; ov.x = pk2(O[dt][0] * inv, O[dt][1] * inv); ov.y = pk2(O[dt][2] * inv, O[dt][3] * inv); *(LAS u32x2*)(ostg + jl * LDP + 16 * d4 + 4 * g) = ov; }
#pragma unroll
            for (int p = 0; p < 2; ++p) { const int rr_ = (lane >> 3) + 8 * p; const u32x4 vrow = *(const LAS u32x4*)(ostg + rr_ * LDP + 8 * (lane & 7));
                *(u32x4*)(OM + (size_t)(t0w + rr_) * 512 + hh * 128 + 64 * hf2 + 8 * (lane & 7)) = vrow; }
        }
        }
    }
}

__device__ __forceinline__ void ph_moe_route(Frame& F) {
    const unsigned short* sele = (const unsigned short*)(F.ws + MOE_SELE); const f32x2* selw = (const f32x2*)(F.ws + MOE_SELW);
    int* rowtok = (int*)(F.ws + MOE_ROWTOK); float* roww = (float*)(F.ws + MOE_ROWW); int* tile_e = (int*)(F.ws + MOE_TILEE); int* meta = (int*)(F.ws + MOE_META);
    LAS unsigned long long* pc = (LAS unsigned long long*)F.lds;
    LAS int* tot = (LAS int*)(F.lds + 8192);
    LAS int* pre = tot + 16; LAS int* segb = tot + 32; LAS int* wcnt = tot + 64;
    __syncthreads();
    { unsigned long long c0 = 0ull, c1 = 0ull; const u32x4* sp = (const u32x4*)(sele + (size_t)F.tid * 128);
      for (int i = 0; i < 16; ++i) { const u32x4 v = sp[i]; const unsigned ww[4] = {v.x, v.y, v.z, v.w};
#pragma unroll
        for (int q = 0; q < 4; ++q) { const unsigned a = ww[q] & 0xffffu, b = ww[q] >> 16;
            c0 += 1ull << (8 * (a & 7u)); c1 += 1ull << (8 * ((a >> 8) & 7u)); c0 += 1ull << (8 * (b & 7u)); c1 += 1ull << (8 * ((b >> 8) & 7u)); } }
      pc[F.tid * 2] = c0; pc[F.tid * 2 + 1] = c1; }
    __syncthreads();
    if (F.tid < 32) { const int seg = F.tid & 15, kind = F.tid >> 4; const int slot = seg >> 3, e = seg & 7; const int lim = kind ? 2 * F.bid : 512; int s = 0;
        for (int i = 0; i < lim; ++i) s += (int)((pc[i * 2 + slot] >> (8 * e)) & 0xffull);
        if (kind) pre[seg] = s; else tot[seg] = s; }
    __syncthreads();
    if (F.tid == 0) { int b = 0; for (int s = 0; s < 16; ++s) { segb[s] = b; b += (tot[s] + 255) & ~255; } segb[16] = b; }
    __syncthreads();
    const int t = F.bid * 256 + (F.tid & 255); const unsigned se = sele[t]; const f32x2 sw = selw[t];
    const int myseg[2] = { (int)(se & 7u), 8 + (int)((se >> 8) & 7u) };
    int rank[2] = {0, 0};
    if (F.tid < 256) {
#pragma unroll
        for (int s = 0; s < 16; ++s) { const int k = s >> 3; const unsigned long long m = __ballot(myseg[k] == s);
            if (myseg[k] == s) rank[k] = __popcll(m & ((1ull << F.lane) - 1ull));
            if (F.lane == 0) wcnt[F.wave * 16 + s] = __popcll(m); }
    }
    __syncthreads();
    if (F.tid < 256) {
#pragma unroll
        for (int k = 0; k < 2; ++k) { const int s = myseg[k]; int off = 0; for (int ww = 0; ww < F.wave; ++ww) off += wcnt[ww * 16 + s];
            const int row = segb[s] + pre[s] + off + rank[k]; rowtok[row] = t; roww[row] = k ? sw.y : sw.x; }
    }
    if (F.bid == 0) {
        for (int s = 0; s < 16; ++s) { const int lo = segb[s] + tot[s], hi = segb[s + 1]; for (int r = lo + F.tid; r < hi; r += NTHR) { rowtok[r] = -1; roww[r] = 0.f; } }
        for (int p = F.tid; p < segb[16] / 256; p += NTHR) { int e = 0; for (int s = 0; s < 16; ++s) if (p * 256 >= segb[s]) e = s & 7; tile_e[p] = e; }
        if (F.tid == 0) { meta[0] = segb[8] / 256; meta[1] = segb[16] / 256; }
    }
}

__global__ void __launch_bounds__(NTHR, 2) fwd(Args args) {
    extern __shared__ __attribute__((aligned(16))) unsigned char lds_raw[];
    Frame F;
    F.lds = (LAS unsigned char*)lds_raw; F.ws = args.ws; F.kb = __builtin_amdgcn_kernarg_segment_ptr(); F.out = args.out;
    F.tid = threadIdx.x; F.lane = F.tid & 63; F.wave = __builtin_amdgcn_readfirstlane(F.tid >> 6); F.G = gridDim.x; F.bid = blockIdx.x;
    volatile LAS unsigned* MISC = (volatile LAS unsigned*)(F.lds + LDS_MISC);
    if (F.tid < 64) MISC[F.tid] = 0u;
    __syncthreads();
    const int lo = args.ph_lo, hi = args.ph_hi;
    XcdBarrier bar; bar.bar = (unsigned*)(F.ws + WS_CTL) + 4096; bar.x = 0; bar.st = nullptr;
    if (hi - lo > 1) bar = xcd_barrier_post((unsigned*)(F.ws + WS_CTL) + 4096, MISC + 8);
    int ph = 0;
    const int wave_s_ = __builtin_amdgcn_readfirstlane((int)threadIdx.x >> 6);
#ifndef SITE_MASK
#define SITE_MASK 0xffffffffffffffffull
#endif
#ifndef PROBE_T_MASK
#define PROBE_T_MASK 0ull
#endif
#ifndef PROBE_T_FACTOR
#define PROBE_T_FACTOR 20ull
#endif
    unsigned long long tacc_ = 0ull, t0_ = 0ull;
#ifndef SITE_MASK
#define SITE_MASK 0xffffffffffffffffull
#endif
#define PHASE_BEGIN { constexpr int site_ = __COUNTER__; if (((SITE_MASK >> site_) & 1ull) && ph >= lo && ph < hi) { if (((PROBE_T_MASK >> site_) & 1ull) && F.bid == 0) t0_ = __builtin_amdgcn_s_memrealtime(); \
      { unsigned _m = ~0u; int _wv = wave_s_; asm volatile("" : "+s"(_m), "+s"(_wv)); int _t = _wv * 64 + (int)__builtin_amdgcn_mbcnt_hi(_m, __builtin_amdgcn_mbcnt_lo(_m, 0u)); asm volatile("" : "+v"(_t)); F.tid = _t; F.lane = _t & 63; F.wave = _wv; { int _b = blockIdx.x, _g = gridDim.x; asm volatile("" : "+s"(_b), "+s"(_g)); F.bid = _b; F.G = _g; } \
      kptr_t _kb = __builtin_amdgcn_kernarg_segment_ptr(); asm volatile("" : "+s"(_kb)); F.kb = _kb; \
      __attribute__((address_space(1))) unsigned char* _w = (__attribute__((address_space(1))) unsigned char*)args.ws; asm volatile("" : "+s"(_w)); F.ws = (unsigned char*)_w; ws = F.ws; __attribute__((address_space(1))) float* _o = (__attribute__((address_space(1))) float*)args.out; asm volatile("" : "+s"(_o)); F.out = (float*)_o; }
#define PHASE_END   if (ph + 1 < hi) xcd_barrier(bar, F.tid); if (((PROBE_T_MASK >> site_) & 1ull) && F.bid == 0) tacc_ += __builtin_amdgcn_s_memrealtime() - t0_; } ++ph; }
    unsigned char* ws = F.ws;
#define HN ((const bf16_t*)(ws + WS_HN))

    PHASE_BEGIN ph_prologue0(F); PHASE_END
    PHASE_BEGIN { pg8::Gemm g{(const bf16_t*)(ws + WS_MEMH), (const bf16_t*)(ws + WS_WKV), D, 0, nullptr}; pg8::StaticOrder S; S.init(MEMROWS, 4096, F.G, F.bid);
        pg8::EpiPlain E{(bf16_t*)(ws + PR_KVRAW), 4096}; pg8::gemm_phase<pg8::EpiPlain, pg8::StaticOrder>(F.lds, g, S, E, F.tid); } PHASE_END
    PHASE_BEGIN ph_prologue2(F); PHASE_END

#pragma unroll 1
    for (int l = 0; l < DEPTH; ++l) {

        PHASE_BEGIN ph_layer0(F, l, l ? (const float*)F.out : FIN(F, I_X)); PHASE_END
#pragma unroll 1
        for (int half = 0; half < 2; ++half) {

            PHASE_BEGIN { pg8::Gemm g{HN + (size_t)half * TH * D, (const bf16_t*)(ws + W_IN), D, 0, nullptr}; pg8::StaticOrder S; S.init(TH, N_INP, F.G, F.bid);
                pg8::EpiWin E{(bf16_t*)(ws + MX_CA), (bf16_t*)(ws + MX_CB), (bf16_t*)(ws + MX_CG)}; pg8::gemm_phase<pg8::EpiWin, pg8::StaticOrder>(F.lds, g, S, E, F.tid); } PHASE_END
                        #ifndef PROBE_RPREP
#define PROBE_RPREP 1
#endif
#ifndef PROBE_S2
#define PROBE_S2 1
#endif
#ifndef PROBE_DSA
#define PROBE_DSA 1
#endif
            PHASE_BEGIN ph_rwkv_pre(F, l, half); ph_dsa_prep(F, l, half); PHASE_END
            PHASE_BEGIN ph_rwkv_s1(F, l, half); PHASE_END
            PHASE_BEGIN { for (int r_ = 0; r_ < PROBE_S2; ++r_) for (int p = F.bid; p < 128; p += F.G) ph_rwkv_s2(F, l, p); ph_dsa(F, half, (unsigned*)(ws + WS_CTL) + 8192 + 64 * (2 * l + half)); } PHASE_END
            PHASE_BEGIN { pg8::Gemm g{(const bf16_t*)(ws + MX_CA + RW_ARR), (const bf16_t*)(ws + W_BA), 512, 0, nullptr}; pg8::StaticOrder S; S.init(TH, D, F.G, F.bid);
                pg8::EpiMerge<false> E{(bf16_t*)(ws + WS_HN) + (size_t)half * TH * D, (const bf16_t*)(ws + MX_CG), 0}; pg8::gemm_phase<pg8::EpiMerge<false>, pg8::StaticOrder>(F.lds, g, S, E, F.tid); } PHASE_END
            PHASE_BEGIN { pg8::Gemm g{(const bf16_t*)(ws + MX_YB), (const bf16_t*)(ws + W_BB), 512, 0, nullptr}; pg8::StaticOrder S; S.init(TH, D, F.G, F.bid);
                pg8::EpiMerge<true> E{(bf16_t*)(ws + WS_HN) + (size_t)half * TH * D, (const bf16_t*)(ws + MX_CG), 1024}; pg8::gemm_phase<pg8::EpiMerge<true>, pg8::StaticOrder>(F.lds, g, S, E, F.tid); } PHASE_END
        }
        PHASE_BEGIN { pg8::Gemm g{HN, (const bf16_t*)(ws + W_OUT), D, 0, nullptr}; pg8::StaticOrder S; S.init(T, D, F.G, F.bid);
            pg8::EpiResid E{l ? (const float*)F.out : FIN(F, I_X), F.out}; pg8::gemm_phase<pg8::EpiResid, pg8::StaticOrder>(F.lds, g, S, E, F.tid); } PHASE_END
        PHASE_BEGIN ph_norm(F); PHASE_END
        PHASE_BEGIN { pg8::Gemm g{HN, (const bf16_t*)(ws + W_MQ), D, 0, nullptr}; pg8::StaticOrder S; S.init(T, 512, F.G, F.bid);
            pg8::EpiPlain E{(bf16_t*)(ws + MA_QM), 512}; pg8::gemm_phase<pg8::EpiPlain, pg8::StaticOrder>(F.lds, g, S, E, F.tid); } PHASE_END
        PHASE_BEGIN ph_mem_attn(F, l); PHASE_END
        PHASE_BEGIN { pg8::Gemm g{(const bf16_t*)(ws + MA_OM), (const bf16_t*)(ws + W_MO), 512, 0, nullptr}; pg8::StaticOrder S; S.init(T, D, F.G, F.bid);
            pg8::EpiResid E{F.out, F.out}; pg8::gemm_phase<pg8::EpiResid, pg8::StaticOrder>(F.lds, g, S, E, F.tid); } PHASE_END
        PHASE_BEGIN ph_norm_ffn(F, l); PHASE_END
        if ((l & 1) == 0) {
            PHASE_BEGIN { pg8::Gemm g{HN, (const bf16_t*)(ws + W_FGU), D, 0, nullptr}; pg8::StaticOrder S; S.init(T, 2 * FFN, F.G, F.bid);
                pg8::EpiSwiGLU E{(bf16_t*)(ws + FF_GU), FFN}; pg8::gemm_phase<pg8::EpiSwiGLU, pg8::StaticOrder>(F.lds, g, S, E, F.tid); } PHASE_END
            PHASE_BEGIN { pg8::Gemm g{(const bf16_t*)(ws + FF_GU), (const bf16_t*)(ws + W_FD), FFN, 0, nullptr}; pg8::StaticOrder S; S.init(T, D, F.G, F.bid);
                pg8::EpiResid E{F.out, F.out}; pg8::gemm_phase<pg8::EpiResid, pg8::StaticOrder, false, true>(F.lds, g, S, E, F.tid); } PHASE_END
            ph += 2;
        } else {
#define meta ((const int*)(ws + MOE_META))
#define tile_e ((const int*)(ws + MOE_TILEE))
            PHASE_BEGIN ph_moe_route(F); PHASE_END
            PHASE_BEGIN { const int nt1 = __builtin_amdgcn_readfirstlane(meta[1]);
                pg8::Gemm g{HN, (const bf16_t*)(ws + W_EGU), D, (size_t)2 * EDIM * D, (const int*)(ws + MOE_ROWTOK)}; pg8::MoeOrder S; S.init(nt1, 11, F.G, F.bid, 0, tile_e);
                pg8::EpiSwiGLU E{(bf16_t*)(ws + FF_GU), EDIM}; pg8::gemm_phase<pg8::EpiSwiGLU, pg8::MoeOrder, true>(F.lds, g, S, E, F.tid); } PHASE_END
            PHASE_BEGIN { const int nt0 = __builtin_amdgcn_readfirstlane(meta[0]);
                pg8::Gemm g{(const bf16_t*)(ws + FF_GU), (const bf16_t*)(ws + W_ED), EDIM, (size_t)D * EDIM, nullptr}; pg8::MoeOrder S; S.init(nt0, 4, F.G, F.bid, 0, tile_e);
                pg8::EpiMoeDown E{F.out, (const int*)(ws + MOE_ROWTOK), (const float*)(ws + MOE_ROWW)}; pg8::gemm_phase<pg8::EpiMoeDown, pg8::MoeOrder, false, true>(F.lds, g, S, E, F.tid); } PHASE_END
            PHASE_BEGIN { const int nt0 = __builtin_amdgcn_readfirstlane(meta[0]), nt1 = __builtin_amdgcn_readfirstlane(meta[1]);
                pg8::Gemm g{(const bf16_t*)(ws + FF_GU), (const bf16_t*)(ws + W_ED), EDIM, (size_t)D * EDIM, nullptr}; pg8::MoeOrder S; S.init(nt1 - nt0, 4, F.G, F.bid, nt0, tile_e);
                pg8::EpiMoeDown E{F.out, (const int*)(ws + MOE_ROWTOK), (const float*)(ws + MOE_ROWW)}; pg8::gemm_phase<pg8::EpiMoeDown, pg8::MoeOrder, false, true>(F.lds, g, S, E, F.tid); } PHASE_END
        }
    }
    if (PROBE_T_MASK != 0ull && F.bid == 0) { const unsigned long long te_ = __builtin_amdgcn_s_memrealtime() + PROBE_T_FACTOR * tacc_; while (__builtin_amdgcn_s_memrealtime() < te_) __builtin_amdgcn_s_sleep(32); }
}
constexpr int N_PHASES = 3 + DEPTH * (1 + 2 * 6 + 6 + 4);

extern "C" void kernel_launch(void* const* d_in, const int* in_sizes, int n_in, void* d_out, int out_size, void* d_ws, size_t ws_size, hipStream_t stream) {
    static int grid = 0;
    if (grid == 0) {
        if (n_in != 41 || out_size != T * D || ws_size < WS_END) { fprintf(stderr, "kernel_launch: unexpected shapes (n_in %d, out %d, ws %zu < %zu); nothing launched\n", n_in, out_size, ws_size, (size_t)WS_END); grid = -1; return; }
        int dev = 0, cus = 0, per_cu = 0;
        if (hipGetDevice(&dev) != hipSuccess || hipDeviceGetAttribute(&cus, hipDeviceAttributeMultiprocessorCount, dev) != hipSuccess) { grid = -1; return; }
        if (hipFuncSetAttribute((const void*)fwd, hipFuncAttributeMaxDynamicSharedMemorySize, LDS_BYTES) != hipSuccess) { fprintf(stderr, "kernel_launch: hipFuncSetAttribute failed\n"); grid = -1; return; }
        if (hipOccupancyMaxActiveBlocksPerMultiprocessor(&per_cu, (const void*)fwd, NTHR, LDS_BYTES) != hipSuccess || per_cu < 1) fprintf(stderr, "kernel_launch: occupancy query reports %d\n", per_cu);
        (void)hipGetLastError();
        grid = cus;
    }
    if (grid < 0) return;
    if (hipMemsetAsync((char*)d_ws + WS_CTL, 0, CTL_ZERO_BYTES, stream) != hipSuccess) return;
    Args a{};
    for (int i = 0; i < 41; ++i) a.in[i] = d_in[i];
    a.out = (float*)d_out; a.ws = (unsigned char*)d_ws;
#if MK_ONE_LAUNCH
    a.ph_lo = 0; a.ph_hi = N_PHASES;
    hipLaunchKernelGGL(fwd, dim3(grid), dim3(NTHR), LDS_BYTES, stream, a);
#else
    for (int p = 0; p < N_PHASES; ++p) { a.ph_lo = p; a.ph_hi = p + 1; hipLaunchKernelGGL(fwd, dim3(grid), dim3(NTHR), LDS_BYTES, stream, a); }
#endif
}
```

```cpp
#include <hip/hip_runtime.h>
#include <cstdio>
#include <cstdint>

#ifndef MK_ONE_LAUNCH
#define MK_ONE_LAUNCH 1
#endif

namespace pg8 {
#define PG8_LAS __attribute__((address_space(3)))
typedef unsigned short bf16_t;
typedef short bf16x8 __attribute__((ext_vector_type(8)));
typedef float f32x4 __attribute__((ext_vector_type(4)));
typedef float f32x2 __attribute__((ext_vector_type(2)));
typedef unsigned u32x4 __attribute__((ext_vector_type(4)));
typedef unsigned u32x2 __attribute__((ext_vector_type(2)));
typedef __bf16 bf16x2_t __attribute__((ext_vector_type(2)));
constexpr int BM = 256, BK = 64, HALF = 128, HTB = HALF * BK * 2, STAGE_BYTES = 8 * HTB, NXCD = 8, WGM = 8;

__host__ __device__ __forceinline__ int lds_byte(int r, int c) { const int st = (r >> 4) * 2 + (c >> 5), rr = r & 15, cc = c & 31, ob = rr * 64 + cc * 2; return st * 1024 + (ob ^ (((ob >> 9) & 1) << 5)); }
__host__ __device__ __forceinline__ void stage_rc(int b, int& R, int& C) { const int st = b / 1024, sb = b % 1024, swz = sb ^ (((sb >> 9) & 1) << 5); R = (st >> 1) * 16 + swz / 64; C = (st & 1) * 32 + (swz % 64) / 2; }
__host__ __device__ __forceinline__ int perm32(int rho) { const int n = rho >> 4, i = rho & 15; return 8 * (i >> 2) + 4 * n + (i & 3); }

struct Unit { int pm, pn, e; };
struct Gemm { const bf16_t* A; const bf16_t* Bt; int K; size_t bstride; const int* rowidx; };

struct StaticOrder {
    int nM, nN, nwg, G, c;
    __device__ void init(int M, int N, int G_, int c_) { nM = M / BM; nN = N / BM; nwg = nM * nN; G = G_; c = c_; }
    __device__ bool next(int i, Unit& u) const {
        const long L = (long)i * G + c; if (L >= nwg) return false;
        int wgid = (int)L; { const int q = nwg / NXCD, r = nwg % NXCD, xcd = wgid % NXCD, off = wgid / NXCD; wgid = (xcd < r ? xcd * (q + 1) : r * (q + 1) + (xcd - r) * q) + off; }
        const int nig = WGM * nN, gid = wgid / nig, fm = gid * WGM, gsz = (nM - fm) < WGM ? (nM - fm) : WGM;
        u.pm = fm + ((wgid % nig) % gsz); u.pn = (wgid % nig) / gsz; u.e = 0; return true;
    }
};
struct MoeOrder {
    int nM, nN, nwg, G, c, pm0; const int* tile_e;
    __device__ void init(int nM_, int nN_, int G_, int c_, int pm0_, const int* te) { nM = nM_; nN = nN_; nwg = nM * nN; G = G_; c = c_; pm0 = pm0_; tile_e = te; }
    __device__ bool next(int i, Unit& u) const {
        const long L = (long)i * G + c; if (L >= nwg) return false;
        int wgid = (int)L; { const int q = nwg / NXCD, r = nwg % NXCD, xcd = wgid % NXCD, off = wgid / NXCD; wgid = (xcd < r ? xcd * (q + 1) : r * (q + 1) + (xcd - r) * q) + off; }
        const int nig = WGM * nN, gid = wgid / nig, fm = gid * WGM, gsz = (nM - fm) < WGM ? (nM - fm) : WGM;
        u.pm = pm0 + fm + ((wgid % nig) % gsz); u.pn = (wgid % nig) / gsz; u.e = __builtin_amdgcn_readfirstlane(tile_e[u.pm]); return true;
    }
};

__device__ __forceinline__ unsigned pk2(float lo, float hi) { const bf16x2_t v = __builtin_convertvector((f32x2){lo, hi}, bf16x2_t); return __builtin_bit_cast(unsigned, v); }
__device__ __forceinline__ float bf_lo(unsigned u) { return __builtin_bit_cast(float, u << 16); }
__device__ __forceinline__ float bf_hi(unsigned u) { return __builtin_bit_cast(float, u & 0xffff0000u); }
__device__ __forceinline__ float bf2f(bf16_t b) { return __builtin_bit_cast(float, (unsigned)b << 16); }
__device__ __forceinline__ bf16_t f2bf(float f) { return (bf16_t)(pk2(f, 0.f) & 0xffffu); }
__device__ __forceinline__ float sigmoidf_(float x) { return __builtin_amdgcn_rcpf(1.0f + __expf(-x)); }

struct EpiPlain {
    static constexpr bool PERM = true;
    bf16_t* O; int ldc;
    __device__ __forceinline__ void operator()(const f32x4 (&acc)[2][2][4][2], const Unit& u, int wr, int wc, int fr, int fq) const {
        const int row0 = u.pm * BM + wr * 64 + fr, col0 = u.pn * BM + wc * 32 + 8 * fq;
#pragma unroll
        for (int ai = 0; ai < 2; ++ai)
#pragma unroll
            for (int m = 0; m < 4; ++m) { bf16_t* rowp = O + (size_t)(row0 + ai * HALF + m * 16) * ldc + col0;
#pragma unroll
                for (int bj = 0; bj < 2; ++bj) { const f32x4 v0 = acc[ai][bj][m][0], v1 = acc[ai][bj][m][1];
                    u32x4 w; w.x = pk2(v0[0], v0[1]); w.y = pk2(v0[2], v0[3]); w.z = pk2(v1[0], v1[1]); w.w = pk2(v1[2], v1[3]);
                    *(u32x4*)(rowp + bj * HALF) = w; } }
    }
};
struct EpiWin {
    static constexpr bool PERM = true;
    bf16_t *CA, *CB, *CG;
    __device__ __forceinline__ void operator()(const f32x4 (&acc)[2][2][4][2], const Unit& u, int wr, int wc, int fr, int fq) const {
        const int row0 = u.pm * BM + wr * 64 + fr; const int pn = u.pn;
        bf16_t* base; int ldc, ct; const bool sg = pn >= 12;
        if (pn < 7) { base = CA; ldc = 1792; ct = pn; } else if (pn < 12) { base = CB; ldc = 1280; ct = pn - 7; } else { base = CG; ldc = 2048; ct = pn - 12; }
        const int col0 = ct * BM + wc * 32 + 8 * fq;
#pragma unroll
        for (int ai = 0; ai < 2; ++ai)
#pragma unroll
            for (int m = 0; m < 4; ++m) { bf16_t* rowp = base + (size_t)(row0 + ai * HALF + m * 16) * ldc + col0;
#pragma unroll
                for (int bj = 0; bj < 2; ++bj) { f32x4 v0 = acc[ai][bj][m][0], v1 = acc[ai][bj][m][1];
                    if (sg) {
#pragma unroll
                        for (int j = 0; j < 4; ++j) { v0[j] = sigmoidf_(v0[j]); v1[j] = sigmoidf_(v1[j]); } }
                    u32x4 w; w.x = pk2(v0[0], v0[1]); w.y = pk2(v0[2], v0[3]); w.z = pk2(v1[0], v1[1]); w.w = pk2(v1[2], v1[3]);
                    *(u32x4*)(rowp + bj * HALF) = w; } }
    }
};
template <bool ADD> struct EpiMerge {
    static constexpr bool PERM = true;
    bf16_t* O; const bf16_t* gate; int gcol;
    __device__ __forceinline__ void operator()(const f32x4 (&acc)[2][2][4][2], const Unit& u, int wr, int wc, int fr, int fq) const {
        const int row0 = u.pm * BM + wr * 64 + fr, col0 = u.pn * BM + wc * 32 + 8 * fq;
#pragma unroll
        for (int ai = 0; ai < 2; ++ai) {
            u32x4 gv[4][2], pv[4][2];
#pragma unroll
            for (int m = 0; m < 4; ++m) { const size_t row = (size_t)(row0 + ai * HALF + m * 16);
#pragma unroll
                for (int bj = 0; bj < 2; ++bj) { gv[m][bj] = *(const u32x4*)(gate + row * 2048 + gcol + col0 + bj * HALF); if (ADD) pv[m][bj] = *(const u32x4*)(O + row * 1024 + col0 + bj * HALF); } }
#pragma unroll
            for (int m = 0; m < 4; ++m) { const size_t row = (size_t)(row0 + ai * HALF + m * 16);
#pragma unroll
                for (int bj = 0; bj < 2; ++bj) { const f32x4 v0 = acc[ai][bj][m][0], v1 = acc[ai][bj][m][1]; const u32x4 g = gv[m][bj];
                    float o[8] = { bf_lo(g.x) * v0[0], bf_hi(g.x) * v0[1], bf_lo(g.y) * v0[2], bf_hi(g.y) * v0[3], bf_lo(g.z) * v1[0], bf_hi(g.z) * v1[1], bf_lo(g.w) * v1[2], bf_hi(g.w) * v1[3] };
                    if (ADD) { const u32x4 p = pv[m][bj];
                        o[0] += bf_lo(p.x); o[1] += bf_hi(p.x); o[2] += bf_lo(p.y); o[3] += bf_hi(p.y); o[4] += bf_lo(p.z); o[5] += bf_hi(p.z); o[6] += bf_lo(p.w); o[7] += bf_hi(p.w); }
                    u32x4 w; w.x = pk2(o[0], o[1]); w.y = pk2(o[2], o[3]); w.z = pk2(o[4], o[5]); w.w = pk2(o[6], o[7]);
                    *(u32x4*)(O + row * 1024 + col0 + bj * HALF) = w; } }
        }
    }
};
struct EpiResid {
    static constexpr bool PERM = false;
    const float* xi; float* xo;
    __device__ __forceinline__ void operator()(const f32x4 (&acc)[2][2][4][2], const Unit& u, int wr, int wc, int fr, int fq) const {
        const int row0 = u.pm * BM + wr * 64 + fr, col0 = u.pn * BM + wc * 32 + 4 * fq;
#pragma unroll
        for (int ai = 0; ai < 2; ++ai) {
            f32x4 xv[4][2][2];
#pragma unroll
            for (int m = 0; m < 4; ++m) { const size_t o = (size_t)(row0 + ai * HALF + m * 16) * 1024 + col0;
#pragma unroll
                for (int bj = 0; bj < 2; ++bj)
#pragma unroll
                    for (int n = 0; n < 2; ++n) xv[m][bj][n] = *(const f32x4*)(xi + o + bj * HALF + n * 16); }
#pragma unroll
            for (int m = 0; m < 4; ++m) { const size_t o = (size_t)(row0 + ai * HALF + m * 16) * 1024 + col0;
#pragma unroll
                for (int bj = 0; bj < 2; ++bj)
#pragma unroll
                    for (int n = 0; n < 2; ++n) *(f32x4*)(xo + o + bj * HALF + n * 16) = xv[m][bj][n] + acc[ai][bj][m][n]; }
        }
    }
};
struct EpiSwiGLU {
    static constexpr bool PERM = true;
    bf16_t* O; int ldc;
    __device__ __forceinline__ void operator()(const f32x4 (&acc)[2][2][4][2], const Unit& u, int wr, int wc, int fr, int fq) const {
        const int row0 = u.pm * BM + wr * 64 + fr, col0 = u.pn * HALF + wc * 32 + 8 * fq;
#pragma unroll
        for (int ai = 0; ai < 2; ++ai)
#pragma unroll
            for (int m = 0; m < 4; ++m) { const int row = row0 + ai * HALF + m * 16;
                bf16_t* rowp = O + ((size_t)((row >> 6) * (ldc >> 4) + (col0 >> 4)) << 10) + (((row & 63) << 4) + (col0 & 15));
                float o[8];
#pragma unroll
                for (int n = 0; n < 2; ++n)
#pragma unroll
                    for (int j = 0; j < 4; ++j) { const float g = acc[ai][0][m][n][j], up = acc[ai][1][m][n][j]; o[4 * n + j] = g * sigmoidf_(g) * up; }
                u32x4 w; w.x = pk2(o[0], o[1]); w.y = pk2(o[2], o[3]); w.z = pk2(o[4], o[5]); w.w = pk2(o[6], o[7]);
                *(u32x4*)rowp = w; }
    }
};
struct EpiMoeDown {
    static constexpr bool PERM = false;
    float* x; const int* tok; const float* wgt;
    __device__ __forceinline__ void operator()(const f32x4 (&acc)[2][2][4][2], const Unit& u, int wr, int wc, int fr, int fq) const {
        const int row0 = u.pm * BM + wr * 64 + fr, col0 = u.pn * BM + wc * 32 + 4 * fq;
        int tk[2][4]; float wv[2][4];
#pragma unroll
        for (int ai = 0; ai < 2; ++ai)
#pragma unroll
            for (int m = 0; m < 4; ++m) { const int row = row0 + ai * HALF + m * 16; tk[ai][m] = tok[row]; wv[ai][m] = wgt[row]; }
#pragma unroll
        for (int ai = 0; ai < 2; ++ai) {
            f32x4 xv[4][2][2];
#pragma unroll
            for (int m = 0; m < 4; ++m) { const int t = tk[ai][m] < 0 ? 0 : tk[ai][m]; const float* xp = x + (size_t)t * 1024 + col0;
#pragma unroll
                for (int bj = 0; bj < 2; ++bj)
#pragma unroll
                    for (int n = 0; n < 2; ++n) xv[m][bj][n] = *(const f32x4*)(xp + bj * HALF + n * 16); }
#pragma unroll
            for (int m = 0; m < 4; ++m) if (tk[ai][m] >= 0) { float* xp = x + (size_t)tk[ai][m] * 1024 + col0;
#pragma unroll
                for (int bj = 0; bj < 2; ++bj)
#pragma unroll
                    for (int n = 0; n < 2; ++n) *(f32x4*)(xp + bj * HALF + n * 16) = xv[m][bj][n] + acc[ai][bj][m][n] * wv[ai][m]; }
        }
    }
};

template <class Epi, class Sched, bool GATHER = false, bool ABLK = false>
__device__ __forceinline__ void gemm_phase(PG8_LAS unsigned char* lds, const Gemm g, const Sched& S, const Epi& E, int tid_) {
    asm volatile("" : "+v"(tid_));
    const int tid = tid_, wid = __builtin_amdgcn_readfirstlane(tid >> 6), lane = tid & 63, wr = wid >> 2, wc = wid & 3, fr = lane & 15, fq = lane >> 4;
    const int K = g.K, nt = K / BK;
    unsigned voffA[2], voffB[2];
#pragma unroll
    for (int i = 0; i < 2; ++i) { int R, C; stage_rc(tid * 16 + i * 8192, R, C); const int Rb = Epi::PERM ? ((R & ~31) + perm32(R & 31)) : R;
        voffA[i] = ABLK ? (unsigned)(((R >> 6) * (K >> 4) + (C >> 4)) * 2048 + (((R & 63) << 4) + (C & 15)) * 2) : (unsigned)(R * K + C) * 2u; voffB[i] = (unsigned)(Rb * K + C) * 2u; }
    const size_t kstep = (size_t)(BK * 2);
    const size_t hstep = (size_t)HALF * K * 2;
    const size_t tstep = 2 * hstep;
    const size_t hstepA = ABLK ? (size_t)2 * (K >> 4) * 2048 : hstep, tstepA = 2 * hstepA; constexpr size_t AKM = ABLK ? 64 : 1;
    const unsigned ldsw = (unsigned)wid * 1024u;
    const int aoff = lds_byte(wr * 64 + fr, fq * 8), boff = lds_byte(wc * 32 + fr, fq * 8);
    unsigned gvo[2][2];
#define PG8_SA(b, h) (((b) * 2 + (h)) * HTB)
#define PG8_SB(b, h) ((4 + (b) * 2 + (h)) * HTB)
#define PG8_STAGE(bufoff, gbase, voff) do { _Pragma("unroll") for (int _i = 0; _i < 2; ++_i) \
        __builtin_amdgcn_global_load_lds((const unsigned*)((const char*)(gbase) + (voff)[_i]), (PG8_LAS unsigned*)(lds + (bufoff) + ldsw + _i * 8192), 16, 0, 0); } while (0)
#define PG8_STAGE_A(bufoff, h, ubase, kb, nx) do { if constexpr (GATHER) { PG8_STAGE(bufoff, (const char*)g.A + (kb), gvo[h]); } \
        else { PG8_STAGE(bufoff, (ubase) + (kb) * AKM + (h) * hstepA, voffA); } } while (0)
#define PG8_LOADROWS(dst, unit) do { if constexpr (GATHER) { _Pragma("unroll") for (int _i = 0; _i < 2; ++_i) { int _R, _C; stage_rc(tid * 16 + _i * 8192, _R, _C); \
        _Pragma("unroll") for (int _h = 0; _h < 2; ++_h) { int _t = g.rowidx[(unit).pm * BM + _h * HALF + _R]; _t = _t < 0 ? 0 : _t; dst[_h][_i] = (unsigned)(_t * K + _C) * 2u; } } } } while (0)
#define PG8_LDA(dst, b, h) do { _Pragma("unroll") for (int m = 0; m < 4; ++m) _Pragma("unroll") for (int k = 0; k < 2; ++k) dst[m][k] = *(const PG8_LAS bf16x8*)(lds + PG8_SA(b, h) + aoff + m * 2048 + k * 1024); } while (0)
#define PG8_LDB(dst, b, h) do { _Pragma("unroll") for (int n = 0; n < 2; ++n) _Pragma("unroll") for (int k = 0; k < 2; ++k) dst[n][k] = *(const PG8_LAS bf16x8*)(lds + PG8_SB(b, h) + boff + n * 2048 + k * 1024); } while (0)
#define PG8_MMA(ai, bj, At, Bt) do { __builtin_amdgcn_s_setprio(1); _Pragma("unroll") for (int m = 0; m < 4; ++m) _Pragma("unroll") for (int n = 0; n < 2; ++n) _Pragma("unroll") for (int k = 0; k < 2; ++k) \
        acc[ai][bj][m][n] = __builtin_amdgcn_mfma_f32_16x16x32_bf16(Bt[n][k], At[m][k], acc[ai][bj][m][n], 0, 0, 0); __builtin_amdgcn_s_setprio(0); } while (0)
#define PG8_WAIT_V(n) asm volatile("s_waitcnt vmcnt(" #n ")" ::: "memory")
#define PG8_WAIT_L(n) asm volatile("s_waitcnt lgkmcnt(" #n ")" ::: "memory")
#define PG8_BAR __builtin_amdgcn_s_barrier()
#define PG8_SCHED __builtin_amdgcn_sched_barrier(0)
    Unit cur, nxt; int ui = 0;
    if (!S.next(0, cur)) return;
    f32x4 acc[2][2][4][2];
#pragma unroll
    for (int a = 0; a < 2; ++a)
#pragma unroll
        for (int b = 0; b < 2; ++b)
#pragma unroll
            for (int m = 0; m < 4; ++m)
#pragma unroll
                for (int n = 0; n < 2; ++n) acc[a][b][m][n] = (f32x4){0.f, 0.f, 0.f, 0.f};
    bf16x8 At[4][2], B0[2][2], B1[2][2];
    const char* cA = GATHER ? (const char*)g.A : (const char*)g.A + (size_t)cur.pm * tstepA;
    const char* cB = (const char*)g.Bt + ((size_t)cur.e * g.bstride) * 2 + (size_t)cur.pn * tstep;
    PG8_LOADROWS(gvo, cur);
    PG8_STAGE(PG8_SB(0, 0), cB, voffB); PG8_STAGE(PG8_SB(0, 1), cB + hstep, voffB); PG8_STAGE_A(PG8_SA(0, 0), 0, cA, 0, false); PG8_STAGE_A(PG8_SA(0, 1), 1, cA, 0, false);
    if (wr == 1) PG8_BAR;
    PG8_WAIT_V(2); PG8_BAR;
    PG8_STAGE(PG8_SB(1, 0), cB + kstep, voffB); PG8_STAGE_A(PG8_SA(1, 0), 0, cA, kstep, false); PG8_STAGE(PG8_SB(1, 1), cB + hstep + kstep, voffB);
    PG8_WAIT_V(6); PG8_BAR;
    for (;;) {
        const bool has_next = S.next(ui + 1, nxt);
        const char* nA = GATHER ? (const char*)g.A : (has_next ? (const char*)g.A + (size_t)nxt.pm * tstepA : cA);
        const char* nB = has_next ? (const char*)g.Bt + ((size_t)nxt.e * g.bstride) * 2 + (size_t)nxt.pn * tstep : cB;
        for (int t = 0; t < nt; t += 2) {
            const bool last = (t == nt - 2);
            const size_t k1 = (size_t)(t + 1) * kstep;
            const size_t k2 = last ? 0 : (size_t)(t + 2) * kstep, k3 = k2 + kstep;
            const char* a2b = last ? nA : cA; const char* b2 = (last ? nB : cB) + k2; const char* b3 = b2 + kstep;
            PG8_LDB(B0, 0, 0); PG8_LDB(B1, 0, 1); PG8_SCHED; PG8_LDA(At, 0, 0); PG8_STAGE_A(PG8_SA(1, 1), 1, cA, k1, false);
            if (last && has_next) PG8_LOADROWS(gvo, nxt);
            PG8_WAIT_V(8); PG8_WAIT_L(0); PG8_BAR; PG8_MMA(0, 0, At, B0); PG8_MMA(0, 1, At, B1); PG8_BAR; PG8_SCHED;
            PG8_LDA(At, 0, 1); PG8_STAGE(PG8_SB(0, 0), b2, voffB); PG8_STAGE(PG8_SB(0, 1), b2 + hstep, voffB); PG8_STAGE_A(PG8_SA(0, 0), 0, a2b, k2, last);
            PG8_WAIT_V(8); PG8_WAIT_L(0); PG8_BAR; PG8_MMA(1, 0, At, B0); PG8_MMA(1, 1, At, B1); PG8_BAR; PG8_SCHED;
            PG8_LDB(B0, 1, 0); PG8_LDB(B1, 1, 1); PG8_SCHED; PG8_LDA(At, 1, 0); PG8_STAGE_A(PG8_SA(0, 1), 1, a2b, k2, last);
            PG8_WAIT_V(8); PG8_WAIT_L(0); PG8_BAR; PG8_MMA(0, 0, At, B0); PG8_MMA(0, 1, At, B1); PG8_BAR; PG8_SCHED;
            PG8_LDA(At, 1, 1); PG8_STAGE(PG8_SB(1, 0), b3, voffB); PG8_STAGE(PG8_SB(1, 1), b3 + hstep, voffB); PG8_STAGE_A(PG8_SA(1, 0), 0, a2b, k3, last);
            PG8_WAIT_V(8); PG8_WAIT_L(0); PG8_BAR; PG8_MMA(1, 0, At, B0); PG8_MMA(1, 1, At, B1); PG8_BAR; PG8_SCHED;
        }
        if (wr == 0) PG8_BAR;
        E(acc, cur, wr, wc, fr, fq);
        if (!has_next) break;
#pragma unroll
        for (int a = 0; a < 2; ++a)
#pragma unroll
            for (int b = 0; b < 2; ++b)
#pragma unroll
                for (int m = 0; m < 4; ++m)
#pragma unroll
                    for (int n = 0; n < 2; ++n) acc[a][b][m][n] = (f32x4){0.f, 0.f, 0.f, 0.f};
        cur = nxt; cA = nA; cB = nB; ++ui;
        if (wr == 1) PG8_BAR;
    }
    PG8_WAIT_V(0);
    PG8_BAR;
#undef PG8_SA
#undef PG8_SB
#undef PG8_STAGE
#undef PG8_STAGE_A
#undef PG8_LOADROWS
#undef PG8_LDA
#undef PG8_LDB
#undef PG8_MMA
#undef PG8_WAIT_V
#undef PG8_WAIT_L
#undef PG8_BAR
#undef PG8_SCHED
}
}
using pg8::bf16_t; using pg8::bf16x8; using pg8::f32x4; using pg8::f32x2; using pg8::u32x4; using pg8::u32x2; using pg8::pk2; using pg8::bf2f; using pg8::f2bf; using pg8::bf_lo; using pg8::bf_hi; using pg8::sigmoidf_;

constexpr int NWAVES = 8, NTHR = 512;
constexpr int D = 1024, NB = 32, SEQ = 2048, T = NB * SEQ, TH = T / 2, DEPTH = 4;
constexpr int RW_COLS = 1792, DS_COLS = 1224, DS_PAD = 1280, N_IN = 5064, N_INP = 5120;
constexpr int NMEM = 256, MEMROWS = NB * NMEM;
constexpr int FFN = 2816, NEXP = 8, EDIM = 1408;
constexpr int MOE_ROWS_MAX = 2 * T + 16 * 256;
constexpr int MOE_TILES_MAX = MOE_ROWS_MAX / 256;

constexpr size_t MiB = 1u << 20;
constexpr size_t WS_CTL = 0, CTL_ZERO_BYTES = 1 * MiB;
constexpr size_t WS_MOE = 1 * MiB;
constexpr size_t MOE_SELE = WS_MOE, MOE_SELW = MOE_SELE + (size_t)T * 2, MOE_ROWTOK = MOE_SELW + (size_t)T * 8, MOE_ROWW = MOE_ROWTOK + (size_t)MOE_ROWS_MAX * 4,
                 MOE_TILEE = MOE_ROWW + (size_t)MOE_ROWS_MAX * 4, MOE_META = MOE_TILEE + (size_t)MOE_TILES_MAX * 4, MOE_END = MOE_META + 256;
static_assert(MOE_END <= 4 * MiB, "moe map");
constexpr size_t WS_W = 4 * MiB;
constexpr size_t W_IN = WS_W, W_BA = W_IN + (size_t)N_INP * D * 2, W_BB = W_BA + (size_t)D * 512 * 2, W_OUT = W_BB + (size_t)D * 512 * 2, W_MQ = W_OUT + (size_t)D * D * 2,
                 W_MO = W_MQ + (size_t)512 * D * 2, W_FF = W_MO + (size_t)D * 512 * 2;
constexpr size_t W_RW2 = W_FF, W_RA2 = W_RW2 + 512 * 64 * 2, W_RG2 = W_RA2 + 512 * 64 * 2, W_RV1 = W_RG2 + 512 * 128 * 2, W_RV2 = W_RV1 + 32 * 512 * 2, W_FF2 = W_RV2 + 512 * 32 * 2;
constexpr size_t W_FGU = W_FF2, W_FD = W_FGU + (size_t)2 * FFN * D * 2;
constexpr size_t W_EGU = W_FF2, W_ED = W_EGU + (size_t)NEXP * 2 * EDIM * D * 2, W_END = W_ED + (size_t)NEXP * D * EDIM * 2;
static_assert(W_FD + (size_t)D * FFN * 2 <= W_END, "w map");
constexpr size_t WS_WKV = (W_END + MiB - 1) / MiB * MiB;
constexpr size_t WS_MEMH = WS_WKV + (size_t)4096 * D * 2;
constexpr size_t WS_MEMK = WS_MEMH + (size_t)MEMROWS * D * 2;
constexpr size_t WS_MEMVT = WS_MEMK + (size_t)DEPTH * MEMROWS * 512 * 2;
constexpr size_t WS_VFIRST = WS_MEMVT + (size_t)DEPTH * MEMROWS * 512 * 2;
constexpr size_t WS_HN = WS_VFIRST + (size_t)T * 512 * 2;
constexpr size_t WS_MIX = WS_HN + (size_t)T * D * 2;
constexpr size_t MX_CA = WS_MIX, MX_CB = MX_CA + (size_t)TH * RW_COLS * 2, MX_CG = MX_CB + (size_t)TH * DS_PAD * 2, MX_RW = MX_CG + (size_t)TH * 2048 * 2;
constexpr size_t RW_ARR = (size_t)TH * 512 * 2;
constexpr size_t MX_VT = MX_RW + 7 * RW_ARR, MX_YB = MX_VT + (size_t)(NB / 2) * 64 * SEQ * 2, MX_END = MX_YB + (size_t)TH * 512 * 2;
constexpr size_t MA_QM = WS_MIX, MA_OM = MA_QM + (size_t)T * 512 * 2;
constexpr size_t FF_GU = WS_MIX;
constexpr size_t PR_KVRAW = WS_MIX;
constexpr size_t MX_BS = MX_END;
constexpr size_t WS_END = MX_BS + (size_t)TH * 8 * 4;
static_assert(FF_GU + (size_t)T * FFN * 2 <= WS_END && FF_GU + (size_t)MOE_ROWS_MAX * EDIM * 2 <= WS_END && MA_OM + (size_t)T * 512 * 2 <= WS_END, "overlay map");
static_assert(WS_END <= 1000 * MiB, "workspace budget");

constexpr int LDS_BYTES = 160 * 1024;
constexpr int LDS_MISC = LDS_BYTES - 256;

#define XB_TMO      128
#define XB_XCNT(j)  (256  + 64 * (j))
#define XB_XSUB(j)  (1280 + 64 * (j))
#define XB_XGEN(j)  (2304 + 64 * (j))
#define XB_TOP      3328
#define XB_TOPGEN   3392
#define XCD_BAR_WORDS 3456
#define XB_SPIN_CAP (1u << 18)
#define LAS __attribute__((address_space(3)))

__device__ __forceinline__ unsigned xb_ld(unsigned* p)              { return __hip_atomic_load(p, __ATOMIC_RELAXED, __HIP_MEMORY_SCOPE_AGENT); }
__device__ __forceinline__ unsigned xb_add(unsigned* p, unsigned v) { return __hip_atomic_fetch_add(p, v, __ATOMIC_RELAXED, __HIP_MEMORY_SCOPE_AGENT); }
__device__ __forceinline__ unsigned xb_xcc_id() { return (unsigned)__builtin_amdgcn_s_getreg((3 << 11) | 20) & 0xFu; }
#define XB_SPIN(cond, bar) do { unsigned _sp = 0; while (cond) { __builtin_amdgcn_s_sleep(1); \
    if ((++_sp & 255u) == 0u) { if (xb_ld(&(bar)[XB_TMO])) break; if (_sp > XB_SPIN_CAP) { atomicAdd(&(bar)[XB_TMO], 1u); break; } } } } while (0)
struct XcdBarrier { unsigned* bar; unsigned x; volatile LAS unsigned* st; };
__device__ __forceinline__ XcdBarrier xcd_barrier_post(unsigned* bar, volatile LAS unsigned* st) {
    XcdBarrier b; b.bar = bar; b.x = xb_xcc_id(); b.st = st;
    if (threadIdx.x == 0) (void)xb_add(&bar[XB_XCNT(b.x)], 1u);
    return b;
}
__device__ __forceinline__ void xcd_barrier_complete(unsigned* bar, unsigned x, unsigned& nloc, unsigned& nx) {
    const unsigned G = gridDim.x * gridDim.y * gridDim.z;
    unsigned sum, cnt, mine, sp = 0u;
    for (;;) {
        sum = 0u; cnt = 0u; mine = 0u;
#pragma unroll
        for (unsigned j = 0; j < 16; ++j) { const unsigned c = xb_ld(&bar[XB_XCNT(j)]); sum += c; cnt += (c > 0u) ? 1u : 0u; mine = (j == x) ? c : mine; }
        if (sum == G) break;
        __builtin_amdgcn_s_sleep(1);
        if ((++sp & 255u) == 0u) { if (xb_ld(&bar[XB_TMO])) break; if (sp > XB_SPIN_CAP) { atomicAdd(&bar[XB_TMO], 1u); break; } }
    }
    nloc = mine > 0u ? mine : 1u; nx = cnt > 0u ? cnt : 1u;
}
__device__ __forceinline__ void xcd_barrier(const XcdBarrier& b, int tid) {
    asm volatile("s_waitcnt vmcnt(0)" ::: "memory");
    __syncthreads();
    if (tid == 0) {
        unsigned* bar = b.bar; asm volatile("" : "+s"(bar));
        __builtin_amdgcn_s_waitcnt(0);
        unsigned nloc = b.st[0], nx = b.st[1];
        if (nloc == 0u) { xcd_barrier_complete(bar, b.x, nloc, nx); b.st[0] = nloc; b.st[1] = nx; }
        const unsigned old = xb_add(&bar[XB_XSUB(b.x)], 1u);
        const unsigned gen = old / nloc;
        if (old + 1u == (gen + 1u) * nloc) {
            __builtin_amdgcn_fence(__ATOMIC_RELEASE, "agent");
            asm volatile("s_waitcnt vmcnt(0)" ::: "memory");
            const unsigned og = xb_add(&bar[XB_TOP], 1u);
            const unsigned tg = og / nx;
            if (og + 1u == (tg + 1u) * nx) xb_add(&bar[XB_TOPGEN], 1u);
            else XB_SPIN(xb_ld(&bar[XB_TOPGEN]) == tg, bar);
            __builtin_amdgcn_fence(__ATOMIC_ACQUIRE, "agent");
            xb_add(&bar[XB_XGEN(b.x)], 1u);
            asm volatile("s_waitcnt vmcnt(0)" ::: "memory");
        } else {
            XB_SPIN(xb_ld(&bar[XB_XGEN(b.x)]) == gen, bar);
            __builtin_amdgcn_fence(__ATOMIC_ACQUIRE, "agent");
            asm volatile("s_waitcnt vmcnt(0)" ::: "memory");
        }
    }
    __syncthreads();
}

struct Args { const void* in[41]; float* out; unsigned char* ws; int ph_lo, ph_hi; };
static_assert(sizeof(Args) == 41 * 8 + 8 + 8 + 8, "Args has no padding");

enum InIdx { I_X = 0, I_MEM, I_POS, I_NORM_MIX, I_W_IN, I_MU, I_W0, I_W2, I_A0, I_A2, I_G2, I_V0, I_V1, I_V2, I_KK, I_KA, I_RK, I_LNG, I_LNB, I_QN, I_KN, I_IKN,
             I_WBA, I_WBB, I_WOUT, I_NORM_MEM, I_MEM_TOKN, I_MWQ, I_MWKV, I_MQN, I_MKN, I_MWO, I_NORM_FFN, I_FWG, I_FWU, I_FWD, I_ROUTER, I_RBIAS, I_EWG, I_EWU, I_EWD };

typedef decltype(__builtin_amdgcn_kernarg_segment_ptr()) kptr_t;
struct Frame {
    LAS unsigned char* lds; unsigned char* ws; kptr_t kb; float* out;
    int tid, lane, wave, G, bid;
};
#define LDS_WAIT() asm volatile("s_waitcnt lgkmcnt(0)" ::: "memory")
__device__ __forceinline__ const void* kargp(kptr_t kb, int i) { typedef const void* cvp; typedef __attribute__((address_space(4))) const cvp* tab_t; return (const void*)(const __attribute__((address_space(1))) void*)(((tab_t)kb)[i]); }
#define KARGP(F, i) kargp((F).kb, (i))
#define FIN(F, i) ((const float*)KARGP(F, i))
__device__ __forceinline__ void lds_barrier() { asm volatile("s_waitcnt lgkmcnt(0)" ::: "memory"); __builtin_amdgcn_s_barrier(); asm volatile("" ::: "memory"); }

__device__ __forceinline__ float wave_sum(float v) {
#pragma unroll
    for (int o = 1; o < 64; o <<= 1) v += __shfl_xor(v, o);
    return v;
}

template <class Map, bool FRAG = false>
__device__ __forceinline__ void transpose_item(const float* W, int K, int N, bf16_t* WT, const Map& map, const float* gain, LAS float* scr, int item, int lane) {
    const int nblk = (N + 31) / 32, kb = item / nblk, nb = item % nblk, k0 = 64 * kb, n0 = 32 * nb;
    const int nn = n0 + (lane & 31);
    float vv[32], gg[32];
#pragma unroll
    for (int i = 0; i < 32; ++i) { const int kk = 2 * i + (lane >> 5); vv[i] = 0.f; gg[i] = 1.f; if (nn < N && k0 + kk < K) { vv[i] = W[(size_t)(k0 + kk) * N + nn]; if (gain) gg[i] = gain[k0 + kk]; } }
#pragma unroll
    for (int i = 0; i < 32; ++i) { const int kk = 2 * i + (lane >> 5); scr[kk * 33 + (lane & 31)] = vv[i] * gg[i]; }
    LDS_WAIT(); asm volatile("" ::: "memory");
    const int c = lane & 7;
#pragma unroll
    for (int j = 0; j < 4; ++j) { const int n = (lane >> 3) + 8 * j; const LAS float* s = scr + (8 * c) * 33 + n;
        u32x4 o; o.x = pk2(s[0 * 33], s[1 * 33]); o.y = pk2(s[2 * 33], s[3 * 33]); o.z = pk2(s[4 * 33], s[5 * 33]); o.w = pk2(s[6 * 33], s[7 * 33]);
        if (n0 + n < N && k0 + 8 * c < K) { const int nn_ = map(n0 + n), kk_ = k0 + 8 * c;
            const size_t off_ = FRAG ? ((((size_t)(nn_ >> 4) * (K >> 5) + (kk_ >> 5)) * 64 + ((kk_ >> 3) & 3) * 16 + (nn_ & 15)) * 8) : ((size_t)nn_ * K + kk_);
            *(u32x4*)(WT + off_) = o; } }
    LDS_WAIT(); asm volatile("" ::: "memory");
}
struct MapId { int off; __device__ int operator()(int n) const { return n + off; } };
struct MapWin { __device__ int operator()(int n) const { return n < 3016 ? n : n + 56; } };
struct MapGU { int up; __device__ int operator()(int n) const { return (n >> 7) * 256 + up * 128 + (n & 127); } };

__device__ __forceinline__ void rms_row_to_bf16(const float* xrow, bf16_t* orow, int lane, f32x4 (&v)[4]) {
    const f32x4* xr = (const f32x4*)xrow + lane; float s = 0.f;
#pragma unroll
    for (int j = 0; j < 4; ++j) { v[j] = xr[64 * j]; s += (v[j].x * v[j].x + v[j].y * v[j].y) + (v[j].z * v[j].z + v[j].w * v[j].w); }
    const float rstd = 1.0f / sqrtf(wave_sum(s) * (1.f / D) + 1e-6f);
    u32x2* o8 = (u32x2*)orow + lane;
#pragma unroll
    for (int j = 0; j < 4; ++j) { v[j] = v[j] * rstd; u32x2 w; w.x = pk2(v[j].x, v[j].y); w.y = pk2(v[j].z, v[j].w); o8[64 * j] = w; }
}

__device__ __forceinline__ void rms_pass_to_bf16(const float* x, bf16_t* o, int first, int stride, int lane) {
    f32x4 v[4][4], n[4][4];
#pragma unroll
    for (int r = 0; r < 4; ++r) { const f32x4* xr = (const f32x4*)(x + (size_t)(first + r * stride) * D) + lane;
#pragma unroll
        for (int j = 0; j < 4; ++j) n[r][j] = xr[64 * j]; }
#pragma unroll 1
    for (int m0 = first; m0 < T; m0 += 4 * stride) {
#pragma unroll
        for (int r = 0; r < 4; ++r)
#pragma unroll
            for (int j = 0; j < 4; ++j) { v[r][j] = n[r][j]; asm volatile("" : "+v"(v[r][j])); }
        { const int mn = (m0 + 4 * stride < T) ? m0 + 4 * stride : m0;
#pragma unroll
          for (int r = 0; r < 4; ++r) { const f32x4* xr = (const f32x4*)(x + (size_t)(mn + r * stride) * D) + lane;
#pragma unroll
              for (int j = 0; j < 4; ++j) n[r][j] = xr[64 * j]; }
          asm volatile("" ::: "memory"); }
        float s[4];
#pragma unroll
        for (int r = 0; r < 4; ++r) { s[r] = 0.f;
#pragma unroll
            for (int j = 0; j < 4; ++j) s[r] += (v[r][j].x * v[r][j].x + v[r][j].y * v[r][j].y) + (v[r][j].z * v[r][j].z + v[r][j].w * v[r][j].w); }
#pragma unroll
        for (int o_ = 1; o_ < 64; o_ <<= 1) {
#pragma unroll
            for (int r = 0; r < 4; ++r) s[r] += __shfl_xor(s[r], o_); }
#pragma unroll
        for (int r = 0; r < 4; ++r) { const float rstd = 1.0f / sqrtf(s[r] * (1.f / D) + 1e-6f); u32x2* o8 = (u32x2*)(o + (size_t)(m0 + r * stride) * D) + lane;
#pragma unroll
            for (int j = 0; j < 4; ++j) { const f32x4 t = v[r][j] * rstd; u32x2 w; w.x = pk2(t.x, t.y); w.y = pk2(t.z, t.w); o8[64 * j] = w; } }
    }
}
__device__ __forceinline__ void ph_prologue0(Frame& F) {
    LAS float* scr = (LAS float*)(F.lds + F.wave * 16384);
    const int gw = F.bid * NWAVES + F.wave, NGW = F.G * NWAVES;
    bf16_t* wkv = (bf16_t*)(F.ws + WS_WKV);
    constexpr int IT = (D / 64) * (1024 / 32);
    for (int it = gw; it < DEPTH * IT; it += NGW) { const int l = it / IT, r = it % IT;
        transpose_item(FIN(F, I_MWKV) + (size_t)l * D * 1024, D, 1024, wkv, MapId{l * 1024}, FIN(F, I_MEM_TOKN) + l * D, scr, r, F.lane); }
    bf16_t* mh = (bf16_t*)(F.ws + WS_MEMH);
    for (int m = gw; m < MEMROWS; m += NGW) { f32x4 v[4]; rms_row_to_bf16(FIN(F, I_MEM) + (size_t)m * D, mh + (size_t)m * D, F.lane, v); }
}
__device__ __forceinline__ void ph_prologue2(Frame& F) {
    const int gw = F.bid * NWAVES + F.wave, NGW = F.G * NWAVES;
    const bf16_t* kv = (const bf16_t*)(F.ws + PR_KVRAW);
    bf16_t* MK = (bf16_t*)(F.ws + WS_MEMK); bf16_t* MVT = (bf16_t*)(F.ws + WS_MEMVT);
    for (int it = gw; it < MEMROWS * 16; it += NGW) {
        const int row = it >> 4, l = (it >> 2) & 3, hh = it & 3, b = row >> 8, m = row & 255;
        const bf16_t* src = kv + (size_t)row * 4096 + l * 1024;
        const unsigned kk = *(const unsigned*)(src + hh * 128 + 2 * F.lane);
        const float k0 = bf_lo(kk), k1 = bf_hi(kk);
        const float rstd = 1.0f / sqrtf(wave_sum(k0 * k0 + k1 * k1) * (1.f / 128.f) + 1e-6f);
        const float* gk = FIN(F, I_MKN) + l * 128;
        *(unsigned*)(MK + ((((size_t)l * NB + b) * 4 + hh) * 256 + m) * 128 + 2 * F.lane) = pk2(k0 * rstd * gk[2 * F.lane], k1 * rstd * gk[2 * F.lane + 1]);
        const unsigned vv = *(const unsigned*)(src + 512 + hh * 128 + 2 * F.lane);
        bf16_t* vt = MVT + (((size_t)l * NB + b) * 4 + hh) * 128 * 256 + m;
        vt[(size_t)(2 * F.lane) * 256] = (bf16_t)(vv & 0xffffu); vt[(size_t)(2 * F.lane + 1) * 256] = (bf16_t)(vv >> 16);
    }
}
__device__ __forceinline__ void ph_layer0(Frame& F, int l, const float* xin) {
    LAS float* scr = (LAS float*)(F.lds + F.wave * 16384);
    const int gw = F.bid * NWAVES + F.wave, NGW = F.G * NWAVES;
    unsigned char* ws = F.ws;
    constexpr int I_WIN = (D / 64) * ((N_IN + 31) / 32), I_B = (512 / 64) * (D / 32), I_O = (D / 64) * (D / 32), I_Q = (D / 64) * (512 / 32);
    constexpr int I_FG = (D / 64) * (FFN / 32), I_FDN = (FFN / 64) * (D / 32), I_EG = (D / 64) * (EDIM / 32), I_EDN = (EDIM / 64) * (D / 32);
    const bool moe = (l & 1) != 0; const int j = l >> 1;
    const int nff = moe ? NEXP * (2 * I_EG + I_EDN) : (2 * I_FG + I_FDN);
    constexpr int I_R2 = 16, I_RG = 32, I_RV1 = 8, I_RV2 = 16;
    const int nrw = 2 * I_R2 + I_RG + (l ? I_RV1 + I_RV2 : 0);
    const int NIT = I_WIN + 2 * I_B + I_O + I_Q + I_B + nrw + nff;
    const float* gffn = FIN(F, I_NORM_FFN) + l * D;
    for (int it = gw; it < NIT; it += NGW) {
        int r = it;
        if (r < I_WIN) { transpose_item(FIN(F, I_W_IN) + (size_t)l * D * N_IN, D, N_IN, (bf16_t*)(ws + W_IN), MapWin{}, FIN(F, I_NORM_MIX) + l * D, scr, r, F.lane); continue; } r -= I_WIN;
        if (r < I_B) { transpose_item(FIN(F, I_WBA) + (size_t)l * 512 * D, 512, D, (bf16_t*)(ws + W_BA), MapId{0}, nullptr, scr, r, F.lane); continue; } r -= I_B;
        if (r < I_B) { transpose_item(FIN(F, I_WBB) + (size_t)l * 512 * D, 512, D, (bf16_t*)(ws + W_BB), MapId{0}, nullptr, scr, r, F.lane); continue; } r -= I_B;
        if (r < I_O) { transpose_item(FIN(F, I_WOUT) + (size_t)l * D * D, D, D, (bf16_t*)(ws + W_OUT), MapId{0}, nullptr, scr, r, F.lane); continue; } r -= I_O;
        if (r < I_Q) { transpose_item(FIN(F, I_MWQ) + (size_t)l * D * 512, D, 512, (bf16_t*)(ws + W_MQ), MapId{0}, FIN(F, I_NORM_MEM) + l * D, scr, r, F.lane); continue; } r -= I_Q;
        if (r < I_B) { transpose_item(FIN(F, I_MWO) + (size_t)l * 512 * D, 512, D, (bf16_t*)(ws + W_MO), MapId{0}, nullptr, scr, r, F.lane); continue; } r -= I_B;
        if (r < nrw) {
            if (r < I_R2) { transpose_item<MapId, true>(FIN(F, I_W2) + (size_t)l * 64 * 512, 64, 512, (bf16_t*)(ws + W_RW2), MapId{0}, nullptr, scr, r, F.lane); continue; } r -= I_R2;
            if (r < I_R2) { transpose_item<MapId, true>(FIN(F, I_A2) + (size_t)l * 64 * 512, 64, 512, (bf16_t*)(ws + W_RA2), MapId{0}, nullptr, scr, r, F.lane); continue; } r -= I_R2;
            if (r < I_RG) { transpose_item<MapId, true>(FIN(F, I_G2) + (size_t)l * 128 * 512, 128, 512, (bf16_t*)(ws + W_RG2), MapId{0}, nullptr, scr, r, F.lane); continue; } r -= I_RG;
            if (r < I_RV1) { transpose_item(FIN(F, I_V1) + (size_t)(l - 1) * 512 * 32, 512, 32, (bf16_t*)(ws + W_RV1), MapId{0}, nullptr, scr, r, F.lane); continue; } r -= I_RV1;
            transpose_item<MapId, true>(FIN(F, I_V2) + (size_t)(l - 1) * 32 * 512, 32, 512, (bf16_t*)(ws + W_RV2), MapId{0}, nullptr, scr, r, F.lane); continue;
        }
        r -= nrw;
        if (!moe) {
            if (r < I_FG) { transpose_item(FIN(F, I_FWG) + (size_t)j * D * FFN, D, FFN, (bf16_t*)(ws + W_FGU), MapGU{0}, gffn, scr, r, F.lane); continue; } r -= I_FG;
            if (r < I_FG) { transpose_item(FIN(F, I_FWU) + (size_t)j * D * FFN, D, FFN, (bf16_t*)(ws + W_FGU), MapGU{1}, gffn, scr, r, F.lane); continue; } r -= I_FG;
            transpose_item(FIN(F, I_FWD) + (size_t)j * FFN * D, FFN, D, (bf16_t*)(ws + W_FD), MapId{0}, nullptr, scr, r, F.lane);
        } else {
            const int per = 2 * I_EG + I_EDN, e = r / per; r -= e * per;
            const size_t eo = (size_t)(j * NEXP + e);
            if (r < I_EG) { transpose_item(FIN(F, I_EWG) + eo * D * EDIM, D, EDIM, (bf16_t*)(ws + W_EGU) + (size_t)e * 2 * EDIM * D, MapGU{0}, gffn, scr, r, F.lane); continue; } r -= I_EG;
            if (r < I_EG) { transpose_item(FIN(F, I_EWU) + eo * D * EDIM, D, EDIM, (bf16_t*)(ws + W_EGU) + (size_t)e * 2 * EDIM * D, MapGU{1}, gffn, scr, r, F.lane); continue; } r -= I_EG;
            transpose_item(FIN(F, I_EWD) + eo * EDIM * D, EDIM, D, (bf16_t*)(ws + W_ED) + (size_t)e * D * EDIM, MapId{0}, nullptr, scr, r, F.lane);
        }
    }
    { u32x4* z = (u32x4*)((bf16_t*)(ws + W_IN) + (size_t)3016 * D); const int n16 = 56 * D * 2 / 16;
      for (int i = F.bid * NTHR + F.tid; i < n16; i += F.G * NTHR) z[i] = (u32x4){0u, 0u, 0u, 0u}; }
    bf16_t* hn = (bf16_t*)(ws + WS_HN);
    rms_pass_to_bf16(xin, hn, gw, NGW, F.lane);
}
__device__ __forceinline__ void ph_norm(Frame& F) {
    const int gw = F.bid * NWAVES + F.wave, NGW = F.G * NWAVES;
    bf16_t* hn = (bf16_t*)(F.ws + WS_HN);
    rms_pass_to_bf16(F.out, hn, gw, NGW, F.lane);
}
__device__ __forceinline__ void ph_norm_ffn(Frame& F, int l) {
    const int gw = F.bid * NWAVES + F.wave, NGW = F.G * NWAVES;
    bf16_t* hn = (bf16_t*)(F.ws + WS_HN);
    const bool moe = (l & 1) != 0; const int j = l >> 1;
    const float* gn = FIN(F, I_NORM_FFN) + l * D;
    const float* rt = FIN(F, I_ROUTER) + (size_t)j * D * NEXP; const float* rb = FIN(F, I_RBIAS) + j * NEXP;
    unsigned short* sele = (unsigned short*)(F.ws + MOE_SELE); f32x2* selw = (f32x2*)(F.ws + MOE_SELW);
    if (!moe) { rms_pass_to_bf16(F.out, hn, gw, NGW, F.lane); return; }
    for (int m = gw; m < T; m += NGW) {
        f32x4 v[4]; rms_row_to_bf16(F.out + (size_t)m * D, hn + (size_t)m * D, F.lane, v);
        if (moe) {
            float lg[8];
#pragma unroll
            for (int e = 0; e < 8; ++e) lg[e] = 0.f;
#pragma unroll
            for (int q = 0; q < 4; ++q)
#pragma unroll
                for (int c = 0; c < 4; ++c) { const int k = 256 * q + 4 * F.lane + c; const float h = v[q][c] * gn[k];
                    const f32x4 r0 = *(const f32x4*)(rt + (size_t)k * 8), r1 = *(const f32x4*)(rt + (size_t)k * 8 + 4);
                    lg[0] += h * r0.x; lg[1] += h * r0.y; lg[2] += h * r0.z; lg[3] += h * r0.w; lg[4] += h * r1.x; lg[5] += h * r1.y; lg[6] += h * r1.z; lg[7] += h * r1.w; }
#pragma unroll
            for (int e = 0; e < 8; ++e) lg[e] = wave_sum(lg[e]) + rb[e];
            int e0 = 0; float l0 = lg[0];
#pragma unroll
            for (int e = 1; e < 8; ++e) if (lg[e] > l0) { l0 = lg[e]; e0 = e; }
            int e1 = -1; float l1 = -3.0e38f;
#pragma unroll
            for (int e = 0; e < 8; ++e) if (e != e0 && lg[e] > l1) { l1 = lg[e]; e1 = e; }
            const float w1 = 1.0f / (1.0f + __expf(l0 - l1)), w0 = 1.0f - w1;
            if (F.lane == 0) { sele[m] = (unsigned short)(e0 | (e1 << 8)); selw[m] = (f32x2){w0, w1}; }
        }
    }
}

#define MFMA16(x, y, c) __builtin_amdgcn_mfma_f32_16x16x32_bf16((x), (y), (c), 0, 0, 0)
__device__ __forceinline__ float softplusf_(float x) { return fmaxf(x, 0.f) + log1pf(expf(-fabsf(x))); }
typedef __attribute__((address_space(3))) bf16_t lbf;
constexpr int LDP = 72;
constexpr int SLOT = 64 * LDP * 2;
__device__ __forceinline__ f32x4 unpack4(u32x2 u) { return (f32x4){bf_lo(u.x), bf_hi(u.x), bf_lo(u.y), bf_hi(u.y)}; }
__device__ __forceinline__ u32x2 pack4(f32x4 v) { u32x2 o; o.x = pk2(v[0], v[1]); o.y = pk2(v[2], v[3]); return o; }
__device__ __forceinline__ size_t rwo(int t, int col) { return ((size_t)((t >> 6) * 32 + (col >> 4)) << 10) + (size_t)(((t & 63) << 4) + (col & 15)); }
__device__ __forceinline__ void mm64(const lbf* X, const lbf* Y, int w, int jl, int g, f32x4 (&acc)[2]) {
    const lbf* xr = X + (16 * (w & 3) + jl) * LDP + 8 * g;
    const lbf* yr = Y + (16 * (2 * (w >> 2)) + jl) * LDP + 8 * g;
    const bf16x8 x0 = *(const LAS bf16x8*)xr, x1 = *(const LAS bf16x8*)(xr + 32);
    const bf16x8 y00 = *(const LAS bf16x8*)yr, y01 = *(const LAS bf16x8*)(yr + 32), y10 = *(const LAS bf16x8*)(yr + 16 * LDP), y11 = *(const LAS bf16x8*)(yr + 16 * LDP + 32);
    acc[0] = MFMA16(x0, y00, acc[0]); acc[1] = MFMA16(x0, y10, acc[1]); acc[0] = MFMA16(x1, y01, acc[0]); acc[1] = MFMA16(x1, y11, acc[1]);
}
struct FrX { bf16x8 k0, k1; }; struct FrY { bf16x8 a0, a1, b0, b1; };
__device__ __forceinline__ FrX ldx64(const lbf* X, int w, int jl, int g) { const lbf* xr = X + (16 * (w & 3) + jl) * LDP + 8 * g; FrX f; f.k0 = *(const LAS bf16x8*)xr; f.k1 = *(const LAS bf16x8*)(xr + 32); return f; }
__device__ __forceinline__ FrY ldy64(const lbf* Y, int w, int jl, int g) { const lbf* yr = Y + (16 * (2 * (w >> 2)) + jl) * LDP + 8 * g; FrY f;
    f.a0 = *(const LAS bf16x8*)yr; f.a1 = *(const LAS bf16x8*)(yr + 32); f.b0 = *(const LAS bf16x8*)(yr + 16 * LDP); f.b1 = *(const LAS bf16x8*)(yr + 16 * LDP + 32); return f; }
__device__ __forceinline__ void mma64(const FrX& x, const FrY& y, f32x4 (&acc)[2]) {
    acc[0] = MFMA16(x.k0, y.a0, acc[0]); acc[1] = MFMA16(x.k0, y.b0, acc[1]); acc[0] = MFMA16(x.k1, y.a1, acc[0]); acc[1] = MFMA16(x.k1, y.b1, acc[1]); }
__device__ __forceinline__ void st_t(lbf* dst, const f32x4 (&acc)[2], int w, int jl, int g) {
#pragma unroll
    for (int i = 0; i < 2; ++i) *(LAS u32x2*)(dst + (16 * (2 * (w >> 2) + i) + jl) * LDP + 16 * (w & 3) + 4 * g) = pack4(acc[i]);
}
__device__ __forceinline__ void st_n(lbf* dst, const f32x4 (&acc)[2], int w, int jl, int g) {
#pragma unroll
    for (int i = 0; i < 2; ++i)
#pragma unroll
        for (int r = 0; r < 4; ++r) dst[(16 * (w & 3) + 4 * g + r) * LDP + 16 * (2 * (w >> 2) + i) + jl] = f2bf(acc[i][r]);
}
#define ZACC(a) do { a[0] = (f32x4){0.f, 0.f, 0.f, 0.f}; a[1] = (f32x4){0.f, 0.f, 0.f, 0.f}; } while (0)

constexpr int XA_LD = 264, XV_LD = 520, VM_LD = 40;
__device__ __forceinline__ void ph_rwkv_pre(Frame& F, int l, int half) {
    lbf* XA = (lbf*)F.lds;
    lbf* XV = (lbf*)(F.lds + 64 * XA_LD * 2);
    lbf* VM = (lbf*)(F.lds + 64 * XA_LD * 2 + 64 * XV_LD * 2);
    const bf16_t* CA = (const bf16_t*)(F.ws + MX_CA);
    bf16_t* RW = (bf16_t*)(F.ws + MX_RW); constexpr size_t AS_ = (size_t)TH * 512;
    bf16_t* VF = (bf16_t*)(F.ws + WS_VFIRST) + (size_t)half * TH * 512;
    const bf16_t* W2T = (const bf16_t*)(F.ws + W_RW2); const bf16_t* A2T = (const bf16_t*)(F.ws + W_RA2); const bf16_t* G2T = (const bf16_t*)(F.ws + W_RG2);
    const bf16_t* V1T = (const bf16_t*)(F.ws + W_RV1); const bf16_t* V2T = (const bf16_t*)(F.ws + W_RV2);
    const float* mu = FIN(F, I_MU) + l * RW_COLS;
    const int lane = F.lane, w = F.wave, jl = lane & 15, g = lane >> 4;
    for (int tile = F.bid; tile < TH / 64; tile += F.G) {
        const int t0 = tile * 64;
        lds_barrier();
        for (int it = F.tid; it < 64 * 32; it += NTHR) { const int i = it >> 5, c = 1536 + (it & 31) * 8; const int t = t0 + i;
            const u32x4 cu = *(const u32x4*)(CA + (size_t)t * RW_COLS + c);
            u32x4 pv = (u32x4){0u, 0u, 0u, 0u}; if ((t & (SEQ - 1)) != 0) pv = *(const u32x4*)(CA + (size_t)(t - 1) * RW_COLS + c);
            const float cv[8] = { bf_lo(cu.x), bf_hi(cu.x), bf_lo(cu.y), bf_hi(cu.y), bf_lo(cu.z), bf_hi(cu.z), bf_lo(cu.w), bf_hi(cu.w) };
            const float pp[8] = { bf_lo(pv.x), bf_hi(pv.x), bf_lo(pv.y), bf_hi(pv.y), bf_lo(pv.z), bf_hi(pv.z), bf_lo(pv.w), bf_hi(pv.w) };
            float x[8];
#pragma unroll
            for (int q = 0; q < 8; ++q) { x[q] = cv[q] + (pp[q] - cv[q]) * mu[c + q]; if (c < 1600) x[q] = 1.0f - 2.0f * __builtin_amdgcn_rcpf(1.0f + __expf(2.0f * x[q])); else if (c >= 1664) x[q] = sigmoidf_(x[q]); }
            u32x4 o; o.x = pk2(x[0], x[1]); o.y = pk2(x[2], x[3]); o.z = pk2(x[4], x[5]); o.w = pk2(x[6], x[7]);
            *(LAS u32x4*)(XA + i * XA_LD + (c - 1536)) = o; }
        if (l) for (int it = F.tid; it < 64 * 64; it += NTHR) { const int i = it >> 6, c = 1024 + (it & 63) * 8; const int t = t0 + i;
            const u32x4 cu = *(const u32x4*)(CA + (size_t)t * RW_COLS + c);
            u32x4 pv = (u32x4){0u, 0u, 0u, 0u}; if ((t & (SEQ - 1)) != 0) pv = *(const u32x4*)(CA + (size_t)(t - 1) * RW_COLS + c);
            const float cv[8] = { bf_lo(cu.x), bf_hi(cu.x), bf_lo(cu.y), bf_hi(cu.y), bf_lo(cu.z), bf_hi(cu.z), bf_lo(cu.w), bf_hi(cu.w) };
            const float pp[8] = { bf_lo(pv.x), bf_hi(pv.x), bf_lo(pv.y), bf_hi(pv.y), bf_lo(pv.z), bf_hi(pv.z), bf_lo(pv.w), bf_hi(pv.w) };
            float x[8];
#pragma unroll
            for (int q = 0; q < 8; ++q) x[q] = cv[q] + (pp[q] - cv[q]) * mu[c + q];
            u32x4 o; o.x = pk2(x[0], x[1]); o.y = pk2(x[2], x[3]); o.z = pk2(x[4], x[5]); o.w = pk2(x[6], x[7]);
            *(LAS u32x4*)(XV + i * XV_LD + (c - 1024)) = o; }
        lds_barrier();
        if (l) { const int tg = w & 3, nt = w >> 2; f32x4 a = (f32x4){0.f, 0.f, 0.f, 0.f};
            const bf16_t* xr = V1T + (size_t)(16 * nt + jl) * 512 + 8 * g; const lbf* yr = XV + (16 * tg + jl) * XV_LD + 8 * g;
#pragma unroll 4
            for (int s = 0; s < 16; ++s) a = MFMA16(*(const bf16x8*)(xr + 32 * s), *(const LAS bf16x8*)(yr + 32 * s), a);
            *(LAS u32x2*)(VM + (16 * tg + jl) * VM_LD + 16 * nt + 4 * g) = pack4(a); }
        lds_barrier();
        { bf16_t* XAG = RW + 0 * AS_; bf16_t* VMG = RW + 2 * AS_;
#pragma unroll
          for (int i = 0; i < 4; ++i) { const int id = F.tid + NTHR * i, row = id >> 5, c16 = id & 31; *(u32x4*)(XAG + (size_t)(t0 + row) * 256 + 8 * c16) = *(const LAS u32x4*)(XA + row * XA_LD + 8 * c16); }
          if (l && F.tid < 256) { const int row = F.tid >> 2, c8 = F.tid & 3; *(u32x4*)(VMG + (size_t)(t0 + row) * 32 + 8 * c8) = *(const LAS u32x4*)(VM + row * VM_LD + 8 * c8); } }
    }
}

__device__ __forceinline__ void ph_rwkv_s1(Frame& F, int l, int half) {
    bf16_t* RW = (bf16_t*)(F.ws + MX_RW); constexpr size_t AS_ = (size_t)TH * 512;
    float* BSW = (float*)(F.ws + MX_BS); const float* rkw = FIN(F, I_RK) + l * 512;
    bf16_t* YH = (bf16_t*)(F.ws + MX_CA);
    LAS unsigned char* L = F.lds;
#define SL(i) ((lbf*)(L + (i) * SLOT))
    lbf *AT = SL(0), *BT = SL(1), *KT = SL(2), *RT = SL(3), *ATt = SL(4), *Vt = SL(5), *BPt = SL(6), *KPt = SL(7), *AAK = SL(10), *ARB = SL(11), *ARK = SL(12);
    LAS float* EL = (LAS float*)(L + 8 * SLOT);
    LAS float* SEGT = (LAS float*)(L + 10 * SLOT);
    LAS float* PC = (LAS float*)(L + 16 * SLOT);
    const int lane = F.lane, w = F.wave, jl = lane & 15, g = lane >> 4;
    const int tok = F.tid >> 3, cg = F.tid & 7;
    const bf16_t* CA = (const bf16_t*)(F.ws + MX_CA); bf16_t* VF = (bf16_t*)(F.ws + WS_VFIRST) + (size_t)half * TH * 512;
    const bf16_t* XAG = RW + 0 * AS_; const bf16_t* VMG = RW + 2 * AS_;
    const bf16_t* W2T = (const bf16_t*)(F.ws + W_RW2); const bf16_t* A2T = (const bf16_t*)(F.ws + W_RA2); const bf16_t* G2T = (const bf16_t*)(F.ws + W_RG2); const bf16_t* V2T = (const bf16_t*)(F.ws + W_RV2);
    const float* mu = FIN(F, I_MU) + l * RW_COLS;
    lbf* XAs = (lbf*)L; lbf* VMs = SL(4);
    const int h = F.bid & 7, nt = w & 3, n0 = 64 * h + 16 * nt, n = n0 + 4 * g;
    LAS float* PRM = (LAS float*)(L + 16 * SLOT + 256);
    lds_barrier();
    { const int a_ = F.tid >> 6, c_ = F.tid & 63, col = 64 * h + c_; float v_ = 0.f;
      if (a_ < 3) v_ = mu[512 * a_ + col]; else if (a_ == 3) v_ = FIN(F, I_W0)[l * 512 + col]; else if (a_ == 4) v_ = FIN(F, I_A0)[l * 512 + col]; else if (a_ == 5) v_ = FIN(F, I_KK)[l * 512 + col];
      else if (a_ == 6) v_ = FIN(F, I_KA)[l * 512 + col]; else if (l) v_ = FIN(F, I_V0)[(l - 1) * 512 + col];
      PRM[F.tid] = v_; }
    u32x4 cxa[4], ctl[4], cpv; u32x2 cvm = (u32x2){0u, 0u}; bf16x8 xw[2], xa[2], xg[4], xm = {0, 0, 0, 0, 0, 0, 0, 0};
    lbf* TR = SL(5); constexpr int T65 = 65 * LDP;
#define A0_LOAD(u_) do { const int uu_ = (u_) < (TH / 64) * 8 ? (u_) : F.bid; const int tz_ = (uu_ >> 3) * 64; \
        _Pragma("unroll") for (int i = 0; i < 4; ++i) { const int id = F.tid + NTHR * i; cxa[i] = *(const u32x4*)(XAG + (size_t)(tz_ + (id >> 5)) * 256 + 8 * (id & 31)); } \
        if (l) cvm = *(const u32x2*)(VMG + (size_t)(tz_ + (F.tid >> 3)) * 32 + 4 * (F.tid & 7)); \
        { const bf16_t* cr_ = CA + (size_t)(tz_ + tok) * RW_COLS + 64 * h + 8 * cg; ctl[0] = *(const u32x4*)cr_; ctl[1] = *(const u32x4*)(cr_ + 512); ctl[2] = *(const u32x4*)(cr_ + 1024); \
          ctl[3] = (u32x4){0u, 0u, 0u, 0u}; cpv = ctl[3]; if (l) ctl[3] = *(const u32x4*)(VF + rwo(tz_ + tok, 64 * h + 8 * cg)); \
          if (F.tid < 24 && (tz_ & (SEQ - 1)) != 0) cpv = *(const u32x4*)(CA + (size_t)(tz_ - 1) * RW_COLS + 512 * (F.tid >> 3) + 64 * h + 8 * (F.tid & 7)); } } while (0)
#define A0_LOADX() do { const int fb_ = 4 * h + nt; \
          _Pragma("unroll") for (int s2 = 0; s2 < 2; ++s2) { xw[s2] = *(const bf16x8*)(W2T + ((size_t)(fb_ * 2 + s2) * 64 + lane) * 8); xa[s2] = *(const bf16x8*)(A2T + ((size_t)(fb_ * 2 + s2) * 64 + lane) * 8); } \
          _Pragma("unroll") for (int s2 = 0; s2 < 4; ++s2) xg[s2] = *(const bf16x8*)(G2T + ((size_t)(fb_ * 4 + s2) * 64 + lane) * 8); \
          if (l) xm = *(const bf16x8*)(V2T + ((size_t)fb_ * 64 + lane) * 8); } while (0)
    A0_LOAD(F.bid); A0_LOADX();
    for (int u = F.bid; u < (TH / 64) * 8; u += F.G) {
        const int ch = u >> 3, t0 = ch * 64;
        lds_barrier();
#pragma unroll
        for (int i = 0; i < 4; ++i) { const int id = F.tid + NTHR * i; *(LAS u32x4*)(XAs + (id >> 5) * XA_LD + 8 * (id & 31)) = cxa[i]; }
        if (l) *(LAS u32x2*)(VMs + (F.tid >> 3) * VM_LD + 4 * (F.tid & 7)) = cvm;
#pragma unroll
        for (int T = 0; T < 3; ++T) *(LAS u32x4*)(TR + T * T65 + (tok + 1) * LDP + 8 * cg) = ctl[T];
        *(LAS u32x4*)(TR + 3 * T65 + tok * LDP + 8 * cg) = ctl[3];
        if (F.tid < 24) *(LAS u32x4*)(TR + (F.tid >> 3) * T65 + 8 * (F.tid & 7)) = cpv;
        lds_barrier();
        {
            const LAS f32x4* pp_ = (const LAS f32x4*)(PRM + 16 * nt + 4 * g);
            const f32x4 mr = pp_[0], mk = pp_[16], mv = pp_[32], w0 = pp_[48], a0 = pp_[64], kkw = pp_[80], ka = pp_[96], v0 = pp_[112];
#pragma unroll
            for (int tgi = 0; tgi < 2; ++tgi) {
                const int tl = 16 * (2 * (w >> 2) + tgi) + jl, t = t0 + tl;
                const lbf* tp = TR + tl * LDP + 16 * nt + 4 * g;
                const f32x4 rp = unpack4(*(const LAS u32x2*)tp), rc = unpack4(*(const LAS u32x2*)(tp + LDP)), kp = unpack4(*(const LAS u32x2*)(tp + T65)), kc = unpack4(*(const LAS u32x2*)(tp + T65 + LDP)),
                            vp = unpack4(*(const LAS u32x2*)(tp + 2 * T65)), vc = unpack4(*(const LAS u32x2*)(tp + 2 * T65 + LDP)), vf = unpack4(*(const LAS u32x2*)(tp + 3 * T65));
                const size_t o = rwo(t, n);
                const lbf* ya = XAs + tl * XA_LD + 8 * g;
                bf16x8 yf[9];
#pragma unroll
                for (int s2 = 0; s2 < 8; ++s2) yf[s2] = *(const LAS bf16x8*)(ya + 32 * s2);
                yf[8] = *(const LAS bf16x8*)(VMs + tl * VM_LD + 8 * g);
                f32x4 aw = (f32x4){0.f, 0.f, 0.f, 0.f}, aa = aw, ag = aw, am = aw;
#pragma unroll
                for (int s2 = 0; s2 < 2; ++s2) { aw = MFMA16(xw[s2], yf[s2], aw); aa = MFMA16(xa[s2], yf[2 + s2], aa); }
#pragma unroll
                for (int s2 = 0; s2 < 4; ++s2) ag = MFMA16(xg[s2], yf[4 + s2], ag);
                if (l) am = MFMA16(xm, yf[8], am);
                const f32x4 r4 = rc + (rp - rc) * mr, k4 = kc + (kp - kc) * mk; f32x4 v4 = vc + (vp - vc) * mv;
                if (l) {
#pragma unroll
                    for (int q = 0; q < 4; ++q) v4[q] = v4[q] + (vf[q] - v4[q]) * sigmoidf_(v0[q] + am[q]); }
                else *(u32x2*)(VF + o) = pack4(v4);
                f32x4 e4, as4, k24, kk4;
#pragma unroll
                for (int q = 0; q < 4; ++q) { const float a = sigmoidf_(a0[q] + aa[q]); as4[q] = a; k24[q] = k4[q] * (1.0f + (a - 1.0f) * ka[q]);
                    e4[q] = 0.6065306597f * sigmoidf_(w0[q] + aw[q]);
                    kk4[q] = k4[q] * kkw[q]; }
                const int lo_ = tl * LDP + 16 * nt + 4 * g;
                *(LAS u32x2*)(SL(10) + lo_) = pack4(r4); *(LAS u32x2*)(SL(11) + lo_) = pack4(e4); *(LAS u32x2*)(SL(12) + lo_) = pack4(k24); *(LAS u32x2*)(SL(13) + lo_) = pack4(v4);
                *(LAS u32x2*)(SL(14) + lo_) = pack4(kk4); *(LAS u32x2*)(SL(15) + lo_) = pack4(as4);
                *(u32x2*)(RW + 3 * AS_ + o) = pack4(v4); *(u32x2*)(RW + 6 * AS_ + o) = pack4(ag);
                __builtin_amdgcn_sched_barrier(0);
            }
        }
        lds_barrier();
        const int lt_ = tok * LDP + 8 * cg;
        const u32x4 ur = *(const LAS u32x4*)(SL(10) + lt_), ue = *(const LAS u32x4*)(SL(11) + lt_), uk = *(const LAS u32x4*)(SL(12) + lt_), uv = *(const LAS u32x4*)(SL(13) + lt_),
                    ukk = *(const LAS u32x4*)(SL(14) + lt_), uas = *(const LAS u32x4*)(SL(15) + lt_);
        const float e8[8] = { bf_lo(ue.x), bf_hi(ue.x), bf_lo(ue.y), bf_hi(ue.y), bf_lo(ue.z), bf_hi(ue.z), bf_lo(ue.w), bf_hi(ue.w) };
#pragma unroll
        for (int i = 0; i < 8; ++i) EL[tok * 65 + 8 * cg + i] = e8[i];
        lds_barrier();
        { const int col = F.tid & 63, seg = F.tid >> 6; float p[8]; float run = 0.f;
#pragma unroll
          for (int i = 0; i < 8; ++i) { run += EL[(8 * seg + i) * 65 + col]; p[i] = run; }
          SEGT[seg * 64 + col] = run;
          lds_barrier();
          float off = 0.f; for (int s = 0; s < seg; ++s) off += SEGT[s * 64 + col];
#pragma unroll
          for (int i = 0; i < 8; ++i) EL[(8 * seg + i) * 65 + col] = -(off + p[i]); }
        lds_barrier();
        {
            const float r8[8] = { bf_lo(ur.x), bf_hi(ur.x), bf_lo(ur.y), bf_hi(ur.y), bf_lo(ur.z), bf_hi(ur.z), bf_lo(ur.w), bf_hi(ur.w) };
            const float k8[8] = { bf_lo(uk.x), bf_hi(uk.x), bf_lo(uk.y), bf_hi(uk.y), bf_lo(uk.z), bf_hi(uk.z), bf_lo(uk.w), bf_hi(uk.w) };
            float kk8[8] = { bf_lo(ukk.x), bf_hi(ukk.x), bf_lo(ukk.y), bf_hi(ukk.y), bf_lo(ukk.z), bf_hi(ukk.z), bf_lo(ukk.w), bf_hi(ukk.w) };
            { float ss = 0.f;
#pragma unroll
              for (int i = 0; i < 8; ++i) ss += kk8[i] * kk8[i];
              ss += __shfl_xor(ss, 1); ss += __shfl_xor(ss, 2); ss += __shfl_xor(ss, 4);
              const float inv = 1.0f / fmaxf(sqrtf(ss), 1e-12f);
#pragma unroll
              for (int i = 0; i < 8; ++i) kk8[i] *= inv; }
            const float as8[8] = { bf_lo(uas.x), bf_hi(uas.x), bf_lo(uas.y), bf_hi(uas.y), bf_lo(uas.z), bf_hi(uas.z), bf_lo(uas.w), bf_hi(uas.w) };
            const unsigned short v8[8] = { (unsigned short)(uv.x & 0xffffu), (unsigned short)(uv.x >> 16), (unsigned short)(uv.y & 0xffffu), (unsigned short)(uv.y >> 16),
                                           (unsigned short)(uv.z & 0xffffu), (unsigned short)(uv.z >> 16), (unsigned short)(uv.w & 0xffffu), (unsigned short)(uv.w >> 16) };
            { const float* rkp = rkw + h * 64 + 8 * cg; float b = 0.f;
#pragma unroll
              for (int i = 0; i < 8; ++i) b += r8[i] * k8[i] * rkp[i];
              b += __shfl_xor(b, 1); b += __shfl_xor(b, 2); b += __shfl_xor(b, 4);
              if (cg == 0) BSW[(size_t)(t0 + tok) * 8 + h] = b; }
            float at[8], bt[8], kt[8], rt[8], bp[8], kp[8];
#pragma unroll
            for (int i = 0; i < 8; ++i) { const float cl = EL[tok * 65 + 8 * cg + i], pc = __expf(EL[63 * 65 + 8 * cg + i]);
                const float ecl = __expf(cl), eicl = __expf(-cl);
                at[i] = -kk8[i] * __expf(cl + e8[i]); bt[i] = kk8[i] * as8[i] * eicl; kt[i] = k8[i] * eicl; rt[i] = r8[i] * ecl; bp[i] = bt[i] * pc; kp[i] = kt[i] * pc;
                if (tok == 0) PC[8 * cg + i] = pc; }
            u32x4 o;
            o.x = pk2(at[0], at[1]); o.y = pk2(at[2], at[3]); o.z = pk2(at[4], at[5]); o.w = pk2(at[6], at[7]); *(LAS u32x4*)(AT + tok * LDP + 8 * cg) = o;
            o.x = pk2(bt[0], bt[1]); o.y = pk2(bt[2], bt[3]); o.z = pk2(bt[4], bt[5]); o.w = pk2(bt[6], bt[7]); *(LAS u32x4*)(BT + tok * LDP + 8 * cg) = o;
            o.x = pk2(kt[0], kt[1]); o.y = pk2(kt[2], kt[3]); o.z = pk2(kt[4], kt[5]); o.w = pk2(kt[6], kt[7]); *(LAS u32x4*)(KT + tok * LDP + 8 * cg) = o;
            o.x = pk2(rt[0], rt[1]); o.y = pk2(rt[2], rt[3]); o.z = pk2(rt[4], rt[5]); o.w = pk2(rt[6], rt[7]); *(LAS u32x4*)(RT + tok * LDP + 8 * cg) = o;
#pragma unroll
            for (int i = 0; i < 8; ++i) { const int c = 8 * cg + i; ATt[c * LDP + tok] = f2bf(at[i]); Vt[c * LDP + tok] = v8[i]; BPt[c * LDP + tok] = f2bf(bp[i]); KPt[c * LDP + tok] = f2bf(kp[i]); }
        }
        lds_barrier();
        {
            const FrX xb = ldx64(BT, w, jl, g), xk = ldx64(KT, w, jl, g); const FrY ya = ldy64(AT, w, jl, g), yr_ = ldy64(RT, w, jl, g);
            f32x4 a1[2], a2[2], a3[2], a4[2]; ZACC(a1); ZACC(a2); ZACC(a3); ZACC(a4);
            mma64(xb, ya, a1); mma64(xk, ya, a2); mma64(xb, yr_, a3); mma64(xk, yr_, a4);
            const int s0 = 16 * (w & 3) + 4 * g;
            f32x4 b[2];
#pragma unroll
            for (int i = 0; i < 2; ++i) { const int t = 16 * (2 * (w >> 2) + i) + jl;
#pragma unroll
                for (int r = 0; r < 4; ++r) { const bool lt = s0 + r < t, le = s0 + r <= t; if (!lt) { a1[i][r] = 0.f; a2[i][r] = 0.f; } if (!le) { a3[i][r] = 0.f; a4[i][r] = 0.f; } b[i][r] = (s0 + r == t) ? 1.0f : a1[i][r]; } }
            st_t(SL(8), a1, w, jl, g); st_n(SL(9), a1, w, jl, g);
            st_t(SL(13), b, w, jl, g); st_n(SL(14), b, w, jl, g);
            st_t(AAK, a2, w, jl, g); st_t(ARB, a3, w, jl, g); st_t(ARK, a4, w, jl, g);
        }
        lds_barrier();
#define NEU_B(srcB, srcBt, dstB, dstBt) do { f32x4 a[2]; ZACC(a); mm64(SL(srcB), SL(srcBt), w, jl, g, a); st_t(SL(dstBt), a, w, jl, g); st_n(SL(dstB), a, w, jl, g); } while (0)
#define NEU_TB(srcT, srcTt, srcB, srcBt, dstT, dstTt, dstB, dstBt) do { f32x4 at[2], ab[2]; ZACC(ab); \
            const FrX xt_ = ldx64(SL(srcT), w, jl, g), xb_ = ldx64(SL(srcB), w, jl, g); const FrY yb_ = ldy64(SL(srcBt), w, jl, g); \
            _Pragma("unroll") for (int i = 0; i < 2; ++i) at[i] = unpack4(*(const LAS u32x2*)(SL(srcTt) + (16 * (2 * (w >> 2) + i) + jl) * LDP + 16 * (w & 3) + 4 * g)); \
            mma64(xt_, yb_, at); mma64(xb_, yb_, ab); \
            st_t(SL(dstTt), at, w, jl, g); st_n(SL(dstT), at, w, jl, g); st_t(SL(dstBt), ab, w, jl, g); st_n(SL(dstB), ab, w, jl, g); } while (0)
#define NEU_T(srcT, srcTt, srcBt, dstT, dstTt, last) do { f32x4 a[2]; \
            _Pragma("unroll") for (int i = 0; i < 2; ++i) a[i] = unpack4(*(const LAS u32x2*)(SL(srcTt) + (16 * (2 * (w >> 2) + i) + jl) * LDP + 16 * (w & 3) + 4 * g)); \
            mm64(SL(srcT), SL(srcBt), w, jl, g, a); if (!(last)) st_t(SL(dstTt), a, w, jl, g); st_n(SL(dstT), a, w, jl, g); } while (0)
        NEU_B(8, 9, 0, 1);                                   lds_barrier();
        NEU_TB(13, 14, 0, 1, 15, 2, 8, 9);                   lds_barrier();
        NEU_TB(15, 2, 8, 9, 13, 14, 0, 1);                   lds_barrier();
        NEU_TB(13, 14, 0, 1, 15, 2, 8, 9);                   lds_barrier();
        NEU_TB(15, 2, 8, 9, 13, 14, 0, 1);                   lds_barrier();
        NEU_T(13, 14, 1, 15, 2, true);                       lds_barrier();
        lbf* TI = SL(15); lbf* Wt = SL(8); lbf* Xt = SL(9); lbf* Ut = SL(0);
        A0_LOAD(u + F.G); asm volatile("" ::: "memory");
        {
            const FrX x1 = ldx64(TI, w, jl, g), x2 = ldx64(AAK, w, jl, g); const FrY y1 = ldy64(ATt, w, jl, g), y2 = ldy64(Vt, w, jl, g);
            f32x4 a[2], b[2]; ZACC(a); ZACC(b); mma64(x1, y1, a); mma64(x2, y2, b); st_t(Wt, a, w, jl, g); st_t(Xt, b, w, jl, g); }
        lds_barrier();
        {
            const FrX xti = ldx64(TI, w, jl, g), xw = ldx64(Wt, w, jl, g); const FrY yx = ldy64(Xt, w, jl, g), yar = ldy64(ARB, w, jl, g), ybp = ldy64(BPt, w, jl, g);
            f32x4 rr[2]; float pcv[2];
#pragma unroll
            for (int i = 0; i < 2; ++i) { const int t = 16 * (2 * (w >> 2) + i) + jl; rr[i] = unpack4(*(const LAS u32x2*)(RT + t * LDP + 16 * (w & 3) + 4 * g)); pcv[i] = PC[t]; }
            f32x4 au[2], ar[2], am[2]; ZACC(au); ZACC(ar); ZACC(am);
            mma64(xti, yx, au); mma64(xw, yar, ar); mma64(xw, ybp, am);
            st_t(Ut, au, w, jl, g);
#pragma unroll
            for (int i = 0; i < 2; ++i) { const int t = 16 * (2 * (w >> 2) + i) + jl, k0 = 16 * (w & 3) + 4 * g;
                *(u32x2*)(RW + 5 * AS_ + rwo(t0 + t, h * 64 + k0)) = pack4(ar[i] + rr[i]);
#pragma unroll
                for (int r = 0; r < 4; ++r) if (k0 + r == t) am[i][r] += pcv[i];
                *(u32x2*)(RW + 4 * AS_ + rwo(t0 + t, h * 64 + k0)) = pack4(am[i]); }
        }
        lds_barrier();
        {
            A0_LOADX(); asm volatile("" ::: "memory");
            f32x4 ay[2], an[2]; ZACC(ay); ZACC(an);
            { const FrX xu = ldx64(Ut, w, jl, g), xbp = ldx64(BPt, w, jl, g); const FrY yar = ldy64(ARB, w, jl, g), yu = ldy64(Ut, w, jl, g); mma64(xu, yar, ay); mma64(xbp, yu, an); }
            { const FrX xv = ldx64(Vt, w, jl, g), xkp = ldx64(KPt, w, jl, g); const FrY yak = ldy64(ARK, w, jl, g), yv = ldy64(Vt, w, jl, g); mma64(xv, yak, ay); mma64(xkp, yv, an); }
#pragma unroll
            for (int i = 0; i < 2; ++i) { const int t = 16 * (2 * (w >> 2) + i) + jl, c0 = 16 * (w & 3) + 4 * g;
                *(u32x2*)(YH + rwo(t0 + t, h * 64 + c0)) = pack4(ay[i]);
                *(u32x2*)(RW + 1 * AS_ + rwo(t0 + t, h * 64 + c0)) = pack4(an[i]); }
        }
    }
#undef A0_LOAD
#undef A0_LOADX
#undef SL
#undef NEU_B
#undef NEU_T
#undef NEU_TB
}

__device__ __forceinline__ void ph_rwkv_s2(Frame& F, int l, int pair) {
    const int bl = pair >> 3, h = pair & 7;
    const bf16_t* RW = (const bf16_t*)(F.ws + MX_RW); constexpr size_t AS_ = (size_t)TH * 512;
    const bf16_t* YH = (const bf16_t*)(F.ws + MX_CA); bf16_t* YA = (bf16_t*)(F.ws + MX_CA) + AS_;
    lbf* HT = (lbf*)F.lds;
    const int lane = F.lane, w = F.wave, jl = lane & 15, g = lane >> 4;
    lds_barrier();
    for (int i = F.tid; i < 64 * LDP / 2; i += NTHR) ((LAS unsigned*)HT)[i] = 0u;
    if (F.tid < 128) ((LAS float*)(F.lds + SLOT))[F.tid] = (F.tid < 64 ? FIN(F, I_LNG) : FIN(F, I_LNB))[l * 512 + h * 64 + (F.tid & 63)];
    lds_barrier();
    if (w < 4) {
        bf16x8 m0[4], m1[4]; u32x2 nn[4][4];
#define S2A_LOAD(j, c) do { const int cc_ = (c) < SEQ / 64 ? (c) : SEQ / 64 - 1; const int tb_ = bl * SEQ + cc_ * 64; \
        m0[j] = *(const bf16x8*)(RW + 4 * AS_ + rwo(tb_ + 16 * w + jl, h * 64 + 8 * g)); m1[j] = *(const bf16x8*)(RW + 4 * AS_ + rwo(tb_ + 16 * w + jl, h * 64 + 32 + 8 * g)); \
        _Pragma("unroll") for (int yt = 0; yt < 4; ++yt) nn[j][yt] = *(const u32x2*)(RW + 1 * AS_ + rwo(tb_ + 16 * yt + jl, h * 64 + 16 * w + 4 * g)); } while (0)
        S2A_LOAD(0, 0); S2A_LOAD(1, 1); S2A_LOAD(2, 2);
#pragma unroll 1
        for (int c4 = 0; c4 < SEQ / 64; c4 += 4) {
#pragma unroll
            for (int j = 0; j < 4; ++j) {
                asm volatile("" : "+v"(m0[j]), "+v"(m1[j]));
#pragma unroll
                for (int yt = 0; yt < 4; ++yt) asm volatile("" : "+v"(nn[j][yt]));
                S2A_LOAD((j + 3) & 3, c4 + j + 3);
                asm volatile("" ::: "memory");
                f32x4 a[4]; bf16x8 hf[4][2];
#pragma unroll
                for (int yt = 0; yt < 4; ++yt) { const lbf* yr = HT + (16 * yt + jl) * LDP + 8 * g; hf[yt][0] = *(const LAS bf16x8*)yr; hf[yt][1] = *(const LAS bf16x8*)(yr + 32); a[yt] = unpack4(nn[j][yt]); }
#pragma unroll
                for (int yt = 0; yt < 4; ++yt) a[yt] = MFMA16(m0[j], hf[yt][0], a[yt]);
#pragma unroll
                for (int yt = 0; yt < 4; ++yt) a[yt] = MFMA16(m1[j], hf[yt][1], a[yt]);
                lds_barrier();
#pragma unroll
                for (int yt = 0; yt < 4; ++yt) *(LAS u32x2*)(HT + (16 * yt + jl) * LDP + 16 * w + 4 * g) = pack4(a[yt]);
                lds_barrier();
            }
        }
#undef S2A_LOAD
    } else {
        const int wt = w - 4;
        const LAS float* lgl = (const LAS float*)(F.lds + SLOT) + 4 * g; const LAS float* lbl = lgl + 64;
        lbf* ystg = (lbf*)(F.lds + 2 * SLOT) + wt * 16 * LDP;
        const float* bsp = (const float*)(F.ws + MX_BS) + (size_t)(bl * SEQ + 16 * wt + jl) * 8 + h;
        bf16x8 r0[4], r1[4]; u32x2 yh[4][4], uv[4][4], ug[4][4]; float bsv[4];
#define S2B_LOAD(j, c) do { const int cc_ = (c) < SEQ / 64 ? (c) : SEQ / 64 - 1; const int tk_ = bl * SEQ + cc_ * 64 + 16 * wt + jl; \
        r0[j] = *(const bf16x8*)(RW + 5 * AS_ + rwo(tk_, h * 64 + 8 * g)); r1[j] = *(const bf16x8*)(RW + 5 * AS_ + rwo(tk_, h * 64 + 32 + 8 * g)); \
        bsv[j] = bsp[(size_t)(cc_ * 64) * 8]; \
        _Pragma("unroll") for (int xt = 0; xt < 4; ++xt) { yh[j][xt] = *(const u32x2*)(YH + rwo(tk_, h * 64 + 16 * xt + 4 * g)); uv[j][xt] = *(const u32x2*)(RW + 3 * AS_ + rwo(tk_, h * 64 + 16 * xt + 4 * g)); ug[j][xt] = *(const u32x2*)(RW + 6 * AS_ + rwo(tk_, h * 64 + 16 * xt + 4 * g)); } } while (0)
        S2B_LOAD(0, 0); S2B_LOAD(1, 1); S2B_LOAD(2, 2);
#pragma unroll 1
        for (int c4 = 0; c4 < SEQ / 64; c4 += 4) {
#pragma unroll
            for (int j = 0; j < 4; ++j) {
                asm volatile("" : "+v"(r0[j]), "+v"(r1[j]), "+v"(bsv[j]));
#pragma unroll
                for (int xt = 0; xt < 4; ++xt) asm volatile("" : "+v"(yh[j][xt]), "+v"(uv[j][xt]), "+v"(ug[j][xt]));
                S2B_LOAD((j + 3) & 3, c4 + j + 3);
                asm volatile("" ::: "memory");
                f32x4 a[4]; bf16x8 hf[4][2];
#pragma unroll
                for (int xt = 0; xt < 4; ++xt) { const lbf* xr = HT + (16 * xt + jl) * LDP + 8 * g; hf[xt][0] = *(const LAS bf16x8*)xr; hf[xt][1] = *(const LAS bf16x8*)(xr + 32); a[xt] = unpack4(yh[j][xt]); }
#pragma unroll
                for (int xt = 0; xt < 4; ++xt) a[xt] = MFMA16(hf[xt][0], r0[j], a[xt]);
#pragma unroll
                for (int xt = 0; xt < 4; ++xt) a[xt] = MFMA16(hf[xt][1], r1[j], a[xt]);
                lds_barrier();
                float s = 0.f; const float bs = bsv[j];
#pragma unroll
                for (int xt = 0; xt < 4; ++xt)
#pragma unroll
                    for (int r = 0; r < 4; ++r) s += a[xt][r];
                s += __shfl_xor(s, 16); s += __shfl_xor(s, 32);
                const float mean = s * (1.f / 64.f); float q = 0.f;
#pragma unroll
                for (int xt = 0; xt < 4; ++xt)
#pragma unroll
                    for (int r = 0; r < 4; ++r) { const float d = a[xt][r] - mean; q += d * d; }
                q += __shfl_xor(q, 16); q += __shfl_xor(q, 32);
                const float rstd = 1.0f / sqrtf(q * (1.f / 64.f) + 64e-5f);
#pragma unroll
                for (int xt = 0; xt < 4; ++xt) { const f32x4 vv = unpack4(uv[j][xt]), gg = unpack4(ug[j][xt]), lg4 = *(const LAS f32x4*)(lgl + 16 * xt), lb4 = *(const LAS f32x4*)(lbl + 16 * xt); f32x4 o;
#pragma unroll
                    for (int r = 0; r < 4; ++r) o[r] = ((a[xt][r] - mean) * rstd * lg4[r] + lb4[r] + bs * vv[r]) * gg[r];
                    *(LAS u32x2*)(ystg + jl * LDP + 16 * xt + 4 * g) = pack4(o); }
#pragma unroll
                for (int p = 0; p < 2; ++p) { const int rr_ = (lane >> 3) + 8 * p; const u32x4 vrow = *(const LAS u32x4*)(ystg + rr_ * LDP + 8 * (lane & 7));
                    *(u32x4*)(YA + (size_t)(bl * SEQ + (c4 + j) * 64 + 16 * wt + rr_) * 512 + h * 64 + 8 * (lane & 7)) = vrow; }
                lds_barrier();
            }
        }
#undef S2B_LOAD
    }
}

__device__ __forceinline__ void ph_dsa_prep(Frame& F, int l, int half) {
    bf16_t* CB = (bf16_t*)(F.ws + MX_CB); bf16_t* VT = (bf16_t*)(F.ws + MX_VT);
    const int* pos = (const int*)KARGP(F, I_POS) + (size_t)half * TH;
    const int lane = F.lane, j = lane & 7;
    float invf[4]; f32x4 gq[2], gk[2], gik[2];
#pragma unroll
    for (int i = 0; i < 4; ++i) invf[i] = __builtin_amdgcn_exp2f(-(float)(2 * (4 * j + i)) * (13.287712379549449f / 64.0f));
#pragma unroll
    for (int hf = 0; hf < 2; ++hf) { gq[hf] = *(const f32x4*)(FIN(F, I_QN) + l * 64 + 32 * hf + 4 * j); gk[hf] = *(const f32x4*)(FIN(F, I_KN) + l * 64 + 32 * hf + 4 * j); gik[hf] = *(const f32x4*)(FIN(F, I_IKN) + l * 64 + 32 * hf + 4 * j); }
    lbf* vst = (lbf*)F.lds;
    for (int tile = F.bid; tile < TH / 64; tile += F.G) {
        lds_barrier();
#pragma unroll 2
        for (int k8 = 0; k8 < 8; ++k8) {
        const int tk = 8 * F.wave + k8, t = tile * 64 + tk;
        const float p = (float)pos[t];
        f32x4 cs, sn;
#pragma unroll
        for (int i = 0; i < 4; ++i) { float rev = p * invf[i] * 0.15915494309189535f; rev = rev - floorf(rev); cs[i] = __builtin_amdgcn_cosf(rev); sn[i] = __builtin_amdgcn_sinf(rev); }
        bf16_t* row = CB + (size_t)t * DS_PAD;
#pragma unroll
        for (int ps = 0; ps < 3; ++ps) {
            const int vec = 8 * ps + (lane >> 3);
            if (vec < 19) {
                bf16_t* vp = row + vec * 64 + 4 * j;
                const u32x2 u1 = *(const u32x2*)vp, u2 = *(const u32x2*)(vp + 32);
                f32x4 x1 = unpack4(u1), x2 = unpack4(u2);
                if (vec == 9) {
                    vst[(4 * j + 0) * LDP + tk] = (bf16_t)(u1.x & 0xffffu); vst[(4 * j + 1) * LDP + tk] = (bf16_t)(u1.x >> 16); vst[(4 * j + 2) * LDP + tk] = (bf16_t)(u1.y & 0xffffu); vst[(4 * j + 3) * LDP + tk] = (bf16_t)(u1.y >> 16);
                    vst[(32 + 4 * j + 0) * LDP + tk] = (bf16_t)(u2.x & 0xffffu); vst[(32 + 4 * j + 1) * LDP + tk] = (bf16_t)(u2.x >> 16); vst[(32 + 4 * j + 2) * LDP + tk] = (bf16_t)(u2.y & 0xffffu); vst[(32 + 4 * j + 3) * LDP + tk] = (bf16_t)(u2.y >> 16);
                } else {
                    const bool nrm = (vec < 9) || (vec == 18);
                    float ss = (x1[0] * x1[0] + x1[1] * x1[1]) + (x1[2] * x1[2] + x1[3] * x1[3]) + (x2[0] * x2[0] + x2[1] * x2[1]) + (x2[2] * x2[2] + x2[3] * x2[3]);
                    ss += __shfl_xor(ss, 1); ss += __shfl_xor(ss, 2); ss += __shfl_xor(ss, 4);
                    if (nrm) { float rstd = 1.0f / sqrtf(ss * (1.f / 64.f) + 1e-6f); if (vec < 8) rstd *= 0.125f * 1.4426950409f;
                        const f32x4 g1 = vec < 8 ? gq[0] : (vec == 8 ? gk[0] : gik[0]), g2 = vec < 8 ? gq[1] : (vec == 8 ? gk[1] : gik[1]);
                        x1 = x1 * rstd * g1; x2 = x2 * rstd * g2; }
                    const f32x4 o1 = x1 * cs - x2 * sn, o2 = x2 * cs + x1 * sn;
                    *(u32x2*)vp = pack4(o1); *(u32x2*)(vp + 32) = pack4(o2);
                }
            }
        }
        }
        lds_barrier();
        { const int dim = F.tid >> 3, ch = F.tid & 7; const int t0 = tile * 64;
          *(u32x4*)(VT + ((size_t)(t0 >> 11) * 64 + dim) * SEQ + (t0 & (SEQ - 1)) + 8 * ch) = *(const LAS u32x4*)(vst + dim * LDP + 8 * ch); }
    }
}

constexpr int SC_LD = 2052;
__device__ __forceinline__ void lds_inc(LAS unsigned* p) { (void)__hip_atomic_fetch_add(p, 1u, __ATOMIC_RELAXED, __HIP_MEMORY_SCOPE_WORKGROUP); }
__device__ __forceinline__ unsigned okey(float s) { const unsigned u = __builtin_bit_cast(unsigned, s); return (u & 0x80000000u) ? ~u : (u | 0x80000000u); }
__device__ __forceinline__ int hist_find(LAS unsigned* hist, int lane, int& R, int& cnt) {
    const u32x4 c4 = *(const LAS u32x4*)(hist + 4 * lane);
    const unsigned tot = c4.x + c4.y + c4.z + c4.w;
    unsigned suf = tot;
#pragma unroll
    for (int o = 1; o < 64; o <<= 1) { const unsigned v = __shfl_down(suf, o); if (lane + o < 64) suf += v; }
    const unsigned above = suf - tot;
    const bool mine = (above < (unsigned)R) && ((unsigned)R <= suf);
    const unsigned long long bal = __ballot(mine);
    const int src = bal ? (int)__builtin_ctzll(bal) : 0;
    int bin, rr, cc;
    { unsigned a = above; int r_ = R;
      if ((unsigned)r_ <= a + c4.w) { bin = 4 * lane + 3; rr = r_ - (int)a; cc = (int)c4.w; } else { a += c4.w;
      if ((unsigned)r_ <= a + c4.z) { bin = 4 * lane + 2; rr = r_ - (int)a; cc = (int)c4.z; } else { a += c4.z;
      if ((unsigned)r_ <= a + c4.y) { bin = 4 * lane + 1; rr = r_ - (int)a; cc = (int)c4.y; } else { a += c4.y; bin = 4 * lane; rr = r_ - (int)a; cc = (int)c4.x; } } } }
    bin = __shfl(bin, src); rr = __shfl(rr, src); cc = __shfl(cc, src);
    R = rr; cnt = cc; return bin;
}
__device__ __forceinline__ void ph_dsa(Frame& F, int half, unsigned* qctr) {
    const bf16_t* CB = (const bf16_t*)(F.ws + MX_CB); const bf16_t* VT = (const bf16_t*)(F.ws + MX_VT);
    bf16_t* YB = (bf16_t*)(F.ws + MX_YB);
    LAS float* sc = (LAS float*)F.lds;
    LAS unsigned* hist = (LAS unsigned*)(F.lds + 16 * SC_LD * 4);
    LAS unsigned* msk = (LAS unsigned*)(F.lds + 16 * SC_LD * 4 + 16 * 256 * 4);
    lbf* KB = (lbf*)F.lds;
    lbf* VB = (lbf*)(F.lds + 2 * SLOT);
    const int lane = F.lane, w = F.wave, jl = lane & 15, g = lane >> 4;
    const int srow = F.tid >> 3, sseg = F.tid & 7;
    volatile LAS unsigned* qslot = (volatile LAS unsigned*)(F.lds + LDS_MISC + 64);
    for (;;) {
        if (F.tid == 0) *qslot = __hip_atomic_fetch_add(qctr, 1u, __ATOMIC_RELAXED, __HIP_MEMORY_SCOPE_AGENT);
        lds_barrier();
        const int ui = (int)*qslot; if (ui >= TH / 16) break;
        const int bl = ui & 15, q0 = (127 - (ui >> 4)) * 16, L = ((q0 >> 6) + 1) * 64;
        const int rowb = bl * SEQ;
        if (L > 256) for (int i = F.tid; i < 16 * 256; i += NTHR) hist[i] = 0u;
        lds_barrier();
        {
            bf16x8 yq[8][2]; float iw[8];
            const bf16_t* qrow = CB + (size_t)(rowb + q0 + jl) * DS_PAD;
#pragma unroll
            for (int h = 0; h < 8; ++h) { iw[h] = bf2f(qrow[1216 + h]);
#pragma unroll
                for (int s = 0; s < 2; ++s) yq[h][s] = *(const bf16x8*)(qrow + 640 + h * 64 + 32 * s + 8 * g); }
            const int nk = L / 16;
            const bf16_t* kbase = CB + (size_t)(rowb + jl) * DS_PAD + 1152 + 8 * g;
            bf16x8 x0 = {0, 0, 0, 0, 0, 0, 0, 0}, x1 = x0;
            if (w < nk) { const bf16_t* kr = kbase + (size_t)(w * 16) * DS_PAD; x0 = *(const bf16x8*)kr; x1 = *(const bf16x8*)(kr + 32); }
            for (int kt = w; kt < nk; kt += 8) {
                bf16x8 n0 = x0, n1 = x1;
                if (kt + 8 < nk) { const bf16_t* kr = kbase + (size_t)((kt + 8) * 16) * DS_PAD; n0 = *(const bf16x8*)kr; n1 = *(const bf16x8*)(kr + 32); }
                f32x4 s4 = (f32x4){0.f, 0.f, 0.f, 0.f};
#pragma unroll
                for (int h = 0; h < 8; ++h) { f32x4 a = (f32x4){0.f, 0.f, 0.f, 0.f}; a = MFMA16(x0, yq[h][0], a); a = MFMA16(x1, yq[h][1], a);
#pragma unroll
                    for (int r = 0; r < 4; ++r) s4[r] += iw[h] * fmaxf(a[r], 0.f); }
                *(LAS f32x4*)(sc + jl * SC_LD + kt * 16 + 4 * g) = s4;
                if (L > 256) {
#pragma unroll
                    for (int r = 0; r < 4; ++r) lds_inc(hist + jl * 256 + (okey(s4[r]) >> 24)); }
                x0 = n0; x1 = n1;
            }
        }
        lds_barrier();
        for (int qi = 0; qi < 2; ++qi) {
            const int qq = 2 * w + qi; LAS unsigned* hq = hist + qq * 256; const LAS float* sq = sc + qq * SC_LD; LAS unsigned* mq = msk + qq * 64;
            if (L <= 256) { mq[lane] = (lane < L / 32) ? 0xffffffffu : 0u; }
            else {
                int R = 256, E = 0; unsigned prefix = (unsigned)hist_find(hq, lane, R, E);
#pragma unroll 1
                for (int pass = 1; pass < 4; ++pass) {
                    const int sh = 24 - 8 * pass;
                    asm volatile("" ::: "memory");
                    *(LAS u32x4*)(hq + 4 * lane) = (u32x4){0u, 0u, 0u, 0u};
                    LDS_WAIT(); asm volatile("" ::: "memory");
                    for (int i = 4 * lane; i < L; i += 256) { const f32x4 s = *(const LAS f32x4*)(sq + i);
#pragma unroll
                        for (int r = 0; r < 4; ++r) { const unsigned k = okey(s[r]); if ((k >> (sh + 8)) == prefix) lds_inc(hq + ((k >> sh) & 255u)); } }
                    LDS_WAIT(); asm volatile("" ::: "memory");
                    const int b = hist_find(hq, lane, R, E); prefix = (prefix << 8) | (unsigned)b;
                }
                const unsigned thr = prefix;
                if (R >= E) {
                    for (int base = 0; base < SEQ; base += 256) {
                        unsigned nib = 0u;
                        if (base + 4 * lane < L) { const f32x4 s = *(const LAS f32x4*)(sq + base + 4 * lane);
#pragma unroll
                            for (int r = 0; r < 4; ++r) nib |= (okey(s[r]) >= thr ? 1u : 0u) << r; }
                        unsigned wv = nib << (4 * (lane & 7));
                        wv |= __shfl_xor(wv, 1); wv |= __shfl_xor(wv, 2); wv |= __shfl_xor(wv, 4);
                        if ((lane & 7) == 0) mq[(base >> 5) + (lane >> 3)] = wv;
                    }
                } else {
                    int taken = 0;
                    for (int base = 0; base < SEQ; base += 64) {
                        bool take = false; bool eq = false;
                        if (base < L) { const unsigned k = okey(sq[base + lane]); take = k > thr; eq = (k == thr); }
                        const unsigned long long em = __ballot(eq);
                        const int myr = taken + __popcll(em & ((1ull << lane) - 1ull));
                        take = take || (eq && myr < R);
                        taken += __popcll(em);
                        const unsigned long long tm = __ballot(take);
                        if (lane == 0) { mq[base / 32] = (unsigned)tm; mq[base / 32 + 1] = (unsigned)(tm >> 32); }
                    }
                }
            }
        }
        lds_barrier();
        {
            const int qloc = 2 * w + (jl >> 3), hd = jl & 7;
            const bf16_t* qrow = CB + (size_t)(rowb + q0 + qloc) * DS_PAD + hd * 64;
            const bf16x8 yq0 = *(const bf16x8*)(qrow + 8 * g), yq1 = *(const bf16x8*)(qrow + 32 + 8 * g);
            f32x4 O[4];
#pragma unroll
            for (int dt = 0; dt < 4; ++dt) O[dt] = (f32x4){0.f, 0.f, 0.f, 0.f};
            float mrun = -1e30f, lsum = 0.f;
            const LAS unsigned* mq = msk + qloc * 64;
            const bf16_t* kg = CB + (size_t)(rowb + srow) * DS_PAD + 512 + 8 * sseg;
            const bf16_t* vg = VT + ((size_t)bl * 64 + srow) * SEQ + 8 * sseg;
            const int ntile = L / 64;
            u32x4 kreg = *(const u32x4*)kg, vreg = *(const u32x4*)vg;
            *(LAS u32x4*)(KB + srow * LDP + 8 * sseg) = kreg; *(LAS u32x4*)(VB + srow * LDP + 8 * sseg) = vreg;
            lds_barrier();
            for (int it = 0; it < ntile; ++it) {
                { const int itn = (it + 1 < ntile) ? it + 1 : it; kreg = *(const u32x4*)(kg + (size_t)(itn * 64) * DS_PAD); vreg = *(const u32x4*)(vg + itn * 64); asm volatile("" ::: "memory"); }
                const lbf* Kt = KB + (it & 1) * 64 * LDP; const lbf* Vt = VB + (it & 1) * 64 * LDP;
                f32x4 s[4]; bf16x8 kf[4][2];
#pragma unroll
                for (int tl = 0; tl < 4; ++tl) { const lbf* xr = Kt + (16 * tl + jl) * LDP + 8 * g; kf[tl][0] = *(const LAS bf16x8*)xr; kf[tl][1] = *(const LAS bf16x8*)(xr + 32); }
                u32x2 vlo[4][2], vhi[4][2];
#pragma unroll
                for (int dt = 0; dt < 4; ++dt)
#pragma unroll
                    for (int ks = 0; ks < 2; ++ks) { const lbf* vr = Vt + (16 * dt + jl) * LDP + 32 * ks + 4 * g; vlo[dt][ks] = *(const LAS u32x2*)vr; vhi[dt][ks] = *(const LAS u32x2*)(vr + 16); }
#pragma unroll
                for (int tl = 0; tl < 4; ++tl) s[tl] = MFMA16(kf[tl][0], yq0, ((f32x4){0.f, 0.f, 0.f, 0.f}));
#pragma unroll
                for (int tl = 0; tl < 4; ++tl) s[tl] = MFMA16(kf[tl][1], yq1, s[tl]);
                const unsigned mw0 = mq[2 * it], mw1 = mq[2 * it + 1];
                float mx = -1e30f;
#pragma unroll
                for (int tl = 0; tl < 4; ++tl)
#pragma unroll
                    for (int r = 0; r < 4; ++r) mx = fmaxf(mx, s[tl][r]);
                mx = fmaxf(mx, __shfl_xor(mx, 16)); mx = fmaxf(mx, __shfl_xor(mx, 32));
                const float mnew = fmaxf(mrun, mx); const float alpha = __builtin_amdgcn_exp2f(mrun - mnew); mrun = mnew;
                float p[16]; float ps = 0.f;
#pragma unroll
                for (int i = 0; i < 16; ++i) { const int tl = i >> 2, r = i & 3; const unsigned mw = (tl < 2) ? mw0 : mw1;
                    const int sel = __builtin_amdgcn_sbfe((int)mw, 16 * (tl & 1) + 4 * g + r, 1);
                    p[i] = __builtin_bit_cast(float, __builtin_bit_cast(int, __builtin_amdgcn_exp2f(s[tl][r] - mnew)) & sel); ps += p[i]; }
                lsum = lsum * alpha + ps;
                bf16x8 pf[2];
#pragma unroll
                for (int ks = 0; ks < 2; ++ks) { u32x4 pw; pw.x = pk2(p[8 * ks], p[8 * ks + 1]); pw.y = pk2(p[8 * ks + 2], p[8 * ks + 3]); pw.z = pk2(p[8 * ks + 4], p[8 * ks + 5]); pw.w = pk2(p[8 * ks + 6], p[8 * ks + 7]);
                    pf[ks] = __builtin_bit_cast(bf16x8, pw); }
#pragma unroll
                for (int dt = 0; dt < 4; ++dt) O[dt] = O[dt] * alpha;
#pragma unroll
                for (int ks = 0; ks < 2; ++ks)
#pragma unroll
                    for (int dt = 0; dt < 4; ++dt) O[dt] = MFMA16(__builtin_bit_cast(bf16x8, (u32x4){vlo[dt][ks].x, vlo[dt][ks].y, vhi[dt][ks].x, vhi[dt][ks].y}), pf[ks], O[dt]);
                if (it + 1 < ntile) { *(LAS u32x4*)(KB + ((it + 1) & 1) * 64 * LDP + srow * LDP + 8 * sseg) = kreg; *(LAS u32x4*)(VB + ((it + 1) & 1) * 64 * LDP + srow * LDP + 8 * sseg) = vreg; }
                lds_barrier();
            }
            lsum += __shfl_xor(lsum, 16); lsum += __shfl_xor(lsum, 32);
            const float inv = 1.0f / lsum;
            lbf* ostg = (lbf*)(F.lds + 4 * SLOT) + w * 16 * LDP;
#pragma unroll
            for (int dt = 0; dt < 4; ++dt) { u32x2 o; o.x = pk2(O[dt][0] * inv, O[dt][1] * inv); o.y = pk2(O[dt][2] * inv, O[dt][3] * inv); *(LAS u32x2*)(ostg + jl * LDP + 16 * dt + 4 * g) = o; }
#pragma unroll
            for (int p = 0; p < 2; ++p) { const int rr_ = (lane >> 3) + 8 * p; const u32x4 vrow = *(const LAS u32x4*)(ostg + rr_ * LDP + 8 * (lane & 7));
                *(u32x4*)(YB + (size_t)(rowb + q0 + 2 * w + (rr_ >> 3)) * 512 + (rr_ & 7) * 64 + 8 * (lane & 7)) = vrow; }
        }
    }
}

constexpr int MK_LD = 136, MV_LD = 264;
__device__ __forceinline__ void ph_mem_attn(Frame& F, int l) {
    const bf16_t* QM = (const bf16_t*)(F.ws + MA_QM); bf16_t* OM = (bf16_t*)(F.ws + MA_OM);
    const bf16_t* MK = (const bf16_t*)(F.ws + WS_MEMK) + (size_t)l * MEMROWS * 512; const bf16_t* MVT = (const bf16_t*)(F.ws + WS_MEMVT) + (size_t)l * MEMROWS * 512;
    lbf* KS = (lbf*)F.lds; lbf* VS = (lbf*)(F.lds + 256 * MK_LD * 2);
    const int lane = F.lane, jl = lane & 15, g = lane >> 4;
    const float* gq = FIN(F, I_MQN) + l * 128;
    for (int it = F.bid; it < NB * 4 * 2; it += F.G) {
        const int pair = it >> 1, b = pair >> 2, hh = pair & 3, sp0 = (it & 1) * 8;
        const bf16_t* kb_ = MK + ((size_t)b * 4 + hh) * 256 * 128; const bf16_t* vb_ = MVT + ((size_t)b * 4 + hh) * 128 * 256;
        lds_barrier();
#pragma unroll
        for (int i = 0; i < 8; ++i) { const int id = F.tid + NTHR * i;
            *(LAS u32x4*)(KS + (id >> 4) * MK_LD + 8 * (id & 15)) = *(const u32x4*)(kb_ + (size_t)(id >> 4) * 128 + 8 * (id & 15));
            *(LAS u32x4*)(VS + (id >> 5) * MV_LD + 8 * (id & 31)) = *(const u32x4*)(vb_ + (size_t)(id >> 5) * 256 + 8 * (id & 31)); }
        lds_barrier();
#pragma unroll 1
        for (int sp = 0; sp < 8; ++sp) {
        const int t = b * SEQ + (sp0 + sp) * 128 + F.wave * 16 + jl;
        const bf16_t* qrow = QM + (size_t)t * 512 + hh * 128;
        float qv[4][8]; float ss = 0.f;
#pragma unroll
        for (int s2 = 0; s2 < 4; ++s2) { const u32x4 q = *(const u32x4*)(qrow + 32 * s2 + 8 * g);
            qv[s2][0] = bf_lo(q.x); qv[s2][1] = bf_hi(q.x); qv[s2][2] = bf_lo(q.y); qv[s2][3] = bf_hi(q.y); qv[s2][4] = bf_lo(q.z); qv[s2][5] = bf_hi(q.z); qv[s2][6] = bf_lo(q.w); qv[s2][7] = bf_hi(q.w);
#pragma unroll
            for (int i = 0; i < 8; ++i) ss += qv[s2][i] * qv[s2][i]; }
        ss += __shfl_xor(ss, 16); ss += __shfl_xor(ss, 32);
        const float sc = (1.0f / sqrtf(ss * (1.f / 128.f) + 1e-6f)) * (0.08838834764831845f * 1.4426950409f);
        bf16x8 yq[4];
#pragma unroll
        for (int s2 = 0; s2 < 4; ++s2) { const float* gp = gq + 32 * s2 + 8 * g; u32x4 pw;
            pw.x = pk2(qv[s2][0] * sc * gp[0], qv[s2][1] * sc * gp[1]); pw.y = pk2(qv[s2][2] * sc * gp[2], qv[s2][3] * sc * gp[3]);
            pw.z = pk2(qv[s2][4] * sc * gp[4], qv[s2][5] * sc * gp[5]); pw.w = pk2(qv[s2][6] * sc * gp[6], qv[s2][7] * sc * gp[7]); yq[s2] = __builtin_bit_cast(bf16x8, pw); }
        f32x4 O[8];
#pragma unroll
        for (int dt = 0; dt < 8; ++dt) O[dt] = (f32x4){0.f, 0.f, 0.f, 0.f};
        float mrun = -1e30f, ls = 0.f;
#pragma unroll 1
        for (int hk = 0; hk < 2; ++hk) {
            f32x4 S[8];
#pragma unroll
            for (int kt = 0; kt < 8; ++kt) { const lbf* kr = KS + (128 * hk + 16 * kt + jl) * MK_LD + 8 * g; f32x4 a = (f32x4){0.f, 0.f, 0.f, 0.f};
#pragma unroll
                for (int s2 = 0; s2 < 4; ++s2) a = MFMA16(*(const LAS bf16x8*)(kr + 32 * s2), yq[s2], a);
                S[kt] = a; }
            float mx = -1e30f;
#pragma unroll
            for (int kt = 0; kt < 8; ++kt)
#pragma unroll
                for (int r = 0; r < 4; ++r) mx = fmaxf(mx, S[kt][r]);
            mx = fmaxf(mx, __shfl_xor(mx, 16)); mx = fmaxf(mx, __shfl_xor(mx, 32));
            const float mnew = fmaxf(mrun, mx), alpha = __builtin_amdgcn_exp2f(mrun - mnew); mrun = mnew;
            float ps = 0.f; bf16x8 pf[4];
#pragma unroll
            for (int ks = 0; ks < 4; ++ks) { float p[8];
#pragma unroll
                for (int i = 0; i < 8; ++i) { p[i] = __builtin_amdgcn_exp2f(S[2 * ks + (i >> 2)][i & 3] - mnew); ps += p[i]; }
                u32x4 pw; pw.x = pk2(p[0], p[1]); pw.y = pk2(p[2], p[3]); pw.z = pk2(p[4], p[5]); pw.w = pk2(p[6], p[7]); pf[ks] = __builtin_bit_cast(bf16x8, pw); }
            ls = ls * alpha + ps;
#pragma unroll
            for (int dt = 0; dt < 8; ++dt) { f32x4 o = O[dt] * alpha; const lbf* vr = VS + (16 * dt + jl) * MV_LD + 128 * hk + 4 * g;
#pragma unroll
                for (int ks = 0; ks < 4; ++ks) { const u32x2 lo = *(const LAS u32x2*)(vr + 32 * ks), hi = *(const LAS u32x2*)(vr + 32 * ks + 16);
                    o = MFMA16(__builtin_bit_cast(bf16x8, (u32x4){lo.x, lo.y, hi.x, hi.y}), pf[ks], o); }
                O[dt] = o; }
        }
        ls += __shfl_xor(ls, 16); ls += __shfl_xor(ls, 32);
        const float inv = 1.0f / ls;
        lbf* ostg = (lbf*)(F.lds + 256 * MK_LD * 2 + 128 * MV_LD * 2) + F.wave * 16 * LDP;
        const int t0w = b * SEQ + (sp0 + sp) * 128 + F.wave * 16;
#pragma unroll
        for (int hf2 = 0; hf2 < 2; ++hf2) {
#pragma unroll
            for (int d4 = 0; d4 < 4; ++d4) { const int dt = 4 * hf2 + d4; u32x2 ov; ov.x = pk2(O[dt][0] * inv, O[dt][1] * inv); ov.y = pk2(O[dt][2] * inv, O[dt][3] * inv); *(LAS u32x2*)(ostg + jl * LDP + 16 * d4 + 4 * g) = ov; }
#pragma unroll
            for (int p = 0; p < 2; ++p) { const int rr_ = (lane >> 3) + 8 * p; const u32x4 vrow = *(const LAS u32x4*)(ostg + rr_ * LDP + 8 * (lane & 7));
                *(u32x4*)(OM + (size_t)(t0w + rr_) * 512 + hh * 128 + 64 * hf2 + 8 * (lane & 7)) = vrow; }
        }
        }
    }
}

__device__ __forceinline__ void ph_moe_route(Frame& F) {
    const unsigned short* sele = (const unsigned short*)(F.ws + MOE_SELE); const f32x2* selw = (const f32x2*)(F.ws + MOE_SELW);
    int* rowtok = (int*)(F.ws + MOE_ROWTOK); float* roww = (float*)(F.ws + MOE_ROWW); int* tile_e = (int*)(F.ws + MOE_TILEE); int* meta = (int*)(F.ws + MOE_META);
    LAS unsigned long long* pc = (LAS unsigned long long*)F.lds;
    LAS int* tot = (LAS int*)(F.lds + 8192);
    LAS int* pre = tot + 16; LAS int* segb = tot + 32; LAS int* wcnt = tot + 64;
    __syncthreads();
    { unsigned long long c0 = 0ull, c1 = 0ull; const u32x4* sp = (const u32x4*)(sele + (size_t)F.tid * 128);
      for (int i = 0; i < 16; ++i) { const u32x4 v = sp[i]; const unsigned ww[4] = {v.x, v.y, v.z, v.w};
#pragma unroll
        for (int q = 0; q < 4; ++q) { const unsigned a = ww[q] & 0xffffu, b = ww[q] >> 16;
            c0 += 1ull << (8 * (a & 7u)); c1 += 1ull << (8 * ((a >> 8) & 7u)); c0 += 1ull << (8 * (b & 7u)); c1 += 1ull << (8 * ((b >> 8) & 7u)); } }
      pc[F.tid * 2] = c0; pc[F.tid * 2 + 1] = c1; }
    __syncthreads();
    if (F.tid < 32) { const int seg = F.tid & 15, kind = F.tid >> 4; const int slot = seg >> 3, e = seg & 7; const int lim = kind ? 2 * F.bid : 512; int s = 0;
        for (int i = 0; i < lim; ++i) s += (int)((pc[i * 2 + slot] >> (8 * e)) & 0xffull);
        if (kind) pre[seg] = s; else tot[seg] = s; }
    __syncthreads();
    if (F.tid == 0) { int b = 0; for (int s = 0; s < 16; ++s) { segb[s] = b; b += (tot[s] + 255) & ~255; } segb[16] = b; }
    __syncthreads();
    const int t = F.bid * 256 + (F.tid & 255); const unsigned se = sele[t]; const f32x2 sw = selw[t];
    const int myseg[2] = { (int)(se & 7u), 8 + (int)((se >> 8) & 7u) };
    int rank[2] = {0, 0};
    if (F.tid < 256) {
#pragma unroll
        for (int s = 0; s < 16; ++s) { const int k = s >> 3; const unsigned long long m = __ballot(myseg[k] == s);
            if (myseg[k] == s) rank[k] = __popcll(m & ((1ull << F.lane) - 1ull));
            if (F.lane == 0) wcnt[F.wave * 16 + s] = __popcll(m); }
    }
    __syncthreads();
    if (F.tid < 256) {
#pragma unroll
        for (int k = 0; k < 2; ++k) { const int s = myseg[k]; int off = 0; for (int ww = 0; ww < F.wave; ++ww) off += wcnt[ww * 16 + s];
            const int row = segb[s] + pre[s] + off + rank[k]; rowtok[row] = t; roww[row] = k ? sw.y : sw.x; }
    }
    if (F.bid == 0) {
        for (int s = 0; s < 16; ++s) { const int lo = segb[s] + tot[s], hi = segb[s + 1]; for (int r = lo + F.tid; r < hi; r += NTHR) { rowtok[r] = -1; roww[r] = 0.f; } }
        for (int p = F.tid; p < segb[16] / 256; p += NTHR) { int e = 0; for (int s = 0; s < 16; ++s) if (p * 256 >= segb[s]) e = s & 7; tile_e[p] = e; }
        if (F.tid == 0) { meta[0] = segb[8] / 256; meta[1] = segb[16] / 256; }
    }
}

__global__ void __launch_bounds__(NTHR, 2) fwd(Args args) {
    extern __shared__ __attribute__((aligned(16))) unsigned char lds_raw[];
    Frame F;
    F.lds = (LAS unsigned char*)lds_raw; F.ws = args.ws; F.kb = __builtin_amdgcn_kernarg_segment_ptr(); F.out = args.out;
    F.tid = threadIdx.x; F.lane = F.tid & 63; F.wave = __builtin_amdgcn_readfirstlane(F.tid >> 6); F.G = gridDim.x; F.bid = blockIdx.x;
    volatile LAS unsigned* MISC = (volatile LAS unsigned*)(F.lds + LDS_MISC);
    if (F.tid < 64) MISC[F.tid] = 0u;
    __syncthreads();
    const int lo = args.ph_lo, hi = args.ph_hi;
    XcdBarrier bar; bar.bar = (unsigned*)(F.ws + WS_CTL) + 4096; bar.x = 0; bar.st = nullptr;
    if (hi - lo > 1) bar = xcd_barrier_post((unsigned*)(F.ws + WS_CTL) + 4096, MISC + 8);
    int ph = 0;
    const int wave_s_ = __builtin_amdgcn_readfirstlane((int)threadIdx.x >> 6);
#ifndef SITE_MASK
#define SITE_MASK 0xffffffffffffffffull
#endif
#ifndef PROBE_T_MASK
#define PROBE_T_MASK 0ull
#endif
#ifndef PROBE_T_FACTOR
#define PROBE_T_FACTOR 20ull
#endif
    unsigned long long tacc_ = 0ull, t0_ = 0ull;
#ifndef SITE_MASK
#define SITE_MASK 0xffffffffffffffffull
#endif
#define PHASE_BEGIN { constexpr int site_ = __COUNTER__; if (((SITE_MASK >> site_) & 1ull) && ph >= lo && ph < hi) { if (((PROBE_T_MASK >> site_) & 1ull) && F.bid == 0) t0_ = __builtin_amdgcn_s_memrealtime(); \
      { unsigned _m = ~0u; int _wv = wave_s_; asm volatile("" : "+s"(_m), "+s"(_wv)); int _t = _wv * 64 + (int)__builtin_amdgcn_mbcnt_hi(_m, __builtin_amdgcn_mbcnt_lo(_m, 0u)); asm volatile("" : "+v"(_t)); F.tid = _t; F.lane = _t & 63; F.wave = _wv; { int _b = blockIdx.x, _g = gridDim.x; asm volatile("" : "+s"(_b), "+s"(_g)); F.bid = _b; F.G = _g; } \
      kptr_t _kb = __builtin_amdgcn_kernarg_segment_ptr(); asm volatile("" : "+s"(_kb)); F.kb = _kb; \
      __attribute__((address_space(1))) unsigned char* _w = (__attribute__((address_space(1))) unsigned char*)args.ws; asm volatile("" : "+s"(_w)); F.ws = (unsigned char*)_w; ws = F.ws; __attribute__((address_space(1))) float* _o = (__attribute__((address_space(1))) float*)args.out; asm volatile("" : "+s"(_o)); F.out = (float*)_o; }
#define PHASE_END   if (ph + 1 < hi) xcd_barrier(bar, F.tid); if (((PROBE_T_MASK >> site_) & 1ull) && F.bid == 0) tacc_ += __builtin_amdgcn_s_memrealtime() - t0_; } ++ph; }
    unsigned char* ws = F.ws;
#define HN ((const bf16_t*)(ws + WS_HN))

    PHASE_BEGIN ph_prologue0(F); PHASE_END
    PHASE_BEGIN { pg8::Gemm g{(const bf16_t*)(ws + WS_MEMH), (const bf16_t*)(ws + WS_WKV), D, 0, nullptr}; pg8::StaticOrder S; S.init(MEMROWS, 4096, F.G, F.bid);
        pg8::EpiPlain E{(bf16_t*)(ws + PR_KVRAW), 4096}; pg8::gemm_phase<pg8::EpiPlain, pg8::StaticOrder>(F.lds, g, S, E, F.tid); } PHASE_END
    PHASE_BEGIN ph_prologue2(F); PHASE_END

#pragma unroll 1
    for (int l = 0; l < DEPTH; ++l) {

        PHASE_BEGIN ph_layer0(F, l, l ? (const float*)F.out : FIN(F, I_X)); PHASE_END
#pragma unroll 1
        for (int half = 0; half < 2; ++half) {

            PHASE_BEGIN { pg8::Gemm g{HN + (size_t)half * TH * D, (const bf16_t*)(ws + W_IN), D, 0, nullptr}; pg8::StaticOrder S; S.init(TH, N_INP, F.G, F.bid);
                pg8::EpiWin E{(bf16_t*)(ws + MX_CA), (bf16_t*)(ws + MX_CB), (bf16_t*)(ws + MX_CG)}; pg8::gemm_phase<pg8::EpiWin, pg8::StaticOrder>(F.lds, g, S, E, F.tid); } PHASE_END
                        #ifndef PROBE_RPREP
#define PROBE_RPREP 1
#endif
#ifndef PROBE_S2
#define PROBE_S2 1
#endif
#ifndef PROBE_DSA
#define PROBE_DSA 1
#endif
            PHASE_BEGIN ph_rwkv_pre(F, l, half); ph_dsa_prep(F, l, half); PHASE_END
            PHASE_BEGIN ph_rwkv_s1(F, l, half); PHASE_END
            PHASE_BEGIN { for (int r_ = 0; r_ < PROBE_S2; ++r_) for (int p = F.bid; p < 128; p += F.G) ph_rwkv_s2(F, l, p); ph_dsa(F, half, (unsigned*)(ws + WS_CTL) + 8192 + 64 * (2 * l + half)); } PHASE_END
            PHASE_BEGIN { pg8::Gemm g{(const bf16_t*)(ws + MX_CA + RW_ARR), (const bf16_t*)(ws + W_BA), 512, 0, nullptr}; pg8::StaticOrder S; S.init(TH, D, F.G, F.bid);
                pg8::EpiMerge<false> E{(bf16_t*)(ws + WS_HN) + (size_t)half * TH * D, (const bf16_t*)(ws + MX_CG), 0}; pg8::gemm_phase<pg8::EpiMerge<false>, pg8::StaticOrder>(F.lds, g, S, E, F.tid); } PHASE_END
            PHASE_BEGIN { pg8::Gemm g{(const bf16_t*)(ws + MX_YB), (const bf16_t*)(ws + W_BB), 512, 0, nullptr}; pg8::StaticOrder S; S.init(TH, D, F.G, F.bid);
                pg8::EpiMerge<true> E{(bf16_t*)(ws + WS_HN) + (size_t)half * TH * D, (const bf16_t*)(ws + MX_CG), 1024}; pg8::gemm_phase<pg8::EpiMerge<true>, pg8::StaticOrder>(F.lds, g, S, E, F.tid); } PHASE_END
        }
        PHASE_BEGIN { pg8::Gemm g{HN, (const bf16_t*)(ws + W_OUT), D, 0, nullptr}; pg8::StaticOrder S; S.init(T, D, F.G, F.bid);
            pg8::EpiResid E{l ? (const float*)F.out : FIN(F, I_X), F.out}; pg8::gemm_phase<pg8::EpiResid, pg8::StaticOrder>(F.lds, g, S, E, F.tid); } PHASE_END
        PHASE_BEGIN ph_norm(F); PHASE_END
        PHASE_BEGIN { pg8::Gemm g{HN, (const bf16_t*)(ws + W_MQ), D, 0, nullptr}; pg8::StaticOrder S; S.init(T, 512, F.G, F.bid);
            pg8::EpiPlain E{(bf16_t*)(ws + MA_QM), 512}; pg8::gemm_phase<pg8::EpiPlain, pg8::StaticOrder>(F.lds, g, S, E, F.tid); } PHASE_END
        PHASE_BEGIN ph_mem_attn(F, l); PHASE_END
        PHASE_BEGIN { pg8::Gemm g{(const bf16_t*)(ws + MA_OM), (const bf16_t*)(ws + W_MO), 512, 0, nullptr}; pg8::StaticOrder S; S.init(T, D, F.G, F.bid);
            pg8::EpiResid E{F.out, F.out}; pg8::gemm_phase<pg8::EpiResid, pg8::StaticOrder>(F.lds, g, S, E, F.tid); } PHASE_END
        PHASE_BEGIN ph_norm_ffn(F, l); PHASE_END
        if ((l & 1) == 0) {
            PHASE_BEGIN { pg8::Gemm g{HN, (const bf16_t*)(ws + W_FGU), D, 0, nullptr}; pg8::StaticOrder S; S.init(T, 2 * FFN, F.G, F.bid);
                pg8::EpiSwiGLU E{(bf16_t*)(ws + FF_GU), FFN}; pg8::gemm_phase<pg8::EpiSwiGLU, pg8::StaticOrder>(F.lds, g, S, E, F.tid); } PHASE_END
            PHASE_BEGIN { pg8::Gemm g{(const bf16_t*)(ws + FF_GU), (const bf16_t*)(ws + W_FD), FFN, 0, nullptr}; pg8::StaticOrder S; S.init(T, D, F.G, F.bid);
                pg8::EpiResid E{F.out, F.out}; pg8::gemm_phase<pg8::EpiResid, pg8::StaticOrder, false, true>(F.lds, g, S, E, F.tid); } PHASE_END
            ph += 2;
        } else {
#define meta ((const int*)(ws + MOE_META))
#define tile_e ((const int*)(ws + MOE_TILEE))
            PHASE_BEGIN ph_moe_route(F); PHASE_END
            PHASE_BEGIN { const int nt1 = __builtin_amdgcn_readfirstlane(meta[1]);
                pg8::Gemm g{HN, (const bf16_t*)(ws + W_EGU), D, (size_t)2 * EDIM * D, (const int*)(ws + MOE_ROWTOK)}; pg8::MoeOrder S; S.init(nt1, 11, F.G, F.bid, 0, tile_e);
                pg8::EpiSwiGLU E{(bf16_t*)(ws + FF_GU), EDIM}; pg8::gemm_phase<pg8::EpiSwiGLU, pg8::MoeOrder, true>(F.lds, g, S, E, F.tid); } PHASE_END
            PHASE_BEGIN { const int nt0 = __builtin_amdgcn_readfirstlane(meta[0]);
                pg8::Gemm g{(const bf16_t*)(ws + FF_GU), (const bf16_t*)(ws + W_ED), EDIM, (size_t)D * EDIM, nullptr}; pg8::MoeOrder S; S.init(nt0, 4, F.G, F.bid, 0, tile_e);
                pg8::EpiMoeDown E{F.out, (const int*)(ws + MOE_ROWTOK), (const float*)(ws + MOE_ROWW)}; pg8::gemm_phase<pg8::EpiMoeDown, pg8::MoeOrder, false, true>(F.lds, g, S, E, F.tid); } PHASE_END
            PHASE_BEGIN { const int nt0 = __builtin_amdgcn_readfirstlane(meta[0]), nt1 = __builtin_amdgcn_readfirstlane(meta[1]);
                pg8::Gemm g{(const bf16_t*)(ws + FF_GU), (const bf16_t*)(ws + W_ED), EDIM, (size_t)D * EDIM, nullptr}; pg8::MoeOrder S; S.init(nt1 - nt0, 4, F.G, F.bid, nt0, tile_e);
                pg8::EpiMoeDown E{F.out, (const int*)(ws + MOE_ROWTOK), (const float*)(ws + MOE_ROWW)}; pg8::gemm_phase<pg8::EpiMoeDown, pg8::MoeOrder, false, true>(F.lds, g, S, E, F.tid); } PHASE_END
        }
    }
    if (PROBE_T_MASK != 0ull && F.bid == 0) { const unsigned long long te_ = __builtin_amdgcn_s_memrealtime() + PROBE_T_FACTOR * tacc_; while (__builtin_amdgcn_s_memrealtime() < te_) __builtin_amdgcn_s_sleep(32); }
}
constexpr int N_PHASES = 3 + DEPTH * (1 + 2 * 6 + 6 + 4);

extern "C" void kernel_launch(void* const* d_in, const int* in_sizes, int n_in, void* d_out, int out_size, void* d_ws, size_t ws_size, hipStream_t stream) {
    static int grid = 0;
    if (grid == 0) {
        if (n_in != 41 || out_size != T * D || ws_size < WS_END) { fprintf(stderr, "kernel_launch: unexpected shapes (n_in %d, out %d, ws %zu < %zu); nothing launched\n", n_in, out_size, ws_size, (size_t)WS_END); grid = -1; return; }
        int dev = 0, cus = 0, per_cu = 0;
        if (hipGetDevice(&dev) != hipSuccess || hipDeviceGetAttribute(&cus, hipDeviceAttributeMultiprocessorCount, dev) != hipSuccess) { grid = -1; return; }
        if (hipFuncSetAttribute((const void*)fwd, hipFuncAttributeMaxDynamicSharedMemorySize, LDS_BYTES) != hipSuccess) { fprintf(stderr, "kernel_launch: hipFuncSetAttribute failed\n"); grid = -1; return; }
        if (hipOccupancyMaxActiveBlocksPerMultiprocessor(&per_cu, (const void*)fwd, NTHR, LDS_BYTES) != hipSuccess || per_cu < 1) fprintf(stderr, "kernel_launch: occupancy query reports %d\n", per_cu);
        (void)hipGetLastError();
        grid = cus;
    }
    if (grid < 0) return;
    if (hipMemsetAsync((char*)d_ws + WS_CTL, 0, CTL_ZERO_BYTES, stream) != hipSuccess) return;
    Args a{};
    for (int i = 0; i < 41; ++i) a.in[i] = d_in[i];
    a.out = (float*)d_out; a.ws = (unsigned char*)d_ws;
#if MK_ONE_LAUNCH
    a.ph_lo = 0; a.ph_hi = N_PHASES;
    hipLaunchKernelGGL(fwd, dim3(grid), dim3(NTHR), LDS_BYTES, stream, a);
#else
    for (int p = 0; p < N_PHASES; ++p) { a.ph_lo = p; a.ph_hi = p + 1; hipLaunchKernelGGL(fwd, dim3(grid), dim3(NTHR), LDS_BYTES, stream, a); }
#endif
}
```

```cpp
#include <hip/hip_runtime.h>
#include <cstdio>
#include <cstdint>

#ifndef MK_ONE_LAUNCH
#define MK_ONE_LAUNCH 1
#endif

namespace pg8 {
#define PG8_LAS __attribute__((address_space(3)))
typedef unsigned short bf16_t;
typedef short bf16x8 __attribute__((ext_vector_type(8)));
typedef float f32x4 __attribute__((ext_vector_type(4)));
typedef float f32x2 __attribute__((ext_vector_type(2)));
typedef unsigned u32x4 __attribute__((ext_vector_type(4)));
typedef unsigned u32x2 __attribute__((ext_vector_type(2)));
typedef __bf16 bf16x2_t __attribute__((ext_vector_type(2)));
constexpr int BM = 256, BK = 64, HALF = 128, HTB = HALF * BK * 2, STAGE_BYTES = 8 * HTB, NXCD = 8, WGM = 8;

__host__ __device__ __forceinline__ int lds_byte(int r, int c) { const int st = (r >> 4) * 2 + (c >> 5), rr = r & 15, cc = c & 31, ob = rr * 64 + cc * 2; return st * 1024 + (ob ^ (((ob >> 9) & 1) << 5)); }
__host__ __device__ __forceinline__ void stage_rc(int b, int& R, int& C) { const int st = b / 1024, sb = b % 1024, swz = sb ^ (((sb >> 9) & 1) << 5); R = (st >> 1) * 16 + swz / 64; C = (st & 1) * 32 + (swz % 64) / 2; }
__host__ __device__ __forceinline__ int perm32(int rho) { const int n = rho >> 4, i = rho & 15; return 8 * (i >> 2) + 4 * n + (i & 3); }

struct Unit { int pm, pn, e; };
struct Gemm { const bf16_t* A; const bf16_t* Bt; int K; size_t bstride; const int* rowidx; };

struct StaticOrder {
    int nM, nN, nwg, G, c;
    __device__ __forceinline__ void init(int M, int N, int G_, int c_) { nM = M / BM; nN = N / BM; nwg = nM * nN; G = G_; c = c_; }
    __device__ __forceinline__ bool next(int i, Unit& u) const {
        const long L = (long)i * G + c; if (L >= nwg) return false;
        int wgid = (int)L; { const int q = nwg / NXCD, r = nwg % NXCD, xcd = wgid % NXCD, off = wgid / NXCD; wgid = (xcd < r ? xcd * (q + 1) : r * (q + 1) + (xcd - r) * q) + off; }
        const int nig = WGM * nN, gid = wgid / nig, fm = gid * WGM, gsz = (nM - fm) < WGM ? (nM - fm) : WGM;
        u.pm = fm + ((wgid % nig) % gsz); u.pn = (wgid % nig) / gsz; u.e = 0; return true;
    }
};
struct MoeOrder {
    int nM, nN, nwg, G, c, pm0; const int* tile_e;
    __device__ void init(int nM_, int nN_, int G_, int c_, int pm0_, const int* te) { nM = nM_; nN = nN_; nwg = nM * nN; G = G_; c = c_; pm0 = pm0_; tile_e = te; }
    __device__ bool next(int i, Unit& u) const {
        const long L = (long)i * G + c; if (L >= nwg) return false;
        int wgid = (int)L; { const int q = nwg / NXCD, r = nwg % NXCD, xcd = wgid % NXCD, off = wgid / NXCD; wgid = (xcd < r ? xcd * (q + 1) : r * (q + 1) + (xcd - r) * q) + off; }
        const int nig = WGM * nN, gid = wgid / nig, fm = gid * WGM, gsz = (nM - fm) < WGM ? (nM - fm) : WGM;
        u.pm = pm0 + fm + ((wgid % nig) % gsz); u.pn = (wgid % nig) / gsz; u.e = __builtin_amdgcn_readfirstlane(tile_e[u.pm]); return true;
    }
};

__device__ __forceinline__ unsigned pk2(float lo, float hi) { const bf16x2_t v = __builtin_convertvector((f32x2){lo, hi}, bf16x2_t); return __builtin_bit_cast(unsigned, v); }
__device__ __forceinline__ u32x4 zu4() { unsigned z = 0u; asm volatile("" : "+v"(z)); return (u32x4){z, z, z, z}; }
__device__ __forceinline__ f32x4 zf4() { float z = 0.f; asm volatile("" : "+v"(z)); return (f32x4){z, z, z, z}; }
__device__ __forceinline__ float bf_lo(unsigned u) { return __builtin_bit_cast(float, u << 16); }
__device__ __forceinline__ float bf_hi(unsigned u) { return __builtin_bit_cast(float, u & 0xffff0000u); }
__device__ __forceinline__ float bf2f(bf16_t b) { return __builtin_bit_cast(float, (unsigned)b << 16); }
__device__ __forceinline__ bf16_t f2bf(float f) { return (bf16_t)(pk2(f, 0.f) & 0xffffu); }
__device__ __forceinline__ float sigmoidf_(float x) { return __builtin_amdgcn_rcpf(1.0f + __expf(-x)); }

struct EpiPlain {
    static constexpr bool PERM = true;
    bf16_t* O; int ldc; const float* rs;
    __device__ __forceinline__ void operator()(const f32x4 (&acc)[2][2][4][2], const Unit& u, int wr, int wc, int fr, int fq) const {
        const int row0 = u.pm * BM + wr * 64 + fr, col0 = u.pn * BM + wc * 32 + 8 * fq;
        float scv[2][4];
#pragma unroll
        for (int ai = 0; ai < 2; ++ai)
#pragma unroll
            for (int m = 0; m < 4; ++m) scv[ai][m] = rs ? rs[row0 + ai * HALF + m * 16] : 1.0f;
#pragma unroll
        for (int ai = 0; ai < 2; ++ai)
#pragma unroll
            for (int m = 0; m < 4; ++m) { bf16_t* rowp = O + (size_t)(row0 + ai * HALF + m * 16) * ldc + col0; const float sc_ = scv[ai][m];
#pragma unroll
                for (int bj = 0; bj < 2; ++bj) { const f32x4 v0 = acc[ai][bj][m][0] * sc_, v1 = acc[ai][bj][m][1] * sc_;
                    u32x4 w; w.x = pk2(v0[0], v0[1]); w.y = pk2(v0[2], v0[3]); w.z = pk2(v1[0], v1[1]); w.w = pk2(v1[2], v1[3]);
                    *(u32x4*)(rowp + bj * HALF) = w; } }
    }
};
struct EpiWin {
    static constexpr bool PERM = true;
    bf16_t *CA, *CB, *CG; const float* rs;
    __device__ __forceinline__ void operator()(const f32x4 (&acc)[2][2][4][2], const Unit& u, int wr, int wc, int fr, int fq) const {
        const int row0 = u.pm * BM + wr * 64 + fr; const int pn = u.pn;
        bf16_t* base; int ldc, ct; const bool sg = pn >= 12;
        if (pn < 7) { base = CA; ldc = 1792; ct = pn; } else if (pn < 12) { base = CB; ldc = 1280; ct = pn - 7; } else { base = CG; ldc = 2048; ct = pn - 12; }
        const int col0 = ct * BM + wc * 32 + 8 * fq;
        float scv[2][4];
#pragma unroll
        for (int ai = 0; ai < 2; ++ai)
#pragma unroll
            for (int m = 0; m < 4; ++m) scv[ai][m] = rs ? rs[row0 + ai * HALF + m * 16] : 1.0f;
#pragma unroll
        for (int ai = 0; ai < 2; ++ai)
#pragma unroll
            for (int m = 0; m < 4; ++m) { bf16_t* rowp = base + (size_t)(row0 + ai * HALF + m * 16) * ldc + col0; const float sc_ = scv[ai][m];
#pragma unroll
                for (int bj = 0; bj < 2; ++bj) { f32x4 v0 = acc[ai][bj][m][0] * sc_, v1 = acc[ai][bj][m][1] * sc_;
                    if (sg) {
#pragma unroll
                        for (int j = 0; j < 4; ++j) { v0[j] = sigmoidf_(v0[j]); v1[j] = sigmoidf_(v1[j]); } }
                    u32x4 w; w.x = pk2(v0[0], v0[1]); w.y = pk2(v0[2], v0[3]); w.z = pk2(v1[0], v1[1]); w.w = pk2(v1[2], v1[3]);
                    *(u32x4*)(rowp + bj * HALF) = w; } }
    }
};
template <bool ADD> struct EpiMerge {
    static constexpr bool PERM = true;
    bf16_t* O; const bf16_t* gate; int gcol;
    __device__ __forceinline__ void operator()(const f32x4 (&acc)[2][2][4][2], const Unit& u, int wr, int wc, int fr, int fq) const {
        const int row0 = u.pm * BM + wr * 64 + fr, col0 = u.pn * BM + wc * 32 + 8 * fq;
        constexpr int NB_ = ADD ? 1 : 2;
#pragma unroll
        for (int a0 = 0; a0 < 2; a0 += NB_) {
            u32x4 gv[NB_][4][2], pv[NB_][4][2];
#pragma unroll
            for (int ab = 0; ab < NB_; ++ab)
#pragma unroll
                for (int m = 0; m < 4; ++m) { const size_t row = (size_t)(row0 + (a0 + ab) * HALF + m * 16);
#pragma unroll
                    for (int bj = 0; bj < 2; ++bj) { gv[ab][m][bj] = *(const u32x4*)(gate + row * 2048 + gcol + col0 + bj * HALF); if (ADD) pv[ab][m][bj] = *(const u32x4*)(O + row * 1024 + col0 + bj * HALF); } }
#pragma unroll
            for (int ab = 0; ab < NB_; ++ab) { const int ai = a0 + ab;
#pragma unroll
                for (int m = 0; m < 4; ++m) { const size_t row = (size_t)(row0 + ai * HALF + m * 16);
#pragma unroll
                    for (int bj = 0; bj < 2; ++bj) { const f32x4 v0 = acc[ai][bj][m][0], v1 = acc[ai][bj][m][1]; const u32x4 g = gv[ab][m][bj];
                        float o[8] = { bf_lo(g.x) * v0[0], bf_hi(g.x) * v0[1], bf_lo(g.y) * v0[2], bf_hi(g.y) * v0[3], bf_lo(g.z) * v1[0], bf_hi(g.z) * v1[1], bf_lo(g.w) * v1[2], bf_hi(g.w) * v1[3] };
                        if (ADD) { const u32x4 p = pv[ab][m][bj];
                            o[0] += bf_lo(p.x); o[1] += bf_hi(p.x); o[2] += bf_lo(p.y); o[3] += bf_hi(p.y); o[4] += bf_lo(p.z); o[5] += bf_hi(p.z); o[6] += bf_lo(p.w); o[7] += bf_hi(p.w); }
                        u32x4 w; w.x = pk2(o[0], o[1]); w.y = pk2(o[2], o[3]); w.z = pk2(o[4], o[5]); w.w = pk2(o[6], o[7]);
                        *(u32x4*)(O + row * 1024 + col0 + bj * HALF) = w; } } }
        }
    }
};
__device__ __forceinline__ float xsum4_(float x) {
    float a = x, b = x; asm volatile("s_nop 1\n\tv_permlane16_swap_b32 %0, %1" : "+v"(a), "+v"(b)); x = a + b; a = x; b = x;
    asm volatile("s_nop 1\n\tv_permlane32_swap_b32 %0, %1" : "+v"(a), "+v"(b)); return a + b; }
__device__ __forceinline__ float sq8_(u32x4 w) { const float a = bf_lo(w.x), b = bf_hi(w.x), c = bf_lo(w.y), d = bf_hi(w.y), e = bf_lo(w.z), f = bf_hi(w.z), g = bf_lo(w.w), h = bf_hi(w.w);
    return ((a * a + b * b) + (c * c + d * d)) + ((e * e + f * f) + (g * g + h * h)); }
struct EpiResid {
    static constexpr bool PERM = true;
    const void* xi; bf16_t* xo; int in_f32; float* part;
    __device__ __forceinline__ void operator()(const f32x4 (&acc)[2][2][4][2], const Unit& u, int wr, int wc, int fr, int fq) const {
        const int row0 = u.pm * BM + wr * 64 + fr, col0 = u.pn * BM + wc * 32 + 8 * fq;
        if (in_f32) {
            const float* xf = (const float*)xi;
#pragma unroll
            for (int ai = 0; ai < 2; ++ai) {
                f32x4 xv[4][2][2];
#pragma unroll
                for (int m = 0; m < 4; ++m) { const size_t o = (size_t)(row0 + ai * HALF + m * 16) * 1024 + col0;
#pragma unroll
                    for (int bj = 0; bj < 2; ++bj)
#pragma unroll
                        for (int n = 0; n < 2; ++n) xv[m][bj][n] = *(const f32x4*)(xf + o + bj * HALF + n * 4); }
#pragma unroll
                for (int m = 0; m < 4; ++m) { const size_t o = (size_t)(row0 + ai * HALF + m * 16) * 1024 + col0; float sq_ = 0.f;
#pragma unroll
                    for (int bj = 0; bj < 2; ++bj) { const f32x4 v0 = xv[m][bj][0] + acc[ai][bj][m][0], v1 = xv[m][bj][1] + acc[ai][bj][m][1];
                        u32x4 w; w.x = pk2(v0[0], v0[1]); w.y = pk2(v0[2], v0[3]); w.z = pk2(v1[0], v1[1]); w.w = pk2(v1[2], v1[3]);
                        *(u32x4*)(xo + o + bj * HALF) = w; sq_ += sq8_(w); }
                    if (part) { const float tot = xsum4_(sq_); if (fq == 0) part[(size_t)(row0 + ai * HALF + m * 16) * 16 + u.pn * 4 + wc] = tot; } }
            }
        } else {
            const bf16_t* xb = (const bf16_t*)xi;
#pragma unroll
            for (int ai = 0; ai < 2; ++ai) {
                u32x4 xv[2][4][2];
#pragma unroll
                for (int m = 0; m < 4; ++m) { const size_t o = (size_t)(row0 + ai * HALF + m * 16) * 1024 + col0;
#pragma unroll
                    for (int bj = 0; bj < 2; ++bj) xv[ai][m][bj] = *(const u32x4*)(xb + o + bj * HALF); }
#pragma unroll
                for (int m = 0; m < 4; ++m) { const size_t o = (size_t)(row0 + ai * HALF + m * 16) * 1024 + col0; float sq_ = 0.f;
#pragma unroll
                    for (int bj = 0; bj < 2; ++bj) { const u32x4 p = xv[ai][m][bj]; const f32x4 v0 = acc[ai][bj][m][0], v1 = acc[ai][bj][m][1];
                        u32x4 w; w.x = pk2(bf_lo(p.x) + v0[0], bf_hi(p.x) + v0[1]); w.y = pk2(bf_lo(p.y) + v0[2], bf_hi(p.y) + v0[3]);
                        w.z = pk2(bf_lo(p.z) + v1[0], bf_hi(p.z) + v1[1]); w.w = pk2(bf_lo(p.w) + v1[2], bf_hi(p.w) + v1[3]);
                        *(u32x4*)(xo + o + bj * HALF) = w; sq_ += sq8_(w); }
                    if (part) { const float tot = xsum4_(sq_); if (fq == 0) part[(size_t)(row0 + ai * HALF + m * 16) * 16 + u.pn * 4 + wc] = tot; } }
            }
        }
    }
};
struct EpiSwiGLU {
    static constexpr bool PERM = true;
    bf16_t* O; int ldc; const float* rs;
    __device__ __forceinline__ void operator()(const f32x4 (&acc)[2][2][4][2], const Unit& u, int wr, int wc, int fr, int fq) const {
        const int row0 = u.pm * BM + wr * 64 + fr, col0 = u.pn * HALF + wc * 32 + 8 * fq;
        float scv[2][4];
#pragma unroll
        for (int ai = 0; ai < 2; ++ai)
#pragma unroll
            for (int m = 0; m < 4; ++m) scv[ai][m] = rs ? rs[row0 + ai * HALF + m * 16] : 1.0f;
#pragma unroll
        for (int ai = 0; ai < 2; ++ai)
#pragma unroll
            for (int m = 0; m < 4; ++m) { const int row = row0 + ai * HALF + m * 16; const float sc_ = scv[ai][m];
                bf16_t* rowp = O + ((size_t)((row >> 6) * (ldc >> 4) + (col0 >> 4)) << 10) + (((row & 63) << 4) + (col0 & 15));
                float o[8];
#pragma unroll
                for (int n = 0; n < 2; ++n)
#pragma unroll
                    for (int j = 0; j < 4; ++j) { const float g = acc[ai][0][m][n][j] * sc_, up = acc[ai][1][m][n][j] * sc_; o[4 * n + j] = g * sigmoidf_(g) * up; }
                u32x4 w; w.x = pk2(o[0], o[1]); w.y = pk2(o[2], o[3]); w.z = pk2(o[4], o[5]); w.w = pk2(o[6], o[7]);
                *(u32x4*)rowp = w; }
    }
};
struct EpiMoeDown {
    static constexpr bool PERM = true;
    const bf16_t* xin; void* xout; const int* tok; const float* wgt; int out_f32; float* part;
    __device__ __forceinline__ void operator()(const f32x4 (&acc)[2][2][4][2], const Unit& u, int wr, int wc, int fr, int fq) const {
        const int row0 = u.pm * BM + wr * 64 + fr, col0 = u.pn * BM + wc * 32 + 8 * fq;
        int tk[2][4]; float wv[2][4];
#pragma unroll
        for (int ai = 0; ai < 2; ++ai)
#pragma unroll
            for (int m = 0; m < 4; ++m) { const int row = row0 + ai * HALF + m * 16; tk[ai][m] = tok[row]; wv[ai][m] = wgt[row]; }
#pragma unroll
        for (int ai = 0; ai < 2; ++ai) {
            u32x4 raw[4][2];
#pragma unroll
            for (int m = 0; m < 4; ++m) { const int t = tk[ai][m] < 0 ? 0 : tk[ai][m]; const bf16_t* xp = xin + (size_t)t * 1024 + col0;
#pragma unroll
                for (int bj = 0; bj < 2; ++bj) raw[m][bj] = *(const u32x4*)(xp + bj * HALF); }
#pragma unroll
            for (int m = 0; m < 4; ++m) { const bool ok = tk[ai][m] >= 0; const size_t ob = (size_t)(ok ? tk[ai][m] : 0) * 1024 + col0; float sq_ = 0.f;
#pragma unroll
                for (int bj = 0; bj < 2; ++bj) { const u32x4 p = raw[m][bj];
                    const f32x4 v0 = (f32x4){bf_lo(p.x), bf_hi(p.x), bf_lo(p.y), bf_hi(p.y)} + acc[ai][bj][m][0] * wv[ai][m], v1 = (f32x4){bf_lo(p.z), bf_hi(p.z), bf_lo(p.w), bf_hi(p.w)} + acc[ai][bj][m][1] * wv[ai][m];
                    if (out_f32) { if (ok) { float* xp_ = (float*)xout + ob + bj * HALF; *(f32x4*)xp_ = v0; *(f32x4*)(xp_ + 4) = v1; } }
                    else { u32x4 w_; w_.x = pk2(v0[0], v0[1]); w_.y = pk2(v0[2], v0[3]); w_.z = pk2(v1[0], v1[1]); w_.w = pk2(v1[2], v1[3]);
                        if (ok) *(u32x4*)((bf16_t*)xout + ob + bj * HALF) = w_; sq_ += sq8_(w_); } }
                if (part) { const float tot = xsum4_(sq_); if (ok && fq == 0) part[(size_t)tk[ai][m] * 16 + u.pn * 4 + wc] = tot; } }
        }
    }
};

template <class Epi, class Sched, bool GATHER = false, bool ABLK = false>
__device__ __forceinline__ void gemm_phase(PG8_LAS unsigned char* lds, const Gemm g, const Sched& S, const Epi& E, int tid_) {
    asm volatile("" : "+v"(tid_));
    const int tid = tid_, wid = __builtin_amdgcn_readfirstlane(tid >> 6), lane = tid & 63, wr = wid >> 2, wc = wid & 3, fr = lane & 15, fq = lane >> 4;
    const int K = g.K, nt = K / BK;
    unsigned voffA[2], voffB[2];
#pragma unroll
    for (int i = 0; i < 2; ++i) { int R, C; stage_rc(tid * 16 + i * 8192, R, C); const int Rb = Epi::PERM ? ((R & ~31) + perm32(R & 31)) : R;
        voffA[i] = ABLK ? (unsigned)(((R >> 6) * (K >> 4) + (C >> 4)) * 2048 + (((R & 63) << 4) + (C & 15)) * 2) : (unsigned)(R * K + C) * 2u; voffB[i] = (unsigned)(Rb * K + C) * 2u; }
    const size_t kstep = (size_t)(BK * 2);
    const size_t hstep = (size_t)HALF * K * 2;
    const size_t tstep = 2 * hstep;
    const size_t hstepA = ABLK ? (size_t)2 * (K >> 4) * 2048 : hstep, tstepA = 2 * hstepA; constexpr size_t AKM = ABLK ? 64 : 1;
    const unsigned ldsw = (unsigned)wid * 1024u;
    const int aoff = lds_byte(wr * 64 + fr, fq * 8), boff = lds_byte(wc * 32 + fr, fq * 8);
    unsigned gvo[2][2];
#define PG8_SA(b, h) (((b) * 2 + (h)) * HTB)
#define PG8_SB(b, h) ((4 + (b) * 2 + (h)) * HTB)
#define PG8_STAGE(bufoff, gbase, voff) do { _Pragma("unroll") for (int _i = 0; _i < 2; ++_i) \
        __builtin_amdgcn_global_load_lds((const unsigned*)((const char*)(gbase) + (voff)[_i]), (PG8_LAS unsigned*)(lds + (bufoff) + ldsw + _i * 8192), 16, 0, 0); } while (0)
#define PG8_STAGE_A(bufoff, h, ubase, kb, nx) do { if constexpr (GATHER) { PG8_STAGE(bufoff, (const char*)g.A + (kb), gvo[h]); } \
        else { PG8_STAGE(bufoff, (ubase) + (kb) * AKM + (h) * hstepA, voffA); } } while (0)
#define PG8_LOADROWS(dst, unit) do { if constexpr (GATHER) { _Pragma("unroll") for (int _i = 0; _i < 2; ++_i) { int _R, _C; stage_rc(tid * 16 + _i * 8192, _R, _C); \
        _Pragma("unroll") for (int _h = 0; _h < 2; ++_h) { int _t = g.rowidx[(unit).pm * BM + _h * HALF + _R]; _t = _t < 0 ? 0 : _t; dst[_h][_i] = (unsigned)(_t * K + _C) * 2u; } } } } while (0)
#define PG8_LDA(dst, b, h) do { _Pragma("unroll") for (int m = 0; m < 4; ++m) _Pragma("unroll") for (int k = 0; k < 2; ++k) dst[m][k] = *(const PG8_LAS bf16x8*)(lds + PG8_SA(b, h) + aoff + m * 2048 + k * 1024); } while (0)
#define PG8_LDB(dst, b, h) do { _Pragma("unroll") for (int n = 0; n < 2; ++n) _Pragma("unroll") for (int k = 0; k < 2; ++k) dst[n][k] = *(const PG8_LAS bf16x8*)(lds + PG8_SB(b, h) + boff + n * 2048 + k * 1024); } while (0)
#define PG8_MMA(ai, bj, At, Bt) do { __builtin_amdgcn_s_setprio(1); _Pragma("unroll") for (int m = 0; m < 4; ++m) _Pragma("unroll") for (int n = 0; n < 2; ++n) _Pragma("unroll") for (int k = 0; k < 2; ++k) \
        acc[ai][bj][m][n] = __builtin_amdgcn_mfma_f32_16x16x32_bf16(Bt[n][k], At[m][k], acc[ai][bj][m][n], 0, 0, 0); __builtin_amdgcn_s_setprio(0); } while (0)
#define PG8_WAIT_V(n) asm volatile("s_waitcnt vmcnt(" #n ")" ::: "memory")
#define PG8_WAIT_L(n) asm volatile("s_waitcnt lgkmcnt(" #n ")" ::: "memory")
#define PG8_BAR __builtin_amdgcn_s_barrier()
#define PG8_SCHED __builtin_amdgcn_sched_barrier(0)
    Unit cur, nxt; int ui = 0;
    if (!S.next(0, cur)) return;
    f32x4 acc[2][2][4][2];
#pragma unroll
    for (int a = 0; a < 2; ++a)
#pragma unroll
        for (int b = 0; b < 2; ++b)
#pragma unroll
            for (int m = 0; m < 4; ++m)
#pragma unroll
                for (int n = 0; n < 2; ++n) acc[a][b][m][n] = zf4();
    bf16x8 At[4][2], B0[2][2], B1[2][2];
    const char* cA = GATHER ? (const char*)g.A : (const char*)g.A + (size_t)cur.pm * tstepA;
    const char* cB = (const char*)g.Bt + ((size_t)cur.e * g.bstride) * 2 + (size_t)cur.pn * tstep;
    PG8_LOADROWS(gvo, cur);
    PG8_STAGE(PG8_SB(0, 0), cB, voffB); PG8_STAGE(PG8_SB(0, 1), cB + hstep, voffB); PG8_STAGE_A(PG8_SA(0, 0), 0, cA, 0, false); PG8_STAGE_A(PG8_SA(0, 1), 1, cA, 0, false);
    if (wr == 1) PG8_BAR;
    PG8_WAIT_V(2); PG8_BAR;
    PG8_STAGE(PG8_SB(1, 0), cB + kstep, voffB); PG8_STAGE_A(PG8_SA(1, 0), 0, cA, kstep, false); PG8_STAGE(PG8_SB(1, 1), cB + hstep + kstep, voffB);
    PG8_WAIT_V(6); PG8_BAR;
    for (;;) {
        const bool has_next = S.next(ui + 1, nxt);
        const char* nA = GATHER ? (const char*)g.A : (has_next ? (const char*)g.A + (size_t)nxt.pm * tstepA : cA);
        const char* nB = has_next ? (const char*)g.Bt + ((size_t)nxt.e * g.bstride) * 2 + (size_t)nxt.pn * tstep : cB;
        for (int t = 0; t < nt; t += 2) {
            const bool last = (t == nt - 2);
            const size_t k1 = (size_t)(t + 1) * kstep;
            const size_t k2 = last ? 0 : (size_t)(t + 2) * kstep, k3 = k2 + kstep;
            const char* a2b = last ? nA : cA; const char* b2 = (last ? nB : cB) + k2; const char* b3 = b2 + kstep;
            PG8_LDB(B0, 0, 0); PG8_LDB(B1, 0, 1); PG8_SCHED; PG8_LDA(At, 0, 0); PG8_STAGE_A(PG8_SA(1, 1), 1, cA, k1, false);
            if (last && has_next) PG8_LOADROWS(gvo, nxt);
            PG8_WAIT_V(8); PG8_WAIT_L(0); PG8_BAR; PG8_MMA(0, 0, At, B0); PG8_MMA(0, 1, At, B1); PG8_BAR; PG8_SCHED;
            PG8_LDA(At, 0, 1); PG8_STAGE(PG8_SB(0, 0), b2, voffB); PG8_STAGE(PG8_SB(0, 1), b2 + hstep, voffB); PG8_STAGE_A(PG8_SA(0, 0), 0, a2b, k2, last);
            PG8_WAIT_V(8); PG8_WAIT_L(0); PG8_BAR; PG8_MMA(1, 0, At, B0); PG8_MMA(1, 1, At, B1); PG8_BAR; PG8_SCHED;
            PG8_LDB(B0, 1, 0); PG8_LDB(B1, 1, 1); PG8_SCHED; PG8_LDA(At, 1, 0); PG8_STAGE_A(PG8_SA(0, 1), 1, a2b, k2, last);
            PG8_WAIT_V(8); PG8_WAIT_L(0); PG8_BAR; PG8_MMA(0, 0, At, B0); PG8_MMA(0, 1, At, B1); PG8_BAR; PG8_SCHED;
            PG8_LDA(At, 1, 1); PG8_STAGE(PG8_SB(1, 0), b3, voffB); PG8_STAGE(PG8_SB(1, 1), b3 + hstep, voffB); PG8_STAGE_A(PG8_SA(1, 0), 0, a2b, k3, last);
            PG8_WAIT_V(8); PG8_WAIT_L(0); PG8_BAR; PG8_MMA(1, 0, At, B0); PG8_MMA(1, 1, At, B1); PG8_BAR; PG8_SCHED;
        }
        if (wr == 0) PG8_BAR;
        E(acc, cur, wr, wc, fr, fq);
        if (!has_next) break;
#pragma unroll
        for (int a = 0; a < 2; ++a)
#pragma unroll
            for (int b = 0; b < 2; ++b)
#pragma unroll
                for (int m = 0; m < 4; ++m)
#pragma unroll
                    for (int n = 0; n < 2; ++n) acc[a][b][m][n] = zf4();
        cur = nxt; cA = nA; cB = nB; ++ui;
        if (wr == 1) PG8_BAR;
    }
    PG8_WAIT_V(0);
    PG8_BAR;
#undef PG8_SA
#undef PG8_SB
#undef PG8_STAGE
#undef PG8_STAGE_A
#undef PG8_LOADROWS
#undef PG8_LDA
#undef PG8_LDB
#undef PG8_MMA
#undef PG8_WAIT_V
#undef PG8_WAIT_L
#undef PG8_BAR
#undef PG8_SCHED
}
}
using pg8::bf16_t; using pg8::bf16x8; using pg8::f32x4; using pg8::f32x2; using pg8::u32x4; using pg8::u32x2; using pg8::pk2; using pg8::bf2f; using pg8::f2bf; using pg8::bf_lo; using pg8::bf_hi; using pg8::sigmoidf_;

constexpr int NWAVES = 8, NTHR = 512;
constexpr int D = 1024, NB = 32, SEQ = 2048, T = NB * SEQ, TH = T / 2, DEPTH = 4;
constexpr int RW_COLS = 1792, DS_COLS = 1224, DS_PAD = 1280, N_IN = 5064, N_INP = 5120;
constexpr int NMEM = 256, MEMROWS = NB * NMEM;
constexpr int FFN = 2816, NEXP = 8, EDIM = 1408;
constexpr int MOE_ROWS_MAX = 2 * T + 16 * 256;
constexpr int MOE_TILES_MAX = MOE_ROWS_MAX / 256;

constexpr size_t MiB = 1u << 20;
constexpr size_t WS_CTL = 0, CTL_ZERO_BYTES = 1 * MiB;
constexpr size_t WS_MOE = 1 * MiB;
constexpr size_t MOE_SELE = WS_MOE, MOE_SELW = MOE_SELE + (size_t)T * 2, MOE_ROWTOK = MOE_SELW + (size_t)T * 8, MOE_ROWW = MOE_ROWTOK + (size_t)MOE_ROWS_MAX * 4,
                 MOE_TILEE = MOE_ROWW + (size_t)MOE_ROWS_MAX * 4, MOE_META = MOE_TILEE + (size_t)MOE_TILES_MAX * 4, MOE_END = MOE_META + 256;
constexpr size_t WS_RS = WS_CTL + 512 * 1024;
constexpr size_t MOE_ROWRS = 3 * MiB;
static_assert(MOE_END <= MOE_ROWRS && MOE_ROWRS + (size_t)MOE_ROWS_MAX * 4 <= 4 * MiB && WS_RS + (size_t)T * 4 <= CTL_ZERO_BYTES, "moe map");
constexpr size_t WS_W = 4 * MiB;
constexpr size_t W_IN = WS_W, W_BA = W_IN + (size_t)N_INP * D * 2, W_BB = W_BA + (size_t)D * 512 * 2, W_OUT = W_BB + (size_t)D * 512 * 2, W_MQ = W_OUT + (size_t)D * D * 2,
                 W_MO = W_MQ + (size_t)512 * D * 2, W_FF = W_MO + (size_t)D * 512 * 2;
constexpr size_t W_RW2 = W_FF, W_RA2 = W_RW2 + 512 * 64 * 2, W_RG2 = W_RA2 + 512 * 64 * 2, W_RV1 = W_RG2 + 512 * 128 * 2, W_RV2 = W_RV1 + 32 * 512 * 2, W_FF2 = W_RV2 + 512 * 32 * 2;
constexpr size_t W_FGU = W_FF2, W_FD = W_FGU + (size_t)2 * FFN * D * 2;
constexpr size_t W_EGU = W_FF2, W_ED = W_EGU + (size_t)NEXP * 2 * EDIM * D * 2, W_END = W_ED + (size_t)NEXP * D * EDIM * 2;
static_assert(W_FD + (size_t)D * FFN * 2 <= W_END, "w map");
constexpr size_t WS_WKV = (W_END + MiB - 1) / MiB * MiB;
constexpr size_t WS_MEMH = WS_WKV + (size_t)4096 * D * 2;
constexpr size_t WS_MEMK = WS_MEMH + (size_t)MEMROWS * D * 2;
constexpr size_t WS_MEMVT = WS_MEMK + (size_t)DEPTH * MEMROWS * 512 * 2;
constexpr size_t WS_VFIRST = WS_MEMVT + (size_t)DEPTH * MEMROWS * 512 * 2;
constexpr size_t WS_HN = WS_VFIRST + (size_t)T * 512 * 2;
constexpr size_t WS_MIX = WS_HN + (size_t)T * D * 2;
constexpr size_t MX_CA = WS_MIX, MX_CB = MX_CA + (size_t)TH * RW_COLS * 2, MX_CG = MX_CB + (size_t)TH * DS_PAD * 2, MX_RW = MX_CG + (size_t)TH * 2048 * 2;
constexpr size_t RW_ARR = (size_t)TH * 512 * 2;
constexpr size_t MX_VT = MX_RW + 7 * RW_ARR, MX_YB = MX_VT + (size_t)(NB / 2) * 64 * SEQ * 2, MX_END = MX_YB + (size_t)TH * 512 * 2;
constexpr size_t MA_QM = WS_MIX, MA_OM = MA_QM + (size_t)T * 512 * 2;
constexpr size_t FF_GU = WS_MIX;
constexpr size_t PR_KVRAW = WS_MIX;
constexpr size_t WS_XS2 = WS_MIX + 364 * MiB;
static_assert(FF_GU + (size_t)MOE_ROWS_MAX * EDIM * 2 <= WS_XS2 && FF_GU + (size_t)T * FFN * 2 <= WS_XS2 && MA_OM + (size_t)T * 512 * 2 <= WS_XS2, "last-layer stream");
constexpr size_t MX_BS = MX_END;
constexpr size_t WS_END = MX_BS + (size_t)TH * 8 * 4;
static_assert(FF_GU + (size_t)T * FFN * 2 <= WS_END && FF_GU + (size_t)MOE_ROWS_MAX * EDIM * 2 <= WS_END && MA_OM + (size_t)T * 512 * 2 <= WS_END, "overlay map");
constexpr size_t WS_PART = WS_END;
constexpr size_t WS_END2 = WS_PART + (size_t)T * 16 * 4;
static_assert(WS_END2 <= 1000 * MiB, "workspace budget 2");
static_assert(WS_END <= 1000 * MiB && WS_XS2 + (size_t)T * D * 2 <= WS_END, "workspace budget");

constexpr int LDS_BYTES = 160 * 1024;
constexpr int LDS_MISC = LDS_BYTES - 256;

#define XB_TMO      128
#define XB_XCNT(j)  (256  + 64 * (j))
#define XB_XSUB(j)  (1280 + 64 * (j))
#define XB_XGEN(j)  (2304 + 64 * (j))
#define XB_TOP      3328
#define XB_TOPGEN   3392
#define XCD_BAR_WORDS 3456
#define XB_SPIN_CAP (1u << 18)
#define LAS __attribute__((address_space(3)))

__device__ __forceinline__ unsigned xb_ld(unsigned* p)              { return __hip_atomic_load(p, __ATOMIC_RELAXED, __HIP_MEMORY_SCOPE_AGENT); }
__device__ __forceinline__ unsigned xb_add(unsigned* p, unsigned v) { return __hip_atomic_fetch_add(p, v, __ATOMIC_RELAXED, __HIP_MEMORY_SCOPE_AGENT); }
__device__ __forceinline__ unsigned xb_xcc_id() { return (unsigned)__builtin_amdgcn_s_getreg((3 << 11) | 20) & 0xFu; }
#define XB_SPIN(cond, bar) do { unsigned _sp = 0; while (cond) { __builtin_amdgcn_s_sleep(1); \
    if ((++_sp & 255u) == 0u) { if (xb_ld(&(bar)[XB_TMO])) break; if (_sp > XB_SPIN_CAP) { atomicAdd(&(bar)[XB_TMO], 1u); break; } } } } while (0)
struct XcdBarrier { unsigned* bar; unsigned x; volatile LAS unsigned* st; };
__device__ __forceinline__ XcdBarrier xcd_barrier_post(unsigned* bar, volatile LAS unsigned* st) {
    XcdBarrier b; b.bar = bar; b.x = xb_xcc_id(); b.st = st;
    if (threadIdx.x == 0) (void)xb_add(&bar[XB_XCNT(b.x)], 1u);
    return b;
}
__device__ __forceinline__ void xcd_barrier_complete(unsigned* bar, unsigned x, unsigned& nloc, unsigned& nx) {
    const unsigned G = gridDim.x * gridDim.y * gridDim.z;
    unsigned sum, cnt, mine, sp = 0u;
    for (;;) {
        sum = 0u; cnt = 0u; mine = 0u;
#pragma unroll
        for (unsigned j = 0; j < 16; ++j) { const unsigned c = xb_ld(&bar[XB_XCNT(j)]); sum += c; cnt += (c > 0u) ? 1u : 0u; mine = (j == x) ? c : mine; }
        if (sum == G) break;
        __builtin_amdgcn_s_sleep(1);
        if ((++sp & 255u) == 0u) { if (xb_ld(&bar[XB_TMO])) break; if (sp > XB_SPIN_CAP) { atomicAdd(&bar[XB_TMO], 1u); break; } }
    }
    nloc = mine > 0u ? mine : 1u; nx = cnt > 0u ? cnt : 1u;
}
__device__ __forceinline__ void xcd_barrier(const XcdBarrier& b, int tid) {
    asm volatile("s_waitcnt vmcnt(0)" ::: "memory");
    __syncthreads();
    if (tid == 0) {
        unsigned* bar = b.bar; asm volatile("" : "+s"(bar));
        __builtin_amdgcn_s_waitcnt(0);
        unsigned nloc = b.st[0], nx = b.st[1];
        if (nloc == 0u) { xcd_barrier_complete(bar, b.x, nloc, nx); b.st[0] = nloc; b.st[1] = nx; }
        const unsigned old = xb_add(&bar[XB_XSUB(b.x)], 1u);
        const unsigned gen = old / nloc;
        if (old + 1u == (gen + 1u) * nloc) {
            __builtin_amdgcn_fence(__ATOMIC_RELEASE, "agent");
            asm volatile("s_waitcnt vmcnt(0)" ::: "memory");
            const unsigned og = xb_add(&bar[XB_TOP], 1u);
            const unsigned tg = og / nx;
            if (og + 1u == (tg + 1u) * nx) xb_add(&bar[XB_TOPGEN], 1u);
            else XB_SPIN(xb_ld(&bar[XB_TOPGEN]) == tg, bar);
            __builtin_amdgcn_fence(__ATOMIC_ACQUIRE, "agent");
            xb_add(&bar[XB_XGEN(b.x)], 1u);
            asm volatile("s_waitcnt vmcnt(0)" ::: "memory");
        } else {
            XB_SPIN(xb_ld(&bar[XB_XGEN(b.x)]) == gen, bar);
            __builtin_amdgcn_fence(__ATOMIC_ACQUIRE, "agent");
            asm volatile("s_waitcnt vmcnt(0)" ::: "memory");
        }
    }
    __syncthreads();
}

struct Args { const void* in[41]; float* out; unsigned char* ws; int ph_lo, ph_hi; };
static_assert(sizeof(Args) == 41 * 8 + 8 + 8 + 8, "Args has no padding");

enum InIdx { I_X = 0, I_MEM, I_POS, I_NORM_MIX, I_W_IN, I_MU, I_W0, I_W2, I_A0, I_A2, I_G2, I_V0, I_V1, I_V2, I_KK, I_KA, I_RK, I_LNG, I_LNB, I_QN, I_KN, I_IKN,
             I_WBA, I_WBB, I_WOUT, I_NORM_MEM, I_MEM_TOKN, I_MWQ, I_MWKV, I_MQN, I_MKN, I_MWO, I_NORM_FFN, I_FWG, I_FWU, I_FWD, I_ROUTER, I_RBIAS, I_EWG, I_EWU, I_EWD };

typedef decltype(__builtin_amdgcn_kernarg_segment_ptr()) kptr_t;
struct Frame {
    LAS unsigned char* lds; unsigned char* ws; kptr_t kb; float* out;
    int tid, lane, wave, G, bid;
};
#define LDS_WAIT() asm volatile("s_waitcnt lgkmcnt(0)" ::: "memory")
__device__ __forceinline__ const void* kargp(kptr_t kb, int i) { typedef const void* cvp; typedef __attribute__((address_space(4))) const cvp* tab_t; return (const void*)(const __attribute__((address_space(1))) void*)(((tab_t)kb)[i]); }
#define KARGP(F, i) kargp((F).kb, (i))
#define FIN(F, i) ((const float*)KARGP(F, i))
__device__ __forceinline__ void lds_barrier() { asm volatile("s_waitcnt lgkmcnt(0)" ::: "memory"); __builtin_amdgcn_s_barrier(); asm volatile("" ::: "memory"); }

template <int CTRL> __device__ __forceinline__ float dppf(float x) { return __builtin_bit_cast(float, __builtin_amdgcn_mov_dpp(__builtin_bit_cast(int, x), CTRL, 0xf, 0xf, true)); }
template <int CTRL> __device__ __forceinline__ unsigned dppu(unsigned x) { return (unsigned)__builtin_amdgcn_mov_dpp((int)x, CTRL, 0xf, 0xf, true); }
__device__ __forceinline__ float sum8(float v) { v += dppf<0xB1>(v); v += dppf<0x4E>(v); v += dppf<0x141>(v); return v; }
__device__ __forceinline__ unsigned or8(unsigned v) { v |= dppu<0xB1>(v); v |= dppu<0x4E>(v); v |= dppu<0x141>(v); return v; }
__device__ __forceinline__ void swap16(float& a, float& b) { asm volatile("s_nop 1\n\tv_permlane16_swap_b32 %0, %1" : "+v"(a), "+v"(b)); }
__device__ __forceinline__ void swap32(float& a, float& b) { asm volatile("s_nop 1\n\tv_permlane32_swap_b32 %0, %1" : "+v"(a), "+v"(b)); }
__device__ __forceinline__ float xrow_sum(float x) {
    float a = x, b = x; swap16(a, b); x = a + b; a = x; b = x; swap32(a, b); return a + b;
}
__device__ __forceinline__ float xrow_max(float x) {
    float a = x, b = x; swap16(a, b); x = fmaxf(a, b); a = x; b = x; swap32(a, b); return fmaxf(a, b);
}
__device__ __forceinline__ float wave_sum(float v) { v = sum8(v); v += dppf<0x140>(v); return xrow_sum(v); }

template <class Map, bool FRAG = false>
__device__ __forceinline__ void transpose_item(const float* W, int K, int N, bf16_t* WT, const Map& map, const float* gain, LAS float* scr, int item, int lane) {
    const int nblk = (N + 31) / 32, kb = item / nblk, nb = item % nblk, k0 = 64 * kb, n0 = 32 * nb;
    const int nn = n0 + (lane & 31);
    float vv[32], gg[32];
#pragma unroll
    for (int i = 0; i < 32; ++i) { const int kk = 2 * i + (lane >> 5); vv[i] = 0.f; gg[i] = 1.f; if (nn < N && k0 + kk < K) { vv[i] = W[(size_t)(k0 + kk) * N + nn]; if (gain) gg[i] = gain[k0 + kk]; } }
#pragma unroll
    for (int i = 0; i < 32; ++i) { const int kk = 2 * i + (lane >> 5); scr[kk * 33 + (lane & 31)] = vv[i] * gg[i]; }
    LDS_WAIT(); asm volatile("" ::: "memory");
    const int c = lane & 7;
#pragma unroll
    for (int j = 0; j < 4; ++j) { const int n = (lane >> 3) + 8 * j; const LAS float* s = scr + (8 * c) * 33 + n;
        u32x4 o; o.x = pk2(s[0 * 33], s[1 * 33]); o.y = pk2(s[2 * 33], s[3 * 33]); o.z = pk2(s[4 * 33], s[5 * 33]); o.w = pk2(s[6 * 33], s[7 * 33]);
        if (n0 + n < N && k0 + 8 * c < K) { const int nn_ = map(n0 + n), kk_ = k0 + 8 * c;
            const size_t off_ = FRAG ? ((((size_t)(nn_ >> 4) * (K >> 5) + (kk_ >> 5)) * 64 + ((kk_ >> 3) & 3) * 16 + (nn_ & 15)) * 8) : ((size_t)nn_ * K + kk_);
            *(u32x4*)(WT + off_) = o; } }
    LDS_WAIT(); asm volatile("" ::: "memory");
}
struct MapId { int off; __device__ int operator()(int n) const { return n + off; } };
struct MapWin { __device__ int operator()(int n) const { return n < 3016 ? n : n + 56; } };
struct MapGU { int up; __device__ int operator()(int n) const { return (n >> 7) * 256 + up * 128 + (n & 127); } };

__device__ __forceinline__ void rms_row_to_bf16(const float* xrow, bf16_t* orow, int lane, f32x4 (&v)[4]) {
    const f32x4* xr = (const f32x4*)xrow + lane; float s = 0.f;
#pragma unroll
    for (int j = 0; j < 4; ++j) { v[j] = xr[64 * j]; s += (v[j].x * v[j].x + v[j].y * v[j].y) + (v[j].z * v[j].z + v[j].w * v[j].w); }
    const float rstd = 1.0f / sqrtf(wave_sum(s) * (1.f / D) + 1e-6f);
    u32x2* o8 = (u32x2*)orow + lane;
#pragma unroll
    for (int j = 0; j < 4; ++j) { v[j] = v[j] * rstd; u32x2 w; w.x = pk2(v[j].x, v[j].y); w.y = pk2(v[j].z, v[j].w); o8[64 * j] = w; }
}

__device__ __forceinline__ void rms_pass_to_bf16(const float* x, bf16_t* o, int first, int stride, int lane) {
    f32x4 v[4][4], n[4][4];
#pragma unroll
    for (int r = 0; r < 4; ++r) { const f32x4* xr = (const f32x4*)(x + (size_t)(first + r * stride) * D) + lane;
#pragma unroll
        for (int j = 0; j < 4; ++j) n[r][j] = xr[64 * j]; }
#pragma unroll 1
    for (int m0 = first; m0 < T; m0 += 4 * stride) {
#pragma unroll
        for (int r = 0; r < 4; ++r)
#pragma unroll
            for (int j = 0; j < 4; ++j) { v[r][j] = n[r][j]; asm volatile("" : "+v"(v[r][j])); }
        { const int mn = (m0 + 4 * stride < T) ? m0 + 4 * stride : m0;
#pragma unroll
          for (int r = 0; r < 4; ++r) { const f32x4* xr = (const f32x4*)(x + (size_t)(mn + r * stride) * D) + lane;
#pragma unroll
              for (int j = 0; j < 4; ++j) n[r][j] = xr[64 * j]; }
          asm volatile("" ::: "memory"); }
        float s[4];
#pragma unroll
        for (int r = 0; r < 4; ++r) { s[r] = 0.f;
#pragma unroll
            for (int j = 0; j < 4; ++j) s[r] += (v[r][j].x * v[r][j].x + v[r][j].y * v[r][j].y) + (v[r][j].z * v[r][j].z + v[r][j].w * v[r][j].w); }
#pragma unroll
        for (int r = 0; r < 4; ++r) s[r] = wave_sum(s[r]);
#pragma unroll
        for (int r = 0; r < 4; ++r) { const float rstd = 1.0f / sqrtf(s[r] * (1.f / D) + 1e-6f); u32x2* o8 = (u32x2*)(o + (size_t)(m0 + r * stride) * D) + lane;
#pragma unroll
            for (int j = 0; j < 4; ++j) { const f32x4 t = v[r][j] * rstd; u32x2 w; w.x = pk2(t.x, t.y); w.y = pk2(t.z, t.w); o8[64 * j] = w; } }
    }
}
__device__ __forceinline__ void rms_pass_bf16in(const bf16_t* x, bf16_t* o, int first, int stride, int lane) {
    f32x4 v[4][4]; u32x2 n[4][4];
#pragma unroll
    for (int r = 0; r < 4; ++r) { const u32x2* xr = (const u32x2*)(x + (size_t)(first + r * stride) * D) + lane;
#pragma unroll
        for (int j = 0; j < 4; ++j) n[r][j] = xr[64 * j]; }
#pragma unroll 1
    for (int m0 = first; m0 < T; m0 += 4 * stride) {
#pragma unroll
        for (int r = 0; r < 4; ++r)
#pragma unroll
            for (int j = 0; j < 4; ++j) { u32x2 t_ = n[r][j]; asm volatile("" : "+v"(t_)); v[r][j] = (f32x4){bf_lo(t_.x), bf_hi(t_.x), bf_lo(t_.y), bf_hi(t_.y)}; }
        { const int mn = (m0 + 4 * stride < T) ? m0 + 4 * stride : m0;
#pragma unroll
          for (int r = 0; r < 4; ++r) { const u32x2* xr = (const u32x2*)(x + (size_t)(mn + r * stride) * D) + lane;
#pragma unroll
              for (int j = 0; j < 4; ++j) n[r][j] = xr[64 * j]; }
          asm volatile("" ::: "memory"); }
        float s[4];
#pragma unroll
        for (int r = 0; r < 4; ++r) { s[r] = 0.f;
#pragma unroll
            for (int j = 0; j < 4; ++j) s[r] += (v[r][j].x * v[r][j].x + v[r][j].y * v[r][j].y) + (v[r][j].z * v[r][j].z + v[r][j].w * v[r][j].w); }
#pragma unroll
        for (int r = 0; r < 4; ++r) s[r] = wave_sum(s[r]);
#pragma unroll
        for (int r = 0; r < 4; ++r) { const float rstd = 1.0f / sqrtf(s[r] * (1.f / D) + 1e-6f); u32x2* o8 = (u32x2*)(o + (size_t)(m0 + r * stride) * D) + lane;
#pragma unroll
            for (int j = 0; j < 4; ++j) { const f32x4 t = v[r][j] * rstd; u32x2 w; w.x = pk2(t.x, t.y); w.y = pk2(t.z, t.w); o8[64 * j] = w; } }
    }
}
__device__ __forceinline__ void rstd_pass_bf16in(const bf16_t* x, float* rs, int first, int stride, int lane) {
    f32x4 v[4][4]; u32x2 n[4][4];
#pragma unroll
    for (int r = 0; r < 4; ++r) { const u32x2* xr = (const u32x2*)(x + (size_t)(first + r * stride) * D) + lane;
#pragma unroll
        for (int j = 0; j < 4; ++j) n[r][j] = xr[64 * j]; }
#pragma unroll 1
    for (int m0 = first; m0 < T; m0 += 4 * stride) {
#pragma unroll
        for (int r = 0; r < 4; ++r)
#pragma unroll
            for (int j = 0; j < 4; ++j) { u32x2 t_ = n[r][j]; asm volatile("" : "+v"(t_)); v[r][j] = (f32x4){bf_lo(t_.x), bf_hi(t_.x), bf_lo(t_.y), bf_hi(t_.y)}; }
        { const int mn = (m0 + 4 * stride < T) ? m0 + 4 * stride : m0;
#pragma unroll
          for (int r = 0; r < 4; ++r) { const u32x2* xr = (const u32x2*)(x + (size_t)(mn + r * stride) * D) + lane;
#pragma unroll
              for (int j = 0; j < 4; ++j) n[r][j] = xr[64 * j]; }
          asm volatile("" ::: "memory"); }
        float s[4];
#pragma unroll
        for (int r = 0; r < 4; ++r) { s[r] = 0.f;
#pragma unroll
            for (int j = 0; j < 4; ++j) s[r] += (v[r][j].x * v[r][j].x + v[r][j].y * v[r][j].y) + (v[r][j].z * v[r][j].z + v[r][j].w * v[r][j].w); }
#pragma unroll
        for (int r = 0; r < 4; ++r) s[r] = wave_sum(s[r]);
#pragma unroll
        for (int r = 0; r < 4; ++r) { const float rstd = 1.0f / sqrtf(s[r] * (1.f / D) + 1e-6f); if (lane == 0) rs[m0 + r * stride] = rstd; }
    }
}
__device__ __forceinline__ void rs_finalize(Frame& F) {
    const float* pp = (const float*)(F.ws + WS_PART); float* rs = (float*)(F.ws + WS_RS);
    for (int rt = F.bid; rt < T / 256; rt += F.G) if (F.tid < 256) { const int row = rt * 256 + F.tid; const f32x4* p4 = (const f32x4*)(pp + (size_t)row * 16); const f32x4 a = p4[0], b = p4[1], c = p4[2], d = p4[3];
        const float t_ = (((a.x + a.y) + (a.z + a.w)) + ((b.x + b.y) + (b.z + b.w))) + (((c.x + c.y) + (c.z + c.w)) + ((d.x + d.y) + (d.z + d.w))); rs[row] = 1.0f / sqrtf(t_ * (1.f / D) + 1e-6f); }
}
__device__ __forceinline__ void ph_prologue0(Frame& F) {
    LAS float* scr = (LAS float*)(F.lds + F.wave * 16384);
    const int gw = F.bid * NWAVES + F.wave, NGW = F.G * NWAVES;
    bf16_t* wkv = (bf16_t*)(F.ws + WS_WKV);
    constexpr int IT = (D / 64) * (1024 / 32);
    for (int it = gw; it < DEPTH * IT; it += NGW) { const int l = it / IT, r = it % IT;
        transpose_item(FIN(F, I_MWKV) + (size_t)l * D * 1024, D, 1024, wkv, MapId{l * 1024}, FIN(F, I_MEM_TOKN) + l * D, scr, r, F.lane); }
    bf16_t* mh = (bf16_t*)(F.ws + WS_MEMH);
    for (int m = gw; m < MEMROWS; m += NGW) { f32x4 v[4]; rms_row_to_bf16(FIN(F, I_MEM) + (size_t)m * D, mh + (size_t)m * D, F.lane, v); }
}
__device__ __forceinline__ void ph_prologue2(Frame& F) {
    const int gw = F.bid * NWAVES + F.wave;
    const bf16_t* kv = (const bf16_t*)(F.ws + PR_KVRAW);
    bf16_t* MK = (bf16_t*)(F.ws + WS_MEMK); bf16_t* MVT = (bf16_t*)(F.ws + WS_MEMVT);
    LAS unsigned* vl = (LAS unsigned*)(F.lds + F.wave * (64 * 65 * 4));
    for (int wv = gw; wv < (MEMROWS / 64) * 16; wv += F.G * NWAVES) {
        const int l = (wv >> 2) & 3, hh = wv & 3, r0 = (wv >> 4) * 64, b = r0 >> 8, m0 = r0 & 255;
        const float g0 = FIN(F, I_MKN)[l * 128 + 2 * F.lane], g1 = FIN(F, I_MKN)[l * 128 + 2 * F.lane + 1];
        bf16_t* mk = MK + ((((size_t)l * NB + b) * 4 + hh) * 256 + m0) * 128 + 2 * F.lane;
#pragma unroll 1
        for (int rb = 0; rb < 64; rb += 8) {
            unsigned kk[8], vv[8];
#pragma unroll
            for (int i = 0; i < 8; ++i) { const bf16_t* src = kv + (size_t)(r0 + rb + i) * 4096 + l * 1024 + hh * 128 + 2 * F.lane; kk[i] = *(const unsigned*)src; vv[i] = *(const unsigned*)(src + 512); }
#pragma unroll
            for (int i = 0; i < 8; ++i) { const float k0 = bf_lo(kk[i]), k1 = bf_hi(kk[i]);
                const float rstd = 1.0f / sqrtf(wave_sum(k0 * k0 + k1 * k1) * (1.f / 128.f) + 1e-6f);
                *(unsigned*)(mk + (size_t)(rb + i) * 128) = pk2(k0 * rstd * g0, k1 * rstd * g1);
                vl[(rb + i) * 65 + F.lane] = vv[i]; }
        }
        LDS_WAIT(); asm volatile("" ::: "memory");
        bf16_t* vt = MVT + (((size_t)l * NB + b) * 4 + hh) * 128 * 256 + m0 + F.lane;
#pragma unroll 8
        for (int p = 0; p < 64; ++p) { const unsigned u = vl[F.lane * 65 + p]; vt[(size_t)(2 * p) * 256] = (bf16_t)(u & 0xffffu); vt[(size_t)(2 * p + 1) * 256] = (bf16_t)(u >> 16); }
        LDS_WAIT(); asm volatile("" ::: "memory");
    }
}
__device__ __forceinline__ void ph_layer0(Frame& F, int l, const bf16_t* xs) {
    LAS float* scr = (LAS float*)(F.lds + F.wave * 16384);
    const int gw = F.bid * NWAVES + F.wave, NGW = F.G * NWAVES;
    unsigned char* ws = F.ws;
    constexpr int I_WIN = (D / 64) * ((N_IN + 31) / 32), I_B = (512 / 64) * (D / 32), I_O = (D / 64) * (D / 32), I_Q = (D / 64) * (512 / 32);
    constexpr int I_FG = (D / 64) * (FFN / 32), I_FDN = (FFN / 64) * (D / 32), I_EG = (D / 64) * (EDIM / 32), I_EDN = (EDIM / 64) * (D / 32);
    const bool moe = (l & 1) != 0; const int j = l >> 1;
    const int nff = moe ? NEXP * (2 * I_EG + I_EDN) : (2 * I_FG + I_FDN);
    constexpr int I_R2 = 16, I_RG = 32, I_RV1 = 8, I_RV2 = 16;
    const int nrw = 2 * I_R2 + I_RG + (l ? I_RV1 + I_RV2 : 0);
    const int NIT = I_WIN + 2 * I_B + I_O + I_Q + I_B + nrw + nff;
    const float* gffn = FIN(F, I_NORM_FFN) + l * D;
    for (int it = gw; it < NIT; it += NGW) {
        int r = it;
        if (r < I_WIN) { transpose_item(FIN(F, I_W_IN) + (size_t)l * D * N_IN, D, N_IN, (bf16_t*)(ws + W_IN), MapWin{}, FIN(F, I_NORM_MIX) + l * D, scr, r, F.lane); continue; } r -= I_WIN;
        if (r < I_B) { transpose_item(FIN(F, I_WBA) + (size_t)l * 512 * D, 512, D, (bf16_t*)(ws + W_BA), MapId{0}, nullptr, scr, r, F.lane); continue; } r -= I_B;
        if (r < I_B) { transpose_item(FIN(F, I_WBB) + (size_t)l * 512 * D, 512, D, (bf16_t*)(ws + W_BB), MapId{0}, nullptr, scr, r, F.lane); continue; } r -= I_B;
        if (r < I_O) { transpose_item(FIN(F, I_WOUT) + (size_t)l * D * D, D, D, (bf16_t*)(ws + W_OUT), MapId{0}, nullptr, scr, r, F.lane); continue; } r -= I_O;
        if (r < I_Q) { transpose_item(FIN(F, I_MWQ) + (size_t)l * D * 512, D, 512, (bf16_t*)(ws + W_MQ), MapId{0}, FIN(F, I_NORM_MEM) + l * D, scr, r, F.lane); continue; } r -= I_Q;
        if (r < I_B) { transpose_item(FIN(F, I_MWO) + (size_t)l * 512 * D, 512, D, (bf16_t*)(ws + W_MO), MapId{0}, nullptr, scr, r, F.lane); continue; } r -= I_B;
        if (r < nrw) {
            if (r < I_R2) { transpose_item<MapId, true>(FIN(F, I_W2) + (size_t)l * 64 * 512, 64, 512, (bf16_t*)(ws + W_RW2), MapId{0}, nullptr, scr, r, F.lane); continue; } r -= I_R2;
            if (r < I_R2) { transpose_item<MapId, true>(FIN(F, I_A2) + (size_t)l * 64 * 512, 64, 512, (bf16_t*)(ws + W_RA2), MapId{0}, nullptr, scr, r, F.lane); continue; } r -= I_R2;
            if (r < I_RG) { transpose_item<MapId, true>(FIN(F, I_G2) + (size_t)l * 128 * 512, 128, 512, (bf16_t*)(ws + W_RG2), MapId{0}, nullptr, scr, r, F.lane); continue; } r -= I_RG;
            if (r < I_RV1) { transpose_item(FIN(F, I_V1) + (size_t)(l - 1) * 512 * 32, 512, 32, (bf16_t*)(ws + W_RV1), MapId{0}, nullptr, scr, r, F.lane); continue; } r -= I_RV1;
            transpose_item<MapId, true>(FIN(F, I_V2) + (size_t)(l - 1) * 32 * 512, 32, 512, (bf16_t*)(ws + W_RV2), MapId{0}, nullptr, scr, r, F.lane); continue;
        }
        r -= nrw;
        if (!moe) {
            if (r < I_FG) { transpose_item(FIN(F, I_FWG) + (size_t)j * D * FFN, D, FFN, (bf16_t*)(ws + W_FGU), MapGU{0}, gffn, scr, r, F.lane); continue; } r -= I_FG;
            if (r < I_FG) { transpose_item(FIN(F, I_FWU) + (size_t)j * D * FFN, D, FFN, (bf16_t*)(ws + W_FGU), MapGU{1}, gffn, scr, r, F.lane); continue; } r -= I_FG;
            transpose_item(FIN(F, I_FWD) + (size_t)j * FFN * D, FFN, D, (bf16_t*)(ws + W_FD), MapId{0}, nullptr, scr, r, F.lane);
        } else {
            const int per = 2 * I_EG + I_EDN, e = r / per; r -= e * per;
            const size_t eo = (size_t)(j * NEXP + e);
            if (r < I_EG) { transpose_item(FIN(F, I_EWG) + eo * D * EDIM, D, EDIM, (bf16_t*)(ws + W_EGU) + (size_t)e * 2 * EDIM * D, MapGU{0}, gffn, scr, r, F.lane); continue; } r -= I_EG;
            if (r < I_EG) { transpose_item(FIN(F, I_EWU) + eo * D * EDIM, D, EDIM, (bf16_t*)(ws + W_EGU) + (size_t)e * 2 * EDIM * D, MapGU{1}, gffn, scr, r, F.lane); continue; } r -= I_EG;
            transpose_item(FIN(F, I_EWD) + eo * EDIM * D, EDIM, D, (bf16_t*)(ws + W_ED) + (size_t)e * D * EDIM, MapId{0}, nullptr, scr, r, F.lane);
        }
    }
    { u32x4* z = (u32x4*)((bf16_t*)(ws + W_IN) + (size_t)3016 * D); const int n16 = 56 * D * 2 / 16;
      for (int i = F.bid * NTHR + F.tid; i < n16; i += F.G * NTHR) z[i] = pg8::zu4(); }
    bf16_t* hn = (bf16_t*)(ws + WS_HN);
    if (l == 0) rms_pass_to_bf16(FIN(F, I_X), hn, gw, NGW, F.lane);
    else rs_finalize(F);
}
__device__ __forceinline__ void ph_norm(Frame& F, const bf16_t* xs) {
    const int gw = F.bid * NWAVES + F.wave, NGW = F.G * NWAVES;
    rstd_pass_bf16in(xs, (float*)(F.ws + WS_RS), gw, NGW, F.lane);
}
__device__ __forceinline__ void ph_norm_ffn(Frame& F, int l, const bf16_t* XS) {
    const int gw = F.bid * NWAVES + F.wave, NGW = F.G * NWAVES;
    bf16_t* hn = (bf16_t*)(F.ws + WS_HN);
    const bool moe = (l & 1) != 0; const int j = l >> 1;
    const float* gn = FIN(F, I_NORM_FFN) + l * D;
    const float* rt = FIN(F, I_ROUTER) + (size_t)j * D * NEXP; const float* rb = FIN(F, I_RBIAS) + j * NEXP;
    unsigned short* sele = (unsigned short*)(F.ws + MOE_SELE); f32x2* selw = (f32x2*)(F.ws + MOE_SELW);
    float* rsv = (float*)(F.ws + WS_RS);
    if (!moe) { rs_finalize(F); return; }
    f32x4 rw0[16], rw1[16]; float rbv[8];
#pragma unroll
    for (int q = 0; q < 4; ++q)
#pragma unroll
        for (int c = 0; c < 4; ++c) { const int k = 256 * q + 4 * F.lane + c; const float g_ = gn[k];
            rw0[4 * q + c] = *(const f32x4*)(rt + (size_t)k * 8) * g_; rw1[4 * q + c] = *(const f32x4*)(rt + (size_t)k * 8 + 4) * g_; }
#pragma unroll
    for (int e = 0; e < 8; ++e) rbv[e] = rb[e];
    u32x2 nx[4];
    { const u32x2* xr = (const u32x2*)(XS + (size_t)gw * D) + F.lane;
#pragma unroll
      for (int j = 0; j < 4; ++j) nx[j] = xr[64 * j]; }
#pragma unroll 1
    for (int m = gw; m < T; m += NGW) {
        f32x4 v[4];
#pragma unroll
        for (int j = 0; j < 4; ++j) { u32x2 t_ = nx[j]; asm volatile("" : "+v"(t_)); v[j] = (f32x4){bf_lo(t_.x), bf_hi(t_.x), bf_lo(t_.y), bf_hi(t_.y)}; }
        { const int mn = (m + NGW < T) ? m + NGW : m; const u32x2* xr = (const u32x2*)(XS + (size_t)mn * D) + F.lane;
#pragma unroll
          for (int j = 0; j < 4; ++j) nx[j] = xr[64 * j];
          asm volatile("" ::: "memory"); }
        float s = 0.f;
#pragma unroll
        for (int j = 0; j < 4; ++j) s += (v[j].x * v[j].x + v[j].y * v[j].y) + (v[j].z * v[j].z + v[j].w * v[j].w);
        const float rstd = 1.0f / sqrtf(wave_sum(s) * (1.f / D) + 1e-6f);
        if (F.lane == 0) rsv[m] = rstd;
#pragma unroll
        for (int j = 0; j < 4; ++j) v[j] = v[j] * rstd;
        f32x4 la = (f32x4){0.f, 0.f, 0.f, 0.f}, lb = la;
#pragma unroll
        for (int q = 0; q < 4; ++q)
#pragma unroll
            for (int c = 0; c < 4; ++c) { const float h = v[q][c]; la += rw0[4 * q + c] * h; lb += rw1[4 * q + c] * h; }
        float lg[8] = { la[0], la[1], la[2], la[3], lb[0], lb[1], lb[2], lb[3] };
#pragma unroll
        for (int e = 0; e < 8; ++e) lg[e] = wave_sum(lg[e]) + rbv[e];
        int e0 = 0; float l0 = lg[0];
#pragma unroll
        for (int e = 1; e < 8; ++e) if (lg[e] > l0) { l0 = lg[e]; e0 = e; }
        int e1 = -1; float l1 = -3.0e38f;
#pragma unroll
        for (int e = 0; e < 8; ++e) if (e != e0 && lg[e] > l1) { l1 = lg[e]; e1 = e; }
        const float w1 = 1.0f / (1.0f + __expf(l0 - l1)), w0 = 1.0f - w1;
        if (F.lane == 0) { sele[m] = (unsigned short)(e0 | (e1 << 8)); selw[m] = (f32x2){w0, w1}; }
    }
}

#define MFMA16(x, y, c) __builtin_amdgcn_mfma_f32_16x16x32_bf16((x), (y), (c), 0, 0, 0)
__device__ __forceinline__ float softplusf_(float x) { return fmaxf(x, 0.f) + log1pf(expf(-fabsf(x))); }
typedef __attribute__((address_space(3))) bf16_t lbf;
constexpr int LDP = 72;
constexpr int SLOT = 64 * LDP * 2;
__device__ __forceinline__ f32x4 unpack4(u32x2 u) { return (f32x4){bf_lo(u.x), bf_hi(u.x), bf_lo(u.y), bf_hi(u.y)}; }
__device__ __forceinline__ u32x2 pack4(f32x4 v) { u32x2 o; o.x = pk2(v[0], v[1]); o.y = pk2(v[2], v[3]); return o; }
__device__ __forceinline__ size_t rwo(int t, int col) { return ((size_t)((t >> 6) * 32 + (col >> 4)) << 10) + (size_t)(((t & 63) << 4) + (col & 15)); }
__device__ __forceinline__ void mm64(const lbf* X, const lbf* Y, int w, int jl, int g, f32x4 (&acc)[2]) {
    const lbf* xr = X + (16 * (w & 3) + jl) * LDP + 8 * g;
    const lbf* yr = Y + (16 * (2 * (w >> 2)) + jl) * LDP + 8 * g;
    const bf16x8 x0 = *(const LAS bf16x8*)xr, x1 = *(const LAS bf16x8*)(xr + 32);
    const bf16x8 y00 = *(const LAS bf16x8*)yr, y01 = *(const LAS bf16x8*)(yr + 32), y10 = *(const LAS bf16x8*)(yr + 16 * LDP), y11 = *(const LAS bf16x8*)(yr + 16 * LDP + 32);
    acc[0] = MFMA16(x0, y00, acc[0]); acc[1] = MFMA16(x0, y10, acc[1]); acc[0] = MFMA16(x1, y01, acc[0]); acc[1] = MFMA16(x1, y11, acc[1]);
}
struct FrX { bf16x8 k0, k1; }; struct FrY { bf16x8 a0, a1, b0, b1; };
__device__ __forceinline__ FrX ldx64(const lbf* X, int w, int jl, int g) { const lbf* xr = X + (16 * (w & 3) + jl) * LDP + 8 * g; FrX f; f.k0 = *(const LAS bf16x8*)xr; f.k1 = *(const LAS bf16x8*)(xr + 32); return f; }
__device__ __forceinline__ FrY ldy64(const lbf* Y, int w, int jl, int g) { const lbf* yr = Y + (16 * (2 * (w >> 2)) + jl) * LDP + 8 * g; FrY f;
    f.a0 = *(const LAS bf16x8*)yr; f.a1 = *(const LAS bf16x8*)(yr + 32); f.b0 = *(const LAS bf16x8*)(yr + 16 * LDP); f.b1 = *(const LAS bf16x8*)(yr + 16 * LDP + 32); return f; }
__device__ __forceinline__ FrX ldx64s(const lbf* X, int w, int jl, int g) { const lbf* xr = X + (16 * (w & 3) + jl) * LDP + 8 * (g ^ (w & 3)); FrX f; f.k0 = *(const LAS bf16x8*)xr; f.k1 = *(const LAS bf16x8*)(xr + 32); return f; }
__device__ __forceinline__ FrY ldy64s(const lbf* Y, int w, int jl, int g) { const int sa = (2 * (w >> 2)) & 3; const lbf* ya = Y + (16 * (2 * (w >> 2)) + jl) * LDP + 8 * (g ^ sa); const lbf* yb = Y + (16 * (2 * (w >> 2) + 1) + jl) * LDP + 8 * (g ^ (sa + 1)); FrY f;
    f.a0 = *(const LAS bf16x8*)ya; f.a1 = *(const LAS bf16x8*)(ya + 32); f.b0 = *(const LAS bf16x8*)yb; f.b1 = *(const LAS bf16x8*)(yb + 32); return f; }
__device__ __forceinline__ void mma64(const FrX& x, const FrY& y, f32x4 (&acc)[2]) {
    acc[0] = MFMA16(x.k0, y.a0, acc[0]); acc[1] = MFMA16(x.k0, y.b0, acc[1]); acc[0] = MFMA16(x.k1, y.a1, acc[0]); acc[1] = MFMA16(x.k1, y.b1, acc[1]); }
__device__ __forceinline__ void st_t(lbf* dst, const f32x4 (&acc)[2], int w, int jl, int g) {
#pragma unroll
    for (int i = 0; i < 2; ++i) *(LAS u32x2*)(dst + (16 * (2 * (w >> 2) + i) + jl) * LDP + 16 * (w & 3) + 4 * g) = pack4(acc[i]);
}
__device__ __forceinline__ void st_n(lbf* dst, const f32x4 (&acc)[2], int w, int jl, int g) {
#pragma unroll
    for (int i = 0; i < 2; ++i)
#pragma unroll
        for (int r = 0; r < 4; ++r) dst[(16 * (w & 3) + 4 * g + r) * LDP + 16 * (2 * (w >> 2) + i) + jl] = f2bf(acc[i][r]);
}
#define ZACC(a) do { a[0] = pg8::zf4(); a[1] = a[0]; } while (0)

constexpr int XA_LD = 264, XV_LD = 520, VM_LD = 40;
__device__ __forceinline__ void ph_rwkv_pre(Frame& F, int l, int half) {
    lbf* XA = (lbf*)F.lds;
    lbf* XV = (lbf*)(F.lds + 64 * XA_LD * 2);
    lbf* VM = (lbf*)(F.lds + 64 * XA_LD * 2 + 64 * XV_LD * 2);
    const bf16_t* CA = (const bf16_t*)(F.ws + MX_CA);
    bf16_t* RW = (bf16_t*)(F.ws + MX_RW); constexpr size_t AS_ = (size_t)TH * 512;
    bf16_t* VF = (bf16_t*)(F.ws + WS_VFIRST) + (size_t)half * TH * 512;
    const bf16_t* W2T = (const bf16_t*)(F.ws + W_RW2); const bf16_t* A2T = (const bf16_t*)(F.ws + W_RA2); const bf16_t* G2T = (const bf16_t*)(F.ws + W_RG2);
    const bf16_t* V1T = (const bf16_t*)(F.ws + W_RV1); const bf16_t* V2T = (const bf16_t*)(F.ws + W_RV2);
    const float* mu = FIN(F, I_MU) + l * RW_COLS;
    const int lane = F.lane, w = F.wave, jl = lane & 15, g = lane >> 4;
    for (int tile = F.bid; tile < TH / 64; tile += F.G) {
        const int t0 = tile * 64;
        lds_barrier();
        { const int c = 1536 + (F.tid & 31) * 8; const f32x4 m0 = *(const f32x4*)(mu + c), m1 = *(const f32x4*)(mu + c + 4);
          const float mq[8] = { m0[0], m0[1], m0[2], m0[3], m1[0], m1[1], m1[2], m1[3] };
          u32x4 cu[4], pv[4];
#pragma unroll
          for (int k = 0; k < 4; ++k) { const int t = t0 + (F.tid >> 5) + 16 * k; const bf16_t* p = CA + (size_t)t * RW_COLS + c; const bool hp = (t & (SEQ - 1)) != 0;
              cu[k] = *(const u32x4*)p; pv[k] = *(const u32x4*)(hp ? p - RW_COLS : p); if (!hp) pv[k] = pg8::zu4(); }
#pragma unroll
          for (int k = 0; k < 4; ++k) { const int i = (F.tid >> 5) + 16 * k;
            const float cv[8] = { bf_lo(cu[k].x), bf_hi(cu[k].x), bf_lo(cu[k].y), bf_hi(cu[k].y), bf_lo(cu[k].z), bf_hi(cu[k].z), bf_lo(cu[k].w), bf_hi(cu[k].w) };
            const float pp[8] = { bf_lo(pv[k].x), bf_hi(pv[k].x), bf_lo(pv[k].y), bf_hi(pv[k].y), bf_lo(pv[k].z), bf_hi(pv[k].z), bf_lo(pv[k].w), bf_hi(pv[k].w) };
            float x[8];
#pragma unroll
            for (int q = 0; q < 8; ++q) { x[q] = cv[q] + (pp[q] - cv[q]) * mq[q]; if (c < 1600) x[q] = 1.0f - 2.0f * __builtin_amdgcn_rcpf(1.0f + __expf(2.0f * x[q])); else if (c >= 1664) x[q] = sigmoidf_(x[q]); }
            u32x4 o; o.x = pk2(x[0], x[1]); o.y = pk2(x[2], x[3]); o.z = pk2(x[4], x[5]); o.w = pk2(x[6], x[7]);
            *(LAS u32x4*)(XA + i * XA_LD + (c - 1536)) = o; } }
        if (l) { const int c = 1024 + (F.tid & 63) * 8; const f32x4 m0 = *(const f32x4*)(mu + c), m1 = *(const f32x4*)(mu + c + 4);
          const float mq[8] = { m0[0], m0[1], m0[2], m0[3], m1[0], m1[1], m1[2], m1[3] };
          u32x4 cu[8], pv[8];
#pragma unroll
          for (int k = 0; k < 8; ++k) { const int t = t0 + (F.tid >> 6) + 8 * k; const bf16_t* p = CA + (size_t)t * RW_COLS + c; const bool hp = (t & (SEQ - 1)) != 0;
              cu[k] = *(const u32x4*)p; pv[k] = *(const u32x4*)(hp ? p - RW_COLS : p); if (!hp) pv[k] = pg8::zu4(); }
#pragma unroll
          for (int k = 0; k < 8; ++k) { const int i = (F.tid >> 6) + 8 * k;
            const float cv[8] = { bf_lo(cu[k].x), bf_hi(cu[k].x), bf_lo(cu[k].y), bf_hi(cu[k].y), bf_lo(cu[k].z), bf_hi(cu[k].z), bf_lo(cu[k].w), bf_hi(cu[k].w) };
            const float pp[8] = { bf_lo(pv[k].x), bf_hi(pv[k].x), bf_lo(pv[k].y), bf_hi(pv[k].y), bf_lo(pv[k].z), bf_hi(pv[k].z), bf_lo(pv[k].w), bf_hi(pv[k].w) };
            float x[8];
#pragma unroll
            for (int q = 0; q < 8; ++q) x[q] = cv[q] + (pp[q] - cv[q]) * mq[q];
            u32x4 o; o.x = pk2(x[0], x[1]); o.y = pk2(x[2], x[3]); o.z = pk2(x[4], x[5]); o.w = pk2(x[6], x[7]);
            *(LAS u32x4*)(XV + i * XV_LD + (c - 1024)) = o; } }
        lds_barrier();
        if (l) { const int tg = w & 3, nt = w >> 2; f32x4 a = (f32x4){0.f, 0.f, 0.f, 0.f};
            const bf16_t* xr = V1T + (size_t)(16 * nt + jl) * 512 + 8 * g; const lbf* yr = XV + (16 * tg + jl) * XV_LD + 8 * g;
#pragma unroll 4
            for (int s = 0; s < 16; ++s) a = MFMA16(*(const bf16x8*)(xr + 32 * s), *(const LAS bf16x8*)(yr + 32 * s), a);
            *(LAS u32x2*)(VM + (16 * tg + jl) * VM_LD + 16 * nt + 4 * g) = pack4(a); }
        lds_barrier();
        { bf16_t* XAG = RW + 0 * AS_; bf16_t* VMG = RW + 2 * AS_;
#pragma unroll
          for (int i = 0; i < 4; ++i) { const int id = F.tid + NTHR * i, row = id >> 5, c16 = id & 31; *(u32x4*)(XAG + (size_t)(t0 + row) * 256 + 8 * c16) = *(const LAS u32x4*)(XA + row * XA_LD + 8 * c16); }
          if (l && F.tid < 256) { const int row = F.tid >> 2, c8 = F.tid & 3; *(u32x4*)(VMG + (size_t)(t0 + row) * 32 + 8 * c8) = *(const LAS u32x4*)(VM + row * VM_LD + 8 * c8); } }
    }
}

__device__ __forceinline__ void ph_rwkv_s1(Frame& F, int l, int half) {
    bf16_t* RW = (bf16_t*)(F.ws + MX_RW); constexpr size_t AS_ = (size_t)TH * 512;
    float* BSW = (float*)(F.ws + MX_BS); const float* rkw = FIN(F, I_RK) + l * 512;
    bf16_t* YH = (bf16_t*)(F.ws + MX_CA);
    LAS unsigned char* L = F.lds;
#define SL(i) ((lbf*)(L + (i) * SLOT))
    lbf *AT = SL(0), *BT = SL(1), *KT = SL(2), *RT = SL(3), *ATt = SL(4), *Vt = SL(5), *BPt = SL(6), *KPt = SL(7), *AAK = SL(10), *ARB = SL(11), *ARK = SL(12);
    LAS float* EL = (LAS float*)(L + 8 * SLOT);
    LAS float* SEGT = (LAS float*)(L + 10 * SLOT);
    LAS float* PC = (LAS float*)(L + 16 * SLOT);
    const int lane = F.lane, w = F.wave, jl = lane & 15, g = lane >> 4;
    const int tok = F.tid >> 3, cg = F.tid & 7;
    const bf16_t* CA = (const bf16_t*)(F.ws + MX_CA); bf16_t* VF = (bf16_t*)(F.ws + WS_VFIRST) + (size_t)half * TH * 512;
    const bf16_t* XAG = RW + 0 * AS_; const bf16_t* VMG = RW + 2 * AS_;
    const bf16_t* W2T = (const bf16_t*)(F.ws + W_RW2); const bf16_t* A2T = (const bf16_t*)(F.ws + W_RA2); const bf16_t* G2T = (const bf16_t*)(F.ws + W_RG2); const bf16_t* V2T = (const bf16_t*)(F.ws + W_RV2);
    const float* mu = FIN(F, I_MU) + l * RW_COLS;
    lbf* XAs = (lbf*)L; lbf* VMs = SL(4);
    const int h = F.bid & 7, nt = w & 3, n0 = 64 * h + 16 * nt, n = n0 + 4 * g;
    LAS float* PRM = (LAS float*)(L + 16 * SLOT + 256);
    lbf* ET = (lbf*)(L + 16 * SLOT + 2816);
    lds_barrier();
    { const int a_ = F.tid >> 6, c_ = F.tid & 63, col = 64 * h + c_; float v_ = 0.f;
      if (a_ < 3) v_ = mu[512 * a_ + col]; else if (a_ == 3) v_ = FIN(F, I_W0)[l * 512 + col]; else if (a_ == 4) v_ = FIN(F, I_A0)[l * 512 + col]; else if (a_ == 5) v_ = FIN(F, I_KK)[l * 512 + col];
      else if (a_ == 6) v_ = FIN(F, I_KA)[l * 512 + col]; else if (l) v_ = FIN(F, I_V0)[(l - 1) * 512 + col];
      PRM[F.tid] = v_; if (F.tid < 64) PRM[512 + F.tid] = rkw[64 * h + F.tid]; }
    u32x4 cxa[4], ctl[4], cpv; u32x2 cvm = (u32x2){0u, 0u}; bf16x8 xw[2], xa[2], xg[4], xm = {0, 0, 0, 0, 0, 0, 0, 0};
    lbf* TR = SL(5); constexpr int T65 = 65 * LDP;
#define A0_LOAD(u_) do { const int uu_ = (u_) < (TH / 64) * 8 ? (u_) : F.bid; const int tz_ = (uu_ >> 3) * 64; \
        _Pragma("unroll") for (int i = 0; i < 4; ++i) { const int id = F.tid + NTHR * i; cxa[i] = *(const u32x4*)(XAG + (size_t)(tz_ + (id >> 5)) * 256 + 8 * (id & 31)); } \
        if (l) cvm = *(const u32x2*)(VMG + (size_t)(tz_ + (F.tid >> 3)) * 32 + 4 * (F.tid & 7)); \
        { const bf16_t* cr_ = CA + (size_t)(tz_ + tok) * RW_COLS + 64 * h + 8 * cg; ctl[0] = *(const u32x4*)cr_; ctl[1] = *(const u32x4*)(cr_ + 512); ctl[2] = *(const u32x4*)(cr_ + 1024); \
          ctl[3] = pg8::zu4(); cpv = ctl[3]; if (l) ctl[3] = *(const u32x4*)(VF + rwo(tz_ + tok, 64 * h + 8 * cg)); \
          if (F.tid < 24 && (tz_ & (SEQ - 1)) != 0) cpv = *(const u32x4*)(CA + (size_t)(tz_ - 1) * RW_COLS + 512 * (F.tid >> 3) + 64 * h + 8 * (F.tid & 7)); } } while (0)
#define A0_LOADX() do { const int fb_ = 4 * h + nt; int ln_ = lane; asm volatile("" : "+v"(ln_));        \
          _Pragma("unroll") for (int s2 = 0; s2 < 2; ++s2) { xw[s2] = *(const bf16x8*)(W2T + ((size_t)(fb_ * 2 + s2) * 64 + ln_) * 8); xa[s2] = *(const bf16x8*)(A2T + ((size_t)(fb_ * 2 + s2) * 64 + ln_) * 8); } \
          _Pragma("unroll") for (int s2 = 0; s2 < 4; ++s2) xg[s2] = *(const bf16x8*)(G2T + ((size_t)(fb_ * 4 + s2) * 64 + ln_) * 8); \
          if (l) xm = *(const bf16x8*)(V2T + ((size_t)fb_ * 64 + ln_) * 8); } while (0)
    A0_LOAD(F.bid); A0_LOADX();
    for (int u = F.bid; u < (TH / 64) * 8; u += F.G) {
        const int ch = u >> 3, t0 = ch * 64;
        lds_barrier();
#pragma unroll
        for (int i = 0; i < 4; ++i) { const int id = F.tid + NTHR * i; *(LAS u32x4*)(XAs + (id >> 5) * XA_LD + 8 * (id & 31)) = cxa[i]; }
        if (l) *(LAS u32x2*)(VMs + (F.tid >> 3) * VM_LD + 4 * (F.tid & 7)) = cvm;
#pragma unroll
        for (int T = 0; T < 3; ++T) *(LAS u32x4*)(TR + T * T65 + (tok + 1) * LDP + 8 * cg) = ctl[T];
        *(LAS u32x4*)(TR + 3 * T65 + tok * LDP + 8 * cg) = ctl[3];
        if (F.tid < 24) *(LAS u32x4*)(TR + (F.tid >> 3) * T65 + 8 * (F.tid & 7)) = cpv;
        lds_barrier();
        {
            const LAS f32x4* pp_ = (const LAS f32x4*)(PRM + 16 * nt + 4 * g);
            const f32x4 mr = pp_[0], mk = pp_[16], mv = pp_[32], w0 = pp_[48], a0 = pp_[64], kkw = pp_[80], ka = pp_[96], v0 = pp_[112];
#pragma unroll
            for (int tgi = 0; tgi < 2; ++tgi) {
                const int tl = 16 * (2 * (w >> 2) + tgi) + jl, t = t0 + tl;
                const lbf* tp = TR + tl * LDP + 16 * nt + 4 * g;
                const f32x4 rp = unpack4(*(const LAS u32x2*)tp), rc = unpack4(*(const LAS u32x2*)(tp + LDP)), kp = unpack4(*(const LAS u32x2*)(tp + T65)), kc = unpack4(*(const LAS u32x2*)(tp + T65 + LDP)),
                            vp = unpack4(*(const LAS u32x2*)(tp + 2 * T65)), vc = unpack4(*(const LAS u32x2*)(tp + 2 * T65 + LDP)), vf = unpack4(*(const LAS u32x2*)(tp + 3 * T65));
                const size_t o = rwo(t, n);
                const lbf* ya = XAs + tl * XA_LD + 8 * g;
                bf16x8 yf[9];
#pragma unroll
                for (int s2 = 0; s2 < 8; ++s2) yf[s2] = *(const LAS bf16x8*)(ya + 32 * s2);
                yf[8] = *(const LAS bf16x8*)(VMs + tl * VM_LD + 8 * g);
                f32x4 aw = (f32x4){0.f, 0.f, 0.f, 0.f}, aa = aw, ag = aw, am = aw;
#pragma unroll
                for (int s2 = 0; s2 < 2; ++s2) { aw = MFMA16(xw[s2], yf[s2], aw); aa = MFMA16(xa[s2], yf[2 + s2], aa); }
#pragma unroll
                for (int s2 = 0; s2 < 4; ++s2) ag = MFMA16(xg[s2], yf[4 + s2], ag);
                if (l) am = MFMA16(xm, yf[8], am);
                const f32x4 r4 = rc + (rp - rc) * mr, k4 = kc + (kp - kc) * mk; f32x4 v4 = vc + (vp - vc) * mv;
                if (l) {
#pragma unroll
                    for (int q = 0; q < 4; ++q) v4[q] = v4[q] + (vf[q] - v4[q]) * sigmoidf_(v0[q] + am[q]); }
                else *(u32x2*)(VF + o) = pack4(v4);
                f32x4 e4, as4, k24, kk4;
#pragma unroll
                for (int q = 0; q < 4; ++q) { const float a = sigmoidf_(a0[q] + aa[q]); as4[q] = a; k24[q] = k4[q] * (1.0f + (a - 1.0f) * ka[q]);
                    e4[q] = 0.6065306597f * sigmoidf_(w0[q] + aw[q]);
                    kk4[q] = k4[q] * kkw[q]; }
                const int lo_ = tl * LDP + 16 * nt + 4 * g;
                *(LAS u32x2*)(SL(10) + lo_) = pack4(r4); *(LAS u32x2*)(SL(11) + lo_) = pack4(e4); *(LAS u32x2*)(SL(12) + lo_) = pack4(k24); *(LAS u32x2*)(SL(13) + lo_) = pack4(v4);
                *(LAS u32x2*)(SL(14) + lo_) = pack4(kk4); *(LAS u32x2*)(SL(15) + lo_) = pack4(as4);
                { const u32x2 ep = pack4(e4); lbf* et = ET + (16 * nt + 4 * g) * LDP + tl;
                  et[0] = (bf16_t)(ep.x & 0xffffu); et[LDP] = (bf16_t)(ep.x >> 16); et[2 * LDP] = (bf16_t)(ep.y & 0xffffu); et[3 * LDP] = (bf16_t)(ep.y >> 16); }
                *(u32x2*)(RW + 3 * AS_ + o) = pack4(v4); *(u32x2*)(RW + 6 * AS_ + o) = pack4(ag);
                __builtin_amdgcn_sched_barrier(0);
            }
        }
        lds_barrier();
        const int lt_ = tok * LDP + 8 * cg;
        const u32x4 ur = *(const LAS u32x4*)(SL(10) + lt_), ue = *(const LAS u32x4*)(SL(11) + lt_), uk = *(const LAS u32x4*)(SL(12) + lt_), uv = *(const LAS u32x4*)(SL(13) + lt_),
                    ukk = *(const LAS u32x4*)(SL(14) + lt_), uas = *(const LAS u32x4*)(SL(15) + lt_);
        const float e8[8] = { bf_lo(ue.x), bf_hi(ue.x), bf_lo(ue.y), bf_hi(ue.y), bf_lo(ue.z), bf_hi(ue.z), bf_lo(ue.w), bf_hi(ue.w) };
        { const FrY ye = ldy64(ET, w, jl, g);
          FrX xl;
          { const int trow = 16 * (w & 3) + jl;
            u32x4 q0, q1;
#pragma unroll
            for (int p2 = 0; p2 < 4; ++p2) { const int s0 = 8 * g + 2 * p2, s1 = 32 + 8 * g + 2 * p2;
                q0[p2] = (s0 <= trow ? 0x3f80u : 0u) | (s0 + 1 <= trow ? 0x3f800000u : 0u); q1[p2] = (s1 <= trow ? 0x3f80u : 0u) | (s1 + 1 <= trow ? 0x3f800000u : 0u); }
            xl.k0 = __builtin_bit_cast(bf16x8, q0); xl.k1 = __builtin_bit_cast(bf16x8, q1); }
          f32x4 ac[2]; ZACC(ac); mma64(xl, ye, ac);
#pragma unroll
          for (int i = 0; i < 2; ++i)
#pragma unroll
              for (int r = 0; r < 4; ++r) EL[(16 * (w & 3) + 4 * g + r) * 65 + 16 * (2 * (w >> 2) + i) + jl] = -ac[i][r]; }
        lds_barrier();
        {
            const float r8[8] = { bf_lo(ur.x), bf_hi(ur.x), bf_lo(ur.y), bf_hi(ur.y), bf_lo(ur.z), bf_hi(ur.z), bf_lo(ur.w), bf_hi(ur.w) };
            const float k8[8] = { bf_lo(uk.x), bf_hi(uk.x), bf_lo(uk.y), bf_hi(uk.y), bf_lo(uk.z), bf_hi(uk.z), bf_lo(uk.w), bf_hi(uk.w) };
            float kk8[8] = { bf_lo(ukk.x), bf_hi(ukk.x), bf_lo(ukk.y), bf_hi(ukk.y), bf_lo(ukk.z), bf_hi(ukk.z), bf_lo(ukk.w), bf_hi(ukk.w) };
            { float ss = 0.f;
#pragma unroll
              for (int i = 0; i < 8; ++i) ss += kk8[i] * kk8[i];
              ss = sum8(ss);
              const float inv = 1.0f / fmaxf(sqrtf(ss), 1e-12f);
#pragma unroll
              for (int i = 0; i < 8; ++i) kk8[i] *= inv; }
            const float as8[8] = { bf_lo(uas.x), bf_hi(uas.x), bf_lo(uas.y), bf_hi(uas.y), bf_lo(uas.z), bf_hi(uas.z), bf_lo(uas.w), bf_hi(uas.w) };
            const unsigned short v8[8] = { (unsigned short)(uv.x & 0xffffu), (unsigned short)(uv.x >> 16), (unsigned short)(uv.y & 0xffffu), (unsigned short)(uv.y >> 16),
                                           (unsigned short)(uv.z & 0xffffu), (unsigned short)(uv.z >> 16), (unsigned short)(uv.w & 0xffffu), (unsigned short)(uv.w >> 16) };
            { const LAS float* rkp = PRM + 512 + 8 * cg; float b = 0.f;
#pragma unroll
              for (int i = 0; i < 8; ++i) b += r8[i] * k8[i] * rkp[i];
              b = sum8(b);
              if (cg == 0) BSW[(size_t)(t0 + tok) * 8 + h] = b; }
            float at[8], bt[8], kt[8], rt[8], bp[8], kp[8];
#pragma unroll
            for (int i = 0; i < 8; ++i) { const float cl = EL[tok * 65 + 8 * cg + i], pc = __expf(EL[63 * 65 + 8 * cg + i]);
                const float ecl = __expf(cl), eicl = __expf(-cl);
                at[i] = -kk8[i] * __expf(cl + e8[i]); bt[i] = kk8[i] * as8[i] * eicl; kt[i] = k8[i] * eicl; rt[i] = r8[i] * ecl; bp[i] = bt[i] * pc; kp[i] = kt[i] * pc;
                if (tok == 0) PC[8 * cg + i] = pc; }
            u32x4 o;
            o.x = pk2(at[0], at[1]); o.y = pk2(at[2], at[3]); o.z = pk2(at[4], at[5]); o.w = pk2(at[6], at[7]); *(LAS u32x4*)(AT + tok * LDP + 8 * cg) = o;
            o.x = pk2(bt[0], bt[1]); o.y = pk2(bt[2], bt[3]); o.z = pk2(bt[4], bt[5]); o.w = pk2(bt[6], bt[7]); *(LAS u32x4*)(BT + tok * LDP + 8 * cg) = o;
            o.x = pk2(kt[0], kt[1]); o.y = pk2(kt[2], kt[3]); o.z = pk2(kt[4], kt[5]); o.w = pk2(kt[6], kt[7]); *(LAS u32x4*)(KT + tok * LDP + 8 * cg) = o;
            o.x = pk2(rt[0], rt[1]); o.y = pk2(rt[2], rt[3]); o.z = pk2(rt[4], rt[5]); o.w = pk2(rt[6], rt[7]); *(LAS u32x4*)(RT + tok * LDP + 8 * cg) = o;
            const int tsw = (((tok >> 3) ^ (cg >> 1)) << 3) + (tok & 7);
#pragma unroll
            for (int i = 0; i < 8; ++i) { const int c = 8 * cg + i; ATt[c * LDP + tsw] = f2bf(at[i]); Vt[c * LDP + tsw] = v8[i]; BPt[c * LDP + tsw] = f2bf(bp[i]); KPt[c * LDP + tsw] = f2bf(kp[i]); }
        }
        lds_barrier();
        {
            const FrX xb = ldx64(BT, w, jl, g), xk = ldx64(KT, w, jl, g); const FrY ya = ldy64(AT, w, jl, g), yr_ = ldy64(RT, w, jl, g);
            f32x4 a1[2], a2[2], a3[2], a4[2]; ZACC(a1); ZACC(a2); ZACC(a3); ZACC(a4);
            mma64(xb, ya, a1); mma64(xk, ya, a2); mma64(xb, yr_, a3); mma64(xk, yr_, a4);
            const int s0 = 16 * (w & 3) + 4 * g;
            f32x4 b[2];
#pragma unroll
            for (int i = 0; i < 2; ++i) { const int t = 16 * (2 * (w >> 2) + i) + jl;
#pragma unroll
                for (int r = 0; r < 4; ++r) { const bool lt = s0 + r < t, le = s0 + r <= t; if (!lt) { a1[i][r] = 0.f; a2[i][r] = 0.f; } if (!le) { a3[i][r] = 0.f; a4[i][r] = 0.f; } b[i][r] = (s0 + r == t) ? 1.0f : a1[i][r]; } }
            st_t(SL(8), a1, w, jl, g); st_n(SL(9), a1, w, jl, g);
            st_t(SL(13), b, w, jl, g); st_n(SL(14), b, w, jl, g);
            st_t(AAK, a2, w, jl, g); st_t(ARB, a3, w, jl, g); st_t(ARK, a4, w, jl, g);
        }
        lds_barrier();
#define NEU_B(srcB, srcBt, dstB, dstBt) do { f32x4 a[2]; ZACC(a); mm64(SL(srcB), SL(srcBt), w, jl, g, a); st_t(SL(dstBt), a, w, jl, g); st_n(SL(dstB), a, w, jl, g); } while (0)
#define NEU_TB(srcT, srcTt, srcB, srcBt, dstT, dstTt, dstB, dstBt) do { f32x4 at[2], ab[2]; ZACC(ab); \
            const FrX xt_ = ldx64(SL(srcT), w, jl, g), xb_ = ldx64(SL(srcB), w, jl, g); const FrY yb_ = ldy64(SL(srcBt), w, jl, g); \
            _Pragma("unroll") for (int i = 0; i < 2; ++i) at[i] = unpack4(*(const LAS u32x2*)(SL(srcTt) + (16 * (2 * (w >> 2) + i) + jl) * LDP + 16 * (w & 3) + 4 * g)); \
            mma64(xt_, yb_, at); mma64(xb_, yb_, ab); \
            st_t(SL(dstTt), at, w, jl, g); st_n(SL(dstT), at, w, jl, g); st_t(SL(dstBt), ab, w, jl, g); st_n(SL(dstB), ab, w, jl, g); } while (0)
#define NEU_T(srcT, srcTt, srcBt, dstT, dstTt, last) do { f32x4 a[2]; \
            _Pragma("unroll") for (int i = 0; i < 2; ++i) a[i] = unpack4(*(const LAS u32x2*)(SL(srcTt) + (16 * (2 * (w >> 2) + i) + jl) * LDP + 16 * (w & 3) + 4 * g)); \
            mm64(SL(srcT), SL(srcBt), w, jl, g, a); if (!(last)) st_t(SL(dstTt), a, w, jl, g); st_n(SL(dstT), a, w, jl, g); } while (0)
        NEU_B(8, 9, 0, 1);                                   lds_barrier();
        NEU_TB(13, 14, 0, 1, 15, 2, 8, 9);                   lds_barrier();
        NEU_TB(15, 2, 8, 9, 13, 14, 0, 1);                   lds_barrier();
        NEU_TB(13, 14, 0, 1, 15, 2, 8, 9);                   lds_barrier();
        NEU_TB(15, 2, 8, 9, 13, 14, 0, 1);                   lds_barrier();
        NEU_T(13, 14, 1, 15, 2, true);                       lds_barrier();
        lbf* TI = SL(15); lbf* Wt = SL(8); lbf* Xt = SL(9); lbf* Ut = SL(0);
        A0_LOAD(u + F.G); asm volatile("" ::: "memory");
        {
            const FrX x1 = ldx64(TI, w, jl, g), x2 = ldx64(AAK, w, jl, g); const FrY y1 = ldy64s(ATt, w, jl, g), y2 = ldy64s(Vt, w, jl, g);
            f32x4 a[2], b[2]; ZACC(a); ZACC(b); mma64(x1, y1, a); mma64(x2, y2, b); st_t(Wt, a, w, jl, g); st_t(Xt, b, w, jl, g); }
        lds_barrier();
        {
            const FrX xti = ldx64(TI, w, jl, g), xw = ldx64(Wt, w, jl, g); const FrY yx = ldy64(Xt, w, jl, g), yar = ldy64(ARB, w, jl, g), ybp = ldy64s(BPt, w, jl, g);
            f32x4 rr[2]; float pcv[2];
#pragma unroll
            for (int i = 0; i < 2; ++i) { const int t = 16 * (2 * (w >> 2) + i) + jl; rr[i] = unpack4(*(const LAS u32x2*)(RT + t * LDP + 16 * (w & 3) + 4 * g)); pcv[i] = PC[t]; }
            f32x4 au[2], ar[2], am[2]; ZACC(au); ZACC(ar); ZACC(am);
            mma64(xti, yx, au); mma64(xw, yar, ar); mma64(xw, ybp, am);
            st_t(Ut, au, w, jl, g);
#pragma unroll
            for (int i = 0; i < 2; ++i) { const int t = 16 * (2 * (w >> 2) + i) + jl, k0 = 16 * (w & 3) + 4 * g;
                *(u32x2*)(RW + 5 * AS_ + rwo(t0 + t, h * 64 + k0)) = pack4(ar[i] + rr[i]);
#pragma unroll
                for (int r = 0; r < 4; ++r) if (k0 + r == t) am[i][r] += pcv[i];
                *(u32x2*)(RW + 4 * AS_ + rwo(t0 + t, h * 64 + k0)) = pack4(am[i]); }
        }
        lds_barrier();
        {
            A0_LOADX(); asm volatile("" ::: "memory");
            f32x4 ay[2], an[2]; ZACC(ay); ZACC(an);
            { const FrX xu = ldx64(Ut, w, jl, g), xbp = ldx64s(BPt, w, jl, g); const FrY yar = ldy64(ARB, w, jl, g), yu = ldy64(Ut, w, jl, g); mma64(xu, yar, ay); mma64(xbp, yu, an); }
            { const FrX xv = ldx64s(Vt, w, jl, g), xkp = ldx64s(KPt, w, jl, g); const FrY yak = ldy64(ARK, w, jl, g), yv = ldy64s(Vt, w, jl, g); mma64(xv, yak, ay); mma64(xkp, yv, an); }
#pragma unroll
            for (int i = 0; i < 2; ++i) { const int t = 16 * (2 * (w >> 2) + i) + jl, c0 = 16 * (w & 3) + 4 * g;
                *(u32x2*)(YH + rwo(t0 + t, h * 64 + c0)) = pack4(ay[i]);
                *(u32x2*)(RW + 1 * AS_ + rwo(t0 + t, h * 64 + c0)) = pack4(an[i]); }
        }
    }
#undef A0_LOAD
#undef A0_LOADX
#undef SL
#undef NEU_B
#undef NEU_T
#undef NEU_TB
}

__device__ __forceinline__ void ph_rwkv_s2(Frame& F, int l, int pair) {
    const int bl = pair >> 3, h = pair & 7;
    const bf16_t* RW = (const bf16_t*)(F.ws + MX_RW); constexpr size_t AS_ = (size_t)TH * 512;
    const bf16_t* YH = (const bf16_t*)(F.ws + MX_CA); bf16_t* YA = (bf16_t*)(F.ws + MX_CA) + AS_;
    lbf* HT = (lbf*)F.lds;
    const int lane = F.lane, w = F.wave, jl = lane & 15, g = lane >> 4;
    lds_barrier();
    for (int i = F.tid; i < 64 * LDP / 2; i += NTHR) ((LAS unsigned*)HT)[i] = 0u;
    if (F.tid < 128) ((LAS float*)(F.lds + SLOT))[F.tid] = (F.tid < 64 ? FIN(F, I_LNG) : FIN(F, I_LNB))[l * 512 + h * 64 + (F.tid & 63)];
    lds_barrier();
    if (w < 4) {
        bf16x8 m0[4], m1[4]; u32x2 nn[4][4];
#define S2A_LOAD(j, c) do { const int cc_ = (c) < SEQ / 64 ? (c) : SEQ / 64 - 1; const int tb_ = bl * SEQ + cc_ * 64; \
        m0[j] = *(const bf16x8*)(RW + 4 * AS_ + rwo(tb_ + 16 * w + jl, h * 64 + 8 * g)); m1[j] = *(const bf16x8*)(RW + 4 * AS_ + rwo(tb_ + 16 * w + jl, h * 64 + 32 + 8 * g)); \
        _Pragma("unroll") for (int yt = 0; yt < 4; ++yt) nn[j][yt] = *(const u32x2*)(RW + 1 * AS_ + rwo(tb_ + 16 * yt + jl, h * 64 + 16 * w + 4 * g)); } while (0)
        S2A_LOAD(0, 0); S2A_LOAD(1, 1); S2A_LOAD(2, 2);
#pragma unroll 1
        for (int c4 = 0; c4 < SEQ / 64; c4 += 4) {
#pragma unroll
            for (int j = 0; j < 4; ++j) {
                asm volatile("" : "+v"(m0[j]), "+v"(m1[j]));
#pragma unroll
                for (int yt = 0; yt < 4; ++yt) asm volatile("" : "+v"(nn[j][yt]));
                S2A_LOAD((j + 3) & 3, c4 + j + 3);
                asm volatile("" ::: "memory");
                f32x4 a[4]; bf16x8 hf[4][2];
#pragma unroll
                for (int yt = 0; yt < 4; ++yt) { const lbf* yr = HT + (16 * yt + jl) * LDP + 8 * g; hf[yt][0] = *(const LAS bf16x8*)yr; hf[yt][1] = *(const LAS bf16x8*)(yr + 32); a[yt] = unpack4(nn[j][yt]); }
#pragma unroll
                for (int yt = 0; yt < 4; ++yt) a[yt] = MFMA16(m0[j], hf[yt][0], a[yt]);
#pragma unroll
                for (int yt = 0; yt < 4; ++yt) a[yt] = MFMA16(m1[j], hf[yt][1], a[yt]);
                lds_barrier();
#pragma unroll
                for (int yt = 0; yt < 4; ++yt) *(LAS u32x2*)(HT + (16 * yt + jl) * LDP + 16 * w + 4 * g) = pack4(a[yt]);
                lds_barrier();
            }
        }
#undef S2A_LOAD
    } else {
        const int wt = w - 4;
        const LAS float* lgl = (const LAS float*)(F.lds + SLOT) + 4 * g; const LAS float* lbl = lgl + 64;
        lbf* ystg = (lbf*)(F.lds + 2 * SLOT) + wt * 16 * LDP;
        const float* bsp = (const float*)(F.ws + MX_BS) + (size_t)(bl * SEQ + 16 * wt + jl) * 8 + h;
        bf16x8 r0[4], r1[4]; u32x2 yh[4][4], uv[4][4], ug[4][4]; float bsv[4];
#define S2B_LOAD(j, c) do { const int cc_ = (c) < SEQ / 64 ? (c) : SEQ / 64 - 1; const int tk_ = bl * SEQ + cc_ * 64 + 16 * wt + jl; \
        r0[j] = *(const bf16x8*)(RW + 5 * AS_ + rwo(tk_, h * 64 + 8 * g)); r1[j] = *(const bf16x8*)(RW + 5 * AS_ + rwo(tk_, h * 64 + 32 + 8 * g)); \
        bsv[j] = bsp[(size_t)(cc_ * 64) * 8]; \
        _Pragma("unroll") for (int xt = 0; xt < 4; ++xt) { yh[j][xt] = *(const u32x2*)(YH + rwo(tk_, h * 64 + 16 * xt + 4 * g)); uv[j][xt] = *(const u32x2*)(RW + 3 * AS_ + rwo(tk_, h * 64 + 16 * xt + 4 * g)); ug[j][xt] = *(const u32x2*)(RW + 6 * AS_ + rwo(tk_, h * 64 + 16 * xt + 4 * g)); } } while (0)
        S2B_LOAD(0, 0); S2B_LOAD(1, 1); S2B_LOAD(2, 2);
#pragma unroll 1
        for (int c4 = 0; c4 < SEQ / 64; c4 += 4) {
#pragma unroll
            for (int j = 0; j < 4; ++j) {
                asm volatile("" : "+v"(r0[j]), "+v"(r1[j]), "+v"(bsv[j]));
#pragma unroll
                for (int xt = 0; xt < 4; ++xt) asm volatile("" : "+v"(yh[j][xt]), "+v"(uv[j][xt]), "+v"(ug[j][xt]));
                S2B_LOAD((j + 3) & 3, c4 + j + 3);
                asm volatile("" ::: "memory");
                f32x4 a[4]; bf16x8 hf[4][2];
#pragma unroll
                for (int xt = 0; xt < 4; ++xt) { const lbf* xr = HT + (16 * xt + jl) * LDP + 8 * g; hf[xt][0] = *(const LAS bf16x8*)xr; hf[xt][1] = *(const LAS bf16x8*)(xr + 32); a[xt] = unpack4(yh[j][xt]); }
#pragma unroll
                for (int xt = 0; xt < 4; ++xt) a[xt] = MFMA16(hf[xt][0], r0[j], a[xt]);
#pragma unroll
                for (int xt = 0; xt < 4; ++xt) a[xt] = MFMA16(hf[xt][1], r1[j], a[xt]);
                lds_barrier();
                float s = 0.f; const float bs = bsv[j];
#pragma unroll
                for (int xt = 0; xt < 4; ++xt)
#pragma unroll
                    for (int r = 0; r < 4; ++r) s += a[xt][r];
                s = xrow_sum(s);
                const float mean = s * (1.f / 64.f); float q = 0.f;
#pragma unroll
                for (int xt = 0; xt < 4; ++xt)
#pragma unroll
                    for (int r = 0; r < 4; ++r) { const float d = a[xt][r] - mean; q += d * d; }
                q = xrow_sum(q);
                const float rstd = 1.0f / sqrtf(q * (1.f / 64.f) + 64e-5f);
#pragma unroll
                for (int xt = 0; xt < 4; ++xt) { const f32x4 vv = unpack4(uv[j][xt]), gg = unpack4(ug[j][xt]), lg4 = *(const LAS f32x4*)(lgl + 16 * xt), lb4 = *(const LAS f32x4*)(lbl + 16 * xt); f32x4 o;
#pragma unroll
                    for (int r = 0; r < 4; ++r) o[r] = ((a[xt][r] - mean) * rstd * lg4[r] + lb4[r] + bs * vv[r]) * gg[r];
                    *(LAS u32x2*)(ystg + jl * LDP + 16 * xt + 4 * g) = pack4(o); }
#pragma unroll
                for (int p = 0; p < 2; ++p) { const int rr_ = (lane >> 3) + 8 * p; const u32x4 vrow = *(const LAS u32x4*)(ystg + rr_ * LDP + 8 * (lane & 7));
                    *(u32x4*)(YA + (size_t)(bl * SEQ + (c4 + j) * 64 + 16 * wt + rr_) * 512 + h * 64 + 8 * (lane & 7)) = vrow; }
                lds_barrier();
            }
        }
#undef S2B_LOAD
    }
}

__device__ __forceinline__ void ph_dsa_prep(Frame& F, int l, int half) {
    bf16_t* CB = (bf16_t*)(F.ws + MX_CB); bf16_t* VT = (bf16_t*)(F.ws + MX_VT);
    const int* pos = (const int*)KARGP(F, I_POS) + (size_t)half * TH;
    const int lane = F.lane, j = lane & 7;
    float invf[4]; f32x4 gq[2], gk[2], gik[2];
#pragma unroll
    for (int i = 0; i < 4; ++i) invf[i] = __builtin_amdgcn_exp2f(-(float)(2 * (4 * j + i)) * (13.287712379549449f / 64.0f));
#pragma unroll
    for (int hf = 0; hf < 2; ++hf) { gq[hf] = *(const f32x4*)(FIN(F, I_QN) + l * 64 + 32 * hf + 4 * j); gk[hf] = *(const f32x4*)(FIN(F, I_KN) + l * 64 + 32 * hf + 4 * j); gik[hf] = *(const f32x4*)(FIN(F, I_IKN) + l * 64 + 32 * hf + 4 * j); }
    lbf* vst = (lbf*)F.lds;
    for (int tile = F.bid; tile < TH / 64; tile += F.G) {
        lds_barrier();
        u32x2 r1[8][3], r2[8][3]; int pv[8];
#pragma unroll
        for (int k8 = 0; k8 < 8; ++k8) { const int t = tile * 64 + 8 * F.wave + k8; pv[k8] = pos[t]; const bf16_t* row = CB + (size_t)t * DS_PAD;
#pragma unroll
            for (int ps = 0; ps < 3; ++ps) { const int vec = 8 * ps + (lane >> 3); const bf16_t* vp = row + (vec < 19 ? vec : 18) * 64 + 4 * j; r1[k8][ps] = *(const u32x2*)vp; r2[k8][ps] = *(const u32x2*)(vp + 32); } }
#pragma unroll
        for (int k8 = 0; k8 < 8; ++k8) {
        const int tk = 8 * F.wave + k8, t = tile * 64 + tk;
        const float p = (float)pv[k8];
        f32x4 cs, sn;
#pragma unroll
        for (int i = 0; i < 4; ++i) { float rev = p * invf[i] * 0.15915494309189535f; rev = rev - floorf(rev); cs[i] = __builtin_amdgcn_cosf(rev); sn[i] = __builtin_amdgcn_sinf(rev); }
        bf16_t* row = CB + (size_t)t * DS_PAD;
#pragma unroll
        for (int ps = 0; ps < 3; ++ps) {
            const int vec = 8 * ps + (lane >> 3);
            {
                bf16_t* vp = row + vec * 64 + 4 * j;
                const u32x2 u1 = r1[k8][ps], u2 = r2[k8][ps];
                f32x4 x1 = unpack4(u1), x2 = unpack4(u2);
                if (vec == 9) {
                    vst[(4 * j + 0) * LDP + tk] = (bf16_t)(u1.x & 0xffffu); vst[(4 * j + 1) * LDP + tk] = (bf16_t)(u1.x >> 16); vst[(4 * j + 2) * LDP + tk] = (bf16_t)(u1.y & 0xffffu); vst[(4 * j + 3) * LDP + tk] = (bf16_t)(u1.y >> 16);
                    vst[(32 + 4 * j + 0) * LDP + tk] = (bf16_t)(u2.x & 0xffffu); vst[(32 + 4 * j + 1) * LDP + tk] = (bf16_t)(u2.x >> 16); vst[(32 + 4 * j + 2) * LDP + tk] = (bf16_t)(u2.y & 0xffffu); vst[(32 + 4 * j + 3) * LDP + tk] = (bf16_t)(u2.y >> 16);
                } else {
                    const bool nrm = (vec < 9) || (vec == 18);
                    float ss = (x1[0] * x1[0] + x1[1] * x1[1]) + (x1[2] * x1[2] + x1[3] * x1[3]) + (x2[0] * x2[0] + x2[1] * x2[1]) + (x2[2] * x2[2] + x2[3] * x2[3]);
                    ss = sum8(ss);
                    if (nrm) { float rstd = 1.0f / sqrtf(ss * (1.f / 64.f) + 1e-6f); if (vec < 8) rstd *= 0.125f * 1.4426950409f;
                        const f32x4 g1 = vec < 8 ? gq[0] : (vec == 8 ? gk[0] : gik[0]), g2 = vec < 8 ? gq[1] : (vec == 8 ? gk[1] : gik[1]);
                        x1 = x1 * rstd * g1; x2 = x2 * rstd * g2; }
                    const f32x4 o1 = x1 * cs - x2 * sn, o2 = x2 * cs + x1 * sn;
                    if (vec < 19) { *(u32x2*)vp = pack4(o1); *(u32x2*)(vp + 32) = pack4(o2); }
                }
            }
        }
        }
        lds_barrier();
        { const int dim = F.tid >> 3, ch = F.tid & 7; const int t0 = tile * 64;
          *(u32x4*)(VT + ((size_t)(t0 >> 11) * 64 + dim) * SEQ + (t0 & (SEQ - 1)) + 8 * ch) = *(const LAS u32x4*)(vst + dim * LDP + 8 * ch); }
    }
}

constexpr int SC_LD = 2052;
__device__ __forceinline__ void lds_inc(LAS unsigned* p) { (void)__hip_atomic_fetch_add(p, 1u, __ATOMIC_RELAXED, __HIP_MEMORY_SCOPE_WORKGROUP); }
__device__ __forceinline__ unsigned okey(float s) { const unsigned u = __builtin_bit_cast(unsigned, s); return (u & 0x80000000u) ? ~u : (u | 0x80000000u); }
__device__ __forceinline__ int hist_find(LAS unsigned* hist, int lane, int& R, int& cnt) {
    const u32x4 c4 = *(const LAS u32x4*)(hist + 4 * lane);
    const unsigned tot = c4.x + c4.y + c4.z + c4.w;
    int pre = (int)tot;
    pre += __builtin_amdgcn_update_dpp(0, pre, 0x111, 0xf, 0xf, false);
    pre += __builtin_amdgcn_update_dpp(0, pre, 0x112, 0xf, 0xf, false);
    pre += __builtin_amdgcn_update_dpp(0, pre, 0x114, 0xf, 0xf, false);
    pre += __builtin_amdgcn_update_dpp(0, pre, 0x118, 0xf, 0xf, false);
    pre += __builtin_amdgcn_update_dpp(0, pre, 0x142, 0xa, 0xf, false);
    pre += __builtin_amdgcn_update_dpp(0, pre, 0x143, 0xc, 0xf, false);
    const unsigned above = (unsigned)__builtin_amdgcn_readlane(pre, 63) - (unsigned)pre;
    const unsigned suf = above + tot;
    const bool mine = (above < (unsigned)R) && ((unsigned)R <= suf);
    const unsigned long long bal = __ballot(mine);
    const int src = bal ? (int)__builtin_ctzll(bal) : 0;
    int bin, rr, cc;
    { unsigned a = above; int r_ = R;
      if ((unsigned)r_ <= a + c4.w) { bin = 4 * lane + 3; rr = r_ - (int)a; cc = (int)c4.w; } else { a += c4.w;
      if ((unsigned)r_ <= a + c4.z) { bin = 4 * lane + 2; rr = r_ - (int)a; cc = (int)c4.z; } else { a += c4.z;
      if ((unsigned)r_ <= a + c4.y) { bin = 4 * lane + 1; rr = r_ - (int)a; cc = (int)c4.y; } else { a += c4.y; bin = 4 * lane; rr = r_ - (int)a; cc = (int)c4.x; } } } }
    bin = __builtin_amdgcn_readlane(bin, src); rr = __builtin_amdgcn_readlane(rr, src); cc = __builtin_amdgcn_readlane(cc, src);
    R = rr; cnt = cc; return bin;
}
__device__ __forceinline__ void ph_dsa(Frame& F, int half, unsigned* qctr) {
    const bf16_t* CB = (const bf16_t*)(F.ws + MX_CB); const bf16_t* VT = (const bf16_t*)(F.ws + MX_VT);
    bf16_t* YB = (bf16_t*)(F.ws + MX_YB);
    LAS float* sc = (LAS float*)F.lds;
    LAS unsigned* hist = (LAS unsigned*)(F.lds + 16 * SC_LD * 4);
    LAS unsigned* msk = (LAS unsigned*)(F.lds + 16 * SC_LD * 4 + 16 * 256 * 4);
    lbf* KB = (lbf*)F.lds;
    lbf* VB = (lbf*)(F.lds + 2 * SLOT);
    const int lane = F.lane, w = F.wave, jl = lane & 15, g = lane >> 4;
    const int srow = F.tid >> 3, sseg = F.tid & 7;
    volatile LAS unsigned* qslot = (volatile LAS unsigned*)(F.lds + LDS_MISC + 64);
    for (;;) {
        if (F.tid == 0) *qslot = __hip_atomic_fetch_add(qctr, 1u, __ATOMIC_RELAXED, __HIP_MEMORY_SCOPE_AGENT);
        lds_barrier();
        const int ui = (int)*qslot; if (ui >= TH / 16) break;
        const int bl = ui & 15, q0 = (127 - (ui >> 4)) * 16, L = ((q0 >> 6) + 1) * 64;
        const int rowb = bl * SEQ;
        if (L > 256) for (int i = F.tid; i < 16 * 256; i += NTHR) hist[i] = 0u;
        lds_barrier();
        {
            bf16x8 yq[8][2]; float iw[8];
            const bf16_t* qrow = CB + (size_t)(rowb + q0 + jl) * DS_PAD;
#pragma unroll
            for (int h = 0; h < 8; ++h) { iw[h] = bf2f(qrow[1216 + h]);
#pragma unroll
                for (int s = 0; s < 2; ++s) yq[h][s] = *(const bf16x8*)(qrow + 640 + h * 64 + 32 * s + 8 * g); }
            const int nk = L / 16;
            const bf16_t* kbase = CB + (size_t)(rowb + jl) * DS_PAD + 1152 + 8 * g;
            bf16x8 xa[4], xb[4];
#define D1_LOAD(j, kt_) do { const int kc_ = (kt_) < nk ? (kt_) : 0; const bf16_t* kr_ = kbase + (size_t)(kc_ * 16) * DS_PAD; xa[j] = *(const bf16x8*)kr_; xb[j] = *(const bf16x8*)(kr_ + 32); } while (0)
#define D1_TILE(j, kt_) do { f32x4 s4 = (f32x4){0.f, 0.f, 0.f, 0.f}; \
                _Pragma("unroll") for (int h = 0; h < 8; ++h) { f32x4 a = (f32x4){0.f, 0.f, 0.f, 0.f}; a = MFMA16(xa[j], yq[h][0], a); a = MFMA16(xb[j], yq[h][1], a); \
                    _Pragma("unroll") for (int r = 0; r < 4; ++r) s4[r] += iw[h] * __builtin_amdgcn_fmed3f(a[r], 0.f, 3.0e38f); }        \
                const u32x4 k4 = (u32x4){okey(s4[0]), okey(s4[1]), okey(s4[2]), okey(s4[3])};        \
                *(LAS u32x4*)(sc + jl * SC_LD + (kt_) * 16 + 4 * g) = k4; \
                if (L > 256) { _Pragma("unroll") for (int r = 0; r < 4; ++r) lds_inc(hist + jl * 256 + (k4[r] >> 24)); } } while (0)
            D1_LOAD(0, w); D1_LOAD(1, w + 8); D1_LOAD(2, w + 16);
            int kt = w;
#pragma unroll 1
            for (; kt + 24 < nk; kt += 32) {
#pragma unroll
                for (int j = 0; j < 4; ++j) { D1_LOAD((j + 3) & 3, kt + 8 * j + 24); asm volatile("" ::: "memory"); D1_TILE(j, kt + 8 * j); }
            }
            if (kt < nk) D1_TILE(0, kt);
            if (kt + 8 < nk) D1_TILE(1, kt + 8);
            if (kt + 16 < nk) D1_TILE(2, kt + 16);
#undef D1_TILE
#undef D1_LOAD
        }
        lds_barrier();
        int R2[2] = {256, 256}, E2[2] = {0, 0}; unsigned pf2[2] = {0u, 0u};
        if (L > 256) {
            int w2_ = 2 * w; asm volatile("" : "+s"(w2_));
            LAS unsigned* hA = hist + w2_ * 256; LAS unsigned* hB = hA + 256; const LAS float* sA = sc + w2_ * SC_LD; const LAS float* sB = sA + SC_LD;
            pf2[0] = (unsigned)hist_find(hA, lane, R2[0], E2[0]); pf2[1] = (unsigned)hist_find(hB, lane, R2[1], E2[1]);
#pragma unroll 1
            for (int pass = 1; pass < 4; ++pass) {
                const int sh = 24 - 8 * pass;
                asm volatile("" ::: "memory");
                *(LAS u32x4*)(hA + 4 * lane) = pg8::zu4(); *(LAS u32x4*)(hB + 4 * lane) = pg8::zu4();
                LDS_WAIT(); asm volatile("" ::: "memory");
                for (int base = 0; base < L; base += 512) {
                    u32x4 s[2][2];
#pragma unroll
                    for (int u = 0; u < 2; ++u) { s[0][u] = *(const LAS u32x4*)(sA + base + 256 * u + 4 * lane); s[1][u] = *(const LAS u32x4*)(sB + base + 256 * u + 4 * lane); }
#pragma unroll
                    for (int u = 0; u < 2; ++u) { const bool in = base + 256 * u + 4 * lane < L;
#pragma unroll
                        for (int r = 0; r < 4; ++r) { const unsigned ka = s[0][u][r], kb = s[1][u][r];
                            if (in && (ka >> (sh + 8)) == pf2[0]) lds_inc(hA + ((ka >> sh) & 255u));
                            if (in && (kb >> (sh + 8)) == pf2[1]) lds_inc(hB + ((kb >> sh) & 255u)); } } }
                LDS_WAIT(); asm volatile("" ::: "memory");
                const int ba = hist_find(hA, lane, R2[0], E2[0]), bb = hist_find(hB, lane, R2[1], E2[1]);
                pf2[0] = (pf2[0] << 8) | (unsigned)ba; pf2[1] = (pf2[1] << 8) | (unsigned)bb;
            }
        }
#pragma unroll
        for (int qi = 0; qi < 2; ++qi) {
            const int qq = 2 * w + qi; const LAS float* sq = sc + qq * SC_LD; LAS unsigned* mq = msk + qq * 64;
            if (L <= 256) { mq[lane] = (lane < L / 32) ? 0xffffffffu : 0u; }
            else {
                const int R = R2[qi], E = E2[qi]; const unsigned prefix = pf2[qi];
                const unsigned thr = prefix;
                if (R >= E) {
                    for (int base = 0; base < L; base += 256) {
                        unsigned nib = 0u;
                        if (base + 4 * lane < L) { const u32x4 s = *(const LAS u32x4*)(sq + base + 4 * lane);
#pragma unroll
                            for (int r = 0; r < 4; ++r) nib |= (s[r] >= thr ? 1u : 0u) << r; }
                        unsigned wv = nib << (4 * (lane & 7));
                        wv = or8(wv);
                        if ((lane & 7) == 0) mq[(base >> 5) + (lane >> 3)] = wv;
                    }
                } else {
                    int taken = 0;
                    for (int base = 0; base < L; base += 64) {
                        bool take = false; bool eq = false;
                        if (base < L) { const unsigned k = ((const LAS unsigned*)sq)[base + lane]; take = k > thr; eq = (k == thr); }
                        const unsigned long long em = __ballot(eq);
                        const int myr = taken + __popcll(em & ((1ull << lane) - 1ull));
                        take = take || (eq && myr < R);
                        taken += __popcll(em);
                        const unsigned long long tm = __ballot(take);
                        if (lane == 0) { mq[base / 32] = (unsigned)tm; mq[base / 32 + 1] = (unsigned)(tm >> 32); }
                    }
                }
            }
        }
        lds_barrier();
        {
            const int qloc = 2 * w + (jl >> 3), hd = jl & 7;
            const bf16_t* qrow = CB + (size_t)(rowb + q0 + qloc) * DS_PAD + hd * 64;
            const bf16x8 yq0 = *(const bf16x8*)(qrow + 8 * g), yq1 = *(const bf16x8*)(qrow + 32 + 8 * g);
            f32x4 O[4];
#pragma unroll
            for (int dt = 0; dt < 4; ++dt) O[dt] = (f32x4){0.f, 0.f, 0.f, 0.f};
            float mrun = -1e30f, lsum = 0.f;
            const LAS unsigned* mq = msk + qloc * 64;
            const bf16_t* kg = CB + (size_t)(rowb + srow) * DS_PAD + 512 + 8 * sseg;
            const bf16_t* vg = VT + ((size_t)bl * 64 + srow) * SEQ + 8 * sseg;
            const int ntile = L / 64;
            u32x4 kreg = *(const u32x4*)kg, vreg = *(const u32x4*)vg;
            *(LAS u32x4*)(KB + srow * LDP + 8 * sseg) = kreg; *(LAS u32x4*)(VB + srow * LDP + 8 * sseg) = vreg;
            lds_barrier();
            for (int it = 0; it < ntile; ++it) {
                { const int itn = (it + 1 < ntile) ? it + 1 : it; kreg = *(const u32x4*)(kg + (size_t)(itn * 64) * DS_PAD); vreg = *(const u32x4*)(vg + itn * 64); asm volatile("" ::: "memory"); }
                const lbf* Kt = KB + (it & 1) * 64 * LDP; const lbf* Vt = VB + (it & 1) * 64 * LDP;
                f32x4 s[4]; bf16x8 kf[4][2];
#pragma unroll
                for (int tl = 0; tl < 4; ++tl) { const lbf* xr = Kt + (16 * tl + jl) * LDP + 8 * g; kf[tl][0] = *(const LAS bf16x8*)xr; kf[tl][1] = *(const LAS bf16x8*)(xr + 32); }
                u32x2 vlo[4][2], vhi[4][2];
#pragma unroll
                for (int dt = 0; dt < 4; ++dt)
#pragma unroll
                    for (int ks = 0; ks < 2; ++ks) { const lbf* vr = Vt + (16 * dt + jl) * LDP + 32 * ks + 4 * g; vlo[dt][ks] = *(const LAS u32x2*)vr; vhi[dt][ks] = *(const LAS u32x2*)(vr + 16); }
#pragma unroll
                for (int tl = 0; tl < 4; ++tl) s[tl] = MFMA16(kf[tl][0], yq0, ((f32x4){0.f, 0.f, 0.f, 0.f}));
#pragma unroll
                for (int tl = 0; tl < 4; ++tl) s[tl] = MFMA16(kf[tl][1], yq1, s[tl]);
                const unsigned mw0 = mq[2 * it], mw1 = mq[2 * it + 1];
                float mx = -1e30f;
#pragma unroll
                for (int tl = 0; tl < 4; ++tl)
#pragma unroll
                    for (int r = 0; r < 4; ++r) mx = fmaxf(mx, s[tl][r]);
                mx = xrow_max(mx);
                const float mnew = fmaxf(mrun, mx);
                if (__builtin_amdgcn_ballot_w64(mnew > mrun) != 0ull) {
                    const float alpha = __builtin_amdgcn_exp2f(mrun - mnew); mrun = mnew; lsum *= alpha;
#pragma unroll
                    for (int dt = 0; dt < 4; ++dt) O[dt] = O[dt] * alpha; }
                float p[16]; float ps = 0.f;
#pragma unroll
                for (int i = 0; i < 16; ++i) { const int tl = i >> 2, r = i & 3; const unsigned mw = (tl < 2) ? mw0 : mw1;
                    const int sel = __builtin_amdgcn_sbfe((int)mw, 16 * (tl & 1) + 4 * g + r, 1);
                    p[i] = __builtin_bit_cast(float, __builtin_bit_cast(int, __builtin_amdgcn_exp2f(s[tl][r] - mnew)) & sel); ps += p[i]; }
                lsum += ps;
                bf16x8 pf[2];
#pragma unroll
                for (int ks = 0; ks < 2; ++ks) { u32x4 pw; pw.x = pk2(p[8 * ks], p[8 * ks + 1]); pw.y = pk2(p[8 * ks + 2], p[8 * ks + 3]); pw.z = pk2(p[8 * ks + 4], p[8 * ks + 5]); pw.w = pk2(p[8 * ks + 6], p[8 * ks + 7]);
                    pf[ks] = __builtin_bit_cast(bf16x8, pw); }
#pragma unroll
                for (int ks = 0; ks < 2; ++ks)
#pragma unroll
                    for (int dt = 0; dt < 4; ++dt) O[dt] = MFMA16(__builtin_bit_cast(bf16x8, (u32x4){vlo[dt][ks].x, vlo[dt][ks].y, vhi[dt][ks].x, vhi[dt][ks].y}), pf[ks], O[dt]);
                if (it + 1 < ntile) { *(LAS u32x4*)(KB + ((it + 1) & 1) * 64 * LDP + srow * LDP + 8 * sseg) = kreg; *(LAS u32x4*)(VB + ((it + 1) & 1) * 64 * LDP + srow * LDP + 8 * sseg) = vreg; }
                lds_barrier();
            }
            lsum = xrow_sum(lsum);
            const float inv = 1.0f / lsum;
            lbf* ostg = (lbf*)(F.lds + 4 * SLOT) + w * 16 * LDP;
#pragma unroll
            for (int dt = 0; dt < 4; ++dt) { u32x2 o; o.x = pk2(O[dt][0] * inv, O[dt][1] * inv); o.y = pk2(O[dt][2] * inv, O[dt][3] * inv); *(LAS u32x2*)(ostg + jl * LDP + 16 * dt + 4 * g) = o; }
#pragma unroll
            for (int p = 0; p < 2; ++p) { const int rr_ = (lane >> 3) + 8 * p; const u32x4 vrow = *(const LAS u32x4*)(ostg + rr_ * LDP + 8 * (lane & 7));
                *(u32x4*)(YB + (size_t)(rowb + q0 + 2 * w + (rr_ >> 3)) * 512 + (rr_ & 7) * 64 + 8 * (lane & 7)) = vrow; }
        }
    }
}

constexpr int MK_LD = 136, MV_LD = 264;
__device__ __forceinline__ void ph_mem_attn(Frame& F, int l) {
    const bf16_t* QM = (const bf16_t*)(F.ws + MA_QM); bf16_t* OM = (bf16_t*)(F.ws + MA_OM);
    const bf16_t* MK = (const bf16_t*)(F.ws + WS_MEMK) + (size_t)l * MEMROWS * 512; const bf16_t* MVT = (const bf16_t*)(F.ws + WS_MEMVT) + (size_t)l * MEMROWS * 512;
    lbf* KS = (lbf*)F.lds; lbf* VS = (lbf*)(F.lds + 256 * MK_LD * 2);
    const int lane = F.lane, jl = lane & 15, g = lane >> 4;
    const float* gq = FIN(F, I_MQN) + l * 128;
    f32x4 gqa[4], gqb[4];
#pragma unroll
    for (int s2 = 0; s2 < 4; ++s2) { gqa[s2] = *(const f32x4*)(gq + 32 * s2 + 8 * g); gqb[s2] = *(const f32x4*)(gq + 32 * s2 + 8 * g + 4); }
    for (int it = F.bid; it < NB * 4 * 2; it += F.G) {
        const int pair = it >> 1, b = pair >> 2, hh = pair & 3, sp0 = (it & 1) * 8;
        const bf16_t* kb_ = MK + ((size_t)b * 4 + hh) * 256 * 128; const bf16_t* vb_ = MVT + ((size_t)b * 4 + hh) * 128 * 256;
        lds_barrier();
#pragma unroll
        for (int i = 0; i < 8; ++i) { const int id = F.tid + NTHR * i;
            *(LAS u32x4*)(KS + (id >> 4) * MK_LD + 8 * (id & 15)) = *(const u32x4*)(kb_ + (size_t)(id >> 4) * 128 + 8 * (id & 15));
            *(LAS u32x4*)(VS + (id >> 5) * MV_LD + 8 * (id & 31)) = *(const u32x4*)(vb_ + (size_t)(id >> 5) * 256 + 8 * (id & 31)); }
        lds_barrier();
        u32x4 qn[4];
        { const bf16_t* qrow = QM + (size_t)(b * SEQ + sp0 * 128 + F.wave * 16 + jl) * 512 + hh * 128;
#pragma unroll
          for (int s2 = 0; s2 < 4; ++s2) qn[s2] = *(const u32x4*)(qrow + 32 * s2 + 8 * g); }
#pragma unroll 1
        for (int sp = 0; sp < 8; ++sp) {
        u32x4 qc[4];
#pragma unroll
        for (int s2 = 0; s2 < 4; ++s2) { qc[s2] = qn[s2]; asm volatile("" : "+v"(qc[s2])); }
        { const int spn = sp < 7 ? sp + 1 : sp; const bf16_t* qrow = QM + (size_t)(b * SEQ + (sp0 + spn) * 128 + F.wave * 16 + jl) * 512 + hh * 128;
#pragma unroll
          for (int s2 = 0; s2 < 4; ++s2) qn[s2] = *(const u32x4*)(qrow + 32 * s2 + 8 * g);
          asm volatile("" ::: "memory"); }
        float qv[4][8]; float ss = 0.f;
#pragma unroll
        for (int s2 = 0; s2 < 4; ++s2) { const u32x4 q = qc[s2];
            qv[s2][0] = bf_lo(q.x); qv[s2][1] = bf_hi(q.x); qv[s2][2] = bf_lo(q.y); qv[s2][3] = bf_hi(q.y); qv[s2][4] = bf_lo(q.z); qv[s2][5] = bf_hi(q.z); qv[s2][6] = bf_lo(q.w); qv[s2][7] = bf_hi(q.w);
#pragma unroll
            for (int i = 0; i < 8; ++i) ss += qv[s2][i] * qv[s2][i]; }
        ss = xrow_sum(ss);
        const float sc = (1.0f / sqrtf(ss * (1.f / 128.f) + 1e-6f)) * (0.08838834764831845f * 1.4426950409f);
        bf16x8 yq[4];
#pragma unroll
        for (int s2 = 0; s2 < 4; ++s2) { const float gp[8] = { gqa[s2][0], gqa[s2][1], gqa[s2][2], gqa[s2][3], gqb[s2][0], gqb[s2][1], gqb[s2][2], gqb[s2][3] }; u32x4 pw;
            pw.x = pk2(qv[s2][0] * sc * gp[0], qv[s2][1] * sc * gp[1]); pw.y = pk2(qv[s2][2] * sc * gp[2], qv[s2][3] * sc * gp[3]);
            pw.z = pk2(qv[s2][4] * sc * gp[4], qv[s2][5] * sc * gp[5]); pw.w = pk2(qv[s2][6] * sc * gp[6], qv[s2][7] * sc * gp[7]); yq[s2] = __builtin_bit_cast(bf16x8, pw); }
        f32x4 O[8];
#pragma unroll
        for (int dt = 0; dt < 8; ++dt) O[dt] = (f32x4){0.f, 0.f, 0.f, 0.f};
        float mrun = -1e30f, ls = 0.f;
#pragma unroll 1
        for (int hk = 0; hk < 2; ++hk) {
            f32x4 S[8];
#pragma unroll
            for (int kt = 0; kt < 8; ++kt) { const lbf* kr = KS + (128 * hk + 16 * kt + jl) * MK_LD + 8 * g; f32x4 a = (f32x4){0.f, 0.f, 0.f, 0.f};
#pragma unroll
                for (int s2 = 0; s2 < 4; ++s2) a = MFMA16(*(const LAS bf16x8*)(kr + 32 * s2), yq[s2], a);
                S[kt] = a; }
            float mx = -1e30f;
#pragma unroll
            for (int kt = 0; kt < 8; ++kt)
#pragma unroll
                for (int r = 0; r < 4; ++r) mx = fmaxf(mx, S[kt][r]);
            mx = xrow_max(mx);
            const float mnew = fmaxf(mrun, mx), alpha = __builtin_amdgcn_exp2f(mrun - mnew); mrun = mnew;
            float ps = 0.f; bf16x8 pf[4];
#pragma unroll
            for (int ks = 0; ks < 4; ++ks) { float p[8];
#pragma unroll
                for (int i = 0; i < 8; ++i) { p[i] = __builtin_amdgcn_exp2f(S[2 * ks + (i >> 2)][i & 3] - mnew); ps += p[i]; }
                u32x4 pw; pw.x = pk2(p[0], p[1]); pw.y = pk2(p[2], p[3]); pw.z = pk2(p[4], p[5]); pw.w = pk2(p[6], p[7]); pf[ks] = __builtin_bit_cast(bf16x8, pw); }
            ls = ls * alpha + ps;
#pragma unroll
            for (int dt = 0; dt < 8; ++dt) { f32x4 o = O[dt] * alpha; const lbf* vr = VS + (16 * dt + jl) * MV_LD + 128 * hk + 4 * g;
#pragma unroll
                for (int ks = 0; ks < 4; ++ks) { const u32x2 lo = *(const LAS u32x2*)(vr + 32 * ks), hi = *(const LAS u32x2*)(vr + 32 * ks + 16);
                    o = MFMA16(__builtin_bit_cast(bf16x8, (u32x4){lo.x, lo.y, hi.x, hi.y}), pf[ks], o); }
                O[dt] = o; }
        }
        ls = xrow_sum(ls);
        const float inv = 1.0f / ls;
        lbf* ostg = (lbf*)(F.lds + 256 * MK_LD * 2 + 128 * MV_LD * 2) + F.wave * 16 * LDP;
        const int t0w = b * SEQ + (sp0 + sp) * 128 + F.wave * 16;
#pragma unroll
        for (int hf2 = 0; hf2 < 2; ++hf2) {
#pragma unroll
            for (int d4 = 0; d4 < 4; ++d4) { const int dt = 4 * hf2 + d4; u32x2 ov; ov.x = pk2(O[dt][0] * inv, O[dt][1] * inv); ov.y = pk2(O[dt][2] * inv, O[dt][3] * inv); *(LAS u32x2*)(ostg + jl * LDP + 16 * d4 + 4 * g) = ov; }
#pragma unroll
            for (int p = 0; p < 2; ++p) { const int rr_ = (lane >> 3) + 8 * p; const u32x4 vrow = *(const LAS u32x4*)(ostg + rr_ * LDP + 8 * (lane & 7));
                *(u32x4*)(OM + (size_t)(t0w + rr_) * 512 + hh * 128 + 64 * hf2 + 8 * (lane & 7)) = vrow; }
        }
        }
    }
}

__device__ __forceinline__ void ph_moe_route(Frame& F) {
    const unsigned short* sele = (const unsigned short*)(F.ws + MOE_SELE); const f32x2* selw = (const f32x2*)(F.ws + MOE_SELW);
    int* rowtok = (int*)(F.ws + MOE_ROWTOK); float* roww = (float*)(F.ws + MOE_ROWW); int* tile_e = (int*)(F.ws + MOE_TILEE); int* meta = (int*)(F.ws + MOE_META);
    float* rowrs = (float*)(F.ws + MOE_ROWRS); const float* rsv_ = (const float*)(F.ws + WS_RS);
    LAS unsigned long long* pc = (LAS unsigned long long*)F.lds;
    LAS int* tot = (LAS int*)(F.lds + 8192);
    LAS int* pre = tot + 16; LAS int* segb = tot + 32; LAS int* wcnt = tot + 64;
    __syncthreads();
    { unsigned long long c0 = 0ull, c1 = 0ull; const u32x4* sp = (const u32x4*)(sele + (size_t)F.tid * 128);
      for (int i = 0; i < 16; ++i) { const u32x4 v = sp[i]; const unsigned ww[4] = {v.x, v.y, v.z, v.w};
#pragma unroll
        for (int q = 0; q < 4; ++q) { const unsigned a = ww[q] & 0xffffu, b = ww[q] >> 16;
            c0 += 1ull << (8 * (a & 7u)); c1 += 1ull << (8 * ((a >> 8) & 7u)); c0 += 1ull << (8 * (b & 7u)); c1 += 1ull << (8 * ((b >> 8) & 7u)); } }
      pc[F.tid * 2] = c0; pc[F.tid * 2 + 1] = c1; }
    __syncthreads();
    if (F.tid < 32) { const int seg = F.tid & 15, kind = F.tid >> 4; const int slot = seg >> 3, e = seg & 7; const int lim = kind ? 2 * F.bid : 512; int s = 0;
        for (int i = 0; i < lim; ++i) s += (int)((pc[i * 2 + slot] >> (8 * e)) & 0xffull);
        if (kind) pre[seg] = s; else tot[seg] = s; }
    __syncthreads();
    if (F.tid == 0) { int b = 0; for (int s = 0; s < 16; ++s) { segb[s] = b; b += (tot[s] + 255) & ~255; } segb[16] = b; }
    __syncthreads();
    const int t = F.bid * 256 + (F.tid & 255); const unsigned se = sele[t]; const f32x2 sw = selw[t];
    const int myseg[2] = { (int)(se & 7u), 8 + (int)((se >> 8) & 7u) };
    int rank[2] = {0, 0};
    if (F.tid < 256) {
#pragma unroll
        for (int s = 0; s < 16; ++s) { const int k = s >> 3; const unsigned long long m = __ballot(myseg[k] == s);
            if (myseg[k] == s) rank[k] = __popcll(m & ((1ull << F.lane) - 1ull));
            if (F.lane == 0) wcnt[F.wave * 16 + s] = __popcll(m); }
    }
    __syncthreads();
    if (F.tid < 256) {
#pragma unroll
        for (int k = 0; k < 2; ++k) { const int s = myseg[k]; int off = 0; for (int ww = 0; ww < F.wave; ++ww) off += wcnt[ww * 16 + s];
            const int row = segb[s] + pre[s] + off + rank[k]; rowtok[row] = t; roww[row] = k ? sw.y : sw.x; rowrs[row] = rsv_[t]; }
    }
    if (F.bid == 0) {
        for (int s = 0; s < 16; ++s) { const int lo = segb[s] + tot[s], hi = segb[s + 1]; for (int r = lo + F.tid; r < hi; r += NTHR) { rowtok[r] = -1; roww[r] = 0.f; rowrs[r] = 0.f; } }
        for (int p = F.tid; p < segb[16] / 256; p += NTHR) { int e = 0; for (int s = 0; s < 16; ++s) if (p * 256 >= segb[s]) e = s & 7; tile_e[p] = e; }
        if (F.tid == 0) { meta[0] = segb[8] / 256; meta[1] = segb[16] / 256; }
    }
}

__global__ void __launch_bounds__(NTHR, 2) fwd(Args args) {
    extern __shared__ __attribute__((aligned(16))) unsigned char lds_raw[];
    Frame F;
    F.lds = (LAS unsigned char*)lds_raw; F.ws = args.ws; F.kb = __builtin_amdgcn_kernarg_segment_ptr(); F.out = args.out;
    F.tid = threadIdx.x; F.lane = F.tid & 63; F.wave = __builtin_amdgcn_readfirstlane(F.tid >> 6); F.G = gridDim.x; F.bid = blockIdx.x;
    volatile LAS unsigned* MISC = (volatile LAS unsigned*)(F.lds + LDS_MISC);
    if (F.tid < 64) MISC[F.tid] = 0u;
    __syncthreads();
    const int lo = args.ph_lo, hi = args.ph_hi;
    XcdBarrier bar; bar.bar = (unsigned*)(F.ws + WS_CTL) + 4096; bar.x = 0; bar.st = nullptr;
    if (hi - lo > 1) bar = xcd_barrier_post((unsigned*)(F.ws + WS_CTL) + 4096, MISC + 8);
    int ph = 0;
    const int wave_s_ = __builtin_amdgcn_readfirstlane((int)threadIdx.x >> 6);
#ifndef SITE_MASK
#define SITE_MASK 0xffffffffffffffffull
#endif
#ifndef PROBE_T_MASK
#define PROBE_T_MASK 0ull
#endif
#ifndef PROBE_T_FACTOR
#define PROBE_T_FACTOR 20ull
#endif
    unsigned long long tacc_ = 0ull, t0_ = 0ull;
#ifndef SITE_MASK
#define SITE_MASK 0xffffffffffffffffull
#endif
#define PHASE_BEGIN { constexpr int site_ = __COUNTER__; if (((SITE_MASK >> site_) & 1ull) && ph >= lo && ph < hi) { if (((PROBE_T_MASK >> site_) & 1ull) && F.bid == 0) t0_ = __builtin_amdgcn_s_memrealtime(); \
      { unsigned _m = ~0u; int _wv = wave_s_; asm volatile("" : "+s"(_m), "+s"(_wv)); int _t = _wv * 64 + (int)__builtin_amdgcn_mbcnt_hi(_m, __builtin_amdgcn_mbcnt_lo(_m, 0u)); asm volatile("" : "+v"(_t)); F.tid = _t; F.lane = _t & 63; F.wave = _wv; { int _b = blockIdx.x, _g = gridDim.x; asm volatile("" : "+s"(_b), "+s"(_g)); F.bid = _b; F.G = _g; } \
      kptr_t _kb = __builtin_amdgcn_kernarg_segment_ptr(); asm volatile("" : "+s"(_kb)); F.kb = _kb; \
      __attribute__((address_space(1))) unsigned char* _w = (__attribute__((address_space(1))) unsigned char*)args.ws; asm volatile("" : "+s"(_w)); F.ws = (unsigned char*)_w; ws = F.ws; __attribute__((address_space(1))) float* _o = (__attribute__((address_space(1))) float*)args.out; asm volatile("" : "+s"(_o)); F.out = (float*)_o; }
#define PHASE_END   if (ph + 1 < hi) xcd_barrier(bar, F.tid); if (((PROBE_T_MASK >> site_) & 1ull) && F.bid == 0) tacc_ += __builtin_amdgcn_s_memrealtime() - t0_; } ++ph; }
#define PHASE_END_NB if (((PROBE_T_MASK >> site_) & 1ull) && F.bid == 0) tacc_ += __builtin_amdgcn_s_memrealtime() - t0_; } ++ph; }
    unsigned char* ws = F.ws;
#define HN ((const bf16_t*)(ws + WS_HN))

    PHASE_BEGIN ph_prologue0(F); PHASE_END
    PHASE_BEGIN { pg8::Gemm g{(const bf16_t*)(ws + WS_MEMH), (const bf16_t*)(ws + WS_WKV), D, 0, nullptr}; pg8::StaticOrder S; S.init(MEMROWS, 4096, F.G, F.bid);
        pg8::EpiPlain E{(bf16_t*)(ws + PR_KVRAW), 4096}; pg8::gemm_phase<pg8::EpiPlain, pg8::StaticOrder>(F.lds, g, S, E, F.tid); } PHASE_END
    PHASE_BEGIN ph_prologue2(F); PHASE_END

#pragma unroll 1
    for (int l = 0; l < DEPTH; ++l) {

        PHASE_BEGIN ph_layer0(F, l, (const bf16_t*)F.out); PHASE_END
#pragma unroll 1
        for (int half = 0; half < 2; ++half) {

            PHASE_BEGIN { pg8::Gemm g{(l ? (const bf16_t*)F.out : HN) + (size_t)half * TH * D, (const bf16_t*)(ws + W_IN), D, 0, nullptr}; pg8::StaticOrder S; S.init(TH, N_INP, F.G, F.bid);
                pg8::EpiWin E{(bf16_t*)(ws + MX_CA), (bf16_t*)(ws + MX_CB), (bf16_t*)(ws + MX_CG), l ? (const float*)(ws + WS_RS) + (size_t)half * TH : nullptr}; pg8::gemm_phase<pg8::EpiWin, pg8::StaticOrder>(F.lds, g, S, E, F.tid); } PHASE_END
                        #ifndef PROBE_RPREP
#define PROBE_RPREP 1
#endif
#ifndef PROBE_S2
#define PROBE_S2 1
#endif
#ifndef PROBE_DSA
#define PROBE_DSA 1
#endif
            PHASE_BEGIN ph_rwkv_pre(F, l, half); ph_dsa_prep(F, l, half); PHASE_END
            PHASE_BEGIN ph_rwkv_s1(F, l, half); PHASE_END
            PHASE_BEGIN { for (int r_ = 0; r_ < PROBE_S2; ++r_) for (int p = F.bid; p < 128; p += F.G) ph_rwkv_s2(F, l, p); ph_dsa(F, half, (unsigned*)(ws + WS_CTL) + 8192 + 64 * (2 * l + half)); } PHASE_END
            PHASE_BEGIN { pg8::Gemm g{(const bf16_t*)(ws + MX_CA + RW_ARR), (const bf16_t*)(ws + W_BA), 512, 0, nullptr}; pg8::StaticOrder S; S.init(TH, D, F.G, F.bid);
                pg8::EpiMerge<false> E{(bf16_t*)(ws + WS_HN) + (size_t)half * TH * D, (const bf16_t*)(ws + MX_CG), 0}; pg8::gemm_phase<pg8::EpiMerge<false>, pg8::StaticOrder>(F.lds, g, S, E, F.tid); } PHASE_END_NB
            PHASE_BEGIN { pg8::Gemm g{(const bf16_t*)(ws + MX_YB), (const bf16_t*)(ws + W_BB), 512, 0, nullptr}; pg8::StaticOrder S; S.init(TH, D, F.G, F.bid);
                pg8::EpiMerge<true> E{(bf16_t*)(ws + WS_HN) + (size_t)half * TH * D, (const bf16_t*)(ws + MX_CG), 1024}; pg8::gemm_phase<pg8::EpiMerge<true>, pg8::StaticOrder>(F.lds, g, S, E, F.tid); } PHASE_END
        }
        PHASE_BEGIN { pg8::Gemm g{HN, (const bf16_t*)(ws + W_OUT), D, 0, nullptr}; pg8::StaticOrder S; S.init(T, D, F.G, F.bid);
            pg8::EpiResid E{l ? (const void*)F.out : (const void*)FIN(F, I_X), (l == DEPTH - 1 ? (bf16_t*)(ws + WS_XS2) : (bf16_t*)F.out), l ? 0 : 1, (float*)(ws + WS_PART)};        pg8::gemm_phase<pg8::EpiResid, pg8::StaticOrder>(F.lds, g, S, E, F.tid); } PHASE_END
        PHASE_BEGIN {
            { pg8::StaticOrder S0; S0.init(T, 512, F.G, F.bid); pg8::Unit u_; const float* pp_ = (const float*)(ws + WS_PART); float* rsw_ = (float*)(ws + WS_RS);
              for (int i_ = 0; S0.next(i_, u_); ++i_) if (F.tid < 256) { const int row_ = u_.pm * 256 + F.tid; const f32x4* p4 = (const f32x4*)(pp_ + (size_t)row_ * 16); const f32x4 a = p4[0], b = p4[1], c = p4[2], d = p4[3];
                  const float t_ = (((a.x + a.y) + (a.z + a.w)) + ((b.x + b.y) + (b.z + b.w))) + (((c.x + c.y) + (c.z + c.w)) + ((d.x + d.y) + (d.z + d.w))); rsw_[row_] = 1.0f / sqrtf(t_ * (1.f / D) + 1e-6f); }
              __builtin_amdgcn_fence(__ATOMIC_RELEASE, "workgroup"); __builtin_amdgcn_s_barrier(); __builtin_amdgcn_fence(__ATOMIC_ACQUIRE, "workgroup"); }
            pg8::Gemm g{(l == DEPTH - 1 ? (bf16_t*)(ws + WS_XS2) : (bf16_t*)F.out), (const bf16_t*)(ws + W_MQ), D, 0, nullptr}; pg8::StaticOrder S; S.init(T, 512, F.G, F.bid);
            pg8::EpiPlain E{(bf16_t*)(ws + MA_QM), 512, (const float*)(ws + WS_RS)}; pg8::gemm_phase<pg8::EpiPlain, pg8::StaticOrder>(F.lds, g, S, E, F.tid); } PHASE_END
        PHASE_BEGIN ph_mem_attn(F, l); PHASE_END
        PHASE_BEGIN { pg8::Gemm g{(const bf16_t*)(ws + MA_OM), (const bf16_t*)(ws + W_MO), 512, 0, nullptr}; pg8::StaticOrder S; S.init(T, D, F.G, F.bid);
            pg8::EpiResid E{(const void*)(l == DEPTH - 1 ? (bf16_t*)(ws + WS_XS2) : (bf16_t*)F.out), (l == DEPTH - 1 ? (bf16_t*)(ws + WS_XS2) : (bf16_t*)F.out), 0, (l & 1) ? nullptr : (float*)(ws + WS_PART)}; pg8::gemm_phase<pg8::EpiResid, pg8::StaticOrder>(F.lds, g, S, E, F.tid); } PHASE_END
        PHASE_BEGIN ph_norm_ffn(F, l, (l == DEPTH - 1 ? (bf16_t*)(ws + WS_XS2) : (bf16_t*)F.out)); PHASE_END
        if ((l & 1) == 0) {
            PHASE_BEGIN { pg8::Gemm g{(l == DEPTH - 1 ? (bf16_t*)(ws + WS_XS2) : (bf16_t*)F.out), (const bf16_t*)(ws + W_FGU), D, 0, nullptr}; pg8::StaticOrder S; S.init(T, 2 * FFN, F.G, F.bid);
                pg8::EpiSwiGLU E{(bf16_t*)(ws + FF_GU), FFN, (const float*)(ws + WS_RS)}; pg8::gemm_phase<pg8::EpiSwiGLU, pg8::StaticOrder>(F.lds, g, S, E, F.tid); } PHASE_END
            PHASE_BEGIN { pg8::Gemm g{(const bf16_t*)(ws + FF_GU), (const bf16_t*)(ws + W_FD), FFN, 0, nullptr}; pg8::StaticOrder S; S.init(T, D, F.G, F.bid);
                pg8::EpiResid E{(const void*)(l == DEPTH - 1 ? (bf16_t*)(ws + WS_XS2) : (bf16_t*)F.out), (l == DEPTH - 1 ? (bf16_t*)(ws + WS_XS2) : (bf16_t*)F.out), 0, (float*)(ws + WS_PART)}; pg8::gemm_phase<pg8::EpiResid, pg8::StaticOrder, false, true>(F.lds, g, S, E, F.tid); } PHASE_END
            ph += 2;
        } else {
#define meta ((const int*)(ws + MOE_META))
#define tile_e ((const int*)(ws + MOE_TILEE))
            const int last_ = (l == DEPTH - 1) ? 1 : 0;
            PHASE_BEGIN ph_moe_route(F); PHASE_END
            PHASE_BEGIN { const int nt1 = __builtin_amdgcn_readfirstlane(meta[1]);
                pg8::Gemm g{(l == DEPTH - 1 ? (bf16_t*)(ws + WS_XS2) : (bf16_t*)F.out), (const bf16_t*)(ws + W_EGU), D, (size_t)2 * EDIM * D, (const int*)(ws + MOE_ROWTOK)}; pg8::MoeOrder S; S.init(nt1, 11, F.G, F.bid, 0, tile_e);
                pg8::EpiSwiGLU E{(bf16_t*)(ws + FF_GU), EDIM, (const float*)(ws + MOE_ROWRS)}; pg8::gemm_phase<pg8::EpiSwiGLU, pg8::MoeOrder, true>(F.lds, g, S, E, F.tid); } PHASE_END
            PHASE_BEGIN { const int nt0 = __builtin_amdgcn_readfirstlane(meta[0]);
                pg8::Gemm g{(const bf16_t*)(ws + FF_GU), (const bf16_t*)(ws + W_ED), EDIM, (size_t)D * EDIM, nullptr}; pg8::MoeOrder S; S.init(nt0, 4, F.G, F.bid, 0, tile_e);
                pg8::EpiMoeDown E{(l == DEPTH - 1 ? (bf16_t*)(ws + WS_XS2) : (bf16_t*)F.out), (void*)(l == DEPTH - 1 ? (bf16_t*)(ws + WS_XS2) : (bf16_t*)F.out), (const int*)(ws + MOE_ROWTOK), (const float*)(ws + MOE_ROWW), 0}; pg8::gemm_phase<pg8::EpiMoeDown, pg8::MoeOrder, false, true>(F.lds, g, S, E, F.tid); } PHASE_END
            PHASE_BEGIN { const int nt0 = __builtin_amdgcn_readfirstlane(meta[0]), nt1 = __builtin_amdgcn_readfirstlane(meta[1]);
                pg8::Gemm g{(const bf16_t*)(ws + FF_GU), (const bf16_t*)(ws + W_ED), EDIM, (size_t)D * EDIM, nullptr}; pg8::MoeOrder S; S.init(nt1 - nt0, 4, F.G, F.bid, nt0, tile_e);
                pg8::EpiMoeDown E{(l == DEPTH - 1 ? (bf16_t*)(ws + WS_XS2) : (bf16_t*)F.out), (void*)F.out, (const int*)(ws + MOE_ROWTOK), (const float*)(ws + MOE_ROWW), last_, last_ ? nullptr : (float*)(ws + WS_PART)};       pg8::gemm_phase<pg8::EpiMoeDown, pg8::MoeOrder, false, true>(F.lds, g, S, E, F.tid); } PHASE_END
        }
    }
    if (PROBE_T_MASK != 0ull && F.bid == 0) { const unsigned long long te_ = __builtin_amdgcn_s_memrealtime() + PROBE_T_FACTOR * tacc_; while (__builtin_amdgcn_s_memrealtime() < te_) __builtin_amdgcn_s_sleep(32); }
}
constexpr int N_PHASES = 3 + DEPTH * (1 + 2 * 6 + 5 + 4);

extern "C" void kernel_launch(void* const* d_in, const int* in_sizes, int n_in, void* d_out, int out_size, void* d_ws, size_t ws_size, hipStream_t stream) {
    static int grid = 0;
    if (grid == 0) {
        if (n_in != 41 || out_size != T * D || ws_size < WS_END2) { fprintf(stderr, "kernel_launch: unexpected shapes (n_in %d, out %d, ws %zu < %zu); nothing launched\n", n_in, out_size, ws_size, (size_t)WS_END); grid = -1; return; }
        int dev = 0, cus = 0, per_cu = 0;
        if (hipGetDevice(&dev) != hipSuccess || hipDeviceGetAttribute(&cus, hipDeviceAttributeMultiprocessorCount, dev) != hipSuccess) { grid = -1; return; }
        if (hipFuncSetAttribute((const void*)fwd, hipFuncAttributeMaxDynamicSharedMemorySize, LDS_BYTES) != hipSuccess) { fprintf(stderr, "kernel_launch: hipFuncSetAttribute failed\n"); grid = -1; return; }
        if (hipOccupancyMaxActiveBlocksPerMultiprocessor(&per_cu, (const void*)fwd, NTHR, LDS_BYTES) != hipSuccess || per_cu < 1) fprintf(stderr, "kernel_launch: occupancy query reports %d\n", per_cu);
        (void)hipGetLastError();
        grid = cus;
    }
    if (grid < 0) return;
    if (hipMemsetAsync((char*)d_ws + WS_CTL, 0, CTL_ZERO_BYTES, stream) != hipSuccess) return;
    Args a{};
    for (int i = 0; i < 41; ++i) a.in[i] = d_in[i];
    a.out = (float*)d_out; a.ws = (unsigned char*)d_ws;
#if MK_ONE_LAUNCH
    a.ph_lo = 0; a.ph_hi = N_PHASES;
    hipLaunchKernelGGL(fwd, dim3(grid), dim3(NTHR), LDS_BYTES, stream, a);
#else
    for (int p = 0; p < N_PHASES; ++p) { a.ph_lo = p; a.ph_hi = p + 1; hipLaunchKernelGGL(fwd, dim3(grid), dim3(NTHR), LDS_BYTES, stream, a); }
#endif
}
```
